# Optimizing an MI355X kernel written in HIP

```python
import math
import jax, jax.numpy as jnp
from jax import lax
import numpy as np

D_MODEL = 1024
BATCH = 8
SEQ = 2048
DEPTH = 1

MEM_LEN = 256
HEAD_DIM = 64
NSA_HEADS = 16
NSA_KV_GROUPS = 4
NSA_HPG = NSA_HEADS // NSA_KV_GROUPS
CMP_LEN = 32
CMP_STRIDE = 16
CMP_HIDDEN = 256
SEL_BLOCK = 64
SEL_TOPK = 8
WINDOW = 512
Q_BLOCK = 128
ROPE_THETA = 500000.0
ROPE_DIM = HEAD_DIM // 4
RNN_WIDTH = D_MODEL
RNN_BLOCKS = 16
RNN_BLOCK_DIM = RNN_WIDTH // RNN_BLOCKS
CONV_WIDTH = 4
RGLRU_C = 8.0
XATTN_HEADS = 4
XATTN_WIDTH = XATTN_HEADS * HEAD_DIM
D_FF = 4 * D_MODEL
N_BRANCHES = 3
RMS_EPS = 1e-6

NSA_Q = NSA_HEADS * HEAD_DIM
NSA_KV = NSA_KV_GROUPS * HEAD_DIM
NSA_GATES = NSA_HEADS * 3
IN_WIDTHS = (NSA_Q, NSA_KV, NSA_KV, NSA_KV, NSA_KV, NSA_KV, NSA_KV, NSA_GATES,
             RNN_WIDTH, RNN_WIDTH, XATTN_WIDTH, N_BRANCHES * D_MODEL)
D_IN = sum(IN_WIDTHS)

kernel_name = "hybrid_nsa_rglru_gated_block"


def rms_norm(x, g):
    xf = x.astype(jnp.float32)
    y = xf * lax.rsqrt(jnp.mean(xf * xf, axis=-1, keepdims=True) + RMS_EPS)
    return (y * g.astype(jnp.float32)).astype(x.dtype)


def masked_softmax(s, mask):
    s = jnp.where(mask, s.astype(jnp.float32), -jnp.inf)
    m = jnp.max(s, axis=-1, keepdims=True)
    m = jnp.where(jnp.isfinite(m), m, 0.0)
    e = jnp.exp(s - m)
    return e / jnp.maximum(jnp.sum(e, axis=-1, keepdims=True), 1e-30)


def rope_tables(pos):
    inv = 1.0 / (ROPE_THETA ** (jnp.arange(0, ROPE_DIM, 2, dtype=jnp.float32) / ROPE_DIM))
    ang = pos.astype(jnp.float32)[:, None] * inv[None, :]
    return jnp.cos(ang), jnp.sin(ang)


def apply_partial_rope(x, cos, sin):
    half = ROPE_DIM // 2
    xf = x.astype(jnp.float32)
    x1 = xf[..., :half]
    x2 = xf[..., half:ROPE_DIM]
    out = jnp.concatenate([x1 * cos - x2 * sin, x2 * cos + x1 * sin, xf[..., ROPE_DIM:]], axis=-1)
    return out.astype(x.dtype)


def cmp_to_sel_weights(n_cmp, n_sel):
    c0 = np.arange(n_cmp)[:, None] * CMP_STRIDE
    s0 = np.arange(n_sel)[None, :] * SEL_BLOCK
    ov = np.clip(np.minimum(c0 + CMP_LEN, s0 + SEL_BLOCK) - np.maximum(c0, s0), 0, None)
    return (ov / CMP_LEN).astype(np.float32)


def compress_blocks(kv, pos_emb, w1, w2):
    B, G, S, hd = kv.shape
    n_cmp = (S - CMP_LEN) // CMP_STRIDE + 1
    idx = jnp.arange(n_cmp)[:, None] * CMP_STRIDE + jnp.arange(CMP_LEN)[None, :]
    blocks = kv[:, :, idx, :] + pos_emb
    flat = blocks.reshape(B, G, n_cmp, CMP_LEN * hd)
    return jax.nn.gelu(flat @ w1) @ w2


def nsa_mixer(q, k_c, v_c, k_s, v_s, k_w, v_w, gates):
    B, G, Hg, S, hd = q.shape
    n_cmp = k_c.shape[2]
    n_sel = S // SEL_BLOCK
    n_top = min(SEL_TOPK, n_sel)
    nq = S // Q_BLOCK
    scale = HEAD_DIM ** -0.5
    c2s = jnp.asarray(cmp_to_sel_weights(n_cmp, n_sel))
    cmp_end = jnp.arange(n_cmp) * CMP_STRIDE + (CMP_LEN - 1)
    ks_blocks = k_s.reshape(B, G, n_sel, SEL_BLOCK, hd)
    vs_blocks = v_s.reshape(B, G, n_sel, SEL_BLOCK, hd)
    kw_pad = jnp.pad(k_w, ((0, 0), (0, 0), (WINDOW, 0), (0, 0)))
    vw_pad = jnp.pad(v_w, ((0, 0), (0, 0), (WINDOW, 0), (0, 0)))
    bi = jnp.arange(B)[:, None, None, None]
    gi = jnp.arange(G)[None, :, None, None]
    blk_ids = jnp.arange(n_sel)

    def block(args):
        i, q_b, g_b = args
        t = i * Q_BLOCK + jnp.arange(Q_BLOCK)
        s_c = jnp.einsum('bghqd,bgnd->bghqn', q_b, k_c) * scale
        p_c = masked_softmax(s_c, cmp_end[None, :] <= t[:, None])
        o_c = jnp.einsum('bghqn,bgnd->bghqd', p_c.astype(q_b.dtype), v_c)
        imp = jnp.einsum('bghqn,ns->bgqs', p_c, c2s)
        cur = (t // SEL_BLOCK)[:, None]
        forced = (blk_ids == 0) | (blk_ids == cur) | (blk_ids == cur - 1)
        future = blk_ids * SEL_BLOCK > t[:, None]
        imp = jnp.where(forced, jnp.inf, jnp.where(future, -jnp.inf, imp))
        _, idx = lax.top_k(imp, n_top)
        k_g = ks_blocks[bi, gi, idx]
        v_g = vs_blocks[bi, gi, idx]
        key_pos = (idx[..., None] * SEL_BLOCK + jnp.arange(SEL_BLOCK)).reshape(B, G, 1, Q_BLOCK, n_top * SEL_BLOCK)
        s_s = jnp.einsum('bghqd,bgqkld->bghqkl', q_b, k_g).reshape(B, G, Hg, Q_BLOCK, n_top * SEL_BLOCK) * scale
        p_s = masked_softmax(s_s, key_pos <= t[:, None])
        o_s = jnp.einsum('bghqkl,bgqkld->bghqd',
                         p_s.astype(q_b.dtype).reshape(B, G, Hg, Q_BLOCK, n_top, SEL_BLOCK), v_g)
        start = i * Q_BLOCK
        k_b = lax.dynamic_slice_in_dim(kw_pad, start, Q_BLOCK + WINDOW, axis=2)
        v_b = lax.dynamic_slice_in_dim(vw_pad, start, Q_BLOCK + WINDOW, axis=2)
        w_pos = start - WINDOW + jnp.arange(Q_BLOCK + WINDOW)
        mask_w = (w_pos[None, :] <= t[:, None]) & (w_pos[None, :] > t[:, None] - WINDOW)
        s_w = jnp.einsum('bghqd,bgkd->bghqk', q_b, k_b) * scale
        p_w = masked_softmax(s_w, mask_w)
        o_w = jnp.einsum('bghqk,bgkd->bghqd', p_w.astype(q_b.dtype), v_b)
        return g_b[..., 0:1] * o_c + g_b[..., 1:2] * o_s + g_b[..., 2:3] * o_w

    q_blocks = jnp.moveaxis(q.reshape(B, G, Hg, nq, Q_BLOCK, hd), 3, 0)
    g_blocks = jnp.moveaxis(gates.reshape(B, G, Hg, nq, Q_BLOCK, 3), 3, 0)
    out = lax.map(block, (jnp.arange(nq), q_blocks, g_blocks))
    out = jnp.moveaxis(out, 0, 3).reshape(B, G, Hg, S, hd)
    return out.transpose(0, 3, 1, 2, 4).reshape(B, S, G * Hg * hd)


def causal_depthwise_conv(x, w, b):
    S = x.shape[1]
    xp = jnp.pad(x, ((0, 0), (CONV_WIDTH - 1, 0), (0, 0)))
    y = b
    for k in range(CONV_WIDTH):
        y = y + xp[:, k:k + S, :] * w[k]
    return y


def rg_lru(xr, w_a, b_a, w_i, b_i, lam):
    B, S, C = xr.shape
    xb = xr.reshape(B, S, RNN_BLOCKS, RNN_BLOCK_DIM)
    r = jax.nn.sigmoid(jnp.einsum('bsnk,nkj->bsnj', xb, w_a).reshape(B, S, C) + b_a)
    gi = jax.nn.sigmoid(jnp.einsum('bsnk,nkj->bsnj', xb, w_i).reshape(B, S, C) + b_i)
    log_a = -RGLRU_C * r.astype(jnp.float32) * jax.nn.softplus(-lam.astype(jnp.float32))
    a = jnp.exp(log_a)
    mult = jnp.sqrt(-jnp.expm1(2.0 * log_a))
    u = mult * (gi * xr).astype(jnp.float32)

    def combine(c1, c2):
        a1, b1 = c1
        a2, b2 = c2
        return a1 * a2, a2 * b1 + b2

    _, h = lax.associative_scan(combine, (a, u), axis=1)
    return h.astype(xr.dtype)


def cross_attention(q_x, mem, g_mem, w_mem_kv, w_xo):
    B, S, _ = q_x.shape
    M = mem.shape[1]
    q = q_x.reshape(B, S, XATTN_HEADS, HEAD_DIM)
    kv = (rms_norm(mem, g_mem) @ w_mem_kv).reshape(B, M, 2, XATTN_HEADS, HEAD_DIM)
    s = jnp.einsum('bshd,bmhd->bhsm', q, kv[:, :, 0]) * (HEAD_DIM ** -0.5)
    p = jax.nn.softmax(s.astype(jnp.float32), axis=-1).astype(q.dtype)
    o = jnp.einsum('bhsm,bmhd->bshd', p, kv[:, :, 1]).reshape(B, S, XATTN_WIDTH)
    return o @ w_xo


def setup_inputs(seed: int = 0) -> dict:
    key = jax.random.key(seed)
    ks = jax.random.split(key, 32)
    L = DEPTH

    def nrm(k, shape, fan_in):
        return jax.random.normal(k, shape, jnp.float32) * (fan_in ** -0.5)

    def gain(k, shape):
        return 1.0 + 0.02 * jax.random.normal(k, shape, jnp.float32)

    def small(k, shape):
        return 0.02 * jax.random.normal(k, shape, jnp.float32)

    u = jax.random.uniform(ks[20], (L, RNN_WIDTH), jnp.float32, 0.9, 0.999) ** (1.0 / RGLRU_C)
    rg_lambda = jnp.log(u) - jnp.log1p(-u)
    return {
        "x": jax.random.normal(ks[0], (BATCH, SEQ, D_MODEL), jnp.float32),
        "mem": jax.random.normal(ks[1], (BATCH, MEM_LEN, D_MODEL), jnp.float32),
        "g_mix": gain(ks[2], (L, D_MODEL)),
        "w_in": nrm(ks[3], (L, D_MODEL, D_IN), D_MODEL),
        "cmp_pos_k": small(ks[4], (L, CMP_LEN, HEAD_DIM)),
        "cmp_pos_v": small(ks[5], (L, CMP_LEN, HEAD_DIM)),
        "w_cmp_k1": nrm(ks[6], (L, CMP_LEN * HEAD_DIM, CMP_HIDDEN), CMP_LEN * HEAD_DIM),
        "w_cmp_k2": nrm(ks[7], (L, CMP_HIDDEN, HEAD_DIM), CMP_HIDDEN),
        "w_cmp_v1": nrm(ks[8], (L, CMP_LEN * HEAD_DIM, CMP_HIDDEN), CMP_LEN * HEAD_DIM),
        "w_cmp_v2": nrm(ks[9], (L, CMP_HIDDEN, HEAD_DIM), CMP_HIDDEN),
        "conv_w": nrm(ks[10], (L, CONV_WIDTH, RNN_WIDTH), CONV_WIDTH),
        "conv_b": small(ks[11], (L, RNN_WIDTH)),
        "w_rg_a": nrm(ks[12], (L, RNN_BLOCKS, RNN_BLOCK_DIM, RNN_BLOCK_DIM), RNN_BLOCK_DIM),
        "b_rg_a": small(ks[13], (L, RNN_WIDTH)),
        "w_rg_i": nrm(ks[14], (L, RNN_BLOCKS, RNN_BLOCK_DIM, RNN_BLOCK_DIM), RNN_BLOCK_DIM),
        "b_rg_i": small(ks[15], (L, RNN_WIDTH)),
        "rg_lambda": rg_lambda,
        "g_mem": gain(ks[16], (L, D_MODEL)),
        "w_mem_kv": nrm(ks[17], (L, D_MODEL, 2 * XATTN_WIDTH), D_MODEL),
        "w_xo": nrm(ks[18], (L, XATTN_WIDTH, D_MODEL), XATTN_WIDTH),
        "w_o": nrm(ks[19], (L, D_MODEL, D_MODEL), D_MODEL),
        "g_mlp": gain(ks[21], (L, D_MODEL)),
        "w_up": nrm(ks[22], (L, D_MODEL, D_FF), D_MODEL),
        "w_down": nrm(ks[23], (L, D_FF, D_MODEL), D_FF),
        "g_final": gain(ks[24], (D_MODEL,)),
    }


def reference(x, mem, g_mix, w_in, cmp_pos_k, cmp_pos_v, w_cmp_k1, w_cmp_k2, w_cmp_v1, w_cmp_v2,
              conv_w, conv_b, w_rg_a, b_rg_a, w_rg_i, b_rg_i, rg_lambda, g_mem, w_mem_kv, w_xo,
              w_o, g_mlp, w_up, w_down, g_final):
    B, S, D = x.shape
    G, Hg, hd = NSA_KV_GROUPS, NSA_HPG, HEAD_DIM
    offsets = np.cumsum(IN_WIDTHS)[:-1].tolist()
    cos, sin = rope_tables(jnp.arange(S))
    n_cmp = (S - CMP_LEN) // CMP_STRIDE + 1
    cos_c, sin_c = rope_tables(jnp.arange(n_cmp) * CMP_STRIDE + (CMP_LEN - 1))

    def to_groups(t):
        return t.reshape(B, S, G, hd).transpose(0, 2, 1, 3)

    h = x
    for l in range(DEPTH):
        u = rms_norm(h, g_mix[l])
        z = u @ w_in[l]
        (q_n, kc_raw, vc_raw, k_s, v_s, k_w, v_w, nsa_g,
         x_rnn, g_rnn, q_x, merge_g) = jnp.split(z, offsets, axis=-1)

        q = q_n.reshape(B, S, G, Hg, hd).transpose(0, 2, 3, 1, 4)
        q = apply_partial_rope(q, cos, sin)
        k_s = apply_partial_rope(to_groups(k_s), cos, sin)
        k_w = apply_partial_rope(to_groups(k_w), cos, sin)
        k_c = compress_blocks(to_groups(kc_raw), cmp_pos_k[l], w_cmp_k1[l], w_cmp_k2[l])
        k_c = apply_partial_rope(k_c, cos_c, sin_c)
        v_c = compress_blocks(to_groups(vc_raw), cmp_pos_v[l], w_cmp_v1[l], w_cmp_v2[l])
        nsa_gates = jax.nn.sigmoid(nsa_g).reshape(B, S, G, Hg, 3).transpose(0, 2, 3, 1, 4)
        y_nsa = nsa_mixer(q, k_c, v_c, k_s, to_groups(v_s), k_w, to_groups(v_w), nsa_gates)

        xc = causal_depthwise_conv(x_rnn, conv_w[l], conv_b[l])
        hr = rg_lru(xc, w_rg_a[l], b_rg_a[l], w_rg_i[l], b_rg_i[l], rg_lambda[l])
        y_rnn = jax.nn.gelu(g_rnn) * hr

        y_x = cross_attention(q_x, mem, g_mem[l], w_mem_kv[l], w_xo[l])

        gm = jax.nn.sigmoid(merge_g).reshape(B, S, N_BRANCHES, D)
        y = gm[:, :, 0] * y_nsa + gm[:, :, 1] * y_rnn + gm[:, :, 2] * y_x
        h = h + y @ w_o[l]

        v = rms_norm(h, g_mlp[l])
        h = h + jnp.square(jax.nn.relu(v @ w_up[l])) @ w_down[l]

    return rms_norm(h, g_final)
```

```cpp
#include <hip/hip_runtime.h>
#include <hip/hip_cooperative_groups.h>
#include <cstdint>
#include <cstdio>
namespace cg = cooperative_groups;

#ifndef MULTI
#define MULTI 0
#endif

typedef unsigned short bf16_t;
typedef short bf16x8 __attribute__((ext_vector_type(8)));
typedef float f32x4 __attribute__((ext_vector_type(4)));
typedef __bf16 bfv2 __attribute__((ext_vector_type(2)));
typedef float f32x2 __attribute__((ext_vector_type(2)));
typedef unsigned u32x4 __attribute__((ext_vector_type(4)));
typedef unsigned u32x2 __attribute__((ext_vector_type(2)));
#define DEV __device__ __forceinline__
DEV int opaque_tid() { int t = threadIdx.x; asm volatile("" : "+v"(t)); return t; }
#define MFMA16(a, b, c) __builtin_amdgcn_mfma_f32_16x16x32_bf16((a), (b), (c), 0, 0, 0)

constexpr int T = 16384, S = 2048;
constexpr int ZW = 4480;
constexpr int C_Q = 0, C_KC = 1024, C_VC = 1280, C_KS = 1536, C_KW = 1792, C_XR = 2048, C_GR = 3072, C_QX = 4096, C_G = 4352;
constexpr int NCMP = 127;
constexpr int NCROWS = 4064;

constexpr size_t O_WTA = 0;
constexpr size_t O_WTB = O_WTA + (size_t)4992 * 1024 * 2;
constexpr size_t O_WTUP = O_WTB + (size_t)3072 * 1024 * 2;
constexpr size_t O_WTDN = O_WTUP + (size_t)4096 * 1024 * 2;
constexpr size_t O_WTO = O_WTDN + (size_t)4096 * 1024 * 2;
constexpr size_t O_WTXO = O_WTO + (size_t)1024 * 1024 * 2;
constexpr size_t O_WTMKV = O_WTXO + (size_t)1024 * 256 * 2;
constexpr size_t O_WTCK1 = O_WTMKV + (size_t)512 * 1024 * 2;
constexpr size_t O_WTCV1 = O_WTCK1 + (size_t)256 * 2048 * 2;
constexpr size_t O_WAT = O_WTCV1 + (size_t)256 * 2048 * 2;
constexpr size_t O_WIT = O_WAT + (size_t)16 * 64 * 64 * 2;
constexpr size_t O_ROPEC = O_WIT + (size_t)16 * 64 * 64 * 2;
constexpr size_t O_ROPES = O_ROPEC + (size_t)2048 * 8 * 4;
constexpr size_t O_MEMN = O_ROPES + (size_t)2048 * 8 * 4;
constexpr size_t O_MEMK = O_MEMN + (size_t)2048 * 1024 * 2;
constexpr size_t O_MEMVT = O_MEMK + (size_t)2048 * 256 * 2;
constexpr size_t O_HIDK = O_MEMVT + (size_t)2048 * 256 * 2;
constexpr size_t O_HIDV = O_HIDK + (size_t)4096 * 256 * 2;
constexpr size_t O_KC = O_HIDV + (size_t)4096 * 256 * 2;
constexpr size_t O_VCT = O_KC + (size_t)32 * 128 * 64 * 2;
constexpr size_t O_AUX_END = O_VCT + (size_t)32 * 64 * 128 * 2;
static_assert(O_AUX_END <= (size_t)64 << 20, "aux overflow");
constexpr size_t MiB = (size_t)1 << 20;
constexpr size_t W_U = 0, W_ZA = 32 * MiB, W_VST = 172 * MiB, W_VWT = 180 * MiB, W_YX = 188 * MiB, W_Y = 220 * MiB;
constexpr size_t W_H = 32 * MiB, W_VN = 0, W_HID = 96 * MiB;

struct Params {
    const float *x, *mem, *g_mix, *w_in, *cpk, *cpv, *wk1, *wk2, *wv1, *wv2, *conv_w, *conv_b, *w_a, *b_a, *w_i, *b_i, *lam,
        *g_mem, *w_mkv, *w_xo, *w_o, *g_mlp, *w_up, *w_down, *g_final;
    float* out;
    char* ws;
};

DEV float bf2f(bf16_t h) { return __uint_as_float(((unsigned)h) << 16); }
DEV unsigned pk2(float lo, float hi) { f32x2 v = {lo, hi}; bfv2 b = __builtin_convertvector(v, bfv2); return __builtin_bit_cast(unsigned, b); }
DEV bf16_t f2bf(float f) { return (bf16_t)(pk2(f, 0.f) & 0xffffu); }
DEV float lo_f(unsigned u) { return __uint_as_float(u << 16); }
DEV float hi_f(unsigned u) { return __uint_as_float(u & 0xffff0000u); }
DEV float sigm(float x) { return 1.f / (1.f + __expf(-x)); }
DEV float gelu_t(float x) {
    float y = 0.7978845608028654f * (x + 0.044715f * x * x * x);
    float e = __expf(2.f * y);
    float th = 1.f - 2.f / (1.f + e);
    return 0.5f * x * (1.f + th);
}
DEV float wave_sum(float v) {
#pragma unroll
    for (int o = 32; o >= 1; o >>= 1) v += __shfl_xor(v, o);
    return v;
}

DEV int map_col(int mapid, int r) {
    if (mapid == 0) return r;
    if (mapid == 1) {
        if (r < 1536) return r;
        if (r < 1792) return 1536 + (r - 1536);
        if (r < 2048) return 2048 + (r - 1792);
        if (r < 3072) return 2608 + (r - 2048);
        if (r < 4096) return 3632 + (r - 3072);
        if (r < 4352) return 4656 + (r - 4096);
        if (r < 4400) return 2560 + (r - 4352);
        if (r < 4480) return -1;
        if (r < 4736) return 1792 + (r - 4480);
        return 2304 + (r - 4736);
    }
    int pn = r / 192, rem = r - pn * 192, wc = rem / 96, rem2 = rem - wc * 96, gidx = rem2 >> 5, cc = rem2 & 31;
    return 4912 + gidx * 1024 + pn * 64 + wc * 32 + cc;
}

DEV void transpose_tile(const float* __restrict__ src, int ld, bf16_t* __restrict__ dst, int K, int r0, int k0, int mapid, char* smem) {
    float* sm = (float*)smem;
    const int tid = threadIdx.x, lane = tid & 63, w = tid >> 6;
    __syncthreads();
    const int sc = map_col(mapid, r0 + lane);
#pragma unroll
    for (int i = 0; i < 16; ++i) {
        int kk = w + 4 * i;
        float v = sc >= 0 ? src[(size_t)(k0 + kk) * ld + sc] : 0.f;
        sm[kk * 65 + lane] = v;
    }
    __syncthreads();
    const int rr = tid >> 2, kq = (tid & 3) * 16;
    unsigned o[8];
#pragma unroll
    for (int e = 0; e < 8; ++e) o[e] = pk2(sm[(kq + 2 * e) * 65 + rr], sm[(kq + 2 * e + 1) * 65 + rr]);
    uint4* dp = (uint4*)(dst + (size_t)(r0 + rr) * K + k0 + kq);
    dp[0] = make_uint4(o[0], o[1], o[2], o[3]);
    dp[1] = make_uint4(o[4], o[5], o[6], o[7]);
}

template <bool OUTF32>
DEV void rownorm(const float* __restrict__ src, const float* __restrict__ g, bf16_t* dstb, float* dstf, int row) {
    const int lane = threadIdx.x & 63;
    const float4* sp = (const float4*)(src + (size_t)row * 1024);
    float4 v[4];
    float ss = 0.f;
#pragma unroll
    for (int i = 0; i < 4; ++i) { v[i] = sp[lane + 64 * i]; ss += v[i].x * v[i].x + v[i].y * v[i].y + v[i].z * v[i].z + v[i].w * v[i].w; }
    ss = wave_sum(ss);
    const float r = rsqrtf(ss * (1.0f / 1024.0f) + 1e-6f);
#pragma unroll
    for (int i = 0; i < 4; ++i) {
        float4 gg = ((const float4*)g)[lane + 64 * i];
        float a = v[i].x * r * gg.x, b = v[i].y * r * gg.y, c = v[i].z * r * gg.z, d = v[i].w * r * gg.w;
        if (OUTF32) ((float4*)(dstf + (size_t)row * 1024))[lane + 64 * i] = make_float4(a, b, c, d);
        else ((uint2*)(dstb + (size_t)row * 1024))[lane + 64 * i] = make_uint2(pk2(a, b), pk2(c, d));
    }
}

DEV void rope_job(float* ct, float* st, int job) {
    const int e = job * 256 + threadIdx.x;
    const int pos = e >> 3, i = e & 7;
    const double inv = exp(-(double)i * 0.125 * 13.122363377404328);
    const double ang = (double)pos * inv;
    const double kq = rint(ang * 0.6366197723675814);
    const double r = ang - kq * 1.5707963267948966;
    const double r2 = r * r;
    const double sn = r * (1.0 + r2 * (-1.0 / 6 + r2 * (1.0 / 120 + r2 * (-1.0 / 5040 + r2 * (1.0 / 362880 + r2 * (-1.0 / 39916800 + r2 * (1.0 / 6227020800.0)))))));
    const double cs = 1.0 + r2 * (-0.5 + r2 * (1.0 / 24 + r2 * (-1.0 / 720 + r2 * (1.0 / 40320 + r2 * (-1.0 / 3628800 + r2 * (1.0 / 479001600.0))))));
    const int q = ((int)kq) & 3;
    double s_, c_;
    if (q == 0) { s_ = sn; c_ = cs; } else if (q == 1) { s_ = cs; c_ = -sn; } else if (q == 2) { s_ = -sn; c_ = -cs; } else { s_ = -cs; c_ = sn; }
    ct[e] = (float)c_; st[e] = (float)s_;
}

struct ALPlain {
    const bf16_t* A; int lda;
    DEV u32x4 load(int row, int k) const { return *(const u32x4*)(A + (size_t)row * lda + k); }
};
struct ALCmp {
    const bf16_t* ZA; const float* pos; int colbase;
    DEV u32x4 load(int row, int k) const {
        if (row >= NCROWS) return (u32x4){0u, 0u, 0u, 0u};
        const int bg = row / NCMP, n = row - bg * NCMP, b = bg >> 2, g = bg & 3, j = k >> 6, d = k & 63;
        const u32x4 v = *(const u32x4*)(ZA + (size_t)(b * S + 16 * n + j) * ZW + colbase + g * 64 + d);
        const float4 p0 = *(const float4*)(pos + j * 64 + d), p1 = *(const float4*)(pos + j * 64 + d + 4);
        u32x4 o;
        o.x = pk2(lo_f(v.x) + p0.x, hi_f(v.x) + p0.y); o.y = pk2(lo_f(v.y) + p0.z, hi_f(v.y) + p0.w);
        o.z = pk2(lo_f(v.z) + p1.x, hi_f(v.z) + p1.y); o.w = pk2(lo_f(v.w) + p1.z, hi_f(v.w) + p1.w);
        return o;
    }
};

template <int TN, class AL, class EP>
DEV void gemm_tile(const AL& al, const bf16_t* __restrict__ Bt, int ldb, int K, int pm, int pn, const EP& ep, char* smem) {
    constexpr int BN = TN * 32;
    bf16_t* sA = (bf16_t*)smem;
    bf16_t* sB = sA + 128 * 72;
    const int tid = opaque_tid(), wid = tid >> 6, lane = tid & 63, wr = wid >> 1, wc = wid & 1, fr = lane & 15, fq = lane >> 4;
    f32x4 acc[4][TN];
#pragma unroll
    for (int m = 0; m < 4; ++m)
#pragma unroll
        for (int n = 0; n < TN; ++n) acc[m][n] = (f32x4){0.f, 0.f, 0.f, 0.f};
    const int lrow = tid >> 3, lk = (tid & 7) * 8;
    u32x4 ra[4], rb[TN];
    const bf16_t* bp = Bt + (size_t)(pn * BN + lrow) * ldb + lk;
#pragma unroll
    for (int i = 0; i < 4; ++i) ra[i] = al.load(pm * 128 + lrow + 32 * i, lk);
#pragma unroll
    for (int i = 0; i < TN; ++i) rb[i] = *(const u32x4*)(bp + (size_t)(32 * i) * ldb);
    const int nk = K >> 6;
    for (int kt = 0; kt < nk; ++kt) {
        __syncthreads();
#pragma unroll
        for (int i = 0; i < 4; ++i) *(u32x4*)(sA + (lrow + 32 * i) * 72 + lk) = ra[i];
#pragma unroll
        for (int i = 0; i < TN; ++i) *(u32x4*)(sB + (lrow + 32 * i) * 72 + lk) = rb[i];
        __syncthreads();
        if (kt + 1 < nk) {
            const int k0 = (kt + 1) * 64;
#pragma unroll
            for (int i = 0; i < 4; ++i) ra[i] = al.load(pm * 128 + lrow + 32 * i, k0 + lk);
#pragma unroll
            for (int i = 0; i < TN; ++i) rb[i] = *(const u32x4*)(bp + (size_t)(32 * i) * ldb + k0);
        }
#pragma unroll
        for (int ks = 0; ks < 2; ++ks) {
            bf16x8 af[4], bfr[TN];
#pragma unroll
            for (int m = 0; m < 4; ++m) af[m] = *(const bf16x8*)(sA + (wr * 64 + m * 16 + fr) * 72 + ks * 32 + fq * 8);
#pragma unroll
            for (int n = 0; n < TN; ++n) bfr[n] = *(const bf16x8*)(sB + (wc * TN * 16 + n * 16 + fr) * 72 + ks * 32 + fq * 8);
#pragma unroll
            for (int m = 0; m < 4; ++m)
#pragma unroll
                for (int n = 0; n < TN; ++n) acc[m][n] = MFMA16(af[m], bfr[n], acc[m][n]);
        }
    }
    ep.run(acc, pm, pn, wr, wc, fr, fq);
}

struct EpiZA {
    bf16_t *ZA, *VST, *VWT; const float *ropec, *ropes;
    DEV void run(f32x4 (&acc)[4][4], int pm, int pn, int wr, int wc, int fr, int fq) const {
#pragma unroll
        for (int n = 0; n < 4; ++n) {
            const int col0 = pn * 128 + wc * 64 + n * 16;
#pragma unroll
            for (int m = 0; m < 4; ++m) {
                const int r = pm * 128 + wr * 64 + m * 16 + 4 * fq;
                f32x4 a = acc[m][n];
                if (col0 >= 4480) {
                    int c = col0 - 4480 + fr;
                    bf16_t* dst = (c < 256) ? VST : VWT;
                    c &= 255;
                    const int g = c >> 6, d = c & 63, b = r >> 11, t = r & 2047;
                    *(uint2*)(dst + ((size_t)((b * 4 + g) * 64 + d)) * S + t) = make_uint2(pk2(a[0], a[1]), pk2(a[2], a[3]));
                    continue;
                }
                const bool rope = (col0 < 1024 || (col0 >= 1536 && col0 < 2048)) && ((col0 & 63) == 0);
                if (rope) {
                    const int i = fr & 7;
#pragma unroll
                    for (int j = 0; j < 4; ++j) {
                        const int t = (r + j) & 2047;
                        const float cs = ropec[t * 8 + i], sn = ropes[t * 8 + i];
                        const float pr = __shfl_xor(a[j], 8);
                        a[j] = (fr & 8) ? (a[j] * cs + pr * sn) : (a[j] * cs - pr * sn);
                    }
                }
                if (col0 >= C_G) {
#pragma unroll
                    for (int j = 0; j < 4; ++j) a[j] = sigm(a[j]);
                }
#pragma unroll
                for (int j = 0; j < 4; ++j) ZA[(size_t)(r + j) * ZW + col0 + fr] = f2bf(a[j]);
            }
        }
    }
};
struct EpiMemKV {
    bf16_t *MK, *MVT;
    DEV void run(f32x4 (&acc)[4][4], int pm, int pn, int wr, int wc, int fr, int fq) const {
#pragma unroll
        for (int n = 0; n < 4; ++n)
#pragma unroll
            for (int m = 0; m < 4; ++m) {
                const int c = pn * 128 + wc * 64 + n * 16 + fr, r = pm * 128 + wr * 64 + m * 16 + 4 * fq;
                const int which = c >> 8, h = (c >> 6) & 3, d = c & 63, b = r >> 8, mm = r & 255;
                const f32x4 a = acc[m][n];
                if (which == 0) {
#pragma unroll
                    for (int j = 0; j < 4; ++j) MK[((size_t)(b * 4 + h) * 256 + mm + j) * 64 + d] = f2bf(a[j]);
                } else {
                    *(uint2*)(MVT + ((size_t)(b * 4 + h) * 64 + d) * 256 + mm) = make_uint2(pk2(a[0], a[1]), pk2(a[2], a[3]));
                }
            }
    }
};
struct EpiHid {
    bf16_t* H;
    DEV void run(f32x4 (&acc)[4][4], int pm, int pn, int wr, int wc, int fr, int fq) const {
#pragma unroll
        for (int n = 0; n < 4; ++n)
#pragma unroll
            for (int m = 0; m < 4; ++m) {
                const int c = pn * 128 + wc * 64 + n * 16 + fr, r = pm * 128 + wr * 64 + m * 16 + 4 * fq;
#pragma unroll
                for (int j = 0; j < 4; ++j)
                    if (r + j < NCROWS) H[(size_t)(r + j) * 256 + c] = f2bf(gelu_t(acc[m][n][j]));
            }
    }
};
template <int ACT>
struct EpiBf {
    bf16_t* O; int ldo;
    DEV void run(f32x4 (&acc)[4][4], int pm, int pn, int wr, int wc, int fr, int fq) const {
#pragma unroll
        for (int n = 0; n < 4; ++n)
#pragma unroll
            for (int m = 0; m < 4; ++m) {
                const int c = pn * 128 + wc * 64 + n * 16 + fr, r = pm * 128 + wr * 64 + m * 16 + 4 * fq;
#pragma unroll
                for (int j = 0; j < 4; ++j) {
                    float v = acc[m][n][j];
                    if (ACT == 1) { v = fmaxf(v, 0.f); v = v * v; }
                    O[(size_t)(r + j) * ldo + c] = f2bf(v);
                }
            }
    }
};
struct EpiRes {
    const float* R; float* O;
    DEV void run(f32x4 (&acc)[4][4], int pm, int pn, int wr, int wc, int fr, int fq) const {
#pragma unroll
        for (int n = 0; n < 4; ++n)
#pragma unroll
            for (int m = 0; m < 4; ++m) {
                const int c = pn * 128 + wc * 64 + n * 16 + fr, r = pm * 128 + wr * 64 + m * 16 + 4 * fq;
#pragma unroll
                for (int j = 0; j < 4; ++j) { const size_t o = (size_t)(r + j) * 1024 + c; O[o] = R[o] + acc[m][n][j]; }
            }
    }
};
struct EpiMerge {
    const bf16_t *ZA, *YX; bf16_t* Y;
    DEV void run(f32x4 (&acc)[4][6], int pm, int pn, int wr, int wc, int fr, int fq) const {
#pragma unroll
        for (int sub = 0; sub < 2; ++sub)
#pragma unroll
            for (int m = 0; m < 4; ++m) {
                const int ch = pn * 64 + wc * 32 + sub * 16 + fr, r = pm * 128 + wr * 64 + m * 16 + 4 * fq;
#pragma unroll
                for (int j = 0; j < 4; ++j) {
                    const size_t row = (size_t)(r + j);
                    const float g0 = sigm(acc[m][sub][j]), g1 = sigm(acc[m][2 + sub][j]), g2 = sigm(acc[m][4 + sub][j]);
                    const float y = g0 * bf2f(ZA[row * ZW + C_Q + ch]) + g1 * bf2f(ZA[row * ZW + C_GR + ch]) + g2 * bf2f(YX[row * 1024 + ch]);
                    Y[row * 1024 + ch] = f2bf(y);
                }
            }
    }
};

DEV bool tile_map(int idx, int NT, int& pm, int& pn) {
    const int x = idx & 7, pl = (idx >> 3) & 7, pmid = (idx >> 6) & 7, st = idx >> 9;
    pm = ((st & 1) * 8 + pmid) * 8 + x;
    pn = (st >> 1) * 8 + pl;
    return pn < NT;
}
DEV int tile_count(int NT) { return 2 * ((NT + 7) / 8) * 512; }

DEV void cmp2_job(const Params& P, int job) {
    char* aux = (char*)P.out;
    const int lane = threadIdx.x & 63, w = threadIdx.x >> 6;
    const int wj = job * 4 + w;
    const int which = wj >= NCROWS ? 1 : 0;
    const int r = wj - which * NCROWS;
    const int bg = r / NCMP, n = r - bg * NCMP;
    const bf16_t* hid = (const bf16_t*)(aux + (which ? O_HIDV : O_HIDK)) + (size_t)r * 256;
    const float* w2 = which ? P.wv2 : P.wk2;
    float acc = 0.f;
#pragma unroll 8
    for (int k = 0; k < 256; ++k) acc += bf2f(hid[k]) * w2[k * 64 + lane];
    if (!which) {
        const int pos = 16 * n + 31, i = lane & 7;
        const float cs = ((const float*)(aux + O_ROPEC))[pos * 8 + i], sn = ((const float*)(aux + O_ROPES))[pos * 8 + i];
        const float pr = __shfl_xor(acc, 8);
        float o = acc;
        if (lane < 16) o = (lane & 8) ? (acc * cs + pr * sn) : (acc * cs - pr * sn);
        bf16_t* KC = (bf16_t*)(aux + O_KC);
        KC[((size_t)bg * 128 + n) * 64 + lane] = f2bf(o);
        if (n == NCMP - 1) KC[((size_t)bg * 128 + 127) * 64 + lane] = 0;
    } else {
        bf16_t* VCT = (bf16_t*)(aux + O_VCT);
        VCT[((size_t)bg * 64 + lane) * 128 + n] = f2bf(acc);
        if (n == NCMP - 1) VCT[((size_t)bg * 64 + lane) * 128 + 127] = 0;
    }
}

DEV void rnn_job(const Params& P, int job, char* smem) {
    char* aux = (char*)P.out;
    bf16_t* ZA = (bf16_t*)(P.ws + W_ZA);
    const int b = job >> 4, n = job & 15;
    bf16_t* sX = (bf16_t*)smem;
    float* sXf = (float*)(smem + 9216);
    float* sCw = (float*)(smem + 9216 + 16640);
    float* sSum = (float*)(smem + 9216 + 16640 + 1280);
    const int tid = opaque_tid(), w = tid >> 6, lane = tid & 63, fr = lane & 15, fq = lane >> 4;
    const bf16_t* WAT = (const bf16_t*)(aux + O_WAT) + n * 4096;
    const bf16_t* WIT = (const bf16_t*)(aux + O_WIT) + n * 4096;
    bf16x8 wa[4][2], wi[4][2];
    float ba[4], bi[4], cl[4], carry[4];
#pragma unroll
    for (int ct = 0; ct < 4; ++ct) {
#pragma unroll
        for (int ks = 0; ks < 2; ++ks) {
            wa[ct][ks] = *(const bf16x8*)(WAT + (16 * ct + fr) * 64 + 32 * ks + 8 * fq);
            wi[ct][ks] = *(const bf16x8*)(WIT + (16 * ct + fr) * 64 + 32 * ks + 8 * fq);
        }
        const int c = n * 64 + 16 * ct + fr;
        ba[ct] = P.b_a[c]; bi[ct] = P.b_i[c];
        cl[ct] = -8.0f * log1pf(__expf(-P.lam[c]));
        carry[ct] = 0.f;
    }
    __syncthreads();
    for (int i = tid; i < 320; i += 256) sCw[i] = (i < 256) ? P.conv_w[(i >> 6) * 1024 + n * 64 + (i & 63)] : P.conv_b[n * 64 + (i & 63)];
    for (int chunk = 0; chunk < 32; ++chunk) {
        const int tc = chunk * 64;
        __syncthreads();
        {
            const int t = tid >> 2, cg = (tid & 3) * 16;
            float xv[16];
#pragma unroll
            for (int e = 0; e < 16; ++e) xv[e] = sCw[256 + cg + e];
#pragma unroll
            for (int k = 0; k < 4; ++k) {
                const int tt = tc + t - 3 + k;
                if (tt >= 0) {
                    const u32x4* xp = (const u32x4*)(ZA + (size_t)(b * S + tt) * ZW + C_XR + n * 64 + cg);
                    const u32x4 v0 = xp[0], v1 = xp[1];
                    const unsigned u[8] = {v0.x, v0.y, v0.z, v0.w, v1.x, v1.y, v1.z, v1.w};
#pragma unroll
                    for (int e = 0; e < 8; ++e) {
                        xv[2 * e] += sCw[k * 64 + cg + 2 * e] * lo_f(u[e]);
                        xv[2 * e + 1] += sCw[k * 64 + cg + 2 * e + 1] * hi_f(u[e]);
                    }
                }
            }
#pragma unroll
            for (int e = 0; e < 16; ++e) sXf[t * 65 + cg + e] = xv[e];
            u32x4 o0 = {pk2(xv[0], xv[1]), pk2(xv[2], xv[3]), pk2(xv[4], xv[5]), pk2(xv[6], xv[7])};
            u32x4 o1 = {pk2(xv[8], xv[9]), pk2(xv[10], xv[11]), pk2(xv[12], xv[13]), pk2(xv[14], xv[15])};
            *(u32x4*)(sX + t * 72 + cg) = o0;
            *(u32x4*)(sX + t * 72 + cg + 8) = o1;
        }
        __syncthreads();
        bf16x8 af[2];
#pragma unroll
        for (int ks = 0; ks < 2; ++ks) af[ks] = *(const bf16x8*)(sX + (16 * w + fr) * 72 + 32 * ks + 8 * fq);
        float hl[4][4], pc[4][4], Ae[4], He[4];
#pragma unroll
        for (int ct = 0; ct < 4; ++ct) {
            f32x4 R = (f32x4){0.f, 0.f, 0.f, 0.f}, I = (f32x4){0.f, 0.f, 0.f, 0.f};
#pragma unroll
            for (int ks = 0; ks < 2; ++ks) { R = MFMA16(af[ks], wa[ct][ks], R); I = MFMA16(af[ks], wi[ct][ks], I); }
            float h = 0.f, pcum = 1.f;
#pragma unroll
            for (int j = 0; j < 4; ++j) {
                const float xcv = sXf[(16 * w + 4 * fq + j) * 65 + 16 * ct + fr];
                const float rg = sigm(R[j] + ba[ct]), gi = sigm(I[j] + bi[ct]);
                const float la = rg * cl[ct];
                const float a_ = __expf(la);
                const float mult = sqrtf(fmaxf(-expm1f(2.f * la), 0.f));
                const float u = mult * gi * xcv;
                h = a_ * h + u; pcum *= a_;
                hl[ct][j] = h; pc[ct][j] = pcum;
            }
            float A = pcum, H = h;
            float A1 = __shfl_up(A, 16), H1 = __shfl_up(H, 16);
            if (fq >= 1) { H = A * H1 + H; A = A * A1; }
            float A2 = __shfl_up(A, 32), H2 = __shfl_up(H, 32);
            if (fq >= 2) { H = A * H2 + H; A = A * A2; }
            float Ax = __shfl_up(A, 16), Hx = __shfl_up(H, 16);
            Ae[ct] = fq == 0 ? 1.f : Ax; He[ct] = fq == 0 ? 0.f : Hx;
            if (fq == 3) { sSum[w * 64 + 16 * ct + fr] = A; sSum[256 + w * 64 + 16 * ct + fr] = H; }
        }
        __syncthreads();
#pragma unroll
        for (int ct = 0; ct < 4; ++ct) {
            float cin = carry[ct], mycin = 0.f;
#pragma unroll
            for (int ww = 0; ww < 4; ++ww) {
                if (ww == w) mycin = cin;
                cin = sSum[ww * 64 + 16 * ct + fr] * cin + sSum[256 + ww * 64 + 16 * ct + fr];
            }
            carry[ct] = cin;
            const float sq = Ae[ct] * mycin + He[ct];
#pragma unroll
            for (int j = 0; j < 4; ++j) {
                const float hfin = hl[ct][j] + pc[ct][j] * sq;
                bf16_t* gp = ZA + (size_t)(b * S + tc + 16 * w + 4 * fq + j) * ZW + C_GR + n * 64 + 16 * ct + fr;
                *gp = f2bf(gelu_t(bf2f(*gp)) * hfin);
            }
        }
    }
}

constexpr float EXPC = 0.125f * 1.4426950408889634f;
struct AttnAcc { f32x4 o[4][2]; float m[2], l[2]; };
DEV void attn_init(AttnAcc& a) {
#pragma unroll
    for (int d = 0; d < 4; ++d)
#pragma unroll
        for (int q = 0; q < 2; ++q) a.o[d][q] = (f32x4){0.f, 0.f, 0.f, 0.f};
    a.m[0] = a.m[1] = -INFINITY; a.l[0] = a.l[1] = 0.f;
}
DEV bf16x8 mk8(unsigned a, unsigned b, unsigned c, unsigned d) { u32x4 u = {a, b, c, d}; return __builtin_bit_cast(bf16x8, u); }

template <class MF>
DEV void attn_step(const bf16_t* sK, const bf16_t* sVt, int vstride, const bf16x8 (&qf)[2][2], AttnAcc& st, const MF& mf, int fr, int fq) {
    f32x4 s[4][2];
#pragma unroll
    for (int kt = 0; kt < 4; ++kt) {
        s[kt][0] = (f32x4){0.f, 0.f, 0.f, 0.f}; s[kt][1] = (f32x4){0.f, 0.f, 0.f, 0.f};
#pragma unroll
        for (int ks = 0; ks < 2; ++ks) {
            const bf16x8 kf = *(const bf16x8*)(sK + (16 * kt + fr) * 72 + 32 * ks + 8 * fq);
            s[kt][0] = MFMA16(kf, qf[0][ks], s[kt][0]);
            s[kt][1] = MFMA16(kf, qf[1][ks], s[kt][1]);
        }
    }
#pragma unroll
    for (int qt = 0; qt < 2; ++qt) {
        float mx = -INFINITY;
#pragma unroll
        for (int kt = 0; kt < 4; ++kt)
#pragma unroll
            for (int j = 0; j < 4; ++j) {
                const float v = mf(qt, 16 * kt + 4 * fq + j) ? s[kt][qt][j] : -INFINITY;
                s[kt][qt][j] = v; mx = fmaxf(mx, v);
            }
        mx = fmaxf(mx, __shfl_xor(mx, 16)); mx = fmaxf(mx, __shfl_xor(mx, 32));
        const float mn = fmaxf(st.m[qt], mx);
        float alpha = 1.f, msub = 0.f;
        if (mn != -INFINITY) { alpha = __builtin_amdgcn_exp2f((st.m[qt] - mn) * EXPC); msub = mn; }
        st.m[qt] = mn;
        float ps = 0.f;
#pragma unroll
        for (int kt = 0; kt < 4; ++kt)
#pragma unroll
            for (int j = 0; j < 4; ++j) { const float p = __builtin_amdgcn_exp2f((s[kt][qt][j] - msub) * EXPC); s[kt][qt][j] = p; ps += p; }
        st.l[qt] = st.l[qt] * alpha + ps;
#pragma unroll
        for (int dt = 0; dt < 4; ++dt) st.o[dt][qt] *= alpha;
    }
#pragma unroll
    for (int ks = 0; ks < 2; ++ks) {
        bf16x8 pf[2];
#pragma unroll
        for (int qt = 0; qt < 2; ++qt)
            pf[qt] = mk8(pk2(s[2 * ks][qt][0], s[2 * ks][qt][1]), pk2(s[2 * ks][qt][2], s[2 * ks][qt][3]),
                         pk2(s[2 * ks + 1][qt][0], s[2 * ks + 1][qt][1]), pk2(s[2 * ks + 1][qt][2], s[2 * ks + 1][qt][3]));
#pragma unroll
        for (int dt = 0; dt < 4; ++dt) {
            const u32x2 v0 = *(const u32x2*)(sVt + (16 * dt + fr) * vstride + 32 * ks + 4 * fq);
            const u32x2 v1 = *(const u32x2*)(sVt + (16 * dt + fr) * vstride + 32 * ks + 16 + 4 * fq);
            const bf16x8 vf = mk8(v0.x, v0.y, v1.x, v1.y);
            st.o[dt][0] = MFMA16(vf, pf[0], st.o[dt][0]);
            st.o[dt][1] = MFMA16(vf, pf[1], st.o[dt][1]);
        }
    }
}
DEV void attn_fold(f32x4 (&tot)[4][2], const AttnAcc& st, const float (&gate)[2]) {
#pragma unroll
    for (int qt = 0; qt < 2; ++qt) {
        float l = st.l[qt];
        l += __shfl_xor(l, 16); l += __shfl_xor(l, 32);
        const float sc = gate[qt] / fmaxf(l, 1e-30f);
#pragma unroll
        for (int dt = 0; dt < 4; ++dt) tot[dt][qt] += st.o[dt][qt] * sc;
    }
}
DEV void stage64(bf16_t* dst, int dstride, const bf16_t* src, size_t sstride, int tid) {
#pragma unroll
    for (int i = 0; i < 2; ++i) {
        const int c = tid + 256 * i, r = c >> 3, k = (c & 7) * 8;
        *(u32x4*)(dst + r * dstride + k) = *(const u32x4*)(src + (size_t)r * sstride + k);
    }
}

struct MaskAll { DEV bool operator()(int, int) const { return true; } };
struct MaskSel { unsigned bit[2]; int t[2]; int k0; DEV bool operator()(int qt, int kk) const { return bit[qt] && (k0 + kk <= t[qt]); } };
struct MaskWin { int t[2]; int k0; DEV bool operator()(int qt, int kk) const { const int k = k0 + kk; return k <= t[qt] && k > t[qt] - 512; } };

DEV void xattn_job(const Params& P, int job, char* smem) {
    char* aux = (char*)P.out;
    bf16_t* ZA = (bf16_t*)(P.ws + W_ZA);
    const int qb = job & 15, h = (job >> 4) & 3, b = job >> 6;
    bf16_t* sK = (bf16_t*)smem;
    bf16_t* sVt = sK + 64 * 72;
    const int tid = opaque_tid(), w = tid >> 6, lane = tid & 63, fr = lane & 15, fq = lane >> 4;
    const int t0 = qb * 128 + w * 32;
    bf16x8 qf[2][2];
#pragma unroll
    for (int qt = 0; qt < 2; ++qt)
#pragma unroll
        for (int ks = 0; ks < 2; ++ks) qf[qt][ks] = *(const bf16x8*)(ZA + (size_t)(b * S + t0 + 16 * qt + fr) * ZW + C_QX + h * 64 + 32 * ks + 8 * fq);
    const bf16_t* MK = (const bf16_t*)(aux + O_MEMK) + (size_t)(b * 4 + h) * 256 * 64;
    const bf16_t* MVT = (const bf16_t*)(aux + O_MEMVT) + (size_t)(b * 4 + h) * 64 * 256;
    AttnAcc st; attn_init(st);
    for (int jb = 0; jb < 4; ++jb) {
        __syncthreads();
        stage64(sK, 72, MK + (size_t)jb * 64 * 64, 64, tid);
        stage64(sVt, 72, MVT + jb * 64, 256, tid);
        __syncthreads();
        attn_step(sK, sVt, 72, qf, st, MaskAll(), fr, fq);
    }
    f32x4 tot[4][2];
#pragma unroll
    for (int dt = 0; dt < 4; ++dt) { tot[dt][0] = (f32x4){0.f, 0.f, 0.f, 0.f}; tot[dt][1] = (f32x4){0.f, 0.f, 0.f, 0.f}; }
    const float one[2] = {1.f, 1.f};
    attn_fold(tot, st, one);
#pragma unroll
    for (int qt = 0; qt < 2; ++qt)
#pragma unroll
        for (int dt = 0; dt < 4; ++dt)
            *(uint2*)(ZA + (size_t)(b * S + t0 + 16 * qt + fr) * ZW + C_QX + h * 64 + 16 * dt + 4 * fq) =
                make_uint2(pk2(tot[dt][qt][0], tot[dt][qt][1]), pk2(tot[dt][qt][2], tot[dt][qt][3]));
}

DEV void nsa_job(const Params& P, int job, char* smem) {
    char* aux = (char*)P.out;
    bf16_t* ZA = (bf16_t*)(P.ws + W_ZA);
    const int bg = job & 31, qb = 63 - (job >> 5), b = bg >> 2, g = bg & 3, t0 = qb * 32;
    bf16_t* sK = (bf16_t*)smem;
    bf16_t* sVt = (bf16_t*)(smem + 18432);
    float* sImp = (float*)(smem + 18432 + 17408);
    unsigned* sSel = (unsigned*)(smem + 18432 + 17408 + 16384);
    const int tid = opaque_tid(), w = tid >> 6, lane = tid & 63, fr = lane & 15, fq = lane >> 4;
    const int head = g * 4 + w;
    int tq[2];
    bf16x8 qf[2][2];
    float gate[3][2];
#pragma unroll
    for (int qt = 0; qt < 2; ++qt) {
        tq[qt] = t0 + 16 * qt + fr;
        const bf16_t* rowp = ZA + (size_t)(b * S + tq[qt]) * ZW;
#pragma unroll
        for (int ks = 0; ks < 2; ++ks) qf[qt][ks] = *(const bf16x8*)(rowp + C_Q + head * 64 + 32 * ks + 8 * fq);
#pragma unroll
        for (int br = 0; br < 3; ++br) gate[br][qt] = bf2f(rowp[C_G + head * 3 + br]);
    }
    f32x4 tot[4][2];
#pragma unroll
    for (int dt = 0; dt < 4; ++dt) { tot[dt][0] = (f32x4){0.f, 0.f, 0.f, 0.f}; tot[dt][1] = (f32x4){0.f, 0.f, 0.f, 0.f}; }

    {
        const bf16_t* KC = (const bf16_t*)(aux + O_KC) + (size_t)bg * 128 * 64;
        const bf16_t* VCT = (const bf16_t*)(aux + O_VCT) + (size_t)bg * 64 * 128;
        __syncthreads();
#pragma unroll
        for (int i = 0; i < 4; ++i) {
            const int c = tid + 256 * i;
            { const int r = c >> 3, k = (c & 7) * 8; *(u32x4*)(sK + r * 72 + k) = *(const u32x4*)(KC + r * 64 + k); }
            { const int r = c >> 4, k = (c & 15) * 8; *(u32x4*)(sVt + r * 136 + k) = *(const u32x4*)(VCT + r * 128 + k); }
        }
        __syncthreads();
#pragma unroll
        for (int qt = 0; qt < 2; ++qt) {
            f32x4 s[8];
#pragma unroll
            for (int kt = 0; kt < 8; ++kt) {
                s[kt] = (f32x4){0.f, 0.f, 0.f, 0.f};
#pragma unroll
                for (int ks = 0; ks < 2; ++ks) {
                    const bf16x8 kf = *(const bf16x8*)(sK + (16 * kt + fr) * 72 + 32 * ks + 8 * fq);
                    s[kt] = MFMA16(kf, qf[qt][ks], s[kt]);
                }
            }
            float mx = -INFINITY;
#pragma unroll
            for (int kt = 0; kt < 8; ++kt)
#pragma unroll
                for (int j = 0; j < 4; ++j) {
                    const int n = 16 * kt + 4 * fq + j;
                    const float v = (n < NCMP && 16 * n + 31 <= tq[qt]) ? s[kt][j] : -INFINITY;
                    s[kt][j] = v; mx = fmaxf(mx, v);
                }
            mx = fmaxf(mx, __shfl_xor(mx, 16)); mx = fmaxf(mx, __shfl_xor(mx, 32));
            const float msub = (mx == -INFINITY) ? 0.f : mx;
            float ps = 0.f;
#pragma unroll
            for (int kt = 0; kt < 8; ++kt)
#pragma unroll
                for (int j = 0; j < 4; ++j) { const float p = __builtin_amdgcn_exp2f((s[kt][j] - msub) * EXPC); s[kt][j] = p; ps += p; }
            ps += __shfl_xor(ps, 16); ps += __shfl_xor(ps, 32);
            const float inv = 1.0f / fmaxf(ps, 1e-30f);
            float bprev = 0.f;
#pragma unroll
            for (int kt = 0; kt < 8; ++kt) {
                s[kt] *= inv;
                const float a = s[kt][0] + s[kt][1] + s[kt][2] + 0.5f * s[kt][3];
                const float bq = 0.5f * s[kt][3];
                const float x = __shfl(bq, (lane + 48) & 63);
                const float y = __shfl(bprev, (lane + 48) & 63);
                sImp[(w * 32 + 16 * qt + fr) * 32 + 4 * kt + fq] = a + (fq > 0 ? x : y);
                bprev = bq;
            }
            f32x4 oc[4];
#pragma unroll
            for (int dt = 0; dt < 4; ++dt) oc[dt] = (f32x4){0.f, 0.f, 0.f, 0.f};
#pragma unroll
            for (int ks = 0; ks < 4; ++ks) {
                const bf16x8 pf = mk8(pk2(s[2 * ks][0], s[2 * ks][1]), pk2(s[2 * ks][2], s[2 * ks][3]),
                                      pk2(s[2 * ks + 1][0], s[2 * ks + 1][1]), pk2(s[2 * ks + 1][2], s[2 * ks + 1][3]));
#pragma unroll
                for (int dt = 0; dt < 4; ++dt) {
                    const u32x2 v0 = *(const u32x2*)(sVt + (16 * dt + fr) * 136 + 32 * ks + 4 * fq);
                    const u32x2 v1 = *(const u32x2*)(sVt + (16 * dt + fr) * 136 + 32 * ks + 16 + 4 * fq);
                    oc[dt] = MFMA16(mk8(v0.x, v0.y, v1.x, v1.y), pf, oc[dt]);
                }
            }
#pragma unroll
            for (int dt = 0; dt < 4; ++dt) tot[dt][qt] += oc[dt] * gate[0][qt];
        }
    }
    __syncthreads();
    if (tid < 32) {
        const int t = t0 + tid, cur = t >> 6;
        for (int m = 0; m < 32; ++m) {
            const float v = ((sImp[(0 * 32 + tid) * 32 + m] + sImp[(1 * 32 + tid) * 32 + m]) + sImp[(2 * 32 + tid) * 32 + m]) + sImp[(3 * 32 + tid) * 32 + m];
            sImp[tid * 32 + m] = v;
        }
        unsigned sel = 0;
        for (int round = 0; round < 8; ++round) {
            float bv = -INFINITY; int bi = -1;
            for (int m = 0; m < 32; ++m) {
                if ((sel >> m) & 1u) continue;
                const bool forced = (m == 0) || (m == cur) || (m == cur - 1);
                const bool future = m * 64 > t;
                const float v = forced ? INFINITY : (future ? -INFINITY : sImp[tid * 32 + m]);
                if (v > bv) { bv = v; bi = m; }
            }
            if (bi < 0) break;
            sel |= 1u << bi;
        }
        sSel[tid] = sel;
        unsigned un = sel;
#pragma unroll
        for (int o = 16; o >= 1; o >>= 1) un |= __shfl_xor(un, o);
        if (tid == 0) sSel[32] = un;
    }
    __syncthreads();
    const unsigned uni = sSel[32];
    const unsigned mysel[2] = {sSel[fr], sSel[16 + fr]};
    const int jmax = (t0 + 31) >> 6;
    {
        AttnAcc st; attn_init(st);
        const bf16_t* Kb = ZA + (size_t)(b * S) * ZW + C_KS + g * 64;
        const bf16_t* Vb = (const bf16_t*)(P.ws + W_VST) + (size_t)bg * 64 * S;
        for (int jb = 0; jb <= jmax; ++jb) {
            if (!((uni >> jb) & 1u)) continue;
            __syncthreads();
            stage64(sK, 72, Kb + (size_t)(jb * 64) * ZW, ZW, tid);
            stage64(sVt, 72, Vb + jb * 64, S, tid);
            __syncthreads();
            MaskSel mf; mf.bit[0] = (mysel[0] >> jb) & 1u; mf.bit[1] = (mysel[1] >> jb) & 1u; mf.t[0] = tq[0]; mf.t[1] = tq[1]; mf.k0 = jb * 64;
            attn_step(sK, sVt, 72, qf, st, mf, fr, fq);
        }
        attn_fold(tot, st, gate[1]);
    }
    {
        AttnAcc st; attn_init(st);
        const bf16_t* Kb = ZA + (size_t)(b * S) * ZW + C_KW + g * 64;
        const bf16_t* Vb = (const bf16_t*)(P.ws + W_VWT) + (size_t)bg * 64 * S;
#pragma unroll
        for (int qt = 0; qt < 2; ++qt) {
            const int npad = 511 - tq[qt];
            if (npad > 0) { st.m[qt] = 0.f; st.l[qt] = (fq == 0) ? (float)npad : 0.f; }
        }
        int jlo = t0 - 511; jlo = jlo < 0 ? 0 : (jlo >> 6);
        for (int jb = jlo; jb <= jmax; ++jb) {
            __syncthreads();
            stage64(sK, 72, Kb + (size_t)(jb * 64) * ZW, ZW, tid);
            stage64(sVt, 72, Vb + jb * 64, S, tid);
            __syncthreads();
            MaskWin mf; mf.t[0] = tq[0]; mf.t[1] = tq[1]; mf.k0 = jb * 64;
            attn_step(sK, sVt, 72, qf, st, mf, fr, fq);
        }
        attn_fold(tot, st, gate[2]);
    }
#pragma unroll
    for (int qt = 0; qt < 2; ++qt)
#pragma unroll
        for (int dt = 0; dt < 4; ++dt)
            *(uint2*)(ZA + (size_t)(b * S + tq[qt]) * ZW + C_Q + head * 64 + 16 * dt + 4 * fq) =
                make_uint2(pk2(tot[dt][qt][0], tot[dt][qt][1]), pk2(tot[dt][qt][2], tot[dt][qt][3]));
}

constexpr int NPHASE = 11;
constexpr int SMEM_BYTES = 53248;

template <int PH>
DEV void run_phase(const Params& P, char* smem) {
    const int nb = gridDim.x, bid = blockIdx.x;
    char* aux = (char*)P.out;
    char* ws = P.ws;
    bf16_t* ZA = (bf16_t*)(ws + W_ZA);
    if (PH == 0) {
        for (int job = bid; job < 4800 + 4096 + 512 + 64; job += nb) {
            int j = job;
            if (j < 4800) {
                bool done = false;
#define TR(SRC, LD, DSTOFF, KK, NN, MAP)                                                                                       \
    if (!done) { const int nrt = (NN) / 64, nt = nrt * ((KK) / 64);                                                              \
        if (j < nt) { transpose_tile((SRC), (LD), (bf16_t*)(aux + (DSTOFF)), (KK), (j % nrt) * 64, (j / nrt) * 64, (MAP), smem); done = true; } else j -= nt; }
                TR(P.w_in, 7984, O_WTA, 1024, 4992, 1)
                TR(P.w_in, 7984, O_WTB, 1024, 3072, 2)
                TR(P.w_up, 4096, O_WTUP, 1024, 4096, 0)
                TR(P.w_down, 1024, O_WTDN, 4096, 1024, 0)
                TR(P.w_o, 1024, O_WTO, 1024, 1024, 0)
                TR(P.w_xo, 1024, O_WTXO, 256, 1024, 0)
                TR(P.w_mkv, 512, O_WTMKV, 1024, 512, 0)
                TR(P.wk1, 256, O_WTCK1, 2048, 256, 0)
                TR(P.wv1, 256, O_WTCV1, 2048, 256, 0)
#undef TR
                if (!done) {
                    if (j < 16) transpose_tile(P.w_a + j * 4096, 64, (bf16_t*)(aux + O_WAT) + j * 4096, 64, 0, 0, 0, smem);
                    else { j -= 16; transpose_tile(P.w_i + j * 4096, 64, (bf16_t*)(aux + O_WIT) + j * 4096, 64, 0, 0, 0, smem); }
                }
                continue;
            }
            j -= 4800;
            if (j < 4096) { rownorm<false>(P.x, P.g_mix, (bf16_t*)(ws + W_U), nullptr, j * 4 + (threadIdx.x >> 6)); continue; }
            j -= 4096;
            if (j < 512) { rownorm<false>(P.mem, P.g_mem, (bf16_t*)(aux + O_MEMN), nullptr, j * 4 + (threadIdx.x >> 6)); continue; }
            j -= 512;
            rope_job((float*)(aux + O_ROPEC), (float*)(aux + O_ROPES), j);
        }
    } else if (PH == 1) {
        const int nA = tile_count(39);
        for (int job = bid; job < 64 + nA; job += nb) {
            if (job < 64) {
                ALPlain al{(const bf16_t*)(aux + O_MEMN), 1024};
                EpiMemKV ep{(bf16_t*)(aux + O_MEMK), (bf16_t*)(aux + O_MEMVT)};
                gemm_tile<4>(al, (const bf16_t*)(aux + O_WTMKV), 1024, 1024, job & 15, job >> 4, ep, smem);
            } else {
                int pm, pn;
                if (!tile_map(job - 64, 39, pm, pn)) continue;
                ALPlain al{(const bf16_t*)(ws + W_U), 1024};
                EpiZA ep{ZA, (bf16_t*)(ws + W_VST), (bf16_t*)(ws + W_VWT), (const float*)(aux + O_ROPEC), (const float*)(aux + O_ROPES)};
                gemm_tile<4>(al, (const bf16_t*)(aux + O_WTA), 1024, 1024, pm, pn, ep, smem);
            }
        }
    } else if (PH == 2) {
        for (int job = bid; job < 128 + 128 + 512; job += nb) {
            if (job < 128) rnn_job(P, job, smem);
            else if (job < 256) {
                const int j = job - 128, which = j >> 6, pm = (j & 63) >> 1, pn = j & 1;
                ALCmp al{ZA, which ? P.cpv : P.cpk, which ? C_VC : C_KC};
                EpiHid ep{(bf16_t*)(aux + (which ? O_HIDV : O_HIDK))};
                gemm_tile<4>(al, (const bf16_t*)(aux + (which ? O_WTCV1 : O_WTCK1)), 2048, 2048, pm, pn, ep, smem);
            } else xattn_job(P, job - 256, smem);
        }
    } else if (PH == 3) {
        for (int job = bid; job < 2032; job += nb) cmp2_job(P, job);
    } else if (PH == 4) {
        for (int job = bid; job < 2048 + 1024; job += nb) {
            if (job < 2048) nsa_job(P, job, smem);
            else {
                int pm, pn;
                if (!tile_map(job - 2048, 8, pm, pn)) continue;
                ALPlain al{ZA + C_QX, ZW};
                EpiBf<0> ep{(bf16_t*)(ws + W_YX), 1024};
                gemm_tile<4>(al, (const bf16_t*)(aux + O_WTXO), 256, 256, pm, pn, ep, smem);
            }
        }
    } else if (PH == 5) {
        for (int job = bid; job < tile_count(16); job += nb) {
            int pm, pn;
            if (!tile_map(job, 16, pm, pn)) continue;
            ALPlain al{(const bf16_t*)(ws + W_U), 1024};
            EpiMerge ep{ZA, (const bf16_t*)(ws + W_YX), (bf16_t*)(ws + W_Y)};
            gemm_tile<6>(al, (const bf16_t*)(aux + O_WTB), 1024, 1024, pm, pn, ep, smem);
        }
    } else if (PH == 6) {
        for (int job = bid; job < tile_count(8); job += nb) {
            int pm, pn;
            if (!tile_map(job, 8, pm, pn)) continue;
            ALPlain al{(const bf16_t*)(ws + W_Y), 1024};
            EpiRes ep{P.x, (float*)(ws + W_H)};
            gemm_tile<4>(al, (const bf16_t*)(aux + O_WTO), 1024, 1024, pm, pn, ep, smem);
        }
    } else if (PH == 7) {
        for (int job = bid; job < 4096; job += nb) rownorm<false>((const float*)(ws + W_H), P.g_mlp, (bf16_t*)(ws + W_VN), nullptr, job * 4 + (threadIdx.x >> 6));
    } else if (PH == 8) {
        for (int job = bid; job < tile_count(32); job += nb) {
            int pm, pn;
            if (!tile_map(job, 32, pm, pn)) continue;
            ALPlain al{(const bf16_t*)(ws + W_VN), 1024};
            EpiBf<1> ep{(bf16_t*)(ws + W_HID), 4096};
            gemm_tile<4>(al, (const bf16_t*)(aux + O_WTUP), 1024, 1024, pm, pn, ep, smem);
        }
    } else if (PH == 9) {
        for (int job = bid; job < tile_count(8); job += nb) {
            int pm, pn;
            if (!tile_map(job, 8, pm, pn)) continue;
            ALPlain al{(const bf16_t*)(ws + W_HID), 4096};
            EpiRes ep{(const float*)(ws + W_H), (float*)(ws + W_H)};
            gemm_tile<4>(al, (const bf16_t*)(aux + O_WTDN), 4096, 4096, pm, pn, ep, smem);
        }
    } else if (PH == 10) {
        for (int job = bid; job < 4096; job += nb) rownorm<true>((const float*)(ws + W_H), P.g_final, nullptr, P.out, job * 4 + (threadIdx.x >> 6));
    }
}

#if MULTI
template <int PH>
__global__ void __launch_bounds__(256, 2) phase_kernel(Params P) {
    __shared__ __attribute__((aligned(16))) char smem[SMEM_BYTES];
    run_phase<PH>(P, smem);
}
#else
__global__ void __launch_bounds__(256, 2) mega_kernel(Params P) {
    __shared__ __attribute__((aligned(16))) char smem[SMEM_BYTES];
    cg::grid_group grid = cg::this_grid();
    run_phase<0>(P, smem); grid.sync();
    run_phase<1>(P, smem); grid.sync();
    run_phase<2>(P, smem); grid.sync();
    run_phase<3>(P, smem); grid.sync();
    run_phase<4>(P, smem); grid.sync();
    run_phase<5>(P, smem); grid.sync();
    run_phase<6>(P, smem); grid.sync();
    run_phase<7>(P, smem); grid.sync();
    run_phase<8>(P, smem); grid.sync();
    run_phase<9>(P, smem); grid.sync();
    run_phase<10>(P, smem);
}
#endif

extern "C" void kernel_launch(void* const* d_in, const int* in_sizes, int n_in, void* d_out, int out_size, void* d_ws, size_t ws_size,
                              hipStream_t stream) {
    Params P{};
    const float** pp = (const float**)&P;
    for (int i = 0; i < 25; ++i) pp[i] = (const float*)d_in[i];
    P.out = (float*)d_out;
    P.ws = (char*)d_ws;
#if MULTI
    const int G = 1024;
    phase_kernel<0><<<G, 256, 0, stream>>>(P);
    phase_kernel<1><<<G, 256, 0, stream>>>(P);
    phase_kernel<2><<<G, 256, 0, stream>>>(P);
    phase_kernel<3><<<G, 256, 0, stream>>>(P);
    phase_kernel<4><<<G, 256, 0, stream>>>(P);
    phase_kernel<5><<<G, 256, 0, stream>>>(P);
    phase_kernel<6><<<G, 256, 0, stream>>>(P);
    phase_kernel<7><<<G, 256, 0, stream>>>(P);
    phase_kernel<8><<<G, 256, 0, stream>>>(P);
    phase_kernel<9><<<G, 256, 0, stream>>>(P);
    phase_kernel<10><<<G, 256, 0, stream>>>(P);
#else
    static int grid_blocks = 0;
    if (!grid_blocks) {
        int dev = 0, cus = 0, per_cu = 0;
        hipGetDevice(&dev);
        hipDeviceGetAttribute(&cus, hipDeviceAttributeMultiprocessorCount, dev);
        hipOccupancyMaxActiveBlocksPerMultiprocessor(&per_cu, mega_kernel, 256, 0);
        if (per_cu > 2) per_cu = 2;
        if (per_cu < 1) per_cu = 1;
        grid_blocks = cus * per_cu;
    }
    void* args[] = {&P};
    hipError_t e = hipLaunchCooperativeKernel((void*)mega_kernel, dim3(grid_blocks), dim3(256), args, 0, stream);
    if (e != hipSuccess) fprintf(stderr, "cooperative launch failed: %s (grid %d)\n", hipGetErrorString(e), grid_blocks);
#endif
}
```

```cpp
#include <hip/hip_runtime.h>
#include <hip/hip_cooperative_groups.h>
#include <cstdint>
#include <cstdio>
namespace cg = cooperative_groups;

#ifndef MULTI
#define MULTI 0
#endif

typedef unsigned short bf16_t;
typedef short bf16x8 __attribute__((ext_vector_type(8)));
typedef float f32x4 __attribute__((ext_vector_type(4)));
typedef __bf16 bfv2 __attribute__((ext_vector_type(2)));
typedef float f32x2 __attribute__((ext_vector_type(2)));
typedef unsigned u32x4 __attribute__((ext_vector_type(4)));
typedef unsigned u32x2 __attribute__((ext_vector_type(2)));
#define DEV __device__ __forceinline__
DEV int opaque_tid() { int t = threadIdx.x; asm volatile("" : "+v"(t)); return t; }
#define MFMA16(a, b, c) __builtin_amdgcn_mfma_f32_16x16x32_bf16((a), (b), (c), 0, 0, 0)

constexpr int T = 16384, S = 2048;
constexpr int ZW = 4480;
constexpr int C_Q = 0, C_KC = 1024, C_VC = 1280, C_KS = 1536, C_KW = 1792, C_XR = 2048, C_GR = 3072, C_QX = 4096, C_G = 4352;
constexpr int NCMP = 127;
constexpr int NCROWS = 4064;

constexpr size_t O_WTA = 0;
constexpr size_t O_WTB = O_WTA + (size_t)4992 * 1024 * 2;
constexpr size_t O_WTUP = O_WTB + (size_t)3072 * 1024 * 2;
constexpr size_t O_WTDN = O_WTUP + (size_t)4096 * 1024 * 2;
constexpr size_t O_WTO = O_WTDN + (size_t)4096 * 1024 * 2;
constexpr size_t O_WTXO = O_WTO + (size_t)1024 * 1024 * 2;
constexpr size_t O_WTMKV = O_WTXO + (size_t)1024 * 256 * 2;
constexpr size_t O_WTCK1 = O_WTMKV + (size_t)512 * 1024 * 2;
constexpr size_t O_WTCV1 = O_WTCK1 + (size_t)256 * 2048 * 2;
constexpr size_t O_WAT = O_WTCV1 + (size_t)256 * 2048 * 2;
constexpr size_t O_WIT = O_WAT + (size_t)16 * 64 * 64 * 2;
constexpr size_t O_ROPEC = O_WIT + (size_t)16 * 64 * 64 * 2;
constexpr size_t O_ROPES = O_ROPEC + (size_t)2048 * 8 * 4;
constexpr size_t O_MEMN = O_ROPES + (size_t)2048 * 8 * 4;
constexpr size_t O_MEMK = O_MEMN + (size_t)2048 * 1024 * 2;
constexpr size_t O_MEMVT = O_MEMK + (size_t)2048 * 256 * 2;
constexpr size_t O_HIDK = O_MEMVT + (size_t)2048 * 256 * 2;
constexpr size_t O_HIDV = O_HIDK + (size_t)4096 * 256 * 2;
constexpr size_t O_KC = O_HIDV + (size_t)4096 * 256 * 2;
constexpr size_t O_VCT = O_KC + (size_t)32 * 128 * 64 * 2;
constexpr size_t O_AUX_END = O_VCT + (size_t)32 * 64 * 128 * 2;
static_assert(O_AUX_END <= (size_t)64 << 20, "aux overflow");
constexpr size_t MiB = (size_t)1 << 20;
constexpr size_t W_U = 0, W_ZA = 32 * MiB, W_VST = 172 * MiB, W_VWT = 180 * MiB, W_YX = 188 * MiB, W_Y = 220 * MiB;
constexpr size_t W_H = 32 * MiB, W_VN = 0, W_HID = 96 * MiB;

struct Params {
    const float *x, *mem, *g_mix, *w_in, *cpk, *cpv, *wk1, *wk2, *wv1, *wv2, *conv_w, *conv_b, *w_a, *b_a, *w_i, *b_i, *lam,
        *g_mem, *w_mkv, *w_xo, *w_o, *g_mlp, *w_up, *w_down, *g_final;
    float* out;
    char* ws;
};

DEV float bf2f(bf16_t h) { return __uint_as_float(((unsigned)h) << 16); }
DEV unsigned pk2(float lo, float hi) { f32x2 v = {lo, hi}; bfv2 b = __builtin_convertvector(v, bfv2); return __builtin_bit_cast(unsigned, b); }
DEV bf16_t f2bf(float f) { return (bf16_t)(pk2(f, 0.f) & 0xffffu); }
DEV float lo_f(unsigned u) { return __uint_as_float(u << 16); }
DEV float hi_f(unsigned u) { return __uint_as_float(u & 0xffff0000u); }
DEV float sigm(float x) { return 1.f / (1.f + __expf(-x)); }
DEV float gelu_t(float x) {
    float y = 0.7978845608028654f * (x + 0.044715f * x * x * x);
    float e = __expf(2.f * y);
    float th = 1.f - 2.f / (1.f + e);
    return 0.5f * x * (1.f + th);
}
DEV float wave_sum(float v) {
#pragma unroll
    for (int o = 32; o >= 1; o >>= 1) v += __shfl_xor(v, o);
    return v;
}

DEV int map_col(int mapid, int r) {
    if (mapid == 0) return r;
    if (mapid == 1) {
        if (r < 1536) return r;
        if (r < 1792) return 1536 + (r - 1536);
        if (r < 2048) return 2048 + (r - 1792);
        if (r < 3072) return 2608 + (r - 2048);
        if (r < 4096) return 3632 + (r - 3072);
        if (r < 4352) return 4656 + (r - 4096);
        if (r < 4400) return 2560 + (r - 4352);
        if (r < 4480) return -1;
        if (r < 4736) return 1792 + (r - 4480);
        return 2304 + (r - 4736);
    }
    int pn = r / 96, rem = r - pn * 96, wc = rem / 48, rem2 = rem - wc * 48, gidx = rem2 >> 4, cc = rem2 & 15;
    return 4912 + gidx * 1024 + pn * 32 + wc * 16 + cc;
}

DEV void transpose_tile(const float* __restrict__ src, int ld, bf16_t* __restrict__ dst, int K, int r0, int k0, int mapid, char* smem) {
    float* sm = (float*)smem;
    const int tid = threadIdx.x, lane = tid & 63, w = tid >> 6;
    __syncthreads();
    const int sc = map_col(mapid, r0 + lane);
#pragma unroll
    for (int i = 0; i < 16; ++i) {
        int kk = w + 4 * i;
        float v = sc >= 0 ? src[(size_t)(k0 + kk) * ld + sc] : 0.f;
        sm[kk * 65 + lane] = v;
    }
    __syncthreads();
    const int rr = tid >> 2, kq = (tid & 3) * 16;
    unsigned o[8];
#pragma unroll
    for (int e = 0; e < 8; ++e) o[e] = pk2(sm[(kq + 2 * e) * 65 + rr], sm[(kq + 2 * e + 1) * 65 + rr]);
    uint4* dp = (uint4*)(dst + (size_t)(r0 + rr) * K + k0 + kq);
    dp[0] = make_uint4(o[0], o[1], o[2], o[3]);
    dp[1] = make_uint4(o[4], o[5], o[6], o[7]);
}

template <bool OUTF32>
DEV void rownorm(const float* __restrict__ src, const float* __restrict__ g, bf16_t* dstb, float* dstf, int row) {
    const int lane = threadIdx.x & 63;
    const float4* sp = (const float4*)(src + (size_t)row * 1024);
    float4 v[4];
    float ss = 0.f;
#pragma unroll
    for (int i = 0; i < 4; ++i) { v[i] = sp[lane + 64 * i]; ss += v[i].x * v[i].x + v[i].y * v[i].y + v[i].z * v[i].z + v[i].w * v[i].w; }
    ss = wave_sum(ss);
    const float r = rsqrtf(ss * (1.0f / 1024.0f) + 1e-6f);
#pragma unroll
    for (int i = 0; i < 4; ++i) {
        float4 gg = ((const float4*)g)[lane + 64 * i];
        float a = v[i].x * r * gg.x, b = v[i].y * r * gg.y, c = v[i].z * r * gg.z, d = v[i].w * r * gg.w;
        if (OUTF32) ((float4*)(dstf + (size_t)row * 1024))[lane + 64 * i] = make_float4(a, b, c, d);
        else ((uint2*)(dstb + (size_t)row * 1024))[lane + 64 * i] = make_uint2(pk2(a, b), pk2(c, d));
    }
}

DEV void rope_job(float* ct, float* st, int job) {
    const int e = job * 256 + threadIdx.x;
    const int pos = e >> 3, i = e & 7;
    const double inv = exp(-(double)i * 0.125 * 13.122363377404328);
    const double ang = (double)pos * inv;
    const double kq = rint(ang * 0.6366197723675814);
    const double r = ang - kq * 1.5707963267948966;
    const double r2 = r * r;
    const double sn = r * (1.0 + r2 * (-1.0 / 6 + r2 * (1.0 / 120 + r2 * (-1.0 / 5040 + r2 * (1.0 / 362880 + r2 * (-1.0 / 39916800 + r2 * (1.0 / 6227020800.0)))))));
    const double cs = 1.0 + r2 * (-0.5 + r2 * (1.0 / 24 + r2 * (-1.0 / 720 + r2 * (1.0 / 40320 + r2 * (-1.0 / 3628800 + r2 * (1.0 / 479001600.0))))));
    const int q = ((int)kq) & 3;
    double s_, c_;
    if (q == 0) { s_ = sn; c_ = cs; } else if (q == 1) { s_ = cs; c_ = -sn; } else if (q == 2) { s_ = -sn; c_ = -cs; } else { s_ = -cs; c_ = sn; }
    ct[e] = (float)c_; st[e] = (float)s_;
}

struct ALPlain {
    const bf16_t* A; int lda;
    const char* base; unsigned off0;
    DEV void init(int row0, int lrow, int lk) { base = (const char*)(A + (size_t)row0 * lda); off0 = (unsigned)(lrow * lda + lk) * 2u; }
    DEV u32x4 load(int i, int k0) const { return *(const u32x4*)(base + (off0 + (unsigned)(i * 64 * lda) + (unsigned)(k0 * 2))); }
};
struct ALCmp {
    const bf16_t* ZA; const float* pos; int colbase;
    unsigned roff[4]; int lk_;
    DEV void init(int row0, int lrow, int lk) {
        lk_ = lk;
#pragma unroll
        for (int i = 0; i < 4; ++i) {
            const int row = row0 + lrow + 32 * i;
            const int bg = row / NCMP, n = row - bg * NCMP, b = bg >> 2, g = bg & 3;
            roff[i] = row < NCROWS ? (unsigned)(((b * S + 16 * n) * ZW + colbase + g * 64 + lk) * 2) : 0xffffffffu;
        }
    }
    DEV u32x4 load(int i, int k0) const {
        if (roff[i] == 0xffffffffu) return (u32x4){0u, 0u, 0u, 0u};
        const int j = k0 >> 6;
        const u32x4 v = *(const u32x4*)((const char*)ZA + (roff[i] + (unsigned)(j * ZW * 2)));
        const float4 p0 = *(const float4*)(pos + j * 64 + lk_), p1 = *(const float4*)(pos + j * 64 + lk_ + 4);
        u32x4 o;
        o.x = pk2(lo_f(v.x) + p0.x, hi_f(v.x) + p0.y); o.y = pk2(lo_f(v.y) + p0.z, hi_f(v.y) + p0.w);
        o.z = pk2(lo_f(v.z) + p1.x, hi_f(v.z) + p1.y); o.w = pk2(lo_f(v.w) + p1.z, hi_f(v.w) + p1.w);
        return o;
    }
};

template <int TM, int TN, bool SWAP, class AL, class EP>
DEV void gemm_tile(AL al, const bf16_t* __restrict__ Bt, int ldb, int K, int pm, int pn, const EP& ep, char* smem) {
    constexpr int BM = TM * 32, BN = TN * 32, NA = TM, NBB = TN;
    bf16_t* sA = (bf16_t*)smem;
    bf16_t* sB = sA + BM * 72;
    const int tid = opaque_tid(), wid = tid >> 6, lane = tid & 63, wr = wid >> 1, wc = wid & 1, fr = lane & 15, fq = lane >> 4;
    f32x4 acc[TM][TN];
#pragma unroll
    for (int m = 0; m < TM; ++m)
#pragma unroll
        for (int n = 0; n < TN; ++n) acc[m][n] = (f32x4){0.f, 0.f, 0.f, 0.f};
    const int lrow = tid >> 3, lk = (tid & 7) * 8;
    u32x4 ra[NA], rb[NBB];
    al.init(pm * BM, lrow, lk);
    const char* bbase = (const char*)(Bt + (size_t)(pn * BN) * ldb);
    const unsigned boff = (unsigned)(lrow * ldb + lk) * 2u;
#pragma unroll
    for (int i = 0; i < NA; ++i) ra[i] = al.load(i, 0);
#pragma unroll
    for (int i = 0; i < NBB; ++i) rb[i] = *(const u32x4*)(bbase + (boff + (unsigned)(i * 64 * ldb)));
    int nk = K >> 6;
    asm volatile("" : "+s"(nk));
    bf16_t* sWa = sA + lrow * 72 + lk;
    bf16_t* sWb = sB + lrow * 72 + lk;
    const bf16_t* sAr = sA + (wr * TM * 16 + fr) * 72 + fq * 8;
    const bf16_t* sBr = sB + (wc * TN * 16 + fr) * 72 + fq * 8;
#pragma unroll 1
    for (int kt = 0; kt < nk; ++kt) {
        __syncthreads();
#pragma unroll
        for (int i = 0; i < NA; ++i) *(u32x4*)(sWa + (32 * i) * 72) = ra[i];
#pragma unroll
        for (int i = 0; i < NBB; ++i) *(u32x4*)(sWb + (32 * i) * 72) = rb[i];
        __syncthreads();
        if (kt + 1 < nk) {
            const int k0 = (kt + 1) * 64;
#pragma unroll
            for (int i = 0; i < NA; ++i) ra[i] = al.load(i, k0);
#pragma unroll
            for (int i = 0; i < NBB; ++i) rb[i] = *(const u32x4*)(bbase + (boff + (unsigned)(i * 64 * ldb) + (unsigned)(k0 * 2)));
        }
        __builtin_amdgcn_sched_barrier(0);
#pragma unroll
        for (int ks = 0; ks < 2; ++ks) {
            bf16x8 bfr[TN];
#pragma unroll
            for (int n = 0; n < TN; ++n) bfr[n] = *(const bf16x8*)(sBr + (n * 16) * 72 + ks * 32);
#pragma unroll
            for (int m = 0; m < TM; ++m) {
                const bf16x8 af = *(const bf16x8*)(sAr + (m * 16) * 72 + ks * 32);
#pragma unroll
                for (int n = 0; n < TN; ++n) acc[m][n] = SWAP ? MFMA16(bfr[n], af, acc[m][n]) : MFMA16(af, bfr[n], acc[m][n]);
            }
        }
    }
    ep.run(acc, pm * BM + wr * TM * 16, pn * BN + wc * TN * 16, fr, fq);
}

DEV uint2 pk4(const f32x4& a) { return make_uint2(pk2(a[0], a[1]), pk2(a[2], a[3])); }

template <bool SWAP>
struct EpiZA {
    bf16_t *ZA, *VST, *VWT; const float *ropec, *ropes;
    DEV void run(f32x4 (&acc)[8][4], int R0, int C0, int fr, int fq) const {
#pragma unroll
        for (int n = 0; n < 4; ++n) {
            const int col0 = C0 + n * 16;
#pragma unroll
            for (int m = 0; m < 8; ++m) {
                f32x4 a = acc[m][n];
                if (!SWAP) {
                    const int r = R0 + m * 16 + 4 * fq;
                    int c = col0 - 4480 + fr;
                    bf16_t* dst = (c < 256) ? VST : VWT;
                    c &= 255;
                    const int g = c >> 6, d = c & 63, b = r >> 11, t = r & 2047;
                    *(uint2*)(dst + ((size_t)((b * 4 + g) * 64 + d)) * S + t) = pk4(a);
                } else {
                    const int row = R0 + m * 16 + fr;
                    const bool rope = (col0 < 1024 || (col0 >= 1536 && col0 < 2048)) && ((col0 & 63) == 0);
                    if (rope) {
                        const int t = row & 2047, i0 = 4 * (fq & 1);
                        const float4 cs = *(const float4*)(ropec + t * 8 + i0), sn = *(const float4*)(ropes + t * 8 + i0);
                        const float c4[4] = {cs.x, cs.y, cs.z, cs.w}, s4[4] = {sn.x, sn.y, sn.z, sn.w};
#pragma unroll
                        for (int j = 0; j < 4; ++j) {
                            const float pr = __shfl_xor(a[j], 32);
                            a[j] = (fq & 2) ? (a[j] * c4[j] + pr * s4[j]) : (a[j] * c4[j] - pr * s4[j]);
                        }
                    }
                    if (col0 >= C_G) {
#pragma unroll
                        for (int j = 0; j < 4; ++j) a[j] = sigm(a[j]);
                    }
                    *(uint2*)(ZA + (size_t)row * ZW + col0 + 4 * fq) = pk4(a);
                }
            }
        }
    }
};
template <bool SWAP>
struct EpiMemKV {
    bf16_t *MK, *MVT;
    DEV void run(f32x4 (&acc)[8][4], int R0, int C0, int fr, int fq) const {
#pragma unroll
        for (int n = 0; n < 4; ++n)
#pragma unroll
            for (int m = 0; m < 8; ++m) {
                if (SWAP) {
                    const int c = C0 + n * 16 + 4 * fq, r = R0 + m * 16 + fr;
                    const int h = (c >> 6) & 3, d = c & 63, b = r >> 8, mm = r & 255;
                    *(uint2*)(MK + ((size_t)(b * 4 + h) * 256 + mm) * 64 + d) = pk4(acc[m][n]);
                } else {
                    const int c = C0 + n * 16 + fr, r = R0 + m * 16 + 4 * fq;
                    const int h = (c >> 6) & 3, d = c & 63, b = r >> 8, mm = r & 255;
                    *(uint2*)(MVT + ((size_t)(b * 4 + h) * 64 + d) * 256 + mm) = pk4(acc[m][n]);
                }
            }
    }
};
struct EpiHid {
    bf16_t* H;
    DEV void run(f32x4 (&acc)[4][4], int R0, int C0, int fr, int fq) const {
#pragma unroll
        for (int n = 0; n < 4; ++n)
#pragma unroll
            for (int m = 0; m < 4; ++m) {
                const int c = C0 + n * 16 + 4 * fq, r = R0 + m * 16 + fr;
                f32x4 a = acc[m][n];
#pragma unroll
                for (int j = 0; j < 4; ++j) a[j] = gelu_t(a[j]);
                if (r < NCROWS) *(uint2*)(H + (size_t)r * 256 + c) = pk4(a);
            }
    }
};
template <int ACT>
struct EpiBf {
    bf16_t* O; int ldo;
    DEV void run(f32x4 (&acc)[8][4], int R0, int C0, int fr, int fq) const {
#pragma unroll
        for (int n = 0; n < 4; ++n)
#pragma unroll
            for (int m = 0; m < 8; ++m) {
                const int c = C0 + n * 16 + 4 * fq, r = R0 + m * 16 + fr;
                f32x4 a = acc[m][n];
                if (ACT == 1) {
#pragma unroll
                    for (int j = 0; j < 4; ++j) { const float v = fmaxf(a[j], 0.f); a[j] = v * v; }
                }
                *(uint2*)(O + (size_t)r * ldo + c) = pk4(a);
            }
    }
};
struct EpiRes {
    const float* R; float* O;
    DEV void run(f32x4 (&acc)[8][4], int R0, int C0, int fr, int fq) const {
#pragma unroll
        for (int n = 0; n < 4; ++n)
#pragma unroll
            for (int m = 0; m < 8; ++m) {
                const size_t o = (size_t)(R0 + m * 16 + fr) * 1024 + C0 + n * 16 + 4 * fq;
                const f32x4 r = *(const f32x4*)(R + o);
                *(f32x4*)(O + o) = r + acc[m][n];
            }
    }
};
struct EpiMerge {
    const bf16_t *ZA, *YX; bf16_t* Y;
    DEV void run(f32x4 (&acc)[8][3], int R0, int C0, int fr, int fq) const {
        const int ch = (C0 / 48) * 16 + 4 * fq;
#pragma unroll
        for (int m = 0; m < 8; ++m) {
            const size_t row = (size_t)(R0 + m * 16 + fr);
            const uint2 a = *(const uint2*)(ZA + row * ZW + C_Q + ch), b = *(const uint2*)(ZA + row * ZW + C_GR + ch), c = *(const uint2*)(YX + row * 1024 + ch);
            f32x4 y;
            y[0] = sigm(acc[m][0][0]) * lo_f(a.x) + sigm(acc[m][1][0]) * lo_f(b.x) + sigm(acc[m][2][0]) * lo_f(c.x);
            y[1] = sigm(acc[m][0][1]) * hi_f(a.x) + sigm(acc[m][1][1]) * hi_f(b.x) + sigm(acc[m][2][1]) * hi_f(c.x);
            y[2] = sigm(acc[m][0][2]) * lo_f(a.y) + sigm(acc[m][1][2]) * lo_f(b.y) + sigm(acc[m][2][2]) * lo_f(c.y);
            y[3] = sigm(acc[m][0][3]) * hi_f(a.y) + sigm(acc[m][1][3]) * hi_f(b.y) + sigm(acc[m][2][3]) * hi_f(c.y);
            *(uint2*)(Y + row * 1024 + ch) = pk4(y);
        }
    }
};

DEV bool tile_map(int idx, int NT, int& pm, int& pn) {
    const int x = idx & 7, pl = (idx >> 3) & 7, pmid = (idx >> 6) & 7, st = idx >> 9;
    pm = pmid * 8 + x;
    pn = st * 8 + pl;
    return pn < NT;
}
DEV int tile_count(int NT) { return ((NT + 7) / 8) * 512; }

DEV void cmp2_job(const Params& P, int job) {
    char* aux = (char*)P.out;
    const int lane = threadIdx.x & 63, w = threadIdx.x >> 6;
    const int wj = job * 4 + w;
    const int which = wj >= NCROWS ? 1 : 0;
    const int r = wj - which * NCROWS;
    const int bg = r / NCMP, n = r - bg * NCMP;
    const bf16_t* hid = (const bf16_t*)(aux + (which ? O_HIDV : O_HIDK)) + (size_t)r * 256;
    const float* w2 = which ? P.wv2 : P.wk2;
    float acc = 0.f;
#pragma unroll 8
    for (int k = 0; k < 256; ++k) acc += bf2f(hid[k]) * w2[k * 64 + lane];
    if (!which) {
        const int pos = 16 * n + 31, i = lane & 7;
        const float cs = ((const float*)(aux + O_ROPEC))[pos * 8 + i], sn = ((const float*)(aux + O_ROPES))[pos * 8 + i];
        const float pr = __shfl_xor(acc, 8);
        float o = acc;
        if (lane < 16) o = (lane & 8) ? (acc * cs + pr * sn) : (acc * cs - pr * sn);
        bf16_t* KC = (bf16_t*)(aux + O_KC);
        KC[((size_t)bg * 128 + n) * 64 + lane] = f2bf(o);
        if (n == NCMP - 1) KC[((size_t)bg * 128 + 127) * 64 + lane] = 0;
    } else {
        bf16_t* VCT = (bf16_t*)(aux + O_VCT);
        VCT[((size_t)bg * 64 + lane) * 128 + n] = f2bf(acc);
        if (n == NCMP - 1) VCT[((size_t)bg * 64 + lane) * 128 + 127] = 0;
    }
}

DEV void rnn_job(const Params& P, int job, char* smem, bool dry) {
    char* aux = (char*)P.out;
    bf16_t* ZA = (bf16_t*)(P.ws + W_ZA);
    const int b = job >> 4, n = job & 15;
    bf16_t* sX = (bf16_t*)smem;
    float* sXf = (float*)(smem + 9216);
    float* sCw = (float*)(smem + 9216 + 16640);
    float* sSum = (float*)(smem + 9216 + 16640 + 1280);
    const int tid = opaque_tid(), w = tid >> 6, lane = tid & 63, fr = lane & 15, fq = lane >> 4;
    const bf16_t* WAT = (const bf16_t*)(aux + O_WAT) + n * 4096;
    const bf16_t* WIT = (const bf16_t*)(aux + O_WIT) + n * 4096;
    bf16x8 wa[4][2], wi[4][2];
    float ba[4], bi[4], cl[4], carry[4];
#pragma unroll
    for (int ct = 0; ct < 4; ++ct) {
#pragma unroll
        for (int ks = 0; ks < 2; ++ks) {
            wa[ct][ks] = *(const bf16x8*)(WAT + (16 * ct + fr) * 64 + 32 * ks + 8 * fq);
            wi[ct][ks] = *(const bf16x8*)(WIT + (16 * ct + fr) * 64 + 32 * ks + 8 * fq);
        }
        const int c = n * 64 + 16 * ct + fr;
        ba[ct] = P.b_a[c]; bi[ct] = P.b_i[c];
        cl[ct] = -8.0f * log1pf(__expf(-P.lam[c]));
        carry[ct] = 0.f;
    }
    __syncthreads();
    for (int i = tid; i < 320; i += 256) sCw[i] = (i < 256) ? P.conv_w[(i >> 6) * 1024 + n * 64 + (i & 63)] : P.conv_b[n * 64 + (i & 63)];
    for (int chunk = 0; chunk < 32; ++chunk) {
        const int tc = chunk * 64;
        __syncthreads();
        {
            const int t = tid >> 2, cg = (tid & 3) * 16;
            float xv[16];
#pragma unroll
            for (int e = 0; e < 16; ++e) xv[e] = sCw[256 + cg + e];
#pragma unroll
            for (int k = 0; k < 4; ++k) {
                const int tt = tc + t - 3 + k;
                if (tt >= 0) {
                    const u32x4* xp = (const u32x4*)(ZA + (size_t)(b * S + tt) * ZW + C_XR + n * 64 + cg);
                    const u32x4 v0 = xp[0], v1 = xp[1];
                    const unsigned u[8] = {v0.x, v0.y, v0.z, v0.w, v1.x, v1.y, v1.z, v1.w};
#pragma unroll
                    for (int e = 0; e < 8; ++e) {
                        xv[2 * e] += sCw[k * 64 + cg + 2 * e] * lo_f(u[e]);
                        xv[2 * e + 1] += sCw[k * 64 + cg + 2 * e + 1] * hi_f(u[e]);
                    }
                }
            }
#pragma unroll
            for (int e = 0; e < 16; ++e) sXf[t * 65 + cg + e] = xv[e];
            u32x4 o0 = {pk2(xv[0], xv[1]), pk2(xv[2], xv[3]), pk2(xv[4], xv[5]), pk2(xv[6], xv[7])};
            u32x4 o1 = {pk2(xv[8], xv[9]), pk2(xv[10], xv[11]), pk2(xv[12], xv[13]), pk2(xv[14], xv[15])};
            *(u32x4*)(sX + t * 72 + cg) = o0;
            *(u32x4*)(sX + t * 72 + cg + 8) = o1;
        }
        __syncthreads();
        bf16x8 af[2];
#pragma unroll
        for (int ks = 0; ks < 2; ++ks) af[ks] = *(const bf16x8*)(sX + (16 * w + fr) * 72 + 32 * ks + 8 * fq);
        float hl[4][4], pc[4][4], Ae[4], He[4];
#pragma unroll
        for (int ct = 0; ct < 4; ++ct) {
            f32x4 R = (f32x4){0.f, 0.f, 0.f, 0.f}, I = (f32x4){0.f, 0.f, 0.f, 0.f};
#pragma unroll
            for (int ks = 0; ks < 2; ++ks) { R = MFMA16(af[ks], wa[ct][ks], R); I = MFMA16(af[ks], wi[ct][ks], I); }
            float h = 0.f, pcum = 1.f;
#pragma unroll
            for (int j = 0; j < 4; ++j) {
                const float xcv = sXf[(16 * w + 4 * fq + j) * 65 + 16 * ct + fr];
                const float rg = sigm(R[j] + ba[ct]), gi = sigm(I[j] + bi[ct]);
                const float la = rg * cl[ct];
                const float a_ = __expf(la);
                const float mult = sqrtf(fmaxf(-expm1f(2.f * la), 0.f));
                const float u = mult * gi * xcv;
                h = a_ * h + u; pcum *= a_;
                hl[ct][j] = h; pc[ct][j] = pcum;
            }
            float A = pcum, H = h;
            float A1 = __shfl_up(A, 16), H1 = __shfl_up(H, 16);
            if (fq >= 1) { H = A * H1 + H; A = A * A1; }
            float A2 = __shfl_up(A, 32), H2 = __shfl_up(H, 32);
            if (fq >= 2) { H = A * H2 + H; A = A * A2; }
            float Ax = __shfl_up(A, 16), Hx = __shfl_up(H, 16);
            Ae[ct] = fq == 0 ? 1.f : Ax; He[ct] = fq == 0 ? 0.f : Hx;
            if (fq == 3) { sSum[w * 64 + 16 * ct + fr] = A; sSum[256 + w * 64 + 16 * ct + fr] = H; }
        }
        __syncthreads();
#pragma unroll
        for (int ct = 0; ct < 4; ++ct) {
            float cin = carry[ct], mycin = 0.f;
#pragma unroll
            for (int ww = 0; ww < 4; ++ww) {
                if (ww == w) mycin = cin;
                cin = sSum[ww * 64 + 16 * ct + fr] * cin + sSum[256 + ww * 64 + 16 * ct + fr];
            }
            carry[ct] = cin;
            const float sq = Ae[ct] * mycin + He[ct];
#pragma unroll
            for (int j = 0; j < 4; ++j) {
                const float hfin = hl[ct][j] + pc[ct][j] * sq;
                const size_t grow = (size_t)(b * S + tc + 16 * w + 4 * fq + j);
                bf16_t* gp = ZA + grow * ZW + C_GR + n * 64 + 16 * ct + fr;
                bf16_t* op = dry ? ((bf16_t*)(P.ws + W_YX) + grow * 1024 + n * 64 + 16 * ct + fr) : gp;
                *op = f2bf(gelu_t(bf2f(*gp)) * hfin);
            }
        }
    }
}

constexpr float EXPC = 0.125f * 1.4426950408889634f;
struct AttnAcc { f32x4 o[4][2]; float m[2], l[2]; };
DEV void attn_init(AttnAcc& a) {
#pragma unroll
    for (int d = 0; d < 4; ++d)
#pragma unroll
        for (int q = 0; q < 2; ++q) a.o[d][q] = (f32x4){0.f, 0.f, 0.f, 0.f};
    a.m[0] = a.m[1] = -INFINITY; a.l[0] = a.l[1] = 0.f;
}
DEV bf16x8 mk8(unsigned a, unsigned b, unsigned c, unsigned d) { u32x4 u = {a, b, c, d}; return __builtin_bit_cast(bf16x8, u); }

template <class MF>
DEV void attn_step(const bf16_t* sK, const bf16_t* sVt, int vstride, const bf16x8 (&qf)[2][2], AttnAcc& st, const MF& mf, int fr, int fq) {
    f32x4 s[4][2];
#pragma unroll
    for (int kt = 0; kt < 4; ++kt) {
        s[kt][0] = (f32x4){0.f, 0.f, 0.f, 0.f}; s[kt][1] = (f32x4){0.f, 0.f, 0.f, 0.f};
#pragma unroll
        for (int ks = 0; ks < 2; ++ks) {
            const bf16x8 kf = *(const bf16x8*)(sK + (16 * kt + fr) * 72 + 32 * ks + 8 * fq);
            s[kt][0] = MFMA16(kf, qf[0][ks], s[kt][0]);
            s[kt][1] = MFMA16(kf, qf[1][ks], s[kt][1]);
        }
    }
#pragma unroll
    for (int qt = 0; qt < 2; ++qt) {
        float mx = -INFINITY;
#pragma unroll
        for (int kt = 0; kt < 4; ++kt)
#pragma unroll
            for (int j = 0; j < 4; ++j) {
                const float v = mf(qt, 16 * kt + 4 * fq + j) ? s[kt][qt][j] : -INFINITY;
                s[kt][qt][j] = v; mx = fmaxf(mx, v);
            }
        mx = fmaxf(mx, __shfl_xor(mx, 16)); mx = fmaxf(mx, __shfl_xor(mx, 32));
        const float mn = fmaxf(st.m[qt], mx);
        float alpha = 1.f, msub = 0.f;
        if (mn != -INFINITY) { alpha = __builtin_amdgcn_exp2f((st.m[qt] - mn) * EXPC); msub = mn; }
        st.m[qt] = mn;
        float ps = 0.f;
#pragma unroll
        for (int kt = 0; kt < 4; ++kt)
#pragma unroll
            for (int j = 0; j < 4; ++j) { const float p = __builtin_amdgcn_exp2f((s[kt][qt][j] - msub) * EXPC); s[kt][qt][j] = p; ps += p; }
        st.l[qt] = st.l[qt] * alpha + ps;
#pragma unroll
        for (int dt = 0; dt < 4; ++dt) st.o[dt][qt] *= alpha;
    }
#pragma unroll
    for (int ks = 0; ks < 2; ++ks) {
        bf16x8 pf[2];
#pragma unroll
        for (int qt = 0; qt < 2; ++qt)
            pf[qt] = mk8(pk2(s[2 * ks][qt][0], s[2 * ks][qt][1]), pk2(s[2 * ks][qt][2], s[2 * ks][qt][3]),
                         pk2(s[2 * ks + 1][qt][0], s[2 * ks + 1][qt][1]), pk2(s[2 * ks + 1][qt][2], s[2 * ks + 1][qt][3]));
#pragma unroll
        for (int dt = 0; dt < 4; ++dt) {
            const u32x2 v0 = *(const u32x2*)(sVt + (16 * dt + fr) * vstride + 32 * ks + 4 * fq);
            const u32x2 v1 = *(const u32x2*)(sVt + (16 * dt + fr) * vstride + 32 * ks + 16 + 4 * fq);
            const bf16x8 vf = mk8(v0.x, v0.y, v1.x, v1.y);
            st.o[dt][0] = MFMA16(vf, pf[0], st.o[dt][0]);
            st.o[dt][1] = MFMA16(vf, pf[1], st.o[dt][1]);
        }
    }
}
DEV void attn_fold(f32x4 (&tot)[4][2], const AttnAcc& st, const float (&gate)[2]) {
#pragma unroll
    for (int qt = 0; qt < 2; ++qt) {
        float l = st.l[qt];
        l += __shfl_xor(l, 16); l += __shfl_xor(l, 32);
        const float sc = gate[qt] / fmaxf(l, 1e-30f);
#pragma unroll
        for (int dt = 0; dt < 4; ++dt) tot[dt][qt] += st.o[dt][qt] * sc;
    }
}
DEV void stage64(bf16_t* dst, int dstride, const bf16_t* src, size_t sstride, int tid) {
#pragma unroll
    for (int i = 0; i < 2; ++i) {
        const int c = tid + 256 * i, r = c >> 3, k = (c & 7) * 8;
        *(u32x4*)(dst + r * dstride + k) = *(const u32x4*)(src + (size_t)r * sstride + k);
    }
}

struct MaskAll { DEV bool operator()(int, int) const { return true; } };
struct MaskSel { unsigned bit[2]; int t[2]; int k0; DEV bool operator()(int qt, int kk) const { return bit[qt] && (k0 + kk <= t[qt]); } };
struct MaskWin { int t[2]; int k0; DEV bool operator()(int qt, int kk) const { const int k = k0 + kk; return k <= t[qt] && k > t[qt] - 512; } };

DEV void xattn_job(const Params& P, int job, char* smem, bool dry) {
    char* aux = (char*)P.out;
    bf16_t* ZA = (bf16_t*)(P.ws + W_ZA);
    const int qb = job & 15, h = (job >> 4) & 3, b = job >> 6;
    bf16_t* sK = (bf16_t*)smem;
    bf16_t* sVt = sK + 64 * 72;
    const int tid = opaque_tid(), w = tid >> 6, lane = tid & 63, fr = lane & 15, fq = lane >> 4;
    const int t0 = qb * 128 + w * 32;
    bf16x8 qf[2][2];
#pragma unroll
    for (int qt = 0; qt < 2; ++qt)
#pragma unroll
        for (int ks = 0; ks < 2; ++ks) qf[qt][ks] = *(const bf16x8*)(ZA + (size_t)(b * S + t0 + 16 * qt + fr) * ZW + C_QX + h * 64 + 32 * ks + 8 * fq);
    const bf16_t* MK = (const bf16_t*)(aux + O_MEMK) + (size_t)(b * 4 + h) * 256 * 64;
    const bf16_t* MVT = (const bf16_t*)(aux + O_MEMVT) + (size_t)(b * 4 + h) * 64 * 256;
    AttnAcc st; attn_init(st);
    for (int jb = 0; jb < 4; ++jb) {
        __syncthreads();
        stage64(sK, 72, MK + (size_t)jb * 64 * 64, 64, tid);
        stage64(sVt, 72, MVT + jb * 64, 256, tid);
        __syncthreads();
        attn_step(sK, sVt, 72, qf, st, MaskAll(), fr, fq);
    }
    f32x4 tot[4][2];
#pragma unroll
    for (int dt = 0; dt < 4; ++dt) { tot[dt][0] = (f32x4){0.f, 0.f, 0.f, 0.f}; tot[dt][1] = (f32x4){0.f, 0.f, 0.f, 0.f}; }
    const float one[2] = {1.f, 1.f};
    attn_fold(tot, st, one);
#pragma unroll
    for (int qt = 0; qt < 2; ++qt)
#pragma unroll
        for (int dt = 0; dt < 4; ++dt)
            *(uint2*)((dry ? (bf16_t*)(P.ws + W_Y) + (size_t)(b * S + t0 + 16 * qt + fr) * 1024 : ZA + (size_t)(b * S + t0 + 16 * qt + fr) * ZW + C_QX) + h * 64 + 16 * dt + 4 * fq) =
                make_uint2(pk2(tot[dt][qt][0], tot[dt][qt][1]), pk2(tot[dt][qt][2], tot[dt][qt][3]));
}

DEV void nsa_job(const Params& P, int job, char* smem, bool dry) {
    char* aux = (char*)P.out;
    bf16_t* ZA = (bf16_t*)(P.ws + W_ZA);
    const int bg = job & 31, qb = 63 - (job >> 5), b = bg >> 2, g = bg & 3, t0 = qb * 32;
    bf16_t* sK = (bf16_t*)smem;
    bf16_t* sVt = (bf16_t*)(smem + 18432);
    float* sImp = (float*)(smem + 18432 + 17408);
    unsigned* sSel = (unsigned*)(smem + 18432 + 17408 + 16384);
    const int tid = opaque_tid(), w = tid >> 6, lane = tid & 63, fr = lane & 15, fq = lane >> 4;
    const int head = g * 4 + w;
    int tq[2];
    bf16x8 qf[2][2];
    float gate[3][2];
#pragma unroll
    for (int qt = 0; qt < 2; ++qt) {
        tq[qt] = t0 + 16 * qt + fr;
        const bf16_t* rowp = ZA + (size_t)(b * S + tq[qt]) * ZW;
#pragma unroll
        for (int ks = 0; ks < 2; ++ks) qf[qt][ks] = *(const bf16x8*)(rowp + C_Q + head * 64 + 32 * ks + 8 * fq);
#pragma unroll
        for (int br = 0; br < 3; ++br) gate[br][qt] = bf2f(rowp[C_G + head * 3 + br]);
    }
    f32x4 tot[4][2];
#pragma unroll
    for (int dt = 0; dt < 4; ++dt) { tot[dt][0] = (f32x4){0.f, 0.f, 0.f, 0.f}; tot[dt][1] = (f32x4){0.f, 0.f, 0.f, 0.f}; }

    {
        const bf16_t* KC = (const bf16_t*)(aux + O_KC) + (size_t)bg * 128 * 64;
        const bf16_t* VCT = (const bf16_t*)(aux + O_VCT) + (size_t)bg * 64 * 128;
        __syncthreads();
#pragma unroll
        for (int i = 0; i < 4; ++i) {
            const int c = tid + 256 * i;
            { const int r = c >> 3, k = (c & 7) * 8; *(u32x4*)(sK + r * 72 + k) = *(const u32x4*)(KC + r * 64 + k); }
            { const int r = c >> 4, k = (c & 15) * 8; *(u32x4*)(sVt + r * 136 + k) = *(const u32x4*)(VCT + r * 128 + k); }
        }
        __syncthreads();
#pragma unroll
        for (int qt = 0; qt < 2; ++qt) {
            f32x4 s[8];
#pragma unroll
            for (int kt = 0; kt < 8; ++kt) {
                s[kt] = (f32x4){0.f, 0.f, 0.f, 0.f};
#pragma unroll
                for (int ks = 0; ks < 2; ++ks) {
                    const bf16x8 kf = *(const bf16x8*)(sK + (16 * kt + fr) * 72 + 32 * ks + 8 * fq);
                    s[kt] = MFMA16(kf, qf[qt][ks], s[kt]);
                }
            }
            float mx = -INFINITY;
#pragma unroll
            for (int kt = 0; kt < 8; ++kt)
#pragma unroll
                for (int j = 0; j < 4; ++j) {
                    const int n = 16 * kt + 4 * fq + j;
                    const float v = (n < NCMP && 16 * n + 31 <= tq[qt]) ? s[kt][j] : -INFINITY;
                    s[kt][j] = v; mx = fmaxf(mx, v);
                }
            mx = fmaxf(mx, __shfl_xor(mx, 16)); mx = fmaxf(mx, __shfl_xor(mx, 32));
            const float msub = (mx == -INFINITY) ? 0.f : mx;
            float ps = 0.f;
#pragma unroll
            for (int kt = 0; kt < 8; ++kt)
#pragma unroll
                for (int j = 0; j < 4; ++j) { const float p = __builtin_amdgcn_exp2f((s[kt][j] - msub) * EXPC); s[kt][j] = p; ps += p; }
            ps += __shfl_xor(ps, 16); ps += __shfl_xor(ps, 32);
            const float inv = 1.0f / fmaxf(ps, 1e-30f);
            float bprev = 0.f;
#pragma unroll
            for (int kt = 0; kt < 8; ++kt) {
                s[kt] *= inv;
                const float a = s[kt][0] + s[kt][1] + s[kt][2] + 0.5f * s[kt][3];
                const float bq = 0.5f * s[kt][3];
                const float x = __shfl(bq, (lane + 48) & 63);
                const float y = __shfl(bprev, (lane + 48) & 63);
                sImp[(w * 32 + 16 * qt + fr) * 32 + 4 * kt + fq] = a + (fq > 0 ? x : y);
                bprev = bq;
            }
            f32x4 oc[4];
#pragma unroll
            for (int dt = 0; dt < 4; ++dt) oc[dt] = (f32x4){0.f, 0.f, 0.f, 0.f};
#pragma unroll
            for (int ks = 0; ks < 4; ++ks) {
                const bf16x8 pf = mk8(pk2(s[2 * ks][0], s[2 * ks][1]), pk2(s[2 * ks][2], s[2 * ks][3]),
                                      pk2(s[2 * ks + 1][0], s[2 * ks + 1][1]), pk2(s[2 * ks + 1][2], s[2 * ks + 1][3]));
#pragma unroll
                for (int dt = 0; dt < 4; ++dt) {
                    const u32x2 v0 = *(const u32x2*)(sVt + (16 * dt + fr) * 136 + 32 * ks + 4 * fq);
                    const u32x2 v1 = *(const u32x2*)(sVt + (16 * dt + fr) * 136 + 32 * ks + 16 + 4 * fq);
                    oc[dt] = MFMA16(mk8(v0.x, v0.y, v1.x, v1.y), pf, oc[dt]);
                }
            }
#pragma unroll
            for (int dt = 0; dt < 4; ++dt) tot[dt][qt] += oc[dt] * gate[0][qt];
        }
    }
    __syncthreads();
    if (tid < 32) {
        const int t = t0 + tid, cur = t >> 6;
        for (int m = 0; m < 32; ++m) {
            const float v = ((sImp[(0 * 32 + tid) * 32 + m] + sImp[(1 * 32 + tid) * 32 + m]) + sImp[(2 * 32 + tid) * 32 + m]) + sImp[(3 * 32 + tid) * 32 + m];
            sImp[tid * 32 + m] = v;
        }
        unsigned sel = 0;
        for (int round = 0; round < 8; ++round) {
            float bv = -INFINITY; int bi = -1;
            for (int m = 0; m < 32; ++m) {
                if ((sel >> m) & 1u) continue;
                const bool forced = (m == 0) || (m == cur) || (m == cur - 1);
                const bool future = m * 64 > t;
                const float v = forced ? INFINITY : (future ? -INFINITY : sImp[tid * 32 + m]);
                if (v > bv) { bv = v; bi = m; }
            }
            if (bi < 0) break;
            sel |= 1u << bi;
        }
        sSel[tid] = sel;
        unsigned un = sel;
#pragma unroll
        for (int o = 16; o >= 1; o >>= 1) un |= __shfl_xor(un, o);
        if (tid == 0) sSel[32] = un;
    }
    __syncthreads();
    const unsigned uni = sSel[32];
    const unsigned mysel[2] = {sSel[fr], sSel[16 + fr]};
    const int jmax = (t0 + 31) >> 6;
    {
        AttnAcc st; attn_init(st);
        const bf16_t* Kb = ZA + (size_t)(b * S) * ZW + C_KS + g * 64;
        const bf16_t* Vb = (const bf16_t*)(P.ws + W_VST) + (size_t)bg * 64 * S;
        for (int jb = 0; jb <= jmax; ++jb) {
            if (!((uni >> jb) & 1u)) continue;
            __syncthreads();
            stage64(sK, 72, Kb + (size_t)(jb * 64) * ZW, ZW, tid);
            stage64(sVt, 72, Vb + jb * 64, S, tid);
            __syncthreads();
            MaskSel mf; mf.bit[0] = (mysel[0] >> jb) & 1u; mf.bit[1] = (mysel[1] >> jb) & 1u; mf.t[0] = tq[0]; mf.t[1] = tq[1]; mf.k0 = jb * 64;
            attn_step(sK, sVt, 72, qf, st, mf, fr, fq);
        }
        attn_fold(tot, st, gate[1]);
    }
    {
        AttnAcc st; attn_init(st);
        const bf16_t* Kb = ZA + (size_t)(b * S) * ZW + C_KW + g * 64;
        const bf16_t* Vb = (const bf16_t*)(P.ws + W_VWT) + (size_t)bg * 64 * S;
#pragma unroll
        for (int qt = 0; qt < 2; ++qt) {
            const int npad = 511 - tq[qt];
            if (npad > 0) { st.m[qt] = 0.f; st.l[qt] = (fq == 0) ? (float)npad : 0.f; }
        }
        int jlo = t0 - 511; jlo = jlo < 0 ? 0 : (jlo >> 6);
        for (int jb = jlo; jb <= jmax; ++jb) {
            __syncthreads();
            stage64(sK, 72, Kb + (size_t)(jb * 64) * ZW, ZW, tid);
            stage64(sVt, 72, Vb + jb * 64, S, tid);
            __syncthreads();
            MaskWin mf; mf.t[0] = tq[0]; mf.t[1] = tq[1]; mf.k0 = jb * 64;
            attn_step(sK, sVt, 72, qf, st, mf, fr, fq);
        }
        attn_fold(tot, st, gate[2]);
    }
#pragma unroll
    for (int qt = 0; qt < 2; ++qt)
#pragma unroll
        for (int dt = 0; dt < 4; ++dt)
            *(uint2*)((dry ? (bf16_t*)(P.ws + W_YX) + (size_t)(b * S + tq[qt]) * 1024 : ZA + (size_t)(b * S + tq[qt]) * ZW + C_Q) + head * 64 + 16 * dt + 4 * fq) =
                make_uint2(pk2(tot[dt][qt][0], tot[dt][qt][1]), pk2(tot[dt][qt][2], tot[dt][qt][3]));
}


#define XB_TMO      128
#define XB_XCNT(j)  (256  + 64 * (j))
#define XB_XSUB(j)  (1280 + 64 * (j))
#define XB_XGEN(j)  (2304 + 64 * (j))
#define XB_TOP      3328
#define XB_TOPGEN   3392
#define XCD_BAR_WORDS 3456
#define XB_SPIN_CAP (1u << 18)
#define LAS __attribute__((address_space(3)))
DEV unsigned xb_ld(unsigned* p) { return __hip_atomic_load(p, __ATOMIC_RELAXED, __HIP_MEMORY_SCOPE_AGENT); }
DEV unsigned xb_add(unsigned* p, unsigned v) { return __hip_atomic_fetch_add(p, v, __ATOMIC_RELAXED, __HIP_MEMORY_SCOPE_AGENT); }
DEV unsigned xb_xcc_id() { return (unsigned)__builtin_amdgcn_s_getreg((3 << 11) | 20) & 0xFu; }
#define XB_SPIN(cond, bar) do { unsigned _sp = 0; while (cond) { __builtin_amdgcn_s_sleep(1); \
    if ((++_sp & 255u) == 0u) { if (xb_ld(&(bar)[XB_TMO])) break; if (_sp > XB_SPIN_CAP) { atomicAdd(&(bar)[XB_TMO], 1u); break; } } } } while (0)
struct XcdBarrier { unsigned* bar; unsigned x; volatile LAS unsigned* st; };
DEV XcdBarrier xcd_barrier_post(unsigned* bar, volatile LAS unsigned* st) {
    XcdBarrier b; b.bar = bar; b.x = xb_xcc_id(); b.st = st;
    if (threadIdx.x == 0) (void)xb_add(&bar[XB_XCNT(b.x)], 1u);
    return b;
}
DEV void xcd_barrier_complete(unsigned* bar, unsigned x, unsigned& nloc, unsigned& nx) {
    const unsigned G = gridDim.x * gridDim.y * gridDim.z;
    unsigned sum, cnt, mine, sp = 0u;
    for (;;) {
        sum = 0u; cnt = 0u; mine = 0u;
#pragma unroll
        for (unsigned j = 0; j < 16; ++j) { const unsigned c = xb_ld(&bar[XB_XCNT(j)]); sum += c; cnt += (c > 0u) ? 1u : 0u; mine = (j == x) ? c : mine; }
        if (sum == G) break;
        __builtin_amdgcn_s_sleep(1);
        if ((++sp & 255u) == 0u) { if (xb_ld(&bar[XB_TMO])) break; if (sp > XB_SPIN_CAP) { atomicAdd(&bar[XB_TMO], 1u); break; } }
    }
    nloc = mine > 0u ? mine : 1u; nx = cnt > 0u ? cnt : 1u;
}
DEV void xcd_barrier(const XcdBarrier& b) {
    asm volatile("s_waitcnt vmcnt(0)" ::: "memory");
    __syncthreads();
    if (threadIdx.x == 0) {
        unsigned* bar = b.bar;
        __builtin_amdgcn_s_waitcnt(0);
        unsigned nloc = b.st[0], nx = b.st[1];
        if (nloc == 0u) { xcd_barrier_complete(bar, b.x, nloc, nx); b.st[0] = nloc; b.st[1] = nx; }
        const unsigned old = xb_add(&bar[XB_XSUB(b.x)], 1u);
        const unsigned gen = old / nloc;
        if (old + 1u == (gen + 1u) * nloc) {
            __builtin_amdgcn_fence(__ATOMIC_RELEASE, "agent");
            asm volatile("s_waitcnt vmcnt(0)" ::: "memory");
            const unsigned og = xb_add(&bar[XB_TOP], 1u);
            const unsigned tg = og / nx;
            if (og + 1u == (tg + 1u) * nx) xb_add(&bar[XB_TOPGEN], 1u);
            else XB_SPIN(xb_ld(&bar[XB_TOPGEN]) == tg, bar);
            __builtin_amdgcn_fence(__ATOMIC_ACQUIRE, "agent");
            xb_add(&bar[XB_XGEN(b.x)], 1u);
            asm volatile("s_waitcnt vmcnt(0)" ::: "memory");
        } else {
            XB_SPIN(xb_ld(&bar[XB_XGEN(b.x)]) == gen, bar);
            __builtin_amdgcn_fence(__ATOMIC_ACQUIRE, "agent");
            asm volatile("s_waitcnt vmcnt(0)" ::: "memory");
        }
    }
    __syncthreads();
}
constexpr size_t W_BAR = 252 * MiB;

constexpr int NPHASE = 11;
constexpr int SMEM_BYTES = 55296;

template <int PH, bool DRY = false>
DEV void run_phase(const Params& P, char* smem) {
    const int nb = gridDim.x, bid = blockIdx.x;
    char* aux = (char*)P.out;
    char* ws = P.ws;
    bf16_t* ZA = (bf16_t*)(ws + W_ZA);
    if (PH == 0) {
        for (int job = bid; job < 4800 + 4096 + 512 + 64; job += nb) {
            int j = job;
            if (j < 4800) {
                bool done = false;
#define TR(SRC, LD, DSTOFF, KK, NN, MAP)                                                                                       \
    if (!done) { const int nrt = (NN) / 64, nt = nrt * ((KK) / 64);                                                              \
        if (j < nt) { transpose_tile((SRC), (LD), (bf16_t*)(aux + (DSTOFF)), (KK), (j % nrt) * 64, (j / nrt) * 64, (MAP), smem); done = true; } else j -= nt; }
                TR(P.w_in, 7984, O_WTA, 1024, 4992, 1)
                TR(P.w_in, 7984, O_WTB, 1024, 3072, 2)
                TR(P.w_up, 4096, O_WTUP, 1024, 4096, 0)
                TR(P.w_down, 1024, O_WTDN, 4096, 1024, 0)
                TR(P.w_o, 1024, O_WTO, 1024, 1024, 0)
                TR(P.w_xo, 1024, O_WTXO, 256, 1024, 0)
                TR(P.w_mkv, 512, O_WTMKV, 1024, 512, 0)
                TR(P.wk1, 256, O_WTCK1, 2048, 256, 0)
                TR(P.wv1, 256, O_WTCV1, 2048, 256, 0)
#undef TR
                if (!done) {
                    if (j < 16) transpose_tile(P.w_a + j * 4096, 64, (bf16_t*)(aux + O_WAT) + j * 4096, 64, 0, 0, 0, smem);
                    else { j -= 16; transpose_tile(P.w_i + j * 4096, 64, (bf16_t*)(aux + O_WIT) + j * 4096, 64, 0, 0, 0, smem); }
                }
                continue;
            }
            j -= 4800;
            if (j < 4096) { rownorm<false>(P.x, P.g_mix, (bf16_t*)(ws + W_U), nullptr, j * 4 + (threadIdx.x >> 6)); continue; }
            j -= 4096;
            if (j < 512) { rownorm<false>(P.mem, P.g_mem, (bf16_t*)(aux + O_MEMN), nullptr, j * 4 + (threadIdx.x >> 6)); continue; }
            j -= 512;
            rope_job((float*)(aux + O_ROPEC), (float*)(aux + O_ROPES), j);
        }
    } else if (PH == 1) {
        const int nA = tile_count(39);
        for (int job = bid; job < 32 + nA; job += nb) {
            if (job < 32) {
                ALPlain al; al.A = (const bf16_t*)(aux + O_MEMN); al.lda = 1024;
                const int pm = job & 7, pn = job >> 3;
                if (pn < 2) { EpiMemKV<true> ep{(bf16_t*)(aux + O_MEMK), (bf16_t*)(aux + O_MEMVT)}; gemm_tile<8, 4, true>(al, (const bf16_t*)(aux + O_WTMKV), 1024, 1024, pm, pn, ep, smem); }
                else { EpiMemKV<false> ep{(bf16_t*)(aux + O_MEMK), (bf16_t*)(aux + O_MEMVT)}; gemm_tile<8, 4, false>(al, (const bf16_t*)(aux + O_WTMKV), 1024, 1024, pm, pn, ep, smem); }
            } else {
                int pm, pn;
                if (!tile_map(job - 32, 39, pm, pn)) continue;
                ALPlain al; al.A = (const bf16_t*)(ws + W_U); al.lda = 1024;
                if (pn < 35) { EpiZA<true> ep{ZA, (bf16_t*)(ws + W_VST), (bf16_t*)(ws + W_VWT), (const float*)(aux + O_ROPEC), (const float*)(aux + O_ROPES)};
                    gemm_tile<8, 4, true>(al, (const bf16_t*)(aux + O_WTA), 1024, 1024, pm, pn, ep, smem); }
                else { EpiZA<false> ep{ZA, (bf16_t*)(ws + W_VST), (bf16_t*)(ws + W_VWT), (const float*)(aux + O_ROPEC), (const float*)(aux + O_ROPES)};
                    gemm_tile<8, 4, false>(al, (const bf16_t*)(aux + O_WTA), 1024, 1024, pm, pn, ep, smem); }
            }
        }
    } else if (PH == 2) {
        for (int job = bid; job < 128 + 128 + 512; job += nb) {
            if (job < 128) rnn_job(P, job, smem, DRY);
            else if (job < 256) {
                const int j = job - 128, which = j >> 6, pm = (j & 63) >> 1, pn = j & 1;
                ALCmp al; al.ZA = ZA; al.pos = which ? P.cpv : P.cpk; al.colbase = which ? C_VC : C_KC;
                EpiHid ep{(bf16_t*)(aux + (which ? O_HIDV : O_HIDK))};
                gemm_tile<4, 4, true>(al, (const bf16_t*)(aux + (which ? O_WTCV1 : O_WTCK1)), 2048, 2048, pm, pn, ep, smem);
            } else xattn_job(P, job - 256, smem, DRY);
        }
    } else if (PH == 3) {
        for (int job = bid; job < 2032; job += nb) cmp2_job(P, job);
    } else if (PH == 4) {
        for (int job = bid; job < 2048 + 512; job += nb) {
            if (job < 2048) nsa_job(P, job, smem, DRY);
            else if (!DRY) {
                int pm, pn;
                if (!tile_map(job - 2048, 8, pm, pn)) continue;
                ALPlain al; al.A = ZA + C_QX; al.lda = ZW;
                EpiBf<0> ep{(bf16_t*)(ws + W_YX), 1024};
                gemm_tile<8, 4, true>(al, (const bf16_t*)(aux + O_WTXO), 256, 256, pm, pn, ep, smem);
            }
        }
    } else if (PH == 5) {
        for (int job = bid; job < tile_count(32); job += nb) {
            int pm, pn;
            if (!tile_map(job, 32, pm, pn)) continue;
            ALPlain al; al.A = (const bf16_t*)(ws + W_U); al.lda = 1024;
            EpiMerge ep{ZA, (const bf16_t*)(ws + W_YX), (bf16_t*)(ws + W_Y)};
            gemm_tile<8, 3, true>(al, (const bf16_t*)(aux + O_WTB), 1024, 1024, pm, pn, ep, smem);
        }
    } else if (PH == 6) {
        for (int job = bid; job < tile_count(8); job += nb) {
            int pm, pn;
            if (!tile_map(job, 8, pm, pn)) continue;
            ALPlain al; al.A = (const bf16_t*)(ws + W_Y); al.lda = 1024;
            EpiRes ep{P.x, (float*)(ws + W_H)};
            gemm_tile<8, 4, true>(al, (const bf16_t*)(aux + O_WTO), 1024, 1024, pm, pn, ep, smem);
        }
    } else if (PH == 7) {
        for (int job = bid; job < 4096; job += nb) rownorm<false>((const float*)(ws + W_H), P.g_mlp, (bf16_t*)(ws + W_VN), nullptr, job * 4 + (threadIdx.x >> 6));
    } else if (PH == 8) {
        for (int job = bid; job < tile_count(32); job += nb) {
            int pm, pn;
            if (!tile_map(job, 32, pm, pn)) continue;
            ALPlain al; al.A = (const bf16_t*)(ws + W_VN); al.lda = 1024;
            EpiBf<1> ep{(bf16_t*)(ws + W_HID), 4096};
            gemm_tile<8, 4, true>(al, (const bf16_t*)(aux + O_WTUP), 1024, 1024, pm, pn, ep, smem);
        }
    } else if (PH == 9) {
        for (int job = bid; job < tile_count(8); job += nb) {
            int pm, pn;
            if (!tile_map(job, 8, pm, pn)) continue;
            ALPlain al; al.A = (const bf16_t*)(ws + W_HID); al.lda = 4096;
            EpiRes ep{(const float*)(ws + W_H), (float*)(ws + W_H)};
            gemm_tile<8, 4, true>(al, (const bf16_t*)(aux + O_WTDN), 4096, 4096, pm, pn, ep, smem);
        }
    } else if (PH == 10) {
        for (int job = bid; job < 4096; job += nb) rownorm<true>((const float*)(ws + W_H), P.g_final, nullptr, P.out, job * 4 + (threadIdx.x >> 6));
    }
}

#if MULTI
template <int PH>
__global__ void __launch_bounds__(256, 2) phase_kernel(Params P) {
    __shared__ __attribute__((aligned(16))) char smem[SMEM_BYTES];
    run_phase<PH>(P, smem);
}
#else
__global__ void __launch_bounds__(256, 2) mega_kernel(Params P) {
    __shared__ __attribute__((aligned(16))) char smem[SMEM_BYTES];
    cg::grid_group grid = cg::this_grid();
    __shared__ uint4 xb_words;
    if (threadIdx.x == 0) xb_words = make_uint4(0u, 0u, 0u, 0u);
    __syncthreads();
    XcdBarrier xb = xcd_barrier_post((unsigned*)(P.ws + W_BAR), (volatile LAS unsigned*)&xb_words);
    if (P.ws == nullptr) grid.sync();
#ifndef REP
#define REP -1
#endif
#define GSYNC() xcd_barrier(xb)
#define PHASE(k) { if (REP == k && k != 9) { run_phase<k, true>(P, smem); GSYNC(); } run_phase<k>(P, smem); GSYNC(); }
    PHASE(0) PHASE(1) PHASE(2) PHASE(3) PHASE(4) PHASE(5) PHASE(6) PHASE(7) PHASE(8) PHASE(9)
    if (REP == 10) { run_phase<10>(P, smem); GSYNC(); }
    if (REP == 11) { GSYNC(); GSYNC(); GSYNC(); GSYNC(); GSYNC(); GSYNC(); GSYNC(); GSYNC(); GSYNC(); GSYNC(); }
    run_phase<10>(P, smem);
}
#endif

extern "C" void kernel_launch(void* const* d_in, const int* in_sizes, int n_in, void* d_out, int out_size, void* d_ws, size_t ws_size,
                              hipStream_t stream) {
    Params P{};
    const float** pp = (const float**)&P;
    for (int i = 0; i < 25; ++i) pp[i] = (const float*)d_in[i];
    P.out = (float*)d_out;
    P.ws = (char*)d_ws;
#if MULTI
    const int G = 1024;
    phase_kernel<0><<<G, 256, 0, stream>>>(P);
    phase_kernel<1><<<G, 256, 0, stream>>>(P);
    phase_kernel<2><<<G, 256, 0, stream>>>(P);
    phase_kernel<3><<<G, 256, 0, stream>>>(P);
    phase_kernel<4><<<G, 256, 0, stream>>>(P);
    phase_kernel<5><<<G, 256, 0, stream>>>(P);
    phase_kernel<6><<<G, 256, 0, stream>>>(P);
    phase_kernel<7><<<G, 256, 0, stream>>>(P);
    phase_kernel<8><<<G, 256, 0, stream>>>(P);
    phase_kernel<9><<<G, 256, 0, stream>>>(P);
    phase_kernel<10><<<G, 256, 0, stream>>>(P);
#else
    static int grid_blocks = 0;
    if (!grid_blocks) {
        int dev = 0, cus = 0, per_cu = 0;
        hipGetDevice(&dev);
        hipDeviceGetAttribute(&cus, hipDeviceAttributeMultiprocessorCount, dev);
        hipOccupancyMaxActiveBlocksPerMultiprocessor(&per_cu, mega_kernel, 256, 0);
        if (per_cu > 2) per_cu = 2;
        if (per_cu < 1) per_cu = 1;
        grid_blocks = cus * per_cu;
    }
    hipMemsetAsync((char*)d_ws + W_BAR, 0, XCD_BAR_WORDS * 4, stream);
    void* args[] = {&P};
    hipError_t e = hipLaunchCooperativeKernel((void*)mega_kernel, dim3(grid_blocks), dim3(256), args, 0, stream);
    if (e != hipSuccess) fprintf(stderr, "cooperative launch failed: %s (grid %d)\n", hipGetErrorString(e), grid_blocks);
#endif
}
```

```cpp
#include <hip/hip_runtime.h>
#include <hip/hip_cooperative_groups.h>
#include <cstdint>
#include <cstdio>
namespace cg = cooperative_groups;

#ifndef MULTI
#define MULTI 0
#endif

typedef unsigned short bf16_t;
typedef short bf16x8 __attribute__((ext_vector_type(8)));
typedef float f32x4 __attribute__((ext_vector_type(4)));
typedef __bf16 bfv2 __attribute__((ext_vector_type(2)));
typedef float f32x2 __attribute__((ext_vector_type(2)));
typedef unsigned u32x4 __attribute__((ext_vector_type(4)));
typedef unsigned u32x2 __attribute__((ext_vector_type(2)));
#define DEV __device__ __forceinline__
DEV int opaque_tid() { int t = threadIdx.x; asm volatile("" : "+v"(t)); return t; }
#define MFMA16(a, b, c) __builtin_amdgcn_mfma_f32_16x16x32_bf16((a), (b), (c), 0, 0, 0)

constexpr int T = 16384, S = 2048;
constexpr int ZW = 4480;
constexpr int C_Q = 0, C_KC = 1024, C_VC = 1280, C_KS = 1536, C_KW = 1792, C_XR = 2048, C_GR = 3072, C_QX = 4096, C_G = 4352;
constexpr int NCMP = 127;
constexpr int NCROWS = 4064;

constexpr size_t O_WTA = 0;
constexpr size_t O_WTB = O_WTA + (size_t)4992 * 1024 * 2;
constexpr size_t O_WTUP = O_WTB + (size_t)3072 * 1024 * 2;
constexpr size_t O_WTDN = O_WTUP + (size_t)4096 * 1024 * 2;
constexpr size_t O_WTO = O_WTDN + (size_t)4096 * 1024 * 2;
constexpr size_t O_WTXO = O_WTO + (size_t)1024 * 1024 * 2;
constexpr size_t O_WTMKV = O_WTXO + (size_t)1024 * 256 * 2;
constexpr size_t O_WTCK1 = O_WTMKV + (size_t)512 * 1024 * 2;
constexpr size_t O_WTCV1 = O_WTCK1 + (size_t)256 * 2048 * 2;
constexpr size_t O_WAT = O_WTCV1 + (size_t)256 * 2048 * 2;
constexpr size_t O_WIT = O_WAT + (size_t)16 * 64 * 64 * 2;
constexpr size_t O_ROPEC = O_WIT + (size_t)16 * 64 * 64 * 2;
constexpr size_t O_ROPES = O_ROPEC + (size_t)2048 * 8 * 4;
constexpr size_t O_MEMN = O_ROPES + (size_t)2048 * 8 * 4;
constexpr size_t O_MEMK = O_MEMN + (size_t)2048 * 1024 * 2;
constexpr size_t O_MEMVT = O_MEMK + (size_t)2048 * 256 * 2;
constexpr size_t O_HIDK = O_MEMVT + (size_t)2048 * 256 * 2;
constexpr size_t O_HIDV = O_HIDK + (size_t)4096 * 256 * 2;
constexpr size_t O_KC = O_HIDV + (size_t)4096 * 256 * 2;
constexpr size_t O_VCT = O_KC + (size_t)32 * 128 * 64 * 2;
constexpr size_t O_AUX_END = O_VCT + (size_t)32 * 64 * 128 * 2;
static_assert(O_AUX_END <= (size_t)64 << 20, "aux overflow");
constexpr size_t MiB = (size_t)1 << 20;
constexpr size_t W_U = 0, W_ZA = 32 * MiB, W_VST = 172 * MiB, W_VWT = 180 * MiB, W_YX = 188 * MiB, W_Y = 220 * MiB;
constexpr size_t W_H = 32 * MiB, W_VN = 0, W_HID = 96 * MiB;

struct Params {
    const float *x, *mem, *g_mix, *w_in, *cpk, *cpv, *wk1, *wk2, *wv1, *wv2, *conv_w, *conv_b, *w_a, *b_a, *w_i, *b_i, *lam,
        *g_mem, *w_mkv, *w_xo, *w_o, *g_mlp, *w_up, *w_down, *g_final;
    float* out;
    char* ws;
};

DEV float bf2f(bf16_t h) { return __uint_as_float(((unsigned)h) << 16); }
DEV unsigned pk2(float lo, float hi) { f32x2 v = {lo, hi}; bfv2 b = __builtin_convertvector(v, bfv2); return __builtin_bit_cast(unsigned, b); }
DEV bf16_t f2bf(float f) { return (bf16_t)(pk2(f, 0.f) & 0xffffu); }
DEV float lo_f(unsigned u) { return __uint_as_float(u << 16); }
DEV float hi_f(unsigned u) { return __uint_as_float(u & 0xffff0000u); }
DEV float sigm(float x) { return __builtin_amdgcn_rcpf(1.f + __expf(-x)); }
DEV float gelu_t(float x) {
    float y = 0.7978845608028654f * (x + 0.044715f * x * x * x);
    float e = __expf(2.f * y);
    float th = 1.f - 2.f * __builtin_amdgcn_rcpf(1.f + e);
    return 0.5f * x * (1.f + th);
}
DEV float wave_sum(float v) {
#pragma unroll
    for (int o = 32; o >= 1; o >>= 1) v += __shfl_xor(v, o);
    return v;
}

DEV int map_col(int mapid, int r) {
    if (mapid == 0) return r;
    if (mapid == 1) {
        if (r < 1536) return r;
        if (r < 1792) return 1536 + (r - 1536);
        if (r < 2048) return 2048 + (r - 1792);
        if (r < 3072) return 2608 + (r - 2048);
        if (r < 4096) return 3632 + (r - 3072);
        if (r < 4352) return 4656 + (r - 4096);
        if (r < 4400) return 2560 + (r - 4352);
        if (r < 4480) return -1;
        if (r < 4736) return 1792 + (r - 4480);
        return 2304 + (r - 4736);
    }
    int pn = r / 96, rem = r - pn * 96, wc = rem / 48, rem2 = rem - wc * 48, gidx = rem2 >> 4, cc = rem2 & 15;
    return 4912 + gidx * 1024 + pn * 32 + wc * 16 + cc;
}

DEV void transpose_tile(const float* __restrict__ src, int ld, bf16_t* __restrict__ dst, int K, int r0, int k0, int mapid, char* smem) {
    float* sm = (float*)smem;
    const int tid = threadIdx.x, lane = tid & 63, w = tid >> 6;
    __syncthreads();
    const int sc = map_col(mapid, r0 + lane);
#pragma unroll
    for (int i = 0; i < 16; ++i) {
        int kk = w + 4 * i;
        float v = sc >= 0 ? src[(size_t)(k0 + kk) * ld + sc] : 0.f;
        sm[kk * 65 + lane] = v;
    }
    __syncthreads();
    const int rr = tid >> 2, kq = (tid & 3) * 16;
    unsigned o[8];
#pragma unroll
    for (int e = 0; e < 8; ++e) o[e] = pk2(sm[(kq + 2 * e) * 65 + rr], sm[(kq + 2 * e + 1) * 65 + rr]);
    uint4* dp = (uint4*)(dst + (size_t)(r0 + rr) * K + k0 + kq);
    dp[0] = make_uint4(o[0], o[1], o[2], o[3]);
    dp[1] = make_uint4(o[4], o[5], o[6], o[7]);
}

template <bool OUTF32>
DEV void rownorm(const float* __restrict__ src, const float* __restrict__ g, bf16_t* dstb, float* dstf, int row) {
    const int lane = threadIdx.x & 63;
    const float4* sp = (const float4*)(src + (size_t)row * 1024);
    float4 v[4];
    float ss = 0.f;
#pragma unroll
    for (int i = 0; i < 4; ++i) { v[i] = sp[lane + 64 * i]; ss += v[i].x * v[i].x + v[i].y * v[i].y + v[i].z * v[i].z + v[i].w * v[i].w; }
    ss = wave_sum(ss);
    const float r = rsqrtf(ss * (1.0f / 1024.0f) + 1e-6f);
#pragma unroll
    for (int i = 0; i < 4; ++i) {
        float4 gg = ((const float4*)g)[lane + 64 * i];
        float a = v[i].x * r * gg.x, b = v[i].y * r * gg.y, c = v[i].z * r * gg.z, d = v[i].w * r * gg.w;
        if (OUTF32) ((float4*)(dstf + (size_t)row * 1024))[lane + 64 * i] = make_float4(a, b, c, d);
        else ((uint2*)(dstb + (size_t)row * 1024))[lane + 64 * i] = make_uint2(pk2(a, b), pk2(c, d));
    }
}

DEV void rope_job(float* ct, float* st, int job) {
    const int e = job * 256 + threadIdx.x;
    const int pos = e >> 3, i = e & 7;
    const double inv = exp(-(double)i * 0.125 * 13.122363377404328);
    const double ang = (double)pos * inv;
    const double kq = rint(ang * 0.6366197723675814);
    const double r = ang - kq * 1.5707963267948966;
    const double r2 = r * r;
    const double sn = r * (1.0 + r2 * (-1.0 / 6 + r2 * (1.0 / 120 + r2 * (-1.0 / 5040 + r2 * (1.0 / 362880 + r2 * (-1.0 / 39916800 + r2 * (1.0 / 6227020800.0)))))));
    const double cs = 1.0 + r2 * (-0.5 + r2 * (1.0 / 24 + r2 * (-1.0 / 720 + r2 * (1.0 / 40320 + r2 * (-1.0 / 3628800 + r2 * (1.0 / 479001600.0))))));
    const int q = ((int)kq) & 3;
    double s_, c_;
    if (q == 0) { s_ = sn; c_ = cs; } else if (q == 1) { s_ = cs; c_ = -sn; } else if (q == 2) { s_ = -sn; c_ = -cs; } else { s_ = -cs; c_ = sn; }
    ct[e] = (float)c_; st[e] = (float)s_;
}

struct ALPlain {
    const bf16_t* A; int lda;
    const char* base; unsigned off0;
    DEV void init(int row0, int lrow, int lk) { base = (const char*)(A + (size_t)row0 * lda); off0 = (unsigned)(lrow * lda + lk) * 2u; }
    DEV u32x4 load(int i, int k0) const { return *(const u32x4*)(base + (off0 + (unsigned)(i * 64 * lda) + (unsigned)(k0 * 2))); }
};
struct ALCmp {
    const bf16_t* ZA; const float* pos; int colbase;
    unsigned roff[4]; int lk_;
    DEV void init(int row0, int lrow, int lk) {
        lk_ = lk;
#pragma unroll
        for (int i = 0; i < 4; ++i) {
            const int row = row0 + lrow + 32 * i;
            const int bg = row / NCMP, n = row - bg * NCMP, b = bg >> 2, g = bg & 3;
            roff[i] = row < NCROWS ? (unsigned)(((b * S + 16 * n) * ZW + colbase + g * 64 + lk) * 2) : 0xffffffffu;
        }
    }
    DEV u32x4 load(int i, int k0) const {
        if (roff[i] == 0xffffffffu) return (u32x4){0u, 0u, 0u, 0u};
        const int j = k0 >> 6;
        const u32x4 v = *(const u32x4*)((const char*)ZA + (roff[i] + (unsigned)(j * ZW * 2)));
        const float4 p0 = *(const float4*)(pos + j * 64 + lk_), p1 = *(const float4*)(pos + j * 64 + lk_ + 4);
        u32x4 o;
        o.x = pk2(lo_f(v.x) + p0.x, hi_f(v.x) + p0.y); o.y = pk2(lo_f(v.y) + p0.z, hi_f(v.y) + p0.w);
        o.z = pk2(lo_f(v.z) + p1.x, hi_f(v.z) + p1.y); o.w = pk2(lo_f(v.w) + p1.z, hi_f(v.w) + p1.w);
        return o;
    }
};

template <int TM, int TN, bool SWAP, class AL, class EP>
DEV void gemm_tile(AL al, const bf16_t* __restrict__ Bt, int ldb, int K, int pm, int pn, const EP& ep, char* smem) {
    constexpr int BM = TM * 32, BN = TN * 32, NA = TM, NBB = TN;
    bf16_t* sA = (bf16_t*)smem;
    bf16_t* sB = sA + BM * 72;
    const int tid = opaque_tid(), wid = tid >> 6, lane = tid & 63, wr = wid >> 1, wc = wid & 1, fr = lane & 15, fq = lane >> 4;
    f32x4 acc[TM][TN];
#pragma unroll
    for (int m = 0; m < TM; ++m)
#pragma unroll
        for (int n = 0; n < TN; ++n) acc[m][n] = (f32x4){0.f, 0.f, 0.f, 0.f};
    const int lrow = tid >> 3, lk = (tid & 7) * 8;
    u32x4 ra[NA], rb[NBB];
    al.init(pm * BM, lrow, lk);
    const char* bbase = (const char*)(Bt + (size_t)(pn * BN) * ldb);
    const unsigned boff = (unsigned)(lrow * ldb + lk) * 2u;
#pragma unroll
    for (int i = 0; i < NA; ++i) ra[i] = al.load(i, 0);
#pragma unroll
    for (int i = 0; i < NBB; ++i) rb[i] = *(const u32x4*)(bbase + (boff + (unsigned)(i * 64 * ldb)));
    int nk = K >> 6;
    asm volatile("" : "+s"(nk));
    bf16_t* sWa = sA + lrow * 72 + lk;
    bf16_t* sWb = sB + lrow * 72 + lk;
    const bf16_t* sAr = sA + (wr * TM * 16 + fr) * 72 + fq * 8;
    const bf16_t* sBr = sB + (wc * TN * 16 + fr) * 72 + fq * 8;
#pragma unroll 1
    for (int kt = 0; kt < nk; ++kt) {
        __syncthreads();
#pragma unroll
        for (int i = 0; i < NA; ++i) *(u32x4*)(sWa + (32 * i) * 72) = ra[i];
#pragma unroll
        for (int i = 0; i < NBB; ++i) *(u32x4*)(sWb + (32 * i) * 72) = rb[i];
        __syncthreads();
        if (kt + 1 < nk) {
            const int k0 = (kt + 1) * 64;
#pragma unroll
            for (int i = 0; i < NA; ++i) ra[i] = al.load(i, k0);
#pragma unroll
            for (int i = 0; i < NBB; ++i) rb[i] = *(const u32x4*)(bbase + (boff + (unsigned)(i * 64 * ldb) + (unsigned)(k0 * 2)));
        }
        __builtin_amdgcn_sched_barrier(0);
        __builtin_amdgcn_s_setprio(1);
#pragma unroll
        for (int ks = 0; ks < 2; ++ks) {
            bf16x8 bfr[TN];
#pragma unroll
            for (int n = 0; n < TN; ++n) bfr[n] = *(const bf16x8*)(sBr + (n * 16) * 72 + ks * 32);
#pragma unroll
            for (int m = 0; m < TM; ++m) {
                const bf16x8 af = *(const bf16x8*)(sAr + (m * 16) * 72 + ks * 32);
#pragma unroll
                for (int n = 0; n < TN; ++n) acc[m][n] = SWAP ? MFMA16(bfr[n], af, acc[m][n]) : MFMA16(af, bfr[n], acc[m][n]);
            }
        }
        __builtin_amdgcn_s_setprio(0);
    }
    ep.run(acc, pm * BM + wr * TM * 16, pn * BN + wc * TN * 16, fr, fq);
}

DEV uint2 pk4(const f32x4& a) { return make_uint2(pk2(a[0], a[1]), pk2(a[2], a[3])); }

template <bool SWAP>
struct EpiZA {
    bf16_t *ZA, *VST, *VWT; const float *ropec, *ropes;
    DEV void run(f32x4 (&acc)[8][4], int R0, int C0, int fr, int fq) const {
#pragma unroll
        for (int n = 0; n < 4; ++n) {
            const int col0 = C0 + n * 16;
#pragma unroll
            for (int m = 0; m < 8; ++m) {
                f32x4 a = acc[m][n];
                if (!SWAP) {
                    const int r = R0 + m * 16 + 4 * fq;
                    int c = col0 - 4480 + fr;
                    bf16_t* dst = (c < 256) ? VST : VWT;
                    c &= 255;
                    const int g = c >> 6, d = c & 63, b = r >> 11, t = r & 2047;
                    *(uint2*)(dst + ((size_t)((b * 4 + g) * 64 + d)) * S + t) = pk4(a);
                } else {
                    const int row = R0 + m * 16 + fr;
                    const bool rope = (col0 < 1024 || (col0 >= 1536 && col0 < 2048)) && ((col0 & 63) == 0);
                    if (rope) {
                        const int t = row & 2047, i0 = 4 * (fq & 1);
                        const float4 cs = *(const float4*)(ropec + t * 8 + i0), sn = *(const float4*)(ropes + t * 8 + i0);
                        const float c4[4] = {cs.x, cs.y, cs.z, cs.w}, s4[4] = {sn.x, sn.y, sn.z, sn.w};
#pragma unroll
                        for (int j = 0; j < 4; ++j) {
                            const float pr = __shfl_xor(a[j], 32);
                            a[j] = (fq & 2) ? (a[j] * c4[j] + pr * s4[j]) : (a[j] * c4[j] - pr * s4[j]);
                        }
                    }
                    if (col0 >= C_G) {
#pragma unroll
                        for (int j = 0; j < 4; ++j) a[j] = sigm(a[j]);
                    }
                    *(uint2*)(ZA + (size_t)row * ZW + col0 + 4 * fq) = pk4(a);
                }
            }
        }
    }
};
template <bool SWAP>
struct EpiMemKV {
    bf16_t *MK, *MVT;
    DEV void run(f32x4 (&acc)[8][4], int R0, int C0, int fr, int fq) const {
#pragma unroll
        for (int n = 0; n < 4; ++n)
#pragma unroll
            for (int m = 0; m < 8; ++m) {
                if (SWAP) {
                    const int c = C0 + n * 16 + 4 * fq, r = R0 + m * 16 + fr;
                    const int h = (c >> 6) & 3, d = c & 63, b = r >> 8, mm = r & 255;
                    *(uint2*)(MK + ((size_t)(b * 4 + h) * 256 + mm) * 64 + d) = pk4(acc[m][n]);
                } else {
                    const int c = C0 + n * 16 + fr, r = R0 + m * 16 + 4 * fq;
                    const int h = (c >> 6) & 3, d = c & 63, b = r >> 8, mm = r & 255;
                    *(uint2*)(MVT + ((size_t)(b * 4 + h) * 64 + d) * 256 + mm) = pk4(acc[m][n]);
                }
            }
    }
};
struct EpiHid {
    bf16_t* H;
    DEV void run(f32x4 (&acc)[4][4], int R0, int C0, int fr, int fq) const {
#pragma unroll
        for (int n = 0; n < 4; ++n)
#pragma unroll
            for (int m = 0; m < 4; ++m) {
                const int c = C0 + n * 16 + 4 * fq, r = R0 + m * 16 + fr;
                f32x4 a = acc[m][n];
#pragma unroll
                for (int j = 0; j < 4; ++j) a[j] = gelu_t(a[j]);
                if (r < NCROWS) *(uint2*)(H + (size_t)r * 256 + c) = pk4(a);
            }
    }
};
template <int ACT>
struct EpiBf {
    bf16_t* O; int ldo;
    DEV void run(f32x4 (&acc)[8][4], int R0, int C0, int fr, int fq) const {
#pragma unroll
        for (int n = 0; n < 4; ++n)
#pragma unroll
            for (int m = 0; m < 8; ++m) {
                const int c = C0 + n * 16 + 4 * fq, r = R0 + m * 16 + fr;
                f32x4 a = acc[m][n];
                if (ACT == 1) {
#pragma unroll
                    for (int j = 0; j < 4; ++j) { const float v = fmaxf(a[j], 0.f); a[j] = v * v; }
                }
                *(uint2*)(O + (size_t)r * ldo + c) = pk4(a);
            }
    }
};
struct EpiRes {
    const float* R; float* O;
    DEV void run(f32x4 (&acc)[8][4], int R0, int C0, int fr, int fq) const {
#pragma unroll
        for (int n = 0; n < 4; ++n)
#pragma unroll
            for (int m = 0; m < 8; ++m) {
                const size_t o = (size_t)(R0 + m * 16 + fr) * 1024 + C0 + n * 16 + 4 * fq;
                const f32x4 r = *(const f32x4*)(R + o);
                *(f32x4*)(O + o) = r + acc[m][n];
            }
    }
};
struct EpiMerge {
    const bf16_t *ZA, *YX; bf16_t* Y;
    DEV void run(f32x4 (&acc)[8][3], int R0, int C0, int fr, int fq) const {
        const int ch = (C0 / 48) * 16 + 4 * fq;
#pragma unroll
        for (int m = 0; m < 8; ++m) {
            const size_t row = (size_t)(R0 + m * 16 + fr);
            const uint2 a = *(const uint2*)(ZA + row * ZW + C_Q + ch), b = *(const uint2*)(ZA + row * ZW + C_GR + ch), c = *(const uint2*)(YX + row * 1024 + ch);
            f32x4 y;
            y[0] = sigm(acc[m][0][0]) * lo_f(a.x) + sigm(acc[m][1][0]) * lo_f(b.x) + sigm(acc[m][2][0]) * lo_f(c.x);
            y[1] = sigm(acc[m][0][1]) * hi_f(a.x) + sigm(acc[m][1][1]) * hi_f(b.x) + sigm(acc[m][2][1]) * hi_f(c.x);
            y[2] = sigm(acc[m][0][2]) * lo_f(a.y) + sigm(acc[m][1][2]) * lo_f(b.y) + sigm(acc[m][2][2]) * lo_f(c.y);
            y[3] = sigm(acc[m][0][3]) * hi_f(a.y) + sigm(acc[m][1][3]) * hi_f(b.y) + sigm(acc[m][2][3]) * hi_f(c.y);
            *(uint2*)(Y + row * 1024 + ch) = pk4(y);
        }
    }
};

DEV bool tile_map(int idx, int NT, int& pm, int& pn) {
    const int x = idx & 7, pl = (idx >> 3) & 7, pmid = (idx >> 6) & 7, st = idx >> 9;
    pm = pmid * 8 + x;
    pn = st * 8 + pl;
    return pn < NT;
}
DEV int tile_count(int NT) { return ((NT + 7) / 8) * 512; }

DEV void cmp2_job(const Params& P, int job) {
    char* aux = (char*)P.out;
    const int lane = threadIdx.x & 63, w = threadIdx.x >> 6;
    const int wj = job * 4 + w;
    const int which = wj >= NCROWS ? 1 : 0;
    const int r = wj - which * NCROWS;
    const int bg = r / NCMP, n = r - bg * NCMP;
    const bf16_t* hid = (const bf16_t*)(aux + (which ? O_HIDV : O_HIDK)) + (size_t)r * 256;
    const float* w2 = which ? P.wv2 : P.wk2;
    float acc = 0.f;
#pragma unroll 8
    for (int k = 0; k < 256; ++k) acc += bf2f(hid[k]) * w2[k * 64 + lane];
    if (!which) {
        const int pos = 16 * n + 31, i = lane & 7;
        const float cs = ((const float*)(aux + O_ROPEC))[pos * 8 + i], sn = ((const float*)(aux + O_ROPES))[pos * 8 + i];
        const float pr = __shfl_xor(acc, 8);
        float o = acc;
        if (lane < 16) o = (lane & 8) ? (acc * cs + pr * sn) : (acc * cs - pr * sn);
        bf16_t* KC = (bf16_t*)(aux + O_KC);
        KC[((size_t)bg * 128 + n) * 64 + lane] = f2bf(o);
        if (n == NCMP - 1) KC[((size_t)bg * 128 + 127) * 64 + lane] = 0;
    } else {
        bf16_t* VCT = (bf16_t*)(aux + O_VCT);
        VCT[((size_t)bg * 64 + lane) * 128 + n] = f2bf(acc);
        if (n == NCMP - 1) VCT[((size_t)bg * 64 + lane) * 128 + 127] = 0;
    }
}

DEV void rnn_job(const Params& P, int job, char* smem, bool dry) {
    char* aux = (char*)P.out;
    bf16_t* ZA = (bf16_t*)(P.ws + W_ZA);
    const int b = job >> 4, n = job & 15;
    bf16_t* sX = (bf16_t*)smem;
    float* sXf = (float*)(smem + 9216);
    float* sCw = (float*)(smem + 9216 + 16640);
    float* sSum = (float*)(smem + 9216 + 16640 + 1280);
    bf16_t* sRaw = (bf16_t*)(smem + 9216 + 16640 + 1280 + 2048);
    const int tid = opaque_tid(), w = tid >> 6, lane = tid & 63, fr = lane & 15, fq = lane >> 4;
    const bf16_t* WAT = (const bf16_t*)(aux + O_WAT) + n * 4096;
    const bf16_t* WIT = (const bf16_t*)(aux + O_WIT) + n * 4096;
    bf16x8 wa[4][2], wi[4][2];
    float ba[4], bi[4], cl[4], carry[4];
#pragma unroll
    for (int ct = 0; ct < 4; ++ct) {
#pragma unroll
        for (int ks = 0; ks < 2; ++ks) {
            wa[ct][ks] = *(const bf16x8*)(WAT + (16 * ct + fr) * 64 + 32 * ks + 8 * fq);
            wi[ct][ks] = *(const bf16x8*)(WIT + (16 * ct + fr) * 64 + 32 * ks + 8 * fq);
        }
        const int c = n * 64 + 16 * ct + fr;
        ba[ct] = P.b_a[c]; bi[ct] = P.b_i[c];
        cl[ct] = -8.0f * log1pf(__expf(-P.lam[c]));
        carry[ct] = 0.f;
    }
    __syncthreads();
    for (int i = tid; i < 320; i += 256) sCw[i] = (i < 256) ? P.conv_w[(i >> 6) * 1024 + n * 64 + (i & 63)] : P.conv_b[n * 64 + (i & 63)];
    const int lt = tid >> 2, cg = (tid & 3) * 16;
    const bf16_t* xbase = ZA + (size_t)(b * S) * ZW + C_XR + n * 64 + cg;
    u32x4 xm0, xm1, xh0 = {0u, 0u, 0u, 0u}, xh1 = {0u, 0u, 0u, 0u};
    { const u32x4* xp = (const u32x4*)(xbase + (size_t)lt * ZW); xm0 = xp[0]; xm1 = xp[1]; }
#pragma unroll 1
    for (int chunk = 0; chunk < 32; ++chunk) {
        const int tc = chunk * 64;
        __syncthreads();
        *(u32x4*)(sRaw + (lt + 3) * 72 + cg) = xm0; *(u32x4*)(sRaw + (lt + 3) * 72 + cg + 8) = xm1;
        if (tid < 12) { *(u32x4*)(sRaw + lt * 72 + cg) = xh0; *(u32x4*)(sRaw + lt * 72 + cg + 8) = xh1; }
        __syncthreads();
        if (chunk + 1 < 32) {
            const u32x4* xp = (const u32x4*)(xbase + (size_t)(tc + 64 + lt) * ZW); xm0 = xp[0]; xm1 = xp[1];
            if (tid < 12) { const u32x4* hp = (const u32x4*)(xbase + (size_t)(tc + 61 + lt) * ZW); xh0 = hp[0]; xh1 = hp[1]; }
        }
        bf16_t gv[4][4];
#pragma unroll
        for (int ct = 0; ct < 4; ++ct)
#pragma unroll
            for (int j = 0; j < 4; ++j) gv[ct][j] = ZA[(size_t)(b * S + tc + 16 * w + 4 * fq + j) * ZW + C_GR + n * 64 + 16 * ct + fr];
        __builtin_amdgcn_sched_barrier(0);
        {
            float xv[16];
#pragma unroll
            for (int e = 0; e < 16; ++e) xv[e] = sCw[256 + cg + e];
#pragma unroll
            for (int k = 0; k < 4; ++k) {
                const u32x4 v0 = *(const u32x4*)(sRaw + (lt + k) * 72 + cg), v1 = *(const u32x4*)(sRaw + (lt + k) * 72 + cg + 8);
                const unsigned u[8] = {v0.x, v0.y, v0.z, v0.w, v1.x, v1.y, v1.z, v1.w};
#pragma unroll
                for (int e = 0; e < 8; ++e) {
                    xv[2 * e] += sCw[k * 64 + cg + 2 * e] * lo_f(u[e]);
                    xv[2 * e + 1] += sCw[k * 64 + cg + 2 * e + 1] * hi_f(u[e]);
                }
            }
#pragma unroll
            for (int e = 0; e < 16; ++e) sXf[lt * 65 + cg + e] = xv[e];
            u32x4 o0 = {pk2(xv[0], xv[1]), pk2(xv[2], xv[3]), pk2(xv[4], xv[5]), pk2(xv[6], xv[7])};
            u32x4 o1 = {pk2(xv[8], xv[9]), pk2(xv[10], xv[11]), pk2(xv[12], xv[13]), pk2(xv[14], xv[15])};
            *(u32x4*)(sX + lt * 72 + cg) = o0;
            *(u32x4*)(sX + lt * 72 + cg + 8) = o1;
        }
        __syncthreads();
        bf16x8 af[2];
#pragma unroll
        for (int ks = 0; ks < 2; ++ks) af[ks] = *(const bf16x8*)(sX + (16 * w + fr) * 72 + 32 * ks + 8 * fq);
        float hl[4][4], pc[4][4], Ae[4], He[4];
#pragma unroll
        for (int ct = 0; ct < 4; ++ct) {
            f32x4 R = (f32x4){0.f, 0.f, 0.f, 0.f}, I = (f32x4){0.f, 0.f, 0.f, 0.f};
#pragma unroll
            for (int ks = 0; ks < 2; ++ks) { R = MFMA16(af[ks], wa[ct][ks], R); I = MFMA16(af[ks], wi[ct][ks], I); }
            float h = 0.f, pcum = 1.f;
#pragma unroll
            for (int j = 0; j < 4; ++j) {
                const float xcv = sXf[(16 * w + 4 * fq + j) * 65 + 16 * ct + fr];
                const float rg = sigm(R[j] + ba[ct]), gi = sigm(I[j] + bi[ct]);
                const float la = rg * cl[ct];
                const float a_ = __expf(la);
                const float mult = sqrtf(fmaxf(-expm1f(2.f * la), 0.f));
                const float u = mult * gi * xcv;
                h = a_ * h + u; pcum *= a_;
                hl[ct][j] = h; pc[ct][j] = pcum;
            }
            float A = pcum, H = h;
            float A1 = __shfl_up(A, 16), H1 = __shfl_up(H, 16);
            if (fq >= 1) { H = A * H1 + H; A = A * A1; }
            float A2 = __shfl_up(A, 32), H2 = __shfl_up(H, 32);
            if (fq >= 2) { H = A * H2 + H; A = A * A2; }
            float Ax = __shfl_up(A, 16), Hx = __shfl_up(H, 16);
            Ae[ct] = fq == 0 ? 1.f : Ax; He[ct] = fq == 0 ? 0.f : Hx;
            if (fq == 3) { sSum[w * 64 + 16 * ct + fr] = A; sSum[256 + w * 64 + 16 * ct + fr] = H; }
        }
        __syncthreads();
#pragma unroll
        for (int ct = 0; ct < 4; ++ct) {
            float cin = carry[ct], mycin = 0.f;
#pragma unroll
            for (int ww = 0; ww < 4; ++ww) {
                if (ww == w) mycin = cin;
                cin = sSum[ww * 64 + 16 * ct + fr] * cin + sSum[256 + ww * 64 + 16 * ct + fr];
            }
            carry[ct] = cin;
            const float sq = Ae[ct] * mycin + He[ct];
#pragma unroll
            for (int j = 0; j < 4; ++j) {
                const float hfin = hl[ct][j] + pc[ct][j] * sq;
                const size_t grow = (size_t)(b * S + tc + 16 * w + 4 * fq + j);
                bf16_t* op = dry ? ((bf16_t*)(P.ws + W_YX) + grow * 1024 + n * 64 + 16 * ct + fr) : (ZA + grow * ZW + C_GR + n * 64 + 16 * ct + fr);
                *op = f2bf(gelu_t(bf2f(gv[ct][j])) * hfin);
            }
        }
    }
}

constexpr float EXPC = 0.125f * 1.4426950408889634f;
struct AttnAcc { f32x4 o[4][2]; float m[2], l[2]; };
DEV void attn_init(AttnAcc& a) {
#pragma unroll
    for (int d = 0; d < 4; ++d)
#pragma unroll
        for (int q = 0; q < 2; ++q) a.o[d][q] = (f32x4){0.f, 0.f, 0.f, 0.f};
    a.m[0] = a.m[1] = -INFINITY; a.l[0] = a.l[1] = 0.f;
}
DEV bf16x8 mk8(unsigned a, unsigned b, unsigned c, unsigned d) { u32x4 u = {a, b, c, d}; return __builtin_bit_cast(bf16x8, u); }

template <class MF>
DEV void attn_step(const bf16_t* sK, const bf16_t* sVt, int vstride, const bf16x8 (&qf)[2][2], AttnAcc& st, const MF& mf, int fr, int fq) {
    f32x4 s[4][2];
#pragma unroll
    for (int kt = 0; kt < 4; ++kt) {
        s[kt][0] = (f32x4){0.f, 0.f, 0.f, 0.f}; s[kt][1] = (f32x4){0.f, 0.f, 0.f, 0.f};
#pragma unroll
        for (int ks = 0; ks < 2; ++ks) {
            const bf16x8 kf = *(const bf16x8*)(sK + (16 * kt + fr) * 72 + 32 * ks + 8 * fq);
            s[kt][0] = MFMA16(kf, qf[0][ks], s[kt][0]);
            s[kt][1] = MFMA16(kf, qf[1][ks], s[kt][1]);
        }
    }
#pragma unroll
    for (int qt = 0; qt < 2; ++qt) {
        float mx = -INFINITY;
#pragma unroll
        for (int kt = 0; kt < 4; ++kt)
#pragma unroll
            for (int j = 0; j < 4; ++j) {
                const float v = mf(qt, 16 * kt + 4 * fq + j) ? s[kt][qt][j] : -INFINITY;
                s[kt][qt][j] = v; mx = fmaxf(mx, v);
            }
        mx = fmaxf(mx, __shfl_xor(mx, 16)); mx = fmaxf(mx, __shfl_xor(mx, 32));
        const float mn = fmaxf(st.m[qt], mx);
        float alpha = 1.f, msub = 0.f;
        if (mn != -INFINITY) { alpha = __builtin_amdgcn_exp2f((st.m[qt] - mn) * EXPC); msub = mn; }
        st.m[qt] = mn;
        float ps = 0.f;
#pragma unroll
        for (int kt = 0; kt < 4; ++kt)
#pragma unroll
            for (int j = 0; j < 4; ++j) { const float p = __builtin_amdgcn_exp2f((s[kt][qt][j] - msub) * EXPC); s[kt][qt][j] = p; ps += p; }
        st.l[qt] = st.l[qt] * alpha + ps;
#pragma unroll
        for (int dt = 0; dt < 4; ++dt) st.o[dt][qt] *= alpha;
    }
#pragma unroll
    for (int ks = 0; ks < 2; ++ks) {
        bf16x8 pf[2];
#pragma unroll
        for (int qt = 0; qt < 2; ++qt)
            pf[qt] = mk8(pk2(s[2 * ks][qt][0], s[2 * ks][qt][1]), pk2(s[2 * ks][qt][2], s[2 * ks][qt][3]),
                         pk2(s[2 * ks + 1][qt][0], s[2 * ks + 1][qt][1]), pk2(s[2 * ks + 1][qt][2], s[2 * ks + 1][qt][3]));
#pragma unroll
        for (int dt = 0; dt < 4; ++dt) {
            const u32x2 v0 = *(const u32x2*)(sVt + (16 * dt + fr) * vstride + 32 * ks + 4 * fq);
            const u32x2 v1 = *(const u32x2*)(sVt + (16 * dt + fr) * vstride + 32 * ks + 16 + 4 * fq);
            const bf16x8 vf = mk8(v0.x, v0.y, v1.x, v1.y);
            st.o[dt][0] = MFMA16(vf, pf[0], st.o[dt][0]);
            st.o[dt][1] = MFMA16(vf, pf[1], st.o[dt][1]);
        }
    }
}
DEV void attn_step_fast(const bf16_t* sK, const bf16_t* sVt, const bf16x8 (&qf)[2][2], AttnAcc& st, const float (&bitoff)[2], int fr, int fq) {
    f32x4 s[4][2];
#pragma unroll
    for (int kt = 0; kt < 4; ++kt) {
        s[kt][0] = (f32x4){0.f, 0.f, 0.f, 0.f}; s[kt][1] = (f32x4){0.f, 0.f, 0.f, 0.f};
#pragma unroll
        for (int ks = 0; ks < 2; ++ks) {
            const bf16x8 kf = *(const bf16x8*)(sK + (16 * kt + fr) * 72 + 32 * ks + 8 * fq);
            s[kt][0] = MFMA16(kf, qf[0][ks], s[kt][0]);
            s[kt][1] = MFMA16(kf, qf[1][ks], s[kt][1]);
        }
    }
#pragma unroll
    for (int qt = 0; qt < 2; ++qt) {
        float mx = fmaxf(fmaxf(s[0][qt][0], s[0][qt][1]), fmaxf(s[0][qt][2], s[0][qt][3]));
#pragma unroll
        for (int kt = 1; kt < 4; ++kt) mx = fmaxf(mx, fmaxf(fmaxf(s[kt][qt][0], s[kt][qt][1]), fmaxf(s[kt][qt][2], s[kt][qt][3])));
        mx = fmaxf(mx, __shfl_xor(mx, 16)); mx = fmaxf(mx, __shfl_xor(mx, 32));
        const float mn = fmaxf(st.m[qt], mx);
        const float alpha = __builtin_amdgcn_exp2f((st.m[qt] - mn) * EXPC);
        st.m[qt] = mn;
        const float off = bitoff[qt] - mn * EXPC;
        float ps = 0.f;
#pragma unroll
        for (int kt = 0; kt < 4; ++kt)
#pragma unroll
            for (int j = 0; j < 4; ++j) { const float p = __builtin_amdgcn_exp2f(fmaf(s[kt][qt][j], EXPC, off)); s[kt][qt][j] = p; ps += p; }
        st.l[qt] = st.l[qt] * alpha + ps;
#pragma unroll
        for (int dt = 0; dt < 4; ++dt) st.o[dt][qt] *= alpha;
    }
#pragma unroll
    for (int ks = 0; ks < 2; ++ks) {
        bf16x8 pf[2];
#pragma unroll
        for (int qt = 0; qt < 2; ++qt)
            pf[qt] = mk8(pk2(s[2 * ks][qt][0], s[2 * ks][qt][1]), pk2(s[2 * ks][qt][2], s[2 * ks][qt][3]),
                         pk2(s[2 * ks + 1][qt][0], s[2 * ks + 1][qt][1]), pk2(s[2 * ks + 1][qt][2], s[2 * ks + 1][qt][3]));
#pragma unroll
        for (int dt = 0; dt < 4; ++dt) {
            const u32x2 v0 = *(const u32x2*)(sVt + (16 * dt + fr) * 72 + 32 * ks + 4 * fq);
            const u32x2 v1 = *(const u32x2*)(sVt + (16 * dt + fr) * 72 + 32 * ks + 16 + 4 * fq);
            const bf16x8 vf = mk8(v0.x, v0.y, v1.x, v1.y);
            st.o[dt][0] = MFMA16(vf, pf[0], st.o[dt][0]);
            st.o[dt][1] = MFMA16(vf, pf[1], st.o[dt][1]);
        }
    }
}
DEV void attn_fold_out(bf16_t* const (&op)[2], const AttnAcc& st, const float (&gate)[2]) {
#pragma unroll
    for (int qt = 0; qt < 2; ++qt) {
        float l = st.l[qt];
        l += __shfl_xor(l, 16); l += __shfl_xor(l, 32);
        const float sc = gate[qt] * __builtin_amdgcn_rcpf(fmaxf(l, 1e-30f));
#pragma unroll
        for (int dt = 0; dt < 4; ++dt) {
            const uint2 pv = *(const uint2*)(op[qt] + 16 * dt);
            f32x4 r = st.o[dt][qt] * sc;
            r[0] += lo_f(pv.x); r[1] += hi_f(pv.x); r[2] += lo_f(pv.y); r[3] += hi_f(pv.y);
            *(uint2*)(op[qt] + 16 * dt) = make_uint2(pk2(r[0], r[1]), pk2(r[2], r[3]));
        }
    }
}
DEV void attn_fold(f32x4 (&tot)[4][2], const AttnAcc& st, const float (&gate)[2]) {
#pragma unroll
    for (int qt = 0; qt < 2; ++qt) {
        float l = st.l[qt];
        l += __shfl_xor(l, 16); l += __shfl_xor(l, 32);
        const float sc = gate[qt] * __builtin_amdgcn_rcpf(fmaxf(l, 1e-30f));
#pragma unroll
        for (int dt = 0; dt < 4; ++dt) tot[dt][qt] += st.o[dt][qt] * sc;
    }
}
DEV void ld64(u32x4 (&r)[2], const bf16_t* src, size_t sstride, int tid) {
#pragma unroll
    for (int i = 0; i < 2; ++i) { const int c = tid + 256 * i; r[i] = *(const u32x4*)(src + (size_t)(c >> 3) * sstride + (c & 7) * 8); }
}
DEV void st64(bf16_t* dst, const u32x4 (&r)[2], int tid) {
#pragma unroll
    for (int i = 0; i < 2; ++i) { const int c = tid + 256 * i; *(u32x4*)(dst + (c >> 3) * 72 + (c & 7) * 8) = r[i]; }
}

#define OUTP(QT) ((dry ? (bf16_t*)(P.ws + W_YX) + (size_t)(b * S + tq[QT]) * 1024 : ZA + (size_t)(b * S + tq[QT]) * ZW + C_Q) + head * 64 + 4 * fq)
#define LOAD_GATE(G2, BR) float G2[2]; { G2[0] = bf2f(ZA[(size_t)(b * S + tq[0]) * ZW + C_G + head * 3 + (BR)]); G2[1] = bf2f(ZA[(size_t)(b * S + tq[1]) * ZW + C_G + head * 3 + (BR)]); }
struct MaskAll { DEV bool operator()(int, int) const { return true; } };
struct MaskSel { unsigned bit[2]; int t[2]; int k0; DEV bool operator()(int qt, int kk) const { return bit[qt] && (k0 + kk <= t[qt]); } };
struct MaskWin { int t[2]; int k0; DEV bool operator()(int qt, int kk) const { const int k = k0 + kk; return k <= t[qt] && k > t[qt] - 512; } };

DEV void xattn_job(const Params& P, int job, char* smem, bool dry) {
    char* aux = (char*)P.out;
    bf16_t* ZA = (bf16_t*)(P.ws + W_ZA);
    const int qb = job & 15, h = (job >> 4) & 3, b = job >> 6;
    bf16_t* sK = (bf16_t*)smem;
    bf16_t* sVt = sK + 64 * 72;
    const int tid = opaque_tid(), w = tid >> 6, lane = tid & 63, fr = lane & 15, fq = lane >> 4;
    const int t0 = qb * 128 + w * 32;
    bf16x8 qf[2][2];
#pragma unroll
    for (int qt = 0; qt < 2; ++qt)
#pragma unroll
        for (int ks = 0; ks < 2; ++ks) qf[qt][ks] = *(const bf16x8*)(ZA + (size_t)(b * S + t0 + 16 * qt + fr) * ZW + C_QX + h * 64 + 32 * ks + 8 * fq);
    const bf16_t* MK = (const bf16_t*)(aux + O_MEMK) + (size_t)(b * 4 + h) * 256 * 64;
    const bf16_t* MVT = (const bf16_t*)(aux + O_MEMVT) + (size_t)(b * 4 + h) * 64 * 256;
    AttnAcc st; attn_init(st);
    u32x4 rk[2], rv[2];
    ld64(rk, MK, 64, tid); ld64(rv, MVT, 256, tid);
#pragma unroll 1
    for (int jb = 0; jb < 4; ++jb) {
        __syncthreads();
        st64(sK, rk, tid); st64(sVt, rv, tid);
        __syncthreads();
        if (jb + 1 < 4) { ld64(rk, MK + (size_t)(jb + 1) * 64 * 64, 64, tid); ld64(rv, MVT + (jb + 1) * 64, 256, tid); }
        __builtin_amdgcn_sched_barrier(0);
        { const float z2[2] = {0.f, 0.f}; attn_step_fast(sK, sVt, qf, st, z2, fr, fq); }
    }
    f32x4 tot[4][2];
#pragma unroll
    for (int dt = 0; dt < 4; ++dt) { tot[dt][0] = (f32x4){0.f, 0.f, 0.f, 0.f}; tot[dt][1] = (f32x4){0.f, 0.f, 0.f, 0.f}; }
    const float one[2] = {1.f, 1.f};
    attn_fold(tot, st, one);
#pragma unroll
    for (int qt = 0; qt < 2; ++qt)
#pragma unroll
        for (int dt = 0; dt < 4; ++dt)
            *(uint2*)((dry ? (bf16_t*)(P.ws + W_Y) + (size_t)(b * S + t0 + 16 * qt + fr) * 1024 : ZA + (size_t)(b * S + t0 + 16 * qt + fr) * ZW + C_QX) + h * 64 + 16 * dt + 4 * fq) =
                make_uint2(pk2(tot[dt][qt][0], tot[dt][qt][1]), pk2(tot[dt][qt][2], tot[dt][qt][3]));
}

DEV void nsa_job(const Params& P, int job, char* smem, bool dry) {
    char* aux = (char*)P.out;
    bf16_t* ZA = (bf16_t*)(P.ws + W_ZA);
    const int bg = job & 31, qb = 63 - (job >> 5), b = bg >> 2, g = bg & 3, t0 = qb * 32;
    bf16_t* sK = (bf16_t*)smem;
    bf16_t* sVt = (bf16_t*)(smem + 18432);
    float* sImp = (float*)(smem + 18432 + 17408);
    unsigned* sSel = (unsigned*)(smem + 18432 + 17408 + 16384);
    const int tid = opaque_tid(), w = tid >> 6, lane = tid & 63, fr = lane & 15, fq = lane >> 4;
    const int head = g * 4 + w;
    int tq[2];
    bf16x8 qf[2][2];
#pragma unroll
    for (int qt = 0; qt < 2; ++qt) {
        tq[qt] = t0 + 16 * qt + fr;
        const bf16_t* rowp = ZA + (size_t)(b * S + tq[qt]) * ZW;
#pragma unroll
        for (int ks = 0; ks < 2; ++ks) qf[qt][ks] = *(const bf16x8*)(rowp + C_Q + head * 64 + 32 * ks + 8 * fq);
    }
    f32x4 tot[4][2];
#pragma unroll
    for (int dt = 0; dt < 4; ++dt) { tot[dt][0] = (f32x4){0.f, 0.f, 0.f, 0.f}; tot[dt][1] = (f32x4){0.f, 0.f, 0.f, 0.f}; }

    {
        const bf16_t* KC = (const bf16_t*)(aux + O_KC) + (size_t)bg * 128 * 64;
        const bf16_t* VCT = (const bf16_t*)(aux + O_VCT) + (size_t)bg * 64 * 128;
        __syncthreads();
#pragma unroll
        for (int i = 0; i < 4; ++i) {
            const int c = tid + 256 * i;
            { const int r = c >> 3, k = (c & 7) * 8; *(u32x4*)(sK + r * 72 + k) = *(const u32x4*)(KC + r * 64 + k); }
            { const int r = c >> 4, k = (c & 15) * 8; *(u32x4*)(sVt + r * 136 + k) = *(const u32x4*)(VCT + r * 128 + k); }
        }
        __syncthreads();
#pragma unroll
        for (int qt = 0; qt < 2; ++qt) {
            const float g0 = bf2f(ZA[(size_t)(b * S + tq[qt]) * ZW + C_G + head * 3 + 0]);
            f32x4 s[8];
#pragma unroll
            for (int kt = 0; kt < 8; ++kt) {
                s[kt] = (f32x4){0.f, 0.f, 0.f, 0.f};
#pragma unroll
                for (int ks = 0; ks < 2; ++ks) {
                    const bf16x8 kf = *(const bf16x8*)(sK + (16 * kt + fr) * 72 + 32 * ks + 8 * fq);
                    s[kt] = MFMA16(kf, qf[qt][ks], s[kt]);
                }
            }
            float mx = -INFINITY;
#pragma unroll
            for (int kt = 0; kt < 8; ++kt)
#pragma unroll
                for (int j = 0; j < 4; ++j) {
                    const int n = 16 * kt + 4 * fq + j;
                    const float v = (n < NCMP && 16 * n + 31 <= tq[qt]) ? s[kt][j] : -INFINITY;
                    s[kt][j] = v; mx = fmaxf(mx, v);
                }
            mx = fmaxf(mx, __shfl_xor(mx, 16)); mx = fmaxf(mx, __shfl_xor(mx, 32));
            const float msub = (mx == -INFINITY) ? 0.f : mx;
            float ps = 0.f;
#pragma unroll
            for (int kt = 0; kt < 8; ++kt)
#pragma unroll
                for (int j = 0; j < 4; ++j) { const float p = __builtin_amdgcn_exp2f((s[kt][j] - msub) * EXPC); s[kt][j] = p; ps += p; }
            ps += __shfl_xor(ps, 16); ps += __shfl_xor(ps, 32);
            const float inv = __builtin_amdgcn_rcpf(fmaxf(ps, 1e-30f));
            float bprev = 0.f;
#pragma unroll
            for (int kt = 0; kt < 8; ++kt) {
                s[kt] *= inv;
                const float a = s[kt][0] + s[kt][1] + s[kt][2] + 0.5f * s[kt][3];
                const float bq = 0.5f * s[kt][3];
                const float x = __shfl(bq, (lane + 48) & 63);
                const float y = __shfl(bprev, (lane + 48) & 63);
                sImp[(w * 32 + 16 * qt + fr) * 32 + 4 * kt + fq] = a + (fq > 0 ? x : y);
                bprev = bq;
            }
#pragma unroll
            for (int ks = 0; ks < 4; ++ks) {
                const f32x4 pa = s[2 * ks] * g0, pb = s[2 * ks + 1] * g0;
                const bf16x8 pf = mk8(pk2(pa[0], pa[1]), pk2(pa[2], pa[3]), pk2(pb[0], pb[1]), pk2(pb[2], pb[3]));
#pragma unroll
                for (int dt = 0; dt < 4; ++dt) {
                    const u32x2 v0 = *(const u32x2*)(sVt + (16 * dt + fr) * 136 + 32 * ks + 4 * fq);
                    const u32x2 v1 = *(const u32x2*)(sVt + (16 * dt + fr) * 136 + 32 * ks + 16 + 4 * fq);
                    tot[dt][qt] = MFMA16(mk8(v0.x, v0.y, v1.x, v1.y), pf, tot[dt][qt]);
                }
            }
            __builtin_amdgcn_sched_barrier(0);
        }
    }
#pragma unroll
    for (int qt = 0; qt < 2; ++qt) {
        bf16_t* op = (dry ? (bf16_t*)(P.ws + W_YX) + (size_t)(b * S + tq[qt]) * 1024 : ZA + (size_t)(b * S + tq[qt]) * ZW + C_Q) + head * 64 + 4 * fq;
#pragma unroll
        for (int dt = 0; dt < 4; ++dt) *(uint2*)(op + 16 * dt) = pk4(tot[dt][qt]);
    }
    __syncthreads();
    if (tid < 32) {
        const int t = t0 + tid, cur = t >> 6;
        for (int m = 0; m < 32; ++m) {
            const float v = ((sImp[(0 * 32 + tid) * 32 + m] + sImp[(1 * 32 + tid) * 32 + m]) + sImp[(2 * 32 + tid) * 32 + m]) + sImp[(3 * 32 + tid) * 32 + m];
            sImp[tid * 32 + m] = v;
        }
        unsigned sel = 0;
        for (int round = 0; round < 8; ++round) {
            float bv = -INFINITY; int bi = -1;
            for (int m = 0; m < 32; ++m) {
                if ((sel >> m) & 1u) continue;
                const bool forced = (m == 0) || (m == cur) || (m == cur - 1);
                const bool future = m * 64 > t;
                const float v = forced ? INFINITY : (future ? -INFINITY : sImp[tid * 32 + m]);
                if (v > bv) { bv = v; bi = m; }
            }
            if (bi < 0) break;
            sel |= 1u << bi;
        }
        sSel[tid] = sel;
        unsigned un = sel;
#pragma unroll
        for (int o = 16; o >= 1; o >>= 1) un |= __shfl_xor(un, o);
        if (tid == 0) sSel[32] = un;
    }
    __syncthreads();
    const unsigned uni = sSel[32];
    const int jmax = (t0 + 31) >> 6;
    {
        AttnAcc st; attn_init(st);
        const bf16_t* Kb = ZA + (size_t)(b * S) * ZW + C_KS + g * 64;
        const bf16_t* Vb = (const bf16_t*)(P.ws + W_VST) + (size_t)bg * 64 * S;
        unsigned rem = uni & ((2u << jmax) - 1u);
        u32x4 rk[2], rv[2];
        if (rem) { const int j0 = __builtin_ctz(rem); ld64(rk, Kb + (size_t)(j0 * 64) * ZW, ZW, tid); ld64(rv, Vb + j0 * 64, S, tid); }
#pragma unroll 1
        while (rem) {
            const int jb = __builtin_ctz(rem);
            rem &= rem - 1u;
            __syncthreads();
            st64(sK, rk, tid); st64(sVt, rv, tid);
            __syncthreads();
            if (rem) { const int jn = __builtin_ctz(rem); ld64(rk, Kb + (size_t)(jn * 64) * ZW, ZW, tid); ld64(rv, Vb + jn * 64, S, tid); }
            __builtin_amdgcn_sched_barrier(0);
            if (jb * 64 + 63 <= t0) {
                const float bo[2] = {((sSel[fr] >> jb) & 1u) ? 0.f : -INFINITY, ((sSel[16 + fr] >> jb) & 1u) ? 0.f : -INFINITY};
                attn_step_fast(sK, sVt, qf, st, bo, fr, fq);
            } else {
                MaskSel mf; mf.bit[0] = (sSel[fr] >> jb) & 1u; mf.bit[1] = (sSel[16 + fr] >> jb) & 1u; mf.t[0] = tq[0]; mf.t[1] = tq[1]; mf.k0 = jb * 64;
                attn_step(sK, sVt, 72, qf, st, mf, fr, fq);
            }
        }
        { LOAD_GATE(g1, 1) bf16_t* const op2[2] = {OUTP(0), OUTP(1)}; attn_fold_out(op2, st, g1); }
    }
    {
        AttnAcc st; attn_init(st);
        const bf16_t* Kb = ZA + (size_t)(b * S) * ZW + C_KW + g * 64;
        const bf16_t* Vb = (const bf16_t*)(P.ws + W_VWT) + (size_t)bg * 64 * S;
#pragma unroll
        for (int qt = 0; qt < 2; ++qt) {
            const int npad = 511 - tq[qt];
            if (npad > 0) { st.m[qt] = 0.f; st.l[qt] = (fq == 0) ? (float)npad : 0.f; }
        }
        int jlo = t0 - 511; jlo = jlo < 0 ? 0 : (jlo >> 6);
        u32x4 rk[2], rv[2];
        ld64(rk, Kb + (size_t)(jlo * 64) * ZW, ZW, tid); ld64(rv, Vb + jlo * 64, S, tid);
#pragma unroll 1
        for (int jb = jlo; jb <= jmax; ++jb) {
            __syncthreads();
            st64(sK, rk, tid); st64(sVt, rv, tid);
            __syncthreads();
            if (jb < jmax) { ld64(rk, Kb + (size_t)((jb + 1) * 64) * ZW, ZW, tid); ld64(rv, Vb + (jb + 1) * 64, S, tid); }
            __builtin_amdgcn_sched_barrier(0);
            if (jb * 64 + 63 <= t0 && jb * 64 > t0 + 31 - 512) {
                const float z2[2] = {0.f, 0.f};
                attn_step_fast(sK, sVt, qf, st, z2, fr, fq);
            } else {
                MaskWin mf; mf.t[0] = tq[0]; mf.t[1] = tq[1]; mf.k0 = jb * 64;
                attn_step(sK, sVt, 72, qf, st, mf, fr, fq);
            }
        }
        { LOAD_GATE(g2, 2) bf16_t* const op2[2] = {OUTP(0), OUTP(1)}; attn_fold_out(op2, st, g2); }
    }
}


#define XB_TMO      128
#define XB_XCNT(j)  (256  + 64 * (j))
#define XB_XSUB(j)  (1280 + 64 * (j))
#define XB_XGEN(j)  (2304 + 64 * (j))
#define XB_TOP      3328
#define XB_TOPGEN   3392
#define XCD_BAR_WORDS 3456
#define XB_SPIN_CAP (1u << 18)
#define LAS __attribute__((address_space(3)))
DEV unsigned xb_ld(unsigned* p) { return __hip_atomic_load(p, __ATOMIC_RELAXED, __HIP_MEMORY_SCOPE_AGENT); }
DEV unsigned xb_add(unsigned* p, unsigned v) { return __hip_atomic_fetch_add(p, v, __ATOMIC_RELAXED, __HIP_MEMORY_SCOPE_AGENT); }
DEV unsigned xb_xcc_id() { return (unsigned)__builtin_amdgcn_s_getreg((3 << 11) | 20) & 0xFu; }
#define XB_SPIN(cond, bar) do { unsigned _sp = 0; while (cond) { __builtin_amdgcn_s_sleep(1); \
    if ((++_sp & 255u) == 0u) { if (xb_ld(&(bar)[XB_TMO])) break; if (_sp > XB_SPIN_CAP) { atomicAdd(&(bar)[XB_TMO], 1u); break; } } } } while (0)
struct XcdBarrier { unsigned* bar; unsigned x; volatile LAS unsigned* st; };
DEV XcdBarrier xcd_barrier_post(unsigned* bar, volatile LAS unsigned* st) {
    XcdBarrier b; b.bar = bar; b.x = xb_xcc_id(); b.st = st;
    if (threadIdx.x == 0) (void)xb_add(&bar[XB_XCNT(b.x)], 1u);
    return b;
}
DEV void xcd_barrier_complete(unsigned* bar, unsigned x, unsigned& nloc, unsigned& nx) {
    const unsigned G = gridDim.x * gridDim.y * gridDim.z;
    unsigned sum, cnt, mine, sp = 0u;
    for (;;) {
        sum = 0u; cnt = 0u; mine = 0u;
#pragma unroll
        for (unsigned j = 0; j < 16; ++j) { const unsigned c = xb_ld(&bar[XB_XCNT(j)]); sum += c; cnt += (c > 0u) ? 1u : 0u; mine = (j == x) ? c : mine; }
        if (sum == G) break;
        __builtin_amdgcn_s_sleep(1);
        if ((++sp & 255u) == 0u) { if (xb_ld(&bar[XB_TMO])) break; if (sp > XB_SPIN_CAP) { atomicAdd(&bar[XB_TMO], 1u); break; } }
    }
    nloc = mine > 0u ? mine : 1u; nx = cnt > 0u ? cnt : 1u;
}
DEV void xcd_barrier(const XcdBarrier& b) {
    asm volatile("s_waitcnt vmcnt(0)" ::: "memory");
    __syncthreads();
    if (threadIdx.x == 0) {
        unsigned* bar = b.bar;
        __builtin_amdgcn_s_waitcnt(0);
        unsigned nloc = b.st[0], nx = b.st[1];
        if (nloc == 0u) { xcd_barrier_complete(bar, b.x, nloc, nx); b.st[0] = nloc; b.st[1] = nx; }
        const unsigned old = xb_add(&bar[XB_XSUB(b.x)], 1u);
        const unsigned gen = old / nloc;
        if (old + 1u == (gen + 1u) * nloc) {
            __builtin_amdgcn_fence(__ATOMIC_RELEASE, "agent");
            asm volatile("s_waitcnt vmcnt(0)" ::: "memory");
            const unsigned og = xb_add(&bar[XB_TOP], 1u);
            const unsigned tg = og / nx;
            if (og + 1u == (tg + 1u) * nx) xb_add(&bar[XB_TOPGEN], 1u);
            else XB_SPIN(xb_ld(&bar[XB_TOPGEN]) == tg, bar);
            __builtin_amdgcn_fence(__ATOMIC_ACQUIRE, "agent");
            xb_add(&bar[XB_XGEN(b.x)], 1u);
            asm volatile("s_waitcnt vmcnt(0)" ::: "memory");
        } else {
            XB_SPIN(xb_ld(&bar[XB_XGEN(b.x)]) == gen, bar);
            __builtin_amdgcn_fence(__ATOMIC_ACQUIRE, "agent");
            asm volatile("s_waitcnt vmcnt(0)" ::: "memory");
        }
    }
    __syncthreads();
}
constexpr size_t W_BAR = 252 * MiB;

constexpr int NPHASE = 11;
constexpr int SMEM_BYTES = 55296;

template <int PH, bool DRY = false>
DEV void run_phase(const Params& P, char* smem) {
    const int nb = gridDim.x, bid = blockIdx.x;
    char* aux = (char*)P.out;
    char* ws = P.ws;
    bf16_t* ZA = (bf16_t*)(ws + W_ZA);
    if (PH == 0) {
        for (int job = bid; job < 4800 + 4096 + 512 + 64; job += nb) {
            int j = job;
            if (j < 4800) {
                bool done = false;
#define TR(SRC, LD, DSTOFF, KK, NN, MAP)                                                                                       \
    if (!done) { const int nrt = (NN) / 64, nt = nrt * ((KK) / 64);                                                              \
        if (j < nt) { transpose_tile((SRC), (LD), (bf16_t*)(aux + (DSTOFF)), (KK), (j % nrt) * 64, (j / nrt) * 64, (MAP), smem); done = true; } else j -= nt; }
                TR(P.w_in, 7984, O_WTA, 1024, 4992, 1)
                TR(P.w_in, 7984, O_WTB, 1024, 3072, 2)
                TR(P.w_up, 4096, O_WTUP, 1024, 4096, 0)
                TR(P.w_down, 1024, O_WTDN, 4096, 1024, 0)
                TR(P.w_o, 1024, O_WTO, 1024, 1024, 0)
                TR(P.w_xo, 1024, O_WTXO, 256, 1024, 0)
                TR(P.w_mkv, 512, O_WTMKV, 1024, 512, 0)
                TR(P.wk1, 256, O_WTCK1, 2048, 256, 0)
                TR(P.wv1, 256, O_WTCV1, 2048, 256, 0)
#undef TR
                if (!done) {
                    if (j < 16) transpose_tile(P.w_a + j * 4096, 64, (bf16_t*)(aux + O_WAT) + j * 4096, 64, 0, 0, 0, smem);
                    else { j -= 16; transpose_tile(P.w_i + j * 4096, 64, (bf16_t*)(aux + O_WIT) + j * 4096, 64, 0, 0, 0, smem); }
                }
                continue;
            }
            j -= 4800;
            if (j < 4096) { rownorm<false>(P.x, P.g_mix, (bf16_t*)(ws + W_U), nullptr, j * 4 + (threadIdx.x >> 6)); continue; }
            j -= 4096;
            if (j < 512) { rownorm<false>(P.mem, P.g_mem, (bf16_t*)(aux + O_MEMN), nullptr, j * 4 + (threadIdx.x >> 6)); continue; }
            j -= 512;
            rope_job((float*)(aux + O_ROPEC), (float*)(aux + O_ROPES), j);
        }
    } else if (PH == 1) {
        const int nA = tile_count(39);
        for (int job = bid; job < 32 + nA; job += nb) {
            if (job < 32) {
                ALPlain al; al.A = (const bf16_t*)(aux + O_MEMN); al.lda = 1024;
                const int pm = job & 7, pn = job >> 3;
                if (pn < 2) { EpiMemKV<true> ep{(bf16_t*)(aux + O_MEMK), (bf16_t*)(aux + O_MEMVT)}; gemm_tile<8, 4, true>(al, (const bf16_t*)(aux + O_WTMKV), 1024, 1024, pm, pn, ep, smem); }
                else { EpiMemKV<false> ep{(bf16_t*)(aux + O_MEMK), (bf16_t*)(aux + O_MEMVT)}; gemm_tile<8, 4, false>(al, (const bf16_t*)(aux + O_WTMKV), 1024, 1024, pm, pn, ep, smem); }
            } else {
                int pm, pn;
                if (!tile_map(job - 32, 39, pm, pn)) continue;
                ALPlain al; al.A = (const bf16_t*)(ws + W_U); al.lda = 1024;
                if (pn < 35) { EpiZA<true> ep{ZA, (bf16_t*)(ws + W_VST), (bf16_t*)(ws + W_VWT), (const float*)(aux + O_ROPEC), (const float*)(aux + O_ROPES)};
                    gemm_tile<8, 4, true>(al, (const bf16_t*)(aux + O_WTA), 1024, 1024, pm, pn, ep, smem); }
                else { EpiZA<false> ep{ZA, (bf16_t*)(ws + W_VST), (bf16_t*)(ws + W_VWT), (const float*)(aux + O_ROPEC), (const float*)(aux + O_ROPES)};
                    gemm_tile<8, 4, false>(al, (const bf16_t*)(aux + O_WTA), 1024, 1024, pm, pn, ep, smem); }
            }
        }
    } else if (PH == 2) {
        for (int job = bid; job < 1024; job += nb) {
            if (job < 128) rnn_job(P, job, smem, DRY);
            else if (job < 256) {
                const int j = job - 128, which = j >> 6, pm = (j & 63) >> 1, pn = j & 1;
                ALCmp al; al.ZA = ZA; al.pos = which ? P.cpv : P.cpk; al.colbase = which ? C_VC : C_KC;
                EpiHid ep{(bf16_t*)(aux + (which ? O_HIDV : O_HIDK))};
                gemm_tile<4, 4, true>(al, (const bf16_t*)(aux + (which ? O_WTCV1 : O_WTCK1)), 2048, 2048, pm, pn, ep, smem);
            } else if (job < 512) xattn_job(P, job - 256, smem, DRY);
            else if (job >= 768) xattn_job(P, job - 512, smem, DRY);
        }
    } else if (PH == 3) {
        for (int job = bid; job < 2032; job += nb) cmp2_job(P, job);
    } else if (PH == 4) {
        for (int job = bid; job < 2048 + 512; job += nb) {
            if (job < 2048) nsa_job(P, job, smem, DRY);
            else if (!DRY) {
                int pm, pn;
                if (!tile_map(job - 2048, 8, pm, pn)) continue;
                ALPlain al; al.A = ZA + C_QX; al.lda = ZW;
                EpiBf<0> ep{(bf16_t*)(ws + W_YX), 1024};
                gemm_tile<8, 4, true>(al, (const bf16_t*)(aux + O_WTXO), 256, 256, pm, pn, ep, smem);
            }
        }
    } else if (PH == 5) {
        for (int job = bid; job < tile_count(32); job += nb) {
            int pm, pn;
            if (!tile_map(job, 32, pm, pn)) continue;
            ALPlain al; al.A = (const bf16_t*)(ws + W_U); al.lda = 1024;
            EpiMerge ep{ZA, (const bf16_t*)(ws + W_YX), (bf16_t*)(ws + W_Y)};
            gemm_tile<8, 3, true>(al, (const bf16_t*)(aux + O_WTB), 1024, 1024, pm, pn, ep, smem);
        }
    } else if (PH == 6) {
        for (int job = bid; job < tile_count(8); job += nb) {
            int pm, pn;
            if (!tile_map(job, 8, pm, pn)) continue;
            ALPlain al; al.A = (const bf16_t*)(ws + W_Y); al.lda = 1024;
            EpiRes ep{P.x, (float*)(ws + W_H)};
            gemm_tile<8, 4, true>(al, (const bf16_t*)(aux + O_WTO), 1024, 1024, pm, pn, ep, smem);
        }
    } else if (PH == 7) {
        for (int job = bid; job < 4096; job += nb) rownorm<false>((const float*)(ws + W_H), P.g_mlp, (bf16_t*)(ws + W_VN), nullptr, job * 4 + (threadIdx.x >> 6));
    } else if (PH == 8) {
        for (int job = bid; job < tile_count(32); job += nb) {
            int pm, pn;
            if (!tile_map(job, 32, pm, pn)) continue;
            ALPlain al; al.A = (const bf16_t*)(ws + W_VN); al.lda = 1024;
            EpiBf<1> ep{(bf16_t*)(ws + W_HID), 4096};
            gemm_tile<8, 4, true>(al, (const bf16_t*)(aux + O_WTUP), 1024, 1024, pm, pn, ep, smem);
        }
    } else if (PH == 9) {
        for (int job = bid; job < tile_count(8); job += nb) {
            int pm, pn;
            if (!tile_map(job, 8, pm, pn)) continue;
            ALPlain al; al.A = (const bf16_t*)(ws + W_HID); al.lda = 4096;
            EpiRes ep{(const float*)(ws + W_H), (float*)(ws + W_H)};
            gemm_tile<8, 4, true>(al, (const bf16_t*)(aux + O_WTDN), 4096, 4096, pm, pn, ep, smem);
        }
    } else if (PH == 10) {
        for (int job = bid; job < 4096; job += nb) rownorm<true>((const float*)(ws + W_H), P.g_final, nullptr, P.out, job * 4 + (threadIdx.x >> 6));
    }
}

#if MULTI
template <int PH>
__global__ void __launch_bounds__(256, 2) phase_kernel(Params P) {
    __shared__ __attribute__((aligned(16))) char smem[SMEM_BYTES];
    run_phase<PH>(P, smem);
}
#else
__global__ void __launch_bounds__(256, 2) mega_kernel(Params P) {
    __shared__ __attribute__((aligned(16))) char smem[SMEM_BYTES];
    cg::grid_group grid = cg::this_grid();
    __shared__ uint4 xb_words;
    if (threadIdx.x == 0) xb_words = make_uint4(0u, 0u, 0u, 0u);
    __syncthreads();
    XcdBarrier xb = xcd_barrier_post((unsigned*)(P.ws + W_BAR), (volatile LAS unsigned*)&xb_words);
    if (P.ws == nullptr) grid.sync();
#ifndef REP
#define REP -1
#endif
#define GSYNC() xcd_barrier(xb)
#define PHASE(k) { if (REP == k && k != 9) { run_phase<k, true>(P, smem); GSYNC(); } run_phase<k>(P, smem); GSYNC(); }
    PHASE(0) PHASE(1) PHASE(2) PHASE(3) PHASE(4) PHASE(5) PHASE(6) PHASE(7) PHASE(8) PHASE(9)
    if (REP == 10) { run_phase<10>(P, smem); GSYNC(); }
    if (REP == 11) { GSYNC(); GSYNC(); GSYNC(); GSYNC(); GSYNC(); GSYNC(); GSYNC(); GSYNC(); GSYNC(); GSYNC(); }
    run_phase<10>(P, smem);
}
#endif

extern "C" void kernel_launch(void* const* d_in, const int* in_sizes, int n_in, void* d_out, int out_size, void* d_ws, size_t ws_size,
                              hipStream_t stream) {
    Params P{};
    const float** pp = (const float**)&P;
    for (int i = 0; i < 25; ++i) pp[i] = (const float*)d_in[i];
    P.out = (float*)d_out;
    P.ws = (char*)d_ws;
#if MULTI
    const int G = 1024;
    phase_kernel<0><<<G, 256, 0, stream>>>(P);
    phase_kernel<1><<<G, 256, 0, stream>>>(P);
    phase_kernel<2><<<G, 256, 0, stream>>>(P);
    phase_kernel<3><<<G, 256, 0, stream>>>(P);
    phase_kernel<4><<<G, 256, 0, stream>>>(P);
    phase_kernel<5><<<G, 256, 0, stream>>>(P);
    phase_kernel<6><<<G, 256, 0, stream>>>(P);
    phase_kernel<7><<<G, 256, 0, stream>>>(P);
    phase_kernel<8><<<G, 256, 0, stream>>>(P);
    phase_kernel<9><<<G, 256, 0, stream>>>(P);
    phase_kernel<10><<<G, 256, 0, stream>>>(P);
#else
    static int grid_blocks = 0;
    if (!grid_blocks) {
        int dev = 0, cus = 0, per_cu = 0;
        hipGetDevice(&dev);
        hipDeviceGetAttribute(&cus, hipDeviceAttributeMultiprocessorCount, dev);
        hipOccupancyMaxActiveBlocksPerMultiprocessor(&per_cu, mega_kernel, 256, 0);
        if (per_cu > 2) per_cu = 2;
        if (per_cu < 1) per_cu = 1;
        grid_blocks = cus * per_cu;
    }
    hipMemsetAsync((char*)d_ws + W_BAR, 0, XCD_BAR_WORDS * 4, stream);
    void* args[] = {&P};
    hipError_t e = hipLaunchCooperativeKernel((void*)mega_kernel, dim3(grid_blocks), dim3(256), args, 0, stream);
    if (e != hipSuccess) fprintf(stderr, "cooperative launch failed: %s (grid %d)\n", hipGetErrorString(e), grid_blocks);
#endif
}
```

```cpp
#include <hip/hip_runtime.h>
#include <hip/hip_cooperative_groups.h>
#include <cstdint>
#include <cstdio>
namespace cg = cooperative_groups;

#ifndef MULTI
#define MULTI 0
#endif

typedef unsigned short bf16_t;
typedef short bf16x8 __attribute__((ext_vector_type(8)));
typedef float f32x4 __attribute__((ext_vector_type(4)));
typedef __bf16 bfv2 __attribute__((ext_vector_type(2)));
typedef float f32x2 __attribute__((ext_vector_type(2)));
typedef unsigned u32x4 __attribute__((ext_vector_type(4)));
typedef unsigned u32x2 __attribute__((ext_vector_type(2)));
#define DEV __device__ __forceinline__
DEV int opaque_tid() { int t = threadIdx.x; asm volatile("" : "+v"(t)); return t; }
#define MFMA16(a, b, c) __builtin_amdgcn_mfma_f32_16x16x32_bf16((a), (b), (c), 0, 0, 0)

constexpr int T = 16384, S = 2048;
constexpr int ZW = 4480;
constexpr int C_Q = 0, C_KC = 1024, C_VC = 1280, C_KS = 1536, C_KW = 1792, C_XR = 2048, C_GR = 3072, C_QX = 4096, C_G = 4352;
constexpr int NCMP = 127;
constexpr int NCROWS = 4064;

constexpr size_t O_WTA = 0;
constexpr size_t O_WTB = O_WTA + (size_t)4992 * 1024 * 2;
constexpr size_t O_WTUP = O_WTB + (size_t)3072 * 1024 * 2;
constexpr size_t O_WTDN = O_WTUP + (size_t)4096 * 1024 * 2;
constexpr size_t O_WTO = O_WTDN + (size_t)4096 * 1024 * 2;
constexpr size_t O_WTXO = O_WTO + (size_t)1024 * 1024 * 2;
constexpr size_t O_WTMKV = O_WTXO + (size_t)1024 * 256 * 2;
constexpr size_t O_WTCK1 = O_WTMKV + (size_t)512 * 1024 * 2;
constexpr size_t O_WTCV1 = O_WTCK1 + (size_t)256 * 2048 * 2;
constexpr size_t O_WAT = O_WTCV1 + (size_t)256 * 2048 * 2;
constexpr size_t O_WIT = O_WAT + (size_t)16 * 64 * 64 * 2;
constexpr size_t O_ROPEC = O_WIT + (size_t)16 * 64 * 64 * 2;
constexpr size_t O_ROPES = O_ROPEC + (size_t)2048 * 8 * 4;
constexpr size_t O_MEMN = O_ROPES + (size_t)2048 * 8 * 4;
constexpr size_t O_MEMK = O_MEMN + (size_t)2048 * 1024 * 2;
constexpr size_t O_MEMVT = O_MEMK + (size_t)2048 * 256 * 2;
constexpr size_t O_HIDK = O_MEMVT + (size_t)2048 * 256 * 2;
constexpr size_t O_HIDV = O_HIDK + (size_t)4096 * 256 * 2;
constexpr size_t O_KC = O_HIDV + (size_t)4096 * 256 * 2;
constexpr size_t O_VCT = O_KC + (size_t)32 * 128 * 64 * 2;
constexpr size_t O_AUX_END = O_VCT + (size_t)32 * 64 * 128 * 2;
static_assert(O_AUX_END <= (size_t)64 << 20, "aux overflow");
constexpr size_t MiB = (size_t)1 << 20;
constexpr size_t W_U = 0, W_ZA = 32 * MiB, W_VST = 172 * MiB, W_VWT = 180 * MiB, W_YX = 188 * MiB, W_Y = 220 * MiB;
constexpr size_t W_H = 32 * MiB, W_VN = 0, W_HID = 96 * MiB;

struct Params {
    const float *x, *mem, *g_mix, *w_in, *cpk, *cpv, *wk1, *wk2, *wv1, *wv2, *conv_w, *conv_b, *w_a, *b_a, *w_i, *b_i, *lam,
        *g_mem, *w_mkv, *w_xo, *w_o, *g_mlp, *w_up, *w_down, *g_final;
    float* out;
    char* ws;
};

DEV float bf2f(bf16_t h) { return __uint_as_float(((unsigned)h) << 16); }
DEV unsigned pk2(float lo, float hi) { f32x2 v = {lo, hi}; bfv2 b = __builtin_convertvector(v, bfv2); return __builtin_bit_cast(unsigned, b); }
DEV bf16_t f2bf(float f) { return (bf16_t)(pk2(f, 0.f) & 0xffffu); }
DEV float lo_f(unsigned u) { return __uint_as_float(u << 16); }
DEV float hi_f(unsigned u) { return __uint_as_float(u & 0xffff0000u); }
DEV float sigm(float x) { return __builtin_amdgcn_rcpf(1.f + __expf(-x)); }
DEV float gelu_t(float x) {
    float y = 0.7978845608028654f * (x + 0.044715f * x * x * x);
    float e = __expf(2.f * y);
    float th = 1.f - 2.f * __builtin_amdgcn_rcpf(1.f + e);
    return 0.5f * x * (1.f + th);
}
DEV float wave_sum(float v) {
#pragma unroll
    for (int o = 32; o >= 1; o >>= 1) v += __shfl_xor(v, o);
    return v;
}

DEV int map_col(int mapid, int r) {
    if (mapid == 0) return r;
    if (mapid == 1) {
        if (r < 1536) return r;
        if (r < 1792) return 1536 + (r - 1536);
        if (r < 2048) return 2048 + (r - 1792);
        if (r < 3072) return 2608 + (r - 2048);
        if (r < 4096) return 3632 + (r - 3072);
        if (r < 4352) return 4656 + (r - 4096);
        if (r < 4400) return 2560 + (r - 4352);
        if (r < 4480) return -1;
        if (r < 4736) return 1792 + (r - 4480);
        return 2304 + (r - 4736);
    }
    int pn = r / 96, rem = r - pn * 96, wc = rem / 48, rem2 = rem - wc * 48, gidx = rem2 >> 4, cc = rem2 & 15;
    return 4912 + gidx * 1024 + pn * 32 + wc * 16 + cc;
}

DEV void transpose_tile(const float* __restrict__ src, int ld, bf16_t* __restrict__ dst, int K, int r0, int k0, int mapid, char* smem) {
    float* sm = (float*)smem;
    const int tid = threadIdx.x, lane = tid & 63, w = tid >> 6;
    __syncthreads();
    const int sc = map_col(mapid, r0 + lane);
#pragma unroll
    for (int i = 0; i < 16; ++i) {
        int kk = w + 4 * i;
        float v = sc >= 0 ? src[(size_t)(k0 + kk) * ld + sc] : 0.f;
        sm[kk * 65 + lane] = v;
    }
    __syncthreads();
    const int rr = tid >> 2, kq = (tid & 3) * 16;
    unsigned o[8];
#pragma unroll
    for (int e = 0; e < 8; ++e) o[e] = pk2(sm[(kq + 2 * e) * 65 + rr], sm[(kq + 2 * e + 1) * 65 + rr]);
    uint4* dp = (uint4*)(dst + (size_t)(r0 + rr) * K + k0 + kq);
    dp[0] = make_uint4(o[0], o[1], o[2], o[3]);
    dp[1] = make_uint4(o[4], o[5], o[6], o[7]);
}

template <bool OUTF32>
DEV void rownorm(const float* __restrict__ src, const float* __restrict__ g, bf16_t* dstb, float* dstf, int row) {
    const int lane = threadIdx.x & 63;
    const float4* sp = (const float4*)(src + (size_t)row * 1024);
    float4 v[4];
    float ss = 0.f;
#pragma unroll
    for (int i = 0; i < 4; ++i) { v[i] = sp[lane + 64 * i]; ss += v[i].x * v[i].x + v[i].y * v[i].y + v[i].z * v[i].z + v[i].w * v[i].w; }
    ss = wave_sum(ss);
    const float r = rsqrtf(ss * (1.0f / 1024.0f) + 1e-6f);
#pragma unroll
    for (int i = 0; i < 4; ++i) {
        float4 gg = ((const float4*)g)[lane + 64 * i];
        float a = v[i].x * r * gg.x, b = v[i].y * r * gg.y, c = v[i].z * r * gg.z, d = v[i].w * r * gg.w;
        if (OUTF32) ((float4*)(dstf + (size_t)row * 1024))[lane + 64 * i] = make_float4(a, b, c, d);
        else ((uint2*)(dstb + (size_t)row * 1024))[lane + 64 * i] = make_uint2(pk2(a, b), pk2(c, d));
    }
}

DEV void rope_job(float* ct, float* st, int job) {
    const int e = job * 256 + threadIdx.x;
    const int pos = e >> 3, i = e & 7;
    const double inv = exp(-(double)i * 0.125 * 13.122363377404328);
    const double ang = (double)pos * inv;
    const double kq = rint(ang * 0.6366197723675814);
    const double r = ang - kq * 1.5707963267948966;
    const double r2 = r * r;
    const double sn = r * (1.0 + r2 * (-1.0 / 6 + r2 * (1.0 / 120 + r2 * (-1.0 / 5040 + r2 * (1.0 / 362880 + r2 * (-1.0 / 39916800 + r2 * (1.0 / 6227020800.0)))))));
    const double cs = 1.0 + r2 * (-0.5 + r2 * (1.0 / 24 + r2 * (-1.0 / 720 + r2 * (1.0 / 40320 + r2 * (-1.0 / 3628800 + r2 * (1.0 / 479001600.0))))));
    const int q = ((int)kq) & 3;
    double s_, c_;
    if (q == 0) { s_ = sn; c_ = cs; } else if (q == 1) { s_ = cs; c_ = -sn; } else if (q == 2) { s_ = -sn; c_ = -cs; } else { s_ = -cs; c_ = sn; }
    ct[e] = (float)c_; st[e] = (float)s_;
}

struct ALPlain {
    const bf16_t* A; int lda;
    const char* base; unsigned off0;
    DEV void init(int row0, int lrow, int lk) { base = (const char*)(A + (size_t)row0 * lda); off0 = (unsigned)(lrow * lda + lk) * 2u; }
    DEV u32x4 load(int i, int k0) const { return *(const u32x4*)(base + (off0 + (unsigned)(i * 64 * lda) + (unsigned)(k0 * 2))); }
    DEV u32x4 fix(int, const u32x4& v, int) const { return v; }
};
struct ALCmp {
    const bf16_t* ZA; const float* spos; int colbase;
    unsigned roff[4]; int lk_;
    DEV void init(int row0, int lrow, int lk) {
        lk_ = lk;
#pragma unroll
        for (int i = 0; i < 4; ++i) {
            const int row = row0 + lrow + 32 * i;
            const int bg = row / NCMP, n = row - bg * NCMP, b = bg >> 2, g = bg & 3;
            roff[i] = row < NCROWS ? (unsigned)(((b * S + 16 * n) * ZW + colbase + g * 64 + lk) * 2) : 0xffffffffu;
        }
    }
    DEV u32x4 load(int i, int k0) const {
        if (roff[i] == 0xffffffffu) return (u32x4){0u, 0u, 0u, 0u};
        return *(const u32x4*)((const char*)ZA + (roff[i] + (unsigned)((k0 >> 6) * ZW * 2)));
    }
    DEV u32x4 fix(int i, const u32x4& v, int k0) const {
        if (roff[i] == 0xffffffffu) return v;
        const float4 p0 = *(const float4*)(spos + k0 + lk_), p1 = *(const float4*)(spos + k0 + lk_ + 4);
        u32x4 o;
        o.x = pk2(lo_f(v.x) + p0.x, hi_f(v.x) + p0.y); o.y = pk2(lo_f(v.y) + p0.z, hi_f(v.y) + p0.w);
        o.z = pk2(lo_f(v.z) + p1.x, hi_f(v.z) + p1.y); o.w = pk2(lo_f(v.w) + p1.z, hi_f(v.w) + p1.w);
        return o;
    }
};

template <int TM, int TN, bool SWAP, class AL, class EP>
DEV void gemm_tile(AL al, const bf16_t* __restrict__ Bt, int ldb, int K, int pm, int pn, const EP& ep, char* smem) {
    constexpr int BM = TM * 32, BN = TN * 32, NA = TM, NBB = TN;
    bf16_t* sA = (bf16_t*)smem;
    bf16_t* sB = sA + BM * 72;
    const int tid = opaque_tid(), wid = tid >> 6, lane = tid & 63, wr = wid >> 1, wc = wid & 1, fr = lane & 15, fq = lane >> 4;
    f32x4 acc[TM][TN];
#pragma unroll
    for (int m = 0; m < TM; ++m)
#pragma unroll
        for (int n = 0; n < TN; ++n) acc[m][n] = (f32x4){0.f, 0.f, 0.f, 0.f};
    const int lrow = tid >> 3, lk = (tid & 7) * 8;
    u32x4 ra[NA], rb[NBB];
    al.init(pm * BM, lrow, lk);
    const char* bbase = (const char*)(Bt + (size_t)(pn * BN) * ldb);
    const unsigned boff = (unsigned)(lrow * ldb + lk) * 2u;
#pragma unroll
    for (int i = 0; i < NA; ++i) ra[i] = al.load(i, 0);
#pragma unroll
    for (int i = 0; i < NBB; ++i) rb[i] = *(const u32x4*)(bbase + (boff + (unsigned)(i * 64 * ldb)));
    int nk = K >> 6;
    asm volatile("" : "+s"(nk));
    bf16_t* sWa = sA + lrow * 72 + lk;
    bf16_t* sWb = sB + lrow * 72 + lk;
    const bf16_t* sAr = sA + (wr * TM * 16 + fr) * 72 + fq * 8;
    const bf16_t* sBr = sB + (wc * TN * 16 + fr) * 72 + fq * 8;
#pragma unroll 1
    for (int kt = 0; kt < nk; ++kt) {
        __syncthreads();
#pragma unroll
        for (int i = 0; i < NA; ++i) *(u32x4*)(sWa + (32 * i) * 72) = al.fix(i, ra[i], kt * 64);
#pragma unroll
        for (int i = 0; i < NBB; ++i) *(u32x4*)(sWb + (32 * i) * 72) = rb[i];
        __syncthreads();
        if (kt + 1 < nk) {
            const int k0 = (kt + 1) * 64;
#pragma unroll
            for (int i = 0; i < NA; ++i) ra[i] = al.load(i, k0);
#pragma unroll
            for (int i = 0; i < NBB; ++i) rb[i] = *(const u32x4*)(bbase + (boff + (unsigned)(i * 64 * ldb) + (unsigned)(k0 * 2)));
        }
        __builtin_amdgcn_sched_barrier(0);
        __builtin_amdgcn_s_setprio(1);
#pragma unroll
        for (int ks = 0; ks < 2; ++ks) {
            bf16x8 bfr[TN];
#pragma unroll
            for (int n = 0; n < TN; ++n) bfr[n] = *(const bf16x8*)(sBr + (n * 16) * 72 + ks * 32);
#pragma unroll
            for (int m = 0; m < TM; ++m) {
                const bf16x8 af = *(const bf16x8*)(sAr + (m * 16) * 72 + ks * 32);
#pragma unroll
                for (int n = 0; n < TN; ++n) acc[m][n] = SWAP ? MFMA16(bfr[n], af, acc[m][n]) : MFMA16(af, bfr[n], acc[m][n]);
            }
        }
        __builtin_amdgcn_s_setprio(0);
    }
    ep.run(acc, pm * BM + wr * TM * 16, pn * BN + wc * TN * 16, fr, fq);
}

DEV uint2 pk4(const f32x4& a) { return make_uint2(pk2(a[0], a[1]), pk2(a[2], a[3])); }

template <bool SWAP>
struct EpiZA {
    bf16_t *ZA, *VST, *VWT; const float *ropec, *ropes;
    DEV void run(f32x4 (&acc)[8][4], int R0, int C0, int fr, int fq) const {
#pragma unroll
        for (int n = 0; n < 4; ++n) {
            const int col0 = C0 + n * 16;
#pragma unroll
            for (int m = 0; m < 8; ++m) {
                f32x4 a = acc[m][n];
                if (!SWAP) {
                    const int r = R0 + m * 16 + 4 * fq;
                    int c = col0 - 4480 + fr;
                    bf16_t* dst = (c < 256) ? VST : VWT;
                    c &= 255;
                    const int g = c >> 6, d = c & 63, b = r >> 11, t = r & 2047;
                    *(uint2*)(dst + ((size_t)((b * 4 + g) * 64 + d)) * S + t) = pk4(a);
                } else {
                    const int row = R0 + m * 16 + fr;
                    const bool rope = (col0 < 1024 || (col0 >= 1536 && col0 < 2048)) && ((col0 & 63) == 0);
                    if (rope) {
                        const int t = row & 2047, i0 = 4 * (fq & 1);
                        const float4 cs = *(const float4*)(ropec + t * 8 + i0), sn = *(const float4*)(ropes + t * 8 + i0);
                        const float c4[4] = {cs.x, cs.y, cs.z, cs.w}, s4[4] = {sn.x, sn.y, sn.z, sn.w};
#pragma unroll
                        for (int j = 0; j < 4; ++j) {
                            const float pr = __shfl_xor(a[j], 32);
                            a[j] = (fq & 2) ? (a[j] * c4[j] + pr * s4[j]) : (a[j] * c4[j] - pr * s4[j]);
                        }
                    }
                    if (col0 >= C_G) {
#pragma unroll
                        for (int j = 0; j < 4; ++j) a[j] = sigm(a[j]);
                    }
                    *(uint2*)(ZA + (size_t)row * ZW + col0 + 4 * fq) = pk4(a);
                }
            }
        }
    }
};
template <bool SWAP>
struct EpiMemKV {
    bf16_t *MK, *MVT;
    DEV void run(f32x4 (&acc)[8][4], int R0, int C0, int fr, int fq) const {
#pragma unroll
        for (int n = 0; n < 4; ++n)
#pragma unroll
            for (int m = 0; m < 8; ++m) {
                if (SWAP) {
                    const int c = C0 + n * 16 + 4 * fq, r = R0 + m * 16 + fr;
                    const int h = (c >> 6) & 3, d = c & 63, b = r >> 8, mm = r & 255;
                    *(uint2*)(MK + ((size_t)(b * 4 + h) * 256 + mm) * 64 + d) = pk4(acc[m][n]);
                } else {
                    const int c = C0 + n * 16 + fr, r = R0 + m * 16 + 4 * fq;
                    const int h = (c >> 6) & 3, d = c & 63, b = r >> 8, mm = r & 255;
                    *(uint2*)(MVT + ((size_t)(b * 4 + h) * 64 + d) * 256 + mm) = pk4(acc[m][n]);
                }
            }
    }
};
struct EpiHid {
    bf16_t* H;
    DEV void run(f32x4 (&acc)[4][4], int R0, int C0, int fr, int fq) const {
#pragma unroll
        for (int n = 0; n < 4; ++n)
#pragma unroll
            for (int m = 0; m < 4; ++m) {
                const int c = C0 + n * 16 + 4 * fq, r = R0 + m * 16 + fr;
                f32x4 a = acc[m][n];
#pragma unroll
                for (int j = 0; j < 4; ++j) a[j] = gelu_t(a[j]);
                if (r < NCROWS) *(uint2*)(H + (size_t)r * 256 + c) = pk4(a);
            }
    }
};
template <int ACT>
struct EpiBf {
    bf16_t* O; int ldo;
    DEV void run(f32x4 (&acc)[8][4], int R0, int C0, int fr, int fq) const {
#pragma unroll
        for (int n = 0; n < 4; ++n)
#pragma unroll
            for (int m = 0; m < 8; ++m) {
                const int c = C0 + n * 16 + 4 * fq, r = R0 + m * 16 + fr;
                f32x4 a = acc[m][n];
                if (ACT == 1) {
#pragma unroll
                    for (int j = 0; j < 4; ++j) { const float v = fmaxf(a[j], 0.f); a[j] = v * v; }
                }
                *(uint2*)(O + (size_t)r * ldo + c) = pk4(a);
            }
    }
};
struct EpiRes {
    const float* R; float* O;
    DEV void run(f32x4 (&acc)[8][4], int R0, int C0, int fr, int fq) const {
#pragma unroll
        for (int n = 0; n < 4; ++n)
#pragma unroll
            for (int m = 0; m < 8; ++m) {
                const size_t o = (size_t)(R0 + m * 16 + fr) * 1024 + C0 + n * 16 + 4 * fq;
                const f32x4 r = *(const f32x4*)(R + o);
                *(f32x4*)(O + o) = r + acc[m][n];
            }
    }
};
struct EpiMerge {
    const bf16_t *ZA, *YX; bf16_t* Y;
    DEV void run(f32x4 (&acc)[8][3], int R0, int C0, int fr, int fq) const {
        const int ch = (C0 / 48) * 16 + 4 * fq;
#pragma unroll
        for (int m = 0; m < 8; ++m) {
            const size_t row = (size_t)(R0 + m * 16 + fr);
            const uint2 a = *(const uint2*)(ZA + row * ZW + C_Q + ch), b = *(const uint2*)(ZA + row * ZW + C_GR + ch), c = *(const uint2*)(YX + row * 1024 + ch);
            f32x4 y;
            y[0] = sigm(acc[m][0][0]) * lo_f(a.x) + sigm(acc[m][1][0]) * lo_f(b.x) + sigm(acc[m][2][0]) * lo_f(c.x);
            y[1] = sigm(acc[m][0][1]) * hi_f(a.x) + sigm(acc[m][1][1]) * hi_f(b.x) + sigm(acc[m][2][1]) * hi_f(c.x);
            y[2] = sigm(acc[m][0][2]) * lo_f(a.y) + sigm(acc[m][1][2]) * lo_f(b.y) + sigm(acc[m][2][2]) * lo_f(c.y);
            y[3] = sigm(acc[m][0][3]) * hi_f(a.y) + sigm(acc[m][1][3]) * hi_f(b.y) + sigm(acc[m][2][3]) * hi_f(c.y);
            *(uint2*)(Y + row * 1024 + ch) = pk4(y);
        }
    }
};

DEV bool tile_map(int idx, int NT, int& pm, int& pn) {
    const int x = idx & 7, pl = (idx >> 3) & 7, pmid = (idx >> 6) & 7, st = idx >> 9;
    pm = pmid * 8 + x;
    pn = st * 8 + pl;
    return pn < NT;
}
DEV int tile_count(int NT) { return ((NT + 7) / 8) * 512; }

DEV void cmp2_job(const Params& P, int job) {
    char* aux = (char*)P.out;
    const int lane = threadIdx.x & 63, w = threadIdx.x >> 6;
    const int wj = job * 4 + w;
    const int which = wj >= NCROWS ? 1 : 0;
    const int r = wj - which * NCROWS;
    const int bg = r / NCMP, n = r - bg * NCMP;
    const bf16_t* hid = (const bf16_t*)(aux + (which ? O_HIDV : O_HIDK)) + (size_t)r * 256;
    const float* w2 = which ? P.wv2 : P.wk2;
    float acc = 0.f;
#pragma unroll 8
    for (int k = 0; k < 256; ++k) acc += bf2f(hid[k]) * w2[k * 64 + lane];
    if (!which) {
        const int pos = 16 * n + 31, i = lane & 7;
        const float cs = ((const float*)(aux + O_ROPEC))[pos * 8 + i], sn = ((const float*)(aux + O_ROPES))[pos * 8 + i];
        const float pr = __shfl_xor(acc, 8);
        float o = acc;
        if (lane < 16) o = (lane & 8) ? (acc * cs + pr * sn) : (acc * cs - pr * sn);
        bf16_t* KC = (bf16_t*)(aux + O_KC);
        KC[((size_t)bg * 128 + n) * 64 + lane] = f2bf(o);
        if (n == NCMP - 1) KC[((size_t)bg * 128 + 127) * 64 + lane] = 0;
    } else {
        bf16_t* VCT = (bf16_t*)(aux + O_VCT);
        VCT[((size_t)bg * 64 + lane) * 128 + n] = f2bf(acc);
        if (n == NCMP - 1) VCT[((size_t)bg * 64 + lane) * 128 + 127] = 0;
    }
}

DEV void rnn_job(const Params& P, int job, char* smem, bool dry) {
    char* aux = (char*)P.out;
    bf16_t* ZA = (bf16_t*)(P.ws + W_ZA);
    const int b = job >> 6, n = (job >> 2) & 15, ct = job & 3;
    bf16_t* sX = (bf16_t*)smem;
    float* sXf = (float*)(smem + 9216);
    float* sCw = (float*)(smem + 9216 + 16640);
    float* sSum = (float*)(smem + 9216 + 16640 + 1280);
    bf16_t* sRaw = (bf16_t*)(smem + 9216 + 16640 + 1280 + 2048);
    const int tid = opaque_tid(), w = tid >> 6, lane = tid & 63, fr = lane & 15, fq = lane >> 4;
    const bf16_t* WAT = (const bf16_t*)(aux + O_WAT) + n * 4096;
    const bf16_t* WIT = (const bf16_t*)(aux + O_WIT) + n * 4096;
    bf16x8 wa[2], wi[2];
#pragma unroll
    for (int ks = 0; ks < 2; ++ks) {
        wa[ks] = *(const bf16x8*)(WAT + (16 * ct + fr) * 64 + 32 * ks + 8 * fq);
        wi[ks] = *(const bf16x8*)(WIT + (16 * ct + fr) * 64 + 32 * ks + 8 * fq);
    }
    const int c = n * 64 + 16 * ct + fr;
    const float ba = P.b_a[c], bi = P.b_i[c], cl = -8.0f * log1pf(__expf(-P.lam[c]));
    float carry = 0.f;
    __syncthreads();
    for (int i = tid; i < 320; i += 256) sCw[i] = (i < 256) ? P.conv_w[(i >> 6) * 1024 + n * 64 + (i & 63)] : P.conv_b[n * 64 + (i & 63)];
    const int lt = tid >> 2, cg = (tid & 3) * 16;
    const bf16_t* xbase = ZA + (size_t)(b * S) * ZW + C_XR + n * 64 + cg;
    bf16_t* sRaw2 = sRaw + 67 * 72;
    u32x4 xm0, xm1, xh0 = {0u, 0u, 0u, 0u}, xh1 = {0u, 0u, 0u, 0u};
    { const u32x4* xp = (const u32x4*)(xbase + (size_t)lt * ZW); xm0 = xp[0]; xm1 = xp[1]; }
    *(u32x4*)(sRaw + (lt + 3) * 72 + cg) = xm0; *(u32x4*)(sRaw + (lt + 3) * 72 + cg + 8) = xm1;
    if (tid < 12) { *(u32x4*)(sRaw + lt * 72 + cg) = xh0; *(u32x4*)(sRaw + lt * 72 + cg + 8) = xh1; }
    { const u32x4* xp = (const u32x4*)(xbase + (size_t)(64 + lt) * ZW); xm0 = xp[0]; xm1 = xp[1];
      if (tid < 12) { const u32x4* hp = (const u32x4*)(xbase + (size_t)(61 + lt) * ZW); xh0 = hp[0]; xh1 = hp[1]; } }
    __syncthreads();
#pragma unroll 1
    for (int chunk = 0; chunk < 32; ++chunk) {
        const int tc = chunk * 64;
        const bf16_t* rawc = (chunk & 1) ? sRaw2 : sRaw;
        bf16_t* rawn = (chunk & 1) ? sRaw : sRaw2;
        bf16_t gv[4];
#pragma unroll
        for (int j = 0; j < 4; ++j) gv[j] = ZA[(size_t)(b * S + tc + 16 * w + 4 * fq + j) * ZW + C_GR + n * 64 + 16 * ct + fr];
        {
            float xv[16];
#pragma unroll
            for (int e4 = 0; e4 < 4; ++e4) { const float4 bb = *(const float4*)(sCw + 256 + cg + 4 * e4); xv[4 * e4] = bb.x; xv[4 * e4 + 1] = bb.y; xv[4 * e4 + 2] = bb.z; xv[4 * e4 + 3] = bb.w; }
#pragma unroll
            for (int k = 0; k < 4; ++k) {
                const u32x4 v0 = *(const u32x4*)(rawc + (lt + k) * 72 + cg), v1 = *(const u32x4*)(rawc + (lt + k) * 72 + cg + 8);
                const unsigned u[8] = {v0.x, v0.y, v0.z, v0.w, v1.x, v1.y, v1.z, v1.w};
#pragma unroll
                for (int e4 = 0; e4 < 4; ++e4) {
                    const float4 wv = *(const float4*)(sCw + k * 64 + cg + 4 * e4);
                    xv[4 * e4] += wv.x * lo_f(u[2 * e4]);
                    xv[4 * e4 + 1] += wv.y * hi_f(u[2 * e4]);
                    xv[4 * e4 + 2] += wv.z * lo_f(u[2 * e4 + 1]);
                    xv[4 * e4 + 3] += wv.w * hi_f(u[2 * e4 + 1]);
                }
            }
            if ((tid & 3) == ct) {
#pragma unroll
                for (int e = 0; e < 16; ++e) sXf[lt * 17 + e] = xv[e];
            }
            u32x4 o0 = {pk2(xv[0], xv[1]), pk2(xv[2], xv[3]), pk2(xv[4], xv[5]), pk2(xv[6], xv[7])};
            u32x4 o1 = {pk2(xv[8], xv[9]), pk2(xv[10], xv[11]), pk2(xv[12], xv[13]), pk2(xv[14], xv[15])};
            *(u32x4*)(sX + lt * 72 + cg) = o0;
            *(u32x4*)(sX + lt * 72 + cg + 8) = o1;
        }
        __syncthreads();
        f32x4 R = (f32x4){0.f, 0.f, 0.f, 0.f}, I = (f32x4){0.f, 0.f, 0.f, 0.f};
#pragma unroll
        for (int ks = 0; ks < 2; ++ks) {
            const bf16x8 af = *(const bf16x8*)(sX + (16 * w + fr) * 72 + 32 * ks + 8 * fq);
            R = MFMA16(af, wa[ks], R); I = MFMA16(af, wi[ks], I);
        }
        if (chunk + 1 < 32) {
            *(u32x4*)(rawn + (lt + 3) * 72 + cg) = xm0; *(u32x4*)(rawn + (lt + 3) * 72 + cg + 8) = xm1;
            if (tid < 12) { *(u32x4*)(rawn + lt * 72 + cg) = xh0; *(u32x4*)(rawn + lt * 72 + cg + 8) = xh1; }
        }
        float hl[4], pc[4];
        float h = 0.f, pcum = 1.f;
#pragma unroll
        for (int j = 0; j < 4; ++j) {
            const float xcv = sXf[(16 * w + 4 * fq + j) * 17 + fr];
            const float rg = sigm(R[j] + ba), gi = sigm(I[j] + bi);
            const float la = rg * cl;
            const float a_ = __expf(la);
            const float mult = sqrtf(fmaxf(1.f - a_ * a_, 0.f));
            const float u = mult * gi * xcv;
            h = a_ * h + u; pcum *= a_;
            hl[j] = h; pc[j] = pcum;
        }
        float A = pcum, H = h;
        float A1 = __shfl_up(A, 16), H1 = __shfl_up(H, 16);
        if (fq >= 1) { H = A * H1 + H; A = A * A1; }
        float A2 = __shfl_up(A, 32), H2 = __shfl_up(H, 32);
        if (fq >= 2) { H = A * H2 + H; A = A * A2; }
        float Ax = __shfl_up(A, 16), Hx = __shfl_up(H, 16);
        const float Ae = fq == 0 ? 1.f : Ax, He = fq == 0 ? 0.f : Hx;
        if (fq == 3) { sSum[w * 16 + fr] = A; sSum[64 + w * 16 + fr] = H; }
        __syncthreads();
        if (chunk + 2 < 32) {
            const u32x4* xp = (const u32x4*)(xbase + (size_t)(tc + 128 + lt) * ZW); xm0 = xp[0]; xm1 = xp[1];
            if (tid < 12) { const u32x4* hp = (const u32x4*)(xbase + (size_t)(tc + 125 + lt) * ZW); xh0 = hp[0]; xh1 = hp[1]; }
        }
        float cin = carry, mycin = 0.f;
#pragma unroll
        for (int ww = 0; ww < 4; ++ww) {
            if (ww == w) mycin = cin;
            cin = sSum[ww * 16 + fr] * cin + sSum[64 + ww * 16 + fr];
        }
        carry = cin;
        const float sq = Ae * mycin + He;
#pragma unroll
        for (int j = 0; j < 4; ++j) {
            const float hfin = hl[j] + pc[j] * sq;
            const size_t grow = (size_t)(b * S + tc + 16 * w + 4 * fq + j);
            bf16_t* op = dry ? ((bf16_t*)(P.ws + W_YX) + grow * 1024 + n * 64 + 16 * ct + fr) : (ZA + grow * ZW + C_GR + n * 64 + 16 * ct + fr);
            *op = f2bf(gelu_t(bf2f(gv[j])) * hfin);
        }
    }
}

constexpr float EXPC = 0.125f * 1.4426950408889634f;
struct AttnAcc { f32x4 o[4][2]; float m[2], l[2]; };
DEV void attn_init(AttnAcc& a) {
#pragma unroll
    for (int d = 0; d < 4; ++d)
#pragma unroll
        for (int q = 0; q < 2; ++q) a.o[d][q] = (f32x4){0.f, 0.f, 0.f, 0.f};
    a.m[0] = a.m[1] = -INFINITY; a.l[0] = a.l[1] = 0.f;
}
DEV bf16x8 mk8(unsigned a, unsigned b, unsigned c, unsigned d) { u32x4 u = {a, b, c, d}; return __builtin_bit_cast(bf16x8, u); }

template <class MF>
DEV void attn_step(const bf16_t* sK, const bf16_t* sVt, int vstride, const bf16x8 (&qf)[2][2], AttnAcc& st, const MF& mf, int fr, int fq) {
    f32x4 s[4][2];
#pragma unroll
    for (int kt = 0; kt < 4; ++kt) {
        s[kt][0] = (f32x4){0.f, 0.f, 0.f, 0.f}; s[kt][1] = (f32x4){0.f, 0.f, 0.f, 0.f};
#pragma unroll
        for (int ks = 0; ks < 2; ++ks) {
            const bf16x8 kf = *(const bf16x8*)(sK + (16 * kt + fr) * 72 + 32 * ks + 8 * fq);
            s[kt][0] = MFMA16(kf, qf[0][ks], s[kt][0]);
            s[kt][1] = MFMA16(kf, qf[1][ks], s[kt][1]);
        }
    }
#pragma unroll
    for (int qt = 0; qt < 2; ++qt) {
        float mx = -INFINITY;
#pragma unroll
        for (int kt = 0; kt < 4; ++kt)
#pragma unroll
            for (int j = 0; j < 4; ++j) {
                const float v = mf(qt, 16 * kt + 4 * fq + j) ? s[kt][qt][j] : -INFINITY;
                s[kt][qt][j] = v; mx = fmaxf(mx, v);
            }
        mx = fmaxf(mx, __shfl_xor(mx, 16)); mx = fmaxf(mx, __shfl_xor(mx, 32));
        const float mn = fmaxf(st.m[qt], mx);
        float alpha = 1.f, msub = 0.f;
        if (mn != -INFINITY) { alpha = __builtin_amdgcn_exp2f((st.m[qt] - mn) * EXPC); msub = mn; }
        st.m[qt] = mn;
        float ps = 0.f;
#pragma unroll
        for (int kt = 0; kt < 4; ++kt)
#pragma unroll
            for (int j = 0; j < 4; ++j) { const float p = __builtin_amdgcn_exp2f((s[kt][qt][j] - msub) * EXPC); s[kt][qt][j] = p; ps += p; }
        st.l[qt] = st.l[qt] * alpha + ps;
#pragma unroll
        for (int dt = 0; dt < 4; ++dt) st.o[dt][qt] *= alpha;
    }
#pragma unroll
    for (int ks = 0; ks < 2; ++ks) {
        bf16x8 pf[2];
#pragma unroll
        for (int qt = 0; qt < 2; ++qt)
            pf[qt] = mk8(pk2(s[2 * ks][qt][0], s[2 * ks][qt][1]), pk2(s[2 * ks][qt][2], s[2 * ks][qt][3]),
                         pk2(s[2 * ks + 1][qt][0], s[2 * ks + 1][qt][1]), pk2(s[2 * ks + 1][qt][2], s[2 * ks + 1][qt][3]));
#pragma unroll
        for (int dt = 0; dt < 4; ++dt) {
            const u32x2 v0 = *(const u32x2*)(sVt + (16 * dt + fr) * vstride + 32 * ks + 4 * fq);
            const u32x2 v1 = *(const u32x2*)(sVt + (16 * dt + fr) * vstride + 32 * ks + 16 + 4 * fq);
            const bf16x8 vf = mk8(v0.x, v0.y, v1.x, v1.y);
            st.o[dt][0] = MFMA16(vf, pf[0], st.o[dt][0]);
            st.o[dt][1] = MFMA16(vf, pf[1], st.o[dt][1]);
        }
    }
}
DEV void attn_step_fast(const bf16_t* sK, const bf16_t* sVt, const bf16x8 (&qf)[2][2], AttnAcc& st, const float (&bitoff)[2], int fr, int fq) {
    f32x4 s[4][2];
#pragma unroll
    for (int kt = 0; kt < 4; ++kt) {
        s[kt][0] = (f32x4){0.f, 0.f, 0.f, 0.f}; s[kt][1] = (f32x4){0.f, 0.f, 0.f, 0.f};
#pragma unroll
        for (int ks = 0; ks < 2; ++ks) {
            const bf16x8 kf = *(const bf16x8*)(sK + (16 * kt + fr) * 72 + 32 * ks + 8 * fq);
            s[kt][0] = MFMA16(kf, qf[0][ks], s[kt][0]);
            s[kt][1] = MFMA16(kf, qf[1][ks], s[kt][1]);
        }
    }
#pragma unroll
    for (int qt = 0; qt < 2; ++qt) {
        float mx = fmaxf(fmaxf(s[0][qt][0], s[0][qt][1]), fmaxf(s[0][qt][2], s[0][qt][3]));
#pragma unroll
        for (int kt = 1; kt < 4; ++kt) mx = fmaxf(mx, fmaxf(fmaxf(s[kt][qt][0], s[kt][qt][1]), fmaxf(s[kt][qt][2], s[kt][qt][3])));
        mx = fmaxf(mx, __shfl_xor(mx, 16)); mx = fmaxf(mx, __shfl_xor(mx, 32));
        const float mn = fmaxf(st.m[qt], mx);
        const float alpha = __builtin_amdgcn_exp2f((st.m[qt] - mn) * EXPC);
        st.m[qt] = mn;
        const float off = bitoff[qt] - mn * EXPC;
        float ps = 0.f;
#pragma unroll
        for (int kt = 0; kt < 4; ++kt)
#pragma unroll
            for (int j = 0; j < 4; ++j) { const float p = __builtin_amdgcn_exp2f(fmaf(s[kt][qt][j], EXPC, off)); s[kt][qt][j] = p; ps += p; }
        st.l[qt] = st.l[qt] * alpha + ps;
#pragma unroll
        for (int dt = 0; dt < 4; ++dt) st.o[dt][qt] *= alpha;
    }
#pragma unroll
    for (int ks = 0; ks < 2; ++ks) {
        bf16x8 pf[2];
#pragma unroll
        for (int qt = 0; qt < 2; ++qt)
            pf[qt] = mk8(pk2(s[2 * ks][qt][0], s[2 * ks][qt][1]), pk2(s[2 * ks][qt][2], s[2 * ks][qt][3]),
                         pk2(s[2 * ks + 1][qt][0], s[2 * ks + 1][qt][1]), pk2(s[2 * ks + 1][qt][2], s[2 * ks + 1][qt][3]));
#pragma unroll
        for (int dt = 0; dt < 4; ++dt) {
            const u32x2 v0 = *(const u32x2*)(sVt + (16 * dt + fr) * 72 + 32 * ks + 4 * fq);
            const u32x2 v1 = *(const u32x2*)(sVt + (16 * dt + fr) * 72 + 32 * ks + 16 + 4 * fq);
            const bf16x8 vf = mk8(v0.x, v0.y, v1.x, v1.y);
            st.o[dt][0] = MFMA16(vf, pf[0], st.o[dt][0]);
            st.o[dt][1] = MFMA16(vf, pf[1], st.o[dt][1]);
        }
    }
}
DEV void attn_fold_out(bf16_t* const (&op)[2], const AttnAcc& st, const float (&gate)[2]) {
#pragma unroll
    for (int qt = 0; qt < 2; ++qt) {
        float l = st.l[qt];
        l += __shfl_xor(l, 16); l += __shfl_xor(l, 32);
        const float sc = gate[qt] * __builtin_amdgcn_rcpf(fmaxf(l, 1e-30f));
#pragma unroll
        for (int dt = 0; dt < 4; ++dt) {
            const uint2 pv = *(const uint2*)(op[qt] + 16 * dt);
            f32x4 r = st.o[dt][qt] * sc;
            r[0] += lo_f(pv.x); r[1] += hi_f(pv.x); r[2] += lo_f(pv.y); r[3] += hi_f(pv.y);
            *(uint2*)(op[qt] + 16 * dt) = make_uint2(pk2(r[0], r[1]), pk2(r[2], r[3]));
        }
    }
}
DEV void attn_fold(f32x4 (&tot)[4][2], const AttnAcc& st, const float (&gate)[2]) {
#pragma unroll
    for (int qt = 0; qt < 2; ++qt) {
        float l = st.l[qt];
        l += __shfl_xor(l, 16); l += __shfl_xor(l, 32);
        const float sc = gate[qt] * __builtin_amdgcn_rcpf(fmaxf(l, 1e-30f));
#pragma unroll
        for (int dt = 0; dt < 4; ++dt) tot[dt][qt] += st.o[dt][qt] * sc;
    }
}
DEV void ld64(u32x4 (&r)[2], const bf16_t* src, size_t sstride, int tid) {
#pragma unroll
    for (int i = 0; i < 2; ++i) { const int c = tid + 256 * i; r[i] = *(const u32x4*)(src + (size_t)(c >> 3) * sstride + (c & 7) * 8); }
}
DEV void st64(bf16_t* dst, const u32x4 (&r)[2], int tid) {
#pragma unroll
    for (int i = 0; i < 2; ++i) { const int c = tid + 256 * i; *(u32x4*)(dst + (c >> 3) * 72 + (c & 7) * 8) = r[i]; }
}

#define OUTP(QT) ((dry ? (bf16_t*)(P.ws + W_YX) + (size_t)(b * S + tq[QT]) * 1024 : ZA + (size_t)(b * S + tq[QT]) * ZW + C_Q) + head * 64 + 4 * fq)
#define LOAD_GATE(G2, BR) float G2[2]; { G2[0] = bf2f(ZA[(size_t)(b * S + tq[0]) * ZW + C_G + head * 3 + (BR)]); G2[1] = bf2f(ZA[(size_t)(b * S + tq[1]) * ZW + C_G + head * 3 + (BR)]); }
struct MaskAll { DEV bool operator()(int, int) const { return true; } };
struct MaskSel { unsigned bit[2]; int t[2]; int k0; DEV bool operator()(int qt, int kk) const { return bit[qt] && (k0 + kk <= t[qt]); } };
struct MaskWin { int t[2]; int k0; DEV bool operator()(int qt, int kk) const { const int k = k0 + kk; return k <= t[qt] && k > t[qt] - 512; } };

DEV void xattn_job(const Params& P, int job, char* smem, bool dry) {
    char* aux = (char*)P.out;
    bf16_t* ZA = (bf16_t*)(P.ws + W_ZA);
    const int qb = job & 15, h = (job >> 4) & 3, b = job >> 6;
    bf16_t* sK = (bf16_t*)smem;
    bf16_t* sVt = sK + 64 * 72;
    const int tid = opaque_tid(), w = tid >> 6, lane = tid & 63, fr = lane & 15, fq = lane >> 4;
    const int t0 = qb * 128 + w * 32;
    bf16x8 qf[2][2];
#pragma unroll
    for (int qt = 0; qt < 2; ++qt)
#pragma unroll
        for (int ks = 0; ks < 2; ++ks) qf[qt][ks] = *(const bf16x8*)(ZA + (size_t)(b * S + t0 + 16 * qt + fr) * ZW + C_QX + h * 64 + 32 * ks + 8 * fq);
    const bf16_t* MK = (const bf16_t*)(aux + O_MEMK) + (size_t)(b * 4 + h) * 256 * 64;
    const bf16_t* MVT = (const bf16_t*)(aux + O_MEMVT) + (size_t)(b * 4 + h) * 64 * 256;
    AttnAcc st; attn_init(st);
    u32x4 rk[2], rv[2];
    ld64(rk, MK, 64, tid); ld64(rv, MVT, 256, tid);
#pragma unroll 1
    for (int jb = 0; jb < 4; ++jb) {
        __syncthreads();
        st64(sK, rk, tid); st64(sVt, rv, tid);
        __syncthreads();
        if (jb + 1 < 4) { ld64(rk, MK + (size_t)(jb + 1) * 64 * 64, 64, tid); ld64(rv, MVT + (jb + 1) * 64, 256, tid); }
        __builtin_amdgcn_sched_barrier(0);
        { const float z2[2] = {0.f, 0.f}; attn_step_fast(sK, sVt, qf, st, z2, fr, fq); }
    }
    f32x4 tot[4][2];
#pragma unroll
    for (int dt = 0; dt < 4; ++dt) { tot[dt][0] = (f32x4){0.f, 0.f, 0.f, 0.f}; tot[dt][1] = (f32x4){0.f, 0.f, 0.f, 0.f}; }
    const float one[2] = {1.f, 1.f};
    attn_fold(tot, st, one);
#pragma unroll
    for (int qt = 0; qt < 2; ++qt)
#pragma unroll
        for (int dt = 0; dt < 4; ++dt)
            *(uint2*)((dry ? (bf16_t*)(P.ws + W_Y) + (size_t)(b * S + t0 + 16 * qt + fr) * 1024 : ZA + (size_t)(b * S + t0 + 16 * qt + fr) * ZW + C_QX) + h * 64 + 16 * dt + 4 * fq) =
                make_uint2(pk2(tot[dt][qt][0], tot[dt][qt][1]), pk2(tot[dt][qt][2], tot[dt][qt][3]));
}

DEV void nsa_job(const Params& P, int job, char* smem, bool dry) {
    char* aux = (char*)P.out;
    bf16_t* ZA = (bf16_t*)(P.ws + W_ZA);
    const int bg = job & 31, qb = 63 - (job >> 5), b = bg >> 2, g = bg & 3, t0 = qb * 32;
    bf16_t* sK = (bf16_t*)smem;
    bf16_t* sVt = (bf16_t*)(smem + 18432);
    float* sImp = (float*)(smem + 18432 + 17408);
    unsigned* sSel = (unsigned*)(smem + 18432 + 17408 + 16384);
    const int tid = opaque_tid(), w = tid >> 6, lane = tid & 63, fr = lane & 15, fq = lane >> 4;
    const int head = g * 4 + w;
    int tq[2];
    bf16x8 qf[2][2];
#pragma unroll
    for (int qt = 0; qt < 2; ++qt) {
        tq[qt] = t0 + 16 * qt + fr;
        const bf16_t* rowp = ZA + (size_t)(b * S + tq[qt]) * ZW;
#pragma unroll
        for (int ks = 0; ks < 2; ++ks) qf[qt][ks] = *(const bf16x8*)(rowp + C_Q + head * 64 + 32 * ks + 8 * fq);
    }
    f32x4 tot[4][2];
#pragma unroll
    for (int dt = 0; dt < 4; ++dt) { tot[dt][0] = (f32x4){0.f, 0.f, 0.f, 0.f}; tot[dt][1] = (f32x4){0.f, 0.f, 0.f, 0.f}; }

    {
        const bf16_t* KC = (const bf16_t*)(aux + O_KC) + (size_t)bg * 128 * 64;
        const bf16_t* VCT = (const bf16_t*)(aux + O_VCT) + (size_t)bg * 64 * 128;
        __syncthreads();
#pragma unroll
        for (int i = 0; i < 4; ++i) {
            const int c = tid + 256 * i;
            { const int r = c >> 3, k = (c & 7) * 8; *(u32x4*)(sK + r * 72 + k) = *(const u32x4*)(KC + r * 64 + k); }
            { const int r = c >> 4, k = (c & 15) * 8; *(u32x4*)(sVt + r * 136 + k) = *(const u32x4*)(VCT + r * 128 + k); }
        }
        __syncthreads();
#pragma unroll
        for (int qt = 0; qt < 2; ++qt) {
            const float g0 = bf2f(ZA[(size_t)(b * S + tq[qt]) * ZW + C_G + head * 3 + 0]);
            f32x4 s[8];
#pragma unroll
            for (int kt = 0; kt < 8; ++kt) {
                s[kt] = (f32x4){0.f, 0.f, 0.f, 0.f};
#pragma unroll
                for (int ks = 0; ks < 2; ++ks) {
                    const bf16x8 kf = *(const bf16x8*)(sK + (16 * kt + fr) * 72 + 32 * ks + 8 * fq);
                    s[kt] = MFMA16(kf, qf[qt][ks], s[kt]);
                }
            }
            float mx = -INFINITY;
#pragma unroll
            for (int kt = 0; kt < 8; ++kt)
#pragma unroll
                for (int j = 0; j < 4; ++j) {
                    const int n = 16 * kt + 4 * fq + j;
                    const float v = (n < NCMP && 16 * n + 31 <= tq[qt]) ? s[kt][j] : -INFINITY;
                    s[kt][j] = v; mx = fmaxf(mx, v);
                }
            mx = fmaxf(mx, __shfl_xor(mx, 16)); mx = fmaxf(mx, __shfl_xor(mx, 32));
            const float msub = (mx == -INFINITY) ? 0.f : mx;
            float ps = 0.f;
#pragma unroll
            for (int kt = 0; kt < 8; ++kt)
#pragma unroll
                for (int j = 0; j < 4; ++j) { const float p = __builtin_amdgcn_exp2f((s[kt][j] - msub) * EXPC); s[kt][j] = p; ps += p; }
            ps += __shfl_xor(ps, 16); ps += __shfl_xor(ps, 32);
            const float inv = __builtin_amdgcn_rcpf(fmaxf(ps, 1e-30f));
            float bprev = 0.f;
#pragma unroll
            for (int kt = 0; kt < 8; ++kt) {
                s[kt] *= inv;
                const float a = s[kt][0] + s[kt][1] + s[kt][2] + 0.5f * s[kt][3];
                const float bq = 0.5f * s[kt][3];
                const float x = __shfl(bq, (lane + 48) & 63);
                const float y = __shfl(bprev, (lane + 48) & 63);
                sImp[(w * 32 + 16 * qt + fr) * 32 + 4 * kt + fq] = a + (fq > 0 ? x : y);
                bprev = bq;
            }
#pragma unroll
            for (int ks = 0; ks < 4; ++ks) {
                const f32x4 pa = s[2 * ks] * g0, pb = s[2 * ks + 1] * g0;
                const bf16x8 pf = mk8(pk2(pa[0], pa[1]), pk2(pa[2], pa[3]), pk2(pb[0], pb[1]), pk2(pb[2], pb[3]));
#pragma unroll
                for (int dt = 0; dt < 4; ++dt) {
                    const u32x2 v0 = *(const u32x2*)(sVt + (16 * dt + fr) * 136 + 32 * ks + 4 * fq);
                    const u32x2 v1 = *(const u32x2*)(sVt + (16 * dt + fr) * 136 + 32 * ks + 16 + 4 * fq);
                    tot[dt][qt] = MFMA16(mk8(v0.x, v0.y, v1.x, v1.y), pf, tot[dt][qt]);
                }
            }
            __builtin_amdgcn_sched_barrier(0);
        }
    }
#pragma unroll
    for (int qt = 0; qt < 2; ++qt) {
        bf16_t* op = (dry ? (bf16_t*)(P.ws + W_YX) + (size_t)(b * S + tq[qt]) * 1024 : ZA + (size_t)(b * S + tq[qt]) * ZW + C_Q) + head * 64 + 4 * fq;
#pragma unroll
        for (int dt = 0; dt < 4; ++dt) *(uint2*)(op + 16 * dt) = pk4(tot[dt][qt]);
    }
    __syncthreads();
    if (tid < 32) {
        const int t = t0 + tid, cur = t >> 6;
        for (int m = 0; m < 32; ++m) {
            const float v = ((sImp[(0 * 32 + tid) * 32 + m] + sImp[(1 * 32 + tid) * 32 + m]) + sImp[(2 * 32 + tid) * 32 + m]) + sImp[(3 * 32 + tid) * 32 + m];
            sImp[tid * 32 + m] = v;
        }
        unsigned sel = 0;
        for (int round = 0; round < 8; ++round) {
            float bv = -INFINITY; int bi = -1;
            for (int m = 0; m < 32; ++m) {
                if ((sel >> m) & 1u) continue;
                const bool forced = (m == 0) || (m == cur) || (m == cur - 1);
                const bool future = m * 64 > t;
                const float v = forced ? INFINITY : (future ? -INFINITY : sImp[tid * 32 + m]);
                if (v > bv) { bv = v; bi = m; }
            }
            if (bi < 0) break;
            sel |= 1u << bi;
        }
        sSel[tid] = sel;
        unsigned un = sel;
#pragma unroll
        for (int o = 16; o >= 1; o >>= 1) un |= __shfl_xor(un, o);
        if (tid == 0) sSel[32] = un;
    }
    __syncthreads();
    const unsigned uni = sSel[32];
    const int jmax = (t0 + 31) >> 6;
    {
        AttnAcc st; attn_init(st);
        const bf16_t* Kb = ZA + (size_t)(b * S) * ZW + C_KS + g * 64;
        const bf16_t* Vb = (const bf16_t*)(P.ws + W_VST) + (size_t)bg * 64 * S;
        unsigned rem = uni & ((2u << jmax) - 1u);
        u32x4 rk[2], rv[2];
        if (rem) { const int j0 = __builtin_ctz(rem); ld64(rk, Kb + (size_t)(j0 * 64) * ZW, ZW, tid); ld64(rv, Vb + j0 * 64, S, tid); }
#pragma unroll 1
        while (rem) {
            const int jb = __builtin_ctz(rem);
            rem &= rem - 1u;
            __syncthreads();
            st64(sK, rk, tid); st64(sVt, rv, tid);
            __syncthreads();
            if (rem) { const int jn = __builtin_ctz(rem); ld64(rk, Kb + (size_t)(jn * 64) * ZW, ZW, tid); ld64(rv, Vb + jn * 64, S, tid); }
            __builtin_amdgcn_sched_barrier(0);
            if (jb * 64 + 63 <= t0) {
                const float bo[2] = {((sSel[fr] >> jb) & 1u) ? 0.f : -INFINITY, ((sSel[16 + fr] >> jb) & 1u) ? 0.f : -INFINITY};
                attn_step_fast(sK, sVt, qf, st, bo, fr, fq);
            } else {
                MaskSel mf; mf.bit[0] = (sSel[fr] >> jb) & 1u; mf.bit[1] = (sSel[16 + fr] >> jb) & 1u; mf.t[0] = tq[0]; mf.t[1] = tq[1]; mf.k0 = jb * 64;
                attn_step(sK, sVt, 72, qf, st, mf, fr, fq);
            }
        }
        { LOAD_GATE(g1, 1) bf16_t* const op2[2] = {OUTP(0), OUTP(1)}; attn_fold_out(op2, st, g1); }
    }
    {
        AttnAcc st; attn_init(st);
        const bf16_t* Kb = ZA + (size_t)(b * S) * ZW + C_KW + g * 64;
        const bf16_t* Vb = (const bf16_t*)(P.ws + W_VWT) + (size_t)bg * 64 * S;
#pragma unroll
        for (int qt = 0; qt < 2; ++qt) {
            const int npad = 511 - tq[qt];
            if (npad > 0) { st.m[qt] = 0.f; st.l[qt] = (fq == 0) ? (float)npad : 0.f; }
        }
        int jlo = t0 - 511; jlo = jlo < 0 ? 0 : (jlo >> 6);
        u32x4 rk[2], rv[2];
        ld64(rk, Kb + (size_t)(jlo * 64) * ZW, ZW, tid); ld64(rv, Vb + jlo * 64, S, tid);
#pragma unroll 1
        for (int jb = jlo; jb <= jmax; ++jb) {
            __syncthreads();
            st64(sK, rk, tid); st64(sVt, rv, tid);
            __syncthreads();
            if (jb < jmax) { ld64(rk, Kb + (size_t)((jb + 1) * 64) * ZW, ZW, tid); ld64(rv, Vb + (jb + 1) * 64, S, tid); }
            __builtin_amdgcn_sched_barrier(0);
            if (jb * 64 + 63 <= t0 && jb * 64 > t0 + 31 - 512) {
                const float z2[2] = {0.f, 0.f};
                attn_step_fast(sK, sVt, qf, st, z2, fr, fq);
            } else {
                MaskWin mf; mf.t[0] = tq[0]; mf.t[1] = tq[1]; mf.k0 = jb * 64;
                attn_step(sK, sVt, 72, qf, st, mf, fr, fq);
            }
        }
        { LOAD_GATE(g2, 2) bf16_t* const op2[2] = {OUTP(0), OUTP(1)}; attn_fold_out(op2, st, g2); }
    }
}


#define XB_TMO      128
#define XB_XCNT(j)  (256  + 64 * (j))
#define XB_XSUB(j)  (1280 + 64 * (j))
#define XB_XGEN(j)  (2304 + 64 * (j))
#define XB_TOP      3328
#define XB_TOPGEN   3392
#define XCD_BAR_WORDS 3456
#define XB_SPIN_CAP (1u << 18)
#define LAS __attribute__((address_space(3)))
DEV unsigned xb_ld(unsigned* p) { return __hip_atomic_load(p, __ATOMIC_RELAXED, __HIP_MEMORY_SCOPE_AGENT); }
DEV unsigned xb_add(unsigned* p, unsigned v) { return __hip_atomic_fetch_add(p, v, __ATOMIC_RELAXED, __HIP_MEMORY_SCOPE_AGENT); }
DEV unsigned xb_xcc_id() { return (unsigned)__builtin_amdgcn_s_getreg((3 << 11) | 20) & 0xFu; }
#define XB_SPIN(cond, bar) do { unsigned _sp = 0; while (cond) { __builtin_amdgcn_s_sleep(1); \
    if ((++_sp & 255u) == 0u) { if (xb_ld(&(bar)[XB_TMO])) break; if (_sp > XB_SPIN_CAP) { atomicAdd(&(bar)[XB_TMO], 1u); break; } } } } while (0)
struct XcdBarrier { unsigned* bar; unsigned x; volatile LAS unsigned* st; };
DEV XcdBarrier xcd_barrier_post(unsigned* bar, volatile LAS unsigned* st) {
    XcdBarrier b; b.bar = bar; b.x = xb_xcc_id(); b.st = st;
    if (threadIdx.x == 0) (void)xb_add(&bar[XB_XCNT(b.x)], 1u);
    return b;
}
DEV void xcd_barrier_complete(unsigned* bar, unsigned x, unsigned& nloc, unsigned& nx) {
    const unsigned G = gridDim.x * gridDim.y * gridDim.z;
    unsigned sum, cnt, mine, sp = 0u;
    for (;;) {
        sum = 0u; cnt = 0u; mine = 0u;
#pragma unroll
        for (unsigned j = 0; j < 16; ++j) { const unsigned c = xb_ld(&bar[XB_XCNT(j)]); sum += c; cnt += (c > 0u) ? 1u : 0u; mine = (j == x) ? c : mine; }
        if (sum == G) break;
        __builtin_amdgcn_s_sleep(1);
        if ((++sp & 255u) == 0u) { if (xb_ld(&bar[XB_TMO])) break; if (sp > XB_SPIN_CAP) { atomicAdd(&bar[XB_TMO], 1u); break; } }
    }
    nloc = mine > 0u ? mine : 1u; nx = cnt > 0u ? cnt : 1u;
}
DEV void xcd_barrier(const XcdBarrier& b) {
    asm volatile("s_waitcnt vmcnt(0)" ::: "memory");
    __syncthreads();
    if (threadIdx.x == 0) {
        unsigned* bar = b.bar;
        __builtin_amdgcn_s_waitcnt(0);
        unsigned nloc = b.st[0], nx = b.st[1];
        if (nloc == 0u) { xcd_barrier_complete(bar, b.x, nloc, nx); b.st[0] = nloc; b.st[1] = nx; }
        const unsigned old = xb_add(&bar[XB_XSUB(b.x)], 1u);
        const unsigned gen = old / nloc;
        if (old + 1u == (gen + 1u) * nloc) {
            __builtin_amdgcn_fence(__ATOMIC_RELEASE, "agent");
            asm volatile("s_waitcnt vmcnt(0)" ::: "memory");
            const unsigned og = xb_add(&bar[XB_TOP], 1u);
            const unsigned tg = og / nx;
            if (og + 1u == (tg + 1u) * nx) xb_add(&bar[XB_TOPGEN], 1u);
            else XB_SPIN(xb_ld(&bar[XB_TOPGEN]) == tg, bar);
            __builtin_amdgcn_fence(__ATOMIC_ACQUIRE, "agent");
            xb_add(&bar[XB_XGEN(b.x)], 1u);
            asm volatile("s_waitcnt vmcnt(0)" ::: "memory");
        } else {
            XB_SPIN(xb_ld(&bar[XB_XGEN(b.x)]) == gen, bar);
            __builtin_amdgcn_fence(__ATOMIC_ACQUIRE, "agent");
            asm volatile("s_waitcnt vmcnt(0)" ::: "memory");
        }
    }
    __syncthreads();
}
constexpr size_t W_BAR = 252 * MiB;

constexpr int NPHASE = 11;
constexpr int SMEM_BYTES = 55296;

template <int PH, bool DRY = false>
DEV void run_phase(const Params& P, char* smem) {
    const int nb = gridDim.x, bid = blockIdx.x;
    char* aux = (char*)P.out;
    char* ws = P.ws;
    bf16_t* ZA = (bf16_t*)(ws + W_ZA);
    if (PH == 0) {
        for (int job = bid; job < 4800 + 4096 + 512 + 64; job += nb) {
            int j = job;
            if (j < 4800) {
                bool done = false;
#define TR(SRC, LD, DSTOFF, KK, NN, MAP)                                                                                       \
    if (!done) { const int nrt = (NN) / 64, nt = nrt * ((KK) / 64);                                                              \
        if (j < nt) { transpose_tile((SRC), (LD), (bf16_t*)(aux + (DSTOFF)), (KK), (j % nrt) * 64, (j / nrt) * 64, (MAP), smem); done = true; } else j -= nt; }
                TR(P.w_in, 7984, O_WTA, 1024, 4992, 1)
                TR(P.w_in, 7984, O_WTB, 1024, 3072, 2)
                TR(P.w_up, 4096, O_WTUP, 1024, 4096, 0)
                TR(P.w_down, 1024, O_WTDN, 4096, 1024, 0)
                TR(P.w_o, 1024, O_WTO, 1024, 1024, 0)
                TR(P.w_xo, 1024, O_WTXO, 256, 1024, 0)
                TR(P.w_mkv, 512, O_WTMKV, 1024, 512, 0)
                TR(P.wk1, 256, O_WTCK1, 2048, 256, 0)
                TR(P.wv1, 256, O_WTCV1, 2048, 256, 0)
#undef TR
                if (!done) {
                    if (j < 16) transpose_tile(P.w_a + j * 4096, 64, (bf16_t*)(aux + O_WAT) + j * 4096, 64, 0, 0, 0, smem);
                    else { j -= 16; transpose_tile(P.w_i + j * 4096, 64, (bf16_t*)(aux + O_WIT) + j * 4096, 64, 0, 0, 0, smem); }
                }
                continue;
            }
            j -= 4800;
            if (j < 4096) { rownorm<false>(P.x, P.g_mix, (bf16_t*)(ws + W_U), nullptr, j * 4 + (threadIdx.x >> 6)); continue; }
            j -= 4096;
            if (j < 512) { rownorm<false>(P.mem, P.g_mem, (bf16_t*)(aux + O_MEMN), nullptr, j * 4 + (threadIdx.x >> 6)); continue; }
            j -= 512;
            rope_job((float*)(aux + O_ROPEC), (float*)(aux + O_ROPES), j);
        }
    } else if (PH == 1) {
        const int nA = tile_count(39);
        for (int job = bid; job < 32 + nA; job += nb) {
            if (job < 32) {
                ALPlain al; al.A = (const bf16_t*)(aux + O_MEMN); al.lda = 1024;
                const int pm = job & 7, pn = job >> 3;
                if (pn < 2) { EpiMemKV<true> ep{(bf16_t*)(aux + O_MEMK), (bf16_t*)(aux + O_MEMVT)}; gemm_tile<8, 4, true>(al, (const bf16_t*)(aux + O_WTMKV), 1024, 1024, pm, pn, ep, smem); }
                else { EpiMemKV<false> ep{(bf16_t*)(aux + O_MEMK), (bf16_t*)(aux + O_MEMVT)}; gemm_tile<8, 4, false>(al, (const bf16_t*)(aux + O_WTMKV), 1024, 1024, pm, pn, ep, smem); }
            } else {
                int pm, pn;
                if (!tile_map(job - 32, 39, pm, pn)) continue;
                ALPlain al; al.A = (const bf16_t*)(ws + W_U); al.lda = 1024;
                if (pn < 35) { EpiZA<true> ep{ZA, (bf16_t*)(ws + W_VST), (bf16_t*)(ws + W_VWT), (const float*)(aux + O_ROPEC), (const float*)(aux + O_ROPES)};
                    gemm_tile<8, 4, true>(al, (const bf16_t*)(aux + O_WTA), 1024, 1024, pm, pn, ep, smem); }
                else { EpiZA<false> ep{ZA, (bf16_t*)(ws + W_VST), (bf16_t*)(ws + W_VWT), (const float*)(aux + O_ROPEC), (const float*)(aux + O_ROPES)};
                    gemm_tile<8, 4, false>(al, (const bf16_t*)(aux + O_WTA), 1024, 1024, pm, pn, ep, smem); }
            }
        }
    } else if (PH == 2) {
        for (int job = bid; job < 1280; job += nb) {
            if (job < 128) {
                const int j = job, which = j >> 6, pm = (j & 63) >> 1, pn = j & 1;
                float* sPos = (float*)(smem + 36864);
                __syncthreads();
                { const float* pg = which ? P.cpv : P.cpk; const int t8 = threadIdx.x * 8; *(float4*)(sPos + t8) = *(const float4*)(pg + t8); *(float4*)(sPos + t8 + 4) = *(const float4*)(pg + t8 + 4); }
                ALCmp al; al.ZA = ZA; al.spos = sPos; al.colbase = which ? C_VC : C_KC;
                EpiHid ep{(bf16_t*)(aux + (which ? O_HIDV : O_HIDK))};
                gemm_tile<4, 4, true>(al, (const bf16_t*)(aux + (which ? O_WTCV1 : O_WTCK1)), 2048, 2048, pm, pn, ep, smem);
            } else if (job < 640) rnn_job(P, job - 128, smem, DRY);
            else if (job < 1024) xattn_job(P, job - 640, smem, DRY);
            else if (job >= 1152) xattn_job(P, job - 1152 + 384, smem, DRY);
        }
    } else if (PH == 3) {
        for (int job = bid; job < 2032; job += nb) cmp2_job(P, job);
    } else if (PH == 4) {
        for (int job = bid; job < 2048 + 512; job += nb) {
            if (job < 2048) nsa_job(P, job, smem, DRY);
            else if (!DRY) {
                int pm, pn;
                if (!tile_map(job - 2048, 8, pm, pn)) continue;
                ALPlain al; al.A = ZA + C_QX; al.lda = ZW;
                EpiBf<0> ep{(bf16_t*)(ws + W_YX), 1024};
                gemm_tile<8, 4, true>(al, (const bf16_t*)(aux + O_WTXO), 256, 256, pm, pn, ep, smem);
            }
        }
    } else if (PH == 5) {
        for (int job = bid; job < tile_count(32); job += nb) {
            int pm, pn;
            if (!tile_map(job, 32, pm, pn)) continue;
            ALPlain al; al.A = (const bf16_t*)(ws + W_U); al.lda = 1024;
            EpiMerge ep{ZA, (const bf16_t*)(ws + W_YX), (bf16_t*)(ws + W_Y)};
            gemm_tile<8, 3, true>(al, (const bf16_t*)(aux + O_WTB), 1024, 1024, pm, pn, ep, smem);
        }
    } else if (PH == 6) {
        for (int job = bid; job < tile_count(8); job += nb) {
            int pm, pn;
            if (!tile_map(job, 8, pm, pn)) continue;
            ALPlain al; al.A = (const bf16_t*)(ws + W_Y); al.lda = 1024;
            EpiRes ep{P.x, (float*)(ws + W_H)};
            gemm_tile<8, 4, true>(al, (const bf16_t*)(aux + O_WTO), 1024, 1024, pm, pn, ep, smem);
        }
    } else if (PH == 7) {
        for (int job = bid; job < 4096; job += nb) rownorm<false>((const float*)(ws + W_H), P.g_mlp, (bf16_t*)(ws + W_VN), nullptr, job * 4 + (threadIdx.x >> 6));
    } else if (PH == 8) {
        for (int job = bid; job < tile_count(32); job += nb) {
            int pm, pn;
            if (!tile_map(job, 32, pm, pn)) continue;
            ALPlain al; al.A = (const bf16_t*)(ws + W_VN); al.lda = 1024;
            EpiBf<1> ep{(bf16_t*)(ws + W_HID), 4096};
            gemm_tile<8, 4, true>(al, (const bf16_t*)(aux + O_WTUP), 1024, 1024, pm, pn, ep, smem);
        }
    } else if (PH == 9) {
        for (int job = bid; job < tile_count(8); job += nb) {
            int pm, pn;
            if (!tile_map(job, 8, pm, pn)) continue;
            ALPlain al; al.A = (const bf16_t*)(ws + W_HID); al.lda = 4096;
            EpiRes ep{(const float*)(ws + W_H), (float*)(ws + W_H)};
            gemm_tile<8, 4, true>(al, (const bf16_t*)(aux + O_WTDN), 4096, 4096, pm, pn, ep, smem);
        }
    } else if (PH == 10) {
        for (int job = bid; job < 4096; job += nb) rownorm<true>((const float*)(ws + W_H), P.g_final, nullptr, P.out, job * 4 + (threadIdx.x >> 6));
    }
}

#if MULTI
template <int PH>
__global__ void __launch_bounds__(256, 2) phase_kernel(Params P) {
    __shared__ __attribute__((aligned(16))) char smem[SMEM_BYTES];
    run_phase<PH>(P, smem);
}
#else
__global__ void __launch_bounds__(256, 2) mega_kernel(Params P) {
    __shared__ __attribute__((aligned(16))) char smem[SMEM_BYTES];
    cg::grid_group grid = cg::this_grid();
    __shared__ uint4 xb_words;
    if (threadIdx.x == 0) xb_words = make_uint4(0u, 0u, 0u, 0u);
    __syncthreads();
    XcdBarrier xb = xcd_barrier_post((unsigned*)(P.ws + W_BAR), (volatile LAS unsigned*)&xb_words);
    if (P.ws == nullptr) grid.sync();
#ifndef REP
#define REP -1
#endif
#define GSYNC() xcd_barrier(xb)
#define PHASE(k) { if (REP == k && k != 9) { run_phase<k, true>(P, smem); GSYNC(); } run_phase<k>(P, smem); GSYNC(); }
    PHASE(0) PHASE(1) PHASE(2) PHASE(3) PHASE(4) PHASE(5) PHASE(6) PHASE(7) PHASE(8) PHASE(9)
    if (REP == 10) { run_phase<10>(P, smem); GSYNC(); }
    if (REP == 11) { GSYNC(); GSYNC(); GSYNC(); GSYNC(); GSYNC(); GSYNC(); GSYNC(); GSYNC(); GSYNC(); GSYNC(); }
    run_phase<10>(P, smem);
}
#endif

extern "C" void kernel_launch(void* const* d_in, const int* in_sizes, int n_in, void* d_out, int out_size, void* d_ws, size_t ws_size,
                              hipStream_t stream) {
    Params P{};
    const float** pp = (const float**)&P;
    for (int i = 0; i < 25; ++i) pp[i] = (const float*)d_in[i];
    P.out = (float*)d_out;
    P.ws = (char*)d_ws;
#if MULTI
    const int G = 1024;
    phase_kernel<0><<<G, 256, 0, stream>>>(P);
    phase_kernel<1><<<G, 256, 0, stream>>>(P);
    phase_kernel<2><<<G, 256, 0, stream>>>(P);
    phase_kernel<3><<<G, 256, 0, stream>>>(P);
    phase_kernel<4><<<G, 256, 0, stream>>>(P);
    phase_kernel<5><<<G, 256, 0, stream>>>(P);
    phase_kernel<6><<<G, 256, 0, stream>>>(P);
    phase_kernel<7><<<G, 256, 0, stream>>>(P);
    phase_kernel<8><<<G, 256, 0, stream>>>(P);
    phase_kernel<9><<<G, 256, 0, stream>>>(P);
    phase_kernel<10><<<G, 256, 0, stream>>>(P);
#else
    static int grid_blocks = 0;
    if (!grid_blocks) {
        int dev = 0, cus = 0, per_cu = 0;
        hipGetDevice(&dev);
        hipDeviceGetAttribute(&cus, hipDeviceAttributeMultiprocessorCount, dev);
        hipOccupancyMaxActiveBlocksPerMultiprocessor(&per_cu, mega_kernel, 256, 0);
        if (per_cu > 2) per_cu = 2;
        if (per_cu < 1) per_cu = 1;
        grid_blocks = cus * per_cu;
    }
    hipMemsetAsync((char*)d_ws + W_BAR, 0, XCD_BAR_WORDS * 4, stream);
    void* args[] = {&P};
    hipError_t e = hipLaunchCooperativeKernel((void*)mega_kernel, dim3(grid_blocks), dim3(256), args, 0, stream);
    if (e != hipSuccess) fprintf(stderr, "cooperative launch failed: %s (grid %d)\n", hipGetErrorString(e), grid_blocks);
#endif
}
```

```cpp
#include <hip/hip_runtime.h>
#include <hip/hip_cooperative_groups.h>
#include <cstdint>
#include <cstdio>
namespace cg = cooperative_groups;

#ifndef MULTI
#define MULTI 0
#endif

typedef unsigned short bf16_t;
typedef short bf16x8 __attribute__((ext_vector_type(8)));
typedef float f32x4 __attribute__((ext_vector_type(4)));
typedef __bf16 bfv2 __attribute__((ext_vector_type(2)));
typedef float f32x2 __attribute__((ext_vector_type(2)));
typedef unsigned u32x4 __attribute__((ext_vector_type(4)));
typedef unsigned u32x2 __attribute__((ext_vector_type(2)));
#define DEV __device__ __forceinline__
DEV int opaque_tid() { int t = threadIdx.x; asm volatile("" : "+v"(t)); return t; }
#define MFMA16(a, b, c) __builtin_amdgcn_mfma_f32_16x16x32_bf16((a), (b), (c), 0, 0, 0)

constexpr int T = 16384, S = 2048;
constexpr int ZW = 4480;
constexpr int C_Q = 0, C_KC = 1024, C_VC = 1280, C_KS = 1536, C_KW = 1792, C_XR = 2048, C_GR = 3072, C_QX = 4096, C_G = 4352;
constexpr int NCMP = 127;
constexpr int NCROWS = 4064;

constexpr size_t O_WTA = 0;
constexpr size_t O_WTB = O_WTA + (size_t)4992 * 1024 * 2;
constexpr size_t O_WTUP = O_WTB + (size_t)3072 * 1024 * 2;
constexpr size_t O_WTDN = O_WTUP + (size_t)4096 * 1024 * 2;
constexpr size_t O_WTO = O_WTDN + (size_t)4096 * 1024 * 2;
constexpr size_t O_WTXO = O_WTO + (size_t)1024 * 1024 * 2;
constexpr size_t O_WTMKV = O_WTXO + (size_t)1024 * 256 * 2;
constexpr size_t O_WTCK1 = O_WTMKV + (size_t)512 * 1024 * 2;
constexpr size_t O_WTCV1 = O_WTCK1 + (size_t)256 * 2048 * 2;
constexpr size_t O_WAT = O_WTCV1 + (size_t)256 * 2048 * 2;
constexpr size_t O_WIT = O_WAT + (size_t)16 * 64 * 64 * 2;
constexpr size_t O_ROPEC = O_WIT + (size_t)16 * 64 * 64 * 2;
constexpr size_t O_ROPES = O_ROPEC + (size_t)2048 * 8 * 4;
constexpr size_t O_MEMN = O_ROPES + (size_t)2048 * 8 * 4;
constexpr size_t O_MEMK = O_MEMN + (size_t)2048 * 1024 * 2;
constexpr size_t O_MEMVT = O_MEMK + (size_t)2048 * 256 * 2;
constexpr size_t O_HIDK = O_MEMVT + (size_t)2048 * 256 * 2;
constexpr size_t O_HIDV = O_HIDK + (size_t)4096 * 256 * 2;
constexpr size_t O_KC = O_HIDV + (size_t)4096 * 256 * 2;
constexpr size_t O_VCT = O_KC + (size_t)32 * 128 * 64 * 2;
constexpr size_t O_AUX_END = O_VCT + (size_t)32 * 64 * 128 * 2;
static_assert(O_AUX_END <= (size_t)64 << 20, "aux overflow");
constexpr size_t MiB = (size_t)1 << 20;
constexpr size_t W_U = 0, W_ZA = 32 * MiB, W_VST = 172 * MiB, W_VWT = 180 * MiB, W_YX = 188 * MiB, W_Y = 220 * MiB;
constexpr size_t W_H = 32 * MiB, W_VN = 0, W_HID = 96 * MiB;

struct Params {
    const float *x, *mem, *g_mix, *w_in, *cpk, *cpv, *wk1, *wk2, *wv1, *wv2, *conv_w, *conv_b, *w_a, *b_a, *w_i, *b_i, *lam,
        *g_mem, *w_mkv, *w_xo, *w_o, *g_mlp, *w_up, *w_down, *g_final;
    float* out;
    char* ws;
};

DEV float bf2f(bf16_t h) { return __uint_as_float(((unsigned)h) << 16); }
DEV unsigned pk2(float lo, float hi) { f32x2 v = {lo, hi}; bfv2 b = __builtin_convertvector(v, bfv2); return __builtin_bit_cast(unsigned, b); }
DEV bf16_t f2bf(float f) { return (bf16_t)(pk2(f, 0.f) & 0xffffu); }
DEV float lo_f(unsigned u) { return __uint_as_float(u << 16); }
DEV float hi_f(unsigned u) { return __uint_as_float(u & 0xffff0000u); }
DEV float sigm(float x) { return __builtin_amdgcn_rcpf(1.f + __expf(-x)); }
DEV float gelu_t(float x) {
    float y = 0.7978845608028654f * (x + 0.044715f * x * x * x);
    float e = __expf(2.f * y);
    float th = 1.f - 2.f * __builtin_amdgcn_rcpf(1.f + e);
    return 0.5f * x * (1.f + th);
}
DEV float wave_sum(float v) {
#pragma unroll
    for (int o = 32; o >= 1; o >>= 1) v += __shfl_xor(v, o);
    return v;
}

DEV int map_col(int mapid, int r) {
    if (mapid == 0) return r;
    if (mapid == 1) {
        if (r < 1536) return r;
        if (r < 1792) return 1536 + (r - 1536);
        if (r < 2048) return 2048 + (r - 1792);
        if (r < 3072) return 2608 + (r - 2048);
        if (r < 4096) return 3632 + (r - 3072);
        if (r < 4352) return 4656 + (r - 4096);
        if (r < 4400) return 2560 + (r - 4352);
        if (r < 4480) return -1;
        if (r < 4736) return 1792 + (r - 4480);
        return 2304 + (r - 4736);
    }
    int pn = r / 96, rem = r - pn * 96, wc = rem / 48, rem2 = rem - wc * 48, gidx = rem2 >> 4, cc = rem2 & 15;
    return 4912 + gidx * 1024 + pn * 32 + wc * 16 + cc;
}

DEV void transpose_tile(const float* __restrict__ src, int ld, bf16_t* __restrict__ dst, int K, int r0, int k0, int mapid, char* smem, int nblk = 0) {
    float* sm = (float*)smem;
    const int tid = threadIdx.x, lane = tid & 63, w = tid >> 6;
    __syncthreads();
    const int sc = map_col(mapid, r0 + lane);
#pragma unroll
    for (int i = 0; i < 16; ++i) {
        int kk = w + 4 * i;
        float v = sc >= 0 ? src[(size_t)(k0 + kk) * ld + sc] : 0.f;
        sm[kk * 65 + lane] = v;
    }
    __syncthreads();
    const int rr = tid >> 2, kq = (tid & 3) * 16;
    unsigned o[8];
#pragma unroll
    for (int e = 0; e < 8; ++e) o[e] = pk2(sm[(kq + 2 * e) * 65 + rr], sm[(kq + 2 * e + 1) * 65 + rr]);
    uint4* dp = nblk ? (uint4*)(dst + (size_t)(k0 >> 6) * nblk * 64 + (size_t)(r0 + rr) * 64 + kq) : (uint4*)(dst + (size_t)(r0 + rr) * K + k0 + kq);
    dp[0] = make_uint4(o[0], o[1], o[2], o[3]);
    dp[1] = make_uint4(o[4], o[5], o[6], o[7]);
}

template <bool OUTF32>
DEV void rownorm(const float* __restrict__ src, const float* __restrict__ g, bf16_t* dstb, float* dstf, int row, bool blk = false) {
    const int lane = threadIdx.x & 63;
    const float4* sp = (const float4*)(src + (size_t)row * 1024);
    float4 v[4];
    float ss = 0.f;
#pragma unroll
    for (int i = 0; i < 4; ++i) { v[i] = sp[lane + 64 * i]; ss += v[i].x * v[i].x + v[i].y * v[i].y + v[i].z * v[i].z + v[i].w * v[i].w; }
    ss = wave_sum(ss);
    const float r = rsqrtf(ss * (1.0f / 1024.0f) + 1e-6f);
#pragma unroll
    for (int i = 0; i < 4; ++i) {
        float4 gg = ((const float4*)g)[lane + 64 * i];
        float a = v[i].x * r * gg.x, b = v[i].y * r * gg.y, c = v[i].z * r * gg.z, d = v[i].w * r * gg.w;
        if (OUTF32) ((float4*)(dstf + (size_t)row * 1024))[lane + 64 * i] = make_float4(a, b, c, d);
        else if (blk) { const int col = 4 * (lane + 64 * i); *(uint2*)(dstb + (size_t)(col >> 6) * ((size_t)16384 * 64) + (size_t)row * 64 + (col & 63)) = make_uint2(pk2(a, b), pk2(c, d)); }
        else ((uint2*)(dstb + (size_t)row * 1024))[lane + 64 * i] = make_uint2(pk2(a, b), pk2(c, d));
    }
}

DEV void rope_job(float* ct, float* st, int job) {
    const int e = job * 256 + threadIdx.x;
    const int pos = e >> 3, i = e & 7;
    const double inv = exp(-(double)i * 0.125 * 13.122363377404328);
    const double ang = (double)pos * inv;
    const double kq = rint(ang * 0.6366197723675814);
    const double r = ang - kq * 1.5707963267948966;
    const double r2 = r * r;
    const double sn = r * (1.0 + r2 * (-1.0 / 6 + r2 * (1.0 / 120 + r2 * (-1.0 / 5040 + r2 * (1.0 / 362880 + r2 * (-1.0 / 39916800 + r2 * (1.0 / 6227020800.0)))))));
    const double cs = 1.0 + r2 * (-0.5 + r2 * (1.0 / 24 + r2 * (-1.0 / 720 + r2 * (1.0 / 40320 + r2 * (-1.0 / 3628800 + r2 * (1.0 / 479001600.0))))));
    const int q = ((int)kq) & 3;
    double s_, c_;
    if (q == 0) { s_ = sn; c_ = cs; } else if (q == 1) { s_ = cs; c_ = -sn; } else if (q == 2) { s_ = -sn; c_ = -cs; } else { s_ = -cs; c_ = sn; }
    ct[e] = (float)c_; st[e] = (float)s_;
}

struct ALPlain {
    const bf16_t* A; int lda; int ks;
    const char* base; unsigned off0;
    DEV void init(int row0, int lrow, int lk) { base = (const char*)(A + (size_t)row0 * lda); off0 = (unsigned)(lrow * lda + lk) * 2u; }
    DEV u32x4 load(int i, int k0) const { return *(const u32x4*)(base + (off0 + (unsigned)(i * 64 * lda) + (unsigned)(k0 >> 6) * (unsigned)(ks * 2))); }
    DEV u32x4 fix(int, const u32x4& v, int) const { return v; }
};
struct ALCmp {
    const bf16_t* ZA; const float* spos; int colbase;
    unsigned roff[4]; int lk_;
    DEV void init(int row0, int lrow, int lk) {
        lk_ = lk;
#pragma unroll
        for (int i = 0; i < 4; ++i) {
            const int row = row0 + lrow + 32 * i;
            const int bg = row / NCMP, n = row - bg * NCMP, b = bg >> 2, g = bg & 3;
            roff[i] = row < NCROWS ? (unsigned)(((b * S + 16 * n) * ZW + colbase + g * 64 + lk) * 2) : 0xffffffffu;
        }
    }
    DEV u32x4 load(int i, int k0) const {
        if (roff[i] == 0xffffffffu) return (u32x4){0u, 0u, 0u, 0u};
        return *(const u32x4*)((const char*)ZA + (roff[i] + (unsigned)((k0 >> 6) * ZW * 2)));
    }
    DEV u32x4 fix(int i, const u32x4& v, int k0) const {
        if (roff[i] == 0xffffffffu) return v;
        const float4 p0 = *(const float4*)(spos + k0 + lk_), p1 = *(const float4*)(spos + k0 + lk_ + 4);
        u32x4 o;
        o.x = pk2(lo_f(v.x) + p0.x, hi_f(v.x) + p0.y); o.y = pk2(lo_f(v.y) + p0.z, hi_f(v.y) + p0.w);
        o.z = pk2(lo_f(v.z) + p1.x, hi_f(v.z) + p1.y); o.w = pk2(lo_f(v.w) + p1.z, hi_f(v.w) + p1.w);
        return o;
    }
};

template <int TM, int TN, bool SWAP, class AL, class EP>
DEV void gemm_tile(AL al, const bf16_t* __restrict__ Bt, int ldb, int bks, int K, int pm, int pn, const EP& ep, char* smem) {
    constexpr int BM = TM * 32, BN = TN * 32, NA = TM, NBB = TN;
    bf16_t* sA = (bf16_t*)smem;
    bf16_t* sB = sA + BM * 72;
    const int tid = opaque_tid(), wid = tid >> 6, lane = tid & 63, wr = wid >> 1, wc = wid & 1, fr = lane & 15, fq = lane >> 4;
    f32x4 acc[TM][TN];
#pragma unroll
    for (int m = 0; m < TM; ++m)
#pragma unroll
        for (int n = 0; n < TN; ++n) acc[m][n] = (f32x4){0.f, 0.f, 0.f, 0.f};
    const int lrow = tid >> 3, lk = (tid & 7) * 8;
    u32x4 ra[NA], rb[NBB];
    al.init(pm * BM, lrow, lk);
    const char* bbase = (const char*)(Bt + (size_t)(pn * BN) * ldb);
    const unsigned boff = (unsigned)(lrow * ldb + lk) * 2u;
#pragma unroll
    for (int i = 0; i < NA; ++i) ra[i] = al.load(i, 0);
#pragma unroll
    for (int i = 0; i < NBB; ++i) rb[i] = *(const u32x4*)(bbase + (boff + (unsigned)(i * 64 * ldb)));
    int nk = K >> 6;
    asm volatile("" : "+s"(nk));
    bf16_t* sWa = sA + lrow * 72 + lk;
    bf16_t* sWb = sB + lrow * 72 + lk;
    const bf16_t* sAr = sA + (wr * TM * 16 + fr) * 72 + fq * 8;
    const bf16_t* sBr = sB + (wc * TN * 16 + fr) * 72 + fq * 8;
#pragma unroll 1
    for (int kt = 0; kt < nk; ++kt) {
        __syncthreads();
#pragma unroll
        for (int i = 0; i < NA; ++i) *(u32x4*)(sWa + (32 * i) * 72) = al.fix(i, ra[i], kt * 64);
#pragma unroll
        for (int i = 0; i < NBB; ++i) *(u32x4*)(sWb + (32 * i) * 72) = rb[i];
        __syncthreads();
        if (kt + 1 < nk) {
            const int k0 = (kt + 1) * 64;
#pragma unroll
            for (int i = 0; i < NA; ++i) ra[i] = al.load(i, k0);
#pragma unroll
            for (int i = 0; i < NBB; ++i) rb[i] = *(const u32x4*)(bbase + (boff + (unsigned)(i * 64 * ldb) + (unsigned)(k0 >> 6) * (unsigned)(bks * 2)));
        }
        __builtin_amdgcn_sched_barrier(0);
        __builtin_amdgcn_s_setprio(1);
#pragma unroll
        for (int ks = 0; ks < 2; ++ks) {
            bf16x8 bfr[TN];
#pragma unroll
            for (int n = 0; n < TN; ++n) bfr[n] = *(const bf16x8*)(sBr + (n * 16) * 72 + ks * 32);
#pragma unroll
            for (int m = 0; m < TM; ++m) {
                const bf16x8 af = *(const bf16x8*)(sAr + (m * 16) * 72 + ks * 32);
#pragma unroll
                for (int n = 0; n < TN; ++n) acc[m][n] = SWAP ? MFMA16(bfr[n], af, acc[m][n]) : MFMA16(af, bfr[n], acc[m][n]);
            }
        }
        __builtin_amdgcn_s_setprio(0);
    }
    ep.run(acc, pm * BM + wr * TM * 16, pn * BN + wc * TN * 16, fr, fq);
}

DEV uint2 pk4(const f32x4& a) { return make_uint2(pk2(a[0], a[1]), pk2(a[2], a[3])); }

template <bool SWAP>
struct EpiZA {
    bf16_t *ZA, *VST, *VWT; const float *ropec, *ropes;
    DEV void run(f32x4 (&acc)[8][4], int R0, int C0, int fr, int fq) const {
#pragma unroll
        for (int n = 0; n < 4; ++n) {
            const int col0 = C0 + n * 16;
#pragma unroll
            for (int m = 0; m < 8; ++m) {
                f32x4 a = acc[m][n];
                if (!SWAP) {
                    const int r = R0 + m * 16 + 4 * fq;
                    int c = col0 - 4480 + fr;
                    bf16_t* dst = (c < 256) ? VST : VWT;
                    c &= 255;
                    const int g = c >> 6, d = c & 63, b = r >> 11, t = r & 2047;
                    *(uint2*)(dst + ((size_t)((b * 4 + g) * 64 + d)) * S + t) = pk4(a);
                } else {
                    const int row = R0 + m * 16 + fr;
                    const bool rope = (col0 < 1024 || (col0 >= 1536 && col0 < 2048)) && ((col0 & 63) == 0);
                    if (rope) {
                        const int t = row & 2047, i0 = 4 * (fq & 1);
                        const float4 cs = *(const float4*)(ropec + t * 8 + i0), sn = *(const float4*)(ropes + t * 8 + i0);
                        const float c4[4] = {cs.x, cs.y, cs.z, cs.w}, s4[4] = {sn.x, sn.y, sn.z, sn.w};
#pragma unroll
                        for (int j = 0; j < 4; ++j) {
                            const float pr = __shfl_xor(a[j], 32);
                            a[j] = (fq & 2) ? (a[j] * c4[j] + pr * s4[j]) : (a[j] * c4[j] - pr * s4[j]);
                        }
                    }
                    if (col0 >= C_G) {
#pragma unroll
                        for (int j = 0; j < 4; ++j) a[j] = sigm(a[j]);
                    }
                    *(uint2*)(ZA + (size_t)row * ZW + col0 + 4 * fq) = pk4(a);
                }
            }
        }
    }
};
template <bool SWAP>
struct EpiMemKV {
    bf16_t *MK, *MVT;
    DEV void run(f32x4 (&acc)[8][4], int R0, int C0, int fr, int fq) const {
#pragma unroll
        for (int n = 0; n < 4; ++n)
#pragma unroll
            for (int m = 0; m < 8; ++m) {
                if (SWAP) {
                    const int c = C0 + n * 16 + 4 * fq, r = R0 + m * 16 + fr;
                    const int h = (c >> 6) & 3, d = c & 63, b = r >> 8, mm = r & 255;
                    *(uint2*)(MK + ((size_t)(b * 4 + h) * 256 + mm) * 64 + d) = pk4(acc[m][n]);
                } else {
                    const int c = C0 + n * 16 + fr, r = R0 + m * 16 + 4 * fq;
                    const int h = (c >> 6) & 3, d = c & 63, b = r >> 8, mm = r & 255;
                    *(uint2*)(MVT + ((size_t)(b * 4 + h) * 64 + d) * 256 + mm) = pk4(acc[m][n]);
                }
            }
    }
};
struct EpiHid {
    bf16_t* H;
    DEV void run(f32x4 (&acc)[4][4], int R0, int C0, int fr, int fq) const {
#pragma unroll
        for (int n = 0; n < 4; ++n)
#pragma unroll
            for (int m = 0; m < 4; ++m) {
                const int c = C0 + n * 16 + 4 * fq, r = R0 + m * 16 + fr;
                f32x4 a = acc[m][n];
#pragma unroll
                for (int j = 0; j < 4; ++j) a[j] = gelu_t(a[j]);
                if (r < NCROWS) *(uint2*)(H + (size_t)r * 256 + c) = pk4(a);
            }
    }
};
template <int ACT>
struct EpiBf {
    bf16_t* O; int ldo;
    DEV void run(f32x4 (&acc)[8][4], int R0, int C0, int fr, int fq) const {
#pragma unroll
        for (int n = 0; n < 4; ++n)
#pragma unroll
            for (int m = 0; m < 8; ++m) {
                const int c = C0 + n * 16 + 4 * fq, r = R0 + m * 16 + fr;
                f32x4 a = acc[m][n];
                if (ACT == 1) {
#pragma unroll
                    for (int j = 0; j < 4; ++j) { const float v = fmaxf(a[j], 0.f); a[j] = v * v; }
                }
                if (ACT == 1) *(uint2*)(O + (size_t)(c >> 6) * ((size_t)16384 * 64) + (size_t)r * 64 + (c & 63)) = pk4(a);
                else *(uint2*)(O + (size_t)r * ldo + c) = pk4(a);
            }
    }
};
struct EpiRes {
    const float* R; float* O;
    DEV void run(f32x4 (&acc)[8][4], int R0, int C0, int fr, int fq) const {
#pragma unroll
        for (int n = 0; n < 4; ++n)
#pragma unroll
            for (int m = 0; m < 8; ++m) {
                const size_t o = (size_t)(R0 + m * 16 + fr) * 1024 + C0 + n * 16 + 4 * fq;
                const f32x4 r = *(const f32x4*)(R + o);
                *(f32x4*)(O + o) = r + acc[m][n];
            }
    }
};
struct EpiMerge {
    const bf16_t *ZA, *YX; bf16_t* Y;
    DEV void run(f32x4 (&acc)[8][3], int R0, int C0, int fr, int fq) const {
        const int ch = (C0 / 48) * 16 + 4 * fq;
#pragma unroll
        for (int m = 0; m < 8; ++m) {
            const size_t row = (size_t)(R0 + m * 16 + fr);
            const uint2 a = *(const uint2*)(ZA + row * ZW + C_Q + ch), b = *(const uint2*)(ZA + row * ZW + C_GR + ch), c = *(const uint2*)(YX + row * 1024 + ch);
            f32x4 y;
            y[0] = sigm(acc[m][0][0]) * lo_f(a.x) + sigm(acc[m][1][0]) * lo_f(b.x) + sigm(acc[m][2][0]) * lo_f(c.x);
            y[1] = sigm(acc[m][0][1]) * hi_f(a.x) + sigm(acc[m][1][1]) * hi_f(b.x) + sigm(acc[m][2][1]) * hi_f(c.x);
            y[2] = sigm(acc[m][0][2]) * lo_f(a.y) + sigm(acc[m][1][2]) * lo_f(b.y) + sigm(acc[m][2][2]) * lo_f(c.y);
            y[3] = sigm(acc[m][0][3]) * hi_f(a.y) + sigm(acc[m][1][3]) * hi_f(b.y) + sigm(acc[m][2][3]) * hi_f(c.y);
            *(uint2*)(Y + (size_t)(ch >> 6) * ((size_t)16384 * 64) + row * 64 + (ch & 63)) = pk4(y);
        }
    }
};

DEV bool tile_map(int idx, int NT, int& pm, int& pn) {
    const int x = idx & 7, pl = (idx >> 3) & 7, pmid = (idx >> 6) & 7, st = idx >> 9;
    pm = pmid * 8 + x;
    pn = st * 8 + pl;
    return pn < NT;
}
DEV int tile_count(int NT) { return ((NT + 7) / 8) * 512; }

DEV void cmp2_job(const Params& P, int job) {
    char* aux = (char*)P.out;
    const int lane = threadIdx.x & 63, w = threadIdx.x >> 6;
    const int wj = job * 4 + w;
    const int which = wj >= NCROWS ? 1 : 0;
    const int r = wj - which * NCROWS;
    const int bg = r / NCMP, n = r - bg * NCMP;
    const bf16_t* hid = (const bf16_t*)(aux + (which ? O_HIDV : O_HIDK)) + (size_t)r * 256;
    const float* w2 = which ? P.wv2 : P.wk2;
    float acc = 0.f;
#pragma unroll 8
    for (int k = 0; k < 256; ++k) acc += bf2f(hid[k]) * w2[k * 64 + lane];
    if (!which) {
        const int pos = 16 * n + 31, i = lane & 7;
        const float cs = ((const float*)(aux + O_ROPEC))[pos * 8 + i], sn = ((const float*)(aux + O_ROPES))[pos * 8 + i];
        const float pr = __shfl_xor(acc, 8);
        float o = acc;
        if (lane < 16) o = (lane & 8) ? (acc * cs + pr * sn) : (acc * cs - pr * sn);
        bf16_t* KC = (bf16_t*)(aux + O_KC);
        KC[((size_t)bg * 128 + n) * 64 + lane] = f2bf(o);
        if (n == NCMP - 1) KC[((size_t)bg * 128 + 127) * 64 + lane] = 0;
    } else {
        bf16_t* VCT = (bf16_t*)(aux + O_VCT);
        VCT[((size_t)bg * 64 + lane) * 128 + n] = f2bf(acc);
        if (n == NCMP - 1) VCT[((size_t)bg * 64 + lane) * 128 + 127] = 0;
    }
}

DEV void rnn_job(const Params& P, int job, char* smem, bool dry) {
    char* aux = (char*)P.out;
    bf16_t* ZA = (bf16_t*)(P.ws + W_ZA);
    const int b = job >> 6, n = (job >> 2) & 15, ct = job & 3;
    bf16_t* sX = (bf16_t*)smem;
    float* sXf = (float*)(smem + 9216);
    float* sCw = (float*)(smem + 9216 + 16640);
    float* sSum = (float*)(smem + 9216 + 16640 + 1280);
    bf16_t* sRaw = (bf16_t*)(smem + 9216 + 16640 + 1280 + 2048);
    const int tid = opaque_tid(), w = tid >> 6, lane = tid & 63, fr = lane & 15, fq = lane >> 4;
    const bf16_t* WAT = (const bf16_t*)(aux + O_WAT) + n * 4096;
    const bf16_t* WIT = (const bf16_t*)(aux + O_WIT) + n * 4096;
    bf16x8 wa[2], wi[2];
#pragma unroll
    for (int ks = 0; ks < 2; ++ks) {
        wa[ks] = *(const bf16x8*)(WAT + (16 * ct + fr) * 64 + 32 * ks + 8 * fq);
        wi[ks] = *(const bf16x8*)(WIT + (16 * ct + fr) * 64 + 32 * ks + 8 * fq);
    }
    const int c = n * 64 + 16 * ct + fr;
    const float ba = P.b_a[c], bi = P.b_i[c], cl = -8.0f * log1pf(__expf(-P.lam[c]));
    float carry = 0.f;
    __syncthreads();
    for (int i = tid; i < 320; i += 256) sCw[i] = (i < 256) ? P.conv_w[(i >> 6) * 1024 + n * 64 + (i & 63)] : P.conv_b[n * 64 + (i & 63)];
    const int lt = tid >> 2, cg = (tid & 3) * 16;
    const bf16_t* xbase = ZA + (size_t)(b * S) * ZW + C_XR + n * 64 + cg;
    bf16_t* sRaw2 = sRaw + 67 * 72;
    u32x4 xm0, xm1, xh0 = {0u, 0u, 0u, 0u}, xh1 = {0u, 0u, 0u, 0u};
    { const u32x4* xp = (const u32x4*)(xbase + (size_t)lt * ZW); xm0 = xp[0]; xm1 = xp[1]; }
    *(u32x4*)(sRaw + (lt + 3) * 72 + cg) = xm0; *(u32x4*)(sRaw + (lt + 3) * 72 + cg + 8) = xm1;
    if (tid < 12) { *(u32x4*)(sRaw + lt * 72 + cg) = xh0; *(u32x4*)(sRaw + lt * 72 + cg + 8) = xh1; }
    { const u32x4* xp = (const u32x4*)(xbase + (size_t)(64 + lt) * ZW); xm0 = xp[0]; xm1 = xp[1];
      if (tid < 12) { const u32x4* hp = (const u32x4*)(xbase + (size_t)(61 + lt) * ZW); xh0 = hp[0]; xh1 = hp[1]; } }
    __syncthreads();
#pragma unroll 1
    for (int chunk = 0; chunk < 32; ++chunk) {
        const int tc = chunk * 64;
        const bf16_t* rawc = (chunk & 1) ? sRaw2 : sRaw;
        bf16_t* rawn = (chunk & 1) ? sRaw : sRaw2;
        bf16_t gv[4];
#pragma unroll
        for (int j = 0; j < 4; ++j) gv[j] = ZA[(size_t)(b * S + tc + 16 * w + 4 * fq + j) * ZW + C_GR + n * 64 + 16 * ct + fr];
        {
            float xv[16];
#pragma unroll
            for (int e4 = 0; e4 < 4; ++e4) { const float4 bb = *(const float4*)(sCw + 256 + cg + 4 * e4); xv[4 * e4] = bb.x; xv[4 * e4 + 1] = bb.y; xv[4 * e4 + 2] = bb.z; xv[4 * e4 + 3] = bb.w; }
#pragma unroll
            for (int k = 0; k < 4; ++k) {
                const u32x4 v0 = *(const u32x4*)(rawc + (lt + k) * 72 + cg), v1 = *(const u32x4*)(rawc + (lt + k) * 72 + cg + 8);
                const unsigned u[8] = {v0.x, v0.y, v0.z, v0.w, v1.x, v1.y, v1.z, v1.w};
#pragma unroll
                for (int e4 = 0; e4 < 4; ++e4) {
                    const float4 wv = *(const float4*)(sCw + k * 64 + cg + 4 * e4);
                    xv[4 * e4] += wv.x * lo_f(u[2 * e4]);
                    xv[4 * e4 + 1] += wv.y * hi_f(u[2 * e4]);
                    xv[4 * e4 + 2] += wv.z * lo_f(u[2 * e4 + 1]);
                    xv[4 * e4 + 3] += wv.w * hi_f(u[2 * e4 + 1]);
                }
            }
            if ((tid & 3) == ct) {
#pragma unroll
                for (int e = 0; e < 16; ++e) sXf[lt * 17 + e] = xv[e];
            }
            u32x4 o0 = {pk2(xv[0], xv[1]), pk2(xv[2], xv[3]), pk2(xv[4], xv[5]), pk2(xv[6], xv[7])};
            u32x4 o1 = {pk2(xv[8], xv[9]), pk2(xv[10], xv[11]), pk2(xv[12], xv[13]), pk2(xv[14], xv[15])};
            *(u32x4*)(sX + lt * 72 + cg) = o0;
            *(u32x4*)(sX + lt * 72 + cg + 8) = o1;
        }
        __syncthreads();
        f32x4 R = (f32x4){0.f, 0.f, 0.f, 0.f}, I = (f32x4){0.f, 0.f, 0.f, 0.f};
#pragma unroll
        for (int ks = 0; ks < 2; ++ks) {
            const bf16x8 af = *(const bf16x8*)(sX + (16 * w + fr) * 72 + 32 * ks + 8 * fq);
            R = MFMA16(af, wa[ks], R); I = MFMA16(af, wi[ks], I);
        }
        if (chunk + 1 < 32) {
            *(u32x4*)(rawn + (lt + 3) * 72 + cg) = xm0; *(u32x4*)(rawn + (lt + 3) * 72 + cg + 8) = xm1;
            if (tid < 12) { *(u32x4*)(rawn + lt * 72 + cg) = xh0; *(u32x4*)(rawn + lt * 72 + cg + 8) = xh1; }
        }
        float hl[4], pc[4];
        float h = 0.f, pcum = 1.f;
#pragma unroll
        for (int j = 0; j < 4; ++j) {
            const float xcv = sXf[(16 * w + 4 * fq + j) * 17 + fr];
            const float rg = sigm(R[j] + ba), gi = sigm(I[j] + bi);
            const float la = rg * cl;
            const float a_ = __expf(la);
            const float mult = sqrtf(fmaxf(1.f - a_ * a_, 0.f));
            const float u = mult * gi * xcv;
            h = a_ * h + u; pcum *= a_;
            hl[j] = h; pc[j] = pcum;
        }
        float A = pcum, H = h;
        float A1 = __shfl_up(A, 16), H1 = __shfl_up(H, 16);
        if (fq >= 1) { H = A * H1 + H; A = A * A1; }
        float A2 = __shfl_up(A, 32), H2 = __shfl_up(H, 32);
        if (fq >= 2) { H = A * H2 + H; A = A * A2; }
        float Ax = __shfl_up(A, 16), Hx = __shfl_up(H, 16);
        const float Ae = fq == 0 ? 1.f : Ax, He = fq == 0 ? 0.f : Hx;
        if (fq == 3) { sSum[w * 16 + fr] = A; sSum[64 + w * 16 + fr] = H; }
        __syncthreads();
        if (chunk + 2 < 32) {
            const u32x4* xp = (const u32x4*)(xbase + (size_t)(tc + 128 + lt) * ZW); xm0 = xp[0]; xm1 = xp[1];
            if (tid < 12) { const u32x4* hp = (const u32x4*)(xbase + (size_t)(tc + 125 + lt) * ZW); xh0 = hp[0]; xh1 = hp[1]; }
        }
        float cin = carry, mycin = 0.f;
#pragma unroll
        for (int ww = 0; ww < 4; ++ww) {
            if (ww == w) mycin = cin;
            cin = sSum[ww * 16 + fr] * cin + sSum[64 + ww * 16 + fr];
        }
        carry = cin;
        const float sq = Ae * mycin + He;
#pragma unroll
        for (int j = 0; j < 4; ++j) {
            const float hfin = hl[j] + pc[j] * sq;
            const size_t grow = (size_t)(b * S + tc + 16 * w + 4 * fq + j);
            bf16_t* op = dry ? ((bf16_t*)(P.ws + W_YX) + grow * 1024 + n * 64 + 16 * ct + fr) : (ZA + grow * ZW + C_GR + n * 64 + 16 * ct + fr);
            *op = f2bf(gelu_t(bf2f(gv[j])) * hfin);
        }
    }
}

constexpr float EXPC = 0.125f * 1.4426950408889634f;
struct AttnAcc { f32x4 o[4][2]; float m[2], l[2]; };
DEV void attn_init(AttnAcc& a) {
#pragma unroll
    for (int d = 0; d < 4; ++d)
#pragma unroll
        for (int q = 0; q < 2; ++q) a.o[d][q] = (f32x4){0.f, 0.f, 0.f, 0.f};
    a.m[0] = a.m[1] = -INFINITY; a.l[0] = a.l[1] = 0.f;
}
DEV bf16x8 mk8(unsigned a, unsigned b, unsigned c, unsigned d) { u32x4 u = {a, b, c, d}; return __builtin_bit_cast(bf16x8, u); }

template <class MF>
DEV void attn_step(const bf16_t* sK, const bf16_t* sVt, int vstride, const bf16x8 (&qf)[2][2], AttnAcc& st, const MF& mf, int fr, int fq) {
    f32x4 s[4][2];
#pragma unroll
    for (int kt = 0; kt < 4; ++kt) {
        s[kt][0] = (f32x4){0.f, 0.f, 0.f, 0.f}; s[kt][1] = (f32x4){0.f, 0.f, 0.f, 0.f};
#pragma unroll
        for (int ks = 0; ks < 2; ++ks) {
            const bf16x8 kf = *(const bf16x8*)(sK + (16 * kt + fr) * 72 + 32 * ks + 8 * fq);
            s[kt][0] = MFMA16(kf, qf[0][ks], s[kt][0]);
            s[kt][1] = MFMA16(kf, qf[1][ks], s[kt][1]);
        }
    }
#pragma unroll
    for (int qt = 0; qt < 2; ++qt) {
        float mx = -INFINITY;
#pragma unroll
        for (int kt = 0; kt < 4; ++kt)
#pragma unroll
            for (int j = 0; j < 4; ++j) {
                const float v = mf(qt, 16 * kt + 4 * fq + j) ? s[kt][qt][j] : -INFINITY;
                s[kt][qt][j] = v; mx = fmaxf(mx, v);
            }
        mx = fmaxf(mx, __shfl_xor(mx, 16)); mx = fmaxf(mx, __shfl_xor(mx, 32));
        const float mn = fmaxf(st.m[qt], mx);
        float alpha = 1.f, msub = 0.f;
        if (mn != -INFINITY) { alpha = __builtin_amdgcn_exp2f((st.m[qt] - mn) * EXPC); msub = mn; }
        st.m[qt] = mn;
        float ps = 0.f;
#pragma unroll
        for (int kt = 0; kt < 4; ++kt)
#pragma unroll
            for (int j = 0; j < 4; ++j) { const float p = __builtin_amdgcn_exp2f((s[kt][qt][j] - msub) * EXPC); s[kt][qt][j] = p; ps += p; }
        st.l[qt] = st.l[qt] * alpha + ps;
#pragma unroll
        for (int dt = 0; dt < 4; ++dt) st.o[dt][qt] *= alpha;
    }
#pragma unroll
    for (int ks = 0; ks < 2; ++ks) {
        bf16x8 pf[2];
#pragma unroll
        for (int qt = 0; qt < 2; ++qt)
            pf[qt] = mk8(pk2(s[2 * ks][qt][0], s[2 * ks][qt][1]), pk2(s[2 * ks][qt][2], s[2 * ks][qt][3]),
                         pk2(s[2 * ks + 1][qt][0], s[2 * ks + 1][qt][1]), pk2(s[2 * ks + 1][qt][2], s[2 * ks + 1][qt][3]));
#pragma unroll
        for (int dt = 0; dt < 4; ++dt) {
            const u32x2 v0 = *(const u32x2*)(sVt + (16 * dt + fr) * vstride + 32 * ks + 4 * fq);
            const u32x2 v1 = *(const u32x2*)(sVt + (16 * dt + fr) * vstride + 32 * ks + 16 + 4 * fq);
            const bf16x8 vf = mk8(v0.x, v0.y, v1.x, v1.y);
            st.o[dt][0] = MFMA16(vf, pf[0], st.o[dt][0]);
            st.o[dt][1] = MFMA16(vf, pf[1], st.o[dt][1]);
        }
    }
}
DEV void attn_step_fast(const bf16_t* sK, const bf16_t* sVt, const bf16x8 (&qf)[2][2], AttnAcc& st, const float (&bitoff)[2], int fr, int fq) {
    f32x4 s[4][2];
#pragma unroll
    for (int kt = 0; kt < 4; ++kt) {
        s[kt][0] = (f32x4){0.f, 0.f, 0.f, 0.f}; s[kt][1] = (f32x4){0.f, 0.f, 0.f, 0.f};
#pragma unroll
        for (int ks = 0; ks < 2; ++ks) {
            const bf16x8 kf = *(const bf16x8*)(sK + (16 * kt + fr) * 72 + 32 * ks + 8 * fq);
            s[kt][0] = MFMA16(kf, qf[0][ks], s[kt][0]);
            s[kt][1] = MFMA16(kf, qf[1][ks], s[kt][1]);
        }
    }
#pragma unroll
    for (int qt = 0; qt < 2; ++qt) {
        float mx = fmaxf(fmaxf(s[0][qt][0], s[0][qt][1]), fmaxf(s[0][qt][2], s[0][qt][3]));
#pragma unroll
        for (int kt = 1; kt < 4; ++kt) mx = fmaxf(mx, fmaxf(fmaxf(s[kt][qt][0], s[kt][qt][1]), fmaxf(s[kt][qt][2], s[kt][qt][3])));
        mx = fmaxf(mx, __shfl_xor(mx, 16)); mx = fmaxf(mx, __shfl_xor(mx, 32));
        const float mn = fmaxf(st.m[qt], mx);
        const float alpha = __builtin_amdgcn_exp2f((st.m[qt] - mn) * EXPC);
        st.m[qt] = mn;
        const float off = bitoff[qt] - mn * EXPC;
        float ps = 0.f;
#pragma unroll
        for (int kt = 0; kt < 4; ++kt)
#pragma unroll
            for (int j = 0; j < 4; ++j) { const float p = __builtin_amdgcn_exp2f(fmaf(s[kt][qt][j], EXPC, off)); s[kt][qt][j] = p; ps += p; }
        st.l[qt] = st.l[qt] * alpha + ps;
#pragma unroll
        for (int dt = 0; dt < 4; ++dt) st.o[dt][qt] *= alpha;
    }
#pragma unroll
    for (int ks = 0; ks < 2; ++ks) {
        bf16x8 pf[2];
#pragma unroll
        for (int qt = 0; qt < 2; ++qt)
            pf[qt] = mk8(pk2(s[2 * ks][qt][0], s[2 * ks][qt][1]), pk2(s[2 * ks][qt][2], s[2 * ks][qt][3]),
                         pk2(s[2 * ks + 1][qt][0], s[2 * ks + 1][qt][1]), pk2(s[2 * ks + 1][qt][2], s[2 * ks + 1][qt][3]));
#pragma unroll
        for (int dt = 0; dt < 4; ++dt) {
            const u32x2 v0 = *(const u32x2*)(sVt + (16 * dt + fr) * 72 + 32 * ks + 4 * fq);
            const u32x2 v1 = *(const u32x2*)(sVt + (16 * dt + fr) * 72 + 32 * ks + 16 + 4 * fq);
            const bf16x8 vf = mk8(v0.x, v0.y, v1.x, v1.y);
            st.o[dt][0] = MFMA16(vf, pf[0], st.o[dt][0]);
            st.o[dt][1] = MFMA16(vf, pf[1], st.o[dt][1]);
        }
    }
}
DEV void attn_fold_out(bf16_t* const (&op)[2], const AttnAcc& st, const float (&gate)[2]) {
#pragma unroll
    for (int qt = 0; qt < 2; ++qt) {
        float l = st.l[qt];
        l += __shfl_xor(l, 16); l += __shfl_xor(l, 32);
        const float sc = gate[qt] * __builtin_amdgcn_rcpf(fmaxf(l, 1e-30f));
#pragma unroll
        for (int dt = 0; dt < 4; ++dt) {
            const uint2 pv = *(const uint2*)(op[qt] + 16 * dt);
            f32x4 r = st.o[dt][qt] * sc;
            r[0] += lo_f(pv.x); r[1] += hi_f(pv.x); r[2] += lo_f(pv.y); r[3] += hi_f(pv.y);
            *(uint2*)(op[qt] + 16 * dt) = make_uint2(pk2(r[0], r[1]), pk2(r[2], r[3]));
        }
    }
}
DEV void attn_fold(f32x4 (&tot)[4][2], const AttnAcc& st, const float (&gate)[2]) {
#pragma unroll
    for (int qt = 0; qt < 2; ++qt) {
        float l = st.l[qt];
        l += __shfl_xor(l, 16); l += __shfl_xor(l, 32);
        const float sc = gate[qt] * __builtin_amdgcn_rcpf(fmaxf(l, 1e-30f));
#pragma unroll
        for (int dt = 0; dt < 4; ++dt) tot[dt][qt] += st.o[dt][qt] * sc;
    }
}
DEV void ld64(u32x4 (&r)[2], const bf16_t* src, size_t sstride, int tid) {
#pragma unroll
    for (int i = 0; i < 2; ++i) { const int c = tid + 256 * i; r[i] = *(const u32x4*)(src + (size_t)(c >> 3) * sstride + (c & 7) * 8); }
}
DEV void st64(bf16_t* dst, const u32x4 (&r)[2], int tid) {
#pragma unroll
    for (int i = 0; i < 2; ++i) { const int c = tid + 256 * i; *(u32x4*)(dst + (c >> 3) * 72 + (c & 7) * 8) = r[i]; }
}

#define OUTP(QT) ((dry ? (bf16_t*)(P.ws + W_YX) + (size_t)(b * S + tq[QT]) * 1024 : ZA + (size_t)(b * S + tq[QT]) * ZW + C_Q) + head * 64 + 4 * fq)
#define LOAD_GATE(G2, BR) float G2[2]; { G2[0] = bf2f(ZA[(size_t)(b * S + tq[0]) * ZW + C_G + head * 3 + (BR)]); G2[1] = bf2f(ZA[(size_t)(b * S + tq[1]) * ZW + C_G + head * 3 + (BR)]); }
struct MaskAll { DEV bool operator()(int, int) const { return true; } };
struct MaskSel { unsigned bit[2]; int t[2]; int k0; DEV bool operator()(int qt, int kk) const { return bit[qt] && (k0 + kk <= t[qt]); } };
struct MaskWin { int t[2]; int k0; DEV bool operator()(int qt, int kk) const { const int k = k0 + kk; return k <= t[qt] && k > t[qt] - 512; } };

DEV void xattn_job(const Params& P, int job, char* smem, bool dry) {
    char* aux = (char*)P.out;
    bf16_t* ZA = (bf16_t*)(P.ws + W_ZA);
    const int qb = job & 15, h = (job >> 4) & 3, b = job >> 6;
    bf16_t* sK = (bf16_t*)smem;
    bf16_t* sVt = sK + 64 * 72;
    const int tid = opaque_tid(), w = tid >> 6, lane = tid & 63, fr = lane & 15, fq = lane >> 4;
    const int t0 = qb * 128 + w * 32;
    bf16x8 qf[2][2];
#pragma unroll
    for (int qt = 0; qt < 2; ++qt)
#pragma unroll
        for (int ks = 0; ks < 2; ++ks) qf[qt][ks] = *(const bf16x8*)(ZA + (size_t)(b * S + t0 + 16 * qt + fr) * ZW + C_QX + h * 64 + 32 * ks + 8 * fq);
    const bf16_t* MK = (const bf16_t*)(aux + O_MEMK) + (size_t)(b * 4 + h) * 256 * 64;
    const bf16_t* MVT = (const bf16_t*)(aux + O_MEMVT) + (size_t)(b * 4 + h) * 64 * 256;
    AttnAcc st; attn_init(st);
    u32x4 rk[2], rv[2];
    ld64(rk, MK, 64, tid); ld64(rv, MVT, 256, tid);
#pragma unroll 1
    for (int jb = 0; jb < 4; ++jb) {
        __syncthreads();
        st64(sK, rk, tid); st64(sVt, rv, tid);
        __syncthreads();
        if (jb + 1 < 4) { ld64(rk, MK + (size_t)(jb + 1) * 64 * 64, 64, tid); ld64(rv, MVT + (jb + 1) * 64, 256, tid); }
        __builtin_amdgcn_sched_barrier(0);
        { const float z2[2] = {0.f, 0.f}; attn_step_fast(sK, sVt, qf, st, z2, fr, fq); }
    }
    f32x4 tot[4][2];
#pragma unroll
    for (int dt = 0; dt < 4; ++dt) { tot[dt][0] = (f32x4){0.f, 0.f, 0.f, 0.f}; tot[dt][1] = (f32x4){0.f, 0.f, 0.f, 0.f}; }
    const float one[2] = {1.f, 1.f};
    attn_fold(tot, st, one);
#pragma unroll
    for (int qt = 0; qt < 2; ++qt)
#pragma unroll
        for (int dt = 0; dt < 4; ++dt)
            *(uint2*)((dry ? (bf16_t*)(P.ws + W_Y) + (size_t)(b * S + t0 + 16 * qt + fr) * 1024 : ZA + (size_t)(b * S + t0 + 16 * qt + fr) * ZW + C_QX) + h * 64 + 16 * dt + 4 * fq) =
                make_uint2(pk2(tot[dt][qt][0], tot[dt][qt][1]), pk2(tot[dt][qt][2], tot[dt][qt][3]));
}

DEV void nsa_job(const Params& P, int job, char* smem, bool dry) {
    char* aux = (char*)P.out;
    bf16_t* ZA = (bf16_t*)(P.ws + W_ZA);
    const int bg = job & 31, qb = 63 - (job >> 5), b = bg >> 2, g = bg & 3, t0 = qb * 32;
    bf16_t* sK = (bf16_t*)smem;
    bf16_t* sVt = (bf16_t*)(smem + 18432);
    float* sImp = (float*)(smem + 18432 + 17408);
    unsigned* sSel = (unsigned*)(smem + 18432 + 17408 + 16384);
    const int tid = opaque_tid(), w = tid >> 6, lane = tid & 63, fr = lane & 15, fq = lane >> 4;
    const int head = g * 4 + w;
    int tq[2];
    bf16x8 qf[2][2];
#pragma unroll
    for (int qt = 0; qt < 2; ++qt) {
        tq[qt] = t0 + 16 * qt + fr;
        const bf16_t* rowp = ZA + (size_t)(b * S + tq[qt]) * ZW;
#pragma unroll
        for (int ks = 0; ks < 2; ++ks) qf[qt][ks] = *(const bf16x8*)(rowp + C_Q + head * 64 + 32 * ks + 8 * fq);
    }
    f32x4 tot[4][2];
#pragma unroll
    for (int dt = 0; dt < 4; ++dt) { tot[dt][0] = (f32x4){0.f, 0.f, 0.f, 0.f}; tot[dt][1] = (f32x4){0.f, 0.f, 0.f, 0.f}; }

    {
        const bf16_t* KC = (const bf16_t*)(aux + O_KC) + (size_t)bg * 128 * 64;
        const bf16_t* VCT = (const bf16_t*)(aux + O_VCT) + (size_t)bg * 64 * 128;
        __syncthreads();
#pragma unroll
        for (int i = 0; i < 4; ++i) {
            const int c = tid + 256 * i;
            { const int r = c >> 3, k = (c & 7) * 8; *(u32x4*)(sK + r * 72 + k) = *(const u32x4*)(KC + r * 64 + k); }
            { const int r = c >> 4, k = (c & 15) * 8; *(u32x4*)(sVt + r * 136 + k) = *(const u32x4*)(VCT + r * 128 + k); }
        }
        __syncthreads();
#pragma unroll
        for (int qt = 0; qt < 2; ++qt) {
            const float g0 = bf2f(ZA[(size_t)(b * S + tq[qt]) * ZW + C_G + head * 3 + 0]);
            f32x4 s[8];
#pragma unroll
            for (int kt = 0; kt < 8; ++kt) {
                s[kt] = (f32x4){0.f, 0.f, 0.f, 0.f};
#pragma unroll
                for (int ks = 0; ks < 2; ++ks) {
                    const bf16x8 kf = *(const bf16x8*)(sK + (16 * kt + fr) * 72 + 32 * ks + 8 * fq);
                    s[kt] = MFMA16(kf, qf[qt][ks], s[kt]);
                }
            }
            float mx = -INFINITY;
#pragma unroll
            for (int kt = 0; kt < 8; ++kt)
#pragma unroll
                for (int j = 0; j < 4; ++j) {
                    const int n = 16 * kt + 4 * fq + j;
                    const float v = (n < NCMP && 16 * n + 31 <= tq[qt]) ? s[kt][j] : -INFINITY;
                    s[kt][j] = v; mx = fmaxf(mx, v);
                }
            mx = fmaxf(mx, __shfl_xor(mx, 16)); mx = fmaxf(mx, __shfl_xor(mx, 32));
            const float msub = (mx == -INFINITY) ? 0.f : mx;
            float ps = 0.f;
#pragma unroll
            for (int kt = 0; kt < 8; ++kt)
#pragma unroll
                for (int j = 0; j < 4; ++j) { const float p = __builtin_amdgcn_exp2f((s[kt][j] - msub) * EXPC); s[kt][j] = p; ps += p; }
            ps += __shfl_xor(ps, 16); ps += __shfl_xor(ps, 32);
            const float inv = __builtin_amdgcn_rcpf(fmaxf(ps, 1e-30f));
            float bprev = 0.f;
#pragma unroll
            for (int kt = 0; kt < 8; ++kt) {
                s[kt] *= inv;
                const float a = s[kt][0] + s[kt][1] + s[kt][2] + 0.5f * s[kt][3];
                const float bq = 0.5f * s[kt][3];
                const float x = __shfl(bq, (lane + 48) & 63);
                const float y = __shfl(bprev, (lane + 48) & 63);
                sImp[(w * 32 + 16 * qt + fr) * 32 + 4 * kt + fq] = a + (fq > 0 ? x : y);
                bprev = bq;
            }
#pragma unroll
            for (int ks = 0; ks < 4; ++ks) {
                const f32x4 pa = s[2 * ks] * g0, pb = s[2 * ks + 1] * g0;
                const bf16x8 pf = mk8(pk2(pa[0], pa[1]), pk2(pa[2], pa[3]), pk2(pb[0], pb[1]), pk2(pb[2], pb[3]));
#pragma unroll
                for (int dt = 0; dt < 4; ++dt) {
                    const u32x2 v0 = *(const u32x2*)(sVt + (16 * dt + fr) * 136 + 32 * ks + 4 * fq);
                    const u32x2 v1 = *(const u32x2*)(sVt + (16 * dt + fr) * 136 + 32 * ks + 16 + 4 * fq);
                    tot[dt][qt] = MFMA16(mk8(v0.x, v0.y, v1.x, v1.y), pf, tot[dt][qt]);
                }
            }
            __builtin_amdgcn_sched_barrier(0);
        }
    }
#pragma unroll
    for (int qt = 0; qt < 2; ++qt) {
        bf16_t* op = (dry ? (bf16_t*)(P.ws + W_YX) + (size_t)(b * S + tq[qt]) * 1024 : ZA + (size_t)(b * S + tq[qt]) * ZW + C_Q) + head * 64 + 4 * fq;
#pragma unroll
        for (int dt = 0; dt < 4; ++dt) *(uint2*)(op + 16 * dt) = pk4(tot[dt][qt]);
    }
    __syncthreads();
    {
        float myv[4];
#pragma unroll
        for (int i = 0; i < 4; ++i) {
            const int pidx = tid + 256 * i, q = pidx >> 5, m = pidx & 31;
            const int t = t0 + q, cur = t >> 6;
            const float sum = ((sImp[(0 * 32 + q) * 32 + m] + sImp[(1 * 32 + q) * 32 + m]) + sImp[(2 * 32 + q) * 32 + m]) + sImp[(3 * 32 + q) * 32 + m];
            const bool forced = (m == 0) || (m == cur) || (m == cur - 1);
            const bool future = m * 64 > t;
            myv[i] = forced ? INFINITY : (future ? -INFINITY : sum);
        }
        if (tid == 0) sSel[32] = 0u;
        __syncthreads();
#pragma unroll
        for (int i = 0; i < 4; ++i) { const int pidx = tid + 256 * i; sImp[pidx] = myv[i]; }
        __syncthreads();
        unsigned wun = 0u;
#pragma unroll
        for (int i = 0; i < 4; ++i) {
            const int pidx = tid + 256 * i, q = pidx >> 5, m = pidx & 31;
            const float v = myv[i];
            int rank = 0;
#pragma unroll
            for (int m2 = 0; m2 < 32; ++m2) {
                const float o = sImp[q * 32 + m2];
                rank += (o > v || (o == v && m2 < m)) ? 1 : 0;
            }
            const bool selb = (rank < 8) && (v > -INFINITY);
            const unsigned long long bal = __ballot(selb);
            const unsigned mk = (unsigned)(bal >> (32 * (lane >> 5)));
            if ((lane & 31) == 0) sSel[q] = mk;
            wun |= (unsigned)bal | (unsigned)(bal >> 32);
        }
        if (lane == 0) atomicOr(&sSel[32], wun);
    }
    __syncthreads();
    const unsigned uni = sSel[32];
    const int jmax = (t0 + 31) >> 6;
    {
        AttnAcc st; attn_init(st);
        const bf16_t* Kb = ZA + (size_t)(b * S) * ZW + C_KS + g * 64;
        const bf16_t* Vb = (const bf16_t*)(P.ws + W_VST) + (size_t)bg * 64 * S;
        unsigned rem = uni & ((2u << jmax) - 1u);
        u32x4 rk[2], rv[2];
        if (rem) { const int j0 = __builtin_ctz(rem); ld64(rk, Kb + (size_t)(j0 * 64) * ZW, ZW, tid); ld64(rv, Vb + j0 * 64, S, tid); }
#pragma unroll 1
        while (rem) {
            const int jb = __builtin_ctz(rem);
            rem &= rem - 1u;
            __syncthreads();
            st64(sK, rk, tid); st64(sVt, rv, tid);
            __syncthreads();
            if (rem) { const int jn = __builtin_ctz(rem); ld64(rk, Kb + (size_t)(jn * 64) * ZW, ZW, tid); ld64(rv, Vb + jn * 64, S, tid); }
            __builtin_amdgcn_sched_barrier(0);
            if (jb * 64 + 63 <= t0) {
                const float bo[2] = {((sSel[fr] >> jb) & 1u) ? 0.f : -INFINITY, ((sSel[16 + fr] >> jb) & 1u) ? 0.f : -INFINITY};
                attn_step_fast(sK, sVt, qf, st, bo, fr, fq);
            } else {
                MaskSel mf; mf.bit[0] = (sSel[fr] >> jb) & 1u; mf.bit[1] = (sSel[16 + fr] >> jb) & 1u; mf.t[0] = tq[0]; mf.t[1] = tq[1]; mf.k0 = jb * 64;
                attn_step(sK, sVt, 72, qf, st, mf, fr, fq);
            }
        }
        { LOAD_GATE(g1, 1) bf16_t* const op2[2] = {OUTP(0), OUTP(1)}; attn_fold_out(op2, st, g1); }
    }
    {
        AttnAcc st; attn_init(st);
        const bf16_t* Kb = ZA + (size_t)(b * S) * ZW + C_KW + g * 64;
        const bf16_t* Vb = (const bf16_t*)(P.ws + W_VWT) + (size_t)bg * 64 * S;
#pragma unroll
        for (int qt = 0; qt < 2; ++qt) {
            const int npad = 511 - tq[qt];
            if (npad > 0) { st.m[qt] = 0.f; st.l[qt] = (fq == 0) ? (float)npad : 0.f; }
        }
        int jlo = t0 - 511; jlo = jlo < 0 ? 0 : (jlo >> 6);
        u32x4 rk[2], rv[2];
        ld64(rk, Kb + (size_t)(jlo * 64) * ZW, ZW, tid); ld64(rv, Vb + jlo * 64, S, tid);
#pragma unroll 1
        for (int jb = jlo; jb <= jmax; ++jb) {
            __syncthreads();
            st64(sK, rk, tid); st64(sVt, rv, tid);
            __syncthreads();
            if (jb < jmax) { ld64(rk, Kb + (size_t)((jb + 1) * 64) * ZW, ZW, tid); ld64(rv, Vb + (jb + 1) * 64, S, tid); }
            __builtin_amdgcn_sched_barrier(0);
            if (jb * 64 + 63 <= t0 && jb * 64 > t0 + 31 - 512) {
                const float z2[2] = {0.f, 0.f};
                attn_step_fast(sK, sVt, qf, st, z2, fr, fq);
            } else {
                MaskWin mf; mf.t[0] = tq[0]; mf.t[1] = tq[1]; mf.k0 = jb * 64;
                attn_step(sK, sVt, 72, qf, st, mf, fr, fq);
            }
        }
        { LOAD_GATE(g2, 2) bf16_t* const op2[2] = {OUTP(0), OUTP(1)}; attn_fold_out(op2, st, g2); }
    }
}


#define XB_TMO      128
#define XB_XCNT(j)  (256  + 64 * (j))
#define XB_XSUB(j)  (1280 + 64 * (j))
#define XB_XGEN(j)  (2304 + 64 * (j))
#define XB_TOP      3328
#define XB_TOPGEN   3392
#define XCD_BAR_WORDS 3456
#define XB_SPIN_CAP (1u << 18)
#define LAS __attribute__((address_space(3)))
DEV unsigned xb_ld(unsigned* p) { return __hip_atomic_load(p, __ATOMIC_RELAXED, __HIP_MEMORY_SCOPE_AGENT); }
DEV unsigned xb_add(unsigned* p, unsigned v) { return __hip_atomic_fetch_add(p, v, __ATOMIC_RELAXED, __HIP_MEMORY_SCOPE_AGENT); }
DEV unsigned xb_xcc_id() { return (unsigned)__builtin_amdgcn_s_getreg((3 << 11) | 20) & 0xFu; }
#define XB_SPIN(cond, bar) do { unsigned _sp = 0; while (cond) { __builtin_amdgcn_s_sleep(1); \
    if ((++_sp & 255u) == 0u) { if (xb_ld(&(bar)[XB_TMO])) break; if (_sp > XB_SPIN_CAP) { atomicAdd(&(bar)[XB_TMO], 1u); break; } } } } while (0)
struct XcdBarrier { unsigned* bar; unsigned x; volatile LAS unsigned* st; };
DEV XcdBarrier xcd_barrier_post(unsigned* bar, volatile LAS unsigned* st) {
    XcdBarrier b; b.bar = bar; b.x = xb_xcc_id(); b.st = st;
    if (threadIdx.x == 0) (void)xb_add(&bar[XB_XCNT(b.x)], 1u);
    return b;
}
DEV void xcd_barrier_complete(unsigned* bar, unsigned x, unsigned& nloc, unsigned& nx) {
    const unsigned G = gridDim.x * gridDim.y * gridDim.z;
    unsigned sum, cnt, mine, sp = 0u;
    for (;;) {
        sum = 0u; cnt = 0u; mine = 0u;
#pragma unroll
        for (unsigned j = 0; j < 16; ++j) { const unsigned c = xb_ld(&bar[XB_XCNT(j)]); sum += c; cnt += (c > 0u) ? 1u : 0u; mine = (j == x) ? c : mine; }
        if (sum == G) break;
        __builtin_amdgcn_s_sleep(1);
        if ((++sp & 255u) == 0u) { if (xb_ld(&bar[XB_TMO])) break; if (sp > XB_SPIN_CAP) { atomicAdd(&bar[XB_TMO], 1u); break; } }
    }
    nloc = mine > 0u ? mine : 1u; nx = cnt > 0u ? cnt : 1u;
}
DEV void xcd_barrier(const XcdBarrier& b) {
    asm volatile("s_waitcnt vmcnt(0)" ::: "memory");
    __syncthreads();
    if (threadIdx.x == 0) {
        unsigned* bar = b.bar;
        __builtin_amdgcn_s_waitcnt(0);
        unsigned nloc = b.st[0], nx = b.st[1];
        if (nloc == 0u) { xcd_barrier_complete(bar, b.x, nloc, nx); b.st[0] = nloc; b.st[1] = nx; }
        const unsigned old = xb_add(&bar[XB_XSUB(b.x)], 1u);
        const unsigned gen = old / nloc;
        if (old + 1u == (gen + 1u) * nloc) {
            __builtin_amdgcn_fence(__ATOMIC_RELEASE, "agent");
            asm volatile("s_waitcnt vmcnt(0)" ::: "memory");
            const unsigned og = xb_add(&bar[XB_TOP], 1u);
            const unsigned tg = og / nx;
            if (og + 1u == (tg + 1u) * nx) xb_add(&bar[XB_TOPGEN], 1u);
            else XB_SPIN(xb_ld(&bar[XB_TOPGEN]) == tg, bar);
            __builtin_amdgcn_fence(__ATOMIC_ACQUIRE, "agent");
            xb_add(&bar[XB_XGEN(b.x)], 1u);
            asm volatile("s_waitcnt vmcnt(0)" ::: "memory");
        } else {
            XB_SPIN(xb_ld(&bar[XB_XGEN(b.x)]) == gen, bar);
            __builtin_amdgcn_fence(__ATOMIC_ACQUIRE, "agent");
            asm volatile("s_waitcnt vmcnt(0)" ::: "memory");
        }
    }
    __syncthreads();
}
constexpr size_t W_BAR = 252 * MiB;

constexpr int NPHASE = 11;
constexpr int SMEM_BYTES = 55296;

template <int PH, bool DRY = false>
DEV void run_phase(const Params& P, char* smem) {
    const int nb = gridDim.x, bid = blockIdx.x;
    char* aux = (char*)P.out;
    char* ws = P.ws;
    bf16_t* ZA = (bf16_t*)(ws + W_ZA);
    if (PH == 0) {
        for (int job = bid; job < 4800 + 4096 + 512 + 64; job += nb) {
            int j = job;
            if (j < 4800) {
                bool done = false;
#define TR(SRC, LD, DSTOFF, KK, NN, MAP, BLK)                                                                                  \
    if (!done) { const int nrt = (NN) / 64, nt = nrt * ((KK) / 64);                                                              \
        if (j < nt) { transpose_tile((SRC), (LD), (bf16_t*)(aux + (DSTOFF)), (KK), (j % nrt) * 64, (j / nrt) * 64, (MAP), smem, (BLK) ? (NN) : 0); done = true; } else j -= nt; }
                TR(P.w_in, 7984, O_WTA, 1024, 4992, 1, 1)
                TR(P.w_in, 7984, O_WTB, 1024, 3072, 2, 1)
                TR(P.w_up, 4096, O_WTUP, 1024, 4096, 0, 1)
                TR(P.w_down, 1024, O_WTDN, 4096, 1024, 0, 1)
                TR(P.w_o, 1024, O_WTO, 1024, 1024, 0, 1)
                TR(P.w_xo, 1024, O_WTXO, 256, 1024, 0, 0)
                TR(P.w_mkv, 512, O_WTMKV, 1024, 512, 0, 0)
                TR(P.wk1, 256, O_WTCK1, 2048, 256, 0, 0)
                TR(P.wv1, 256, O_WTCV1, 2048, 256, 0, 0)
#undef TR
                if (!done) {
                    if (j < 16) transpose_tile(P.w_a + j * 4096, 64, (bf16_t*)(aux + O_WAT) + j * 4096, 64, 0, 0, 0, smem);
                    else { j -= 16; transpose_tile(P.w_i + j * 4096, 64, (bf16_t*)(aux + O_WIT) + j * 4096, 64, 0, 0, 0, smem); }
                }
                continue;
            }
            j -= 4800;
            if (j < 4096) { rownorm<false>(P.x, P.g_mix, (bf16_t*)(ws + W_U), nullptr, j * 4 + (threadIdx.x >> 6), true); continue; }
            j -= 4096;
            if (j < 512) { rownorm<false>(P.mem, P.g_mem, (bf16_t*)(aux + O_MEMN), nullptr, j * 4 + (threadIdx.x >> 6)); continue; }
            j -= 512;
            rope_job((float*)(aux + O_ROPEC), (float*)(aux + O_ROPES), j);
        }
    } else if (PH == 1) {
        const int nA = tile_count(39);
        for (int job = bid; job < 32 + nA; job += nb) {
            if (job < 32) {
                ALPlain al; al.A = (const bf16_t*)(aux + O_MEMN); al.lda = 1024; al.ks = 64;
                const int pm = job & 7, pn = job >> 3;
                if (pn < 2) { EpiMemKV<true> ep{(bf16_t*)(aux + O_MEMK), (bf16_t*)(aux + O_MEMVT)}; gemm_tile<8, 4, true>(al, (const bf16_t*)(aux + O_WTMKV), 1024, 64, 1024, pm, pn, ep, smem); }
                else { EpiMemKV<false> ep{(bf16_t*)(aux + O_MEMK), (bf16_t*)(aux + O_MEMVT)}; gemm_tile<8, 4, false>(al, (const bf16_t*)(aux + O_WTMKV), 1024, 64, 1024, pm, pn, ep, smem); }
            } else {
                int pm, pn;
                if (!tile_map(job - 32, 39, pm, pn)) continue;
                ALPlain al; al.A = (const bf16_t*)(ws + W_U); al.lda = 64; al.ks = 16384 * 64;
                if (pn < 35) { EpiZA<true> ep{ZA, (bf16_t*)(ws + W_VST), (bf16_t*)(ws + W_VWT), (const float*)(aux + O_ROPEC), (const float*)(aux + O_ROPES)};
                    gemm_tile<8, 4, true>(al, (const bf16_t*)(aux + O_WTA), 64, 4992 * 64, 1024, pm, pn, ep, smem); }
                else { EpiZA<false> ep{ZA, (bf16_t*)(ws + W_VST), (bf16_t*)(ws + W_VWT), (const float*)(aux + O_ROPEC), (const float*)(aux + O_ROPES)};
                    gemm_tile<8, 4, false>(al, (const bf16_t*)(aux + O_WTA), 64, 4992 * 64, 1024, pm, pn, ep, smem); }
            }
        }
    } else if (PH == 2) {
        for (int job = bid; job < 1280; job += nb) {
            if (job < 128) {
                const int j = job, which = j >> 6, pm = (j & 63) >> 1, pn = j & 1;
                float* sPos = (float*)(smem + 36864);
                __syncthreads();
                { const float* pg = which ? P.cpv : P.cpk; const int t8 = threadIdx.x * 8; *(float4*)(sPos + t8) = *(const float4*)(pg + t8); *(float4*)(sPos + t8 + 4) = *(const float4*)(pg + t8 + 4); }
                ALCmp al; al.ZA = ZA; al.spos = sPos; al.colbase = which ? C_VC : C_KC;
                EpiHid ep{(bf16_t*)(aux + (which ? O_HIDV : O_HIDK))};
                gemm_tile<4, 4, true>(al, (const bf16_t*)(aux + (which ? O_WTCV1 : O_WTCK1)), 2048, 64, 2048, pm, pn, ep, smem);
            } else if (job < 640) rnn_job(P, job - 128, smem, DRY);
            else if (job < 1024) xattn_job(P, job - 640, smem, DRY);
            else if (job >= 1152) xattn_job(P, job - 1152 + 384, smem, DRY);
        }
    } else if (PH == 3) {
        for (int job = bid; job < 2032; job += nb) cmp2_job(P, job);
    } else if (PH == 4) {
        for (int job = bid; job < 2048 + 512; job += nb) {
            if (job < 2048) nsa_job(P, job, smem, DRY);
            else if (!DRY) {
                int pm, pn;
                if (!tile_map(job - 2048, 8, pm, pn)) continue;
                ALPlain al; al.A = ZA + C_QX; al.lda = ZW; al.ks = 64;
                EpiBf<0> ep{(bf16_t*)(ws + W_YX), 1024};
                gemm_tile<8, 4, true>(al, (const bf16_t*)(aux + O_WTXO), 256, 64, 256, pm, pn, ep, smem);
            }
        }
    } else if (PH == 5) {
        for (int job = bid; job < tile_count(32); job += nb) {
            int pm, pn;
            if (!tile_map(job, 32, pm, pn)) continue;
            ALPlain al; al.A = (const bf16_t*)(ws + W_U); al.lda = 64; al.ks = 16384 * 64;
            EpiMerge ep{ZA, (const bf16_t*)(ws + W_YX), (bf16_t*)(ws + W_Y)};
            gemm_tile<8, 3, true>(al, (const bf16_t*)(aux + O_WTB), 64, 3072 * 64, 1024, pm, pn, ep, smem);
        }
    } else if (PH == 6) {
        for (int job = bid; job < tile_count(8); job += nb) {
            int pm, pn;
            if (!tile_map(job, 8, pm, pn)) continue;
            ALPlain al; al.A = (const bf16_t*)(ws + W_Y); al.lda = 64; al.ks = 16384 * 64;
            EpiRes ep{P.x, (float*)(ws + W_H)};
            gemm_tile<8, 4, true>(al, (const bf16_t*)(aux + O_WTO), 64, 1024 * 64, 1024, pm, pn, ep, smem);
        }
    } else if (PH == 7) {
        for (int job = bid; job < 4096; job += nb) rownorm<false>((const float*)(ws + W_H), P.g_mlp, (bf16_t*)(ws + W_VN), nullptr, job * 4 + (threadIdx.x >> 6), true);
    } else if (PH == 8) {
        for (int job = bid; job < tile_count(32); job += nb) {
            int pm, pn;
            if (!tile_map(job, 32, pm, pn)) continue;
            ALPlain al; al.A = (const bf16_t*)(ws + W_VN); al.lda = 64; al.ks = 16384 * 64;
            EpiBf<1> ep{(bf16_t*)(ws + W_HID), 4096};
            gemm_tile<8, 4, true>(al, (const bf16_t*)(aux + O_WTUP), 64, 4096 * 64, 1024, pm, pn, ep, smem);
        }
    } else if (PH == 9) {
        for (int job = bid; job < tile_count(8); job += nb) {
            int pm, pn;
            if (!tile_map(job, 8, pm, pn)) continue;
            ALPlain al; al.A = (const bf16_t*)(ws + W_HID); al.lda = 64; al.ks = 16384 * 64;
            EpiRes ep{(const float*)(ws + W_H), (float*)(ws + W_H)};
            gemm_tile<8, 4, true>(al, (const bf16_t*)(aux + O_WTDN), 64, 1024 * 64, 4096, pm, pn, ep, smem);
        }
    } else if (PH == 10) {
        for (int job = bid; job < 4096; job += nb) rownorm<true>((const float*)(ws + W_H), P.g_final, nullptr, P.out, job * 4 + (threadIdx.x >> 6));
    }
}

#if MULTI
template <int PH>
__global__ void __launch_bounds__(256, 2) phase_kernel(Params P) {
    __shared__ __attribute__((aligned(16))) char smem[SMEM_BYTES];
    run_phase<PH>(P, smem);
}
#else
__global__ void __launch_bounds__(256, 2) mega_kernel(Params P) {
    __shared__ __attribute__((aligned(16))) char smem[SMEM_BYTES];
    cg::grid_group grid = cg::this_grid();
    __shared__ uint4 xb_words;
    if (threadIdx.x == 0) xb_words = make_uint4(0u, 0u, 0u, 0u);
    __syncthreads();
    XcdBarrier xb = xcd_barrier_post((unsigned*)(P.ws + W_BAR), (volatile LAS unsigned*)&xb_words);
    if (P.ws == nullptr) grid.sync();
#ifndef REP
#define REP -1
#endif
#define GSYNC() xcd_barrier(xb)
#define PHASE(k) { if (REP == k && k != 9) { run_phase<k, true>(P, smem); GSYNC(); } run_phase<k>(P, smem); GSYNC(); }
    PHASE(0) PHASE(1) PHASE(2) PHASE(3) PHASE(4) PHASE(5) PHASE(6) PHASE(7) PHASE(8) PHASE(9)
    if (REP == 10) { run_phase<10>(P, smem); GSYNC(); }
    if (REP == 11) { GSYNC(); GSYNC(); GSYNC(); GSYNC(); GSYNC(); GSYNC(); GSYNC(); GSYNC(); GSYNC(); GSYNC(); }
    run_phase<10>(P, smem);
}
#endif

extern "C" void kernel_launch(void* const* d_in, const int* in_sizes, int n_in, void* d_out, int out_size, void* d_ws, size_t ws_size,
                              hipStream_t stream) {
    Params P{};
    const float** pp = (const float**)&P;
    for (int i = 0; i < 25; ++i) pp[i] = (const float*)d_in[i];
    P.out = (float*)d_out;
    P.ws = (char*)d_ws;
#if MULTI
    const int G = 1024;
    phase_kernel<0><<<G, 256, 0, stream>>>(P);
    phase_kernel<1><<<G, 256, 0, stream>>>(P);
    phase_kernel<2><<<G, 256, 0, stream>>>(P);
    phase_kernel<3><<<G, 256, 0, stream>>>(P);
    phase_kernel<4><<<G, 256, 0, stream>>>(P);
    phase_kernel<5><<<G, 256, 0, stream>>>(P);
    phase_kernel<6><<<G, 256, 0, stream>>>(P);
    phase_kernel<7><<<G, 256, 0, stream>>>(P);
    phase_kernel<8><<<G, 256, 0, stream>>>(P);
    phase_kernel<9><<<G, 256, 0, stream>>>(P);
    phase_kernel<10><<<G, 256, 0, stream>>>(P);
#else
    static int grid_blocks = 0;
    if (!grid_blocks) {
        int dev = 0, cus = 0, per_cu = 0;
        hipGetDevice(&dev);
        hipDeviceGetAttribute(&cus, hipDeviceAttributeMultiprocessorCount, dev);
        hipOccupancyMaxActiveBlocksPerMultiprocessor(&per_cu, mega_kernel, 256, 0);
        if (per_cu > 2) per_cu = 2;
        if (per_cu < 1) per_cu = 1;
        grid_blocks = cus * per_cu;
    }
    hipMemsetAsync((char*)d_ws + W_BAR, 0, XCD_BAR_WORDS * 4, stream);
    void* args[] = {&P};
    hipError_t e = hipLaunchCooperativeKernel((void*)mega_kernel, dim3(grid_blocks), dim3(256), args, 0, stream);
    if (e != hipSuccess) fprintf(stderr, "cooperative launch failed: %s (grid %d)\n", hipGetErrorString(e), grid_blocks);
#endif
}
```

```cpp
#include <hip/hip_runtime.h>
#include <hip/hip_cooperative_groups.h>
#include <cstdint>
#include <cstdio>
namespace cg = cooperative_groups;

#ifndef MULTI
#define MULTI 0
#endif

typedef unsigned short bf16_t;
typedef short bf16x8 __attribute__((ext_vector_type(8)));
typedef float f32x4 __attribute__((ext_vector_type(4)));
typedef __bf16 bfv2 __attribute__((ext_vector_type(2)));
typedef float f32x2 __attribute__((ext_vector_type(2)));
typedef unsigned u32x4 __attribute__((ext_vector_type(4)));
typedef unsigned u32x2 __attribute__((ext_vector_type(2)));
#define DEV __device__ __forceinline__
DEV int opaque_tid() { int t = threadIdx.x; asm volatile("" : "+v"(t)); return t; }
#define MFMA16(a, b, c) __builtin_amdgcn_mfma_f32_16x16x32_bf16((a), (b), (c), 0, 0, 0)

constexpr int T = 16384, S = 2048;
constexpr int ZW = 4480;
constexpr int C_Q = 0, C_KC = 1024, C_VC = 1280, C_KS = 1536, C_KW = 1792, C_XR = 2048, C_GR = 3072, C_QX = 4096, C_G = 4352;
constexpr int NCMP = 127;
constexpr int NCROWS = 4064;

constexpr size_t O_WTA = 0;
constexpr size_t O_WTB = O_WTA + (size_t)4992 * 1024 * 2;
constexpr size_t O_WTUP = O_WTB + (size_t)3072 * 1024 * 2;
constexpr size_t O_WTDN = O_WTUP + (size_t)4096 * 1024 * 2;
constexpr size_t O_WTO = O_WTDN + (size_t)4096 * 1024 * 2;
constexpr size_t O_WTXO = O_WTO + (size_t)1024 * 1024 * 2;
constexpr size_t O_WTMKV = O_WTXO + (size_t)1024 * 256 * 2;
constexpr size_t O_WTCK1 = O_WTMKV + (size_t)512 * 1024 * 2;
constexpr size_t O_WTCV1 = O_WTCK1 + (size_t)256 * 2048 * 2;
constexpr size_t O_WAT = O_WTCV1 + (size_t)256 * 2048 * 2;
constexpr size_t O_WIT = O_WAT + (size_t)16 * 64 * 64 * 2;
constexpr size_t O_ROPEC = O_WIT + (size_t)16 * 64 * 64 * 2;
constexpr size_t O_ROPES = O_ROPEC + (size_t)2048 * 8 * 4;
constexpr size_t O_MEMN = O_ROPES + (size_t)2048 * 8 * 4;
constexpr size_t O_MEMK = O_MEMN + (size_t)2048 * 1024 * 2;
constexpr size_t O_MEMVT = O_MEMK + (size_t)2048 * 256 * 2;
constexpr size_t O_HIDK = O_MEMVT + (size_t)2048 * 256 * 2;
constexpr size_t O_HIDV = O_HIDK + (size_t)4096 * 256 * 2;
constexpr size_t O_KC = O_HIDV + (size_t)4096 * 256 * 2;
constexpr size_t O_VCT = O_KC + (size_t)32 * 128 * 64 * 2;
constexpr size_t O_AUX_END = O_VCT + (size_t)32 * 64 * 128 * 2;
static_assert(O_AUX_END <= (size_t)64 << 20, "aux overflow");
constexpr size_t MiB = (size_t)1 << 20;
constexpr size_t W_U = 0, W_ZA = 32 * MiB, W_VST = 172 * MiB, W_VWT = 180 * MiB, W_YX = 188 * MiB, W_Y = 220 * MiB;
constexpr size_t W_H = 32 * MiB, W_VN = 0, W_HID = 96 * MiB;

struct Params {
    const float *x, *mem, *g_mix, *w_in, *cpk, *cpv, *wk1, *wk2, *wv1, *wv2, *conv_w, *conv_b, *w_a, *b_a, *w_i, *b_i, *lam,
        *g_mem, *w_mkv, *w_xo, *w_o, *g_mlp, *w_up, *w_down, *g_final;
    float* out;
    char* ws;
};

DEV float bf2f(bf16_t h) { return __uint_as_float(((unsigned)h) << 16); }
DEV unsigned pk2(float lo, float hi) { f32x2 v = {lo, hi}; bfv2 b = __builtin_convertvector(v, bfv2); return __builtin_bit_cast(unsigned, b); }
DEV bf16_t f2bf(float f) { return (bf16_t)(pk2(f, 0.f) & 0xffffu); }
DEV float lo_f(unsigned u) { return __uint_as_float(u << 16); }
DEV float hi_f(unsigned u) { return __uint_as_float(u & 0xffff0000u); }
DEV float sigm(float x) { return __builtin_amdgcn_rcpf(1.f + __expf(-x)); }
DEV float gelu_t(float x) {
    float y = 0.7978845608028654f * (x + 0.044715f * x * x * x);
    float e = __expf(2.f * y);
    float th = 1.f - 2.f * __builtin_amdgcn_rcpf(1.f + e);
    return 0.5f * x * (1.f + th);
}
DEV float wave_sum(float v) {
#pragma unroll
    for (int o = 32; o >= 1; o >>= 1) v += __shfl_xor(v, o);
    return v;
}

DEV int map_col(int mapid, int r) {
    if (mapid == 0) return r;
    if (mapid == 1) {
        if (r < 1536) return r;
        if (r < 1792) return 1536 + (r - 1536);
        if (r < 2048) return 2048 + (r - 1792);
        if (r < 3072) return 2608 + (r - 2048);
        if (r < 4096) return 3632 + (r - 3072);
        if (r < 4352) return 4656 + (r - 4096);
        if (r < 4400) return 2560 + (r - 4352);
        if (r < 4480) return -1;
        if (r < 4736) return 1792 + (r - 4480);
        return 2304 + (r - 4736);
    }
    int pn = r / 96, rem = r - pn * 96, wc = rem / 48, rem2 = rem - wc * 48, gidx = rem2 >> 4, cc = rem2 & 15;
    return 4912 + gidx * 1024 + pn * 32 + wc * 16 + cc;
}

DEV void transpose_tile(const float* __restrict__ src, int ld, bf16_t* __restrict__ dst, int K, int r0, int k0, int mapid, char* smem, int nblk = 0) {
    float* sm = (float*)smem;
    const int tid = threadIdx.x, lane = tid & 63, w = tid >> 6;
    __syncthreads();
    const int sc = map_col(mapid, r0 + lane);
#pragma unroll
    for (int i = 0; i < 16; ++i) {
        int kk = w + 4 * i;
        float v = sc >= 0 ? src[(size_t)(k0 + kk) * ld + sc] : 0.f;
        sm[kk * 65 + lane] = v;
    }
    __syncthreads();
    const int rr = tid >> 2, kq = (tid & 3) * 16;
    unsigned o[8];
#pragma unroll
    for (int e = 0; e < 8; ++e) o[e] = pk2(sm[(kq + 2 * e) * 65 + rr], sm[(kq + 2 * e + 1) * 65 + rr]);
    uint4* dp = nblk ? (uint4*)(dst + (size_t)(k0 >> 6) * nblk * 64 + (size_t)(r0 + rr) * 64 + kq) : (uint4*)(dst + (size_t)(r0 + rr) * K + k0 + kq);
    dp[0] = make_uint4(o[0], o[1], o[2], o[3]);
    dp[1] = make_uint4(o[4], o[5], o[6], o[7]);
}

template <bool OUTF32>
DEV void rownorm(const float* __restrict__ src, const float* __restrict__ g, bf16_t* dstb, float* dstf, int row, bool blk = false) {
    const int lane = threadIdx.x & 63;
    const float4* sp = (const float4*)(src + (size_t)row * 1024);
    float4 v[4];
    float ss = 0.f;
#pragma unroll
    for (int i = 0; i < 4; ++i) { v[i] = sp[lane + 64 * i]; ss += v[i].x * v[i].x + v[i].y * v[i].y + v[i].z * v[i].z + v[i].w * v[i].w; }
    ss = wave_sum(ss);
    const float r = rsqrtf(ss * (1.0f / 1024.0f) + 1e-6f);
#pragma unroll
    for (int i = 0; i < 4; ++i) {
        float4 gg = ((const float4*)g)[lane + 64 * i];
        float a = v[i].x * r * gg.x, b = v[i].y * r * gg.y, c = v[i].z * r * gg.z, d = v[i].w * r * gg.w;
        if (OUTF32) ((float4*)(dstf + (size_t)row * 1024))[lane + 64 * i] = make_float4(a, b, c, d);
        else if (blk) { const int col = 4 * (lane + 64 * i); *(uint2*)(dstb + (size_t)(col >> 6) * ((size_t)16384 * 64) + (size_t)row * 64 + (col & 63)) = make_uint2(pk2(a, b), pk2(c, d)); }
        else ((uint2*)(dstb + (size_t)row * 1024))[lane + 64 * i] = make_uint2(pk2(a, b), pk2(c, d));
    }
}

DEV void rope_job(float* ct, float* st, int job) {
    const int e = job * 256 + threadIdx.x;
    const int pos = e >> 3, i = e & 7;
    const double inv = exp(-(double)i * 0.125 * 13.122363377404328);
    const double ang = (double)pos * inv;
    const double kq = rint(ang * 0.6366197723675814);
    const double r = ang - kq * 1.5707963267948966;
    const double r2 = r * r;
    const double sn = r * (1.0 + r2 * (-1.0 / 6 + r2 * (1.0 / 120 + r2 * (-1.0 / 5040 + r2 * (1.0 / 362880 + r2 * (-1.0 / 39916800 + r2 * (1.0 / 6227020800.0)))))));
    const double cs = 1.0 + r2 * (-0.5 + r2 * (1.0 / 24 + r2 * (-1.0 / 720 + r2 * (1.0 / 40320 + r2 * (-1.0 / 3628800 + r2 * (1.0 / 479001600.0))))));
    const int q = ((int)kq) & 3;
    double s_, c_;
    if (q == 0) { s_ = sn; c_ = cs; } else if (q == 1) { s_ = cs; c_ = -sn; } else if (q == 2) { s_ = -sn; c_ = -cs; } else { s_ = -cs; c_ = sn; }
    ct[e] = (float)c_; st[e] = (float)s_;
}

struct ALPlain {
    const bf16_t* A; int lda; int ks;
    const char* base; unsigned off0;
    DEV void init(int row0, int lrow, int lk) { base = (const char*)(A + (size_t)row0 * lda); off0 = (unsigned)(lrow * lda + lk) * 2u; }
    DEV u32x4 load(int i, int k0) const { return *(const u32x4*)(base + (off0 + (unsigned)(i * 64 * lda) + (unsigned)(k0 >> 6) * (unsigned)(ks * 2))); }
    DEV u32x4 fix(int, const u32x4& v, int) const { return v; }
};
struct ALCmp {
    const bf16_t* ZA; const float* spos; int colbase;
    unsigned roff[4]; int lk_;
    DEV void init(int row0, int lrow, int lk) {
        lk_ = lk;
#pragma unroll
        for (int i = 0; i < 4; ++i) {
            const int row = row0 + lrow + 32 * i;
            const int bg = row / NCMP, n = row - bg * NCMP, b = bg >> 2, g = bg & 3;
            roff[i] = row < NCROWS ? (unsigned)(((b * S + 16 * n) * ZW + colbase + g * 64 + lk) * 2) : 0xffffffffu;
        }
    }
    DEV u32x4 load(int i, int k0) const {
        if (roff[i] == 0xffffffffu) return (u32x4){0u, 0u, 0u, 0u};
        return *(const u32x4*)((const char*)ZA + (roff[i] + (unsigned)((k0 >> 6) * ZW * 2)));
    }
    DEV u32x4 fix(int i, const u32x4& v, int k0) const {
        if (roff[i] == 0xffffffffu) return v;
        const float4 p0 = *(const float4*)(spos + k0 + lk_), p1 = *(const float4*)(spos + k0 + lk_ + 4);
        u32x4 o;
        o.x = pk2(lo_f(v.x) + p0.x, hi_f(v.x) + p0.y); o.y = pk2(lo_f(v.y) + p0.z, hi_f(v.y) + p0.w);
        o.z = pk2(lo_f(v.z) + p1.x, hi_f(v.z) + p1.y); o.w = pk2(lo_f(v.w) + p1.z, hi_f(v.w) + p1.w);
        return o;
    }
};

template <int TM, int TN, bool SWAP, class AL, class EP>
DEV void gemm_tile(AL al, const bf16_t* __restrict__ Bt, int ldb, int bks, int K, int pm, int pn, const EP& ep, char* smem) {
    constexpr int BM = TM * 32, BN = TN * 32, NA = TM, NBB = TN;
    bf16_t* sA = (bf16_t*)smem;
    bf16_t* sB = sA + BM * 80;
    const int tid = opaque_tid(), wid = tid >> 6, lane = tid & 63, wr = wid >> 1, wc = wid & 1, fr = lane & 15, fq = lane >> 4;
    f32x4 acc[TM][TN];
#pragma unroll
    for (int m = 0; m < TM; ++m)
#pragma unroll
        for (int n = 0; n < TN; ++n) acc[m][n] = (f32x4){0.f, 0.f, 0.f, 0.f};
    const int lrow = tid >> 3, lk = (tid & 7) * 8;
    u32x4 ra[NA], rb[NBB];
    al.init(pm * BM, lrow, lk);
    const char* bbase = (const char*)(Bt + (size_t)(pn * BN) * ldb);
    const unsigned boff = (unsigned)(lrow * ldb + lk) * 2u;
#pragma unroll
    for (int i = 0; i < NA; ++i) ra[i] = al.load(i, 0);
#pragma unroll
    for (int i = 0; i < NBB; ++i) rb[i] = *(const u32x4*)(bbase + (boff + (unsigned)(i * 64 * ldb)));
    int nk = K >> 6;
    asm volatile("" : "+s"(nk));
    bf16_t* sWa = sA + lrow * 80 + lk;
    bf16_t* sWb = sB + lrow * 80 + lk;
    const bf16_t* sAr = sA + (wr * TM * 16 + fr) * 80 + fq * 8;
    const bf16_t* sBr = sB + (wc * TN * 16 + fr) * 80 + fq * 8;
#pragma unroll 1
    for (int kt = 0; kt < nk; ++kt) {
        __syncthreads();
#pragma unroll
        for (int i = 0; i < NA; ++i) *(u32x4*)(sWa + (32 * i) * 80) = al.fix(i, ra[i], kt * 64);
#pragma unroll
        for (int i = 0; i < NBB; ++i) *(u32x4*)(sWb + (32 * i) * 80) = rb[i];
        __syncthreads();
        if (kt + 1 < nk) {
            const int k0 = (kt + 1) * 64;
#pragma unroll
            for (int i = 0; i < NA; ++i) ra[i] = al.load(i, k0);
#pragma unroll
            for (int i = 0; i < NBB; ++i) rb[i] = *(const u32x4*)(bbase + (boff + (unsigned)(i * 64 * ldb) + (unsigned)(k0 >> 6) * (unsigned)(bks * 2)));
        }
        __builtin_amdgcn_sched_barrier(0);
        __builtin_amdgcn_s_setprio(1);
#pragma unroll
        for (int ks = 0; ks < 2; ++ks) {
            bf16x8 bfr[TN];
#pragma unroll
            for (int n = 0; n < TN; ++n) bfr[n] = *(const bf16x8*)(sBr + (n * 16) * 80 + ks * 32);
#pragma unroll
            for (int m = 0; m < TM; ++m) {
                const bf16x8 af = *(const bf16x8*)(sAr + (m * 16) * 80 + ks * 32);
#pragma unroll
                for (int n = 0; n < TN; ++n) acc[m][n] = SWAP ? MFMA16(bfr[n], af, acc[m][n]) : MFMA16(af, bfr[n], acc[m][n]);
            }
        }
        __builtin_amdgcn_s_setprio(0);
    }
    ep.run(acc, pm * BM + wr * TM * 16, pn * BN + wc * TN * 16, fr, fq);
}

DEV uint2 pk4(const f32x4& a) { return make_uint2(pk2(a[0], a[1]), pk2(a[2], a[3])); }

template <bool SWAP>
struct EpiZA {
    bf16_t *ZA, *VST, *VWT; const float *ropec, *ropes;
    DEV void run(f32x4 (&acc)[8][4], int R0, int C0, int fr, int fq) const {
#pragma unroll
        for (int n = 0; n < 4; ++n) {
            const int col0 = C0 + n * 16;
#pragma unroll
            for (int m = 0; m < 8; ++m) {
                f32x4 a = acc[m][n];
                if (!SWAP) {
                    const int r = R0 + m * 16 + 4 * fq;
                    int c = col0 - 4480 + fr;
                    bf16_t* dst = (c < 256) ? VST : VWT;
                    c &= 255;
                    const int g = c >> 6, d = c & 63, b = r >> 11, t = r & 2047;
                    *(uint2*)(dst + ((size_t)((b * 4 + g) * 64 + d)) * S + t) = pk4(a);
                } else {
                    const int row = R0 + m * 16 + fr;
                    const bool rope = (col0 < 1024 || (col0 >= 1536 && col0 < 2048)) && ((col0 & 63) == 0);
                    if (rope) {
                        const int t = row & 2047, i0 = 4 * (fq & 1);
                        const float4 cs = *(const float4*)(ropec + t * 8 + i0), sn = *(const float4*)(ropes + t * 8 + i0);
                        const float c4[4] = {cs.x, cs.y, cs.z, cs.w}, s4[4] = {sn.x, sn.y, sn.z, sn.w};
#pragma unroll
                        for (int j = 0; j < 4; ++j) {
                            const float pr = __shfl_xor(a[j], 32);
                            a[j] = (fq & 2) ? (a[j] * c4[j] + pr * s4[j]) : (a[j] * c4[j] - pr * s4[j]);
                        }
                    }
                    if (col0 >= C_G) {
#pragma unroll
                        for (int j = 0; j < 4; ++j) a[j] = sigm(a[j]);
                    }
                    *(uint2*)(ZA + (size_t)row * ZW + col0 + 4 * fq) = pk4(a);
                }
            }
        }
    }
};
template <bool SWAP>
struct EpiMemKV {
    bf16_t *MK, *MVT;
    DEV void run(f32x4 (&acc)[8][4], int R0, int C0, int fr, int fq) const {
#pragma unroll
        for (int n = 0; n < 4; ++n)
#pragma unroll
            for (int m = 0; m < 8; ++m) {
                if (SWAP) {
                    const int c = C0 + n * 16 + 4 * fq, r = R0 + m * 16 + fr;
                    const int h = (c >> 6) & 3, d = c & 63, b = r >> 8, mm = r & 255;
                    *(uint2*)(MK + ((size_t)(b * 4 + h) * 256 + mm) * 64 + d) = pk4(acc[m][n]);
                } else {
                    const int c = C0 + n * 16 + fr, r = R0 + m * 16 + 4 * fq;
                    const int h = (c >> 6) & 3, d = c & 63, b = r >> 8, mm = r & 255;
                    *(uint2*)(MVT + ((size_t)(b * 4 + h) * 64 + d) * 256 + mm) = pk4(acc[m][n]);
                }
            }
    }
};
struct EpiHid {
    bf16_t* H;
    DEV void run(f32x4 (&acc)[4][4], int R0, int C0, int fr, int fq) const {
#pragma unroll
        for (int n = 0; n < 4; ++n)
#pragma unroll
            for (int m = 0; m < 4; ++m) {
                const int c = C0 + n * 16 + 4 * fq, r = R0 + m * 16 + fr;
                f32x4 a = acc[m][n];
#pragma unroll
                for (int j = 0; j < 4; ++j) a[j] = gelu_t(a[j]);
                if (r < NCROWS) *(uint2*)(H + (size_t)r * 256 + c) = pk4(a);
            }
    }
};
template <int ACT>
struct EpiBf {
    bf16_t* O; int ldo;
    DEV void run(f32x4 (&acc)[8][4], int R0, int C0, int fr, int fq) const {
#pragma unroll
        for (int n = 0; n < 4; ++n)
#pragma unroll
            for (int m = 0; m < 8; ++m) {
                const int c = C0 + n * 16 + 4 * fq, r = R0 + m * 16 + fr;
                f32x4 a = acc[m][n];
                if (ACT == 1) {
#pragma unroll
                    for (int j = 0; j < 4; ++j) { const float v = fmaxf(a[j], 0.f); a[j] = v * v; }
                }
                if (ACT == 1) *(uint2*)(O + (size_t)(c >> 6) * ((size_t)16384 * 64) + (size_t)r * 64 + (c & 63)) = pk4(a);
                else *(uint2*)(O + (size_t)r * ldo + c) = pk4(a);
            }
    }
};
struct EpiRes {
    const float* R; float* O;
    DEV void run(f32x4 (&acc)[8][4], int R0, int C0, int fr, int fq) const {
#pragma unroll
        for (int n = 0; n < 4; ++n)
#pragma unroll
            for (int m = 0; m < 8; ++m) {
                const size_t o = (size_t)(R0 + m * 16 + fr) * 1024 + C0 + n * 16 + 4 * fq;
                const f32x4 r = *(const f32x4*)(R + o);
                *(f32x4*)(O + o) = r + acc[m][n];
            }
    }
};
struct EpiMerge {
    const bf16_t *ZA, *YX; bf16_t* Y;
    DEV void run(f32x4 (&acc)[8][3], int R0, int C0, int fr, int fq) const {
        const int ch = (C0 / 48) * 16 + 4 * fq;
#pragma unroll
        for (int m = 0; m < 8; ++m) {
            const size_t row = (size_t)(R0 + m * 16 + fr);
            const uint2 a = *(const uint2*)(ZA + row * ZW + C_Q + ch), b = *(const uint2*)(ZA + row * ZW + C_GR + ch), c = *(const uint2*)(YX + row * 1024 + ch);
            f32x4 y;
            y[0] = sigm(acc[m][0][0]) * lo_f(a.x) + sigm(acc[m][1][0]) * lo_f(b.x) + sigm(acc[m][2][0]) * lo_f(c.x);
            y[1] = sigm(acc[m][0][1]) * hi_f(a.x) + sigm(acc[m][1][1]) * hi_f(b.x) + sigm(acc[m][2][1]) * hi_f(c.x);
            y[2] = sigm(acc[m][0][2]) * lo_f(a.y) + sigm(acc[m][1][2]) * lo_f(b.y) + sigm(acc[m][2][2]) * lo_f(c.y);
            y[3] = sigm(acc[m][0][3]) * hi_f(a.y) + sigm(acc[m][1][3]) * hi_f(b.y) + sigm(acc[m][2][3]) * hi_f(c.y);
            *(uint2*)(Y + (size_t)(ch >> 6) * ((size_t)16384 * 64) + row * 64 + (ch & 63)) = pk4(y);
        }
    }
};

DEV bool tile_map(int idx, int NT, int& pm, int& pn) {
    const int x = idx & 7, pl = (idx >> 3) & 7, pmid = (idx >> 6) & 7, st = idx >> 9;
    pm = pmid * 8 + x;
    pn = st * 8 + pl;
    return pn < NT;
}
DEV int tile_count(int NT) { return ((NT + 7) / 8) * 512; }

DEV void cmp2_job(const Params& P, int job) {
    char* aux = (char*)P.out;
    const int lane = threadIdx.x & 63, w = threadIdx.x >> 6;
    const int wj = job * 4 + w;
    const int which = wj >= NCROWS ? 1 : 0;
    const int r = wj - which * NCROWS;
    const int bg = r / NCMP, n = r - bg * NCMP;
    const bf16_t* hid = (const bf16_t*)(aux + (which ? O_HIDV : O_HIDK)) + (size_t)r * 256;
    const float* w2 = which ? P.wv2 : P.wk2;
    float acc = 0.f;
#pragma unroll 8
    for (int k = 0; k < 256; ++k) acc += bf2f(hid[k]) * w2[k * 64 + lane];
    if (!which) {
        const int pos = 16 * n + 31, i = lane & 7;
        const float cs = ((const float*)(aux + O_ROPEC))[pos * 8 + i], sn = ((const float*)(aux + O_ROPES))[pos * 8 + i];
        const float pr = __shfl_xor(acc, 8);
        float o = acc;
        if (lane < 16) o = (lane & 8) ? (acc * cs + pr * sn) : (acc * cs - pr * sn);
        bf16_t* KC = (bf16_t*)(aux + O_KC);
        KC[((size_t)bg * 128 + n) * 64 + lane] = f2bf(o);
        if (n == NCMP - 1) KC[((size_t)bg * 128 + 127) * 64 + lane] = 0;
    } else {
        bf16_t* VCT = (bf16_t*)(aux + O_VCT);
        VCT[((size_t)bg * 64 + lane) * 128 + n] = f2bf(acc);
        if (n == NCMP - 1) VCT[((size_t)bg * 64 + lane) * 128 + 127] = 0;
    }
}

DEV void rnn_job(const Params& P, int job, char* smem, bool dry) {
    char* aux = (char*)P.out;
    bf16_t* ZA = (bf16_t*)(P.ws + W_ZA);
    const int b = job >> 6, n = (job >> 2) & 15, ct = job & 3;
    bf16_t* sX = (bf16_t*)smem;
    float* sXf = (float*)(smem + 10240);
    float* sCw = (float*)(smem + 10240 + 16640);
    float* sSum = (float*)(smem + 10240 + 16640 + 1280);
    bf16_t* sRaw = (bf16_t*)(smem + 10240 + 16640 + 1280 + 2048);
    const int tid = opaque_tid(), w = tid >> 6, lane = tid & 63, fr = lane & 15, fq = lane >> 4;
    const bf16_t* WAT = (const bf16_t*)(aux + O_WAT) + n * 4096;
    const bf16_t* WIT = (const bf16_t*)(aux + O_WIT) + n * 4096;
    bf16x8 wa[2], wi[2];
#pragma unroll
    for (int ks = 0; ks < 2; ++ks) {
        wa[ks] = *(const bf16x8*)(WAT + (16 * ct + fr) * 64 + 32 * ks + 8 * fq);
        wi[ks] = *(const bf16x8*)(WIT + (16 * ct + fr) * 64 + 32 * ks + 8 * fq);
    }
    const int c = n * 64 + 16 * ct + fr;
    const float ba = P.b_a[c], bi = P.b_i[c], cl = -8.0f * log1pf(__expf(-P.lam[c]));
    float carry = 0.f;
    __syncthreads();
    for (int i = tid; i < 320; i += 256) sCw[i] = (i < 256) ? P.conv_w[(i >> 6) * 1024 + n * 64 + (i & 63)] : P.conv_b[n * 64 + (i & 63)];
    const int lt = tid >> 2, cg = (tid & 3) * 16;
    const bf16_t* xbase = ZA + (size_t)(b * S) * ZW + C_XR + n * 64 + cg;
    bf16_t* sRaw2 = sRaw + 67 * 72;
    u32x4 xm0, xm1, xh0 = {0u, 0u, 0u, 0u}, xh1 = {0u, 0u, 0u, 0u};
    { const u32x4* xp = (const u32x4*)(xbase + (size_t)lt * ZW); xm0 = xp[0]; xm1 = xp[1]; }
    *(u32x4*)(sRaw + (lt + 3) * 72 + cg) = xm0; *(u32x4*)(sRaw + (lt + 3) * 72 + cg + 8) = xm1;
    if (tid < 12) { *(u32x4*)(sRaw + lt * 72 + cg) = xh0; *(u32x4*)(sRaw + lt * 72 + cg + 8) = xh1; }
    { const u32x4* xp = (const u32x4*)(xbase + (size_t)(64 + lt) * ZW); xm0 = xp[0]; xm1 = xp[1];
      if (tid < 12) { const u32x4* hp = (const u32x4*)(xbase + (size_t)(61 + lt) * ZW); xh0 = hp[0]; xh1 = hp[1]; } }
    __syncthreads();
#pragma unroll 1
    for (int chunk = 0; chunk < 32; ++chunk) {
        const int tc = chunk * 64;
        const bf16_t* rawc = (chunk & 1) ? sRaw2 : sRaw;
        bf16_t* rawn = (chunk & 1) ? sRaw : sRaw2;
        bf16_t gv[4];
#pragma unroll
        for (int j = 0; j < 4; ++j) gv[j] = ZA[(size_t)(b * S + tc + 16 * w + 4 * fq + j) * ZW + C_GR + n * 64 + 16 * ct + fr];
        {
            float xv[16];
#pragma unroll
            for (int e4 = 0; e4 < 4; ++e4) { const float4 bb = *(const float4*)(sCw + 256 + cg + 4 * e4); xv[4 * e4] = bb.x; xv[4 * e4 + 1] = bb.y; xv[4 * e4 + 2] = bb.z; xv[4 * e4 + 3] = bb.w; }
#pragma unroll
            for (int k = 0; k < 4; ++k) {
                const u32x4 v0 = *(const u32x4*)(rawc + (lt + k) * 72 + cg), v1 = *(const u32x4*)(rawc + (lt + k) * 72 + cg + 8);
                const unsigned u[8] = {v0.x, v0.y, v0.z, v0.w, v1.x, v1.y, v1.z, v1.w};
#pragma unroll
                for (int e4 = 0; e4 < 4; ++e4) {
                    const float4 wv = *(const float4*)(sCw + k * 64 + cg + 4 * e4);
                    xv[4 * e4] += wv.x * lo_f(u[2 * e4]);
                    xv[4 * e4 + 1] += wv.y * hi_f(u[2 * e4]);
                    xv[4 * e4 + 2] += wv.z * lo_f(u[2 * e4 + 1]);
                    xv[4 * e4 + 3] += wv.w * hi_f(u[2 * e4 + 1]);
                }
            }
            if ((tid & 3) == ct) {
#pragma unroll
                for (int e = 0; e < 16; ++e) sXf[lt * 17 + e] = xv[e];
            }
            u32x4 o0 = {pk2(xv[0], xv[1]), pk2(xv[2], xv[3]), pk2(xv[4], xv[5]), pk2(xv[6], xv[7])};
            u32x4 o1 = {pk2(xv[8], xv[9]), pk2(xv[10], xv[11]), pk2(xv[12], xv[13]), pk2(xv[14], xv[15])};
            *(u32x4*)(sX + lt * 80 + cg) = o0;
            *(u32x4*)(sX + lt * 80 + cg + 8) = o1;
        }
        __syncthreads();
        f32x4 R = (f32x4){0.f, 0.f, 0.f, 0.f}, I = (f32x4){0.f, 0.f, 0.f, 0.f};
#pragma unroll
        for (int ks = 0; ks < 2; ++ks) {
            const bf16x8 af = *(const bf16x8*)(sX + (16 * w + fr) * 80 + 32 * ks + 8 * fq);
            R = MFMA16(af, wa[ks], R); I = MFMA16(af, wi[ks], I);
        }
        if (chunk + 1 < 32) {
            *(u32x4*)(rawn + (lt + 3) * 72 + cg) = xm0; *(u32x4*)(rawn + (lt + 3) * 72 + cg + 8) = xm1;
            if (tid < 12) { *(u32x4*)(rawn + lt * 72 + cg) = xh0; *(u32x4*)(rawn + lt * 72 + cg + 8) = xh1; }
        }
        float hl[4], pc[4];
        float h = 0.f, pcum = 1.f;
#pragma unroll
        for (int j = 0; j < 4; ++j) {
            const float xcv = sXf[(16 * w + 4 * fq + j) * 17 + fr];
            const float rg = sigm(R[j] + ba), gi = sigm(I[j] + bi);
            const float la = rg * cl;
            const float a_ = __expf(la);
            const float mult = sqrtf(fmaxf(1.f - a_ * a_, 0.f));
            const float u = mult * gi * xcv;
            h = a_ * h + u; pcum *= a_;
            hl[j] = h; pc[j] = pcum;
        }
        float A = pcum, H = h;
        float A1 = __shfl_up(A, 16), H1 = __shfl_up(H, 16);
        if (fq >= 1) { H = A * H1 + H; A = A * A1; }
        float A2 = __shfl_up(A, 32), H2 = __shfl_up(H, 32);
        if (fq >= 2) { H = A * H2 + H; A = A * A2; }
        float Ax = __shfl_up(A, 16), Hx = __shfl_up(H, 16);
        const float Ae = fq == 0 ? 1.f : Ax, He = fq == 0 ? 0.f : Hx;
        if (fq == 3) { sSum[w * 16 + fr] = A; sSum[64 + w * 16 + fr] = H; }
        __syncthreads();
        if (chunk + 2 < 32) {
            const u32x4* xp = (const u32x4*)(xbase + (size_t)(tc + 128 + lt) * ZW); xm0 = xp[0]; xm1 = xp[1];
            if (tid < 12) { const u32x4* hp = (const u32x4*)(xbase + (size_t)(tc + 125 + lt) * ZW); xh0 = hp[0]; xh1 = hp[1]; }
        }
        float cin = carry, mycin = 0.f;
#pragma unroll
        for (int ww = 0; ww < 4; ++ww) {
            if (ww == w) mycin = cin;
            cin = sSum[ww * 16 + fr] * cin + sSum[64 + ww * 16 + fr];
        }
        carry = cin;
        const float sq = Ae * mycin + He;
#pragma unroll
        for (int j = 0; j < 4; ++j) {
            const float hfin = hl[j] + pc[j] * sq;
            const size_t grow = (size_t)(b * S + tc + 16 * w + 4 * fq + j);
            bf16_t* op = dry ? ((bf16_t*)(P.ws + W_YX) + grow * 1024 + n * 64 + 16 * ct + fr) : (ZA + grow * ZW + C_GR + n * 64 + 16 * ct + fr);
            *op = f2bf(gelu_t(bf2f(gv[j])) * hfin);
        }
    }
}

constexpr float EXPC = 0.125f * 1.4426950408889634f;
struct AttnAcc { f32x4 o[4][2]; float m[2], l[2]; };
DEV void attn_init(AttnAcc& a) {
#pragma unroll
    for (int d = 0; d < 4; ++d)
#pragma unroll
        for (int q = 0; q < 2; ++q) a.o[d][q] = (f32x4){0.f, 0.f, 0.f, 0.f};
    a.m[0] = a.m[1] = -INFINITY; a.l[0] = a.l[1] = 0.f;
}
DEV bf16x8 mk8(unsigned a, unsigned b, unsigned c, unsigned d) { u32x4 u = {a, b, c, d}; return __builtin_bit_cast(bf16x8, u); }

template <class MF>
DEV void attn_step(const bf16_t* sK, const bf16_t* sVt, int vstride, const bf16x8 (&qf)[2][2], AttnAcc& st, const MF& mf, int fr, int fq) {
    f32x4 s[4][2];
#pragma unroll
    for (int kt = 0; kt < 4; ++kt) {
        s[kt][0] = (f32x4){0.f, 0.f, 0.f, 0.f}; s[kt][1] = (f32x4){0.f, 0.f, 0.f, 0.f};
#pragma unroll
        for (int ks = 0; ks < 2; ++ks) {
            const bf16x8 kf = *(const bf16x8*)(sK + (16 * kt + fr) * 80 + 32 * ks + 8 * fq);
            s[kt][0] = MFMA16(kf, qf[0][ks], s[kt][0]);
            s[kt][1] = MFMA16(kf, qf[1][ks], s[kt][1]);
        }
    }
#pragma unroll
    for (int qt = 0; qt < 2; ++qt) {
        float mx = -INFINITY;
#pragma unroll
        for (int kt = 0; kt < 4; ++kt)
#pragma unroll
            for (int j = 0; j < 4; ++j) {
                const float v = mf(qt, 16 * kt + 4 * fq + j) ? s[kt][qt][j] : -INFINITY;
                s[kt][qt][j] = v; mx = fmaxf(mx, v);
            }
        mx = fmaxf(mx, __shfl_xor(mx, 16)); mx = fmaxf(mx, __shfl_xor(mx, 32));
        const float mn = fmaxf(st.m[qt], mx);
        float alpha = 1.f, msub = 0.f;
        if (mn != -INFINITY) { alpha = __builtin_amdgcn_exp2f((st.m[qt] - mn) * EXPC); msub = mn; }
        st.m[qt] = mn;
        float ps = 0.f;
#pragma unroll
        for (int kt = 0; kt < 4; ++kt)
#pragma unroll
            for (int j = 0; j < 4; ++j) { const float p = __builtin_amdgcn_exp2f((s[kt][qt][j] - msub) * EXPC); s[kt][qt][j] = p; ps += p; }
        st.l[qt] = st.l[qt] * alpha + ps;
#pragma unroll
        for (int dt = 0; dt < 4; ++dt) st.o[dt][qt] *= alpha;
    }
#pragma unroll
    for (int ks = 0; ks < 2; ++ks) {
        bf16x8 pf[2];
#pragma unroll
        for (int qt = 0; qt < 2; ++qt)
            pf[qt] = mk8(pk2(s[2 * ks][qt][0], s[2 * ks][qt][1]), pk2(s[2 * ks][qt][2], s[2 * ks][qt][3]),
                         pk2(s[2 * ks + 1][qt][0], s[2 * ks + 1][qt][1]), pk2(s[2 * ks + 1][qt][2], s[2 * ks + 1][qt][3]));
#pragma unroll
        for (int dt = 0; dt < 4; ++dt) {
            const u32x2 v0 = *(const u32x2*)(sVt + (16 * dt + fr) * vstride + 32 * ks + 4 * fq);
            const u32x2 v1 = *(const u32x2*)(sVt + (16 * dt + fr) * vstride + 32 * ks + 16 + 4 * fq);
            const bf16x8 vf = mk8(v0.x, v0.y, v1.x, v1.y);
            st.o[dt][0] = MFMA16(vf, pf[0], st.o[dt][0]);
            st.o[dt][1] = MFMA16(vf, pf[1], st.o[dt][1]);
        }
    }
}
DEV void attn_step_fast(const bf16_t* sK, const bf16_t* sVt, const bf16x8 (&qf)[2][2], AttnAcc& st, const float (&bitoff)[2], int fr, int fq) {
    f32x4 s[4][2];
#pragma unroll
    for (int kt = 0; kt < 4; ++kt) {
        s[kt][0] = (f32x4){0.f, 0.f, 0.f, 0.f}; s[kt][1] = (f32x4){0.f, 0.f, 0.f, 0.f};
#pragma unroll
        for (int ks = 0; ks < 2; ++ks) {
            const bf16x8 kf = *(const bf16x8*)(sK + (16 * kt + fr) * 80 + 32 * ks + 8 * fq);
            s[kt][0] = MFMA16(kf, qf[0][ks], s[kt][0]);
            s[kt][1] = MFMA16(kf, qf[1][ks], s[kt][1]);
        }
    }
#pragma unroll
    for (int qt = 0; qt < 2; ++qt) {
        float mx = fmaxf(fmaxf(s[0][qt][0], s[0][qt][1]), fmaxf(s[0][qt][2], s[0][qt][3]));
#pragma unroll
        for (int kt = 1; kt < 4; ++kt) mx = fmaxf(mx, fmaxf(fmaxf(s[kt][qt][0], s[kt][qt][1]), fmaxf(s[kt][qt][2], s[kt][qt][3])));
        mx = fmaxf(mx, __shfl_xor(mx, 16)); mx = fmaxf(mx, __shfl_xor(mx, 32));
        const float mn = fmaxf(st.m[qt], mx);
        const float alpha = __builtin_amdgcn_exp2f((st.m[qt] - mn) * EXPC);
        st.m[qt] = mn;
        const float off = bitoff[qt] - mn * EXPC;
        float ps = 0.f;
#pragma unroll
        for (int kt = 0; kt < 4; ++kt)
#pragma unroll
            for (int j = 0; j < 4; ++j) { const float p = __builtin_amdgcn_exp2f(fmaf(s[kt][qt][j], EXPC, off)); s[kt][qt][j] = p; ps += p; }
        st.l[qt] = st.l[qt] * alpha + ps;
#pragma unroll
        for (int dt = 0; dt < 4; ++dt) st.o[dt][qt] *= alpha;
    }
#pragma unroll
    for (int ks = 0; ks < 2; ++ks) {
        bf16x8 pf[2];
#pragma unroll
        for (int qt = 0; qt < 2; ++qt)
            pf[qt] = mk8(pk2(s[2 * ks][qt][0], s[2 * ks][qt][1]), pk2(s[2 * ks][qt][2], s[2 * ks][qt][3]),
                         pk2(s[2 * ks + 1][qt][0], s[2 * ks + 1][qt][1]), pk2(s[2 * ks + 1][qt][2], s[2 * ks + 1][qt][3]));
#pragma unroll
        for (int dt = 0; dt < 4; ++dt) {
            const u32x2 v0 = *(const u32x2*)(sVt + (16 * dt + fr) * 72 + 32 * ks + 4 * fq);
            const u32x2 v1 = *(const u32x2*)(sVt + (16 * dt + fr) * 72 + 32 * ks + 16 + 4 * fq);
            const bf16x8 vf = mk8(v0.x, v0.y, v1.x, v1.y);
            st.o[dt][0] = MFMA16(vf, pf[0], st.o[dt][0]);
            st.o[dt][1] = MFMA16(vf, pf[1], st.o[dt][1]);
        }
    }
}
DEV void attn_fold_out(bf16_t* const (&op)[2], const AttnAcc& st, const float (&gate)[2]) {
#pragma unroll
    for (int qt = 0; qt < 2; ++qt) {
        float l = st.l[qt];
        l += __shfl_xor(l, 16); l += __shfl_xor(l, 32);
        const float sc = gate[qt] * __builtin_amdgcn_rcpf(fmaxf(l, 1e-30f));
#pragma unroll
        for (int dt = 0; dt < 4; ++dt) {
            const uint2 pv = *(const uint2*)(op[qt] + 16 * dt);
            f32x4 r = st.o[dt][qt] * sc;
            r[0] += lo_f(pv.x); r[1] += hi_f(pv.x); r[2] += lo_f(pv.y); r[3] += hi_f(pv.y);
            *(uint2*)(op[qt] + 16 * dt) = make_uint2(pk2(r[0], r[1]), pk2(r[2], r[3]));
        }
    }
}
DEV void attn_fold(f32x4 (&tot)[4][2], const AttnAcc& st, const float (&gate)[2]) {
#pragma unroll
    for (int qt = 0; qt < 2; ++qt) {
        float l = st.l[qt];
        l += __shfl_xor(l, 16); l += __shfl_xor(l, 32);
        const float sc = gate[qt] * __builtin_amdgcn_rcpf(fmaxf(l, 1e-30f));
#pragma unroll
        for (int dt = 0; dt < 4; ++dt) tot[dt][qt] += st.o[dt][qt] * sc;
    }
}
DEV void ld64(u32x4 (&r)[2], const bf16_t* src, size_t sstride, int tid) {
#pragma unroll
    for (int i = 0; i < 2; ++i) { const int c = tid + 256 * i; r[i] = *(const u32x4*)(src + (size_t)(c >> 3) * sstride + (c & 7) * 8); }
}
DEV void st64(bf16_t* dst, const u32x4 (&r)[2], int tid, int stride) {
#pragma unroll
    for (int i = 0; i < 2; ++i) { const int c = tid + 256 * i; *(u32x4*)(dst + (c >> 3) * stride + (c & 7) * 8) = r[i]; }
}

#define OUTP(QT) ((dry ? (bf16_t*)(P.ws + W_YX) + (size_t)(b * S + tq[QT]) * 1024 : ZA + (size_t)(b * S + tq[QT]) * ZW + C_Q) + head * 64 + 4 * fq)
#define LOAD_GATE(G2, BR) float G2[2]; { G2[0] = bf2f(ZA[(size_t)(b * S + tq[0]) * ZW + C_G + head * 3 + (BR)]); G2[1] = bf2f(ZA[(size_t)(b * S + tq[1]) * ZW + C_G + head * 3 + (BR)]); }
struct MaskAll { DEV bool operator()(int, int) const { return true; } };
struct MaskSel { unsigned bit[2]; int t[2]; int k0; DEV bool operator()(int qt, int kk) const { return bit[qt] && (k0 + kk <= t[qt]); } };
struct MaskWin { int t[2]; int k0; DEV bool operator()(int qt, int kk) const { const int k = k0 + kk; return k <= t[qt] && k > t[qt] - 512; } };

DEV void xattn_job(const Params& P, int job, char* smem, bool dry) {
    char* aux = (char*)P.out;
    bf16_t* ZA = (bf16_t*)(P.ws + W_ZA);
    const int qb = job & 15, h = (job >> 4) & 3, b = job >> 6;
    bf16_t* sK = (bf16_t*)smem;
    bf16_t* sVt = sK + 64 * 80;
    const int tid = opaque_tid(), w = tid >> 6, lane = tid & 63, fr = lane & 15, fq = lane >> 4;
    const int t0 = qb * 128 + w * 32;
    bf16x8 qf[2][2];
#pragma unroll
    for (int qt = 0; qt < 2; ++qt)
#pragma unroll
        for (int ks = 0; ks < 2; ++ks) qf[qt][ks] = *(const bf16x8*)(ZA + (size_t)(b * S + t0 + 16 * qt + fr) * ZW + C_QX + h * 64 + 32 * ks + 8 * fq);
    const bf16_t* MK = (const bf16_t*)(aux + O_MEMK) + (size_t)(b * 4 + h) * 256 * 64;
    const bf16_t* MVT = (const bf16_t*)(aux + O_MEMVT) + (size_t)(b * 4 + h) * 64 * 256;
    AttnAcc st; attn_init(st);
    u32x4 rk[2], rv[2];
    ld64(rk, MK, 64, tid); ld64(rv, MVT, 256, tid);
#pragma unroll 1
    for (int jb = 0; jb < 4; ++jb) {
        __syncthreads();
        st64(sK, rk, tid, 80); st64(sVt, rv, tid, 72);
        __syncthreads();
        if (jb + 1 < 4) { ld64(rk, MK + (size_t)(jb + 1) * 64 * 64, 64, tid); ld64(rv, MVT + (jb + 1) * 64, 256, tid); }
        __builtin_amdgcn_sched_barrier(0);
        { const float z2[2] = {0.f, 0.f}; attn_step_fast(sK, sVt, qf, st, z2, fr, fq); }
    }
    f32x4 tot[4][2];
#pragma unroll
    for (int dt = 0; dt < 4; ++dt) { tot[dt][0] = (f32x4){0.f, 0.f, 0.f, 0.f}; tot[dt][1] = (f32x4){0.f, 0.f, 0.f, 0.f}; }
    const float one[2] = {1.f, 1.f};
    attn_fold(tot, st, one);
#pragma unroll
    for (int qt = 0; qt < 2; ++qt)
#pragma unroll
        for (int dt = 0; dt < 4; ++dt)
            *(uint2*)((dry ? (bf16_t*)(P.ws + W_Y) + (size_t)(b * S + t0 + 16 * qt + fr) * 1024 : ZA + (size_t)(b * S + t0 + 16 * qt + fr) * ZW + C_QX) + h * 64 + 16 * dt + 4 * fq) =
                make_uint2(pk2(tot[dt][qt][0], tot[dt][qt][1]), pk2(tot[dt][qt][2], tot[dt][qt][3]));
}

DEV void nsa_job(const Params& P, int job, char* smem, bool dry) {
    char* aux = (char*)P.out;
    bf16_t* ZA = (bf16_t*)(P.ws + W_ZA);
    const int bg = job & 31, qb = 63 - (job >> 5), b = bg >> 2, g = bg & 3, t0 = qb * 32;
    bf16_t* sK = (bf16_t*)smem;
    bf16_t* sVt = (bf16_t*)(smem + 20480);
    float* sImp = (float*)(smem + 20480 + 17408);
    unsigned* sSel = (unsigned*)(smem + 20480 + 17408 + 16384);
    const int tid = opaque_tid(), w = tid >> 6, lane = tid & 63, fr = lane & 15, fq = lane >> 4;
    const int head = g * 4 + w;
    int tq[2];
    bf16x8 qf[2][2];
#pragma unroll
    for (int qt = 0; qt < 2; ++qt) {
        tq[qt] = t0 + 16 * qt + fr;
        const bf16_t* rowp = ZA + (size_t)(b * S + tq[qt]) * ZW;
#pragma unroll
        for (int ks = 0; ks < 2; ++ks) qf[qt][ks] = *(const bf16x8*)(rowp + C_Q + head * 64 + 32 * ks + 8 * fq);
    }
    f32x4 tot[4][2];
#pragma unroll
    for (int dt = 0; dt < 4; ++dt) { tot[dt][0] = (f32x4){0.f, 0.f, 0.f, 0.f}; tot[dt][1] = (f32x4){0.f, 0.f, 0.f, 0.f}; }

    {
        const bf16_t* KC = (const bf16_t*)(aux + O_KC) + (size_t)bg * 128 * 64;
        const bf16_t* VCT = (const bf16_t*)(aux + O_VCT) + (size_t)bg * 64 * 128;
        __syncthreads();
#pragma unroll
        for (int i = 0; i < 4; ++i) {
            const int c = tid + 256 * i;
            { const int r = c >> 3, k = (c & 7) * 8; *(u32x4*)(sK + r * 80 + k) = *(const u32x4*)(KC + r * 64 + k); }
            { const int r = c >> 4, k = (c & 15) * 8; *(u32x4*)(sVt + r * 136 + k) = *(const u32x4*)(VCT + r * 128 + k); }
        }
        __syncthreads();
#pragma unroll
        for (int qt = 0; qt < 2; ++qt) {
            const float g0 = bf2f(ZA[(size_t)(b * S + tq[qt]) * ZW + C_G + head * 3 + 0]);
            f32x4 s[8];
#pragma unroll
            for (int kt = 0; kt < 8; ++kt) {
                s[kt] = (f32x4){0.f, 0.f, 0.f, 0.f};
#pragma unroll
                for (int ks = 0; ks < 2; ++ks) {
                    const bf16x8 kf = *(const bf16x8*)(sK + (16 * kt + fr) * 80 + 32 * ks + 8 * fq);
                    s[kt] = MFMA16(kf, qf[qt][ks], s[kt]);
                }
            }
            float mx = -INFINITY;
#pragma unroll
            for (int kt = 0; kt < 8; ++kt)
#pragma unroll
                for (int j = 0; j < 4; ++j) {
                    const int n = 16 * kt + 4 * fq + j;
                    const float v = (n < NCMP && 16 * n + 31 <= tq[qt]) ? s[kt][j] : -INFINITY;
                    s[kt][j] = v; mx = fmaxf(mx, v);
                }
            mx = fmaxf(mx, __shfl_xor(mx, 16)); mx = fmaxf(mx, __shfl_xor(mx, 32));
            const float msub = (mx == -INFINITY) ? 0.f : mx;
            float ps = 0.f;
#pragma unroll
            for (int kt = 0; kt < 8; ++kt)
#pragma unroll
                for (int j = 0; j < 4; ++j) { const float p = __builtin_amdgcn_exp2f((s[kt][j] - msub) * EXPC); s[kt][j] = p; ps += p; }
            ps += __shfl_xor(ps, 16); ps += __shfl_xor(ps, 32);
            const float inv = __builtin_amdgcn_rcpf(fmaxf(ps, 1e-30f));
            float bprev = 0.f;
#pragma unroll
            for (int kt = 0; kt < 8; ++kt) {
                s[kt] *= inv;
                const float a = s[kt][0] + s[kt][1] + s[kt][2] + 0.5f * s[kt][3];
                const float bq = 0.5f * s[kt][3];
                const float x = __shfl(bq, (lane + 48) & 63);
                const float y = __shfl(bprev, (lane + 48) & 63);
                sImp[(w * 32 + 16 * qt + fr) * 32 + 4 * kt + fq] = a + (fq > 0 ? x : y);
                bprev = bq;
            }
#pragma unroll
            for (int ks = 0; ks < 4; ++ks) {
                const f32x4 pa = s[2 * ks] * g0, pb = s[2 * ks + 1] * g0;
                const bf16x8 pf = mk8(pk2(pa[0], pa[1]), pk2(pa[2], pa[3]), pk2(pb[0], pb[1]), pk2(pb[2], pb[3]));
#pragma unroll
                for (int dt = 0; dt < 4; ++dt) {
                    const u32x2 v0 = *(const u32x2*)(sVt + (16 * dt + fr) * 136 + 32 * ks + 4 * fq);
                    const u32x2 v1 = *(const u32x2*)(sVt + (16 * dt + fr) * 136 + 32 * ks + 16 + 4 * fq);
                    tot[dt][qt] = MFMA16(mk8(v0.x, v0.y, v1.x, v1.y), pf, tot[dt][qt]);
                }
            }
            __builtin_amdgcn_sched_barrier(0);
        }
    }
#pragma unroll
    for (int qt = 0; qt < 2; ++qt) {
        bf16_t* op = (dry ? (bf16_t*)(P.ws + W_YX) + (size_t)(b * S + tq[qt]) * 1024 : ZA + (size_t)(b * S + tq[qt]) * ZW + C_Q) + head * 64 + 4 * fq;
#pragma unroll
        for (int dt = 0; dt < 4; ++dt) *(uint2*)(op + 16 * dt) = pk4(tot[dt][qt]);
    }
    __syncthreads();
    {
        float myv[4];
#pragma unroll
        for (int i = 0; i < 4; ++i) {
            const int pidx = tid + 256 * i, q = pidx >> 5, m = pidx & 31;
            const int t = t0 + q, cur = t >> 6;
            const float sum = ((sImp[(0 * 32 + q) * 32 + m] + sImp[(1 * 32 + q) * 32 + m]) + sImp[(2 * 32 + q) * 32 + m]) + sImp[(3 * 32 + q) * 32 + m];
            const bool forced = (m == 0) || (m == cur) || (m == cur - 1);
            const bool future = m * 64 > t;
            myv[i] = forced ? INFINITY : (future ? -INFINITY : sum);
        }
        if (tid == 0) sSel[32] = 0u;
        __syncthreads();
#pragma unroll
        for (int i = 0; i < 4; ++i) { const int pidx = tid + 256 * i; sImp[pidx] = myv[i]; }
        __syncthreads();
        unsigned wun = 0u;
#pragma unroll
        for (int i = 0; i < 4; ++i) {
            const int pidx = tid + 256 * i, q = pidx >> 5, m = pidx & 31;
            const float v = myv[i];
            int rank = 0;
#pragma unroll
            for (int m2 = 0; m2 < 32; ++m2) {
                const float o = sImp[q * 32 + m2];
                rank += (o > v || (o == v && m2 < m)) ? 1 : 0;
            }
            const bool selb = (rank < 8) && (v > -INFINITY);
            const unsigned long long bal = __ballot(selb);
            const unsigned mk = (unsigned)(bal >> (32 * (lane >> 5)));
            if ((lane & 31) == 0) sSel[q] = mk;
            wun |= (unsigned)bal | (unsigned)(bal >> 32);
        }
        if (lane == 0) atomicOr(&sSel[32], wun);
    }
    __syncthreads();
    const unsigned uni = sSel[32];
    const int jmax = (t0 + 31) >> 6;
    {
        AttnAcc st; attn_init(st);
        const bf16_t* Kb = ZA + (size_t)(b * S) * ZW + C_KS + g * 64;
        const bf16_t* Vb = (const bf16_t*)(P.ws + W_VST) + (size_t)bg * 64 * S;
        unsigned rem = uni & ((2u << jmax) - 1u);
        u32x4 rk[2], rv[2];
        if (rem) { const int j0 = __builtin_ctz(rem); ld64(rk, Kb + (size_t)(j0 * 64) * ZW, ZW, tid); ld64(rv, Vb + j0 * 64, S, tid); }
#pragma unroll 1
        while (rem) {
            const int jb = __builtin_ctz(rem);
            rem &= rem - 1u;
            __syncthreads();
            st64(sK, rk, tid, 80); st64(sVt, rv, tid, 72);
            __syncthreads();
            if (rem) { const int jn = __builtin_ctz(rem); ld64(rk, Kb + (size_t)(jn * 64) * ZW, ZW, tid); ld64(rv, Vb + jn * 64, S, tid); }
            __builtin_amdgcn_sched_barrier(0);
            if (jb * 64 + 63 <= t0) {
                const float bo[2] = {((sSel[fr] >> jb) & 1u) ? 0.f : -INFINITY, ((sSel[16 + fr] >> jb) & 1u) ? 0.f : -INFINITY};
                attn_step_fast(sK, sVt, qf, st, bo, fr, fq);
            } else {
                MaskSel mf; mf.bit[0] = (sSel[fr] >> jb) & 1u; mf.bit[1] = (sSel[16 + fr] >> jb) & 1u; mf.t[0] = tq[0]; mf.t[1] = tq[1]; mf.k0 = jb * 64;
                attn_step(sK, sVt, 72, qf, st, mf, fr, fq);
            }
        }
        { LOAD_GATE(g1, 1) bf16_t* const op2[2] = {OUTP(0), OUTP(1)}; attn_fold_out(op2, st, g1); }
    }
    {
        AttnAcc st; attn_init(st);
        const bf16_t* Kb = ZA + (size_t)(b * S) * ZW + C_KW + g * 64;
        const bf16_t* Vb = (const bf16_t*)(P.ws + W_VWT) + (size_t)bg * 64 * S;
#pragma unroll
        for (int qt = 0; qt < 2; ++qt) {
            const int npad = 511 - tq[qt];
            if (npad > 0) { st.m[qt] = 0.f; st.l[qt] = (fq == 0) ? (float)npad : 0.f; }
        }
        int jlo = t0 - 511; jlo = jlo < 0 ? 0 : (jlo >> 6);
        u32x4 rk[2], rv[2];
        ld64(rk, Kb + (size_t)(jlo * 64) * ZW, ZW, tid); ld64(rv, Vb + jlo * 64, S, tid);
#pragma unroll 1
        for (int jb = jlo; jb <= jmax; ++jb) {
            __syncthreads();
            st64(sK, rk, tid, 80); st64(sVt, rv, tid, 72);
            __syncthreads();
            if (jb < jmax) { ld64(rk, Kb + (size_t)((jb + 1) * 64) * ZW, ZW, tid); ld64(rv, Vb + (jb + 1) * 64, S, tid); }
            __builtin_amdgcn_sched_barrier(0);
            if (jb * 64 + 63 <= t0 && jb * 64 > t0 + 31 - 512) {
                const float z2[2] = {0.f, 0.f};
                attn_step_fast(sK, sVt, qf, st, z2, fr, fq);
            } else {
                MaskWin mf; mf.t[0] = tq[0]; mf.t[1] = tq[1]; mf.k0 = jb * 64;
                attn_step(sK, sVt, 72, qf, st, mf, fr, fq);
            }
        }
        { LOAD_GATE(g2, 2) bf16_t* const op2[2] = {OUTP(0), OUTP(1)}; attn_fold_out(op2, st, g2); }
    }
}


#define XB_TMO      128
#define XB_XCNT(j)  (256  + 64 * (j))
#define XB_XSUB(j)  (1280 + 64 * (j))
#define XB_XGEN(j)  (2304 + 64 * (j))
#define XB_TOP      3328
#define XB_TOPGEN   3392
#define XCD_BAR_WORDS 3456
#define XB_SPIN_CAP (1u << 18)
#define LAS __attribute__((address_space(3)))
DEV unsigned xb_ld(unsigned* p) { return __hip_atomic_load(p, __ATOMIC_RELAXED, __HIP_MEMORY_SCOPE_AGENT); }
DEV unsigned xb_add(unsigned* p, unsigned v) { return __hip_atomic_fetch_add(p, v, __ATOMIC_RELAXED, __HIP_MEMORY_SCOPE_AGENT); }
DEV unsigned xb_xcc_id() { return (unsigned)__builtin_amdgcn_s_getreg((3 << 11) | 20) & 0xFu; }
#define XB_SPIN(cond, bar) do { unsigned _sp = 0; while (cond) { __builtin_amdgcn_s_sleep(1); \
    if ((++_sp & 255u) == 0u) { if (xb_ld(&(bar)[XB_TMO])) break; if (_sp > XB_SPIN_CAP) { atomicAdd(&(bar)[XB_TMO], 1u); break; } } } } while (0)
struct XcdBarrier { unsigned* bar; unsigned x; volatile LAS unsigned* st; };
DEV XcdBarrier xcd_barrier_post(unsigned* bar, volatile LAS unsigned* st) {
    XcdBarrier b; b.bar = bar; b.x = xb_xcc_id(); b.st = st;
    if (threadIdx.x == 0) (void)xb_add(&bar[XB_XCNT(b.x)], 1u);
    return b;
}
DEV void xcd_barrier_complete(unsigned* bar, unsigned x, unsigned& nloc, unsigned& nx) {
    const unsigned G = gridDim.x * gridDim.y * gridDim.z;
    unsigned sum, cnt, mine, sp = 0u;
    for (;;) {
        sum = 0u; cnt = 0u; mine = 0u;
#pragma unroll
        for (unsigned j = 0; j < 16; ++j) { const unsigned c = xb_ld(&bar[XB_XCNT(j)]); sum += c; cnt += (c > 0u) ? 1u : 0u; mine = (j == x) ? c : mine; }
        if (sum == G) break;
        __builtin_amdgcn_s_sleep(1);
        if ((++sp & 255u) == 0u) { if (xb_ld(&bar[XB_TMO])) break; if (sp > XB_SPIN_CAP) { atomicAdd(&bar[XB_TMO], 1u); break; } }
    }
    nloc = mine > 0u ? mine : 1u; nx = cnt > 0u ? cnt : 1u;
}
DEV void xcd_barrier(const XcdBarrier& b) {
    asm volatile("s_waitcnt vmcnt(0)" ::: "memory");
    __syncthreads();
    if (threadIdx.x == 0) {
        unsigned* bar = b.bar;
        __builtin_amdgcn_s_waitcnt(0);
        unsigned nloc = b.st[0], nx = b.st[1];
        if (nloc == 0u) { xcd_barrier_complete(bar, b.x, nloc, nx); b.st[0] = nloc; b.st[1] = nx; }
        const unsigned old = xb_add(&bar[XB_XSUB(b.x)], 1u);
        const unsigned gen = old / nloc;
        if (old + 1u == (gen + 1u) * nloc) {
            __builtin_amdgcn_fence(__ATOMIC_RELEASE, "agent");
            asm volatile("s_waitcnt vmcnt(0)" ::: "memory");
            const unsigned og = xb_add(&bar[XB_TOP], 1u);
            const unsigned tg = og / nx;
            if (og + 1u == (tg + 1u) * nx) xb_add(&bar[XB_TOPGEN], 1u);
            else XB_SPIN(xb_ld(&bar[XB_TOPGEN]) == tg, bar);
            __builtin_amdgcn_fence(__ATOMIC_ACQUIRE, "agent");
            xb_add(&bar[XB_XGEN(b.x)], 1u);
            asm volatile("s_waitcnt vmcnt(0)" ::: "memory");
        } else {
            XB_SPIN(xb_ld(&bar[XB_XGEN(b.x)]) == gen, bar);
            __builtin_amdgcn_fence(__ATOMIC_ACQUIRE, "agent");
            asm volatile("s_waitcnt vmcnt(0)" ::: "memory");
        }
    }
    __syncthreads();
}
constexpr size_t W_BAR = 252 * MiB;

constexpr int NPHASE = 11;
constexpr int SMEM_BYTES = 61440;

template <int PH, bool DRY = false>
DEV void run_phase(const Params& P, char* smem) {
    const int nb = gridDim.x, bid = blockIdx.x;
    char* aux = (char*)P.out;
    char* ws = P.ws;
    bf16_t* ZA = (bf16_t*)(ws + W_ZA);
    if (PH == 0) {
        for (int job = bid; job < 4800 + 4096 + 512 + 64; job += nb) {
            int j = job;
            if (j < 4800) {
                bool done = false;
#define TR(SRC, LD, DSTOFF, KK, NN, MAP, BLK)                                                                                  \
    if (!done) { const int nrt = (NN) / 64, nt = nrt * ((KK) / 64);                                                              \
        if (j < nt) { transpose_tile((SRC), (LD), (bf16_t*)(aux + (DSTOFF)), (KK), (j % nrt) * 64, (j / nrt) * 64, (MAP), smem, (BLK) ? (NN) : 0); done = true; } else j -= nt; }
                TR(P.w_in, 7984, O_WTA, 1024, 4992, 1, 1)
                TR(P.w_in, 7984, O_WTB, 1024, 3072, 2, 1)
                TR(P.w_up, 4096, O_WTUP, 1024, 4096, 0, 1)
                TR(P.w_down, 1024, O_WTDN, 4096, 1024, 0, 1)
                TR(P.w_o, 1024, O_WTO, 1024, 1024, 0, 1)
                TR(P.w_xo, 1024, O_WTXO, 256, 1024, 0, 0)
                TR(P.w_mkv, 512, O_WTMKV, 1024, 512, 0, 0)
                TR(P.wk1, 256, O_WTCK1, 2048, 256, 0, 0)
                TR(P.wv1, 256, O_WTCV1, 2048, 256, 0, 0)
#undef TR
                if (!done) {
                    if (j < 16) transpose_tile(P.w_a + j * 4096, 64, (bf16_t*)(aux + O_WAT) + j * 4096, 64, 0, 0, 0, smem);
                    else { j -= 16; transpose_tile(P.w_i + j * 4096, 64, (bf16_t*)(aux + O_WIT) + j * 4096, 64, 0, 0, 0, smem); }
                }
                continue;
            }
            j -= 4800;
            if (j < 4096) { rownorm<false>(P.x, P.g_mix, (bf16_t*)(ws + W_U), nullptr, j * 4 + (threadIdx.x >> 6), true); continue; }
            j -= 4096;
            if (j < 512) { rownorm<false>(P.mem, P.g_mem, (bf16_t*)(aux + O_MEMN), nullptr, j * 4 + (threadIdx.x >> 6)); continue; }
            j -= 512;
            rope_job((float*)(aux + O_ROPEC), (float*)(aux + O_ROPES), j);
        }
    } else if (PH == 1) {
        const int nA = tile_count(39);
        for (int job = bid; job < 32 + nA; job += nb) {
            if (job < 32) {
                ALPlain al; al.A = (const bf16_t*)(aux + O_MEMN); al.lda = 1024; al.ks = 64;
                const int pm = job & 7, pn = job >> 3;
                if (pn < 2) { EpiMemKV<true> ep{(bf16_t*)(aux + O_MEMK), (bf16_t*)(aux + O_MEMVT)}; gemm_tile<8, 4, true>(al, (const bf16_t*)(aux + O_WTMKV), 1024, 64, 1024, pm, pn, ep, smem); }
                else { EpiMemKV<false> ep{(bf16_t*)(aux + O_MEMK), (bf16_t*)(aux + O_MEMVT)}; gemm_tile<8, 4, false>(al, (const bf16_t*)(aux + O_WTMKV), 1024, 64, 1024, pm, pn, ep, smem); }
            } else {
                int pm, pn;
                if (!tile_map(job - 32, 39, pm, pn)) continue;
                ALPlain al; al.A = (const bf16_t*)(ws + W_U); al.lda = 64; al.ks = 16384 * 64;
                if (pn < 35) { EpiZA<true> ep{ZA, (bf16_t*)(ws + W_VST), (bf16_t*)(ws + W_VWT), (const float*)(aux + O_ROPEC), (const float*)(aux + O_ROPES)};
                    gemm_tile<8, 4, true>(al, (const bf16_t*)(aux + O_WTA), 64, 4992 * 64, 1024, pm, pn, ep, smem); }
                else { EpiZA<false> ep{ZA, (bf16_t*)(ws + W_VST), (bf16_t*)(ws + W_VWT), (const float*)(aux + O_ROPEC), (const float*)(aux + O_ROPES)};
                    gemm_tile<8, 4, false>(al, (const bf16_t*)(aux + O_WTA), 64, 4992 * 64, 1024, pm, pn, ep, smem); }
            }
        }
    } else if (PH == 2) {
        for (int job = bid; job < 1280; job += nb) {
            if (job < 128) {
                const int j = job, which = j >> 6, pm = (j & 63) >> 1, pn = j & 1;
                float* sPos = (float*)(smem + 40960);
                __syncthreads();
                { const float* pg = which ? P.cpv : P.cpk; const int t8 = threadIdx.x * 8; *(float4*)(sPos + t8) = *(const float4*)(pg + t8); *(float4*)(sPos + t8 + 4) = *(const float4*)(pg + t8 + 4); }
                ALCmp al; al.ZA = ZA; al.spos = sPos; al.colbase = which ? C_VC : C_KC;
                EpiHid ep{(bf16_t*)(aux + (which ? O_HIDV : O_HIDK))};
                gemm_tile<4, 4, true>(al, (const bf16_t*)(aux + (which ? O_WTCV1 : O_WTCK1)), 2048, 64, 2048, pm, pn, ep, smem);
            } else if (job < 640) rnn_job(P, job - 128, smem, DRY);
            else if (job < 1024) xattn_job(P, job - 640, smem, DRY);
            else if (job >= 1152) xattn_job(P, job - 1152 + 384, smem, DRY);
        }
    } else if (PH == 3) {
        for (int job = bid; job < 2032; job += nb) cmp2_job(P, job);
    } else if (PH == 4) {
        for (int job = bid; job < 2048 + 512; job += nb) {
            if (job < 2048) nsa_job(P, job, smem, DRY);
            else if (!DRY) {
                int pm, pn;
                if (!tile_map(job - 2048, 8, pm, pn)) continue;
                ALPlain al; al.A = ZA + C_QX; al.lda = ZW; al.ks = 64;
                EpiBf<0> ep{(bf16_t*)(ws + W_YX), 1024};
                gemm_tile<8, 4, true>(al, (const bf16_t*)(aux + O_WTXO), 256, 64, 256, pm, pn, ep, smem);
            }
        }
    } else if (PH == 5) {
        for (int job = bid; job < tile_count(32); job += nb) {
            int pm, pn;
            if (!tile_map(job, 32, pm, pn)) continue;
            ALPlain al; al.A = (const bf16_t*)(ws + W_U); al.lda = 64; al.ks = 16384 * 64;
            EpiMerge ep{ZA, (const bf16_t*)(ws + W_YX), (bf16_t*)(ws + W_Y)};
            gemm_tile<8, 3, true>(al, (const bf16_t*)(aux + O_WTB), 64, 3072 * 64, 1024, pm, pn, ep, smem);
        }
    } else if (PH == 6) {
        for (int job = bid; job < tile_count(8); job += nb) {
            int pm, pn;
            if (!tile_map(job, 8, pm, pn)) continue;
            ALPlain al; al.A = (const bf16_t*)(ws + W_Y); al.lda = 64; al.ks = 16384 * 64;
            EpiRes ep{P.x, (float*)(ws + W_H)};
            gemm_tile<8, 4, true>(al, (const bf16_t*)(aux + O_WTO), 64, 1024 * 64, 1024, pm, pn, ep, smem);
        }
    } else if (PH == 7) {
        for (int job = bid; job < 4096; job += nb) rownorm<false>((const float*)(ws + W_H), P.g_mlp, (bf16_t*)(ws + W_VN), nullptr, job * 4 + (threadIdx.x >> 6), true);
    } else if (PH == 8) {
        for (int job = bid; job < tile_count(32); job += nb) {
            int pm, pn;
            if (!tile_map(job, 32, pm, pn)) continue;
            ALPlain al; al.A = (const bf16_t*)(ws + W_VN); al.lda = 64; al.ks = 16384 * 64;
            EpiBf<1> ep{(bf16_t*)(ws + W_HID), 4096};
            gemm_tile<8, 4, true>(al, (const bf16_t*)(aux + O_WTUP), 64, 4096 * 64, 1024, pm, pn, ep, smem);
        }
    } else if (PH == 9) {
        for (int job = bid; job < tile_count(8); job += nb) {
            int pm, pn;
            if (!tile_map(job, 8, pm, pn)) continue;
            ALPlain al; al.A = (const bf16_t*)(ws + W_HID); al.lda = 64; al.ks = 16384 * 64;
            EpiRes ep{(const float*)(ws + W_H), (float*)(ws + W_H)};
            gemm_tile<8, 4, true>(al, (const bf16_t*)(aux + O_WTDN), 64, 1024 * 64, 4096, pm, pn, ep, smem);
        }
    } else if (PH == 10) {
        for (int job = bid; job < 4096; job += nb) rownorm<true>((const float*)(ws + W_H), P.g_final, nullptr, P.out, job * 4 + (threadIdx.x >> 6));
    }
}

#if MULTI
template <int PH>
__global__ void __launch_bounds__(256, 2) phase_kernel(Params P) {
    __shared__ __attribute__((aligned(16))) char smem[SMEM_BYTES];
    run_phase<PH>(P, smem);
}
#else
__global__ void __launch_bounds__(256, 2) mega_kernel(Params P) {
    __shared__ __attribute__((aligned(16))) char smem[SMEM_BYTES];
    cg::grid_group grid = cg::this_grid();
    __shared__ uint4 xb_words;
    if (threadIdx.x == 0) xb_words = make_uint4(0u, 0u, 0u, 0u);
    __syncthreads();
    XcdBarrier xb = xcd_barrier_post((unsigned*)(P.ws + W_BAR), (volatile LAS unsigned*)&xb_words);
    if (P.ws == nullptr) grid.sync();
#ifndef REP
#define REP -1
#endif
#define GSYNC() xcd_barrier(xb)
#define PHASE(k) { if (REP == k && k != 9) { run_phase<k, true>(P, smem); GSYNC(); } run_phase<k>(P, smem); GSYNC(); }
    PHASE(0) PHASE(1) PHASE(2) PHASE(3) PHASE(4) PHASE(5) PHASE(6) PHASE(7) PHASE(8) PHASE(9)
    if (REP == 10) { run_phase<10>(P, smem); GSYNC(); }
    if (REP == 11) { GSYNC(); GSYNC(); GSYNC(); GSYNC(); GSYNC(); GSYNC(); GSYNC(); GSYNC(); GSYNC(); GSYNC(); }
    run_phase<10>(P, smem);
}
#endif

extern "C" void kernel_launch(void* const* d_in, const int* in_sizes, int n_in, void* d_out, int out_size, void* d_ws, size_t ws_size,
                              hipStream_t stream) {
    Params P{};
    const float** pp = (const float**)&P;
    for (int i = 0; i < 25; ++i) pp[i] = (const float*)d_in[i];
    P.out = (float*)d_out;
    P.ws = (char*)d_ws;
#if MULTI
    const int G = 1024;
    phase_kernel<0><<<G, 256, 0, stream>>>(P);
    phase_kernel<1><<<G, 256, 0, stream>>>(P);
    phase_kernel<2><<<G, 256, 0, stream>>>(P);
    phase_kernel<3><<<G, 256, 0, stream>>>(P);
    phase_kernel<4><<<G, 256, 0, stream>>>(P);
    phase_kernel<5><<<G, 256, 0, stream>>>(P);
    phase_kernel<6><<<G, 256, 0, stream>>>(P);
    phase_kernel<7><<<G, 256, 0, stream>>>(P);
    phase_kernel<8><<<G, 256, 0, stream>>>(P);
    phase_kernel<9><<<G, 256, 0, stream>>>(P);
    phase_kernel<10><<<G, 256, 0, stream>>>(P);
#else
    static int grid_blocks = 0;
    if (!grid_blocks) {
        int dev = 0, cus = 0, per_cu = 0;
        hipGetDevice(&dev);
        hipDeviceGetAttribute(&cus, hipDeviceAttributeMultiprocessorCount, dev);
        hipOccupancyMaxActiveBlocksPerMultiprocessor(&per_cu, mega_kernel, 256, 0);
        if (per_cu > 2) per_cu = 2;
        if (per_cu < 1) per_cu = 1;
        grid_blocks = cus * per_cu;
    }
    hipMemsetAsync((char*)d_ws + W_BAR, 0, XCD_BAR_WORDS * 4, stream);
    void* args[] = {&P};
    hipError_t e = hipLaunchCooperativeKernel((void*)mega_kernel, dim3(grid_blocks), dim3(256), args, 0, stream);
    if (e != hipSuccess) fprintf(stderr, "cooperative launch failed: %s (grid %d)\n", hipGetErrorString(e), grid_blocks);
#endif
}
```

```cpp
#include <hip/hip_runtime.h>
#include <hip/hip_cooperative_groups.h>
#include <cstdint>
#include <cstdio>
namespace cg = cooperative_groups;

#ifndef MULTI
#define MULTI 0
#endif

typedef unsigned short bf16_t;
typedef short bf16x8 __attribute__((ext_vector_type(8)));
typedef float f32x4 __attribute__((ext_vector_type(4)));
typedef __bf16 bfv2 __attribute__((ext_vector_type(2)));
typedef float f32x2 __attribute__((ext_vector_type(2)));
typedef unsigned u32x4 __attribute__((ext_vector_type(4)));
typedef unsigned u32x2 __attribute__((ext_vector_type(2)));
#define DEV __device__ __forceinline__
DEV int opaque_tid() { int t = threadIdx.x; asm volatile("" : "+v"(t)); return t; }
#define MFMA16(a, b, c) __builtin_amdgcn_mfma_f32_16x16x32_bf16((a), (b), (c), 0, 0, 0)

constexpr int T = 16384, S = 2048;
constexpr int ZW = 4480;
constexpr int C_Q = 0, C_KC = 1024, C_VC = 1280, C_KS = 1536, C_KW = 1792, C_XR = 2048, C_GR = 3072, C_QX = 4096, C_G = 4352;
constexpr int NCMP = 127;
constexpr int NCROWS = 4064;

constexpr size_t O_WTA = 0;
constexpr size_t O_WTB = O_WTA + (size_t)4992 * 1024 * 2;
constexpr size_t O_WTUP = O_WTB + (size_t)3072 * 1024 * 2;
constexpr size_t O_WTDN = O_WTUP + (size_t)4096 * 1024 * 2;
constexpr size_t O_WTO = O_WTDN + (size_t)4096 * 1024 * 2;
constexpr size_t O_WTXO = O_WTO + (size_t)1024 * 1024 * 2;
constexpr size_t O_WTMKV = O_WTXO + (size_t)1024 * 256 * 2;
constexpr size_t O_WTCK1 = O_WTMKV + (size_t)512 * 1024 * 2;
constexpr size_t O_WTCV1 = O_WTCK1 + (size_t)256 * 2048 * 2;
constexpr size_t O_WAT = O_WTCV1 + (size_t)256 * 2048 * 2;
constexpr size_t O_WIT = O_WAT + (size_t)16 * 64 * 64 * 2;
constexpr size_t O_ROPEC = O_WIT + (size_t)16 * 64 * 64 * 2;
constexpr size_t O_ROPES = O_ROPEC + (size_t)2048 * 8 * 4;
constexpr size_t O_MEMN = O_ROPES + (size_t)2048 * 8 * 4;
constexpr size_t O_MEMK = O_MEMN + (size_t)2048 * 1024 * 2;
constexpr size_t O_MEMVT = O_MEMK + (size_t)2048 * 256 * 2;
constexpr size_t O_HIDK = O_MEMVT + (size_t)2048 * 256 * 2;
constexpr size_t O_HIDV = O_HIDK + (size_t)4096 * 256 * 2;
constexpr size_t O_KC = O_HIDV + (size_t)4096 * 256 * 2;
constexpr size_t O_VCT = O_KC + (size_t)32 * 128 * 64 * 2;
constexpr size_t O_AUX_END = O_VCT + (size_t)32 * 64 * 128 * 2;
static_assert(O_AUX_END <= (size_t)64 << 20, "aux overflow");
constexpr size_t MiB = (size_t)1 << 20;
constexpr size_t W_U = 0, W_ZA = 32 * MiB, W_VST = 172 * MiB, W_VWT = 180 * MiB, W_YX = 188 * MiB, W_Y = 220 * MiB;
constexpr size_t W_H = 32 * MiB, W_VN = 0, W_HID = 96 * MiB;

struct Params {
    const float *x, *mem, *g_mix, *w_in, *cpk, *cpv, *wk1, *wk2, *wv1, *wv2, *conv_w, *conv_b, *w_a, *b_a, *w_i, *b_i, *lam,
        *g_mem, *w_mkv, *w_xo, *w_o, *g_mlp, *w_up, *w_down, *g_final;
    float* out;
    char* ws;
};

DEV float bf2f(bf16_t h) { return __uint_as_float(((unsigned)h) << 16); }
DEV unsigned pk2(float lo, float hi) { f32x2 v = {lo, hi}; bfv2 b = __builtin_convertvector(v, bfv2); return __builtin_bit_cast(unsigned, b); }
DEV bf16_t f2bf(float f) { return (bf16_t)(pk2(f, 0.f) & 0xffffu); }
DEV float lo_f(unsigned u) { return __uint_as_float(u << 16); }
DEV float hi_f(unsigned u) { return __uint_as_float(u & 0xffff0000u); }
DEV float sigm(float x) { return __builtin_amdgcn_rcpf(1.f + __expf(-x)); }
DEV float gelu_t(float x) {
    float y = 0.7978845608028654f * (x + 0.044715f * x * x * x);
    float e = __expf(2.f * y);
    float th = 1.f - 2.f * __builtin_amdgcn_rcpf(1.f + e);
    return 0.5f * x * (1.f + th);
}
DEV float wave_sum(float v) {
#pragma unroll
    for (int o = 32; o >= 1; o >>= 1) v += __shfl_xor(v, o);
    return v;
}

DEV int map_col(int mapid, int r) {
    if (mapid == 0) return r;
    if (mapid == 1) {
        if (r < 1536) return r;
        if (r < 1792) return 1536 + (r - 1536);
        if (r < 2048) return 2048 + (r - 1792);
        if (r < 3072) return 2608 + (r - 2048);
        if (r < 4096) return 3632 + (r - 3072);
        if (r < 4352) return 4656 + (r - 4096);
        if (r < 4400) return 2560 + (r - 4352);
        if (r < 4480) return -1;
        if (r < 4736) return 1792 + (r - 4480);
        return 2304 + (r - 4736);
    }
    int pn = r / 96, rem = r - pn * 96, wc = rem / 48, rem2 = rem - wc * 48, gidx = rem2 >> 4, cc = rem2 & 15;
    return 4912 + gidx * 1024 + pn * 32 + wc * 16 + cc;
}

DEV void transpose_tile(const float* __restrict__ src, int ld, bf16_t* __restrict__ dst, int K, int r0, int k0, int mapid, char* smem, int nblk = 0) {
    float* sm = (float*)smem;
    const int tid = threadIdx.x, lane = tid & 63, w = tid >> 6;
    __syncthreads();
    const int sc = map_col(mapid, r0 + lane);
#pragma unroll
    for (int i = 0; i < 16; ++i) {
        int kk = w + 4 * i;
        float v = sc >= 0 ? src[(size_t)(k0 + kk) * ld + sc] : 0.f;
        sm[kk * 65 + lane] = v;
    }
    __syncthreads();
    const int rr = tid >> 2, kq = (tid & 3) * 16;
    unsigned o[8];
#pragma unroll
    for (int e = 0; e < 8; ++e) o[e] = pk2(sm[(kq + 2 * e) * 65 + rr], sm[(kq + 2 * e + 1) * 65 + rr]);
    uint4* dp = nblk ? (uint4*)(dst + (size_t)(k0 >> 6) * nblk * 64 + (size_t)(r0 + rr) * 64 + kq) : (uint4*)(dst + (size_t)(r0 + rr) * K + k0 + kq);
    dp[0] = make_uint4(o[0], o[1], o[2], o[3]);
    dp[1] = make_uint4(o[4], o[5], o[6], o[7]);
}

template <bool OUTF32>
DEV void rownorm(const float* __restrict__ src, const float* __restrict__ g, bf16_t* dstb, float* dstf, int row, bool blk = false) {
    const int lane = threadIdx.x & 63;
    const float4* sp = (const float4*)(src + (size_t)row * 1024);
    float4 v[4];
    float ss = 0.f;
#pragma unroll
    for (int i = 0; i < 4; ++i) { v[i] = sp[lane + 64 * i]; ss += v[i].x * v[i].x + v[i].y * v[i].y + v[i].z * v[i].z + v[i].w * v[i].w; }
    ss = wave_sum(ss);
    const float r = rsqrtf(ss * (1.0f / 1024.0f) + 1e-6f);
#pragma unroll
    for (int i = 0; i < 4; ++i) {
        float4 gg = ((const float4*)g)[lane + 64 * i];
        float a = v[i].x * r * gg.x, b = v[i].y * r * gg.y, c = v[i].z * r * gg.z, d = v[i].w * r * gg.w;
        if (OUTF32) ((float4*)(dstf + (size_t)row * 1024))[lane + 64 * i] = make_float4(a, b, c, d);
        else if (blk) { const int col = 4 * (lane + 64 * i); *(uint2*)(dstb + (size_t)(col >> 6) * ((size_t)16384 * 64) + (size_t)row * 64 + (col & 63)) = make_uint2(pk2(a, b), pk2(c, d)); }
        else ((uint2*)(dstb + (size_t)row * 1024))[lane + 64 * i] = make_uint2(pk2(a, b), pk2(c, d));
    }
}

DEV void rope_job(float* ct, float* st, int job) {
    const int e = job * 256 + threadIdx.x;
    const int pos = e >> 3, i = e & 7;
    const double inv = exp(-(double)i * 0.125 * 13.122363377404328);
    const double ang = (double)pos * inv;
    const double kq = rint(ang * 0.6366197723675814);
    const double r = ang - kq * 1.5707963267948966;
    const double r2 = r * r;
    const double sn = r * (1.0 + r2 * (-1.0 / 6 + r2 * (1.0 / 120 + r2 * (-1.0 / 5040 + r2 * (1.0 / 362880 + r2 * (-1.0 / 39916800 + r2 * (1.0 / 6227020800.0)))))));
    const double cs = 1.0 + r2 * (-0.5 + r2 * (1.0 / 24 + r2 * (-1.0 / 720 + r2 * (1.0 / 40320 + r2 * (-1.0 / 3628800 + r2 * (1.0 / 479001600.0))))));
    const int q = ((int)kq) & 3;
    double s_, c_;
    if (q == 0) { s_ = sn; c_ = cs; } else if (q == 1) { s_ = cs; c_ = -sn; } else if (q == 2) { s_ = -sn; c_ = -cs; } else { s_ = -cs; c_ = sn; }
    ct[e] = (float)c_; st[e] = (float)s_;
}

struct ALPlain {
    const bf16_t* A; int lda; int ks;
    const char* base; unsigned off0;
    DEV void init(int row0, int lrow, int lk) { base = (const char*)(A + (size_t)row0 * lda); off0 = (unsigned)(lrow * lda + lk) * 2u; }
    DEV u32x4 load(int i, int k0) const { return *(const u32x4*)(base + (off0 + (unsigned)(i * 64 * lda) + (unsigned)(k0 >> 6) * (unsigned)(ks * 2))); }
    DEV u32x4 fix(int, const u32x4& v, int) const { return v; }
};
struct ALCmp {
    const bf16_t* ZA; const float* spos; int colbase;
    unsigned roff[4]; int lk_;
    DEV void init(int row0, int lrow, int lk) {
        lk_ = lk;
#pragma unroll
        for (int i = 0; i < 4; ++i) {
            const int row = row0 + lrow + 32 * i;
            const int bg = row / NCMP, n = row - bg * NCMP, b = bg >> 2, g = bg & 3;
            roff[i] = row < NCROWS ? (unsigned)(((b * S + 16 * n) * ZW + colbase + g * 64 + lk) * 2) : 0xffffffffu;
        }
    }
    DEV u32x4 load(int i, int k0) const {
        if (roff[i] == 0xffffffffu) return (u32x4){0u, 0u, 0u, 0u};
        return *(const u32x4*)((const char*)ZA + (roff[i] + (unsigned)((k0 >> 6) * ZW * 2)));
    }
    DEV u32x4 fix(int i, const u32x4& v, int k0) const {
        if (roff[i] == 0xffffffffu) return v;
        const float4 p0 = *(const float4*)(spos + k0 + lk_), p1 = *(const float4*)(spos + k0 + lk_ + 4);
        u32x4 o;
        o.x = pk2(lo_f(v.x) + p0.x, hi_f(v.x) + p0.y); o.y = pk2(lo_f(v.y) + p0.z, hi_f(v.y) + p0.w);
        o.z = pk2(lo_f(v.z) + p1.x, hi_f(v.z) + p1.y); o.w = pk2(lo_f(v.w) + p1.z, hi_f(v.w) + p1.w);
        return o;
    }
};

template <int TM, int TN, bool SWAP, class AL, class EP>
DEV void gemm_tile(AL al, const bf16_t* __restrict__ Bt, int ldb, int bks, int K, int pm, int pn, const EP& ep, char* smem) {
    constexpr int BM = TM * 32, BN = TN * 32, NA = TM, NBB = TN;
    bf16_t* sA = (bf16_t*)smem;
    bf16_t* sB = sA + BM * 80;
    const int tid = opaque_tid(), wid = tid >> 6, lane = tid & 63, wr = wid >> 1, wc = wid & 1, fr = lane & 15, fq = lane >> 4;
    f32x4 acc[TM][TN];
#pragma unroll
    for (int m = 0; m < TM; ++m)
#pragma unroll
        for (int n = 0; n < TN; ++n) acc[m][n] = (f32x4){0.f, 0.f, 0.f, 0.f};
    const int lrow = tid >> 3, lk = (tid & 7) * 8;
    u32x4 ra[NA], rb[NBB];
    al.init(pm * BM, lrow, lk);
    const char* bbase = (const char*)(Bt + (size_t)(pn * BN) * ldb);
    const unsigned boff = (unsigned)(lrow * ldb + lk) * 2u;
#pragma unroll
    for (int i = 0; i < NA; ++i) ra[i] = al.load(i, 0);
#pragma unroll
    for (int i = 0; i < NBB; ++i) rb[i] = *(const u32x4*)(bbase + (boff + (unsigned)(i * 64 * ldb)));
    int nk = K >> 6;
    asm volatile("" : "+s"(nk));
    bf16_t* sWa = sA + lrow * 80 + lk;
    bf16_t* sWb = sB + lrow * 80 + lk;
    const bf16_t* sAr = sA + (wr * TM * 16 + fr) * 80 + fq * 8;
    const bf16_t* sBr = sB + (wc * TN * 16 + fr) * 80 + fq * 8;
#pragma unroll 1
    for (int kt = 0; kt < nk; ++kt) {
        __syncthreads();
#pragma unroll
        for (int i = 0; i < NA; ++i) *(u32x4*)(sWa + (32 * i) * 80) = al.fix(i, ra[i], kt * 64);
#pragma unroll
        for (int i = 0; i < NBB; ++i) *(u32x4*)(sWb + (32 * i) * 80) = rb[i];
        __syncthreads();
        if (kt + 1 < nk) {
            const int k0 = (kt + 1) * 64;
#pragma unroll
            for (int i = 0; i < NA; ++i) ra[i] = al.load(i, k0);
#pragma unroll
            for (int i = 0; i < NBB; ++i) rb[i] = *(const u32x4*)(bbase + (boff + (unsigned)(i * 64 * ldb) + (unsigned)(k0 >> 6) * (unsigned)(bks * 2)));
        }
        __builtin_amdgcn_sched_barrier(0);
        __builtin_amdgcn_s_setprio(1);
#pragma unroll
        for (int ks = 0; ks < 2; ++ks) {
            bf16x8 bfr[TN];
#pragma unroll
            for (int n = 0; n < TN; ++n) bfr[n] = *(const bf16x8*)(sBr + (n * 16) * 80 + ks * 32);
#pragma unroll
            for (int m = 0; m < TM; ++m) {
                const bf16x8 af = *(const bf16x8*)(sAr + (m * 16) * 80 + ks * 32);
#pragma unroll
                for (int n = 0; n < TN; ++n) acc[m][n] = SWAP ? MFMA16(bfr[n], af, acc[m][n]) : MFMA16(af, bfr[n], acc[m][n]);
            }
        }
        __builtin_amdgcn_s_setprio(0);
    }
    ep.run(acc, pm * BM + wr * TM * 16, pn * BN + wc * TN * 16, fr, fq);
}

DEV uint2 pk4(const f32x4& a) { return make_uint2(pk2(a[0], a[1]), pk2(a[2], a[3])); }

template <bool SWAP>
struct EpiZA {
    bf16_t *ZA, *VST, *VWT; const float *ropec, *ropes;
    DEV void run(f32x4 (&acc)[8][4], int R0, int C0, int fr, int fq) const {
#pragma unroll
        for (int n = 0; n < 4; ++n) {
            const int col0 = C0 + n * 16;
#pragma unroll
            for (int m = 0; m < 8; ++m) {
                f32x4 a = acc[m][n];
                if (!SWAP) {
                    const int r = R0 + m * 16 + 4 * fq;
                    int c = col0 - 4480 + fr;
                    bf16_t* dst = (c < 256) ? VST : VWT;
                    c &= 255;
                    const int g = c >> 6, d = c & 63, b = r >> 11, t = r & 2047;
                    *(uint2*)(dst + ((size_t)((b * 4 + g) * 64 + d)) * S + t) = pk4(a);
                } else {
                    const int row = R0 + m * 16 + fr;
                    const bool rope = (col0 < 1024 || (col0 >= 1536 && col0 < 2048)) && ((col0 & 63) == 0);
                    if (rope) {
                        const int t = row & 2047, i0 = 4 * (fq & 1);
                        const float4 cs = *(const float4*)(ropec + t * 8 + i0), sn = *(const float4*)(ropes + t * 8 + i0);
                        const float c4[4] = {cs.x, cs.y, cs.z, cs.w}, s4[4] = {sn.x, sn.y, sn.z, sn.w};
#pragma unroll
                        for (int j = 0; j < 4; ++j) {
                            const float pr = __shfl_xor(a[j], 32);
                            a[j] = (fq & 2) ? (a[j] * c4[j] + pr * s4[j]) : (a[j] * c4[j] - pr * s4[j]);
                        }
                    }
                    if (col0 >= C_G) {
#pragma unroll
                        for (int j = 0; j < 4; ++j) a[j] = sigm(a[j]);
                    }
                    *(uint2*)(ZA + (size_t)row * ZW + col0 + 4 * fq) = pk4(a);
                }
            }
        }
    }
};
template <bool SWAP>
struct EpiMemKV {
    bf16_t *MK, *MVT;
    DEV void run(f32x4 (&acc)[8][4], int R0, int C0, int fr, int fq) const {
#pragma unroll
        for (int n = 0; n < 4; ++n)
#pragma unroll
            for (int m = 0; m < 8; ++m) {
                if (SWAP) {
                    const int c = C0 + n * 16 + 4 * fq, r = R0 + m * 16 + fr;
                    const int h = (c >> 6) & 3, d = c & 63, b = r >> 8, mm = r & 255;
                    *(uint2*)(MK + ((size_t)(b * 4 + h) * 256 + mm) * 64 + d) = pk4(acc[m][n]);
                } else {
                    const int c = C0 + n * 16 + fr, r = R0 + m * 16 + 4 * fq;
                    const int h = (c >> 6) & 3, d = c & 63, b = r >> 8, mm = r & 255;
                    *(uint2*)(MVT + ((size_t)(b * 4 + h) * 64 + d) * 256 + mm) = pk4(acc[m][n]);
                }
            }
    }
};
struct EpiHid {
    bf16_t* H;
    DEV void run(f32x4 (&acc)[4][4], int R0, int C0, int fr, int fq) const {
#pragma unroll
        for (int n = 0; n < 4; ++n)
#pragma unroll
            for (int m = 0; m < 4; ++m) {
                const int c = C0 + n * 16 + 4 * fq, r = R0 + m * 16 + fr;
                f32x4 a = acc[m][n];
#pragma unroll
                for (int j = 0; j < 4; ++j) a[j] = gelu_t(a[j]);
                if (r < NCROWS) *(uint2*)(H + (size_t)r * 256 + c) = pk4(a);
            }
    }
};
template <int ACT>
struct EpiBf {
    bf16_t* O; int ldo;
    DEV void run(f32x4 (&acc)[8][4], int R0, int C0, int fr, int fq) const {
#pragma unroll
        for (int n = 0; n < 4; ++n)
#pragma unroll
            for (int m = 0; m < 8; ++m) {
                const int c = C0 + n * 16 + 4 * fq, r = R0 + m * 16 + fr;
                f32x4 a = acc[m][n];
                if (ACT == 1) {
#pragma unroll
                    for (int j = 0; j < 4; ++j) { const float v = fmaxf(a[j], 0.f); a[j] = v * v; }
                }
                if (ACT == 1) *(uint2*)(O + (size_t)(c >> 6) * ((size_t)16384 * 64) + (size_t)r * 64 + (c & 63)) = pk4(a);
                else *(uint2*)(O + (size_t)r * ldo + c) = pk4(a);
            }
    }
};
struct EpiRes {
    const float* R; float* O;
    DEV void run(f32x4 (&acc)[8][4], int R0, int C0, int fr, int fq) const {
#pragma unroll
        for (int n = 0; n < 4; ++n)
#pragma unroll
            for (int m = 0; m < 8; ++m) {
                const size_t o = (size_t)(R0 + m * 16 + fr) * 1024 + C0 + n * 16 + 4 * fq;
                const f32x4 r = *(const f32x4*)(R + o);
                *(f32x4*)(O + o) = r + acc[m][n];
            }
    }
};
struct EpiMerge {
    const bf16_t *ZA, *YX; bf16_t* Y;
    DEV void run(f32x4 (&acc)[8][3], int R0, int C0, int fr, int fq) const {
        const int ch = (C0 / 48) * 16 + 4 * fq;
#pragma unroll
        for (int m = 0; m < 8; ++m) {
            const size_t row = (size_t)(R0 + m * 16 + fr);
            const uint2 a = *(const uint2*)(ZA + row * ZW + C_Q + ch), b = *(const uint2*)(ZA + row * ZW + C_GR + ch), c = *(const uint2*)(YX + row * 1024 + ch);
            f32x4 y;
            y[0] = sigm(acc[m][0][0]) * lo_f(a.x) + sigm(acc[m][1][0]) * lo_f(b.x) + sigm(acc[m][2][0]) * lo_f(c.x);
            y[1] = sigm(acc[m][0][1]) * hi_f(a.x) + sigm(acc[m][1][1]) * hi_f(b.x) + sigm(acc[m][2][1]) * hi_f(c.x);
            y[2] = sigm(acc[m][0][2]) * lo_f(a.y) + sigm(acc[m][1][2]) * lo_f(b.y) + sigm(acc[m][2][2]) * lo_f(c.y);
            y[3] = sigm(acc[m][0][3]) * hi_f(a.y) + sigm(acc[m][1][3]) * hi_f(b.y) + sigm(acc[m][2][3]) * hi_f(c.y);
            *(uint2*)(Y + (size_t)(ch >> 6) * ((size_t)16384 * 64) + row * 64 + (ch & 63)) = pk4(y);
        }
    }
};

DEV bool tile_map(int idx, int NT, int& pm, int& pn) {
    const int x = idx & 7, pl = (idx >> 3) & 7, pmid = (idx >> 6) & 7, st = idx >> 9;
    pm = pmid * 8 + x;
    pn = st * 8 + pl;
    return pn < NT;
}
DEV int tile_count(int NT) { return ((NT + 7) / 8) * 512; }

DEV void cmp2_job(const Params& P, int job) {
    char* aux = (char*)P.out;
    const int lane = threadIdx.x & 63, w = threadIdx.x >> 6;
    const int wj = job * 4 + w;
    const int which = wj >= NCROWS ? 1 : 0;
    const int r = wj - which * NCROWS;
    const int bg = r / NCMP, n = r - bg * NCMP;
    const bf16_t* hid = (const bf16_t*)(aux + (which ? O_HIDV : O_HIDK)) + (size_t)r * 256;
    const float* w2 = which ? P.wv2 : P.wk2;
    float acc = 0.f;
#pragma unroll 8
    for (int k = 0; k < 256; ++k) acc += bf2f(hid[k]) * w2[k * 64 + lane];
    if (!which) {
        const int pos = 16 * n + 31, i = lane & 7;
        const float cs = ((const float*)(aux + O_ROPEC))[pos * 8 + i], sn = ((const float*)(aux + O_ROPES))[pos * 8 + i];
        const float pr = __shfl_xor(acc, 8);
        float o = acc;
        if (lane < 16) o = (lane & 8) ? (acc * cs + pr * sn) : (acc * cs - pr * sn);
        bf16_t* KC = (bf16_t*)(aux + O_KC);
        KC[((size_t)bg * 128 + n) * 64 + lane] = f2bf(o);
        if (n == NCMP - 1) KC[((size_t)bg * 128 + 127) * 64 + lane] = 0;
    } else {
        bf16_t* VCT = (bf16_t*)(aux + O_VCT);
        VCT[((size_t)bg * 64 + lane) * 128 + n] = f2bf(acc);
        if (n == NCMP - 1) VCT[((size_t)bg * 64 + lane) * 128 + 127] = 0;
    }
}

DEV void rnn_job(const Params& P, int job, char* smem, bool dry) {
    char* aux = (char*)P.out;
    bf16_t* ZA = (bf16_t*)(P.ws + W_ZA);
    const int b = job >> 6, n = (job >> 2) & 15, ct = job & 3;
    bf16_t* sX = (bf16_t*)smem;
    float* sXf = (float*)(smem + 10240);
    float* sCw = (float*)(smem + 10240 + 16640);
    float* sSum = (float*)(smem + 10240 + 16640 + 1280);
    bf16_t* sRaw = (bf16_t*)(smem + 10240 + 16640 + 1280 + 2048);
    const int tid = opaque_tid(), w = tid >> 6, lane = tid & 63, fr = lane & 15, fq = lane >> 4;
    const bf16_t* WAT = (const bf16_t*)(aux + O_WAT) + n * 4096;
    const bf16_t* WIT = (const bf16_t*)(aux + O_WIT) + n * 4096;
    bf16x8 wa[2], wi[2];
#pragma unroll
    for (int ks = 0; ks < 2; ++ks) {
        wa[ks] = *(const bf16x8*)(WAT + (16 * ct + fr) * 64 + 32 * ks + 8 * fq);
        wi[ks] = *(const bf16x8*)(WIT + (16 * ct + fr) * 64 + 32 * ks + 8 * fq);
    }
    const int c = n * 64 + 16 * ct + fr;
    const float ba = P.b_a[c], bi = P.b_i[c], cl = -8.0f * log1pf(__expf(-P.lam[c]));
    float carry = 0.f;
    __syncthreads();
    for (int i = tid; i < 320; i += 256) sCw[i] = (i < 256) ? P.conv_w[(i >> 6) * 1024 + n * 64 + (i & 63)] : P.conv_b[n * 64 + (i & 63)];
    const int lt = tid >> 2, cg = (tid & 3) * 16;
    const bf16_t* xbase = ZA + (size_t)(b * S) * ZW + C_XR + n * 64 + cg;
    bf16_t* sRaw2 = sRaw + 67 * 72;
    u32x4 xm0, xm1, xh0 = {0u, 0u, 0u, 0u}, xh1 = {0u, 0u, 0u, 0u};
    { const u32x4* xp = (const u32x4*)(xbase + (size_t)lt * ZW); xm0 = xp[0]; xm1 = xp[1]; }
    *(u32x4*)(sRaw + (lt + 3) * 72 + cg) = xm0; *(u32x4*)(sRaw + (lt + 3) * 72 + cg + 8) = xm1;
    if (tid < 12) { *(u32x4*)(sRaw + lt * 72 + cg) = xh0; *(u32x4*)(sRaw + lt * 72 + cg + 8) = xh1; }
    { const u32x4* xp = (const u32x4*)(xbase + (size_t)(64 + lt) * ZW); xm0 = xp[0]; xm1 = xp[1];
      if (tid < 12) { const u32x4* hp = (const u32x4*)(xbase + (size_t)(61 + lt) * ZW); xh0 = hp[0]; xh1 = hp[1]; } }
    __syncthreads();
#pragma unroll 1
    for (int chunk = 0; chunk < 32; ++chunk) {
        const int tc = chunk * 64;
        const bf16_t* rawc = (chunk & 1) ? sRaw2 : sRaw;
        bf16_t* rawn = (chunk & 1) ? sRaw : sRaw2;
        bf16_t gv[4];
#pragma unroll
        for (int j = 0; j < 4; ++j) gv[j] = ZA[(size_t)(b * S + tc + 16 * w + 4 * fq + j) * ZW + C_GR + n * 64 + 16 * ct + fr];
        {
            float xv[16];
#pragma unroll
            for (int e4 = 0; e4 < 4; ++e4) { const float4 bb = *(const float4*)(sCw + 256 + cg + 4 * e4); xv[4 * e4] = bb.x; xv[4 * e4 + 1] = bb.y; xv[4 * e4 + 2] = bb.z; xv[4 * e4 + 3] = bb.w; }
#pragma unroll
            for (int k = 0; k < 4; ++k) {
                const u32x4 v0 = *(const u32x4*)(rawc + (lt + k) * 72 + cg), v1 = *(const u32x4*)(rawc + (lt + k) * 72 + cg + 8);
                const unsigned u[8] = {v0.x, v0.y, v0.z, v0.w, v1.x, v1.y, v1.z, v1.w};
#pragma unroll
                for (int e4 = 0; e4 < 4; ++e4) {
                    const float4 wv = *(const float4*)(sCw + k * 64 + cg + 4 * e4);
                    xv[4 * e4] += wv.x * lo_f(u[2 * e4]);
                    xv[4 * e4 + 1] += wv.y * hi_f(u[2 * e4]);
                    xv[4 * e4 + 2] += wv.z * lo_f(u[2 * e4 + 1]);
                    xv[4 * e4 + 3] += wv.w * hi_f(u[2 * e4 + 1]);
                }
            }
            if ((tid & 3) == ct) {
#pragma unroll
                for (int e = 0; e < 16; ++e) sXf[lt * 17 + e] = xv[e];
            }
            u32x4 o0 = {pk2(xv[0], xv[1]), pk2(xv[2], xv[3]), pk2(xv[4], xv[5]), pk2(xv[6], xv[7])};
            u32x4 o1 = {pk2(xv[8], xv[9]), pk2(xv[10], xv[11]), pk2(xv[12], xv[13]), pk2(xv[14], xv[15])};
            *(u32x4*)(sX + lt * 80 + cg) = o0;
            *(u32x4*)(sX + lt * 80 + cg + 8) = o1;
        }
        __syncthreads();
        f32x4 R = (f32x4){0.f, 0.f, 0.f, 0.f}, I = (f32x4){0.f, 0.f, 0.f, 0.f};
#pragma unroll
        for (int ks = 0; ks < 2; ++ks) {
            const bf16x8 af = *(const bf16x8*)(sX + (16 * w + fr) * 80 + 32 * ks + 8 * fq);
            R = MFMA16(af, wa[ks], R); I = MFMA16(af, wi[ks], I);
        }
        if (chunk + 1 < 32) {
            *(u32x4*)(rawn + (lt + 3) * 72 + cg) = xm0; *(u32x4*)(rawn + (lt + 3) * 72 + cg + 8) = xm1;
            if (tid < 12) { *(u32x4*)(rawn + lt * 72 + cg) = xh0; *(u32x4*)(rawn + lt * 72 + cg + 8) = xh1; }
        }
        float hl[4], pc[4];
        float h = 0.f, pcum = 1.f;
#pragma unroll
        for (int j = 0; j < 4; ++j) {
            const float xcv = sXf[(16 * w + 4 * fq + j) * 17 + fr];
            const float rg = sigm(R[j] + ba), gi = sigm(I[j] + bi);
            const float la = rg * cl;
            const float a_ = __expf(la);
            const float mult = sqrtf(fmaxf(1.f - a_ * a_, 0.f));
            const float u = mult * gi * xcv;
            h = a_ * h + u; pcum *= a_;
            hl[j] = h; pc[j] = pcum;
        }
        float A = pcum, H = h;
        float A1 = __shfl_up(A, 16), H1 = __shfl_up(H, 16);
        if (fq >= 1) { H = A * H1 + H; A = A * A1; }
        float A2 = __shfl_up(A, 32), H2 = __shfl_up(H, 32);
        if (fq >= 2) { H = A * H2 + H; A = A * A2; }
        float Ax = __shfl_up(A, 16), Hx = __shfl_up(H, 16);
        const float Ae = fq == 0 ? 1.f : Ax, He = fq == 0 ? 0.f : Hx;
        if (fq == 3) { sSum[w * 16 + fr] = A; sSum[64 + w * 16 + fr] = H; }
        __syncthreads();
        if (chunk + 2 < 32) {
            const u32x4* xp = (const u32x4*)(xbase + (size_t)(tc + 128 + lt) * ZW); xm0 = xp[0]; xm1 = xp[1];
            if (tid < 12) { const u32x4* hp = (const u32x4*)(xbase + (size_t)(tc + 125 + lt) * ZW); xh0 = hp[0]; xh1 = hp[1]; }
        }
        float cin = carry, mycin = 0.f;
#pragma unroll
        for (int ww = 0; ww < 4; ++ww) {
            if (ww == w) mycin = cin;
            cin = sSum[ww * 16 + fr] * cin + sSum[64 + ww * 16 + fr];
        }
        carry = cin;
        const float sq = Ae * mycin + He;
#pragma unroll
        for (int j = 0; j < 4; ++j) {
            const float hfin = hl[j] + pc[j] * sq;
            const size_t grow = (size_t)(b * S + tc + 16 * w + 4 * fq + j);
            bf16_t* op = dry ? ((bf16_t*)(P.ws + W_YX) + grow * 1024 + n * 64 + 16 * ct + fr) : (ZA + grow * ZW + C_GR + n * 64 + 16 * ct + fr);
            *op = f2bf(gelu_t(bf2f(gv[j])) * hfin);
        }
    }
}

constexpr float EXPC = 0.125f * 1.4426950408889634f;
struct AttnAcc { f32x4 o[4][2]; float m[2], l[2]; };
DEV void attn_init(AttnAcc& a) {
#pragma unroll
    for (int d = 0; d < 4; ++d)
#pragma unroll
        for (int q = 0; q < 2; ++q) a.o[d][q] = (f32x4){0.f, 0.f, 0.f, 0.f};
    a.m[0] = a.m[1] = -INFINITY; a.l[0] = a.l[1] = 0.f;
}
DEV bf16x8 mk8(unsigned a, unsigned b, unsigned c, unsigned d) { u32x4 u = {a, b, c, d}; return __builtin_bit_cast(bf16x8, u); }

template <class MF>
DEV void attn_step(const bf16_t* sK, const bf16_t* sVt, int vstride, const bf16x8 (&qf)[2][2], AttnAcc& st, const MF& mf, int fr, int fq) {
    f32x4 s[4][2];
#pragma unroll
    for (int kt = 0; kt < 4; ++kt) {
        s[kt][0] = (f32x4){0.f, 0.f, 0.f, 0.f}; s[kt][1] = (f32x4){0.f, 0.f, 0.f, 0.f};
#pragma unroll
        for (int ks = 0; ks < 2; ++ks) {
            const bf16x8 kf = *(const bf16x8*)(sK + (16 * kt + fr) * 80 + 32 * ks + 8 * fq);
            s[kt][0] = MFMA16(kf, qf[0][ks], s[kt][0]);
            s[kt][1] = MFMA16(kf, qf[1][ks], s[kt][1]);
        }
    }
#pragma unroll
    for (int qt = 0; qt < 2; ++qt) {
        float mx = -INFINITY;
#pragma unroll
        for (int kt = 0; kt < 4; ++kt)
#pragma unroll
            for (int j = 0; j < 4; ++j) {
                const float v = mf(qt, 16 * kt + 4 * fq + j) ? s[kt][qt][j] : -INFINITY;
                s[kt][qt][j] = v; mx = fmaxf(mx, v);
            }
        mx = fmaxf(mx, __shfl_xor(mx, 16)); mx = fmaxf(mx, __shfl_xor(mx, 32));
        const float mn = fmaxf(st.m[qt], mx);
        float alpha = 1.f, msub = 0.f;
        if (mn != -INFINITY) { alpha = __builtin_amdgcn_exp2f((st.m[qt] - mn) * EXPC); msub = mn; }
        st.m[qt] = mn;
        float ps = 0.f;
#pragma unroll
        for (int kt = 0; kt < 4; ++kt)
#pragma unroll
            for (int j = 0; j < 4; ++j) { const float p = __builtin_amdgcn_exp2f((s[kt][qt][j] - msub) * EXPC); s[kt][qt][j] = p; ps += p; }
        st.l[qt] = st.l[qt] * alpha + ps;
#pragma unroll
        for (int dt = 0; dt < 4; ++dt) st.o[dt][qt] *= alpha;
    }
#pragma unroll
    for (int ks = 0; ks < 2; ++ks) {
        bf16x8 pf[2];
#pragma unroll
        for (int qt = 0; qt < 2; ++qt)
            pf[qt] = mk8(pk2(s[2 * ks][qt][0], s[2 * ks][qt][1]), pk2(s[2 * ks][qt][2], s[2 * ks][qt][3]),
                         pk2(s[2 * ks + 1][qt][0], s[2 * ks + 1][qt][1]), pk2(s[2 * ks + 1][qt][2], s[2 * ks + 1][qt][3]));
#pragma unroll
        for (int dt = 0; dt < 4; ++dt) {
            const u32x2 v0 = *(const u32x2*)(sVt + (16 * dt + fr) * vstride + 32 * ks + 4 * fq);
            const u32x2 v1 = *(const u32x2*)(sVt + (16 * dt + fr) * vstride + 32 * ks + 16 + 4 * fq);
            const bf16x8 vf = mk8(v0.x, v0.y, v1.x, v1.y);
            st.o[dt][0] = MFMA16(vf, pf[0], st.o[dt][0]);
            st.o[dt][1] = MFMA16(vf, pf[1], st.o[dt][1]);
        }
    }
}
DEV void attn_step_fast(const bf16_t* sK, const bf16_t* sVt, const bf16x8 (&qf)[2][2], AttnAcc& st, const float (&bitoff)[2], int fr, int fq) {
    f32x4 s[4][2];
#pragma unroll
    for (int kt = 0; kt < 4; ++kt) {
        s[kt][0] = (f32x4){0.f, 0.f, 0.f, 0.f}; s[kt][1] = (f32x4){0.f, 0.f, 0.f, 0.f};
#pragma unroll
        for (int ks = 0; ks < 2; ++ks) {
            const bf16x8 kf = *(const bf16x8*)(sK + (16 * kt + fr) * 80 + 32 * ks + 8 * fq);
            s[kt][0] = MFMA16(kf, qf[0][ks], s[kt][0]);
            s[kt][1] = MFMA16(kf, qf[1][ks], s[kt][1]);
        }
    }
#pragma unroll
    for (int qt = 0; qt < 2; ++qt) {
        float mx = fmaxf(fmaxf(s[0][qt][0], s[0][qt][1]), fmaxf(s[0][qt][2], s[0][qt][3]));
#pragma unroll
        for (int kt = 1; kt < 4; ++kt) mx = fmaxf(mx, fmaxf(fmaxf(s[kt][qt][0], s[kt][qt][1]), fmaxf(s[kt][qt][2], s[kt][qt][3])));
        mx = fmaxf(mx, __shfl_xor(mx, 16)); mx = fmaxf(mx, __shfl_xor(mx, 32));
        const float mn = fmaxf(st.m[qt], mx);
        const float alpha = __builtin_amdgcn_exp2f((st.m[qt] - mn) * EXPC);
        st.m[qt] = mn;
        const float off = bitoff[qt] - mn * EXPC;
        float ps = 0.f;
#pragma unroll
        for (int kt = 0; kt < 4; ++kt)
#pragma unroll
            for (int j = 0; j < 4; ++j) { const float p = __builtin_amdgcn_exp2f(fmaf(s[kt][qt][j], EXPC, off)); s[kt][qt][j] = p; ps += p; }
        st.l[qt] = st.l[qt] * alpha + ps;
#pragma unroll
        for (int dt = 0; dt < 4; ++dt) st.o[dt][qt] *= alpha;
    }
#pragma unroll
    for (int ks = 0; ks < 2; ++ks) {
        bf16x8 pf[2];
#pragma unroll
        for (int qt = 0; qt < 2; ++qt)
            pf[qt] = mk8(pk2(s[2 * ks][qt][0], s[2 * ks][qt][1]), pk2(s[2 * ks][qt][2], s[2 * ks][qt][3]),
                         pk2(s[2 * ks + 1][qt][0], s[2 * ks + 1][qt][1]), pk2(s[2 * ks + 1][qt][2], s[2 * ks + 1][qt][3]));
#pragma unroll
        for (int dt = 0; dt < 4; ++dt) {
            const u32x2 v0 = *(const u32x2*)(sVt + (16 * dt + fr) * 72 + 32 * ks + 4 * fq);
            const u32x2 v1 = *(const u32x2*)(sVt + (16 * dt + fr) * 72 + 32 * ks + 16 + 4 * fq);
            const bf16x8 vf = mk8(v0.x, v0.y, v1.x, v1.y);
            st.o[dt][0] = MFMA16(vf, pf[0], st.o[dt][0]);
            st.o[dt][1] = MFMA16(vf, pf[1], st.o[dt][1]);
        }
    }
}
template <int QT>
DEV void attn_half_fast(const bf16_t* sK, const bf16_t* sVt, const bf16x8 (&qf)[2][2], AttnAcc& st, float bitoff, int fr, int fq) {
    f32x4 s[4];
#pragma unroll
    for (int kt = 0; kt < 4; ++kt) {
        s[kt] = (f32x4){0.f, 0.f, 0.f, 0.f};
#pragma unroll
        for (int ks = 0; ks < 2; ++ks) {
            const bf16x8 kf = *(const bf16x8*)(sK + (16 * kt + fr) * 80 + 32 * ks + 8 * fq);
            s[kt] = MFMA16(kf, qf[QT][ks], s[kt]);
        }
    }
    float mx = fmaxf(fmaxf(s[0][0], s[0][1]), fmaxf(s[0][2], s[0][3]));
#pragma unroll
    for (int kt = 1; kt < 4; ++kt) mx = fmaxf(mx, fmaxf(fmaxf(s[kt][0], s[kt][1]), fmaxf(s[kt][2], s[kt][3])));
    mx = fmaxf(mx, __shfl_xor(mx, 16)); mx = fmaxf(mx, __shfl_xor(mx, 32));
    const float mn = fmaxf(st.m[QT], mx);
    const float alpha = __builtin_amdgcn_exp2f((st.m[QT] - mn) * EXPC);
    st.m[QT] = mn;
    const float off = bitoff - mn * EXPC;
    float ps = 0.f;
#pragma unroll
    for (int kt = 0; kt < 4; ++kt)
#pragma unroll
        for (int j = 0; j < 4; ++j) { const float p = __builtin_amdgcn_exp2f(fmaf(s[kt][j], EXPC, off)); s[kt][j] = p; ps += p; }
    st.l[QT] = st.l[QT] * alpha + ps;
#pragma unroll
    for (int dt = 0; dt < 4; ++dt) st.o[dt][QT] *= alpha;
#pragma unroll
    for (int ks = 0; ks < 2; ++ks) {
        const bf16x8 pf = mk8(pk2(s[2 * ks][0], s[2 * ks][1]), pk2(s[2 * ks][2], s[2 * ks][3]), pk2(s[2 * ks + 1][0], s[2 * ks + 1][1]), pk2(s[2 * ks + 1][2], s[2 * ks + 1][3]));
#pragma unroll
        for (int dt = 0; dt < 4; ++dt) {
            const u32x2 v0 = *(const u32x2*)(sVt + (16 * dt + fr) * 72 + 32 * ks + 4 * fq);
            const u32x2 v1 = *(const u32x2*)(sVt + (16 * dt + fr) * 72 + 32 * ks + 16 + 4 * fq);
            st.o[dt][QT] = MFMA16(mk8(v0.x, v0.y, v1.x, v1.y), pf, st.o[dt][QT]);
        }
    }
}
DEV void attn_fold_out(bf16_t* const (&op)[2], const AttnAcc& st, const float (&gate)[2]) {
#pragma unroll
    for (int qt = 0; qt < 2; ++qt) {
        float l = st.l[qt];
        l += __shfl_xor(l, 16); l += __shfl_xor(l, 32);
        const float sc = gate[qt] * __builtin_amdgcn_rcpf(fmaxf(l, 1e-30f));
#pragma unroll
        for (int dt = 0; dt < 4; ++dt) {
            const uint2 pv = *(const uint2*)(op[qt] + 16 * dt);
            f32x4 r = st.o[dt][qt] * sc;
            r[0] += lo_f(pv.x); r[1] += hi_f(pv.x); r[2] += lo_f(pv.y); r[3] += hi_f(pv.y);
            *(uint2*)(op[qt] + 16 * dt) = make_uint2(pk2(r[0], r[1]), pk2(r[2], r[3]));
        }
    }
}
DEV void attn_fold(f32x4 (&tot)[4][2], const AttnAcc& st, const float (&gate)[2]) {
#pragma unroll
    for (int qt = 0; qt < 2; ++qt) {
        float l = st.l[qt];
        l += __shfl_xor(l, 16); l += __shfl_xor(l, 32);
        const float sc = gate[qt] * __builtin_amdgcn_rcpf(fmaxf(l, 1e-30f));
#pragma unroll
        for (int dt = 0; dt < 4; ++dt) tot[dt][qt] += st.o[dt][qt] * sc;
    }
}
DEV void ld64(u32x4 (&r)[2], const bf16_t* src, size_t sstride, int tid) {
#pragma unroll
    for (int i = 0; i < 2; ++i) { const int c = tid + 256 * i; r[i] = *(const u32x4*)(src + (size_t)(c >> 3) * sstride + (c & 7) * 8); }
}
DEV void st64(bf16_t* dst, const u32x4 (&r)[2], int tid, int stride) {
#pragma unroll
    for (int i = 0; i < 2; ++i) { const int c = tid + 256 * i; *(u32x4*)(dst + (c >> 3) * stride + (c & 7) * 8) = r[i]; }
}

#define OUTP(QT) ((dry ? (bf16_t*)(P.ws + W_YX) + (size_t)(b * S + tq[QT]) * 1024 : ZA + (size_t)(b * S + tq[QT]) * ZW + C_Q) + head * 64 + 4 * fq)
#define LOAD_GATE(G2, BR) float G2[2]; { G2[0] = bf2f(ZA[(size_t)(b * S + tq[0]) * ZW + C_G + head * 3 + (BR)]); G2[1] = bf2f(ZA[(size_t)(b * S + tq[1]) * ZW + C_G + head * 3 + (BR)]); }
struct MaskAll { DEV bool operator()(int, int) const { return true; } };
struct MaskSel { unsigned bit[2]; int t[2]; int k0; DEV bool operator()(int qt, int kk) const { return bit[qt] && (k0 + kk <= t[qt]); } };
struct MaskWin { int t[2]; int k0; DEV bool operator()(int qt, int kk) const { const int k = k0 + kk; return k <= t[qt] && k > t[qt] - 512; } };

DEV void xattn_job(const Params& P, int job, char* smem, bool dry) {
    char* aux = (char*)P.out;
    bf16_t* ZA = (bf16_t*)(P.ws + W_ZA);
    const int qb = job & 15, h = (job >> 4) & 3, b = job >> 6;
    bf16_t* sK = (bf16_t*)smem;
    bf16_t* sVt = sK + 64 * 80;
    const int tid = opaque_tid(), w = tid >> 6, lane = tid & 63, fr = lane & 15, fq = lane >> 4;
    const int t0 = qb * 128 + w * 32;
    bf16x8 qf[2][2];
#pragma unroll
    for (int qt = 0; qt < 2; ++qt)
#pragma unroll
        for (int ks = 0; ks < 2; ++ks) qf[qt][ks] = *(const bf16x8*)(ZA + (size_t)(b * S + t0 + 16 * qt + fr) * ZW + C_QX + h * 64 + 32 * ks + 8 * fq);
    const bf16_t* MK = (const bf16_t*)(aux + O_MEMK) + (size_t)(b * 4 + h) * 256 * 64;
    const bf16_t* MVT = (const bf16_t*)(aux + O_MEMVT) + (size_t)(b * 4 + h) * 64 * 256;
    AttnAcc st; attn_init(st);
    u32x4 rk[2], rv[2];
    ld64(rk, MK, 64, tid); ld64(rv, MVT, 256, tid);
#pragma unroll 1
    for (int jb = 0; jb < 4; ++jb) {
        __syncthreads();
        st64(sK, rk, tid, 80); st64(sVt, rv, tid, 72);
        __syncthreads();
        if (jb + 1 < 4) { ld64(rk, MK + (size_t)(jb + 1) * 64 * 64, 64, tid); ld64(rv, MVT + (jb + 1) * 64, 256, tid); }
        __builtin_amdgcn_sched_barrier(0);
        { const float z2[2] = {0.f, 0.f}; attn_step_fast(sK, sVt, qf, st, z2, fr, fq); }
    }
    f32x4 tot[4][2];
#pragma unroll
    for (int dt = 0; dt < 4; ++dt) { tot[dt][0] = (f32x4){0.f, 0.f, 0.f, 0.f}; tot[dt][1] = (f32x4){0.f, 0.f, 0.f, 0.f}; }
    const float one[2] = {1.f, 1.f};
    attn_fold(tot, st, one);
#pragma unroll
    for (int qt = 0; qt < 2; ++qt)
#pragma unroll
        for (int dt = 0; dt < 4; ++dt)
            *(uint2*)((dry ? (bf16_t*)(P.ws + W_Y) + (size_t)(b * S + t0 + 16 * qt + fr) * 1024 : ZA + (size_t)(b * S + t0 + 16 * qt + fr) * ZW + C_QX) + h * 64 + 16 * dt + 4 * fq) =
                make_uint2(pk2(tot[dt][qt][0], tot[dt][qt][1]), pk2(tot[dt][qt][2], tot[dt][qt][3]));
}

DEV void nsa_job(const Params& P, int job, char* smem, bool dry) {
    char* aux = (char*)P.out;
    bf16_t* ZA = (bf16_t*)(P.ws + W_ZA);
    const int bg = job & 31, qb = 63 - (job >> 5), b = bg >> 2, g = bg & 3, t0 = qb * 32;
    bf16_t* sK = (bf16_t*)smem;
    bf16_t* sVt = (bf16_t*)(smem + 20480);
    float* sImp = (float*)(smem + 38912);
    unsigned* sSel = (unsigned*)(smem + 38912 + 4096);
    constexpr int KVBUF = 9728;
    const int tid = opaque_tid(), w = tid >> 6, lane = tid & 63, fr = lane & 15, fq = lane >> 4;
    const int head = g * 4 + (fr & 3);
    const int qi0 = 8 * w + (fr >> 2);
    int tq[2];
    bf16x8 qf[2][2];
#pragma unroll
    for (int qt = 0; qt < 2; ++qt) {
        tq[qt] = t0 + qi0 + 4 * qt;
        const bf16_t* rowp = ZA + (size_t)(b * S + tq[qt]) * ZW;
#pragma unroll
        for (int ks = 0; ks < 2; ++ks) qf[qt][ks] = *(const bf16x8*)(rowp + C_Q + head * 64 + 32 * ks + 8 * fq);
    }
    f32x4 tot[4][2];
#pragma unroll
    for (int dt = 0; dt < 4; ++dt) { tot[dt][0] = (f32x4){0.f, 0.f, 0.f, 0.f}; tot[dt][1] = (f32x4){0.f, 0.f, 0.f, 0.f}; }

    {
        const bf16_t* KC = (const bf16_t*)(aux + O_KC) + (size_t)bg * 128 * 64;
        const bf16_t* VCT = (const bf16_t*)(aux + O_VCT) + (size_t)bg * 64 * 128;
        __syncthreads();
#pragma unroll
        for (int i = 0; i < 4; ++i) {
            const int c = tid + 256 * i;
            { const int r = c >> 3, k = (c & 7) * 8; *(u32x4*)(sK + r * 80 + k) = *(const u32x4*)(KC + r * 64 + k); }
            { const int r = c >> 4, k = (c & 15) * 8; *(u32x4*)(sVt + r * 136 + k) = *(const u32x4*)(VCT + r * 128 + k); }
        }
        __syncthreads();
#pragma unroll
        for (int qt = 0; qt < 2; ++qt) {
            const float g0 = bf2f(ZA[(size_t)(b * S + tq[qt]) * ZW + C_G + head * 3 + 0]);
            f32x4 s[8];
#pragma unroll
            for (int kt = 0; kt < 8; ++kt) {
                s[kt] = (f32x4){0.f, 0.f, 0.f, 0.f};
#pragma unroll
                for (int ks = 0; ks < 2; ++ks) {
                    const bf16x8 kf = *(const bf16x8*)(sK + (16 * kt + fr) * 80 + 32 * ks + 8 * fq);
                    s[kt] = MFMA16(kf, qf[qt][ks], s[kt]);
                }
            }
            float mx = -INFINITY;
#pragma unroll
            for (int kt = 0; kt < 8; ++kt)
#pragma unroll
                for (int j = 0; j < 4; ++j) {
                    const int n = 16 * kt + 4 * fq + j;
                    const float v = (n < NCMP && 16 * n + 31 <= tq[qt]) ? s[kt][j] : -INFINITY;
                    s[kt][j] = v; mx = fmaxf(mx, v);
                }
            mx = fmaxf(mx, __shfl_xor(mx, 16)); mx = fmaxf(mx, __shfl_xor(mx, 32));
            const float msub = (mx == -INFINITY) ? 0.f : mx;
            float ps = 0.f;
#pragma unroll
            for (int kt = 0; kt < 8; ++kt)
#pragma unroll
                for (int j = 0; j < 4; ++j) { const float p = __builtin_amdgcn_exp2f((s[kt][j] - msub) * EXPC); s[kt][j] = p; ps += p; }
            ps += __shfl_xor(ps, 16); ps += __shfl_xor(ps, 32);
            const float inv = __builtin_amdgcn_rcpf(fmaxf(ps, 1e-30f));
            float bprev = 0.f;
#pragma unroll
            for (int kt = 0; kt < 8; ++kt) {
                s[kt] *= inv;
                const float a = s[kt][0] + s[kt][1] + s[kt][2] + 0.5f * s[kt][3];
                const float bq = 0.5f * s[kt][3];
                const float x = __shfl(bq, (lane + 48) & 63);
                const float y = __shfl(bprev, (lane + 48) & 63);
                float iv = a + (fq > 0 ? x : y);
                iv += __shfl_xor(iv, 1); iv += __shfl_xor(iv, 2);
                if ((fr & 3) == 0) sImp[(qi0 + 4 * qt) * 32 + 4 * kt + fq] = iv;
                bprev = bq;
            }
#pragma unroll
            for (int ks = 0; ks < 4; ++ks) {
                const f32x4 pa = s[2 * ks] * g0, pb = s[2 * ks + 1] * g0;
                const bf16x8 pf = mk8(pk2(pa[0], pa[1]), pk2(pa[2], pa[3]), pk2(pb[0], pb[1]), pk2(pb[2], pb[3]));
#pragma unroll
                for (int dt = 0; dt < 4; ++dt) {
                    const u32x2 v0 = *(const u32x2*)(sVt + (16 * dt + fr) * 136 + 32 * ks + 4 * fq);
                    const u32x2 v1 = *(const u32x2*)(sVt + (16 * dt + fr) * 136 + 32 * ks + 16 + 4 * fq);
                    tot[dt][qt] = MFMA16(mk8(v0.x, v0.y, v1.x, v1.y), pf, tot[dt][qt]);
                }
            }
            __builtin_amdgcn_sched_barrier(0);
        }
    }
#pragma unroll
    for (int qt = 0; qt < 2; ++qt) {
        bf16_t* op = (dry ? (bf16_t*)(P.ws + W_YX) + (size_t)(b * S + tq[qt]) * 1024 : ZA + (size_t)(b * S + tq[qt]) * ZW + C_Q) + head * 64 + 4 * fq;
#pragma unroll
        for (int dt = 0; dt < 4; ++dt) *(uint2*)(op + 16 * dt) = pk4(tot[dt][qt]);
    }
    __syncthreads();
    {
        float myv[4];
#pragma unroll
        for (int i = 0; i < 4; ++i) {
            const int pidx = tid + 256 * i, q = pidx >> 5, m = pidx & 31;
            const int t = t0 + q, cur = t >> 6;
            const float sum = sImp[q * 32 + m];
            const bool forced = (m == 0) || (m == cur) || (m == cur - 1);
            const bool future = m * 64 > t;
            myv[i] = forced ? INFINITY : (future ? -INFINITY : sum);
        }
        if (tid == 0) sSel[32] = 0u;
        __syncthreads();
#pragma unroll
        for (int i = 0; i < 4; ++i) { const int pidx = tid + 256 * i; sImp[pidx] = myv[i]; }
        __syncthreads();
        unsigned wun = 0u;
#pragma unroll
        for (int i = 0; i < 4; ++i) {
            const int pidx = tid + 256 * i, q = pidx >> 5, m = pidx & 31;
            const float v = myv[i];
            int rank = 0;
#pragma unroll
            for (int m2 = 0; m2 < 32; ++m2) {
                const float o = sImp[q * 32 + m2];
                rank += (o > v || (o == v && m2 < m)) ? 1 : 0;
            }
            const bool selb = (rank < 8) && (v > -INFINITY);
            const unsigned long long bal = __ballot(selb);
            const unsigned mk = (unsigned)(bal >> (32 * (lane >> 5)));
            if ((lane & 31) == 0) sSel[q] = mk;
            wun |= (unsigned)bal | (unsigned)(bal >> 32);
        }
        if (lane == 0) atomicOr(&sSel[32], wun);
    }
    __syncthreads();
    const unsigned uni = sSel[32];
    const int jmax = (t0 + 31) >> 6;
    {
        AttnAcc st; attn_init(st);
        const bf16_t* Kb = ZA + (size_t)(b * S) * ZW + C_KS + g * 64;
        const bf16_t* Vb = (const bf16_t*)(P.ws + W_VST) + (size_t)bg * 64 * S;
        unsigned rem = uni & ((2u << jmax) - 1u);
        u32x4 rk[2], rv[2];
        if (rem) { const int j0 = __builtin_ctz(rem); ld64(rk, Kb + (size_t)(j0 * 64) * ZW, ZW, tid); ld64(rv, Vb + j0 * 64, S, tid); }
        __syncthreads();
        int it = 0;
#pragma unroll 1
        while (rem) {
            const int jb = __builtin_ctz(rem);
            rem &= rem - 1u;
            bf16_t* sKb = (bf16_t*)smem + (it & 1) * KVBUF; bf16_t* sVb = sKb + 64 * 80; ++it;
            st64(sKb, rk, tid, 80); st64(sVb, rv, tid, 72);
            __syncthreads();
            if (rem) { const int jn = __builtin_ctz(rem); ld64(rk, Kb + (size_t)(jn * 64) * ZW, ZW, tid); ld64(rv, Vb + jn * 64, S, tid); }
            __builtin_amdgcn_sched_barrier(0);
            const unsigned b0 = (sSel[qi0] >> jb) & 1u, b1 = (sSel[qi0 + 4] >> jb) & 1u;
            if (jb * 64 + 63 <= t0) {
                const bool need0 = __builtin_amdgcn_ballot_w64(b0 != 0u) != 0ull, need1 = __builtin_amdgcn_ballot_w64(b1 != 0u) != 0ull;
                const float bo[2] = {b0 ? 0.f : -INFINITY, b1 ? 0.f : -INFINITY};
                if (need0 && need1) attn_step_fast(sKb, sVb, qf, st, bo, fr, fq);
                else if (need0) attn_half_fast<0>(sKb, sVb, qf, st, bo[0], fr, fq);
                else if (need1) attn_half_fast<1>(sKb, sVb, qf, st, bo[1], fr, fq);
            } else {
                MaskSel mf; mf.bit[0] = b0; mf.bit[1] = b1; mf.t[0] = tq[0]; mf.t[1] = tq[1]; mf.k0 = jb * 64;
                attn_step(sKb, sVb, 72, qf, st, mf, fr, fq);
            }
        }
        { LOAD_GATE(g1, 1) bf16_t* const op2[2] = {OUTP(0), OUTP(1)}; attn_fold_out(op2, st, g1); }
    }
    {
        AttnAcc st; attn_init(st);
        const bf16_t* Kb = ZA + (size_t)(b * S) * ZW + C_KW + g * 64;
        const bf16_t* Vb = (const bf16_t*)(P.ws + W_VWT) + (size_t)bg * 64 * S;
#pragma unroll
        for (int qt = 0; qt < 2; ++qt) {
            const int npad = 511 - tq[qt];
            if (npad > 0) { st.m[qt] = 0.f; st.l[qt] = (fq == 0) ? (float)npad : 0.f; }
        }
        int jlo = t0 - 511; jlo = jlo < 0 ? 0 : (jlo >> 6);
        u32x4 rk[2], rv[2];
        ld64(rk, Kb + (size_t)(jlo * 64) * ZW, ZW, tid); ld64(rv, Vb + jlo * 64, S, tid);
        __syncthreads();
#pragma unroll 1
        for (int jb = jlo; jb <= jmax; ++jb) {
            bf16_t* sKb = (bf16_t*)smem + ((jb - jlo) & 1) * KVBUF; bf16_t* sVb = sKb + 64 * 80;
            st64(sKb, rk, tid, 80); st64(sVb, rv, tid, 72);
            __syncthreads();
            if (jb < jmax) { ld64(rk, Kb + (size_t)((jb + 1) * 64) * ZW, ZW, tid); ld64(rv, Vb + (jb + 1) * 64, S, tid); }
            __builtin_amdgcn_sched_barrier(0);
            if (jb * 64 + 63 <= t0 && jb * 64 > t0 + 31 - 512) {
                const float z2[2] = {0.f, 0.f};
                attn_step_fast(sKb, sVb, qf, st, z2, fr, fq);
            } else {
                MaskWin mf; mf.t[0] = tq[0]; mf.t[1] = tq[1]; mf.k0 = jb * 64;
                attn_step(sKb, sVb, 72, qf, st, mf, fr, fq);
            }
        }
        { LOAD_GATE(g2, 2) bf16_t* const op2[2] = {OUTP(0), OUTP(1)}; attn_fold_out(op2, st, g2); }
    }
}


#define XB_TMO      128
#define XB_XCNT(j)  (256  + 64 * (j))
#define XB_XSUB(j)  (1280 + 64 * (j))
#define XB_XGEN(j)  (2304 + 64 * (j))
#define XB_TOP      3328
#define XB_TOPGEN   3392
#define XCD_BAR_WORDS 3456
#define XB_SPIN_CAP (1u << 18)
#define LAS __attribute__((address_space(3)))
DEV unsigned xb_ld(unsigned* p) { return __hip_atomic_load(p, __ATOMIC_RELAXED, __HIP_MEMORY_SCOPE_AGENT); }
DEV unsigned xb_add(unsigned* p, unsigned v) { return __hip_atomic_fetch_add(p, v, __ATOMIC_RELAXED, __HIP_MEMORY_SCOPE_AGENT); }
DEV unsigned xb_xcc_id() { return (unsigned)__builtin_amdgcn_s_getreg((3 << 11) | 20) & 0xFu; }
#define XB_SPIN(cond, bar) do { unsigned _sp = 0; while (cond) { __builtin_amdgcn_s_sleep(1); \
    if ((++_sp & 255u) == 0u) { if (xb_ld(&(bar)[XB_TMO])) break; if (_sp > XB_SPIN_CAP) { atomicAdd(&(bar)[XB_TMO], 1u); break; } } } } while (0)
struct XcdBarrier { unsigned* bar; unsigned x; volatile LAS unsigned* st; };
DEV XcdBarrier xcd_barrier_post(unsigned* bar, volatile LAS unsigned* st) {
    XcdBarrier b; b.bar = bar; b.x = xb_xcc_id(); b.st = st;
    if (threadIdx.x == 0) (void)xb_add(&bar[XB_XCNT(b.x)], 1u);
    return b;
}
DEV void xcd_barrier_complete(unsigned* bar, unsigned x, unsigned& nloc, unsigned& nx) {
    const unsigned G = gridDim.x * gridDim.y * gridDim.z;
    unsigned sum, cnt, mine, sp = 0u;
    for (;;) {
        sum = 0u; cnt = 0u; mine = 0u;
#pragma unroll
        for (unsigned j = 0; j < 16; ++j) { const unsigned c = xb_ld(&bar[XB_XCNT(j)]); sum += c; cnt += (c > 0u) ? 1u : 0u; mine = (j == x) ? c : mine; }
        if (sum == G) break;
        __builtin_amdgcn_s_sleep(1);
        if ((++sp & 255u) == 0u) { if (xb_ld(&bar[XB_TMO])) break; if (sp > XB_SPIN_CAP) { atomicAdd(&bar[XB_TMO], 1u); break; } }
    }
    nloc = mine > 0u ? mine : 1u; nx = cnt > 0u ? cnt : 1u;
}
DEV void xcd_barrier(const XcdBarrier& b) {
    asm volatile("s_waitcnt vmcnt(0)" ::: "memory");
    __syncthreads();
    if (threadIdx.x == 0) {
        unsigned* bar = b.bar;
        __builtin_amdgcn_s_waitcnt(0);
        unsigned nloc = b.st[0], nx = b.st[1];
        if (nloc == 0u) { xcd_barrier_complete(bar, b.x, nloc, nx); b.st[0] = nloc; b.st[1] = nx; }
        const unsigned old = xb_add(&bar[XB_XSUB(b.x)], 1u);
        const unsigned gen = old / nloc;
        if (old + 1u == (gen + 1u) * nloc) {
            __builtin_amdgcn_fence(__ATOMIC_RELEASE, "agent");
            asm volatile("s_waitcnt vmcnt(0)" ::: "memory");
            const unsigned og = xb_add(&bar[XB_TOP], 1u);
            const unsigned tg = og / nx;
            if (og + 1u == (tg + 1u) * nx) xb_add(&bar[XB_TOPGEN], 1u);
            else XB_SPIN(xb_ld(&bar[XB_TOPGEN]) == tg, bar);
            __builtin_amdgcn_fence(__ATOMIC_ACQUIRE, "agent");
            xb_add(&bar[XB_XGEN(b.x)], 1u);
            asm volatile("s_waitcnt vmcnt(0)" ::: "memory");
        } else {
            XB_SPIN(xb_ld(&bar[XB_XGEN(b.x)]) == gen, bar);
            __builtin_amdgcn_fence(__ATOMIC_ACQUIRE, "agent");
            asm volatile("s_waitcnt vmcnt(0)" ::: "memory");
        }
    }
    __syncthreads();
}
constexpr size_t W_BAR = 252 * MiB;

constexpr int NPHASE = 11;
constexpr int SMEM_BYTES = 61440;

template <int PH, bool DRY = false>
DEV void run_phase(const Params& P, char* smem) {
    const int nb = gridDim.x, bid = blockIdx.x;
    char* aux = (char*)P.out;
    char* ws = P.ws;
    bf16_t* ZA = (bf16_t*)(ws + W_ZA);
    if (PH == 0) {
        for (int job = bid; job < 4800 + 4096 + 512 + 64; job += nb) {
            int j = job;
            if (j < 4800) {
                bool done = false;
#define TR(SRC, LD, DSTOFF, KK, NN, MAP, BLK)                                                                                  \
    if (!done) { const int nrt = (NN) / 64, nt = nrt * ((KK) / 64);                                                              \
        if (j < nt) { transpose_tile((SRC), (LD), (bf16_t*)(aux + (DSTOFF)), (KK), (j % nrt) * 64, (j / nrt) * 64, (MAP), smem, (BLK) ? (NN) : 0); done = true; } else j -= nt; }
                TR(P.w_in, 7984, O_WTA, 1024, 4992, 1, 1)
                TR(P.w_in, 7984, O_WTB, 1024, 3072, 2, 1)
                TR(P.w_up, 4096, O_WTUP, 1024, 4096, 0, 1)
                TR(P.w_down, 1024, O_WTDN, 4096, 1024, 0, 1)
                TR(P.w_o, 1024, O_WTO, 1024, 1024, 0, 1)
                TR(P.w_xo, 1024, O_WTXO, 256, 1024, 0, 0)
                TR(P.w_mkv, 512, O_WTMKV, 1024, 512, 0, 0)
                TR(P.wk1, 256, O_WTCK1, 2048, 256, 0, 0)
                TR(P.wv1, 256, O_WTCV1, 2048, 256, 0, 0)
#undef TR
                if (!done) {
                    if (j < 16) transpose_tile(P.w_a + j * 4096, 64, (bf16_t*)(aux + O_WAT) + j * 4096, 64, 0, 0, 0, smem);
                    else { j -= 16; transpose_tile(P.w_i + j * 4096, 64, (bf16_t*)(aux + O_WIT) + j * 4096, 64, 0, 0, 0, smem); }
                }
                continue;
            }
            j -= 4800;
            if (j < 4096) { rownorm<false>(P.x, P.g_mix, (bf16_t*)(ws + W_U), nullptr, j * 4 + (threadIdx.x >> 6), true); continue; }
            j -= 4096;
            if (j < 512) { rownorm<false>(P.mem, P.g_mem, (bf16_t*)(aux + O_MEMN), nullptr, j * 4 + (threadIdx.x >> 6)); continue; }
            j -= 512;
            rope_job((float*)(aux + O_ROPEC), (float*)(aux + O_ROPES), j);
        }
    } else if (PH == 1) {
        const int nA = tile_count(39);
        for (int job = bid; job < 32 + nA; job += nb) {
            if (job < 32) {
                ALPlain al; al.A = (const bf16_t*)(aux + O_MEMN); al.lda = 1024; al.ks = 64;
                const int pm = job & 7, pn = job >> 3;
                if (pn < 2) { EpiMemKV<true> ep{(bf16_t*)(aux + O_MEMK), (bf16_t*)(aux + O_MEMVT)}; gemm_tile<8, 4, true>(al, (const bf16_t*)(aux + O_WTMKV), 1024, 64, 1024, pm, pn, ep, smem); }
                else { EpiMemKV<false> ep{(bf16_t*)(aux + O_MEMK), (bf16_t*)(aux + O_MEMVT)}; gemm_tile<8, 4, false>(al, (const bf16_t*)(aux + O_WTMKV), 1024, 64, 1024, pm, pn, ep, smem); }
            } else {
                int pm, pn;
                if (!tile_map(job - 32, 39, pm, pn)) continue;
                ALPlain al; al.A = (const bf16_t*)(ws + W_U); al.lda = 64; al.ks = 16384 * 64;
                if (pn < 35) { EpiZA<true> ep{ZA, (bf16_t*)(ws + W_VST), (bf16_t*)(ws + W_VWT), (const float*)(aux + O_ROPEC), (const float*)(aux + O_ROPES)};
                    gemm_tile<8, 4, true>(al, (const bf16_t*)(aux + O_WTA), 64, 4992 * 64, 1024, pm, pn, ep, smem); }
                else { EpiZA<false> ep{ZA, (bf16_t*)(ws + W_VST), (bf16_t*)(ws + W_VWT), (const float*)(aux + O_ROPEC), (const float*)(aux + O_ROPES)};
                    gemm_tile<8, 4, false>(al, (const bf16_t*)(aux + O_WTA), 64, 4992 * 64, 1024, pm, pn, ep, smem); }
            }
        }
    } else if (PH == 2) {
        for (int job = bid; job < 1280; job += nb) {
            if (job < 128) {
                const int j = job, which = j >> 6, pm = (j & 63) >> 1, pn = j & 1;
                float* sPos = (float*)(smem + 40960);
                __syncthreads();
                { const float* pg = which ? P.cpv : P.cpk; const int t8 = threadIdx.x * 8; *(float4*)(sPos + t8) = *(const float4*)(pg + t8); *(float4*)(sPos + t8 + 4) = *(const float4*)(pg + t8 + 4); }
                ALCmp al; al.ZA = ZA; al.spos = sPos; al.colbase = which ? C_VC : C_KC;
                EpiHid ep{(bf16_t*)(aux + (which ? O_HIDV : O_HIDK))};
                gemm_tile<4, 4, true>(al, (const bf16_t*)(aux + (which ? O_WTCV1 : O_WTCK1)), 2048, 64, 2048, pm, pn, ep, smem);
            } else if (job < 640) rnn_job(P, job - 128, smem, DRY);
            else if (job < 1024) xattn_job(P, job - 640, smem, DRY);
            else if (job >= 1152) xattn_job(P, job - 1152 + 384, smem, DRY);
        }
    } else if (PH == 3) {
        for (int job = bid; job < 2032; job += nb) cmp2_job(P, job);
    } else if (PH == 4) {
        for (int job = bid; job < 2048 + 512; job += nb) {
            if (job < 2048) nsa_job(P, job, smem, DRY);
            else if (!DRY) {
                int pm, pn;
                if (!tile_map(job - 2048, 8, pm, pn)) continue;
                ALPlain al; al.A = ZA + C_QX; al.lda = ZW; al.ks = 64;
                EpiBf<0> ep{(bf16_t*)(ws + W_YX), 1024};
                gemm_tile<8, 4, true>(al, (const bf16_t*)(aux + O_WTXO), 256, 64, 256, pm, pn, ep, smem);
            }
        }
    } else if (PH == 5) {
        for (int job = bid; job < tile_count(32); job += nb) {
            int pm, pn;
            if (!tile_map(job, 32, pm, pn)) continue;
            ALPlain al; al.A = (const bf16_t*)(ws + W_U); al.lda = 64; al.ks = 16384 * 64;
            EpiMerge ep{ZA, (const bf16_t*)(ws + W_YX), (bf16_t*)(ws + W_Y)};
            gemm_tile<8, 3, true>(al, (const bf16_t*)(aux + O_WTB), 64, 3072 * 64, 1024, pm, pn, ep, smem);
        }
    } else if (PH == 6) {
        for (int job = bid; job < tile_count(8); job += nb) {
            int pm, pn;
            if (!tile_map(job, 8, pm, pn)) continue;
            ALPlain al; al.A = (const bf16_t*)(ws + W_Y); al.lda = 64; al.ks = 16384 * 64;
            EpiRes ep{P.x, (float*)(ws + W_H)};
            gemm_tile<8, 4, true>(al, (const bf16_t*)(aux + O_WTO), 64, 1024 * 64, 1024, pm, pn, ep, smem);
        }
    } else if (PH == 7) {
        for (int job = bid; job < 4096; job += nb) rownorm<false>((const float*)(ws + W_H), P.g_mlp, (bf16_t*)(ws + W_VN), nullptr, job * 4 + (threadIdx.x >> 6), true);
    } else if (PH == 8) {
        for (int job = bid; job < tile_count(32); job += nb) {
            int pm, pn;
            if (!tile_map(job, 32, pm, pn)) continue;
            ALPlain al; al.A = (const bf16_t*)(ws + W_VN); al.lda = 64; al.ks = 16384 * 64;
            EpiBf<1> ep{(bf16_t*)(ws + W_HID), 4096};
            gemm_tile<8, 4, true>(al, (const bf16_t*)(aux + O_WTUP), 64, 4096 * 64, 1024, pm, pn, ep, smem);
        }
    } else if (PH == 9) {
        for (int job = bid; job < tile_count(8); job += nb) {
            int pm, pn;
            if (!tile_map(job, 8, pm, pn)) continue;
            ALPlain al; al.A = (const bf16_t*)(ws + W_HID); al.lda = 64; al.ks = 16384 * 64;
            EpiRes ep{(const float*)(ws + W_H), (float*)(ws + W_H)};
            gemm_tile<8, 4, true>(al, (const bf16_t*)(aux + O_WTDN), 64, 1024 * 64, 4096, pm, pn, ep, smem);
        }
    } else if (PH == 10) {
        for (int job = bid; job < 4096; job += nb) rownorm<true>((const float*)(ws + W_H), P.g_final, nullptr, P.out, job * 4 + (threadIdx.x >> 6));
    }
}

#if MULTI
template <int PH>
__global__ void __launch_bounds__(256, 2) phase_kernel(Params P) {
    __shared__ __attribute__((aligned(16))) char smem[SMEM_BYTES];
    run_phase<PH>(P, smem);
}
#else
__global__ void __launch_bounds__(256, 2) mega_kernel(Params P) {
    __shared__ __attribute__((aligned(16))) char smem[SMEM_BYTES];
    cg::grid_group grid = cg::this_grid();
    __shared__ uint4 xb_words;
    if (threadIdx.x == 0) xb_words = make_uint4(0u, 0u, 0u, 0u);
    __syncthreads();
    XcdBarrier xb = xcd_barrier_post((unsigned*)(P.ws + W_BAR), (volatile LAS unsigned*)&xb_words);
    if (P.ws == nullptr) grid.sync();
#ifndef REP
#define REP -1
#endif
#define GSYNC() xcd_barrier(xb)
#define PHASE(k) { if (REP == k && k != 9) { run_phase<k, true>(P, smem); GSYNC(); } run_phase<k>(P, smem); GSYNC(); }
    PHASE(0) PHASE(1) PHASE(2) PHASE(3) PHASE(4) PHASE(5) PHASE(6) PHASE(7) PHASE(8) PHASE(9)
    if (REP == 10) { run_phase<10>(P, smem); GSYNC(); }
    if (REP == 11) { GSYNC(); GSYNC(); GSYNC(); GSYNC(); GSYNC(); GSYNC(); GSYNC(); GSYNC(); GSYNC(); GSYNC(); }
    run_phase<10>(P, smem);
}
#endif

extern "C" void kernel_launch(void* const* d_in, const int* in_sizes, int n_in, void* d_out, int out_size, void* d_ws, size_t ws_size,
                              hipStream_t stream) {
    Params P{};
    const float** pp = (const float**)&P;
    for (int i = 0; i < 25; ++i) pp[i] = (const float*)d_in[i];
    P.out = (float*)d_out;
    P.ws = (char*)d_ws;
#if MULTI
    const int G = 1024;
    phase_kernel<0><<<G, 256, 0, stream>>>(P);
    phase_kernel<1><<<G, 256, 0, stream>>>(P);
    phase_kernel<2><<<G, 256, 0, stream>>>(P);
    phase_kernel<3><<<G, 256, 0, stream>>>(P);
    phase_kernel<4><<<G, 256, 0, stream>>>(P);
    phase_kernel<5><<<G, 256, 0, stream>>>(P);
    phase_kernel<6><<<G, 256, 0, stream>>>(P);
    phase_kernel<7><<<G, 256, 0, stream>>>(P);
    phase_kernel<8><<<G, 256, 0, stream>>>(P);
    phase_kernel<9><<<G, 256, 0, stream>>>(P);
    phase_kernel<10><<<G, 256, 0, stream>>>(P);
#else
    static int grid_blocks = 0;
    if (!grid_blocks) {
        int dev = 0, cus = 0, per_cu = 0;
        hipGetDevice(&dev);
        hipDeviceGetAttribute(&cus, hipDeviceAttributeMultiprocessorCount, dev);
        hipOccupancyMaxActiveBlocksPerMultiprocessor(&per_cu, mega_kernel, 256, 0);
        if (per_cu > 2) per_cu = 2;
        if (per_cu < 1) per_cu = 1;
        grid_blocks = cus * per_cu;
    }
    hipMemsetAsync((char*)d_ws + W_BAR, 0, XCD_BAR_WORDS * 4, stream);
    void* args[] = {&P};
    hipError_t e = hipLaunchCooperativeKernel((void*)mega_kernel, dim3(grid_blocks), dim3(256), args, 0, stream);
    if (e != hipSuccess) fprintf(stderr, "cooperative launch failed: %s (grid %d)\n", hipGetErrorString(e), grid_blocks);
#endif
}
```

```cpp
#include <hip/hip_runtime.h>
#include <hip/hip_cooperative_groups.h>
#include <cstdint>
#include <cstdio>
namespace cg = cooperative_groups;

#ifndef MULTI
#define MULTI 0
#endif

typedef unsigned short bf16_t;
typedef short bf16x8 __attribute__((ext_vector_type(8)));
typedef float f32x4 __attribute__((ext_vector_type(4)));
typedef __bf16 bfv2 __attribute__((ext_vector_type(2)));
typedef float f32x2 __attribute__((ext_vector_type(2)));
typedef unsigned u32x4 __attribute__((ext_vector_type(4)));
typedef unsigned u32x2 __attribute__((ext_vector_type(2)));
#define DEV __device__ __forceinline__
DEV int opaque_tid() { int t = threadIdx.x & 255; asm volatile("" : "+v"(t)); return t; }
DEV int opaque_tid512() { int t = threadIdx.x; asm volatile("" : "+v"(t)); return t; }
#define MFMA16(a, b, c) __builtin_amdgcn_mfma_f32_16x16x32_bf16((a), (b), (c), 0, 0, 0)

constexpr int T = 16384, S = 2048;
constexpr int ZW = 4480;
constexpr int C_Q = 0, C_KC = 1024, C_VC = 1280, C_KS = 1536, C_KW = 1792, C_XR = 2048, C_GR = 3072, C_QX = 4096, C_G = 4352;
constexpr int NCMP = 127;
constexpr int NCROWS = 4064;

constexpr size_t O_WTA = 0;
constexpr size_t O_WTB = O_WTA + (size_t)5120 * 1024 * 2;
constexpr size_t O_WTUP = O_WTB + (size_t)4096 * 1024 * 2;
constexpr size_t O_WTDN = O_WTUP + (size_t)4096 * 1024 * 2;
constexpr size_t O_WTO = O_WTDN + (size_t)4096 * 1024 * 2;
constexpr size_t O_WTXO = O_WTO + (size_t)1024 * 1024 * 2;
constexpr size_t O_WTMKV = O_WTXO + (size_t)1024 * 256 * 2;
constexpr size_t O_WTCK1 = O_WTMKV + (size_t)512 * 1024 * 2;
constexpr size_t O_WTCV1 = O_WTCK1 + (size_t)256 * 2048 * 2;
constexpr size_t O_WAT = O_WTCV1 + (size_t)256 * 2048 * 2;
constexpr size_t O_WIT = O_WAT + (size_t)16 * 64 * 64 * 2;
constexpr size_t O_ROPEC = O_WIT + (size_t)16 * 64 * 64 * 2;
constexpr size_t O_ROPES = O_ROPEC + (size_t)2048 * 8 * 4;
constexpr size_t O_MEMN = O_ROPES + (size_t)2048 * 8 * 4;
constexpr size_t O_MEMK = O_MEMN + (size_t)2048 * 1024 * 2;
constexpr size_t O_MEMVT = O_MEMK + (size_t)2048 * 256 * 2;
constexpr size_t O_HIDK = O_MEMVT + (size_t)2048 * 256 * 2;
constexpr size_t O_HIDV = O_HIDK + (size_t)4096 * 256 * 2;
constexpr size_t O_KC = O_HIDV + (size_t)4096 * 256 * 2;
constexpr size_t O_VCT = O_KC + (size_t)32 * 128 * 64 * 2;
constexpr size_t O_AUX_END = O_VCT + (size_t)32 * 64 * 128 * 2;
static_assert(O_AUX_END <= (size_t)64 << 20, "aux overflow");
constexpr size_t MiB = (size_t)1 << 20;
constexpr size_t W_U = 0, W_ZA = 32 * MiB, W_VST = 172 * MiB, W_VWT = 180 * MiB, W_YX = 188 * MiB, W_Y = 220 * MiB;
constexpr size_t W_H = 32 * MiB, W_VN = 0, W_HID = 96 * MiB;

struct Params {
    const float *x, *mem, *g_mix, *w_in, *cpk, *cpv, *wk1, *wk2, *wv1, *wv2, *conv_w, *conv_b, *w_a, *b_a, *w_i, *b_i, *lam,
        *g_mem, *w_mkv, *w_xo, *w_o, *g_mlp, *w_up, *w_down, *g_final;
    float* out;
    char* ws;
};

DEV float bf2f(bf16_t h) { return __uint_as_float(((unsigned)h) << 16); }
DEV unsigned pk2(float lo, float hi) { f32x2 v = {lo, hi}; bfv2 b = __builtin_convertvector(v, bfv2); return __builtin_bit_cast(unsigned, b); }
DEV bf16_t f2bf(float f) { return (bf16_t)(pk2(f, 0.f) & 0xffffu); }
DEV float lo_f(unsigned u) { return __uint_as_float(u << 16); }
DEV float hi_f(unsigned u) { return __uint_as_float(u & 0xffff0000u); }
DEV float sigm(float x) { return __builtin_amdgcn_rcpf(1.f + __expf(-x)); }
DEV float gelu_t(float x) {
    float y = 0.7978845608028654f * (x + 0.044715f * x * x * x);
    float e = __expf(2.f * y);
    float th = 1.f - 2.f * __builtin_amdgcn_rcpf(1.f + e);
    return 0.5f * x * (1.f + th);
}
DEV float wave_sum(float v) {
#pragma unroll
    for (int o = 32; o >= 1; o >>= 1) v += __shfl_xor(v, o);
    return v;
}

DEV int map_col(int mapid, int r) {
    if (mapid == 0) return r;
    if (mapid == 1) {
        if (r < 1536) return r;
        if (r < 1792) return 1536 + (r - 1536);
        if (r < 2048) return 2048 + (r - 1792);
        if (r < 3072) return 2608 + (r - 2048);
        if (r < 4096) return 3632 + (r - 3072);
        if (r < 4352) return 4656 + (r - 4096);
        if (r < 4608) return 1792 + (r - 4352);
        if (r < 4864) return 2304 + (r - 4608);
        if (r < 4912) return 2560 + (r - 4864);
        return -1;
    }
    const int pn = r >> 8, rem = r & 255, bj = rem >> 7, wc = (rem >> 5) & 3, n = (rem >> 4) & 1, c16 = rem & 15, slot = 2 * bj + n;
    if (slot == 3) return -1;
    return 4912 + slot * 1024 + pn * 64 + wc * 16 + c16;
}

DEV void transpose_tile(const float* __restrict__ src, int ld, bf16_t* __restrict__ dst, int K, int r0, int k0, int mapid, char* smem, int nblk = 0) {
    float* sm = (float*)smem;
    const int tid = threadIdx.x & 255, lane = tid & 63, w = tid >> 6;
    __syncthreads();
    const int sc = map_col(mapid, r0 + lane);
#pragma unroll
    for (int i = 0; i < 16; ++i) {
        int kk = w + 4 * i;
        float v = sc >= 0 ? src[(size_t)(k0 + kk) * ld + sc] : 0.f;
        sm[kk * 65 + lane] = v;
    }
    __syncthreads();
    const int rr = tid >> 2, kq = (tid & 3) * 16;
    unsigned o[8];
#pragma unroll
    for (int e = 0; e < 8; ++e) o[e] = pk2(sm[(kq + 2 * e) * 65 + rr], sm[(kq + 2 * e + 1) * 65 + rr]);
    uint4* dp = nblk ? (uint4*)(dst + (size_t)(k0 >> 6) * nblk * 64 + (size_t)(r0 + rr) * 64 + kq) : (uint4*)(dst + (size_t)(r0 + rr) * K + k0 + kq);
    dp[0] = make_uint4(o[0], o[1], o[2], o[3]);
    dp[1] = make_uint4(o[4], o[5], o[6], o[7]);
}

template <bool OUTF32>
DEV void rownorm(const float* __restrict__ src, const float* __restrict__ g, bf16_t* dstb, float* dstf, int row, bool blk = false) {
    const int lane = opaque_tid() & 63;
    const float4* sp = (const float4*)(src + (size_t)row * 1024);
    float4 v[4];
    float ss = 0.f;
#pragma unroll
    for (int i = 0; i < 4; ++i) { v[i] = sp[lane + 64 * i]; ss += v[i].x * v[i].x + v[i].y * v[i].y + v[i].z * v[i].z + v[i].w * v[i].w; }
    ss = wave_sum(ss);
    const float r = rsqrtf(ss * (1.0f / 1024.0f) + 1e-6f);
#pragma unroll
    for (int i = 0; i < 4; ++i) {
        float4 gg = ((const float4*)g)[lane + 64 * i];
        float a = v[i].x * r * gg.x, b = v[i].y * r * gg.y, c = v[i].z * r * gg.z, d = v[i].w * r * gg.w;
        if (OUTF32) ((float4*)(dstf + (size_t)row * 1024))[lane + 64 * i] = make_float4(a, b, c, d);
        else if (blk) { const int col = 4 * (lane + 64 * i); *(uint2*)(dstb + (size_t)(col >> 6) * ((size_t)16384 * 64) + (size_t)row * 64 + (col & 63)) = make_uint2(pk2(a, b), pk2(c, d)); }
        else ((uint2*)(dstb + (size_t)row * 1024))[lane + 64 * i] = make_uint2(pk2(a, b), pk2(c, d));
    }
}

DEV void rope_job(float* ct, float* st, int job) {
    const int e = job * 256 + (threadIdx.x & 255);
    const int pos = e >> 3, i = e & 7;
    const double inv = exp(-(double)i * 0.125 * 13.122363377404328);
    const double ang = (double)pos * inv;
    const double kq = rint(ang * 0.6366197723675814);
    const double r = ang - kq * 1.5707963267948966;
    const double r2 = r * r;
    const double sn = r * (1.0 + r2 * (-1.0 / 6 + r2 * (1.0 / 120 + r2 * (-1.0 / 5040 + r2 * (1.0 / 362880 + r2 * (-1.0 / 39916800 + r2 * (1.0 / 6227020800.0)))))));
    const double cs = 1.0 + r2 * (-0.5 + r2 * (1.0 / 24 + r2 * (-1.0 / 720 + r2 * (1.0 / 40320 + r2 * (-1.0 / 3628800 + r2 * (1.0 / 479001600.0))))));
    const int q = ((int)kq) & 3;
    double s_, c_;
    if (q == 0) { s_ = sn; c_ = cs; } else if (q == 1) { s_ = cs; c_ = -sn; } else if (q == 2) { s_ = -sn; c_ = -cs; } else { s_ = -cs; c_ = sn; }
    ct[e] = (float)c_; st[e] = (float)s_;
}

struct ALPlain {
    const bf16_t* A; int lda; int ks;
    const char* base; unsigned off0;
    DEV void init(int row0, int lrow, int lk) { base = (const char*)(A + (size_t)row0 * lda); off0 = (unsigned)(lrow * lda + lk) * 2u; }
    DEV u32x4 load(int i, int k0) const { return *(const u32x4*)(base + (off0 + (unsigned)(i * 128 * lda) + (unsigned)(k0 >> 6) * (unsigned)(ks * 2))); }
    DEV u32x4 fix(int, const u32x4& v, int) const { return v; }
};
struct ALCmp {
    const bf16_t* ZA; const float* spos; int colbase;
    unsigned roff[4]; int lk_;
    DEV void init(int row0, int lrow, int lk) {
        lk_ = lk;
#pragma unroll
        for (int i = 0; i < 4; ++i) {
            const int row = row0 + lrow + 64 * i;
            const int bg = row / NCMP, n = row - bg * NCMP, b = bg >> 2, g = bg & 3;
            roff[i] = row < NCROWS ? (unsigned)(((b * S + 16 * n) * ZW + colbase + g * 64 + lk) * 2) : 0xffffffffu;
        }
    }
    DEV u32x4 load(int i, int k0) const {
        if (roff[i] == 0xffffffffu) return (u32x4){0u, 0u, 0u, 0u};
        return *(const u32x4*)((const char*)ZA + (roff[i] + (unsigned)((k0 >> 6) * ZW * 2)));
    }
    DEV u32x4 fix(int i, const u32x4& v, int k0) const {
        if (roff[i] == 0xffffffffu) return v;
        const float4 p0 = *(const float4*)(spos + k0 + lk_), p1 = *(const float4*)(spos + k0 + lk_ + 4);
        u32x4 o;
        o.x = pk2(lo_f(v.x) + p0.x, hi_f(v.x) + p0.y); o.y = pk2(lo_f(v.y) + p0.z, hi_f(v.y) + p0.w);
        o.z = pk2(lo_f(v.z) + p1.x, hi_f(v.z) + p1.y); o.w = pk2(lo_f(v.w) + p1.z, hi_f(v.w) + p1.w);
        return o;
    }
};

template <int TM, int TN, bool SWAP, class AL, class EP>
DEV void gemm_tile(AL al, const bf16_t* __restrict__ Bt, int ldb, int bks, int K, int pm, int pn, const EP& ep, char* smem) {
    constexpr int BM = TM * 32, BN = TN * 64, NA = BM / 64, NBB = (BN + 63) / 64;
    bf16_t* sA = (bf16_t*)smem;
    bf16_t* sB = sA + BM * 72;
    const int tid = opaque_tid512(), wid = tid >> 6, lane = tid & 63, wr = wid >> 2, wc = wid & 3, fr = lane & 15, fq = lane >> 4;
    f32x4 acc[TM][TN];
#pragma unroll
    for (int m = 0; m < TM; ++m)
#pragma unroll
        for (int n = 0; n < TN; ++n) acc[m][n] = (f32x4){0.f, 0.f, 0.f, 0.f};
    const int lrow = tid >> 3, lk = (tid & 7) * 8;
    u32x4 ra[NA], rb[NBB];
    al.init(pm * BM, lrow, lk);
    const char* bbase = (const char*)(Bt + (size_t)(pn * BN) * ldb);
    const unsigned boff = (unsigned)(lrow * ldb + lk) * 2u;
#pragma unroll
    for (int i = 0; i < NBB; ++i) rb[i] = (u32x4){0u, 0u, 0u, 0u};
#pragma unroll
    for (int i = 0; i < NA; ++i) ra[i] = al.load(i, 0);
#pragma unroll
    for (int i = 0; i < NBB; ++i) if (BN % 64 == 0 || lrow + 64 * i < BN) rb[i] = *(const u32x4*)(bbase + (boff + (unsigned)(i * 128 * ldb)));
    int nk = K >> 6;
    asm volatile("" : "+s"(nk));
    bf16_t* sWa = sA + lrow * 72 + lk;
    bf16_t* sWb = sB + lrow * 72 + lk;
    const bf16_t* sAr = sA + (wr * TM * 16 + fr) * 72 + fq * 8;
    const bf16_t* sBr = sB + (wc * TN * 16 + fr) * 72 + fq * 8;
#pragma unroll 1
    for (int kt = 0; kt < nk; ++kt) {
        __syncthreads();
#pragma unroll
        for (int i = 0; i < NA; ++i) *(u32x4*)(sWa + (64 * i) * 72) = al.fix(i, ra[i], kt * 64);
#pragma unroll
        for (int i = 0; i < NBB; ++i) if (BN % 64 == 0 || lrow + 64 * i < BN) *(u32x4*)(sWb + (64 * i) * 72) = rb[i];
        __syncthreads();
        if (kt + 1 < nk) {
            const int k0 = (kt + 1) * 64;
#pragma unroll
            for (int i = 0; i < NA; ++i) ra[i] = al.load(i, k0);
#pragma unroll
            for (int i = 0; i < NBB; ++i) if (BN % 64 == 0 || lrow + 64 * i < BN) rb[i] = *(const u32x4*)(bbase + (boff + (unsigned)(i * 128 * ldb) + (unsigned)(k0 >> 6) * (unsigned)(bks * 2)));
        }
        __builtin_amdgcn_sched_barrier(0);
        __builtin_amdgcn_s_setprio(1);
#pragma unroll
        for (int ks = 0; ks < 2; ++ks) {
            bf16x8 bfr[TN];
#pragma unroll
            for (int n = 0; n < TN; ++n) bfr[n] = *(const bf16x8*)(sBr + (n * 16) * 72 + ks * 32);
#pragma unroll
            for (int m = 0; m < TM; ++m) {
                const bf16x8 af = *(const bf16x8*)(sAr + (m * 16) * 72 + ks * 32);
#pragma unroll
                for (int n = 0; n < TN; ++n) acc[m][n] = SWAP ? MFMA16(bfr[n], af, acc[m][n]) : MFMA16(af, bfr[n], acc[m][n]);
            }
        }
        __builtin_amdgcn_s_setprio(0);
    }
    ep.run(acc, pm * BM + wr * TM * 16, pn * BN + wc * TN * 16, fr, fq);
}

DEV uint2 pk4(const f32x4& a) { return make_uint2(pk2(a[0], a[1]), pk2(a[2], a[3])); }

namespace pg8 {
#define PG8_LAS __attribute__((address_space(3)))
typedef unsigned short bf16_t;
typedef short bf16x8 __attribute__((ext_vector_type(8)));
typedef float f32x4 __attribute__((ext_vector_type(4)));
typedef unsigned u32x4 __attribute__((ext_vector_type(4)));
constexpr int BM = 256, BK = 64, HALF = 128, HTB = HALF * BK * 2  , STAGE_BYTES = 8 * HTB, NXCD = 8, WGM = 8;

__host__ __device__ __forceinline__ int lds_byte(int r, int c) { const int st = (r >> 4) * 2 + (c >> 5), rr = r & 15, cc = c & 31, ob = rr * 64 + cc * 2; return st * 1024 + (ob ^ (((ob >> 9) & 1) << 5)); }
__host__ __device__ __forceinline__ void stage_rc(int b, int& R, int& C) { const int st = b / 1024, sb = b % 1024, swz = sb ^ (((sb >> 9) & 1) << 5); R = (st >> 1) * 16 + swz / 64; C = (st & 1) * 32 + (swz % 64) / 2; }
__host__ __device__ __forceinline__ int perm32(int rho) { const int n = rho >> 4, i = rho & 15; return 8 * (i >> 2) + 4 * n + (i & 3); }

struct Unit { int pm, pn; };
struct Gemm { const bf16_t* A; const bf16_t* Bt; int M, N, K, lda, ldb; };

struct StaticOrder {
    int nM, nN, nwg, G, c;
    __host__ __device__ void init(int M, int N, int G_, int c_) { nM = M / BM; nN = N / BM; nwg = nM * nN; G = G_; c = c_; }
    __host__ __device__ bool next(int i, Unit& u) const {
        const long L = (long)i * G + c; if (L >= nwg) return false;
        int wgid = (int)L; { const int q = nwg / NXCD, r = nwg % NXCD, xcd = wgid % NXCD, off = wgid / NXCD; wgid = (xcd < r ? xcd * (q + 1) : r * (q + 1) + (xcd - r) * q) + off; }
        const int nig = WGM * nN, gid = wgid / nig, fm = gid * WGM, gsz = (nM - fm) < WGM ? (nM - fm) : WGM;
        u.pm = fm + ((wgid % nig) % gsz); u.pn = (wgid % nig) / gsz; return true;
    }
    __device__ __forceinline__ void a_ready(const Unit&) const {}
    __device__ __forceinline__ void done(const Unit&) const {}
};

template <class Epi, class Sched, bool ALIGN_EPI = false, bool SP2 = false>
__device__ __forceinline__ void gemm_phase(PG8_LAS unsigned char* lds, const Gemm g, const Sched& S, const Epi& E) {
    const int tid = opaque_tid512(), wid = __builtin_amdgcn_readfirstlane(tid >> 6), lane = tid & 63, wr = wid >> 2, wc = wid & 3, fr = lane & 15, fq = lane >> 4;
    const int K = g.K, nt = K / BK;
    unsigned voffA[2], voffB[2];
#pragma unroll
    for (int i = 0; i < 2; ++i) { int R, C; stage_rc(tid * 16 + i * 8192, R, C); const int Rb = Epi::PERM ? ((R & ~31) + perm32(R & 31)) : R;
        voffA[i] = (unsigned)(R * g.lda + C) * 2u; voffB[i] = (unsigned)(Rb * g.ldb + C) * 2u; }
    const size_t kstep = (size_t)(BK * 2);
    const size_t hstepA = (size_t)HALF * g.lda * 2, hstepB = (size_t)HALF * g.ldb * 2;
    const size_t tstepA = 2 * hstepA, tstepB = 2 * hstepB;
    const unsigned ldsw = (unsigned)wid * 1024u;
    const int aoff = lds_byte(wr * 64 + fr, fq * 8), boff = lds_byte(wc * 32 + fr, fq * 8);
#define PG8_SA(b, h) (((b) * 2 + (h)) * HTB)
#define PG8_SB(b, h) ((4 + (b) * 2 + (h)) * HTB)
#define PG8_STAGE(bufoff, gbase, voff) do { _Pragma("unroll") for (int _i = 0; _i < 2; ++_i) \
        __builtin_amdgcn_global_load_lds((const unsigned*)((const char*)(gbase) + (voff)[_i]), (PG8_LAS unsigned*)(lds + (bufoff) + ldsw + _i * 8192), 16, 0, 0); } while (0)
#define PG8_LDA(dst, b, h) do { _Pragma("unroll") for (int m = 0; m < 4; ++m) _Pragma("unroll") for (int k = 0; k < 2; ++k) dst[m][k] = *(const PG8_LAS bf16x8*)(lds + PG8_SA(b, h) + aoff + m * 2048 + k * 1024); } while (0)
#define PG8_LDB(dst, b, h) do { _Pragma("unroll") for (int n = 0; n < 2; ++n) _Pragma("unroll") for (int k = 0; k < 2; ++k) dst[n][k] = *(const PG8_LAS bf16x8*)(lds + PG8_SB(b, h) + boff + n * 2048 + k * 1024); } while (0)
#define PG8_MMA(ai, bj, At, Bt) do { __builtin_amdgcn_s_setprio(1); _Pragma("unroll") for (int m = 0; m < 4; ++m) _Pragma("unroll") for (int n = 0; n < 2; ++n) _Pragma("unroll") for (int k = 0; k < 2; ++k) \
        acc[ai][bj][m][n] = __builtin_amdgcn_mfma_f32_16x16x32_bf16(Bt[n][k], At[m][k], acc[ai][bj][m][n], 0, 0, 0); __builtin_amdgcn_s_setprio(0); } while (0)
#define PG8_WAIT_V(n) asm volatile("s_waitcnt vmcnt(" #n ")" ::: "memory")
#define PG8_WAIT_L(n) asm volatile("s_waitcnt lgkmcnt(" #n ")" ::: "memory")
#define PG8_BAR __builtin_amdgcn_s_barrier()
#define PG8_SCHED __builtin_amdgcn_sched_barrier(0)
    Unit cur, nxt; int ui = 0;
    if (!S.next(0, cur)) return;
    f32x4 acc[2][2][4][2];
#pragma unroll
    for (int a = 0; a < 2; ++a)
#pragma unroll
        for (int b = 0; b < 2; ++b)
#pragma unroll
            for (int m = 0; m < 4; ++m)
#pragma unroll
                for (int n = 0; n < 2; ++n) acc[a][b][m][n] = (f32x4){0.f, 0.f, 0.f, 0.f};
    bf16x8 At[4][2], B0[2][2], B1[2][2];
    const char* cA = (const char*)g.A + (size_t)cur.pm * tstepA; const char* cB = (const char*)g.Bt + (size_t)cur.pn * tstepB;
    S.a_ready(cur);
    if constexpr (SP2) {
        PG8_STAGE(PG8_SB(0, 0), cB, voffB); PG8_STAGE(PG8_SB(0, 1), cB + hstepB, voffB); PG8_STAGE(PG8_SA(0, 0), cA, voffA); PG8_STAGE(PG8_SA(0, 1), cA + hstepA, voffA);
        if (wr == 1) PG8_BAR;
        PG8_WAIT_V(2); PG8_BAR;
        PG8_STAGE(PG8_SB(1, 0), cB + kstep, voffB); PG8_STAGE(PG8_SA(1, 0), cA + kstep, voffA); PG8_STAGE(PG8_SB(1, 1), cB + hstepB + kstep, voffB);
        PG8_WAIT_V(6); PG8_BAR;
    } else {
        PG8_STAGE(PG8_SB(0, 0), cB, voffB); PG8_STAGE(PG8_SA(0, 0), cA, voffA); PG8_STAGE(PG8_SB(0, 1), cB + hstepB, voffB); PG8_STAGE(PG8_SA(0, 1), cA + hstepA, voffA);
        if (wr == 1) PG8_BAR;
        PG8_WAIT_V(4); PG8_BAR;
        PG8_STAGE(PG8_SB(1, 0), cB + kstep, voffB); PG8_STAGE(PG8_SA(1, 0), cA + kstep, voffA); PG8_STAGE(PG8_SB(1, 1), cB + hstepB + kstep, voffB);
        PG8_WAIT_V(6); PG8_BAR;
    }
    for (;;) {
        const bool has_next = S.next(ui + 1, nxt);
        const char* nA = has_next ? (const char*)g.A + (size_t)nxt.pm * tstepA : cA; const char* nB = has_next ? (const char*)g.Bt + (size_t)nxt.pn * tstepB : cB;
        for (int t = 0; t < nt; t += 2) {
            const bool last = (t == nt - 2);
            const char* a1 = cA + (size_t)(t + 1) * kstep;
            const char* a2 = last ? nA : cA + (size_t)(t + 2) * kstep; const char* b2 = last ? nB : cB + (size_t)(t + 2) * kstep;
            const char* a3 = a2 + kstep; const char* b3 = b2 + kstep;
            if (last && has_next) S.a_ready(nxt);
            if constexpr (SP2) {
            PG8_LDB(B0, 0, 0); PG8_LDB(B1, 0, 1); PG8_SCHED; PG8_LDA(At, 0, 0); PG8_STAGE(PG8_SA(1, 1), a1 + hstepA, voffA);
            PG8_WAIT_V(8); PG8_WAIT_L(0); PG8_BAR; PG8_MMA(0, 0, At, B0); PG8_MMA(0, 1, At, B1); PG8_BAR; PG8_SCHED;
            PG8_LDA(At, 0, 1); PG8_STAGE(PG8_SB(0, 0), b2, voffB); PG8_STAGE(PG8_SB(0, 1), b2 + hstepB, voffB); PG8_STAGE(PG8_SA(0, 0), a2, voffA);
            PG8_WAIT_V(8); PG8_WAIT_L(0); PG8_BAR; PG8_MMA(1, 0, At, B0); PG8_MMA(1, 1, At, B1); PG8_BAR; PG8_SCHED;
            PG8_LDB(B0, 1, 0); PG8_LDB(B1, 1, 1); PG8_SCHED; PG8_LDA(At, 1, 0); PG8_STAGE(PG8_SA(0, 1), a2 + hstepA, voffA);
            PG8_WAIT_V(8); PG8_WAIT_L(0); PG8_BAR; PG8_MMA(0, 0, At, B0); PG8_MMA(0, 1, At, B1); PG8_BAR; PG8_SCHED;
            PG8_LDA(At, 1, 1); PG8_STAGE(PG8_SB(1, 0), b3, voffB); PG8_STAGE(PG8_SB(1, 1), b3 + hstepB, voffB); PG8_STAGE(PG8_SA(1, 0), a3, voffA);
            PG8_WAIT_V(8); PG8_WAIT_L(0); PG8_BAR; PG8_MMA(1, 0, At, B0); PG8_MMA(1, 1, At, B1); PG8_BAR; PG8_SCHED;
            } else {
            PG8_LDB(B0, 0, 0); PG8_SCHED; PG8_LDA(At, 0, 0); PG8_STAGE(PG8_SA(1, 1), a1 + hstepA, voffA);
            PG8_WAIT_L(8); PG8_BAR; PG8_WAIT_L(0); PG8_MMA(0, 0, At, B0); PG8_BAR; PG8_SCHED;
            PG8_LDB(B1, 0, 1); PG8_STAGE(PG8_SB(0, 0), b2, voffB);
            PG8_BAR; PG8_WAIT_L(0); PG8_MMA(0, 1, At, B1); PG8_BAR;
            PG8_LDA(At, 0, 1); PG8_STAGE(PG8_SA(0, 0), a2, voffA);
            PG8_BAR; PG8_WAIT_L(0); PG8_MMA(1, 0, At, B0); PG8_BAR; PG8_SCHED;
            PG8_STAGE(PG8_SB(0, 1), b2 + hstepB, voffB);
            PG8_WAIT_V(6); PG8_BAR; PG8_MMA(1, 1, At, B1); PG8_BAR;
            PG8_LDB(B0, 1, 0); PG8_SCHED; PG8_LDA(At, 1, 0); PG8_STAGE(PG8_SA(0, 1), a2 + hstepA, voffA);
            PG8_WAIT_L(8); PG8_BAR; PG8_WAIT_L(0); PG8_MMA(0, 0, At, B0); PG8_BAR; PG8_SCHED;
            PG8_LDB(B1, 1, 1); PG8_STAGE(PG8_SB(1, 0), b3, voffB);
            PG8_BAR; PG8_WAIT_L(0); PG8_MMA(0, 1, At, B1); PG8_BAR;
            PG8_LDA(At, 1, 1); PG8_STAGE(PG8_SA(1, 0), a3, voffA);
            PG8_BAR; PG8_WAIT_L(0); PG8_MMA(1, 0, At, B0); PG8_BAR; PG8_SCHED;
            PG8_STAGE(PG8_SB(1, 1), b3 + hstepB, voffB);
            PG8_WAIT_V(6); PG8_BAR; PG8_MMA(1, 1, At, B1); PG8_BAR;
            }
        }
        if constexpr (ALIGN_EPI) { if (wr == 0) PG8_BAR; }
        if constexpr (!Epi::AFTER_DRAIN) { E(acc, cur, wr, wc, fr, fq); S.done(cur); }
        if (!has_next) break;
#pragma unroll
        for (int a = 0; a < 2; ++a)
#pragma unroll
            for (int b = 0; b < 2; ++b)
#pragma unroll
                for (int m = 0; m < 4; ++m)
#pragma unroll
                    for (int n = 0; n < 2; ++n) acc[a][b][m][n] = (f32x4){0.f, 0.f, 0.f, 0.f};
        cur = nxt; cA = nA; cB = nB; ++ui;
        if constexpr (ALIGN_EPI) { if (wr == 1) PG8_BAR; }
    }
    PG8_WAIT_V(0);
    if constexpr (!ALIGN_EPI) { if (wr == 0) PG8_BAR; }
    PG8_BAR;
    if constexpr (Epi::AFTER_DRAIN) { E.fused(acc, cur, wr, wc, fr, fq, lds, wid, lane); S.done(cur); }
#undef PG8_SA
#undef PG8_SB
#undef PG8_STAGE
#undef PG8_LDA
#undef PG8_LDB
#undef PG8_MMA
#undef PG8_WAIT_V
#undef PG8_WAIT_L
#undef PG8_BAR
#undef PG8_SCHED
}
}

struct EpiHid {
    bf16_t* H;
    DEV void run(f32x4 (&acc)[8][4], int R0, int C0, int fr, int fq) const {
#pragma unroll
        for (int n = 0; n < 4; ++n)
#pragma unroll
            for (int m = 0; m < 8; ++m) {
                const int c = C0 + n * 16 + 4 * fq, r = R0 + m * 16 + fr;
                f32x4 a = acc[m][n];
#pragma unroll
                for (int j = 0; j < 4; ++j) a[j] = gelu_t(a[j]);
                if (r < NCROWS) *(uint2*)(H + (size_t)r * 256 + c) = pk4(a);
            }
    }
};
#define PG8_EPI_HEAD static constexpr bool PERM = false, AFTER_DRAIN = false;
#define PG8_FOR_TILES _Pragma("unroll") for (int ai = 0; ai < 2; ++ai) _Pragma("unroll") for (int bj = 0; bj < 2; ++bj) _Pragma("unroll") for (int m = 0; m < 4; ++m) _Pragma("unroll") for (int n = 0; n < 2; ++n)
struct PEpiZA {
    PG8_EPI_HEAD
    bf16_t *ZA, *VST, *VWT; const float *ropec, *ropes;
    DEV void operator()(const f32x4 (&acc)[2][2][4][2], const pg8::Unit& u, int wr, int wc, int fr, int fq) const {
        asm volatile("" : "+v"(fr), "+v"(fq));
        PG8_FOR_TILES {
            const int row = u.pm * 256 + ai * 128 + wr * 64 + m * 16 + fr, col0 = u.pn * 256 + bj * 128 + wc * 32 + n * 16;
            f32x4 a = acc[ai][bj][m][n];
            if (u.pn == 17 || u.pn == 18) {
                bf16_t* dst = (u.pn == 17) ? VST : VWT;
                const int c = (col0 & 255) + 4 * fq, b = row >> 11, t = row & 2047;
#pragma unroll
                for (int j = 0; j < 4; ++j) { const int cc = c + j; dst[((size_t)((b * 4 + (cc >> 6)) * 64 + (cc & 63))) * S + t] = f2bf(a[j]); }
            } else {
                const bool rope = (col0 < 1024 || (col0 >= 1536 && col0 < 2048)) && ((col0 & 63) == 0);
                if (rope) {
                    const int t = row & 2047, i0 = 4 * (fq & 1);
                    const float4 cs = *(const float4*)(ropec + t * 8 + i0), sn = *(const float4*)(ropes + t * 8 + i0);
                    const float c4[4] = {cs.x, cs.y, cs.z, cs.w}, s4[4] = {sn.x, sn.y, sn.z, sn.w};
#pragma unroll
                    for (int j = 0; j < 4; ++j) {
                        const float pr = __shfl_xor(a[j], 32);
                        a[j] = (fq & 2) ? (a[j] * c4[j] + pr * s4[j]) : (a[j] * c4[j] - pr * s4[j]);
                    }
                }
                int zc0 = col0;
                if (col0 >= 4864) {
                    zc0 = col0 - 512;
#pragma unroll
                    for (int j = 0; j < 4; ++j) a[j] = sigm(a[j]);
                }
                if (zc0 < ZW) *(uint2*)(ZA + (size_t)row * ZW + zc0 + 4 * fq) = pk4(a);
            }
        }
    }
};
struct PEpiMemKV {
    PG8_EPI_HEAD
    bf16_t *MK, *MVT;
    DEV void operator()(const f32x4 (&acc)[2][2][4][2], const pg8::Unit& u, int wr, int wc, int fr, int fq) const {
        asm volatile("" : "+v"(fr), "+v"(fq));
        PG8_FOR_TILES {
            const int r = u.pm * 256 + ai * 128 + wr * 64 + m * 16 + fr, c = u.pn * 256 + bj * 128 + wc * 32 + n * 16 + 4 * fq;
            const int b = r >> 8, mm = r & 255;
            const f32x4 a = acc[ai][bj][m][n];
            if (u.pn == 0) { const int h = (c >> 6) & 3, d = c & 63; *(uint2*)(MK + ((size_t)(b * 4 + h) * 256 + mm) * 64 + d) = pk4(a); }
            else {
#pragma unroll
                for (int j = 0; j < 4; ++j) { const int cc = c + j, h = (cc >> 6) & 3, d = cc & 63; MVT[((size_t)(b * 4 + h) * 64 + d) * 256 + mm] = f2bf(a[j]); }
            }
        }
    }
};
template <int ACT>
struct PEpiBf {
    PG8_EPI_HEAD
    bf16_t* O; int ldo;
    DEV void operator()(const f32x4 (&acc)[2][2][4][2], const pg8::Unit& u, int wr, int wc, int fr, int fq) const {
        asm volatile("" : "+v"(fr), "+v"(fq));
        PG8_FOR_TILES {
            const int r = u.pm * 256 + ai * 128 + wr * 64 + m * 16 + fr, c = u.pn * 256 + bj * 128 + wc * 32 + n * 16 + 4 * fq;
            f32x4 a = acc[ai][bj][m][n];
            if (ACT == 1) {
#pragma unroll
                for (int j = 0; j < 4; ++j) { const float v = fmaxf(a[j], 0.f); a[j] = v * v; }
            }
            *(uint2*)(O + (size_t)r * ldo + c) = pk4(a);
        }
    }
};
struct PEpiRes {
    PG8_EPI_HEAD
    const float* R; float* O;
    DEV void operator()(const f32x4 (&acc)[2][2][4][2], const pg8::Unit& u, int wr, int wc, int fr, int fq) const {
        asm volatile("" : "+v"(fr), "+v"(fq));
        PG8_FOR_TILES {
            const size_t o = (size_t)(u.pm * 256 + ai * 128 + wr * 64 + m * 16 + fr) * 1024 + u.pn * 256 + bj * 128 + wc * 32 + n * 16 + 4 * fq;
            const f32x4 r = *(const f32x4*)(R + o);
            *(f32x4*)(O + o) = r + acc[ai][bj][m][n];
        }
    }
};
struct PEpiMerge {
    PG8_EPI_HEAD
    const bf16_t *ZA, *YX; bf16_t* Y;
    DEV void operator()(const f32x4 (&acc)[2][2][4][2], const pg8::Unit& u, int wr, int wc, int fr, int fq) const {
        asm volatile("" : "+v"(fr), "+v"(fq));
        const int ch = u.pn * 64 + wc * 16 + 4 * fq;
#pragma unroll
        for (int ai = 0; ai < 2; ++ai)
#pragma unroll
            for (int m = 0; m < 4; ++m) {
                const size_t row = (size_t)(u.pm * 256 + ai * 128 + wr * 64 + m * 16 + fr);
                const uint2 a = *(const uint2*)(ZA + row * ZW + C_Q + ch), b = *(const uint2*)(ZA + row * ZW + C_GR + ch), c = *(const uint2*)(YX + row * 1024 + ch);
                const f32x4 g0 = acc[ai][0][m][0], g1 = acc[ai][0][m][1], g2 = acc[ai][1][m][0];
                f32x4 y;
                y[0] = sigm(g0[0]) * lo_f(a.x) + sigm(g1[0]) * lo_f(b.x) + sigm(g2[0]) * lo_f(c.x);
                y[1] = sigm(g0[1]) * hi_f(a.x) + sigm(g1[1]) * hi_f(b.x) + sigm(g2[1]) * hi_f(c.x);
                y[2] = sigm(g0[2]) * lo_f(a.y) + sigm(g1[2]) * lo_f(b.y) + sigm(g2[2]) * lo_f(c.y);
                y[3] = sigm(g0[3]) * hi_f(a.y) + sigm(g1[3]) * hi_f(b.y) + sigm(g2[3]) * hi_f(c.y);
                *(uint2*)(Y + row * 1024 + ch) = pk4(y);
            }
    }
};

DEV bool tile_map(int idx, int NT, int& pm, int& pn) {
    const int x = idx & 7, pl = (idx >> 3) & 3, pmid = (idx >> 5) & 7, st = idx >> 8;
    pm = pmid * 8 + x;
    pn = st * 4 + pl;
    return pn < NT;
}
DEV int tile_count(int NT) { return ((NT + 3) / 4) * 256; }

DEV void cmp2_job(const Params& P, int job) {
    char* aux = (char*)P.out;
    const int lane = threadIdx.x & 63, w = (threadIdx.x & 255) >> 6;
    const int wj = job * 4 + w;
    const int which = wj >= NCROWS ? 1 : 0;
    const int r = wj - which * NCROWS;
    const int bg = r / NCMP, n = r - bg * NCMP;
    const bf16_t* hid = (const bf16_t*)(aux + (which ? O_HIDV : O_HIDK)) + (size_t)r * 256;
    const float* w2 = which ? P.wv2 : P.wk2;
    float acc = 0.f;
#pragma unroll 8
    for (int k = 0; k < 256; ++k) acc += bf2f(hid[k]) * w2[k * 64 + lane];
    if (!which) {
        const int pos = 16 * n + 31, i = lane & 7;
        const float cs = ((const float*)(aux + O_ROPEC))[pos * 8 + i], sn = ((const float*)(aux + O_ROPES))[pos * 8 + i];
        const float pr = __shfl_xor(acc, 8);
        float o = acc;
        if (lane < 16) o = (lane & 8) ? (acc * cs + pr * sn) : (acc * cs - pr * sn);
        bf16_t* KC = (bf16_t*)(aux + O_KC);
        KC[((size_t)bg * 128 + n) * 64 + lane] = f2bf(o);
        if (n == NCMP - 1) KC[((size_t)bg * 128 + 127) * 64 + lane] = 0;
    } else {
        bf16_t* VCT = (bf16_t*)(aux + O_VCT);
        VCT[((size_t)bg * 64 + lane) * 128 + n] = f2bf(acc);
        if (n == NCMP - 1) VCT[((size_t)bg * 64 + lane) * 128 + 127] = 0;
    }
}

DEV void rnn_job(const Params& P, int job, char* smem, bool dry) {
    char* aux = (char*)P.out;
    bf16_t* ZA = (bf16_t*)(P.ws + W_ZA);
    const int b = job >> 6, n = (job >> 2) & 15, ct = job & 3;
    bf16_t* sX = (bf16_t*)smem;
    float* sXf = (float*)(smem + 9216);
    float* sCw = (float*)(smem + 9216 + 16640);
    float* sSum = (float*)(smem + 9216 + 16640 + 1280);
    bf16_t* sRaw = (bf16_t*)(smem + 9216 + 16640 + 1280 + 2048);
    const int tid = opaque_tid(), w = tid >> 6, lane = tid & 63, fr = lane & 15, fq = lane >> 4;
    const bf16_t* WAT = (const bf16_t*)(aux + O_WAT) + n * 4096;
    const bf16_t* WIT = (const bf16_t*)(aux + O_WIT) + n * 4096;
    bf16x8 wa[2], wi[2];
#pragma unroll
    for (int ks = 0; ks < 2; ++ks) {
        wa[ks] = *(const bf16x8*)(WAT + (16 * ct + fr) * 64 + 32 * ks + 8 * fq);
        wi[ks] = *(const bf16x8*)(WIT + (16 * ct + fr) * 64 + 32 * ks + 8 * fq);
    }
    const int c = n * 64 + 16 * ct + fr;
    const float ba = P.b_a[c], bi = P.b_i[c], cl = -8.0f * log1pf(__expf(-P.lam[c]));
    float carry = 0.f;
    __syncthreads();
    for (int i = tid; i < 320; i += 256) sCw[i] = (i < 256) ? P.conv_w[(i >> 6) * 1024 + n * 64 + (i & 63)] : P.conv_b[n * 64 + (i & 63)];
    const int lt = tid >> 2, cg = (tid & 3) * 16;
    const bf16_t* xbase = ZA + (size_t)(b * S) * ZW + C_XR + n * 64 + cg;
    bf16_t* sRaw2 = sRaw + 67 * 72;
    u32x4 xm0, xm1, xh0 = {0u, 0u, 0u, 0u}, xh1 = {0u, 0u, 0u, 0u};
    { const u32x4* xp = (const u32x4*)(xbase + (size_t)lt * ZW); xm0 = xp[0]; xm1 = xp[1]; }
    *(u32x4*)(sRaw + (lt + 3) * 72 + cg) = xm0; *(u32x4*)(sRaw + (lt + 3) * 72 + cg + 8) = xm1;
    if (tid < 12) { *(u32x4*)(sRaw + lt * 72 + cg) = xh0; *(u32x4*)(sRaw + lt * 72 + cg + 8) = xh1; }
    { const u32x4* xp = (const u32x4*)(xbase + (size_t)(64 + lt) * ZW); xm0 = xp[0]; xm1 = xp[1];
      if (tid < 12) { const u32x4* hp = (const u32x4*)(xbase + (size_t)(61 + lt) * ZW); xh0 = hp[0]; xh1 = hp[1]; } }
    __syncthreads();
#pragma unroll 1
    for (int chunk = 0; chunk < 32; ++chunk) {
        const int tc = chunk * 64;
        const bf16_t* rawc = (chunk & 1) ? sRaw2 : sRaw;
        bf16_t* rawn = (chunk & 1) ? sRaw : sRaw2;
        bf16_t gv[4];
#pragma unroll
        for (int j = 0; j < 4; ++j) gv[j] = ZA[(size_t)(b * S + tc + 16 * w + 4 * fq + j) * ZW + C_GR + n * 64 + 16 * ct + fr];
        {
            float xv[16];
#pragma unroll
            for (int e4 = 0; e4 < 4; ++e4) { const float4 bb = *(const float4*)(sCw + 256 + cg + 4 * e4); xv[4 * e4] = bb.x; xv[4 * e4 + 1] = bb.y; xv[4 * e4 + 2] = bb.z; xv[4 * e4 + 3] = bb.w; }
#pragma unroll
            for (int k = 0; k < 4; ++k) {
                const u32x4 v0 = *(const u32x4*)(rawc + (lt + k) * 72 + cg), v1 = *(const u32x4*)(rawc + (lt + k) * 72 + cg + 8);
                const unsigned u[8] = {v0.x, v0.y, v0.z, v0.w, v1.x, v1.y, v1.z, v1.w};
#pragma unroll
                for (int e4 = 0; e4 < 4; ++e4) {
                    const float4 wv = *(const float4*)(sCw + k * 64 + cg + 4 * e4);
                    xv[4 * e4] += wv.x * lo_f(u[2 * e4]);
                    xv[4 * e4 + 1] += wv.y * hi_f(u[2 * e4]);
                    xv[4 * e4 + 2] += wv.z * lo_f(u[2 * e4 + 1]);
                    xv[4 * e4 + 3] += wv.w * hi_f(u[2 * e4 + 1]);
                }
            }
            if ((tid & 3) == ct) {
#pragma unroll
                for (int e = 0; e < 16; ++e) sXf[lt * 17 + e] = xv[e];
            }
            u32x4 o0 = {pk2(xv[0], xv[1]), pk2(xv[2], xv[3]), pk2(xv[4], xv[5]), pk2(xv[6], xv[7])};
            u32x4 o1 = {pk2(xv[8], xv[9]), pk2(xv[10], xv[11]), pk2(xv[12], xv[13]), pk2(xv[14], xv[15])};
            *(u32x4*)(sX + lt * 72 + cg) = o0;
            *(u32x4*)(sX + lt * 72 + cg + 8) = o1;
        }
        __syncthreads();
        f32x4 R = (f32x4){0.f, 0.f, 0.f, 0.f}, I = (f32x4){0.f, 0.f, 0.f, 0.f};
#pragma unroll
        for (int ks = 0; ks < 2; ++ks) {
            const bf16x8 af = *(const bf16x8*)(sX + (16 * w + fr) * 72 + 32 * ks + 8 * fq);
            R = MFMA16(af, wa[ks], R); I = MFMA16(af, wi[ks], I);
        }
        if (chunk + 1 < 32) {
            *(u32x4*)(rawn + (lt + 3) * 72 + cg) = xm0; *(u32x4*)(rawn + (lt + 3) * 72 + cg + 8) = xm1;
            if (tid < 12) { *(u32x4*)(rawn + lt * 72 + cg) = xh0; *(u32x4*)(rawn + lt * 72 + cg + 8) = xh1; }
        }
        float hl[4], pc[4];
        float h = 0.f, pcum = 1.f;
#pragma unroll
        for (int j = 0; j < 4; ++j) {
            const float xcv = sXf[(16 * w + 4 * fq + j) * 17 + fr];
            const float rg = sigm(R[j] + ba), gi = sigm(I[j] + bi);
            const float la = rg * cl;
            const float a_ = __expf(la);
            const float mult = sqrtf(fmaxf(1.f - a_ * a_, 0.f));
            const float u = mult * gi * xcv;
            h = a_ * h + u; pcum *= a_;
            hl[j] = h; pc[j] = pcum;
        }
        float A = pcum, H = h;
        float A1 = __shfl_up(A, 16), H1 = __shfl_up(H, 16);
        if (fq >= 1) { H = A * H1 + H; A = A * A1; }
        float A2 = __shfl_up(A, 32), H2 = __shfl_up(H, 32);
        if (fq >= 2) { H = A * H2 + H; A = A * A2; }
        float Ax = __shfl_up(A, 16), Hx = __shfl_up(H, 16);
        const float Ae = fq == 0 ? 1.f : Ax, He = fq == 0 ? 0.f : Hx;
        if (fq == 3) { sSum[w * 16 + fr] = A; sSum[64 + w * 16 + fr] = H; }
        __syncthreads();
        if (chunk + 2 < 32) {
            const u32x4* xp = (const u32x4*)(xbase + (size_t)(tc + 128 + lt) * ZW); xm0 = xp[0]; xm1 = xp[1];
            if (tid < 12) { const u32x4* hp = (const u32x4*)(xbase + (size_t)(tc + 125 + lt) * ZW); xh0 = hp[0]; xh1 = hp[1]; }
        }
        float cin = carry, mycin = 0.f;
#pragma unroll
        for (int ww = 0; ww < 4; ++ww) {
            if (ww == w) mycin = cin;
            cin = sSum[ww * 16 + fr] * cin + sSum[64 + ww * 16 + fr];
        }
        carry = cin;
        const float sq = Ae * mycin + He;
#pragma unroll
        for (int j = 0; j < 4; ++j) {
            const float hfin = hl[j] + pc[j] * sq;
            const size_t grow = (size_t)(b * S + tc + 16 * w + 4 * fq + j);
            bf16_t* op = dry ? ((bf16_t*)(P.ws + W_YX) + grow * 1024 + n * 64 + 16 * ct + fr) : (ZA + grow * ZW + C_GR + n * 64 + 16 * ct + fr);
            *op = f2bf(gelu_t(bf2f(gv[j])) * hfin);
        }
    }
}

constexpr float EXPC = 0.125f * 1.4426950408889634f;
struct AttnAcc { f32x4 o[4][2]; float m[2], l[2]; };
DEV void attn_init(AttnAcc& a) {
#pragma unroll
    for (int d = 0; d < 4; ++d)
#pragma unroll
        for (int q = 0; q < 2; ++q) a.o[d][q] = (f32x4){0.f, 0.f, 0.f, 0.f};
    a.m[0] = a.m[1] = -INFINITY; a.l[0] = a.l[1] = 0.f;
}
DEV bf16x8 mk8(unsigned a, unsigned b, unsigned c, unsigned d) { u32x4 u = {a, b, c, d}; return __builtin_bit_cast(bf16x8, u); }

template <class MF>
DEV void attn_step(const bf16_t* sK, const bf16_t* sVt, int vstride, const bf16x8 (&qf)[2][2], AttnAcc& st, const MF& mf, int fr, int fq) {
    f32x4 s[4][2];
#pragma unroll
    for (int kt = 0; kt < 4; ++kt) {
        s[kt][0] = (f32x4){0.f, 0.f, 0.f, 0.f}; s[kt][1] = (f32x4){0.f, 0.f, 0.f, 0.f};
#pragma unroll
        for (int ks = 0; ks < 2; ++ks) {
            const bf16x8 kf = *(const bf16x8*)(sK + (16 * kt + fr) * 72 + 32 * ks + 8 * fq);
            s[kt][0] = MFMA16(kf, qf[0][ks], s[kt][0]);
            s[kt][1] = MFMA16(kf, qf[1][ks], s[kt][1]);
        }
    }
#pragma unroll
    for (int qt = 0; qt < 2; ++qt) {
        float mx = -INFINITY;
#pragma unroll
        for (int kt = 0; kt < 4; ++kt)
#pragma unroll
            for (int j = 0; j < 4; ++j) {
                const float v = mf(qt, 16 * kt + 4 * fq + j) ? s[kt][qt][j] : -INFINITY;
                s[kt][qt][j] = v; mx = fmaxf(mx, v);
            }
        mx = fmaxf(mx, __shfl_xor(mx, 16)); mx = fmaxf(mx, __shfl_xor(mx, 32));
        const float mn = fmaxf(st.m[qt], mx);
        float alpha = 1.f, msub = 0.f;
        if (mn != -INFINITY) { alpha = __builtin_amdgcn_exp2f((st.m[qt] - mn) * EXPC); msub = mn; }
        st.m[qt] = mn;
        float ps = 0.f;
#pragma unroll
        for (int kt = 0; kt < 4; ++kt)
#pragma unroll
            for (int j = 0; j < 4; ++j) { const float p = __builtin_amdgcn_exp2f((s[kt][qt][j] - msub) * EXPC); s[kt][qt][j] = p; ps += p; }
        st.l[qt] = st.l[qt] * alpha + ps;
#pragma unroll
        for (int dt = 0; dt < 4; ++dt) st.o[dt][qt] *= alpha;
    }
#pragma unroll
    for (int ks = 0; ks < 2; ++ks) {
        bf16x8 pf[2];
#pragma unroll
        for (int qt = 0; qt < 2; ++qt)
            pf[qt] = mk8(pk2(s[2 * ks][qt][0], s[2 * ks][qt][1]), pk2(s[2 * ks][qt][2], s[2 * ks][qt][3]),
                         pk2(s[2 * ks + 1][qt][0], s[2 * ks + 1][qt][1]), pk2(s[2 * ks + 1][qt][2], s[2 * ks + 1][qt][3]));
#pragma unroll
        for (int dt = 0; dt < 4; ++dt) {
            const u32x2 v0 = *(const u32x2*)(sVt + (16 * dt + fr) * vstride + 32 * ks + 4 * fq);
            const u32x2 v1 = *(const u32x2*)(sVt + (16 * dt + fr) * vstride + 32 * ks + 16 + 4 * fq);
            const bf16x8 vf = mk8(v0.x, v0.y, v1.x, v1.y);
            st.o[dt][0] = MFMA16(vf, pf[0], st.o[dt][0]);
            st.o[dt][1] = MFMA16(vf, pf[1], st.o[dt][1]);
        }
    }
}
DEV void attn_step_fast(const bf16_t* sK, const bf16_t* sVt, const bf16x8 (&qf)[2][2], AttnAcc& st, const float (&bitoff)[2], int fr, int fq) {
    f32x4 s[4][2];
#pragma unroll
    for (int kt = 0; kt < 4; ++kt) {
        s[kt][0] = (f32x4){0.f, 0.f, 0.f, 0.f}; s[kt][1] = (f32x4){0.f, 0.f, 0.f, 0.f};
#pragma unroll
        for (int ks = 0; ks < 2; ++ks) {
            const bf16x8 kf = *(const bf16x8*)(sK + (16 * kt + fr) * 72 + 32 * ks + 8 * fq);
            s[kt][0] = MFMA16(kf, qf[0][ks], s[kt][0]);
            s[kt][1] = MFMA16(kf, qf[1][ks], s[kt][1]);
        }
    }
#pragma unroll
    for (int qt = 0; qt < 2; ++qt) {
        float mx = fmaxf(fmaxf(s[0][qt][0], s[0][qt][1]), fmaxf(s[0][qt][2], s[0][qt][3]));
#pragma unroll
        for (int kt = 1; kt < 4; ++kt) mx = fmaxf(mx, fmaxf(fmaxf(s[kt][qt][0], s[kt][qt][1]), fmaxf(s[kt][qt][2], s[kt][qt][3])));
        mx = fmaxf(mx, __shfl_xor(mx, 16)); mx = fmaxf(mx, __shfl_xor(mx, 32));
        const float mn = fmaxf(st.m[qt], mx);
        const float alpha = __builtin_amdgcn_exp2f((st.m[qt] - mn) * EXPC);
        st.m[qt] = mn;
        const float off = bitoff[qt] - mn * EXPC;
        float ps = 0.f;
#pragma unroll
        for (int kt = 0; kt < 4; ++kt)
#pragma unroll
            for (int j = 0; j < 4; ++j) { const float p = __builtin_amdgcn_exp2f(fmaf(s[kt][qt][j], EXPC, off)); s[kt][qt][j] = p; ps += p; }
        st.l[qt] = st.l[qt] * alpha + ps;
#pragma unroll
        for (int dt = 0; dt < 4; ++dt) st.o[dt][qt] *= alpha;
    }
#pragma unroll
    for (int ks = 0; ks < 2; ++ks) {
        bf16x8 pf[2];
#pragma unroll
        for (int qt = 0; qt < 2; ++qt)
            pf[qt] = mk8(pk2(s[2 * ks][qt][0], s[2 * ks][qt][1]), pk2(s[2 * ks][qt][2], s[2 * ks][qt][3]),
                         pk2(s[2 * ks + 1][qt][0], s[2 * ks + 1][qt][1]), pk2(s[2 * ks + 1][qt][2], s[2 * ks + 1][qt][3]));
#pragma unroll
        for (int dt = 0; dt < 4; ++dt) {
            const u32x2 v0 = *(const u32x2*)(sVt + (16 * dt + fr) * 72 + 32 * ks + 4 * fq);
            const u32x2 v1 = *(const u32x2*)(sVt + (16 * dt + fr) * 72 + 32 * ks + 16 + 4 * fq);
            const bf16x8 vf = mk8(v0.x, v0.y, v1.x, v1.y);
            st.o[dt][0] = MFMA16(vf, pf[0], st.o[dt][0]);
            st.o[dt][1] = MFMA16(vf, pf[1], st.o[dt][1]);
        }
    }
}
DEV void attn_fold_out(bf16_t* const (&op)[2], const AttnAcc& st, const float (&gate)[2]) {
#pragma unroll
    for (int qt = 0; qt < 2; ++qt) {
        float l = st.l[qt];
        l += __shfl_xor(l, 16); l += __shfl_xor(l, 32);
        const float sc = gate[qt] * __builtin_amdgcn_rcpf(fmaxf(l, 1e-30f));
#pragma unroll
        for (int dt = 0; dt < 4; ++dt) {
            const uint2 pv = *(const uint2*)(op[qt] + 16 * dt);
            f32x4 r = st.o[dt][qt] * sc;
            r[0] += lo_f(pv.x); r[1] += hi_f(pv.x); r[2] += lo_f(pv.y); r[3] += hi_f(pv.y);
            *(uint2*)(op[qt] + 16 * dt) = make_uint2(pk2(r[0], r[1]), pk2(r[2], r[3]));
        }
    }
}
DEV void attn_fold(f32x4 (&tot)[4][2], const AttnAcc& st, const float (&gate)[2]) {
#pragma unroll
    for (int qt = 0; qt < 2; ++qt) {
        float l = st.l[qt];
        l += __shfl_xor(l, 16); l += __shfl_xor(l, 32);
        const float sc = gate[qt] * __builtin_amdgcn_rcpf(fmaxf(l, 1e-30f));
#pragma unroll
        for (int dt = 0; dt < 4; ++dt) tot[dt][qt] += st.o[dt][qt] * sc;
    }
}
DEV void ld64(u32x4 (&r)[2], const bf16_t* src, size_t sstride, int tid) {
#pragma unroll
    for (int i = 0; i < 2; ++i) { const int c = tid + 256 * i; r[i] = *(const u32x4*)(src + (size_t)(c >> 3) * sstride + (c & 7) * 8); }
}
DEV void st64(bf16_t* dst, const u32x4 (&r)[2], int tid) {
#pragma unroll
    for (int i = 0; i < 2; ++i) { const int c = tid + 256 * i; *(u32x4*)(dst + (c >> 3) * 72 + (c & 7) * 8) = r[i]; }
}

#define OUTP(QT) ((dry ? (bf16_t*)(P.ws + W_YX) + (size_t)(b * S + tq[QT]) * 1024 : ZA + (size_t)(b * S + tq[QT]) * ZW + C_Q) + head * 64 + 4 * fq)
#define LOAD_GATE(G2, BR) float G2[2]; { G2[0] = bf2f(ZA[(size_t)(b * S + tq[0]) * ZW + C_G + head * 3 + (BR)]); G2[1] = bf2f(ZA[(size_t)(b * S + tq[1]) * ZW + C_G + head * 3 + (BR)]); }
struct MaskAll { DEV bool operator()(int, int) const { return true; } };
struct MaskSel { unsigned bit[2]; int t[2]; int k0; DEV bool operator()(int qt, int kk) const { return bit[qt] && (k0 + kk <= t[qt]); } };
struct MaskWin { int t[2]; int k0; DEV bool operator()(int qt, int kk) const { const int k = k0 + kk; return k <= t[qt] && k > t[qt] - 512; } };

DEV void xattn_job(const Params& P, int job, char* smem, bool dry) {
    char* aux = (char*)P.out;
    bf16_t* ZA = (bf16_t*)(P.ws + W_ZA);
    const int qb = job & 15, h = (job >> 4) & 3, b = job >> 6;
    bf16_t* sK = (bf16_t*)smem;
    bf16_t* sVt = sK + 64 * 72;
    const int tid = opaque_tid(), w = tid >> 6, lane = tid & 63, fr = lane & 15, fq = lane >> 4;
    const int t0 = qb * 128 + w * 32;
    bf16x8 qf[2][2];
#pragma unroll
    for (int qt = 0; qt < 2; ++qt)
#pragma unroll
        for (int ks = 0; ks < 2; ++ks) qf[qt][ks] = *(const bf16x8*)(ZA + (size_t)(b * S + t0 + 16 * qt + fr) * ZW + C_QX + h * 64 + 32 * ks + 8 * fq);
    const bf16_t* MK = (const bf16_t*)(aux + O_MEMK) + (size_t)(b * 4 + h) * 256 * 64;
    const bf16_t* MVT = (const bf16_t*)(aux + O_MEMVT) + (size_t)(b * 4 + h) * 64 * 256;
    AttnAcc st; attn_init(st);
    u32x4 rk[2], rv[2];
    ld64(rk, MK, 64, tid); ld64(rv, MVT, 256, tid);
#pragma unroll 1
    for (int jb = 0; jb < 4; ++jb) {
        __syncthreads();
        st64(sK, rk, tid); st64(sVt, rv, tid);
        __syncthreads();
        if (jb + 1 < 4) { ld64(rk, MK + (size_t)(jb + 1) * 64 * 64, 64, tid); ld64(rv, MVT + (jb + 1) * 64, 256, tid); }
        __builtin_amdgcn_sched_barrier(0);
        { const float z2[2] = {0.f, 0.f}; attn_step_fast(sK, sVt, qf, st, z2, fr, fq); }
    }
    f32x4 tot[4][2];
#pragma unroll
    for (int dt = 0; dt < 4; ++dt) { tot[dt][0] = (f32x4){0.f, 0.f, 0.f, 0.f}; tot[dt][1] = (f32x4){0.f, 0.f, 0.f, 0.f}; }
    const float one[2] = {1.f, 1.f};
    attn_fold(tot, st, one);
#pragma unroll
    for (int qt = 0; qt < 2; ++qt)
#pragma unroll
        for (int dt = 0; dt < 4; ++dt)
            *(uint2*)((dry ? (bf16_t*)(P.ws + W_Y) + (size_t)(b * S + t0 + 16 * qt + fr) * 1024 : ZA + (size_t)(b * S + t0 + 16 * qt + fr) * ZW + C_QX) + h * 64 + 16 * dt + 4 * fq) =
                make_uint2(pk2(tot[dt][qt][0], tot[dt][qt][1]), pk2(tot[dt][qt][2], tot[dt][qt][3]));
}

DEV void nsa_job(const Params& P, int job, char* smem, bool dry) {
    char* aux = (char*)P.out;
    bf16_t* ZA = (bf16_t*)(P.ws + W_ZA);
    const int bg = job & 31, qb = 63 - (job >> 5), b = bg >> 2, g = bg & 3, t0 = qb * 32;
    bf16_t* sK = (bf16_t*)smem;
    bf16_t* sVt = (bf16_t*)(smem + 18432);
    float* sImp = (float*)(smem + 18432 + 17408);
    unsigned* sSel = (unsigned*)(smem + 18432 + 17408 + 16384);
    const int tid = opaque_tid(), w = tid >> 6, lane = tid & 63, fr = lane & 15, fq = lane >> 4;
    const int head = g * 4 + w;
    int tq[2];
    bf16x8 qf[2][2];
#pragma unroll
    for (int qt = 0; qt < 2; ++qt) {
        tq[qt] = t0 + 16 * qt + fr;
        const bf16_t* rowp = ZA + (size_t)(b * S + tq[qt]) * ZW;
#pragma unroll
        for (int ks = 0; ks < 2; ++ks) qf[qt][ks] = *(const bf16x8*)(rowp + C_Q + head * 64 + 32 * ks + 8 * fq);
    }
    f32x4 tot[4][2];
#pragma unroll
    for (int dt = 0; dt < 4; ++dt) { tot[dt][0] = (f32x4){0.f, 0.f, 0.f, 0.f}; tot[dt][1] = (f32x4){0.f, 0.f, 0.f, 0.f}; }

    {
        const bf16_t* KC = (const bf16_t*)(aux + O_KC) + (size_t)bg * 128 * 64;
        const bf16_t* VCT = (const bf16_t*)(aux + O_VCT) + (size_t)bg * 64 * 128;
        __syncthreads();
#pragma unroll
        for (int i = 0; i < 4; ++i) {
            const int c = tid + 256 * i;
            { const int r = c >> 3, k = (c & 7) * 8; *(u32x4*)(sK + r * 72 + k) = *(const u32x4*)(KC + r * 64 + k); }
            { const int r = c >> 4, k = (c & 15) * 8; *(u32x4*)(sVt + r * 136 + k) = *(const u32x4*)(VCT + r * 128 + k); }
        }
        __syncthreads();
#pragma unroll
        for (int qt = 0; qt < 2; ++qt) {
            const float g0 = bf2f(ZA[(size_t)(b * S + tq[qt]) * ZW + C_G + head * 3 + 0]);
            f32x4 s[8];
#pragma unroll
            for (int kt = 0; kt < 8; ++kt) {
                s[kt] = (f32x4){0.f, 0.f, 0.f, 0.f};
#pragma unroll
                for (int ks = 0; ks < 2; ++ks) {
                    const bf16x8 kf = *(const bf16x8*)(sK + (16 * kt + fr) * 72 + 32 * ks + 8 * fq);
                    s[kt] = MFMA16(kf, qf[qt][ks], s[kt]);
                }
            }
            float mx = -INFINITY;
#pragma unroll
            for (int kt = 0; kt < 8; ++kt)
#pragma unroll
                for (int j = 0; j < 4; ++j) {
                    const int n = 16 * kt + 4 * fq + j;
                    const float v = (n < NCMP && 16 * n + 31 <= tq[qt]) ? s[kt][j] : -INFINITY;
                    s[kt][j] = v; mx = fmaxf(mx, v);
                }
            mx = fmaxf(mx, __shfl_xor(mx, 16)); mx = fmaxf(mx, __shfl_xor(mx, 32));
            const float msub = (mx == -INFINITY) ? 0.f : mx;
            float ps = 0.f;
#pragma unroll
            for (int kt = 0; kt < 8; ++kt)
#pragma unroll
                for (int j = 0; j < 4; ++j) { const float p = __builtin_amdgcn_exp2f((s[kt][j] - msub) * EXPC); s[kt][j] = p; ps += p; }
            ps += __shfl_xor(ps, 16); ps += __shfl_xor(ps, 32);
            const float inv = __builtin_amdgcn_rcpf(fmaxf(ps, 1e-30f));
            float bprev = 0.f;
#pragma unroll
            for (int kt = 0; kt < 8; ++kt) {
                s[kt] *= inv;
                const float a = s[kt][0] + s[kt][1] + s[kt][2] + 0.5f * s[kt][3];
                const float bq = 0.5f * s[kt][3];
                const float x = __shfl(bq, (lane + 48) & 63);
                const float y = __shfl(bprev, (lane + 48) & 63);
                sImp[(w * 32 + 16 * qt + fr) * 32 + 4 * kt + fq] = a + (fq > 0 ? x : y);
                bprev = bq;
            }
#pragma unroll
            for (int ks = 0; ks < 4; ++ks) {
                const f32x4 pa = s[2 * ks] * g0, pb = s[2 * ks + 1] * g0;
                const bf16x8 pf = mk8(pk2(pa[0], pa[1]), pk2(pa[2], pa[3]), pk2(pb[0], pb[1]), pk2(pb[2], pb[3]));
#pragma unroll
                for (int dt = 0; dt < 4; ++dt) {
                    const u32x2 v0 = *(const u32x2*)(sVt + (16 * dt + fr) * 136 + 32 * ks + 4 * fq);
                    const u32x2 v1 = *(const u32x2*)(sVt + (16 * dt + fr) * 136 + 32 * ks + 16 + 4 * fq);
                    tot[dt][qt] = MFMA16(mk8(v0.x, v0.y, v1.x, v1.y), pf, tot[dt][qt]);
                }
            }
            __builtin_amdgcn_sched_barrier(0);
        }
    }
#pragma unroll
    for (int qt = 0; qt < 2; ++qt) {
        bf16_t* op = (dry ? (bf16_t*)(P.ws + W_YX) + (size_t)(b * S + tq[qt]) * 1024 : ZA + (size_t)(b * S + tq[qt]) * ZW + C_Q) + head * 64 + 4 * fq;
#pragma unroll
        for (int dt = 0; dt < 4; ++dt) *(uint2*)(op + 16 * dt) = pk4(tot[dt][qt]);
    }
    __syncthreads();
    {
        float myv[4];
#pragma unroll
        for (int i = 0; i < 4; ++i) {
            const int pidx = tid + 256 * i, q = pidx >> 5, m = pidx & 31;
            const int t = t0 + q, cur = t >> 6;
            const float sum = ((sImp[(0 * 32 + q) * 32 + m] + sImp[(1 * 32 + q) * 32 + m]) + sImp[(2 * 32 + q) * 32 + m]) + sImp[(3 * 32 + q) * 32 + m];
            const bool forced = (m == 0) || (m == cur) || (m == cur - 1);
            const bool future = m * 64 > t;
            myv[i] = forced ? INFINITY : (future ? -INFINITY : sum);
        }
        if (tid == 0) sSel[32] = 0u;
        __syncthreads();
#pragma unroll
        for (int i = 0; i < 4; ++i) { const int pidx = tid + 256 * i; sImp[pidx] = myv[i]; }
        __syncthreads();
        unsigned wun = 0u;
#pragma unroll
        for (int i = 0; i < 4; ++i) {
            const int pidx = tid + 256 * i, q = pidx >> 5, m = pidx & 31;
            const float v = myv[i];
            int rank = 0;
#pragma unroll
            for (int m2 = 0; m2 < 32; ++m2) {
                const float o = sImp[q * 32 + m2];
                rank += (o > v || (o == v && m2 < m)) ? 1 : 0;
            }
            const bool selb = (rank < 8) && (v > -INFINITY);
            const unsigned long long bal = __ballot(selb);
            const unsigned mk = (unsigned)(bal >> (32 * (lane >> 5)));
            if ((lane & 31) == 0) sSel[q] = mk;
            wun |= (unsigned)bal | (unsigned)(bal >> 32);
        }
        if (lane == 0) atomicOr(&sSel[32], wun);
    }
    __syncthreads();
    __shared__ unsigned s_xuni[2];
    if (tid == 0) s_xuni[threadIdx.x >> 8] = sSel[32];
    __syncthreads();
    const unsigned uni = s_xuni[0] | s_xuni[1];
    const int jmax = (t0 + 31) >> 6;
    {
        AttnAcc st; attn_init(st);
        const bf16_t* Kb = ZA + (size_t)(b * S) * ZW + C_KS + g * 64;
        const bf16_t* Vb = (const bf16_t*)(P.ws + W_VST) + (size_t)bg * 64 * S;
        unsigned rem = uni & ((2u << jmax) - 1u);
        u32x4 rk[2], rv[2];
        if (rem) { const int j0 = __builtin_ctz(rem); ld64(rk, Kb + (size_t)(j0 * 64) * ZW, ZW, tid); ld64(rv, Vb + j0 * 64, S, tid); }
#pragma unroll 1
        while (rem) {
            const int jb = __builtin_ctz(rem);
            rem &= rem - 1u;
            __syncthreads();
            st64(sK, rk, tid); st64(sVt, rv, tid);
            __syncthreads();
            if (rem) { const int jn = __builtin_ctz(rem); ld64(rk, Kb + (size_t)(jn * 64) * ZW, ZW, tid); ld64(rv, Vb + jn * 64, S, tid); }
            __builtin_amdgcn_sched_barrier(0);
            if (jb * 64 + 63 <= t0) {
                const float bo[2] = {((sSel[fr] >> jb) & 1u) ? 0.f : -INFINITY, ((sSel[16 + fr] >> jb) & 1u) ? 0.f : -INFINITY};
                attn_step_fast(sK, sVt, qf, st, bo, fr, fq);
            } else {
                MaskSel mf; mf.bit[0] = (sSel[fr] >> jb) & 1u; mf.bit[1] = (sSel[16 + fr] >> jb) & 1u; mf.t[0] = tq[0]; mf.t[1] = tq[1]; mf.k0 = jb * 64;
                attn_step(sK, sVt, 72, qf, st, mf, fr, fq);
            }
        }
        { LOAD_GATE(g1, 1) bf16_t* const op2[2] = {OUTP(0), OUTP(1)}; attn_fold_out(op2, st, g1); }
    }
    {
        AttnAcc st; attn_init(st);
        const bf16_t* Kb = ZA + (size_t)(b * S) * ZW + C_KW + g * 64;
        const bf16_t* Vb = (const bf16_t*)(P.ws + W_VWT) + (size_t)bg * 64 * S;
#pragma unroll
        for (int qt = 0; qt < 2; ++qt) {
            const int npad = 511 - tq[qt];
            if (npad > 0) { st.m[qt] = 0.f; st.l[qt] = (fq == 0) ? (float)npad : 0.f; }
        }
        int jlo = t0 - 511; jlo = jlo < 0 ? 0 : (jlo >> 6);
        u32x4 rk[2], rv[2];
        ld64(rk, Kb + (size_t)(jlo * 64) * ZW, ZW, tid); ld64(rv, Vb + jlo * 64, S, tid);
#pragma unroll 1
        for (int jb = jlo; jb <= jmax; ++jb) {
            __syncthreads();
            st64(sK, rk, tid); st64(sVt, rv, tid);
            __syncthreads();
            if (jb < jmax) { ld64(rk, Kb + (size_t)((jb + 1) * 64) * ZW, ZW, tid); ld64(rv, Vb + (jb + 1) * 64, S, tid); }
            __builtin_amdgcn_sched_barrier(0);
            if (jb * 64 + 63 <= t0 && jb * 64 > t0 + 31 - 512) {
                const float z2[2] = {0.f, 0.f};
                attn_step_fast(sK, sVt, qf, st, z2, fr, fq);
            } else {
                MaskWin mf; mf.t[0] = tq[0]; mf.t[1] = tq[1]; mf.k0 = jb * 64;
                attn_step(sK, sVt, 72, qf, st, mf, fr, fq);
            }
        }
        { LOAD_GATE(g2, 2) bf16_t* const op2[2] = {OUTP(0), OUTP(1)}; attn_fold_out(op2, st, g2); }
    }
}


#define XB_TMO      128
#define XB_XCNT(j)  (256  + 64 * (j))
#define XB_XSUB(j)  (1280 + 64 * (j))
#define XB_XGEN(j)  (2304 + 64 * (j))
#define XB_TOP      3328
#define XB_TOPGEN   3392
#define XCD_BAR_WORDS 3456
#define XB_SPIN_CAP (1u << 18)
#define LAS __attribute__((address_space(3)))
DEV unsigned xb_ld(unsigned* p) { return __hip_atomic_load(p, __ATOMIC_RELAXED, __HIP_MEMORY_SCOPE_AGENT); }
DEV unsigned xb_add(unsigned* p, unsigned v) { return __hip_atomic_fetch_add(p, v, __ATOMIC_RELAXED, __HIP_MEMORY_SCOPE_AGENT); }
DEV unsigned xb_xcc_id() { return (unsigned)__builtin_amdgcn_s_getreg((3 << 11) | 20) & 0xFu; }
#define XB_SPIN(cond, bar) do { unsigned _sp = 0; while (cond) { __builtin_amdgcn_s_sleep(1); \
    if ((++_sp & 255u) == 0u) { if (xb_ld(&(bar)[XB_TMO])) break; if (_sp > XB_SPIN_CAP) { atomicAdd(&(bar)[XB_TMO], 1u); break; } } } } while (0)
struct XcdBarrier { unsigned* bar; unsigned x; volatile LAS unsigned* st; };
DEV XcdBarrier xcd_barrier_post(unsigned* bar, volatile LAS unsigned* st) {
    XcdBarrier b; b.bar = bar; b.x = xb_xcc_id(); b.st = st;
    if (threadIdx.x == 0) (void)xb_add(&bar[XB_XCNT(b.x)], 1u);
    return b;
}
DEV void xcd_barrier_complete(unsigned* bar, unsigned x, unsigned& nloc, unsigned& nx) {
    const unsigned G = gridDim.x * gridDim.y * gridDim.z;
    unsigned sum, cnt, mine, sp = 0u;
    for (;;) {
        sum = 0u; cnt = 0u; mine = 0u;
#pragma unroll
        for (unsigned j = 0; j < 16; ++j) { const unsigned c = xb_ld(&bar[XB_XCNT(j)]); sum += c; cnt += (c > 0u) ? 1u : 0u; mine = (j == x) ? c : mine; }
        if (sum == G) break;
        __builtin_amdgcn_s_sleep(1);
        if ((++sp & 255u) == 0u) { if (xb_ld(&bar[XB_TMO])) break; if (sp > XB_SPIN_CAP) { atomicAdd(&bar[XB_TMO], 1u); break; } }
    }
    nloc = mine > 0u ? mine : 1u; nx = cnt > 0u ? cnt : 1u;
}
DEV void xcd_barrier(const XcdBarrier& b) {
    asm volatile("s_waitcnt vmcnt(0)" ::: "memory");
    __syncthreads();
    if (threadIdx.x == 0) {
        unsigned* bar = b.bar;
        __builtin_amdgcn_s_waitcnt(0);
        unsigned nloc = b.st[0], nx = b.st[1];
        if (nloc == 0u) { xcd_barrier_complete(bar, b.x, nloc, nx); b.st[0] = nloc; b.st[1] = nx; }
        const unsigned old = xb_add(&bar[XB_XSUB(b.x)], 1u);
        const unsigned gen = old / nloc;
        if (old + 1u == (gen + 1u) * nloc) {
            __builtin_amdgcn_fence(__ATOMIC_RELEASE, "agent");
            asm volatile("s_waitcnt vmcnt(0)" ::: "memory");
            const unsigned og = xb_add(&bar[XB_TOP], 1u);
            const unsigned tg = og / nx;
            if (og + 1u == (tg + 1u) * nx) xb_add(&bar[XB_TOPGEN], 1u);
            else XB_SPIN(xb_ld(&bar[XB_TOPGEN]) == tg, bar);
            __builtin_amdgcn_fence(__ATOMIC_ACQUIRE, "agent");
            xb_add(&bar[XB_XGEN(b.x)], 1u);
            asm volatile("s_waitcnt vmcnt(0)" ::: "memory");
        } else {
            XB_SPIN(xb_ld(&bar[XB_XGEN(b.x)]) == gen, bar);
            __builtin_amdgcn_fence(__ATOMIC_ACQUIRE, "agent");
            asm volatile("s_waitcnt vmcnt(0)" ::: "memory");
        }
    }
    __syncthreads();
}
constexpr size_t W_BAR = 252 * MiB;

constexpr int HALF_SMEM = 56320;
constexpr int SMEM_BYTES = 131072;

extern __shared__ __attribute__((aligned(16))) char dyn_smem[];
#define RUN_PG8(EPI_T, EPI_OBJ, A_, LDA_, BT_, LDB_, M_, N_, K_) { pg8::Gemm g_; g_.A = (A_); g_.Bt = (BT_); g_.M = (M_); g_.N = (N_); g_.K = (K_); g_.lda = (LDA_); g_.ldb = (LDB_); \
        pg8::StaticOrder so_; so_.init((M_), (N_), (int)gridDim.x, (int)blockIdx.x); __syncthreads(); \
        pg8::gemm_phase<EPI_T, pg8::StaticOrder, true, true>((PG8_LAS unsigned char*)dyn_smem, g_, so_, (EPI_OBJ)); __syncthreads(); }

template <int PH, bool DRY = false>
DEV void run_phase(const Params& P, char* smem) {
    const int nb = gridDim.x, bid = blockIdx.x, sub = opaque_tid512() >> 8;
    char* hsm = smem + sub * HALF_SMEM;
    char* aux = (char*)P.out;
    char* ws = P.ws;
    bf16_t* ZA = (bf16_t*)(ws + W_ZA);
    if (PH == 0) {
        for (int pj = bid; pj < (5088 + 4096 + 512 + 64) / 2; pj += nb) {
            int j = 2 * pj + sub;
            if (j < 5088) {
                bool done = false;
#define TR(SRC, LD, DSTOFF, KK, NN, MAP, BLK)                                                                                  \
    if (!done) { const int nrt = (NN) / 64, nt = nrt * ((KK) / 64);                                                              \
        if (j < nt) { transpose_tile((SRC), (LD), (bf16_t*)(aux + (DSTOFF)), (KK), (j % nrt) * 64, (j / nrt) * 64, (MAP), hsm, (BLK) ? (NN) : 0); done = true; } else j -= nt; }
                TR(P.w_in, 7984, O_WTA, 1024, 5120, 1, 0)
                TR(P.w_in, 7984, O_WTB, 1024, 4096, 2, 0)
                TR(P.w_up, 4096, O_WTUP, 1024, 4096, 0, 0)
                TR(P.w_down, 1024, O_WTDN, 4096, 1024, 0, 0)
                TR(P.w_o, 1024, O_WTO, 1024, 1024, 0, 0)
                TR(P.w_xo, 1024, O_WTXO, 256, 1024, 0, 0)
                TR(P.w_mkv, 512, O_WTMKV, 1024, 512, 0, 0)
                TR(P.wk1, 256, O_WTCK1, 2048, 256, 0, 0)
                TR(P.wv1, 256, O_WTCV1, 2048, 256, 0, 0)
#undef TR
                if (!done) {
                    if (j < 16) transpose_tile(P.w_a + j * 4096, 64, (bf16_t*)(aux + O_WAT) + j * 4096, 64, 0, 0, 0, hsm);
                    else { j -= 16; transpose_tile(P.w_i + j * 4096, 64, (bf16_t*)(aux + O_WIT) + j * 4096, 64, 0, 0, 0, hsm); }
                }
                continue;
            }
            j -= 5088;
            if (j < 4096) { rownorm<false>(P.x, P.g_mix, (bf16_t*)(ws + W_U), nullptr, j * 4 + (opaque_tid() >> 6)); continue; }
            j -= 4096;
            if (j < 512) { rownorm<false>(P.mem, P.g_mem, (bf16_t*)(aux + O_MEMN), nullptr, j * 4 + (opaque_tid() >> 6)); continue; }
            j -= 512;
            rope_job((float*)(aux + O_ROPEC), (float*)(aux + O_ROPES), j);
        }
    } else if (PH == 1) {
        { PEpiMemKV ep; ep.MK = (bf16_t*)(aux + O_MEMK); ep.MVT = (bf16_t*)(aux + O_MEMVT);
          RUN_PG8(PEpiMemKV, ep, (const bf16_t*)(aux + O_MEMN), 1024, (const bf16_t*)(aux + O_WTMKV), 1024, 2048, 512, 1024) }
        { PEpiZA ep; ep.ZA = ZA; ep.VST = (bf16_t*)(ws + W_VST); ep.VWT = (bf16_t*)(ws + W_VWT); ep.ropec = (const float*)(aux + O_ROPEC); ep.ropes = (const float*)(aux + O_ROPES);
          RUN_PG8(PEpiZA, ep, (const bf16_t*)(ws + W_U), 1024, (const bf16_t*)(aux + O_WTA), 1024, 16384, 5120, 1024) }
    } else if (PH == 2) {
        for (int job = bid; job < 32 + 256 + 256; job += nb) {
            if (job < 32) {
                const int which = job >> 4, pm = job & 15;
                float* sPos = (float*)(smem + 73728);
                __syncthreads();
                if (threadIdx.x < 256) { const float* pg = which ? P.cpv : P.cpk; const int t8 = threadIdx.x * 8; *(float4*)(sPos + t8) = *(const float4*)(pg + t8); *(float4*)(sPos + t8 + 4) = *(const float4*)(pg + t8 + 4); }
                ALCmp al; al.ZA = ZA; al.spos = sPos; al.colbase = which ? C_VC : C_KC;
                EpiHid ep{(bf16_t*)(aux + (which ? O_HIDV : O_HIDK))};
                gemm_tile<8, 4, true>(al, (const bf16_t*)(aux + (which ? O_WTCV1 : O_WTCK1)), 2048, 64, 2048, pm, 0, ep, smem);
            } else if (job < 288) rnn_job(P, 2 * (job - 32) + sub, hsm, DRY);
            else xattn_job(P, 2 * (job - 288) + sub, hsm, DRY);
        }
    } else if (PH == 3) {
        for (int pj = bid; pj < 1016; pj += nb) cmp2_job(P, 2 * pj + sub);
    } else if (PH == 4) {
        for (int job = bid; job < 1024; job += nb) nsa_job(P, 2 * job + sub, hsm, DRY);
        if (!DRY) { PEpiBf<0> ep; ep.O = (bf16_t*)(ws + W_YX); ep.ldo = 1024;
          RUN_PG8(PEpiBf<0>, ep, ZA + C_QX, ZW, (const bf16_t*)(aux + O_WTXO), 256, 16384, 1024, 256) }
    } else if (PH == 5) {
        { PEpiMerge ep; ep.ZA = ZA; ep.YX = (const bf16_t*)(ws + W_YX); ep.Y = (bf16_t*)(ws + W_Y);
          RUN_PG8(PEpiMerge, ep, (const bf16_t*)(ws + W_U), 1024, (const bf16_t*)(aux + O_WTB), 1024, 16384, 4096, 1024) }
    } else if (PH == 6) {
        { PEpiRes ep; ep.R = P.x; ep.O = (float*)(ws + W_H);
          RUN_PG8(PEpiRes, ep, (const bf16_t*)(ws + W_Y), 1024, (const bf16_t*)(aux + O_WTO), 1024, 16384, 1024, 1024) }
    } else if (PH == 7) {
        for (int pj = bid; pj < 2048; pj += nb) rownorm<false>((const float*)(ws + W_H), P.g_mlp, (bf16_t*)(ws + W_VN), nullptr, (2 * pj + sub) * 4 + (opaque_tid() >> 6));
    } else if (PH == 8) {
        { PEpiBf<1> ep; ep.O = (bf16_t*)(ws + W_HID); ep.ldo = 4096;
          RUN_PG8(PEpiBf<1>, ep, (const bf16_t*)(ws + W_VN), 1024, (const bf16_t*)(aux + O_WTUP), 1024, 16384, 4096, 1024) }
    } else if (PH == 9) {
        { PEpiRes ep; ep.R = (const float*)(ws + W_H); ep.O = (float*)(ws + W_H);
          RUN_PG8(PEpiRes, ep, (const bf16_t*)(ws + W_HID), 4096, (const bf16_t*)(aux + O_WTDN), 4096, 16384, 1024, 4096) }
    } else if (PH == 10) {
        for (int pj = bid; pj < 2048; pj += nb) rownorm<true>((const float*)(ws + W_H), P.g_final, nullptr, P.out, (2 * pj + sub) * 4 + (opaque_tid() >> 6));
    }
}

__global__ void __launch_bounds__(512, 2) mega_kernel(Params P) {
    char* smem = dyn_smem;
    cg::grid_group grid = cg::this_grid();
    __shared__ uint4 xb_words;
    if (threadIdx.x == 0) xb_words = make_uint4(0u, 0u, 0u, 0u);
    __syncthreads();
    XcdBarrier xb = xcd_barrier_post((unsigned*)(P.ws + W_BAR), (volatile LAS unsigned*)&xb_words);
    if (P.ws == nullptr) grid.sync();
#ifndef REP
#define REP -1
#endif
#define GSYNC() xcd_barrier(xb)
#define PHASE(k) { if (REP == k && k != 9) { run_phase<k, true>(P, smem); GSYNC(); } run_phase<k>(P, smem); GSYNC(); }
    PHASE(0) PHASE(1) PHASE(2) PHASE(3) PHASE(4) PHASE(5) PHASE(6) PHASE(7) PHASE(8) PHASE(9)
    if (REP == 10) { run_phase<10>(P, smem); GSYNC(); }
    if (REP == 11) { GSYNC(); GSYNC(); GSYNC(); GSYNC(); GSYNC(); GSYNC(); GSYNC(); GSYNC(); GSYNC(); GSYNC(); }
    run_phase<10>(P, smem);
}

extern "C" void kernel_launch(void* const* d_in, const int* in_sizes, int n_in, void* d_out, int out_size, void* d_ws, size_t ws_size,
                              hipStream_t stream) {
    Params P{};
    const float** pp = (const float**)&P;
    for (int i = 0; i < 25; ++i) pp[i] = (const float*)d_in[i];
    P.out = (float*)d_out;
    P.ws = (char*)d_ws;
    static int grid_blocks = 0;
    if (!grid_blocks) {
        int dev = 0, cus = 0, per_cu = 0;
        hipGetDevice(&dev);
        hipDeviceGetAttribute(&cus, hipDeviceAttributeMultiprocessorCount, dev);
        hipFuncSetAttribute((const void*)mega_kernel, hipFuncAttributeMaxDynamicSharedMemorySize, SMEM_BYTES);
        hipOccupancyMaxActiveBlocksPerMultiprocessor(&per_cu, mega_kernel, 512, SMEM_BYTES);
        if (per_cu > 1) per_cu = 1;
        if (per_cu < 1) per_cu = 1;
        grid_blocks = cus * per_cu;
    }
    hipMemsetAsync((char*)d_ws + W_BAR, 0, XCD_BAR_WORDS * 4, stream);
    void* args[] = {&P};
    hipError_t e = hipLaunchCooperativeKernel((void*)mega_kernel, dim3(grid_blocks), dim3(512), args, SMEM_BYTES, stream);
    if (e != hipSuccess) fprintf(stderr, "cooperative launch failed: %s (grid %d)\n", hipGetErrorString(e), grid_blocks);
}
```

```cpp
#include <hip/hip_runtime.h>
#include <hip/hip_cooperative_groups.h>
#include <cstdint>
#include <cstdio>
namespace cg = cooperative_groups;

#ifndef MULTI
#define MULTI 0
#endif

typedef unsigned short bf16_t;
typedef short bf16x8 __attribute__((ext_vector_type(8)));
typedef float f32x4 __attribute__((ext_vector_type(4)));
typedef __bf16 bfv2 __attribute__((ext_vector_type(2)));
typedef float f32x2 __attribute__((ext_vector_type(2)));
typedef unsigned u32x4 __attribute__((ext_vector_type(4)));
typedef unsigned u32x2 __attribute__((ext_vector_type(2)));
#define DEV __device__ __forceinline__
DEV int opaque_tid() { int t = threadIdx.x & 255; asm volatile("" : "+v"(t)); return t; }
DEV int opaque_tid512() { int t = threadIdx.x; asm volatile("" : "+v"(t)); return t; }
#define MFMA16(a, b, c) __builtin_amdgcn_mfma_f32_16x16x32_bf16((a), (b), (c), 0, 0, 0)

constexpr int T = 16384, S = 2048;
constexpr int ZW = 4480;
constexpr int C_Q = 0, C_KC = 1024, C_VC = 1280, C_KS = 1536, C_KW = 1792, C_XR = 2048, C_GR = 3072, C_QX = 4096, C_G = 4352;
constexpr int NCMP = 127;
constexpr int NCROWS = 4064;

constexpr size_t O_WTA = 0;
constexpr size_t O_WTB = O_WTA + (size_t)5120 * 1024 * 2;
constexpr size_t O_WTUP = O_WTB + (size_t)4096 * 1024 * 2;
constexpr size_t O_WTDN = O_WTUP + (size_t)4096 * 1024 * 2;
constexpr size_t O_WTO = O_WTDN + (size_t)4096 * 1024 * 2;
constexpr size_t O_WTXO = O_WTO + (size_t)1024 * 1024 * 2;
constexpr size_t O_WTMKV = O_WTXO + (size_t)1024 * 256 * 2;
constexpr size_t O_WTCK1 = O_WTMKV + (size_t)512 * 1024 * 2;
constexpr size_t O_WTCV1 = O_WTCK1 + (size_t)256 * 2048 * 2;
constexpr size_t O_WAT = O_WTCV1 + (size_t)256 * 2048 * 2;
constexpr size_t O_WIT = O_WAT + (size_t)16 * 64 * 64 * 2;
constexpr size_t O_ROPEC = O_WIT + (size_t)16 * 64 * 64 * 2;
constexpr size_t O_ROPES = O_ROPEC + (size_t)2048 * 8 * 4;
constexpr size_t O_MEMN = O_ROPES + (size_t)2048 * 8 * 4;
constexpr size_t O_MEMK = O_MEMN + (size_t)2048 * 1024 * 2;
constexpr size_t O_MEMVT = O_MEMK + (size_t)2048 * 256 * 2;
constexpr size_t O_HIDK = O_MEMVT + (size_t)2048 * 256 * 2;
constexpr size_t O_HIDV = O_HIDK + (size_t)4096 * 256 * 2;
constexpr size_t O_KC = O_HIDV + (size_t)4096 * 256 * 2;
constexpr size_t O_VCT = O_KC + (size_t)32 * 128 * 64 * 2;
constexpr size_t O_AUX_END = O_VCT + (size_t)32 * 64 * 128 * 2;
static_assert(O_AUX_END <= (size_t)64 << 20, "aux overflow");
constexpr size_t MiB = (size_t)1 << 20;
constexpr size_t W_U = 0, W_ZA = 32 * MiB, W_VST = 172 * MiB, W_VWT = 180 * MiB, W_YX = 188 * MiB, W_Y = 220 * MiB;
constexpr size_t W_H = 32 * MiB, W_VN = 0, W_HID = 96 * MiB;

struct Params {
    const float *x, *mem, *g_mix, *w_in, *cpk, *cpv, *wk1, *wk2, *wv1, *wv2, *conv_w, *conv_b, *w_a, *b_a, *w_i, *b_i, *lam,
        *g_mem, *w_mkv, *w_xo, *w_o, *g_mlp, *w_up, *w_down, *g_final;
    float* out;
    char* ws;
};

DEV float bf2f(bf16_t h) { return __uint_as_float(((unsigned)h) << 16); }
DEV unsigned pk2(float lo, float hi) { f32x2 v = {lo, hi}; bfv2 b = __builtin_convertvector(v, bfv2); return __builtin_bit_cast(unsigned, b); }
DEV bf16_t f2bf(float f) { return (bf16_t)(pk2(f, 0.f) & 0xffffu); }
DEV float lo_f(unsigned u) { return __uint_as_float(u << 16); }
DEV float hi_f(unsigned u) { return __uint_as_float(u & 0xffff0000u); }
DEV float sigm(float x) { return __builtin_amdgcn_rcpf(1.f + __expf(-x)); }
DEV float gelu_t(float x) {
    float y = 0.7978845608028654f * (x + 0.044715f * x * x * x);
    float e = __expf(2.f * y);
    float th = 1.f - 2.f * __builtin_amdgcn_rcpf(1.f + e);
    return 0.5f * x * (1.f + th);
}
DEV float wave_sum(float v) {
#pragma unroll
    for (int o = 32; o >= 1; o >>= 1) v += __shfl_xor(v, o);
    return v;
}

DEV int map_col(int mapid, int r) {
    if (mapid == 0) return r;
    if (mapid == 1) {
        if (r < 1536) return r;
        if (r < 1792) return 1536 + (r - 1536);
        if (r < 2048) return 2048 + (r - 1792);
        if (r < 3072) return 2608 + (r - 2048);
        if (r < 4096) return 3632 + (r - 3072);
        if (r < 4352) return 4656 + (r - 4096);
        if (r < 4608) return 1792 + (r - 4352);
        if (r < 4864) return 2304 + (r - 4608);
        if (r < 4912) return 2560 + (r - 4864);
        return -1;
    }
    const int pn = r >> 8, rem = r & 255, bj = rem >> 7, wc = (rem >> 5) & 3, n = (rem >> 4) & 1, c16 = rem & 15, slot = 2 * bj + n;
    if (slot == 3) return -1;
    return 4912 + slot * 1024 + pn * 64 + wc * 16 + c16;
}

DEV void transpose_tile(const float* __restrict__ src, int ld, bf16_t* __restrict__ dst, int K, int r0, int k0, int mapid, char* smem, int nblk = 0) {
    float* sm = (float*)smem;
    const int tid = threadIdx.x & 255, lane = tid & 63, w = tid >> 6;
    __syncthreads();
    const int sc = map_col(mapid, r0 + lane);
#pragma unroll
    for (int i = 0; i < 16; ++i) {
        int kk = w + 4 * i;
        float v = sc >= 0 ? src[(size_t)(k0 + kk) * ld + sc] : 0.f;
        sm[kk * 65 + lane] = v;
    }
    __syncthreads();
    const int rr = tid >> 2, kq = (tid & 3) * 16;
    unsigned o[8];
#pragma unroll
    for (int e = 0; e < 8; ++e) o[e] = pk2(sm[(kq + 2 * e) * 65 + rr], sm[(kq + 2 * e + 1) * 65 + rr]);
    uint4* dp = nblk ? (uint4*)(dst + (size_t)(k0 >> 6) * nblk * 64 + (size_t)(r0 + rr) * 64 + kq) : (uint4*)(dst + (size_t)(r0 + rr) * K + k0 + kq);
    dp[0] = make_uint4(o[0], o[1], o[2], o[3]);
    dp[1] = make_uint4(o[4], o[5], o[6], o[7]);
}

template <bool OUTF32>
DEV void rownorm(const float* __restrict__ src, const float* __restrict__ g, bf16_t* dstb, float* dstf, int row, bool blk = false) {
    const int lane = opaque_tid() & 63;
    const float4* sp = (const float4*)(src + (size_t)row * 1024);
    float4 v[4];
    float ss = 0.f;
#pragma unroll
    for (int i = 0; i < 4; ++i) { v[i] = sp[lane + 64 * i]; ss += v[i].x * v[i].x + v[i].y * v[i].y + v[i].z * v[i].z + v[i].w * v[i].w; }
    ss = wave_sum(ss);
    const float r = rsqrtf(ss * (1.0f / 1024.0f) + 1e-6f);
#pragma unroll
    for (int i = 0; i < 4; ++i) {
        float4 gg = ((const float4*)g)[lane + 64 * i];
        float a = v[i].x * r * gg.x, b = v[i].y * r * gg.y, c = v[i].z * r * gg.z, d = v[i].w * r * gg.w;
        if (OUTF32) ((float4*)(dstf + (size_t)row * 1024))[lane + 64 * i] = make_float4(a, b, c, d);
        else if (blk) { const int col = 4 * (lane + 64 * i); *(uint2*)(dstb + (size_t)(col >> 6) * ((size_t)16384 * 64) + (size_t)row * 64 + (col & 63)) = make_uint2(pk2(a, b), pk2(c, d)); }
        else ((uint2*)(dstb + (size_t)row * 1024))[lane + 64 * i] = make_uint2(pk2(a, b), pk2(c, d));
    }
}

DEV void rope_job(float* ct, float* st, int job) {
    const int e = job * 256 + (threadIdx.x & 255);
    const int pos = e >> 3, i = e & 7;
    const double inv = exp(-(double)i * 0.125 * 13.122363377404328);
    const double ang = (double)pos * inv;
    const double kq = rint(ang * 0.6366197723675814);
    const double r = ang - kq * 1.5707963267948966;
    const double r2 = r * r;
    const double sn = r * (1.0 + r2 * (-1.0 / 6 + r2 * (1.0 / 120 + r2 * (-1.0 / 5040 + r2 * (1.0 / 362880 + r2 * (-1.0 / 39916800 + r2 * (1.0 / 6227020800.0)))))));
    const double cs = 1.0 + r2 * (-0.5 + r2 * (1.0 / 24 + r2 * (-1.0 / 720 + r2 * (1.0 / 40320 + r2 * (-1.0 / 3628800 + r2 * (1.0 / 479001600.0))))));
    const int q = ((int)kq) & 3;
    double s_, c_;
    if (q == 0) { s_ = sn; c_ = cs; } else if (q == 1) { s_ = cs; c_ = -sn; } else if (q == 2) { s_ = -sn; c_ = -cs; } else { s_ = -cs; c_ = sn; }
    ct[e] = (float)c_; st[e] = (float)s_;
}

struct ALPlain {
    const bf16_t* A; int lda; int ks;
    const char* base; unsigned off0;
    DEV void init(int row0, int lrow, int lk) { base = (const char*)(A + (size_t)row0 * lda); off0 = (unsigned)(lrow * lda + lk) * 2u; }
    DEV u32x4 load(int i, int k0) const { return *(const u32x4*)(base + (off0 + (unsigned)(i * 128 * lda) + (unsigned)(k0 >> 6) * (unsigned)(ks * 2))); }
    DEV u32x4 fix(int, const u32x4& v, int) const { return v; }
};
struct ALCmp {
    const bf16_t* ZA; const float* spos; int colbase;
    unsigned roff[4]; int lk_;
    DEV void init(int row0, int lrow, int lk) {
        lk_ = lk;
#pragma unroll
        for (int i = 0; i < 4; ++i) {
            const int row = row0 + lrow + 64 * i;
            const int bg = row / NCMP, n = row - bg * NCMP, b = bg >> 2, g = bg & 3;
            roff[i] = row < NCROWS ? (unsigned)(((b * S + 16 * n) * ZW + colbase + g * 64 + lk) * 2) : 0xffffffffu;
        }
    }
    DEV u32x4 load(int i, int k0) const {
        if (roff[i] == 0xffffffffu) return (u32x4){0u, 0u, 0u, 0u};
        return *(const u32x4*)((const char*)ZA + (roff[i] + (unsigned)((k0 >> 6) * ZW * 2)));
    }
    DEV u32x4 fix(int i, const u32x4& v, int k0) const {
        if (roff[i] == 0xffffffffu) return v;
        const float4 p0 = *(const float4*)(spos + k0 + lk_), p1 = *(const float4*)(spos + k0 + lk_ + 4);
        u32x4 o;
        o.x = pk2(lo_f(v.x) + p0.x, hi_f(v.x) + p0.y); o.y = pk2(lo_f(v.y) + p0.z, hi_f(v.y) + p0.w);
        o.z = pk2(lo_f(v.z) + p1.x, hi_f(v.z) + p1.y); o.w = pk2(lo_f(v.w) + p1.z, hi_f(v.w) + p1.w);
        return o;
    }
};

template <int TM, int TN, bool SWAP, class AL, class EP>
DEV void gemm_tile(AL al, const bf16_t* __restrict__ Bt, int ldb, int bks, int K, int pm, int pn, const EP& ep, char* smem) {
    constexpr int BM = TM * 32, BN = TN * 64, NA = BM / 64, NBB = (BN + 63) / 64;
    bf16_t* sA = (bf16_t*)smem;
    bf16_t* sB = sA + BM * 72;
    const int tid = opaque_tid512(), wid = tid >> 6, lane = tid & 63, wr = wid >> 2, wc = wid & 3, fr = lane & 15, fq = lane >> 4;
    f32x4 acc[TM][TN];
#pragma unroll
    for (int m = 0; m < TM; ++m)
#pragma unroll
        for (int n = 0; n < TN; ++n) acc[m][n] = (f32x4){0.f, 0.f, 0.f, 0.f};
    const int lrow = tid >> 3, lk = (tid & 7) * 8;
    u32x4 ra[NA], rb[NBB];
    al.init(pm * BM, lrow, lk);
    const char* bbase = (const char*)(Bt + (size_t)(pn * BN) * ldb);
    const unsigned boff = (unsigned)(lrow * ldb + lk) * 2u;
#pragma unroll
    for (int i = 0; i < NBB; ++i) rb[i] = (u32x4){0u, 0u, 0u, 0u};
#pragma unroll
    for (int i = 0; i < NA; ++i) ra[i] = al.load(i, 0);
#pragma unroll
    for (int i = 0; i < NBB; ++i) if (BN % 64 == 0 || lrow + 64 * i < BN) rb[i] = *(const u32x4*)(bbase + (boff + (unsigned)(i * 128 * ldb)));
    int nk = K >> 6;
    asm volatile("" : "+s"(nk));
    bf16_t* sWa = sA + lrow * 72 + lk;
    bf16_t* sWb = sB + lrow * 72 + lk;
    const bf16_t* sAr = sA + (wr * TM * 16 + fr) * 72 + fq * 8;
    const bf16_t* sBr = sB + (wc * TN * 16 + fr) * 72 + fq * 8;
#pragma unroll 1
    for (int kt = 0; kt < nk; ++kt) {
        __syncthreads();
#pragma unroll
        for (int i = 0; i < NA; ++i) *(u32x4*)(sWa + (64 * i) * 72) = al.fix(i, ra[i], kt * 64);
#pragma unroll
        for (int i = 0; i < NBB; ++i) if (BN % 64 == 0 || lrow + 64 * i < BN) *(u32x4*)(sWb + (64 * i) * 72) = rb[i];
        __syncthreads();
        if (kt + 1 < nk) {
            const int k0 = (kt + 1) * 64;
#pragma unroll
            for (int i = 0; i < NA; ++i) ra[i] = al.load(i, k0);
#pragma unroll
            for (int i = 0; i < NBB; ++i) if (BN % 64 == 0 || lrow + 64 * i < BN) rb[i] = *(const u32x4*)(bbase + (boff + (unsigned)(i * 128 * ldb) + (unsigned)(k0 >> 6) * (unsigned)(bks * 2)));
        }
        __builtin_amdgcn_sched_barrier(0);
        __builtin_amdgcn_s_setprio(1);
#pragma unroll
        for (int ks = 0; ks < 2; ++ks) {
            bf16x8 bfr[TN];
#pragma unroll
            for (int n = 0; n < TN; ++n) bfr[n] = *(const bf16x8*)(sBr + (n * 16) * 72 + ks * 32);
#pragma unroll
            for (int m = 0; m < TM; ++m) {
                const bf16x8 af = *(const bf16x8*)(sAr + (m * 16) * 72 + ks * 32);
#pragma unroll
                for (int n = 0; n < TN; ++n) acc[m][n] = SWAP ? MFMA16(bfr[n], af, acc[m][n]) : MFMA16(af, bfr[n], acc[m][n]);
            }
        }
        __builtin_amdgcn_s_setprio(0);
    }
    ep.run(acc, pm * BM + wr * TM * 16, pn * BN + wc * TN * 16, fr, fq);
}

DEV uint2 pk4(const f32x4& a) { return make_uint2(pk2(a[0], a[1]), pk2(a[2], a[3])); }

namespace pg8 {
#define PG8_LAS __attribute__((address_space(3)))
typedef unsigned short bf16_t;
typedef short bf16x8 __attribute__((ext_vector_type(8)));
typedef float f32x4 __attribute__((ext_vector_type(4)));
typedef unsigned u32x4 __attribute__((ext_vector_type(4)));
constexpr int BM = 256, BK = 64, HALF = 128, HTB = HALF * BK * 2  , STAGE_BYTES = 8 * HTB, NXCD = 8, WGM = 8;

__host__ __device__ __forceinline__ int lds_byte(int r, int c) { const int st = (r >> 4) * 2 + (c >> 5), rr = r & 15, cc = c & 31, ob = rr * 64 + cc * 2; return st * 1024 + (ob ^ (((ob >> 9) & 1) << 5)); }
__host__ __device__ __forceinline__ void stage_rc(int b, int& R, int& C) { const int st = b / 1024, sb = b % 1024, swz = sb ^ (((sb >> 9) & 1) << 5); R = (st >> 1) * 16 + swz / 64; C = (st & 1) * 32 + (swz % 64) / 2; }
__host__ __device__ __forceinline__ int perm32(int rho) { const int n = rho >> 4, i = rho & 15; return 8 * (i >> 2) + 4 * n + (i & 3); }

struct Unit { int pm, pn; };
struct Gemm { const bf16_t* A; const bf16_t* Bt; int M, N, K, lda, ldb; };

struct StaticOrder {
    int nM, nN, nwg, G, c;
    __host__ __device__ void init(int M, int N, int G_, int c_) { nM = M / BM; nN = N / BM; nwg = nM * nN; G = G_; c = c_; }
    __host__ __device__ bool next(int i, Unit& u) const {
        const long L = (long)i * G + c; if (L >= nwg) return false;
        int wgid = (int)L; { const int q = nwg / NXCD, r = nwg % NXCD, xcd = wgid % NXCD, off = wgid / NXCD; wgid = (xcd < r ? xcd * (q + 1) : r * (q + 1) + (xcd - r) * q) + off; }
        const int nig = WGM * nN, gid = wgid / nig, fm = gid * WGM, gsz = (nM - fm) < WGM ? (nM - fm) : WGM;
        u.pm = fm + ((wgid % nig) % gsz); u.pn = (wgid % nig) / gsz; return true;
    }
    __device__ __forceinline__ void a_ready(const Unit&) const {}
    __device__ __forceinline__ void done(const Unit&) const {}
};

template <class Epi, class Sched, bool ALIGN_EPI = false, bool SP2 = false>
__device__ __forceinline__ void gemm_phase(PG8_LAS unsigned char* lds, const Gemm g, const Sched& S, const Epi& E) {
    const int tid = opaque_tid512(), wid = __builtin_amdgcn_readfirstlane(tid >> 6), lane = tid & 63, wr = wid >> 2, wc = wid & 3, fr = lane & 15, fq = lane >> 4;
    const int K = g.K, nt = K / BK;
    unsigned voffA[2], voffB[2];
#pragma unroll
    for (int i = 0; i < 2; ++i) { int R, C; stage_rc(tid * 16 + i * 8192, R, C); const int Rb = Epi::PERM ? ((R & ~31) + perm32(R & 31)) : R;
        voffA[i] = (unsigned)(R * g.lda + C) * 2u; voffB[i] = (unsigned)(Rb * g.ldb + C) * 2u; }
    const size_t kstep = (size_t)(BK * 2);
    const size_t hstepA = (size_t)HALF * g.lda * 2, hstepB = (size_t)HALF * g.ldb * 2;
    const size_t tstepA = 2 * hstepA, tstepB = 2 * hstepB;
    const unsigned ldsw = (unsigned)wid * 1024u;
    const int aoff = lds_byte(wr * 64 + fr, fq * 8), boff = lds_byte(wc * 32 + fr, fq * 8);
#define PG8_SA(b, h) (((b) * 2 + (h)) * HTB)
#define PG8_SB(b, h) ((4 + (b) * 2 + (h)) * HTB)
#define PG8_STAGE(bufoff, gbase, voff) do { _Pragma("unroll") for (int _i = 0; _i < 2; ++_i) \
        __builtin_amdgcn_global_load_lds((const unsigned*)((const char*)(gbase) + (voff)[_i]), (PG8_LAS unsigned*)(lds + (bufoff) + ldsw + _i * 8192), 16, 0, 0); } while (0)
#define PG8_LDA(dst, b, h) do { _Pragma("unroll") for (int m = 0; m < 4; ++m) _Pragma("unroll") for (int k = 0; k < 2; ++k) dst[m][k] = *(const PG8_LAS bf16x8*)(lds + PG8_SA(b, h) + aoff + m * 2048 + k * 1024); } while (0)
#define PG8_LDB(dst, b, h) do { _Pragma("unroll") for (int n = 0; n < 2; ++n) _Pragma("unroll") for (int k = 0; k < 2; ++k) dst[n][k] = *(const PG8_LAS bf16x8*)(lds + PG8_SB(b, h) + boff + n * 2048 + k * 1024); } while (0)
#define PG8_MMA(ai, bj, At, Bt) do { __builtin_amdgcn_s_setprio(1); _Pragma("unroll") for (int m = 0; m < 4; ++m) _Pragma("unroll") for (int n = 0; n < 2; ++n) _Pragma("unroll") for (int k = 0; k < 2; ++k) \
        acc[ai][bj][m][n] = __builtin_amdgcn_mfma_f32_16x16x32_bf16(Bt[n][k], At[m][k], acc[ai][bj][m][n], 0, 0, 0); __builtin_amdgcn_s_setprio(0); } while (0)
#define PG8_WAIT_V(n) asm volatile("s_waitcnt vmcnt(" #n ")" ::: "memory")
#define PG8_WAIT_L(n) asm volatile("s_waitcnt lgkmcnt(" #n ")" ::: "memory")
#define PG8_BAR __builtin_amdgcn_s_barrier()
#define PG8_SCHED __builtin_amdgcn_sched_barrier(0)
    Unit cur, nxt; int ui = 0;
    if (!S.next(0, cur)) return;
    f32x4 acc[2][2][4][2];
#pragma unroll
    for (int a = 0; a < 2; ++a)
#pragma unroll
        for (int b = 0; b < 2; ++b)
#pragma unroll
            for (int m = 0; m < 4; ++m)
#pragma unroll
                for (int n = 0; n < 2; ++n) acc[a][b][m][n] = (f32x4){0.f, 0.f, 0.f, 0.f};
    bf16x8 At[4][2], B0[2][2], B1[2][2];
    const char* cA = (const char*)g.A + (size_t)cur.pm * tstepA; const char* cB = (const char*)g.Bt + (size_t)cur.pn * tstepB;
    S.a_ready(cur);
    if constexpr (SP2) {
        PG8_STAGE(PG8_SB(0, 0), cB, voffB); PG8_STAGE(PG8_SB(0, 1), cB + hstepB, voffB); PG8_STAGE(PG8_SA(0, 0), cA, voffA); PG8_STAGE(PG8_SA(0, 1), cA + hstepA, voffA);
        if (wr == 1) PG8_BAR;
        PG8_WAIT_V(2); PG8_BAR;
        PG8_STAGE(PG8_SB(1, 0), cB + kstep, voffB); PG8_STAGE(PG8_SA(1, 0), cA + kstep, voffA); PG8_STAGE(PG8_SB(1, 1), cB + hstepB + kstep, voffB);
        PG8_WAIT_V(6); PG8_BAR;
    } else {
        PG8_STAGE(PG8_SB(0, 0), cB, voffB); PG8_STAGE(PG8_SA(0, 0), cA, voffA); PG8_STAGE(PG8_SB(0, 1), cB + hstepB, voffB); PG8_STAGE(PG8_SA(0, 1), cA + hstepA, voffA);
        if (wr == 1) PG8_BAR;
        PG8_WAIT_V(4); PG8_BAR;
        PG8_STAGE(PG8_SB(1, 0), cB + kstep, voffB); PG8_STAGE(PG8_SA(1, 0), cA + kstep, voffA); PG8_STAGE(PG8_SB(1, 1), cB + hstepB + kstep, voffB);
        PG8_WAIT_V(6); PG8_BAR;
    }
    for (;;) {
        const bool has_next = S.next(ui + 1, nxt);
        const char* nA = has_next ? (const char*)g.A + (size_t)nxt.pm * tstepA : cA; const char* nB = has_next ? (const char*)g.Bt + (size_t)nxt.pn * tstepB : cB;
        for (int t = 0; t < nt; t += 2) {
            const bool last = (t == nt - 2);
            const char* a1 = cA + (size_t)(t + 1) * kstep;
            const char* a2 = last ? nA : cA + (size_t)(t + 2) * kstep; const char* b2 = last ? nB : cB + (size_t)(t + 2) * kstep;
            const char* a3 = a2 + kstep; const char* b3 = b2 + kstep;
            if (last && has_next) S.a_ready(nxt);
            if constexpr (SP2) {
            PG8_LDB(B0, 0, 0); PG8_LDB(B1, 0, 1); PG8_SCHED; PG8_LDA(At, 0, 0); PG8_STAGE(PG8_SA(1, 1), a1 + hstepA, voffA);
            PG8_WAIT_V(8); PG8_WAIT_L(0); PG8_BAR; PG8_MMA(0, 0, At, B0); PG8_MMA(0, 1, At, B1); PG8_BAR; PG8_SCHED;
            PG8_LDA(At, 0, 1); PG8_STAGE(PG8_SB(0, 0), b2, voffB); PG8_STAGE(PG8_SB(0, 1), b2 + hstepB, voffB); PG8_STAGE(PG8_SA(0, 0), a2, voffA);
            PG8_WAIT_V(8); PG8_WAIT_L(0); PG8_BAR; PG8_MMA(1, 0, At, B0); PG8_MMA(1, 1, At, B1); PG8_BAR; PG8_SCHED;
            PG8_LDB(B0, 1, 0); PG8_LDB(B1, 1, 1); PG8_SCHED; PG8_LDA(At, 1, 0); PG8_STAGE(PG8_SA(0, 1), a2 + hstepA, voffA);
            PG8_WAIT_V(8); PG8_WAIT_L(0); PG8_BAR; PG8_MMA(0, 0, At, B0); PG8_MMA(0, 1, At, B1); PG8_BAR; PG8_SCHED;
            PG8_LDA(At, 1, 1); PG8_STAGE(PG8_SB(1, 0), b3, voffB); PG8_STAGE(PG8_SB(1, 1), b3 + hstepB, voffB); PG8_STAGE(PG8_SA(1, 0), a3, voffA);
            PG8_WAIT_V(8); PG8_WAIT_L(0); PG8_BAR; PG8_MMA(1, 0, At, B0); PG8_MMA(1, 1, At, B1); PG8_BAR; PG8_SCHED;
            } else {
            PG8_LDB(B0, 0, 0); PG8_SCHED; PG8_LDA(At, 0, 0); PG8_STAGE(PG8_SA(1, 1), a1 + hstepA, voffA);
            PG8_WAIT_L(8); PG8_BAR; PG8_WAIT_L(0); PG8_MMA(0, 0, At, B0); PG8_BAR; PG8_SCHED;
            PG8_LDB(B1, 0, 1); PG8_STAGE(PG8_SB(0, 0), b2, voffB);
            PG8_BAR; PG8_WAIT_L(0); PG8_MMA(0, 1, At, B1); PG8_BAR;
            PG8_LDA(At, 0, 1); PG8_STAGE(PG8_SA(0, 0), a2, voffA);
            PG8_BAR; PG8_WAIT_L(0); PG8_MMA(1, 0, At, B0); PG8_BAR; PG8_SCHED;
            PG8_STAGE(PG8_SB(0, 1), b2 + hstepB, voffB);
            PG8_WAIT_V(6); PG8_BAR; PG8_MMA(1, 1, At, B1); PG8_BAR;
            PG8_LDB(B0, 1, 0); PG8_SCHED; PG8_LDA(At, 1, 0); PG8_STAGE(PG8_SA(0, 1), a2 + hstepA, voffA);
            PG8_WAIT_L(8); PG8_BAR; PG8_WAIT_L(0); PG8_MMA(0, 0, At, B0); PG8_BAR; PG8_SCHED;
            PG8_LDB(B1, 1, 1); PG8_STAGE(PG8_SB(1, 0), b3, voffB);
            PG8_BAR; PG8_WAIT_L(0); PG8_MMA(0, 1, At, B1); PG8_BAR;
            PG8_LDA(At, 1, 1); PG8_STAGE(PG8_SA(1, 0), a3, voffA);
            PG8_BAR; PG8_WAIT_L(0); PG8_MMA(1, 0, At, B0); PG8_BAR; PG8_SCHED;
            PG8_STAGE(PG8_SB(1, 1), b3 + hstepB, voffB);
            PG8_WAIT_V(6); PG8_BAR; PG8_MMA(1, 1, At, B1); PG8_BAR;
            }
        }
        if constexpr (ALIGN_EPI) { if (wr == 0) PG8_BAR; }
        if constexpr (!Epi::AFTER_DRAIN) { E(acc, cur, wr, wc, fr, fq); S.done(cur); }
        if (!has_next) break;
#pragma unroll
        for (int a = 0; a < 2; ++a)
#pragma unroll
            for (int b = 0; b < 2; ++b)
#pragma unroll
                for (int m = 0; m < 4; ++m)
#pragma unroll
                    for (int n = 0; n < 2; ++n) acc[a][b][m][n] = (f32x4){0.f, 0.f, 0.f, 0.f};
        cur = nxt; cA = nA; cB = nB; ++ui;
        if constexpr (ALIGN_EPI) { if (wr == 1) PG8_BAR; }
    }
    PG8_WAIT_V(0);
    if constexpr (!ALIGN_EPI) { if (wr == 0) PG8_BAR; }
    PG8_BAR;
    if constexpr (Epi::AFTER_DRAIN) { E.fused(acc, cur, wr, wc, fr, fq, lds, wid, lane); S.done(cur); }
#undef PG8_SA
#undef PG8_SB
#undef PG8_STAGE
#undef PG8_LDA
#undef PG8_LDB
#undef PG8_MMA
#undef PG8_WAIT_V
#undef PG8_WAIT_L
#undef PG8_BAR
#undef PG8_SCHED
}
}

struct EpiHid {
    bf16_t* H;
    DEV void run(f32x4 (&acc)[8][4], int R0, int C0, int fr, int fq) const {
#pragma unroll
        for (int n = 0; n < 4; ++n)
#pragma unroll
            for (int m = 0; m < 8; ++m) {
                const int c = C0 + n * 16 + 4 * fq, r = R0 + m * 16 + fr;
                f32x4 a = acc[m][n];
#pragma unroll
                for (int j = 0; j < 4; ++j) a[j] = gelu_t(a[j]);
                if (r < NCROWS) *(uint2*)(H + (size_t)r * 256 + c) = pk4(a);
            }
    }
};
#define PG8_EPI_HEAD static constexpr bool PERM = false, AFTER_DRAIN = false;
#define PG8_FOR_TILES _Pragma("unroll") for (int ai = 0; ai < 2; ++ai) _Pragma("unroll") for (int bj = 0; bj < 2; ++bj) _Pragma("unroll") for (int m = 0; m < 4; ++m) _Pragma("unroll") for (int n = 0; n < 2; ++n)
struct PEpiZA {
    PG8_EPI_HEAD
    bf16_t *ZA, *VST, *VWT; const float *ropec, *ropes;
    DEV void operator()(const f32x4 (&acc)[2][2][4][2], const pg8::Unit& u, int wr, int wc, int fr, int fq) const {
        asm volatile("" : "+v"(fr), "+v"(fq));
        PG8_FOR_TILES {
            const int row = u.pm * 256 + ai * 128 + wr * 64 + m * 16 + fr, col0 = u.pn * 256 + bj * 128 + wc * 32 + n * 16;
            f32x4 a = acc[ai][bj][m][n];
            if (u.pn == 17 || u.pn == 18) {
                bf16_t* dst = (u.pn == 17) ? VST : VWT;
                const int c = (col0 & 255) + 4 * fq, b = row >> 11, t = row & 2047;
#pragma unroll
                for (int j = 0; j < 4; ++j) { const int cc = c + j; dst[((size_t)((b * 4 + (cc >> 6)) * 64 + (cc & 63))) * S + t] = f2bf(a[j]); }
            } else {
                const bool rope = (col0 < 1024 || (col0 >= 1536 && col0 < 2048)) && ((col0 & 63) == 0);
                if (rope) {
                    const int t = row & 2047, i0 = 4 * (fq & 1);
                    const float4 cs = *(const float4*)(ropec + t * 8 + i0), sn = *(const float4*)(ropes + t * 8 + i0);
                    const float c4[4] = {cs.x, cs.y, cs.z, cs.w}, s4[4] = {sn.x, sn.y, sn.z, sn.w};
#pragma unroll
                    for (int j = 0; j < 4; ++j) {
                        const float pr = __shfl_xor(a[j], 32);
                        a[j] = (fq & 2) ? (a[j] * c4[j] + pr * s4[j]) : (a[j] * c4[j] - pr * s4[j]);
                    }
                }
                int zc0 = col0;
                if (col0 >= 4864) {
                    zc0 = col0 - 512;
#pragma unroll
                    for (int j = 0; j < 4; ++j) a[j] = sigm(a[j]);
                }
                if (zc0 < ZW) *(uint2*)(ZA + (size_t)row * ZW + zc0 + 4 * fq) = pk4(a);
            }
        }
    }
};
struct PEpiMemKV {
    PG8_EPI_HEAD
    bf16_t *MK, *MVT;
    DEV void operator()(const f32x4 (&acc)[2][2][4][2], const pg8::Unit& u, int wr, int wc, int fr, int fq) const {
        asm volatile("" : "+v"(fr), "+v"(fq));
        PG8_FOR_TILES {
            const int r = u.pm * 256 + ai * 128 + wr * 64 + m * 16 + fr, c = u.pn * 256 + bj * 128 + wc * 32 + n * 16 + 4 * fq;
            const int b = r >> 8, mm = r & 255;
            const f32x4 a = acc[ai][bj][m][n];
            if (u.pn == 0) { const int h = (c >> 6) & 3, d = c & 63; *(uint2*)(MK + ((size_t)(b * 4 + h) * 256 + mm) * 64 + d) = pk4(a); }
            else {
#pragma unroll
                for (int j = 0; j < 4; ++j) { const int cc = c + j, h = (cc >> 6) & 3, d = cc & 63; MVT[((size_t)(b * 4 + h) * 64 + d) * 256 + mm] = f2bf(a[j]); }
            }
        }
    }
};
template <int ACT>
struct PEpiBf {
    PG8_EPI_HEAD
    bf16_t* O; int ldo;
    DEV void operator()(const f32x4 (&acc)[2][2][4][2], const pg8::Unit& u, int wr, int wc, int fr, int fq) const {
        asm volatile("" : "+v"(fr), "+v"(fq));
        PG8_FOR_TILES {
            const int r = u.pm * 256 + ai * 128 + wr * 64 + m * 16 + fr, c = u.pn * 256 + bj * 128 + wc * 32 + n * 16 + 4 * fq;
            f32x4 a = acc[ai][bj][m][n];
            if (ACT == 1) {
#pragma unroll
                for (int j = 0; j < 4; ++j) { const float v = fmaxf(a[j], 0.f); a[j] = v * v; }
            }
            *(uint2*)(O + (size_t)r * ldo + c) = pk4(a);
        }
    }
};
struct PEpiRes {
    PG8_EPI_HEAD
    const float* R; float* O;
    DEV void operator()(const f32x4 (&acc)[2][2][4][2], const pg8::Unit& u, int wr, int wc, int fr, int fq) const {
        asm volatile("" : "+v"(fr), "+v"(fq));
        PG8_FOR_TILES {
            const size_t o = (size_t)(u.pm * 256 + ai * 128 + wr * 64 + m * 16 + fr) * 1024 + u.pn * 256 + bj * 128 + wc * 32 + n * 16 + 4 * fq;
            const f32x4 r = *(const f32x4*)(R + o);
            *(f32x4*)(O + o) = r + acc[ai][bj][m][n];
        }
    }
};
struct PEpiMerge {
    PG8_EPI_HEAD
    const bf16_t *ZA, *YX; bf16_t* Y;
    DEV void operator()(const f32x4 (&acc)[2][2][4][2], const pg8::Unit& u, int wr, int wc, int fr, int fq) const {
        asm volatile("" : "+v"(fr), "+v"(fq));
        const int ch = u.pn * 64 + wc * 16 + 4 * fq;
#pragma unroll
        for (int ai = 0; ai < 2; ++ai)
#pragma unroll
            for (int m = 0; m < 4; ++m) {
                const size_t row = (size_t)(u.pm * 256 + ai * 128 + wr * 64 + m * 16 + fr);
                const uint2 a = *(const uint2*)(ZA + row * ZW + C_Q + ch), b = *(const uint2*)(ZA + row * ZW + C_GR + ch), c = *(const uint2*)(YX + row * 1024 + ch);
                const f32x4 g0 = acc[ai][0][m][0], g1 = acc[ai][0][m][1], g2 = acc[ai][1][m][0];
                f32x4 y;
                y[0] = sigm(g0[0]) * lo_f(a.x) + sigm(g1[0]) * lo_f(b.x) + sigm(g2[0]) * lo_f(c.x);
                y[1] = sigm(g0[1]) * hi_f(a.x) + sigm(g1[1]) * hi_f(b.x) + sigm(g2[1]) * hi_f(c.x);
                y[2] = sigm(g0[2]) * lo_f(a.y) + sigm(g1[2]) * lo_f(b.y) + sigm(g2[2]) * lo_f(c.y);
                y[3] = sigm(g0[3]) * hi_f(a.y) + sigm(g1[3]) * hi_f(b.y) + sigm(g2[3]) * hi_f(c.y);
                *(uint2*)(Y + row * 1024 + ch) = pk4(y);
            }
    }
};

DEV bool tile_map(int idx, int NT, int& pm, int& pn) {
    const int x = idx & 7, pl = (idx >> 3) & 3, pmid = (idx >> 5) & 7, st = idx >> 8;
    pm = pmid * 8 + x;
    pn = st * 4 + pl;
    return pn < NT;
}
DEV int tile_count(int NT) { return ((NT + 3) / 4) * 256; }

DEV void cmp2_job(const Params& P, int job) {
    char* aux = (char*)P.out;
    const int lane = threadIdx.x & 63, w = (threadIdx.x & 255) >> 6;
    const int wj = job * 4 + w;
    const int which = wj >= NCROWS ? 1 : 0;
    const int r = wj - which * NCROWS;
    const int bg = r / NCMP, n = r - bg * NCMP;
    const bf16_t* hid = (const bf16_t*)(aux + (which ? O_HIDV : O_HIDK)) + (size_t)r * 256;
    const float* w2 = which ? P.wv2 : P.wk2;
    float acc = 0.f;
#pragma unroll 8
    for (int k = 0; k < 256; ++k) acc += bf2f(hid[k]) * w2[k * 64 + lane];
    if (!which) {
        const int pos = 16 * n + 31, i = lane & 7;
        const float cs = ((const float*)(aux + O_ROPEC))[pos * 8 + i], sn = ((const float*)(aux + O_ROPES))[pos * 8 + i];
        const float pr = __shfl_xor(acc, 8);
        float o = acc;
        if (lane < 16) o = (lane & 8) ? (acc * cs + pr * sn) : (acc * cs - pr * sn);
        bf16_t* KC = (bf16_t*)(aux + O_KC);
        KC[((size_t)bg * 128 + n) * 64 + lane] = f2bf(o);
        if (n == NCMP - 1) KC[((size_t)bg * 128 + 127) * 64 + lane] = 0;
    } else {
        bf16_t* VCT = (bf16_t*)(aux + O_VCT);
        VCT[((size_t)bg * 64 + lane) * 128 + n] = f2bf(acc);
        if (n == NCMP - 1) VCT[((size_t)bg * 64 + lane) * 128 + 127] = 0;
    }
}

DEV void rnn_job(const Params& P, int job, char* smem, bool dry) {
    char* aux = (char*)P.out;
    bf16_t* ZA = (bf16_t*)(P.ws + W_ZA);
    const int b = job >> 6, n = (job >> 2) & 15, ct = job & 3;
    bf16_t* sX = (bf16_t*)smem;
    float* sXf = (float*)(smem + 9216);
    float* sCw = (float*)(smem + 9216 + 16640);
    float* sSum = (float*)(smem + 9216 + 16640 + 1280);
    bf16_t* sRaw = (bf16_t*)(smem + 9216 + 16640 + 1280 + 2048);
    const int tid = opaque_tid(), w = tid >> 6, lane = tid & 63, fr = lane & 15, fq = lane >> 4;
    const bf16_t* WAT = (const bf16_t*)(aux + O_WAT) + n * 4096;
    const bf16_t* WIT = (const bf16_t*)(aux + O_WIT) + n * 4096;
    bf16x8 wa[2], wi[2];
#pragma unroll
    for (int ks = 0; ks < 2; ++ks) {
        wa[ks] = *(const bf16x8*)(WAT + (16 * ct + fr) * 64 + 32 * ks + 8 * fq);
        wi[ks] = *(const bf16x8*)(WIT + (16 * ct + fr) * 64 + 32 * ks + 8 * fq);
    }
    const int c = n * 64 + 16 * ct + fr;
    const float ba = P.b_a[c], bi = P.b_i[c], cl = -8.0f * log1pf(__expf(-P.lam[c]));
    float carry = 0.f;
    __syncthreads();
    for (int i = tid; i < 320; i += 256) sCw[i] = (i < 256) ? P.conv_w[(i >> 6) * 1024 + n * 64 + (i & 63)] : P.conv_b[n * 64 + (i & 63)];
    const int lt = tid >> 2, cg = (tid & 3) * 16;
    const bf16_t* xbase = ZA + (size_t)(b * S) * ZW + C_XR + n * 64 + cg;
    bf16_t* sRaw2 = sRaw + 67 * 72;
    u32x4 xm0, xm1, xh0 = {0u, 0u, 0u, 0u}, xh1 = {0u, 0u, 0u, 0u};
    { const u32x4* xp = (const u32x4*)(xbase + (size_t)lt * ZW); xm0 = xp[0]; xm1 = xp[1]; }
    *(u32x4*)(sRaw + (lt + 3) * 72 + cg) = xm0; *(u32x4*)(sRaw + (lt + 3) * 72 + cg + 8) = xm1;
    if (tid < 12) { *(u32x4*)(sRaw + lt * 72 + cg) = xh0; *(u32x4*)(sRaw + lt * 72 + cg + 8) = xh1; }
    { const u32x4* xp = (const u32x4*)(xbase + (size_t)(64 + lt) * ZW); xm0 = xp[0]; xm1 = xp[1];
      if (tid < 12) { const u32x4* hp = (const u32x4*)(xbase + (size_t)(61 + lt) * ZW); xh0 = hp[0]; xh1 = hp[1]; } }
    __syncthreads();
#pragma unroll 1
    for (int chunk = 0; chunk < 32; ++chunk) {
        const int tc = chunk * 64;
        const bf16_t* rawc = (chunk & 1) ? sRaw2 : sRaw;
        bf16_t* rawn = (chunk & 1) ? sRaw : sRaw2;
        bf16_t gv[4];
#pragma unroll
        for (int j = 0; j < 4; ++j) gv[j] = ZA[(size_t)(b * S + tc + 16 * w + 4 * fq + j) * ZW + C_GR + n * 64 + 16 * ct + fr];
        {
            float xv[16];
#pragma unroll
            for (int e4 = 0; e4 < 4; ++e4) { const float4 bb = *(const float4*)(sCw + 256 + cg + 4 * e4); xv[4 * e4] = bb.x; xv[4 * e4 + 1] = bb.y; xv[4 * e4 + 2] = bb.z; xv[4 * e4 + 3] = bb.w; }
#pragma unroll
            for (int k = 0; k < 4; ++k) {
                const u32x4 v0 = *(const u32x4*)(rawc + (lt + k) * 72 + cg), v1 = *(const u32x4*)(rawc + (lt + k) * 72 + cg + 8);
                const unsigned u[8] = {v0.x, v0.y, v0.z, v0.w, v1.x, v1.y, v1.z, v1.w};
#pragma unroll
                for (int e4 = 0; e4 < 4; ++e4) {
                    const float4 wv = *(const float4*)(sCw + k * 64 + cg + 4 * e4);
                    xv[4 * e4] += wv.x * lo_f(u[2 * e4]);
                    xv[4 * e4 + 1] += wv.y * hi_f(u[2 * e4]);
                    xv[4 * e4 + 2] += wv.z * lo_f(u[2 * e4 + 1]);
                    xv[4 * e4 + 3] += wv.w * hi_f(u[2 * e4 + 1]);
                }
            }
            if ((tid & 3) == ct) {
#pragma unroll
                for (int e = 0; e < 16; ++e) sXf[lt * 17 + e] = xv[e];
            }
            u32x4 o0 = {pk2(xv[0], xv[1]), pk2(xv[2], xv[3]), pk2(xv[4], xv[5]), pk2(xv[6], xv[7])};
            u32x4 o1 = {pk2(xv[8], xv[9]), pk2(xv[10], xv[11]), pk2(xv[12], xv[13]), pk2(xv[14], xv[15])};
            *(u32x4*)(sX + lt * 72 + cg) = o0;
            *(u32x4*)(sX + lt * 72 + cg + 8) = o1;
        }
        __syncthreads();
        f32x4 R = (f32x4){0.f, 0.f, 0.f, 0.f}, I = (f32x4){0.f, 0.f, 0.f, 0.f};
#pragma unroll
        for (int ks = 0; ks < 2; ++ks) {
            const bf16x8 af = *(const bf16x8*)(sX + (16 * w + fr) * 72 + 32 * ks + 8 * fq);
            R = MFMA16(af, wa[ks], R); I = MFMA16(af, wi[ks], I);
        }
        if (chunk + 1 < 32) {
            *(u32x4*)(rawn + (lt + 3) * 72 + cg) = xm0; *(u32x4*)(rawn + (lt + 3) * 72 + cg + 8) = xm1;
            if (tid < 12) { *(u32x4*)(rawn + lt * 72 + cg) = xh0; *(u32x4*)(rawn + lt * 72 + cg + 8) = xh1; }
        }
        float hl[4], pc[4];
        float h = 0.f, pcum = 1.f;
#pragma unroll
        for (int j = 0; j < 4; ++j) {
            const float xcv = sXf[(16 * w + 4 * fq + j) * 17 + fr];
            const float rg = sigm(R[j] + ba), gi = sigm(I[j] + bi);
            const float la = rg * cl;
            const float a_ = __expf(la);
            const float mult = sqrtf(fmaxf(1.f - a_ * a_, 0.f));
            const float u = mult * gi * xcv;
            h = a_ * h + u; pcum *= a_;
            hl[j] = h; pc[j] = pcum;
        }
        float A = pcum, H = h;
        float A1 = __shfl_up(A, 16), H1 = __shfl_up(H, 16);
        if (fq >= 1) { H = A * H1 + H; A = A * A1; }
        float A2 = __shfl_up(A, 32), H2 = __shfl_up(H, 32);
        if (fq >= 2) { H = A * H2 + H; A = A * A2; }
        float Ax = __shfl_up(A, 16), Hx = __shfl_up(H, 16);
        const float Ae = fq == 0 ? 1.f : Ax, He = fq == 0 ? 0.f : Hx;
        if (fq == 3) { sSum[w * 16 + fr] = A; sSum[64 + w * 16 + fr] = H; }
        __syncthreads();
        if (chunk + 2 < 32) {
            const u32x4* xp = (const u32x4*)(xbase + (size_t)(tc + 128 + lt) * ZW); xm0 = xp[0]; xm1 = xp[1];
            if (tid < 12) { const u32x4* hp = (const u32x4*)(xbase + (size_t)(tc + 125 + lt) * ZW); xh0 = hp[0]; xh1 = hp[1]; }
        }
        float cin = carry, mycin = 0.f;
#pragma unroll
        for (int ww = 0; ww < 4; ++ww) {
            if (ww == w) mycin = cin;
            cin = sSum[ww * 16 + fr] * cin + sSum[64 + ww * 16 + fr];
        }
        carry = cin;
        const float sq = Ae * mycin + He;
#pragma unroll
        for (int j = 0; j < 4; ++j) {
            const float hfin = hl[j] + pc[j] * sq;
            const size_t grow = (size_t)(b * S + tc + 16 * w + 4 * fq + j);
            bf16_t* op = dry ? ((bf16_t*)(P.ws + W_YX) + grow * 1024 + n * 64 + 16 * ct + fr) : (ZA + grow * ZW + C_GR + n * 64 + 16 * ct + fr);
            *op = f2bf(gelu_t(bf2f(gv[j])) * hfin);
        }
    }
}

constexpr float EXPC = 0.125f * 1.4426950408889634f;
struct AttnAcc { f32x4 o[4][2]; float m[2], l[2]; };
DEV void attn_init(AttnAcc& a) {
#pragma unroll
    for (int d = 0; d < 4; ++d)
#pragma unroll
        for (int q = 0; q < 2; ++q) a.o[d][q] = (f32x4){0.f, 0.f, 0.f, 0.f};
    a.m[0] = a.m[1] = -INFINITY; a.l[0] = a.l[1] = 0.f;
}
DEV bf16x8 mk8(unsigned a, unsigned b, unsigned c, unsigned d) { u32x4 u = {a, b, c, d}; return __builtin_bit_cast(bf16x8, u); }

template <class MF>
DEV void attn_step(const bf16_t* sK, const bf16_t* sVt, int vstride, const bf16x8 (&qf)[2][2], AttnAcc& st, const MF& mf, int fr, int fq) {
    f32x4 s[4][2];
#pragma unroll
    for (int kt = 0; kt < 4; ++kt) {
        s[kt][0] = (f32x4){0.f, 0.f, 0.f, 0.f}; s[kt][1] = (f32x4){0.f, 0.f, 0.f, 0.f};
#pragma unroll
        for (int ks = 0; ks < 2; ++ks) {
            const bf16x8 kf = *(const bf16x8*)(sK + (16 * kt + fr) * 80 + 32 * ks + 8 * fq);
            s[kt][0] = MFMA16(kf, qf[0][ks], s[kt][0]);
            s[kt][1] = MFMA16(kf, qf[1][ks], s[kt][1]);
        }
    }
#pragma unroll
    for (int qt = 0; qt < 2; ++qt) {
        float mx = -INFINITY;
#pragma unroll
        for (int kt = 0; kt < 4; ++kt)
#pragma unroll
            for (int j = 0; j < 4; ++j) {
                const float v = mf(qt, 16 * kt + 4 * fq + j) ? s[kt][qt][j] : -INFINITY;
                s[kt][qt][j] = v; mx = fmaxf(mx, v);
            }
        mx = fmaxf(mx, __shfl_xor(mx, 16)); mx = fmaxf(mx, __shfl_xor(mx, 32));
        const float mn = fmaxf(st.m[qt], mx);
        float alpha = 1.f, msub = 0.f;
        if (mn != -INFINITY) { alpha = __builtin_amdgcn_exp2f((st.m[qt] - mn) * EXPC); msub = mn; }
        st.m[qt] = mn;
        float ps = 0.f;
#pragma unroll
        for (int kt = 0; kt < 4; ++kt)
#pragma unroll
            for (int j = 0; j < 4; ++j) { const float p = __builtin_amdgcn_exp2f((s[kt][qt][j] - msub) * EXPC); s[kt][qt][j] = p; ps += p; }
        st.l[qt] = st.l[qt] * alpha + ps;
#pragma unroll
        for (int dt = 0; dt < 4; ++dt) st.o[dt][qt] *= alpha;
    }
#pragma unroll
    for (int ks = 0; ks < 2; ++ks) {
        bf16x8 pf[2];
#pragma unroll
        for (int qt = 0; qt < 2; ++qt)
            pf[qt] = mk8(pk2(s[2 * ks][qt][0], s[2 * ks][qt][1]), pk2(s[2 * ks][qt][2], s[2 * ks][qt][3]),
                         pk2(s[2 * ks + 1][qt][0], s[2 * ks + 1][qt][1]), pk2(s[2 * ks + 1][qt][2], s[2 * ks + 1][qt][3]));
#pragma unroll
        for (int dt = 0; dt < 4; ++dt) {
            const u32x2 v0 = *(const u32x2*)(sVt + (16 * dt + fr) * vstride + 32 * ks + 4 * fq);
            const u32x2 v1 = *(const u32x2*)(sVt + (16 * dt + fr) * vstride + 32 * ks + 16 + 4 * fq);
            const bf16x8 vf = mk8(v0.x, v0.y, v1.x, v1.y);
            st.o[dt][0] = MFMA16(vf, pf[0], st.o[dt][0]);
            st.o[dt][1] = MFMA16(vf, pf[1], st.o[dt][1]);
        }
    }
}
DEV void attn_step_fast(const bf16_t* sK, const bf16_t* sVt, const bf16x8 (&qf)[2][2], AttnAcc& st, const float (&bitoff)[2], int fr, int fq) {
    f32x4 s[4][2];
#pragma unroll
    for (int kt = 0; kt < 4; ++kt) {
        s[kt][0] = (f32x4){0.f, 0.f, 0.f, 0.f}; s[kt][1] = (f32x4){0.f, 0.f, 0.f, 0.f};
#pragma unroll
        for (int ks = 0; ks < 2; ++ks) {
            const bf16x8 kf = *(const bf16x8*)(sK + (16 * kt + fr) * 80 + 32 * ks + 8 * fq);
            s[kt][0] = MFMA16(kf, qf[0][ks], s[kt][0]);
            s[kt][1] = MFMA16(kf, qf[1][ks], s[kt][1]);
        }
    }
#pragma unroll
    for (int qt = 0; qt < 2; ++qt) {
        float mx = fmaxf(fmaxf(s[0][qt][0], s[0][qt][1]), fmaxf(s[0][qt][2], s[0][qt][3]));
#pragma unroll
        for (int kt = 1; kt < 4; ++kt) mx = fmaxf(mx, fmaxf(fmaxf(s[kt][qt][0], s[kt][qt][1]), fmaxf(s[kt][qt][2], s[kt][qt][3])));
        mx = fmaxf(mx, __shfl_xor(mx, 16)); mx = fmaxf(mx, __shfl_xor(mx, 32));
        const float mn = fmaxf(st.m[qt], mx);
        const float alpha = __builtin_amdgcn_exp2f((st.m[qt] - mn) * EXPC);
        st.m[qt] = mn;
        const float off = bitoff[qt] - mn * EXPC;
        float ps = 0.f;
#pragma unroll
        for (int kt = 0; kt < 4; ++kt)
#pragma unroll
            for (int j = 0; j < 4; ++j) { const float p = __builtin_amdgcn_exp2f(fmaf(s[kt][qt][j], EXPC, off)); s[kt][qt][j] = p; ps += p; }
        st.l[qt] = st.l[qt] * alpha + ps;
#pragma unroll
        for (int dt = 0; dt < 4; ++dt) st.o[dt][qt] *= alpha;
    }
#pragma unroll
    for (int ks = 0; ks < 2; ++ks) {
        bf16x8 pf[2];
#pragma unroll
        for (int qt = 0; qt < 2; ++qt)
            pf[qt] = mk8(pk2(s[2 * ks][qt][0], s[2 * ks][qt][1]), pk2(s[2 * ks][qt][2], s[2 * ks][qt][3]),
                         pk2(s[2 * ks + 1][qt][0], s[2 * ks + 1][qt][1]), pk2(s[2 * ks + 1][qt][2], s[2 * ks + 1][qt][3]));
#pragma unroll
        for (int dt = 0; dt < 4; ++dt) {
            const u32x2 v0 = *(const u32x2*)(sVt + (16 * dt + fr) * 72 + 32 * ks + 4 * fq);
            const u32x2 v1 = *(const u32x2*)(sVt + (16 * dt + fr) * 72 + 32 * ks + 16 + 4 * fq);
            const bf16x8 vf = mk8(v0.x, v0.y, v1.x, v1.y);
            st.o[dt][0] = MFMA16(vf, pf[0], st.o[dt][0]);
            st.o[dt][1] = MFMA16(vf, pf[1], st.o[dt][1]);
        }
    }
}
template <int QT>
DEV void attn_half_fast(const bf16_t* sK, const bf16_t* sVt, const bf16x8 (&qf)[2][2], AttnAcc& st, float bitoff, int fr, int fq) {
    f32x4 s[4];
#pragma unroll
    for (int kt = 0; kt < 4; ++kt) {
        s[kt] = (f32x4){0.f, 0.f, 0.f, 0.f};
#pragma unroll
        for (int ks = 0; ks < 2; ++ks) {
            const bf16x8 kf = *(const bf16x8*)(sK + (16 * kt + fr) * 80 + 32 * ks + 8 * fq);
            s[kt] = MFMA16(kf, qf[QT][ks], s[kt]);
        }
    }
    float mx = fmaxf(fmaxf(s[0][0], s[0][1]), fmaxf(s[0][2], s[0][3]));
#pragma unroll
    for (int kt = 1; kt < 4; ++kt) mx = fmaxf(mx, fmaxf(fmaxf(s[kt][0], s[kt][1]), fmaxf(s[kt][2], s[kt][3])));
    mx = fmaxf(mx, __shfl_xor(mx, 16)); mx = fmaxf(mx, __shfl_xor(mx, 32));
    const float mn = fmaxf(st.m[QT], mx);
    const float alpha = __builtin_amdgcn_exp2f((st.m[QT] - mn) * EXPC);
    st.m[QT] = mn;
    const float off = bitoff - mn * EXPC;
    float ps = 0.f;
#pragma unroll
    for (int kt = 0; kt < 4; ++kt)
#pragma unroll
        for (int j = 0; j < 4; ++j) { const float p = __builtin_amdgcn_exp2f(fmaf(s[kt][j], EXPC, off)); s[kt][j] = p; ps += p; }
    st.l[QT] = st.l[QT] * alpha + ps;
#pragma unroll
    for (int dt = 0; dt < 4; ++dt) st.o[dt][QT] *= alpha;
#pragma unroll
    for (int ks = 0; ks < 2; ++ks) {
        const bf16x8 pf = mk8(pk2(s[2 * ks][0], s[2 * ks][1]), pk2(s[2 * ks][2], s[2 * ks][3]), pk2(s[2 * ks + 1][0], s[2 * ks + 1][1]), pk2(s[2 * ks + 1][2], s[2 * ks + 1][3]));
#pragma unroll
        for (int dt = 0; dt < 4; ++dt) {
            const u32x2 v0 = *(const u32x2*)(sVt + (16 * dt + fr) * 72 + 32 * ks + 4 * fq);
            const u32x2 v1 = *(const u32x2*)(sVt + (16 * dt + fr) * 72 + 32 * ks + 16 + 4 * fq);
            st.o[dt][QT] = MFMA16(mk8(v0.x, v0.y, v1.x, v1.y), pf, st.o[dt][QT]);
        }
    }
}
DEV void attn_fold_out(bf16_t* const (&op)[2], const AttnAcc& st, const float (&gate)[2]) {
#pragma unroll
    for (int qt = 0; qt < 2; ++qt) {
        float l = st.l[qt];
        l += __shfl_xor(l, 16); l += __shfl_xor(l, 32);
        const float sc = gate[qt] * __builtin_amdgcn_rcpf(fmaxf(l, 1e-30f));
#pragma unroll
        for (int dt = 0; dt < 4; ++dt) {
            const uint2 pv = *(const uint2*)(op[qt] + 16 * dt);
            f32x4 r = st.o[dt][qt] * sc;
            r[0] += lo_f(pv.x); r[1] += hi_f(pv.x); r[2] += lo_f(pv.y); r[3] += hi_f(pv.y);
            *(uint2*)(op[qt] + 16 * dt) = make_uint2(pk2(r[0], r[1]), pk2(r[2], r[3]));
        }
    }
}
DEV void attn_fold(f32x4 (&tot)[4][2], const AttnAcc& st, const float (&gate)[2]) {
#pragma unroll
    for (int qt = 0; qt < 2; ++qt) {
        float l = st.l[qt];
        l += __shfl_xor(l, 16); l += __shfl_xor(l, 32);
        const float sc = gate[qt] * __builtin_amdgcn_rcpf(fmaxf(l, 1e-30f));
#pragma unroll
        for (int dt = 0; dt < 4; ++dt) tot[dt][qt] += st.o[dt][qt] * sc;
    }
}
DEV void ld64(u32x4 (&r)[2], const bf16_t* src, size_t sstride, int tid) {
#pragma unroll
    for (int i = 0; i < 2; ++i) { const int c = tid + 256 * i; r[i] = *(const u32x4*)(src + (size_t)(c >> 3) * sstride + (c & 7) * 8); }
}
DEV void st64(bf16_t* dst, const u32x4 (&r)[2], int tid, int stride) {
#pragma unroll
    for (int i = 0; i < 2; ++i) { const int c = tid + 256 * i; *(u32x4*)(dst + (c >> 3) * stride + (c & 7) * 8) = r[i]; }
}

#define OUTP(QT) ((dry ? (bf16_t*)(P.ws + W_YX) + (size_t)(b * S + tq[QT]) * 1024 : ZA + (size_t)(b * S + tq[QT]) * ZW + C_Q) + head * 64 + 4 * fq)
#define LOAD_GATE(G2, BR) float G2[2]; { G2[0] = bf2f(ZA[(size_t)(b * S + tq[0]) * ZW + C_G + head * 3 + (BR)]); G2[1] = bf2f(ZA[(size_t)(b * S + tq[1]) * ZW + C_G + head * 3 + (BR)]); }
struct MaskAll { DEV bool operator()(int, int) const { return true; } };
struct MaskSel { unsigned bit[2]; int t[2]; int k0; DEV bool operator()(int qt, int kk) const { return bit[qt] && (k0 + kk <= t[qt]); } };
struct MaskWin { int t[2]; int k0; DEV bool operator()(int qt, int kk) const { const int k = k0 + kk; return k <= t[qt] && k > t[qt] - 512; } };

DEV void xattn_job(const Params& P, int job, char* smem, bool dry) {
    char* aux = (char*)P.out;
    bf16_t* ZA = (bf16_t*)(P.ws + W_ZA);
    const int qb = job & 15, h = (job >> 4) & 3, b = job >> 6;
    bf16_t* sK = (bf16_t*)smem;
    bf16_t* sVt = sK + 64 * 80;
    const int tid = opaque_tid(), w = tid >> 6, lane = tid & 63, fr = lane & 15, fq = lane >> 4;
    const int t0 = qb * 128 + w * 32;
    bf16x8 qf[2][2];
#pragma unroll
    for (int qt = 0; qt < 2; ++qt)
#pragma unroll
        for (int ks = 0; ks < 2; ++ks) qf[qt][ks] = *(const bf16x8*)(ZA + (size_t)(b * S + t0 + 16 * qt + fr) * ZW + C_QX + h * 64 + 32 * ks + 8 * fq);
    const bf16_t* MK = (const bf16_t*)(aux + O_MEMK) + (size_t)(b * 4 + h) * 256 * 64;
    const bf16_t* MVT = (const bf16_t*)(aux + O_MEMVT) + (size_t)(b * 4 + h) * 64 * 256;
    AttnAcc st; attn_init(st);
    u32x4 rk[2], rv[2];
    ld64(rk, MK, 64, tid); ld64(rv, MVT, 256, tid);
#pragma unroll 1
    for (int jb = 0; jb < 4; ++jb) {
        __syncthreads();
        st64(sK, rk, tid, 80); st64(sVt, rv, tid, 72);
        __syncthreads();
        if (jb + 1 < 4) { ld64(rk, MK + (size_t)(jb + 1) * 64 * 64, 64, tid); ld64(rv, MVT + (jb + 1) * 64, 256, tid); }
        __builtin_amdgcn_sched_barrier(0);
        { const float z2[2] = {0.f, 0.f}; attn_step_fast(sK, sVt, qf, st, z2, fr, fq); }
    }
    f32x4 tot[4][2];
#pragma unroll
    for (int dt = 0; dt < 4; ++dt) { tot[dt][0] = (f32x4){0.f, 0.f, 0.f, 0.f}; tot[dt][1] = (f32x4){0.f, 0.f, 0.f, 0.f}; }
    const float one[2] = {1.f, 1.f};
    attn_fold(tot, st, one);
#pragma unroll
    for (int qt = 0; qt < 2; ++qt)
#pragma unroll
        for (int dt = 0; dt < 4; ++dt)
            *(uint2*)((dry ? (bf16_t*)(P.ws + W_Y) + (size_t)(b * S + t0 + 16 * qt + fr) * 1024 : ZA + (size_t)(b * S + t0 + 16 * qt + fr) * ZW + C_QX) + h * 64 + 16 * dt + 4 * fq) =
                make_uint2(pk2(tot[dt][qt][0], tot[dt][qt][1]), pk2(tot[dt][qt][2], tot[dt][qt][3]));
}

DEV void nsa_job(const Params& P, int job, char* smem, bool dry) {
    char* aux = (char*)P.out;
    bf16_t* ZA = (bf16_t*)(P.ws + W_ZA);
    const int bg = job & 31, qb = 63 - (job >> 5), b = bg >> 2, g = bg & 3, t0 = qb * 32;
    bf16_t* sK = (bf16_t*)smem;
    bf16_t* sVt = (bf16_t*)(smem + 20480);
    float* sImp = (float*)(smem + 38912);
    unsigned* sSel = (unsigned*)(smem + 38912 + 4096);
    constexpr int KVBUF = 9728;
    const int tid = opaque_tid(), w = tid >> 6, lane = tid & 63, fr = lane & 15, fq = lane >> 4;
    const int head = g * 4 + (fr & 3);
    const int qi0 = 8 * w + (fr >> 2);
    int tq[2];
    bf16x8 qf[2][2];
#pragma unroll
    for (int qt = 0; qt < 2; ++qt) {
        tq[qt] = t0 + qi0 + 4 * qt;
        const bf16_t* rowp = ZA + (size_t)(b * S + tq[qt]) * ZW;
#pragma unroll
        for (int ks = 0; ks < 2; ++ks) qf[qt][ks] = *(const bf16x8*)(rowp + C_Q + head * 64 + 32 * ks + 8 * fq);
    }
    f32x4 tot[4][2];
#pragma unroll
    for (int dt = 0; dt < 4; ++dt) { tot[dt][0] = (f32x4){0.f, 0.f, 0.f, 0.f}; tot[dt][1] = (f32x4){0.f, 0.f, 0.f, 0.f}; }

    {
        const bf16_t* KC = (const bf16_t*)(aux + O_KC) + (size_t)bg * 128 * 64;
        const bf16_t* VCT = (const bf16_t*)(aux + O_VCT) + (size_t)bg * 64 * 128;
        __syncthreads();
#pragma unroll
        for (int i = 0; i < 4; ++i) {
            const int c = tid + 256 * i;
            { const int r = c >> 3, k = (c & 7) * 8; *(u32x4*)(sK + r * 80 + k) = *(const u32x4*)(KC + r * 64 + k); }
            { const int r = c >> 4, k = (c & 15) * 8; *(u32x4*)(sVt + r * 136 + k) = *(const u32x4*)(VCT + r * 128 + k); }
        }
        __syncthreads();
#pragma unroll
        for (int qt = 0; qt < 2; ++qt) {
            const float g0 = bf2f(ZA[(size_t)(b * S + tq[qt]) * ZW + C_G + head * 3 + 0]);
            f32x4 s[8];
#pragma unroll
            for (int kt = 0; kt < 8; ++kt) {
                s[kt] = (f32x4){0.f, 0.f, 0.f, 0.f};
#pragma unroll
                for (int ks = 0; ks < 2; ++ks) {
                    const bf16x8 kf = *(const bf16x8*)(sK + (16 * kt + fr) * 80 + 32 * ks + 8 * fq);
                    s[kt] = MFMA16(kf, qf[qt][ks], s[kt]);
                }
            }
            float mx = -INFINITY;
#pragma unroll
            for (int kt = 0; kt < 8; ++kt)
#pragma unroll
                for (int j = 0; j < 4; ++j) {
                    const int n = 16 * kt + 4 * fq + j;
                    const float v = (n < NCMP && 16 * n + 31 <= tq[qt]) ? s[kt][j] : -INFINITY;
                    s[kt][j] = v; mx = fmaxf(mx, v);
                }
            mx = fmaxf(mx, __shfl_xor(mx, 16)); mx = fmaxf(mx, __shfl_xor(mx, 32));
            const float msub = (mx == -INFINITY) ? 0.f : mx;
            float ps = 0.f;
#pragma unroll
            for (int kt = 0; kt < 8; ++kt)
#pragma unroll
                for (int j = 0; j < 4; ++j) { const float p = __builtin_amdgcn_exp2f((s[kt][j] - msub) * EXPC); s[kt][j] = p; ps += p; }
            ps += __shfl_xor(ps, 16); ps += __shfl_xor(ps, 32);
            const float inv = __builtin_amdgcn_rcpf(fmaxf(ps, 1e-30f));
            float bprev = 0.f;
#pragma unroll
            for (int kt = 0; kt < 8; ++kt) {
                s[kt] *= inv;
                const float a = s[kt][0] + s[kt][1] + s[kt][2] + 0.5f * s[kt][3];
                const float bq = 0.5f * s[kt][3];
                const float x = __shfl(bq, (lane + 48) & 63);
                const float y = __shfl(bprev, (lane + 48) & 63);
                float iv = a + (fq > 0 ? x : y);
                iv += __shfl_xor(iv, 1); iv += __shfl_xor(iv, 2);
                if ((fr & 3) == 0) sImp[(qi0 + 4 * qt) * 32 + 4 * kt + fq] = iv;
                bprev = bq;
            }
#pragma unroll
            for (int ks = 0; ks < 4; ++ks) {
                const f32x4 pa = s[2 * ks] * g0, pb = s[2 * ks + 1] * g0;
                const bf16x8 pf = mk8(pk2(pa[0], pa[1]), pk2(pa[2], pa[3]), pk2(pb[0], pb[1]), pk2(pb[2], pb[3]));
#pragma unroll
                for (int dt = 0; dt < 4; ++dt) {
                    const u32x2 v0 = *(const u32x2*)(sVt + (16 * dt + fr) * 136 + 32 * ks + 4 * fq);
                    const u32x2 v1 = *(const u32x2*)(sVt + (16 * dt + fr) * 136 + 32 * ks + 16 + 4 * fq);
                    tot[dt][qt] = MFMA16(mk8(v0.x, v0.y, v1.x, v1.y), pf, tot[dt][qt]);
                }
            }
            __builtin_amdgcn_sched_barrier(0);
        }
    }
#pragma unroll
    for (int qt = 0; qt < 2; ++qt) {
        bf16_t* op = (dry ? (bf16_t*)(P.ws + W_YX) + (size_t)(b * S + tq[qt]) * 1024 : ZA + (size_t)(b * S + tq[qt]) * ZW + C_Q) + head * 64 + 4 * fq;
#pragma unroll
        for (int dt = 0; dt < 4; ++dt) *(uint2*)(op + 16 * dt) = pk4(tot[dt][qt]);
    }
    __syncthreads();
    {
        float myv[4];
#pragma unroll
        for (int i = 0; i < 4; ++i) {
            const int pidx = tid + 256 * i, q = pidx >> 5, m = pidx & 31;
            const int t = t0 + q, cur = t >> 6;
            const float sum = sImp[q * 32 + m];
            const bool forced = (m == 0) || (m == cur) || (m == cur - 1);
            const bool future = m * 64 > t;
            myv[i] = forced ? INFINITY : (future ? -INFINITY : sum);
        }
        if (tid == 0) sSel[32] = 0u;
        __syncthreads();
#pragma unroll
        for (int i = 0; i < 4; ++i) { const int pidx = tid + 256 * i; sImp[pidx] = myv[i]; }
        __syncthreads();
        unsigned wun = 0u;
#pragma unroll
        for (int i = 0; i < 4; ++i) {
            const int pidx = tid + 256 * i, q = pidx >> 5, m = pidx & 31;
            const float v = myv[i];
            int rank = 0;
#pragma unroll
            for (int m2 = 0; m2 < 32; ++m2) {
                const float o = sImp[q * 32 + m2];
                rank += (o > v || (o == v && m2 < m)) ? 1 : 0;
            }
            const bool selb = (rank < 8) && (v > -INFINITY);
            const unsigned long long bal = __ballot(selb);
            const unsigned mk = (unsigned)(bal >> (32 * (lane >> 5)));
            if ((lane & 31) == 0) sSel[q] = mk;
            wun |= (unsigned)bal | (unsigned)(bal >> 32);
        }
        if (lane == 0) atomicOr(&sSel[32], wun);
    }
    __syncthreads();
    __shared__ unsigned s_xuni[2];
    if (tid == 0) s_xuni[threadIdx.x >> 8] = sSel[32];
    __syncthreads();
    const unsigned uni = s_xuni[0] | s_xuni[1];
    const int jmax = (t0 + 31) >> 6;
    {
        AttnAcc st; attn_init(st);
        const bf16_t* Kb = ZA + (size_t)(b * S) * ZW + C_KS + g * 64;
        const bf16_t* Vb = (const bf16_t*)(P.ws + W_VST) + (size_t)bg * 64 * S;
        unsigned rem = uni & ((2u << jmax) - 1u);
        u32x4 rk[2], rv[2];
        if (rem) { const int j0 = __builtin_ctz(rem); ld64(rk, Kb + (size_t)(j0 * 64) * ZW, ZW, tid); ld64(rv, Vb + j0 * 64, S, tid); }
        __syncthreads();
        int it = 0;
#pragma unroll 1
        while (rem) {
            const int jb = __builtin_ctz(rem);
            rem &= rem - 1u;
            bf16_t* sKb = (bf16_t*)smem + (it & 1) * KVBUF; bf16_t* sVb = sKb + 64 * 80; ++it;
            st64(sKb, rk, tid, 80); st64(sVb, rv, tid, 72);
            __syncthreads();
            if (rem) { const int jn = __builtin_ctz(rem); ld64(rk, Kb + (size_t)(jn * 64) * ZW, ZW, tid); ld64(rv, Vb + jn * 64, S, tid); }
            __builtin_amdgcn_sched_barrier(0);
            const unsigned b0 = (sSel[qi0] >> jb) & 1u, b1 = (sSel[qi0 + 4] >> jb) & 1u;
            if (jb * 64 + 63 <= t0) {
                const bool need0 = __builtin_amdgcn_ballot_w64(b0 != 0u) != 0ull, need1 = __builtin_amdgcn_ballot_w64(b1 != 0u) != 0ull;
                const float bo[2] = {b0 ? 0.f : -INFINITY, b1 ? 0.f : -INFINITY};
                if (need0 && need1) attn_step_fast(sKb, sVb, qf, st, bo, fr, fq);
                else if (need0) attn_half_fast<0>(sKb, sVb, qf, st, bo[0], fr, fq);
                else if (need1) attn_half_fast<1>(sKb, sVb, qf, st, bo[1], fr, fq);
            } else {
                MaskSel mf; mf.bit[0] = b0; mf.bit[1] = b1; mf.t[0] = tq[0]; mf.t[1] = tq[1]; mf.k0 = jb * 64;
                attn_step(sKb, sVb, 72, qf, st, mf, fr, fq);
            }
        }
        { LOAD_GATE(g1, 1) bf16_t* const op2[2] = {OUTP(0), OUTP(1)}; attn_fold_out(op2, st, g1); }
    }
    {
        AttnAcc st; attn_init(st);
        const bf16_t* Kb = ZA + (size_t)(b * S) * ZW + C_KW + g * 64;
        const bf16_t* Vb = (const bf16_t*)(P.ws + W_VWT) + (size_t)bg * 64 * S;
#pragma unroll
        for (int qt = 0; qt < 2; ++qt) {
            const int npad = 511 - tq[qt];
            if (npad > 0) { st.m[qt] = 0.f; st.l[qt] = (fq == 0) ? (float)npad : 0.f; }
        }
        int jlo = t0 - 511; jlo = jlo < 0 ? 0 : (jlo >> 6);
        u32x4 rk[2], rv[2];
        ld64(rk, Kb + (size_t)(jlo * 64) * ZW, ZW, tid); ld64(rv, Vb + jlo * 64, S, tid);
        __syncthreads();
#pragma unroll 1
        for (int jb = jlo; jb <= jmax; ++jb) {
            bf16_t* sKb = (bf16_t*)smem + ((jb - jlo) & 1) * KVBUF; bf16_t* sVb = sKb + 64 * 80;
            st64(sKb, rk, tid, 80); st64(sVb, rv, tid, 72);
            __syncthreads();
            if (jb < jmax) { ld64(rk, Kb + (size_t)((jb + 1) * 64) * ZW, ZW, tid); ld64(rv, Vb + (jb + 1) * 64, S, tid); }
            __builtin_amdgcn_sched_barrier(0);
            if (jb * 64 + 63 <= t0 && jb * 64 > t0 + 31 - 512) {
                const float z2[2] = {0.f, 0.f};
                attn_step_fast(sKb, sVb, qf, st, z2, fr, fq);
            } else {
                MaskWin mf; mf.t[0] = tq[0]; mf.t[1] = tq[1]; mf.k0 = jb * 64;
                attn_step(sKb, sVb, 72, qf, st, mf, fr, fq);
            }
        }
        { LOAD_GATE(g2, 2) bf16_t* const op2[2] = {OUTP(0), OUTP(1)}; attn_fold_out(op2, st, g2); }
    }
}


#define XB_TMO      128
#define XB_XCNT(j)  (256  + 64 * (j))
#define XB_XSUB(j)  (1280 + 64 * (j))
#define XB_XGEN(j)  (2304 + 64 * (j))
#define XB_TOP      3328
#define XB_TOPGEN   3392
#define XCD_BAR_WORDS 3456
#define XB_SPIN_CAP (1u << 18)
#define LAS __attribute__((address_space(3)))
DEV unsigned xb_ld(unsigned* p) { return __hip_atomic_load(p, __ATOMIC_RELAXED, __HIP_MEMORY_SCOPE_AGENT); }
DEV unsigned xb_add(unsigned* p, unsigned v) { return __hip_atomic_fetch_add(p, v, __ATOMIC_RELAXED, __HIP_MEMORY_SCOPE_AGENT); }
DEV unsigned xb_xcc_id() { return (unsigned)__builtin_amdgcn_s_getreg((3 << 11) | 20) & 0xFu; }
#define XB_SPIN(cond, bar) do { unsigned _sp = 0; while (cond) { __builtin_amdgcn_s_sleep(1); \
    if ((++_sp & 255u) == 0u) { if (xb_ld(&(bar)[XB_TMO])) break; if (_sp > XB_SPIN_CAP) { atomicAdd(&(bar)[XB_TMO], 1u); break; } } } } while (0)
struct XcdBarrier { unsigned* bar; unsigned x; volatile LAS unsigned* st; };
DEV XcdBarrier xcd_barrier_post(unsigned* bar, volatile LAS unsigned* st) {
    XcdBarrier b; b.bar = bar; b.x = xb_xcc_id(); b.st = st;
    if (threadIdx.x == 0) (void)xb_add(&bar[XB_XCNT(b.x)], 1u);
    return b;
}
DEV void xcd_barrier_complete(unsigned* bar, unsigned x, unsigned& nloc, unsigned& nx) {
    const unsigned G = gridDim.x * gridDim.y * gridDim.z;
    unsigned sum, cnt, mine, sp = 0u;
    for (;;) {
        sum = 0u; cnt = 0u; mine = 0u;
#pragma unroll
        for (unsigned j = 0; j < 16; ++j) { const unsigned c = xb_ld(&bar[XB_XCNT(j)]); sum += c; cnt += (c > 0u) ? 1u : 0u; mine = (j == x) ? c : mine; }
        if (sum == G) break;
        __builtin_amdgcn_s_sleep(1);
        if ((++sp & 255u) == 0u) { if (xb_ld(&bar[XB_TMO])) break; if (sp > XB_SPIN_CAP) { atomicAdd(&bar[XB_TMO], 1u); break; } }
    }
    nloc = mine > 0u ? mine : 1u; nx = cnt > 0u ? cnt : 1u;
}
DEV void xcd_barrier(const XcdBarrier& b) {
    asm volatile("s_waitcnt vmcnt(0)" ::: "memory");
    __syncthreads();
    if (threadIdx.x == 0) {
        unsigned* bar = b.bar;
        __builtin_amdgcn_s_waitcnt(0);
        unsigned nloc = b.st[0], nx = b.st[1];
        if (nloc == 0u) { xcd_barrier_complete(bar, b.x, nloc, nx); b.st[0] = nloc; b.st[1] = nx; }
        const unsigned old = xb_add(&bar[XB_XSUB(b.x)], 1u);
        const unsigned gen = old / nloc;
        if (old + 1u == (gen + 1u) * nloc) {
            __builtin_amdgcn_fence(__ATOMIC_RELEASE, "agent");
            asm volatile("s_waitcnt vmcnt(0)" ::: "memory");
            const unsigned og = xb_add(&bar[XB_TOP], 1u);
            const unsigned tg = og / nx;
            if (og + 1u == (tg + 1u) * nx) xb_add(&bar[XB_TOPGEN], 1u);
            else XB_SPIN(xb_ld(&bar[XB_TOPGEN]) == tg, bar);
            __builtin_amdgcn_fence(__ATOMIC_ACQUIRE, "agent");
            xb_add(&bar[XB_XGEN(b.x)], 1u);
            asm volatile("s_waitcnt vmcnt(0)" ::: "memory");
        } else {
            XB_SPIN(xb_ld(&bar[XB_XGEN(b.x)]) == gen, bar);
            __builtin_amdgcn_fence(__ATOMIC_ACQUIRE, "agent");
            asm volatile("s_waitcnt vmcnt(0)" ::: "memory");
        }
    }
    __syncthreads();
}
constexpr size_t W_BAR = 252 * MiB;

constexpr int HALF_SMEM = 56320;
constexpr int SMEM_BYTES = 131072;

extern __shared__ __attribute__((aligned(16))) char dyn_smem[];
#define RUN_PG8(EPI_T, EPI_OBJ, A_, LDA_, BT_, LDB_, M_, N_, K_) { pg8::Gemm g_; g_.A = (A_); g_.Bt = (BT_); g_.M = (M_); g_.N = (N_); g_.K = (K_); g_.lda = (LDA_); g_.ldb = (LDB_); \
        pg8::StaticOrder so_; so_.init((M_), (N_), (int)gridDim.x, (int)blockIdx.x); __syncthreads(); \
        pg8::gemm_phase<EPI_T, pg8::StaticOrder, true, true>((PG8_LAS unsigned char*)dyn_smem, g_, so_, (EPI_OBJ)); __syncthreads(); }

template <int PH, bool DRY = false>
DEV void run_phase(const Params& P, char* smem) {
    const int nb = gridDim.x, bid = blockIdx.x, sub = opaque_tid512() >> 8;
    char* hsm = smem + sub * HALF_SMEM;
    char* aux = (char*)P.out;
    char* ws = P.ws;
    bf16_t* ZA = (bf16_t*)(ws + W_ZA);
    if (PH == 0) {
        for (int pj = bid; pj < (5088 + 4096 + 512 + 64) / 2; pj += nb) {
            int j = 2 * pj + sub;
            if (j < 5088) {
                bool done = false;
#define TR(SRC, LD, DSTOFF, KK, NN, MAP, BLK)                                                                                  \
    if (!done) { const int nrt = (NN) / 64, nt = nrt * ((KK) / 64);                                                              \
        if (j < nt) { transpose_tile((SRC), (LD), (bf16_t*)(aux + (DSTOFF)), (KK), (j % nrt) * 64, (j / nrt) * 64, (MAP), hsm, (BLK) ? (NN) : 0); done = true; } else j -= nt; }
                TR(P.w_in, 7984, O_WTA, 1024, 5120, 1, 0)
                TR(P.w_in, 7984, O_WTB, 1024, 4096, 2, 0)
                TR(P.w_up, 4096, O_WTUP, 1024, 4096, 0, 0)
                TR(P.w_down, 1024, O_WTDN, 4096, 1024, 0, 0)
                TR(P.w_o, 1024, O_WTO, 1024, 1024, 0, 0)
                TR(P.w_xo, 1024, O_WTXO, 256, 1024, 0, 0)
                TR(P.w_mkv, 512, O_WTMKV, 1024, 512, 0, 0)
                TR(P.wk1, 256, O_WTCK1, 2048, 256, 0, 0)
                TR(P.wv1, 256, O_WTCV1, 2048, 256, 0, 0)
#undef TR
                if (!done) {
                    if (j < 16) transpose_tile(P.w_a + j * 4096, 64, (bf16_t*)(aux + O_WAT) + j * 4096, 64, 0, 0, 0, hsm);
                    else { j -= 16; transpose_tile(P.w_i + j * 4096, 64, (bf16_t*)(aux + O_WIT) + j * 4096, 64, 0, 0, 0, hsm); }
                }
                continue;
            }
            j -= 5088;
            if (j < 4096) { rownorm<false>(P.x, P.g_mix, (bf16_t*)(ws + W_U), nullptr, j * 4 + (opaque_tid() >> 6)); continue; }
            j -= 4096;
            if (j < 512) { rownorm<false>(P.mem, P.g_mem, (bf16_t*)(aux + O_MEMN), nullptr, j * 4 + (opaque_tid() >> 6)); continue; }
            j -= 512;
            rope_job((float*)(aux + O_ROPEC), (float*)(aux + O_ROPES), j);
        }
    } else if (PH == 1) {
        { PEpiMemKV ep; ep.MK = (bf16_t*)(aux + O_MEMK); ep.MVT = (bf16_t*)(aux + O_MEMVT);
          RUN_PG8(PEpiMemKV, ep, (const bf16_t*)(aux + O_MEMN), 1024, (const bf16_t*)(aux + O_WTMKV), 1024, 2048, 512, 1024) }
        { PEpiZA ep; ep.ZA = ZA; ep.VST = (bf16_t*)(ws + W_VST); ep.VWT = (bf16_t*)(ws + W_VWT); ep.ropec = (const float*)(aux + O_ROPEC); ep.ropes = (const float*)(aux + O_ROPES);
          RUN_PG8(PEpiZA, ep, (const bf16_t*)(ws + W_U), 1024, (const bf16_t*)(aux + O_WTA), 1024, 16384, 5120, 1024) }
    } else if (PH == 2) {
        for (int job = bid; job < 32 + 256 + 256; job += nb) {
            if (job < 32) {
                const int which = job >> 4, pm = job & 15;
                float* sPos = (float*)(smem + 73728);
                __syncthreads();
                if (threadIdx.x < 256) { const float* pg = which ? P.cpv : P.cpk; const int t8 = threadIdx.x * 8; *(float4*)(sPos + t8) = *(const float4*)(pg + t8); *(float4*)(sPos + t8 + 4) = *(const float4*)(pg + t8 + 4); }
                ALCmp al; al.ZA = ZA; al.spos = sPos; al.colbase = which ? C_VC : C_KC;
                EpiHid ep{(bf16_t*)(aux + (which ? O_HIDV : O_HIDK))};
                gemm_tile<8, 4, true>(al, (const bf16_t*)(aux + (which ? O_WTCV1 : O_WTCK1)), 2048, 64, 2048, pm, 0, ep, smem);
            } else if (job < 288) rnn_job(P, 2 * (job - 32) + sub, hsm, DRY);
            else xattn_job(P, 2 * (job - 288) + sub, hsm, DRY);
        }
    } else if (PH == 3) {
        for (int pj = bid; pj < 1016; pj += nb) cmp2_job(P, 2 * pj + sub);
    } else if (PH == 4) {
        for (int job = bid; job < 1024; job += nb) nsa_job(P, 2 * job + sub, hsm, DRY);
        if (!DRY) { PEpiBf<0> ep; ep.O = (bf16_t*)(ws + W_YX); ep.ldo = 1024;
          RUN_PG8(PEpiBf<0>, ep, ZA + C_QX, ZW, (const bf16_t*)(aux + O_WTXO), 256, 16384, 1024, 256) }
    } else if (PH == 5) {
        { PEpiMerge ep; ep.ZA = ZA; ep.YX = (const bf16_t*)(ws + W_YX); ep.Y = (bf16_t*)(ws + W_Y);
          RUN_PG8(PEpiMerge, ep, (const bf16_t*)(ws + W_U), 1024, (const bf16_t*)(aux + O_WTB), 1024, 16384, 4096, 1024) }
    } else if (PH == 6) {
        { PEpiRes ep; ep.R = P.x; ep.O = (float*)(ws + W_H);
          RUN_PG8(PEpiRes, ep, (const bf16_t*)(ws + W_Y), 1024, (const bf16_t*)(aux + O_WTO), 1024, 16384, 1024, 1024) }
    } else if (PH == 7) {
        for (int pj = bid; pj < 2048; pj += nb) rownorm<false>((const float*)(ws + W_H), P.g_mlp, (bf16_t*)(ws + W_VN), nullptr, (2 * pj + sub) * 4 + (opaque_tid() >> 6));
    } else if (PH == 8) {
        { PEpiBf<1> ep; ep.O = (bf16_t*)(ws + W_HID); ep.ldo = 4096;
          RUN_PG8(PEpiBf<1>, ep, (const bf16_t*)(ws + W_VN), 1024, (const bf16_t*)(aux + O_WTUP), 1024, 16384, 4096, 1024) }
    } else if (PH == 9) {
        { PEpiRes ep; ep.R = (const float*)(ws + W_H); ep.O = (float*)(ws + W_H);
          RUN_PG8(PEpiRes, ep, (const bf16_t*)(ws + W_HID), 4096, (const bf16_t*)(aux + O_WTDN), 4096, 16384, 1024, 4096) }
    } else if (PH == 10) {
        for (int pj = bid; pj < 2048; pj += nb) rownorm<true>((const float*)(ws + W_H), P.g_final, nullptr, P.out, (2 * pj + sub) * 4 + (opaque_tid() >> 6));
    }
}

__global__ void __launch_bounds__(512, 2) mega_kernel(Params P) {
    char* smem = dyn_smem;
    cg::grid_group grid = cg::this_grid();
    __shared__ uint4 xb_words;
    if (threadIdx.x == 0) xb_words = make_uint4(0u, 0u, 0u, 0u);
    __syncthreads();
    XcdBarrier xb = xcd_barrier_post((unsigned*)(P.ws + W_BAR), (volatile LAS unsigned*)&xb_words);
    if (P.ws == nullptr) grid.sync();
#ifndef REP
#define REP -1
#endif
#define GSYNC() xcd_barrier(xb)
#define PHASE(k) { if (REP == k && k != 9) { run_phase<k, true>(P, smem); GSYNC(); } run_phase<k>(P, smem); GSYNC(); }
    PHASE(0) PHASE(1) PHASE(2) PHASE(3) PHASE(4) PHASE(5) PHASE(6) PHASE(7) PHASE(8) PHASE(9)
    if (REP == 10) { run_phase<10>(P, smem); GSYNC(); }
    if (REP == 11) { GSYNC(); GSYNC(); GSYNC(); GSYNC(); GSYNC(); GSYNC(); GSYNC(); GSYNC(); GSYNC(); GSYNC(); }
    run_phase<10>(P, smem);
}

extern "C" void kernel_launch(void* const* d_in, const int* in_sizes, int n_in, void* d_out, int out_size, void* d_ws, size_t ws_size,
                              hipStream_t stream) {
    Params P{};
    const float** pp = (const float**)&P;
    for (int i = 0; i < 25; ++i) pp[i] = (const float*)d_in[i];
    P.out = (float*)d_out;
    P.ws = (char*)d_ws;
    static int grid_blocks = 0;
    if (!grid_blocks) {
        int dev = 0, cus = 0, per_cu = 0;
        hipGetDevice(&dev);
        hipDeviceGetAttribute(&cus, hipDeviceAttributeMultiprocessorCount, dev);
        hipFuncSetAttribute((const void*)mega_kernel, hipFuncAttributeMaxDynamicSharedMemorySize, SMEM_BYTES);
        hipOccupancyMaxActiveBlocksPerMultiprocessor(&per_cu, mega_kernel, 512, SMEM_BYTES);
        if (per_cu > 1) per_cu = 1;
        if (per_cu < 1) per_cu = 1;
        grid_blocks = cus * per_cu;
    }
    hipMemsetAsync((char*)d_ws + W_BAR, 0, XCD_BAR_WORDS * 4, stream);
    void* args[] = {&P};
    hipError_t e = hipLaunchCooperativeKernel((void*)mega_kernel, dim3(grid_blocks), dim3(512), args, SMEM_BYTES, stream);
    if (e != hipSuccess) fprintf(stderr, "cooperative launch failed: %s (grid %d)\n", hipGetErrorString(e), grid_blocks);
}
```

```cpp
#include <hip/hip_runtime.h>
#include <hip/hip_cooperative_groups.h>
#include <cstdint>
#include <cstdio>
namespace cg = cooperative_groups;

#ifndef MULTI
#define MULTI 0
#endif

typedef unsigned short bf16_t;
typedef short bf16x8 __attribute__((ext_vector_type(8)));
typedef float f32x4 __attribute__((ext_vector_type(4)));
typedef __bf16 bfv2 __attribute__((ext_vector_type(2)));
typedef float f32x2 __attribute__((ext_vector_type(2)));
typedef unsigned u32x4 __attribute__((ext_vector_type(4)));
typedef unsigned u32x2 __attribute__((ext_vector_type(2)));
#define DEV __device__ __forceinline__
DEV int opaque_tid() { int t = threadIdx.x & 255; asm volatile("" : "+v"(t)); return t; }
DEV int opaque_tid512() { int t = threadIdx.x; asm volatile("" : "+v"(t)); return t; }
#define MFMA16(a, b, c) __builtin_amdgcn_mfma_f32_16x16x32_bf16((a), (b), (c), 0, 0, 0)

constexpr int T = 16384, S = 2048;
constexpr int ZW = 4480;
constexpr int C_Q = 0, C_KC = 1024, C_VC = 1280, C_KS = 1536, C_KW = 1792, C_XR = 2048, C_GR = 3072, C_QX = 4096, C_G = 4352;
constexpr int NCMP = 127;
constexpr int NCROWS = 4064;

constexpr size_t O_WTA = 0;
constexpr size_t O_WTB = O_WTA + (size_t)5120 * 1024 * 2;
constexpr size_t O_WTUP = O_WTB + (size_t)4096 * 1024 * 2;
constexpr size_t O_WTDN = O_WTUP + (size_t)4096 * 1024 * 2;
constexpr size_t O_WTO = O_WTDN + (size_t)4096 * 1024 * 2;
constexpr size_t O_WTXO = O_WTO + (size_t)1024 * 1024 * 2;
constexpr size_t O_WTMKV = O_WTXO + (size_t)1024 * 256 * 2;
constexpr size_t O_WTCK1 = O_WTMKV + (size_t)512 * 1024 * 2;
constexpr size_t O_WTCV1 = O_WTCK1 + (size_t)256 * 2048 * 2;
constexpr size_t O_WAT = O_WTCV1 + (size_t)256 * 2048 * 2;
constexpr size_t O_WIT = O_WAT + (size_t)16 * 64 * 64 * 2;
constexpr size_t O_ROPEC = O_WIT + (size_t)16 * 64 * 64 * 2;
constexpr size_t O_ROPES = O_ROPEC + (size_t)2048 * 8 * 4;
constexpr size_t O_MEMN = O_ROPES + (size_t)2048 * 8 * 4;
constexpr size_t O_MEMK = O_MEMN + (size_t)2048 * 1024 * 2;
constexpr size_t O_MEMVT = O_MEMK + (size_t)2048 * 256 * 2;
constexpr size_t O_HIDK = O_MEMVT + (size_t)2048 * 256 * 2;
constexpr size_t O_HIDV = O_HIDK + (size_t)4096 * 256 * 2;
constexpr size_t O_KC = O_HIDV + (size_t)4096 * 256 * 2;
constexpr size_t O_VCT = O_KC + (size_t)32 * 128 * 64 * 2;
constexpr size_t O_PB = O_VCT + (size_t)32 * 64 * 128 * 2;
constexpr size_t O_AUX_END = O_PB + 16384;
static_assert(O_AUX_END <= (size_t)64 << 20, "aux overflow");
constexpr size_t MiB = (size_t)1 << 20;
constexpr size_t W_U = 0, W_ZA = 32 * MiB, W_VST = 172 * MiB, W_VWT = 180 * MiB, W_YX = 188 * MiB, W_Y = 220 * MiB;
constexpr size_t W_H = 32 * MiB, W_VN = 0, W_HID = 96 * MiB;

struct Params {
    const float *x, *mem, *g_mix, *w_in, *cpk, *cpv, *wk1, *wk2, *wv1, *wv2, *conv_w, *conv_b, *w_a, *b_a, *w_i, *b_i, *lam,
        *g_mem, *w_mkv, *w_xo, *w_o, *g_mlp, *w_up, *w_down, *g_final;
    float* out;
    char* ws;
};

DEV float bf2f(bf16_t h) { return __uint_as_float(((unsigned)h) << 16); }
DEV unsigned pk2(float lo, float hi) { f32x2 v = {lo, hi}; bfv2 b = __builtin_convertvector(v, bfv2); return __builtin_bit_cast(unsigned, b); }
DEV bf16_t f2bf(float f) { return (bf16_t)(pk2(f, 0.f) & 0xffffu); }
DEV float lo_f(unsigned u) { return __uint_as_float(u << 16); }
DEV float hi_f(unsigned u) { return __uint_as_float(u & 0xffff0000u); }
DEV float sigm(float x) { return __builtin_amdgcn_rcpf(1.f + __expf(-x)); }
DEV float gelu_t(float x) {
    float y = 0.7978845608028654f * (x + 0.044715f * x * x * x);
    float e = __expf(2.f * y);
    float th = 1.f - 2.f * __builtin_amdgcn_rcpf(1.f + e);
    return 0.5f * x * (1.f + th);
}
DEV float wave_sum(float v) {
#pragma unroll
    for (int o = 32; o >= 1; o >>= 1) v += __shfl_xor(v, o);
    return v;
}

DEV int map_col(int mapid, int r) {
    if (mapid == 0) return r;
    if (mapid == 1) {
        if (r < 1536) return r;
        if (r < 1792) return 1536 + (r - 1536);
        if (r < 2048) return 2048 + (r - 1792);
        if (r < 3072) return 2608 + (r - 2048);
        if (r < 4096) return 3632 + (r - 3072);
        if (r < 4352) return 4656 + (r - 4096);
        if (r < 4608) return 1792 + (r - 4352);
        if (r < 4864) return 2304 + (r - 4608);
        if (r < 4912) return 2560 + (r - 4864);
        return -1;
    }
    const int pn = r >> 8, rem = r & 255, bj = rem >> 7, wc = (rem >> 5) & 3, n = (rem >> 4) & 1, c16 = rem & 15, slot = 2 * bj + n;
    if (slot == 3) return -1;
    return 4912 + slot * 1024 + pn * 64 + wc * 16 + c16;
}

DEV void transpose_tile(const float* __restrict__ src, int ld, bf16_t* __restrict__ dst, int K, int r0, int k0, int mapid, char* smem, int nblk = 0) {
    float* sm = (float*)smem;
    const int tid = threadIdx.x & 255, lane = tid & 63, w = tid >> 6;
    __syncthreads();
    const int sc = map_col(mapid, r0 + lane);
#pragma unroll
    for (int i = 0; i < 16; ++i) {
        int kk = w + 4 * i;
        float v = sc >= 0 ? src[(size_t)(k0 + kk) * ld + sc] : 0.f;
        sm[kk * 65 + lane] = v;
    }
    __syncthreads();
    const int rr = tid >> 2, kq = (tid & 3) * 16;
    unsigned o[8];
#pragma unroll
    for (int e = 0; e < 8; ++e) o[e] = pk2(sm[(kq + 2 * e) * 65 + rr], sm[(kq + 2 * e + 1) * 65 + rr]);
    uint4* dp = nblk ? (uint4*)(dst + (size_t)(k0 >> 6) * nblk * 64 + (size_t)(r0 + rr) * 64 + kq) : (uint4*)(dst + (size_t)(r0 + rr) * K + k0 + kq);
    dp[0] = make_uint4(o[0], o[1], o[2], o[3]);
    dp[1] = make_uint4(o[4], o[5], o[6], o[7]);
}

template <bool OUTF32>
DEV void rownorm(const float* __restrict__ src, const float* __restrict__ g, bf16_t* dstb, float* dstf, int row, bool blk = false) {
    const int lane = opaque_tid() & 63;
    const float4* sp = (const float4*)(src + (size_t)row * 1024);
    float4 v[4];
    float ss = 0.f;
#pragma unroll
    for (int i = 0; i < 4; ++i) { v[i] = sp[lane + 64 * i]; ss += v[i].x * v[i].x + v[i].y * v[i].y + v[i].z * v[i].z + v[i].w * v[i].w; }
    ss = wave_sum(ss);
    const float r = rsqrtf(ss * (1.0f / 1024.0f) + 1e-6f);
#pragma unroll
    for (int i = 0; i < 4; ++i) {
        float4 gg = ((const float4*)g)[lane + 64 * i];
        float a = v[i].x * r * gg.x, b = v[i].y * r * gg.y, c = v[i].z * r * gg.z, d = v[i].w * r * gg.w;
        if (OUTF32) ((float4*)(dstf + (size_t)row * 1024))[lane + 64 * i] = make_float4(a, b, c, d);
        else if (blk) { const int col = 4 * (lane + 64 * i); *(uint2*)(dstb + (size_t)(col >> 6) * ((size_t)16384 * 64) + (size_t)row * 64 + (col & 63)) = make_uint2(pk2(a, b), pk2(c, d)); }
        else ((uint2*)(dstb + (size_t)row * 1024))[lane + 64 * i] = make_uint2(pk2(a, b), pk2(c, d));
    }
}

DEV void rope_job(float* ct, float* st, int job) {
    const int e = job * 256 + (threadIdx.x & 255);
    const int pos = e >> 3, i = e & 7;
    const double inv = exp(-(double)i * 0.125 * 13.122363377404328);
    const double ang = (double)pos * inv;
    const double kq = rint(ang * 0.6366197723675814);
    const double r = ang - kq * 1.5707963267948966;
    const double r2 = r * r;
    const double sn = r * (1.0 + r2 * (-1.0 / 6 + r2 * (1.0 / 120 + r2 * (-1.0 / 5040 + r2 * (1.0 / 362880 + r2 * (-1.0 / 39916800 + r2 * (1.0 / 6227020800.0)))))));
    const double cs = 1.0 + r2 * (-0.5 + r2 * (1.0 / 24 + r2 * (-1.0 / 720 + r2 * (1.0 / 40320 + r2 * (-1.0 / 3628800 + r2 * (1.0 / 479001600.0))))));
    const int q = ((int)kq) & 3;
    double s_, c_;
    if (q == 0) { s_ = sn; c_ = cs; } else if (q == 1) { s_ = cs; c_ = -sn; } else if (q == 2) { s_ = -sn; c_ = -cs; } else { s_ = -cs; c_ = sn; }
    ct[e] = (float)c_; st[e] = (float)s_;
}

DEV void posbias_job(const Params& P, float* PB, int job, char* smem) {
    float* sred = (float*)smem;
    const int tid = opaque_tid(), which = job >> 5, cgi = (job >> 3) & 3, kc = job & 7, c = cgi * 64 + (tid & 63), kp = tid >> 6;
    const float* pos = (which ? P.cpv : P.cpk) + kc * 256 + kp * 64;
    const float* w1 = (which ? P.wv1 : P.wk1) + (size_t)(kc * 256 + kp * 64) * 256 + c;
    float a0 = 0.f, a1 = 0.f, a2 = 0.f, a3 = 0.f;
#pragma unroll 4
    for (int k = 0; k < 64; k += 4) {
        a0 += pos[k] * w1[(size_t)k * 256]; a1 += pos[k + 1] * w1[(size_t)(k + 1) * 256];
        a2 += pos[k + 2] * w1[(size_t)(k + 2) * 256]; a3 += pos[k + 3] * w1[(size_t)(k + 3) * 256];
    }
    __syncthreads();
    sred[kp * 64 + (tid & 63)] = (a0 + a1) + (a2 + a3);
    __syncthreads();
    if (tid < 64) PB[(which * 8 + kc) * 256 + c] = (sred[tid] + sred[64 + tid]) + (sred[128 + tid] + sred[192 + tid]);
}

struct ALPlain {
    const bf16_t* A; int lda; int ks;
    const char* base; unsigned off0;
    DEV void init(int row0, int lrow, int lk) { base = (const char*)(A + (size_t)row0 * lda); off0 = (unsigned)(lrow * lda + lk) * 2u; }
    DEV u32x4 load(int i, int k0) const { return *(const u32x4*)(base + (off0 + (unsigned)(i * 128 * lda) + (unsigned)(k0 >> 6) * (unsigned)(ks * 2))); }
    DEV u32x4 fix(int, const u32x4& v, int) const { return v; }
};
struct ALCmp {
    const bf16_t* ZA; const float* spos; int colbase;
    unsigned roff[4]; int lk_;
    DEV void init(int row0, int lrow, int lk) {
        lk_ = lk;
#pragma unroll
        for (int i = 0; i < 4; ++i) {
            const int row = row0 + lrow + 64 * i;
            const int bg = row / NCMP, n = row - bg * NCMP, b = bg >> 2, g = bg & 3;
            roff[i] = row < NCROWS ? (unsigned)(((b * S + 16 * n) * ZW + colbase + g * 64 + lk) * 2) : 0xffffffffu;
        }
    }
    DEV u32x4 load(int i, int k0) const {
        if (roff[i] == 0xffffffffu) return (u32x4){0u, 0u, 0u, 0u};
        return *(const u32x4*)((const char*)ZA + (roff[i] + (unsigned)((k0 >> 6) * ZW * 2)));
    }
    DEV u32x4 fix(int i, const u32x4& v, int k0) const {
        if (roff[i] == 0xffffffffu) return v;
        const float4 p0 = *(const float4*)(spos + k0 + lk_), p1 = *(const float4*)(spos + k0 + lk_ + 4);
        u32x4 o;
        o.x = pk2(lo_f(v.x) + p0.x, hi_f(v.x) + p0.y); o.y = pk2(lo_f(v.y) + p0.z, hi_f(v.y) + p0.w);
        o.z = pk2(lo_f(v.z) + p1.x, hi_f(v.z) + p1.y); o.w = pk2(lo_f(v.w) + p1.z, hi_f(v.w) + p1.w);
        return o;
    }
};

template <int TM, int TN, bool SWAP, class AL, class EP>
DEV void gemm_tile(AL al, const bf16_t* __restrict__ Bt, int ldb, int bks, int K, int pm, int pn, const EP& ep, char* smem) {
    constexpr int BM = TM * 32, BN = TN * 64, NA = BM / 64, NBB = (BN + 63) / 64;
    bf16_t* sA = (bf16_t*)smem;
    bf16_t* sB = sA + BM * 72;
    const int tid = opaque_tid512(), wid = tid >> 6, lane = tid & 63, wr = wid >> 2, wc = wid & 3, fr = lane & 15, fq = lane >> 4;
    f32x4 acc[TM][TN];
#pragma unroll
    for (int m = 0; m < TM; ++m)
#pragma unroll
        for (int n = 0; n < TN; ++n) acc[m][n] = (f32x4){0.f, 0.f, 0.f, 0.f};
    const int lrow = tid >> 3, lk = (tid & 7) * 8;
    u32x4 ra[NA], rb[NBB];
    al.init(pm * BM, lrow, lk);
    const char* bbase = (const char*)(Bt + (size_t)(pn * BN) * ldb);
    const unsigned boff = (unsigned)(lrow * ldb + lk) * 2u;
#pragma unroll
    for (int i = 0; i < NBB; ++i) rb[i] = (u32x4){0u, 0u, 0u, 0u};
#pragma unroll
    for (int i = 0; i < NA; ++i) ra[i] = al.load(i, 0);
#pragma unroll
    for (int i = 0; i < NBB; ++i) if (BN % 64 == 0 || lrow + 64 * i < BN) rb[i] = *(const u32x4*)(bbase + (boff + (unsigned)(i * 128 * ldb)));
    int nk = K >> 6;
    asm volatile("" : "+s"(nk));
    bf16_t* sWa = sA + lrow * 72 + lk;
    bf16_t* sWb = sB + lrow * 72 + lk;
    const bf16_t* sAr = sA + (wr * TM * 16 + fr) * 72 + fq * 8;
    const bf16_t* sBr = sB + (wc * TN * 16 + fr) * 72 + fq * 8;
#pragma unroll 1
    for (int kt = 0; kt < nk; ++kt) {
        __syncthreads();
#pragma unroll
        for (int i = 0; i < NA; ++i) *(u32x4*)(sWa + (64 * i) * 72) = al.fix(i, ra[i], kt * 64);
#pragma unroll
        for (int i = 0; i < NBB; ++i) if (BN % 64 == 0 || lrow + 64 * i < BN) *(u32x4*)(sWb + (64 * i) * 72) = rb[i];
        __syncthreads();
        if (kt + 1 < nk) {
            const int k0 = (kt + 1) * 64;
#pragma unroll
            for (int i = 0; i < NA; ++i) ra[i] = al.load(i, k0);
#pragma unroll
            for (int i = 0; i < NBB; ++i) if (BN % 64 == 0 || lrow + 64 * i < BN) rb[i] = *(const u32x4*)(bbase + (boff + (unsigned)(i * 128 * ldb) + (unsigned)(k0 >> 6) * (unsigned)(bks * 2)));
        }
        __builtin_amdgcn_sched_barrier(0);
        __builtin_amdgcn_s_setprio(1);
#pragma unroll
        for (int ks = 0; ks < 2; ++ks) {
            bf16x8 bfr[TN];
#pragma unroll
            for (int n = 0; n < TN; ++n) bfr[n] = *(const bf16x8*)(sBr + (n * 16) * 72 + ks * 32);
#pragma unroll
            for (int m = 0; m < TM; ++m) {
                const bf16x8 af = *(const bf16x8*)(sAr + (m * 16) * 72 + ks * 32);
#pragma unroll
                for (int n = 0; n < TN; ++n) acc[m][n] = SWAP ? MFMA16(bfr[n], af, acc[m][n]) : MFMA16(af, bfr[n], acc[m][n]);
            }
        }
        __builtin_amdgcn_s_setprio(0);
    }
    ep.run(acc, pm * BM + wr * TM * 16, pn * BN + wc * TN * 16, fr, fq);
}

DEV uint2 pk4(const f32x4& a) { return make_uint2(pk2(a[0], a[1]), pk2(a[2], a[3])); }

namespace pg8 {
#define PG8_LAS __attribute__((address_space(3)))
typedef unsigned short bf16_t;
typedef short bf16x8 __attribute__((ext_vector_type(8)));
typedef float f32x4 __attribute__((ext_vector_type(4)));
typedef unsigned u32x4 __attribute__((ext_vector_type(4)));
constexpr int BM = 256, BK = 64, HALF = 128, HTB = HALF * BK * 2  , STAGE_BYTES = 8 * HTB, NXCD = 8, WGM = 8;

__host__ __device__ __forceinline__ int lds_byte(int r, int c) { const int st = (r >> 4) * 2 + (c >> 5), rr = r & 15, cc = c & 31, ob = rr * 64 + cc * 2; return st * 1024 + (ob ^ (((ob >> 9) & 1) << 5)); }
__host__ __device__ __forceinline__ void stage_rc(int b, int& R, int& C) { const int st = b / 1024, sb = b % 1024, swz = sb ^ (((sb >> 9) & 1) << 5); R = (st >> 1) * 16 + swz / 64; C = (st & 1) * 32 + (swz % 64) / 2; }
__host__ __device__ __forceinline__ int perm32(int rho) { const int n = rho >> 4, i = rho & 15; return 8 * (i >> 2) + 4 * n + (i & 3); }

struct Unit { int pm, pn; };
struct Gemm { const bf16_t* A; const bf16_t* Bt; int M, N, K, lda, ldb; int gather; };

struct StaticOrder {
    int nM, nN, nwg, G, c;
    __host__ __device__ void init(int M, int N, int G_, int c_) { nM = M / BM; nN = N / BM; nwg = nM * nN; G = G_; c = c_; }
    __host__ __device__ bool next(int i, Unit& u) const {
        const long L = (long)i * G + c; if (L >= nwg) return false;
        int wgid = (int)L; { const int q = nwg / NXCD, r = nwg % NXCD, xcd = wgid % NXCD, off = wgid / NXCD; wgid = (xcd < r ? xcd * (q + 1) : r * (q + 1) + (xcd - r) * q) + off; }
        const int nig = WGM * nN, gid = wgid / nig, fm = gid * WGM, gsz = (nM - fm) < WGM ? (nM - fm) : WGM;
        u.pm = fm + ((wgid % nig) % gsz); u.pn = (wgid % nig) / gsz; return true;
    }
    __device__ __forceinline__ void a_ready(const Unit&) const {}
    __device__ __forceinline__ void done(const Unit&) const {}
};

template <class Epi, class Sched, bool ALIGN_EPI = false, bool SP2 = false>
__device__ __forceinline__ void gemm_phase(PG8_LAS unsigned char* lds, const Gemm g, const Sched& S, const Epi& E) {
    const int tid = opaque_tid512(), wid = __builtin_amdgcn_readfirstlane(tid >> 6), lane = tid & 63, wr = wid >> 2, wc = wid & 3, fr = lane & 15, fq = lane >> 4;
    const int K = g.K, nt = K / BK;
    unsigned voffA2[2][2], voffB[2];
#pragma unroll
    for (int i = 0; i < 2; ++i) { int R, C; stage_rc(tid * 16 + i * 8192, R, C); const int Rb = Epi::PERM ? ((R & ~31) + perm32(R & 31)) : R;
        voffA2[0][i] = (unsigned)(R * g.lda + C) * 2u; voffA2[1][i] = voffA2[0][i]; voffB[i] = (unsigned)(Rb * g.ldb + C) * 2u; }
    const size_t kstepB = (size_t)(BK * 2), kstepA = g.gather ? (size_t)(ZW * 2) : kstepB;
    const size_t hstepA = g.gather ? (size_t)0 : (size_t)HALF * g.lda * 2, hstepB = (size_t)HALF * g.ldb * 2;
    const size_t tstepA = 2 * hstepA, tstepB = 2 * hstepB;
    const unsigned ldsw = (unsigned)wid * 1024u;
    const int aoff = lds_byte(wr * 64 + fr, fq * 8), boff = lds_byte(wc * 32 + fr, fq * 8);
#define PG8_SA(b, h) (((b) * 2 + (h)) * HTB)
#define PG8_SB(b, h) ((4 + (b) * 2 + (h)) * HTB)
#define PG8_STAGE(bufoff, gbase, voff) do { _Pragma("unroll") for (int _i = 0; _i < 2; ++_i) \
        __builtin_amdgcn_global_load_lds((const unsigned*)((const char*)(gbase) + (voff)[_i]), (PG8_LAS unsigned*)(lds + (bufoff) + ldsw + _i * 8192), 16, 0, 0); } while (0)
#define PG8_LDA(dst, b, h) do { _Pragma("unroll") for (int m = 0; m < 4; ++m) _Pragma("unroll") for (int k = 0; k < 2; ++k) dst[m][k] = *(const PG8_LAS bf16x8*)(lds + PG8_SA(b, h) + aoff + m * 2048 + k * 1024); } while (0)
#define PG8_LDB(dst, b, h) do { _Pragma("unroll") for (int n = 0; n < 2; ++n) _Pragma("unroll") for (int k = 0; k < 2; ++k) dst[n][k] = *(const PG8_LAS bf16x8*)(lds + PG8_SB(b, h) + boff + n * 2048 + k * 1024); } while (0)
#define PG8_MMA(ai, bj, At, Bt) do { __builtin_amdgcn_s_setprio(1); _Pragma("unroll") for (int m = 0; m < 4; ++m) _Pragma("unroll") for (int n = 0; n < 2; ++n) _Pragma("unroll") for (int k = 0; k < 2; ++k) \
        acc[ai][bj][m][n] = __builtin_amdgcn_mfma_f32_16x16x32_bf16(Bt[n][k], At[m][k], acc[ai][bj][m][n], 0, 0, 0); __builtin_amdgcn_s_setprio(0); } while (0)
#define PG8_WAIT_V(n) asm volatile("s_waitcnt vmcnt(" #n ")" ::: "memory")
#define PG8_WAIT_L(n) asm volatile("s_waitcnt lgkmcnt(" #n ")" ::: "memory")
#define PG8_BAR __builtin_amdgcn_s_barrier()
#define PG8_SCHED __builtin_amdgcn_sched_barrier(0)
    Unit cur, nxt; int ui = 0;
    if (!S.next(0, cur)) return;
    f32x4 acc[2][2][4][2];
#pragma unroll
    for (int a = 0; a < 2; ++a)
#pragma unroll
        for (int b = 0; b < 2; ++b)
#pragma unroll
            for (int m = 0; m < 4; ++m)
#pragma unroll
                for (int n = 0; n < 2; ++n) acc[a][b][m][n] = (f32x4){0.f, 0.f, 0.f, 0.f};
    bf16x8 At[4][2], B0[2][2], B1[2][2];
    const char* cA = (const char*)g.A + (g.gather ? (size_t)0 : (size_t)cur.pm * tstepA); const char* cB = (const char*)g.Bt + (size_t)cur.pn * tstepB;
    if (g.gather) {
#pragma unroll
        for (int h = 0; h < 2; ++h)
#pragma unroll
            for (int i = 0; i < 2; ++i) { int R, C; stage_rc(tid * 16 + i * 8192, R, C);
                int r = cur.pm * 256 + h * HALF + R; r = r < NCROWS ? r : NCROWS - 1;
                const int bg = r / NCMP, n = r - bg * NCMP;
                voffA2[h][i] = (unsigned)((((bg >> 2) * ::S + 16 * n) * ZW + (cur.pn ? C_VC : C_KC) + (bg & 3) * 64 + C) * 2); }
    }
    S.a_ready(cur);
    if constexpr (SP2) {
        PG8_STAGE(PG8_SB(0, 0), cB, voffB); PG8_STAGE(PG8_SB(0, 1), cB + hstepB, voffB); PG8_STAGE(PG8_SA(0, 0), cA, voffA2[0]); PG8_STAGE(PG8_SA(0, 1), cA + hstepA, voffA2[1]);
        if (wr == 1) PG8_BAR;
        PG8_WAIT_V(2); PG8_BAR;
        PG8_STAGE(PG8_SB(1, 0), cB + kstepB, voffB); PG8_STAGE(PG8_SA(1, 0), cA + kstepA, voffA2[0]); PG8_STAGE(PG8_SB(1, 1), cB + hstepB + kstepB, voffB);
        PG8_WAIT_V(6); PG8_BAR;
    } else {
        PG8_STAGE(PG8_SB(0, 0), cB, voffB); PG8_STAGE(PG8_SA(0, 0), cA, voffA2[0]); PG8_STAGE(PG8_SB(0, 1), cB + hstepB, voffB); PG8_STAGE(PG8_SA(0, 1), cA + hstepA, voffA2[1]);
        if (wr == 1) PG8_BAR;
        PG8_WAIT_V(4); PG8_BAR;
        PG8_STAGE(PG8_SB(1, 0), cB + kstepB, voffB); PG8_STAGE(PG8_SA(1, 0), cA + kstepA, voffA2[0]); PG8_STAGE(PG8_SB(1, 1), cB + hstepB + kstepB, voffB);
        PG8_WAIT_V(6); PG8_BAR;
    }
    for (;;) {
        const bool has_next = S.next(ui + 1, nxt);
        const char* nA = has_next ? (const char*)g.A + (size_t)nxt.pm * tstepA : cA; const char* nB = has_next ? (const char*)g.Bt + (size_t)nxt.pn * tstepB : cB;
        for (int t = 0; t < nt; t += 2) {
            const bool last = (t == nt - 2);
            const char* a1 = cA + (size_t)(t + 1) * kstepA;
            const char* a2 = last ? nA : cA + (size_t)(t + 2) * kstepA; const char* b2 = last ? nB : cB + (size_t)(t + 2) * kstepB;
            const char* a3 = a2 + kstepA; const char* b3 = b2 + kstepB;
            if (last && has_next) S.a_ready(nxt);
            if constexpr (SP2) {
            PG8_LDB(B0, 0, 0); PG8_LDB(B1, 0, 1); PG8_SCHED; PG8_LDA(At, 0, 0); PG8_STAGE(PG8_SA(1, 1), a1 + hstepA, voffA2[1]);
            PG8_WAIT_V(8); PG8_WAIT_L(0); PG8_BAR; PG8_MMA(0, 0, At, B0); PG8_MMA(0, 1, At, B1); PG8_BAR; PG8_SCHED;
            PG8_LDA(At, 0, 1); PG8_STAGE(PG8_SB(0, 0), b2, voffB); PG8_STAGE(PG8_SB(0, 1), b2 + hstepB, voffB); PG8_STAGE(PG8_SA(0, 0), a2, voffA2[0]);
            PG8_WAIT_V(8); PG8_WAIT_L(0); PG8_BAR; PG8_MMA(1, 0, At, B0); PG8_MMA(1, 1, At, B1); PG8_BAR; PG8_SCHED;
            PG8_LDB(B0, 1, 0); PG8_LDB(B1, 1, 1); PG8_SCHED; PG8_LDA(At, 1, 0); PG8_STAGE(PG8_SA(0, 1), a2 + hstepA, voffA2[1]);
            PG8_WAIT_V(8); PG8_WAIT_L(0); PG8_BAR; PG8_MMA(0, 0, At, B0); PG8_MMA(0, 1, At, B1); PG8_BAR; PG8_SCHED;
            PG8_LDA(At, 1, 1); PG8_STAGE(PG8_SB(1, 0), b3, voffB); PG8_STAGE(PG8_SB(1, 1), b3 + hstepB, voffB); PG8_STAGE(PG8_SA(1, 0), a3, voffA2[0]);
            PG8_WAIT_V(8); PG8_WAIT_L(0); PG8_BAR; PG8_MMA(1, 0, At, B0); PG8_MMA(1, 1, At, B1); PG8_BAR; PG8_SCHED;
            } else {
            PG8_LDB(B0, 0, 0); PG8_SCHED; PG8_LDA(At, 0, 0); PG8_STAGE(PG8_SA(1, 1), a1 + hstepA, voffA2[1]);
            PG8_WAIT_L(8); PG8_BAR; PG8_WAIT_L(0); PG8_MMA(0, 0, At, B0); PG8_BAR; PG8_SCHED;
            PG8_LDB(B1, 0, 1); PG8_STAGE(PG8_SB(0, 0), b2, voffB);
            PG8_BAR; PG8_WAIT_L(0); PG8_MMA(0, 1, At, B1); PG8_BAR;
            PG8_LDA(At, 0, 1); PG8_STAGE(PG8_SA(0, 0), a2, voffA2[0]);
            PG8_BAR; PG8_WAIT_L(0); PG8_MMA(1, 0, At, B0); PG8_BAR; PG8_SCHED;
            PG8_STAGE(PG8_SB(0, 1), b2 + hstepB, voffB);
            PG8_WAIT_V(6); PG8_BAR; PG8_MMA(1, 1, At, B1); PG8_BAR;
            PG8_LDB(B0, 1, 0); PG8_SCHED; PG8_LDA(At, 1, 0); PG8_STAGE(PG8_SA(0, 1), a2 + hstepA, voffA2[1]);
            PG8_WAIT_L(8); PG8_BAR; PG8_WAIT_L(0); PG8_MMA(0, 0, At, B0); PG8_BAR; PG8_SCHED;
            PG8_LDB(B1, 1, 1); PG8_STAGE(PG8_SB(1, 0), b3, voffB);
            PG8_BAR; PG8_WAIT_L(0); PG8_MMA(0, 1, At, B1); PG8_BAR;
            PG8_LDA(At, 1, 1); PG8_STAGE(PG8_SA(1, 0), a3, voffA2[0]);
            PG8_BAR; PG8_WAIT_L(0); PG8_MMA(1, 0, At, B0); PG8_BAR; PG8_SCHED;
            PG8_STAGE(PG8_SB(1, 1), b3 + hstepB, voffB);
            PG8_WAIT_V(6); PG8_BAR; PG8_MMA(1, 1, At, B1); PG8_BAR;
            }
        }
        if constexpr (ALIGN_EPI) { if (wr == 0) PG8_BAR; }
        if constexpr (!Epi::AFTER_DRAIN) { E(acc, cur, wr, wc, fr, fq); S.done(cur); }
        if (!has_next) break;
#pragma unroll
        for (int a = 0; a < 2; ++a)
#pragma unroll
            for (int b = 0; b < 2; ++b)
#pragma unroll
                for (int m = 0; m < 4; ++m)
#pragma unroll
                    for (int n = 0; n < 2; ++n) acc[a][b][m][n] = (f32x4){0.f, 0.f, 0.f, 0.f};
        cur = nxt; cA = nA; cB = nB; ++ui;
        if constexpr (ALIGN_EPI) { if (wr == 1) PG8_BAR; }
    }
    PG8_WAIT_V(0);
    if constexpr (!ALIGN_EPI) { if (wr == 0) PG8_BAR; }
    PG8_BAR;
    if constexpr (Epi::AFTER_DRAIN) { E.fused(acc, cur, wr, wc, fr, fq, lds, wid, lane); S.done(cur); }
#undef PG8_SA
#undef PG8_SB
#undef PG8_STAGE
#undef PG8_LDA
#undef PG8_LDB
#undef PG8_MMA
#undef PG8_WAIT_V
#undef PG8_WAIT_L
#undef PG8_BAR
#undef PG8_SCHED
}
}

struct EpiHid {
    bf16_t* H;
    DEV void run(f32x4 (&acc)[8][4], int R0, int C0, int fr, int fq) const {
#pragma unroll
        for (int n = 0; n < 4; ++n)
#pragma unroll
            for (int m = 0; m < 8; ++m) {
                const int c = C0 + n * 16 + 4 * fq, r = R0 + m * 16 + fr;
                f32x4 a = acc[m][n];
#pragma unroll
                for (int j = 0; j < 4; ++j) a[j] = gelu_t(a[j]);
                if (r < NCROWS) *(uint2*)(H + (size_t)r * 256 + c) = pk4(a);
            }
    }
};
#define PG8_EPI_HEAD static constexpr bool PERM = false, AFTER_DRAIN = false;
#define PG8_FOR_TILES _Pragma("unroll") for (int ai = 0; ai < 2; ++ai) _Pragma("unroll") for (int bj = 0; bj < 2; ++bj) _Pragma("unroll") for (int m = 0; m < 4; ++m) _Pragma("unroll") for (int n = 0; n < 2; ++n)
struct PEpiZA {
    PG8_EPI_HEAD
    bf16_t *ZA, *VST, *VWT; const float *ropec, *ropes;
    DEV void operator()(const f32x4 (&acc)[2][2][4][2], const pg8::Unit& u, int wr, int wc, int fr, int fq) const {
        asm volatile("" : "+v"(fr), "+v"(fq));
        PG8_FOR_TILES {
            const int row = u.pm * 256 + ai * 128 + wr * 64 + m * 16 + fr, col0 = u.pn * 256 + bj * 128 + wc * 32 + n * 16;
            f32x4 a = acc[ai][bj][m][n];
            if (u.pn == 17 || u.pn == 18) {
                bf16_t* dst = (u.pn == 17) ? VST : VWT;
                const int c = (col0 & 255) + 4 * fq, b = row >> 11, t = row & 2047;
#pragma unroll
                for (int j = 0; j < 4; ++j) { const int cc = c + j; dst[((size_t)((b * 4 + (cc >> 6)) * 64 + (cc & 63))) * S + t] = f2bf(a[j]); }
            } else {
                const bool rope = (col0 < 1024 || (col0 >= 1536 && col0 < 2048)) && ((col0 & 63) == 0);
                if (rope) {
                    const int t = row & 2047, i0 = 4 * (fq & 1);
                    const float4 cs = *(const float4*)(ropec + t * 8 + i0), sn = *(const float4*)(ropes + t * 8 + i0);
                    const float c4[4] = {cs.x, cs.y, cs.z, cs.w}, s4[4] = {sn.x, sn.y, sn.z, sn.w};
#pragma unroll
                    for (int j = 0; j < 4; ++j) {
                        const float pr = __shfl_xor(a[j], 32);
                        a[j] = (fq & 2) ? (a[j] * c4[j] + pr * s4[j]) : (a[j] * c4[j] - pr * s4[j]);
                    }
                }
                int zc0 = col0;
                if (col0 >= 4864) {
                    zc0 = col0 - 512;
#pragma unroll
                    for (int j = 0; j < 4; ++j) a[j] = sigm(a[j]);
                }
                if (zc0 < ZW) *(uint2*)(ZA + (size_t)row * ZW + zc0 + 4 * fq) = pk4(a);
            }
        }
    }
};
struct PEpiHid {
    PG8_EPI_HEAD
    bf16_t *HK, *HV; const float* pb;
    DEV void operator()(const f32x4 (&acc)[2][2][4][2], const pg8::Unit& u, int wr, int wc, int fr, int fq) const {
        asm volatile("" : "+v"(fr), "+v"(fq));
        bf16_t* H = u.pn ? HV : HK;
        PG8_FOR_TILES {
            const int r = u.pm * 256 + ai * 128 + wr * 64 + m * 16 + fr, c = bj * 128 + wc * 32 + n * 16 + 4 * fq;
            float4 bb = *(const float4*)(pb + (u.pn * 8) * 256 + c);
#pragma unroll
            for (int kc = 1; kc < 8; ++kc) { const float4 t4 = *(const float4*)(pb + (u.pn * 8 + kc) * 256 + c); bb.x += t4.x; bb.y += t4.y; bb.z += t4.z; bb.w += t4.w; }
            f32x4 a = acc[ai][bj][m][n];
            a[0] = gelu_t(a[0] + bb.x); a[1] = gelu_t(a[1] + bb.y); a[2] = gelu_t(a[2] + bb.z); a[3] = gelu_t(a[3] + bb.w);
            if (r < NCROWS) *(uint2*)(H + (size_t)r * 256 + c) = pk4(a);
        }
    }
};
struct PEpiMemKV {
    PG8_EPI_HEAD
    bf16_t *MK, *MVT;
    DEV void operator()(const f32x4 (&acc)[2][2][4][2], const pg8::Unit& u, int wr, int wc, int fr, int fq) const {
        asm volatile("" : "+v"(fr), "+v"(fq));
        PG8_FOR_TILES {
            const int r = u.pm * 256 + ai * 128 + wr * 64 + m * 16 + fr, c = u.pn * 256 + bj * 128 + wc * 32 + n * 16 + 4 * fq;
            const int b = r >> 8, mm = r & 255;
            const f32x4 a = acc[ai][bj][m][n];
            if (u.pn == 0) { const int h = (c >> 6) & 3, d = c & 63; *(uint2*)(MK + ((size_t)(b * 4 + h) * 256 + mm) * 64 + d) = pk4(a); }
            else {
#pragma unroll
                for (int j = 0; j < 4; ++j) { const int cc = c + j, h = (cc >> 6) & 3, d = cc & 63; MVT[((size_t)(b * 4 + h) * 64 + d) * 256 + mm] = f2bf(a[j]); }
            }
        }
    }
};
template <int ACT>
struct PEpiBf {
    PG8_EPI_HEAD
    bf16_t* O; int ldo;
    DEV void operator()(const f32x4 (&acc)[2][2][4][2], const pg8::Unit& u, int wr, int wc, int fr, int fq) const {
        asm volatile("" : "+v"(fr), "+v"(fq));
        PG8_FOR_TILES {
            const int r = u.pm * 256 + ai * 128 + wr * 64 + m * 16 + fr, c = u.pn * 256 + bj * 128 + wc * 32 + n * 16 + 4 * fq;
            f32x4 a = acc[ai][bj][m][n];
            if (ACT == 1) {
#pragma unroll
                for (int j = 0; j < 4; ++j) { const float v = fmaxf(a[j], 0.f); a[j] = v * v; }
            }
            *(uint2*)(O + (size_t)r * ldo + c) = pk4(a);
        }
    }
};
struct PEpiRes {
    PG8_EPI_HEAD
    const float* R; float* O;
    DEV void operator()(const f32x4 (&acc)[2][2][4][2], const pg8::Unit& u, int wr, int wc, int fr, int fq) const {
        asm volatile("" : "+v"(fr), "+v"(fq));
        PG8_FOR_TILES {
            const size_t o = (size_t)(u.pm * 256 + ai * 128 + wr * 64 + m * 16 + fr) * 1024 + u.pn * 256 + bj * 128 + wc * 32 + n * 16 + 4 * fq;
            const f32x4 r = *(const f32x4*)(R + o);
            *(f32x4*)(O + o) = r + acc[ai][bj][m][n];
        }
    }
};
struct PEpiMerge {
    PG8_EPI_HEAD
    const bf16_t *ZA, *YX; bf16_t* Y;
    DEV void operator()(const f32x4 (&acc)[2][2][4][2], const pg8::Unit& u, int wr, int wc, int fr, int fq) const {
        asm volatile("" : "+v"(fr), "+v"(fq));
        const int ch = u.pn * 64 + wc * 16 + 4 * fq;
#pragma unroll
        for (int ai = 0; ai < 2; ++ai)
#pragma unroll
            for (int m = 0; m < 4; ++m) {
                const size_t row = (size_t)(u.pm * 256 + ai * 128 + wr * 64 + m * 16 + fr);
                const uint2 a = *(const uint2*)(ZA + row * ZW + C_Q + ch), b = *(const uint2*)(ZA + row * ZW + C_GR + ch), c = *(const uint2*)(YX + row * 1024 + ch);
                const f32x4 g0 = acc[ai][0][m][0], g1 = acc[ai][0][m][1], g2 = acc[ai][1][m][0];
                f32x4 y;
                y[0] = sigm(g0[0]) * lo_f(a.x) + sigm(g1[0]) * lo_f(b.x) + sigm(g2[0]) * lo_f(c.x);
                y[1] = sigm(g0[1]) * hi_f(a.x) + sigm(g1[1]) * hi_f(b.x) + sigm(g2[1]) * hi_f(c.x);
                y[2] = sigm(g0[2]) * lo_f(a.y) + sigm(g1[2]) * lo_f(b.y) + sigm(g2[2]) * lo_f(c.y);
                y[3] = sigm(g0[3]) * hi_f(a.y) + sigm(g1[3]) * hi_f(b.y) + sigm(g2[3]) * hi_f(c.y);
                *(uint2*)(Y + row * 1024 + ch) = pk4(y);
            }
    }
};

DEV bool tile_map(int idx, int NT, int& pm, int& pn) {
    const int x = idx & 7, pl = (idx >> 3) & 3, pmid = (idx >> 5) & 7, st = idx >> 8;
    pm = pmid * 8 + x;
    pn = st * 4 + pl;
    return pn < NT;
}
DEV int tile_count(int NT) { return ((NT + 3) / 4) * 256; }

DEV void cmp2_job(const Params& P, int job) {
    char* aux = (char*)P.out;
    const int lane = threadIdx.x & 63, w = (threadIdx.x & 255) >> 6;
    const int wj = job * 4 + w;
    const int which = wj >= NCROWS ? 1 : 0;
    const int r = wj - which * NCROWS;
    const int bg = r / NCMP, n = r - bg * NCMP;
    const bf16_t* hid = (const bf16_t*)(aux + (which ? O_HIDV : O_HIDK)) + (size_t)r * 256;
    const float* w2 = which ? P.wv2 : P.wk2;
    float acc = 0.f;
#pragma unroll 8
    for (int k = 0; k < 256; ++k) acc += bf2f(hid[k]) * w2[k * 64 + lane];
    if (!which) {
        const int pos = 16 * n + 31, i = lane & 7;
        const float cs = ((const float*)(aux + O_ROPEC))[pos * 8 + i], sn = ((const float*)(aux + O_ROPES))[pos * 8 + i];
        const float pr = __shfl_xor(acc, 8);
        float o = acc;
        if (lane < 16) o = (lane & 8) ? (acc * cs + pr * sn) : (acc * cs - pr * sn);
        bf16_t* KC = (bf16_t*)(aux + O_KC);
        KC[((size_t)bg * 128 + n) * 64 + lane] = f2bf(o);
        if (n == NCMP - 1) KC[((size_t)bg * 128 + 127) * 64 + lane] = 0;
    } else {
        bf16_t* VCT = (bf16_t*)(aux + O_VCT);
        VCT[((size_t)bg * 64 + lane) * 128 + n] = f2bf(acc);
        if (n == NCMP - 1) VCT[((size_t)bg * 64 + lane) * 128 + 127] = 0;
    }
}

DEV void rnn_job(const Params& P, int job, char* smem, bool dry) {
    char* aux = (char*)P.out;
    bf16_t* ZA = (bf16_t*)(P.ws + W_ZA);
    const int b = job >> 6, n = (job >> 2) & 15, ct = job & 3;
    bf16_t* sX = (bf16_t*)smem;
    float* sXf = (float*)(smem + 9216);
    float* sCw = (float*)(smem + 9216 + 16640);
    float* sSum = (float*)(smem + 9216 + 16640 + 1280);
    bf16_t* sRaw = (bf16_t*)(smem + 9216 + 16640 + 1280 + 2048);
    const int tid = opaque_tid(), w = tid >> 6, lane = tid & 63, fr = lane & 15, fq = lane >> 4;
    const bf16_t* WAT = (const bf16_t*)(aux + O_WAT) + n * 4096;
    const bf16_t* WIT = (const bf16_t*)(aux + O_WIT) + n * 4096;
    bf16x8 wa[2], wi[2];
#pragma unroll
    for (int ks = 0; ks < 2; ++ks) {
        wa[ks] = *(const bf16x8*)(WAT + (16 * ct + fr) * 64 + 32 * ks + 8 * fq);
        wi[ks] = *(const bf16x8*)(WIT + (16 * ct + fr) * 64 + 32 * ks + 8 * fq);
    }
    const int c = n * 64 + 16 * ct + fr;
    const float ba = P.b_a[c], bi = P.b_i[c], cl = -8.0f * log1pf(__expf(-P.lam[c]));
    float carry = 0.f;
    __syncthreads();
    for (int i = tid; i < 320; i += 256) sCw[i] = (i < 256) ? P.conv_w[(i >> 6) * 1024 + n * 64 + (i & 63)] : P.conv_b[n * 64 + (i & 63)];
    const int lt = tid >> 2, cg = (tid & 3) * 16;
    const bf16_t* xbase = ZA + (size_t)(b * S) * ZW + C_XR + n * 64 + cg;
    bf16_t* sRaw2 = sRaw + 67 * 72;
    u32x4 xm0, xm1, xh0 = {0u, 0u, 0u, 0u}, xh1 = {0u, 0u, 0u, 0u};
    { const u32x4* xp = (const u32x4*)(xbase + (size_t)lt * ZW); xm0 = xp[0]; xm1 = xp[1]; }
    *(u32x4*)(sRaw + (lt + 3) * 72 + cg) = xm0; *(u32x4*)(sRaw + (lt + 3) * 72 + cg + 8) = xm1;
    if (tid < 12) { *(u32x4*)(sRaw + lt * 72 + cg) = xh0; *(u32x4*)(sRaw + lt * 72 + cg + 8) = xh1; }
    { const u32x4* xp = (const u32x4*)(xbase + (size_t)(64 + lt) * ZW); xm0 = xp[0]; xm1 = xp[1];
      if (tid < 12) { const u32x4* hp = (const u32x4*)(xbase + (size_t)(61 + lt) * ZW); xh0 = hp[0]; xh1 = hp[1]; } }
    __syncthreads();
#pragma unroll 1
    for (int chunk = 0; chunk < 32; ++chunk) {
        const int tc = chunk * 64;
        const bf16_t* rawc = (chunk & 1) ? sRaw2 : sRaw;
        bf16_t* rawn = (chunk & 1) ? sRaw : sRaw2;
        bf16_t gv[4];
#pragma unroll
        for (int j = 0; j < 4; ++j) gv[j] = ZA[(size_t)(b * S + tc + 16 * w + 4 * fq + j) * ZW + C_GR + n * 64 + 16 * ct + fr];
        {
            float xv[16];
#pragma unroll
            for (int e4 = 0; e4 < 4; ++e4) { const float4 bb = *(const float4*)(sCw + 256 + cg + 4 * e4); xv[4 * e4] = bb.x; xv[4 * e4 + 1] = bb.y; xv[4 * e4 + 2] = bb.z; xv[4 * e4 + 3] = bb.w; }
#pragma unroll
            for (int k = 0; k < 4; ++k) {
                const u32x4 v0 = *(const u32x4*)(rawc + (lt + k) * 72 + cg), v1 = *(const u32x4*)(rawc + (lt + k) * 72 + cg + 8);
                const unsigned u[8] = {v0.x, v0.y, v0.z, v0.w, v1.x, v1.y, v1.z, v1.w};
#pragma unroll
                for (int e4 = 0; e4 < 4; ++e4) {
                    const float4 wv = *(const float4*)(sCw + k * 64 + cg + 4 * e4);
                    xv[4 * e4] += wv.x * lo_f(u[2 * e4]);
                    xv[4 * e4 + 1] += wv.y * hi_f(u[2 * e4]);
                    xv[4 * e4 + 2] += wv.z * lo_f(u[2 * e4 + 1]);
                    xv[4 * e4 + 3] += wv.w * hi_f(u[2 * e4 + 1]);
                }
            }
            if ((tid & 3) == ct) {
#pragma unroll
                for (int e = 0; e < 16; ++e) sXf[lt * 17 + e] = xv[e];
            }
            u32x4 o0 = {pk2(xv[0], xv[1]), pk2(xv[2], xv[3]), pk2(xv[4], xv[5]), pk2(xv[6], xv[7])};
            u32x4 o1 = {pk2(xv[8], xv[9]), pk2(xv[10], xv[11]), pk2(xv[12], xv[13]), pk2(xv[14], xv[15])};
            *(u32x4*)(sX + lt * 72 + cg) = o0;
            *(u32x4*)(sX + lt * 72 + cg + 8) = o1;
        }
        __syncthreads();
        f32x4 R = (f32x4){0.f, 0.f, 0.f, 0.f}, I = (f32x4){0.f, 0.f, 0.f, 0.f};
#pragma unroll
        for (int ks = 0; ks < 2; ++ks) {
            const bf16x8 af = *(const bf16x8*)(sX + (16 * w + fr) * 72 + 32 * ks + 8 * fq);
            R = MFMA16(af, wa[ks], R); I = MFMA16(af, wi[ks], I);
        }
        if (chunk + 1 < 32) {
            *(u32x4*)(rawn + (lt + 3) * 72 + cg) = xm0; *(u32x4*)(rawn + (lt + 3) * 72 + cg + 8) = xm1;
            if (tid < 12) { *(u32x4*)(rawn + lt * 72 + cg) = xh0; *(u32x4*)(rawn + lt * 72 + cg + 8) = xh1; }
        }
        float hl[4], pc[4];
        float h = 0.f, pcum = 1.f;
#pragma unroll
        for (int j = 0; j < 4; ++j) {
            const float xcv = sXf[(16 * w + 4 * fq + j) * 17 + fr];
            const float rg = sigm(R[j] + ba), gi = sigm(I[j] + bi);
            const float la = rg * cl;
            const float a_ = __expf(la);
            const float mult = sqrtf(fmaxf(1.f - a_ * a_, 0.f));
            const float u = mult * gi * xcv;
            h = a_ * h + u; pcum *= a_;
            hl[j] = h; pc[j] = pcum;
        }
        float A = pcum, H = h;
        float A1 = __shfl_up(A, 16), H1 = __shfl_up(H, 16);
        if (fq >= 1) { H = A * H1 + H; A = A * A1; }
        float A2 = __shfl_up(A, 32), H2 = __shfl_up(H, 32);
        if (fq >= 2) { H = A * H2 + H; A = A * A2; }
        float Ax = __shfl_up(A, 16), Hx = __shfl_up(H, 16);
        const float Ae = fq == 0 ? 1.f : Ax, He = fq == 0 ? 0.f : Hx;
        if (fq == 3) { sSum[w * 16 + fr] = A; sSum[64 + w * 16 + fr] = H; }
        __syncthreads();
        if (chunk + 2 < 32) {
            const u32x4* xp = (const u32x4*)(xbase + (size_t)(tc + 128 + lt) * ZW); xm0 = xp[0]; xm1 = xp[1];
            if (tid < 12) { const u32x4* hp = (const u32x4*)(xbase + (size_t)(tc + 125 + lt) * ZW); xh0 = hp[0]; xh1 = hp[1]; }
        }
        float cin = carry, mycin = 0.f;
#pragma unroll
        for (int ww = 0; ww < 4; ++ww) {
            if (ww == w) mycin = cin;
            cin = sSum[ww * 16 + fr] * cin + sSum[64 + ww * 16 + fr];
        }
        carry = cin;
        const float sq = Ae * mycin + He;
#pragma unroll
        for (int j = 0; j < 4; ++j) {
            const float hfin = hl[j] + pc[j] * sq;
            const size_t grow = (size_t)(b * S + tc + 16 * w + 4 * fq + j);
            bf16_t* op = dry ? ((bf16_t*)(P.ws + W_YX) + grow * 1024 + n * 64 + 16 * ct + fr) : (ZA + grow * ZW + C_GR + n * 64 + 16 * ct + fr);
            *op = f2bf(gelu_t(bf2f(gv[j])) * hfin);
        }
    }
}

constexpr float EXPC = 0.125f * 1.4426950408889634f;
struct AttnAcc { f32x4 o[4][2]; float m[2], l[2]; };
DEV void attn_init(AttnAcc& a) {
#pragma unroll
    for (int d = 0; d < 4; ++d)
#pragma unroll
        for (int q = 0; q < 2; ++q) a.o[d][q] = (f32x4){0.f, 0.f, 0.f, 0.f};
    a.m[0] = a.m[1] = -INFINITY; a.l[0] = a.l[1] = 0.f;
}
DEV bf16x8 mk8(unsigned a, unsigned b, unsigned c, unsigned d) { u32x4 u = {a, b, c, d}; return __builtin_bit_cast(bf16x8, u); }

template <class MF>
DEV void attn_step(const bf16_t* sK, const bf16_t* sVt, int vstride, const bf16x8 (&qf)[2][2], AttnAcc& st, const MF& mf, int fr, int fq) {
    f32x4 s[4][2];
#pragma unroll
    for (int kt = 0; kt < 4; ++kt) {
        s[kt][0] = (f32x4){0.f, 0.f, 0.f, 0.f}; s[kt][1] = (f32x4){0.f, 0.f, 0.f, 0.f};
#pragma unroll
        for (int ks = 0; ks < 2; ++ks) {
            const bf16x8 kf = *(const bf16x8*)(sK + (16 * kt + fr) * 80 + 32 * ks + 8 * fq);
            s[kt][0] = MFMA16(kf, qf[0][ks], s[kt][0]);
            s[kt][1] = MFMA16(kf, qf[1][ks], s[kt][1]);
        }
    }
#pragma unroll
    for (int qt = 0; qt < 2; ++qt) {
        float mx = -INFINITY;
#pragma unroll
        for (int kt = 0; kt < 4; ++kt)
#pragma unroll
            for (int j = 0; j < 4; ++j) {
                const float v = mf(qt, 16 * kt + 4 * fq + j) ? s[kt][qt][j] : -INFINITY;
                s[kt][qt][j] = v; mx = fmaxf(mx, v);
            }
        mx = fmaxf(mx, __shfl_xor(mx, 16)); mx = fmaxf(mx, __shfl_xor(mx, 32));
        const float mn = fmaxf(st.m[qt], mx);
        float alpha = 1.f, msub = 0.f;
        if (mn != -INFINITY) { alpha = __builtin_amdgcn_exp2f((st.m[qt] - mn) * EXPC); msub = mn; }
        st.m[qt] = mn;
        float ps = 0.f;
#pragma unroll
        for (int kt = 0; kt < 4; ++kt)
#pragma unroll
            for (int j = 0; j < 4; ++j) { const float p = __builtin_amdgcn_exp2f((s[kt][qt][j] - msub) * EXPC); s[kt][qt][j] = p; ps += p; }
        st.l[qt] = st.l[qt] * alpha + ps;
#pragma unroll
        for (int dt = 0; dt < 4; ++dt) st.o[dt][qt] *= alpha;
    }
#pragma unroll
    for (int ks = 0; ks < 2; ++ks) {
        bf16x8 pf[2];
#pragma unroll
        for (int qt = 0; qt < 2; ++qt)
            pf[qt] = mk8(pk2(s[2 * ks][qt][0], s[2 * ks][qt][1]), pk2(s[2 * ks][qt][2], s[2 * ks][qt][3]),
                         pk2(s[2 * ks + 1][qt][0], s[2 * ks + 1][qt][1]), pk2(s[2 * ks + 1][qt][2], s[2 * ks + 1][qt][3]));
#pragma unroll
        for (int dt = 0; dt < 4; ++dt) {
            const u32x2 v0 = *(const u32x2*)(sVt + (16 * dt + fr) * vstride + 32 * ks + 4 * fq);
            const u32x2 v1 = *(const u32x2*)(sVt + (16 * dt + fr) * vstride + 32 * ks + 16 + 4 * fq);
            const bf16x8 vf = mk8(v0.x, v0.y, v1.x, v1.y);
            st.o[dt][0] = MFMA16(vf, pf[0], st.o[dt][0]);
            st.o[dt][1] = MFMA16(vf, pf[1], st.o[dt][1]);
        }
    }
}
DEV void attn_step_fast(const bf16_t* sK, const bf16_t* sVt, const bf16x8 (&qf)[2][2], AttnAcc& st, const float (&bitoff)[2], int fr, int fq) {
    f32x4 s[4][2];
#pragma unroll
    for (int kt = 0; kt < 4; ++kt) {
        s[kt][0] = (f32x4){0.f, 0.f, 0.f, 0.f}; s[kt][1] = (f32x4){0.f, 0.f, 0.f, 0.f};
#pragma unroll
        for (int ks = 0; ks < 2; ++ks) {
            const bf16x8 kf = *(const bf16x8*)(sK + (16 * kt + fr) * 80 + 32 * ks + 8 * fq);
            s[kt][0] = MFMA16(kf, qf[0][ks], s[kt][0]);
            s[kt][1] = MFMA16(kf, qf[1][ks], s[kt][1]);
        }
    }
#pragma unroll
    for (int qt = 0; qt < 2; ++qt) {
        float mx = fmaxf(fmaxf(s[0][qt][0], s[0][qt][1]), fmaxf(s[0][qt][2], s[0][qt][3]));
#pragma unroll
        for (int kt = 1; kt < 4; ++kt) mx = fmaxf(mx, fmaxf(fmaxf(s[kt][qt][0], s[kt][qt][1]), fmaxf(s[kt][qt][2], s[kt][qt][3])));
        mx = fmaxf(mx, __shfl_xor(mx, 16)); mx = fmaxf(mx, __shfl_xor(mx, 32));
        const float mn = fmaxf(st.m[qt], mx);
        const float alpha = __builtin_amdgcn_exp2f((st.m[qt] - mn) * EXPC);
        st.m[qt] = mn;
        const float off = bitoff[qt] - mn * EXPC;
        float ps = 0.f;
#pragma unroll
        for (int kt = 0; kt < 4; ++kt)
#pragma unroll
            for (int j = 0; j < 4; ++j) { const float p = __builtin_amdgcn_exp2f(fmaf(s[kt][qt][j], EXPC, off)); s[kt][qt][j] = p; ps += p; }
        st.l[qt] = st.l[qt] * alpha + ps;
#pragma unroll
        for (int dt = 0; dt < 4; ++dt) st.o[dt][qt] *= alpha;
    }
#pragma unroll
    for (int ks = 0; ks < 2; ++ks) {
        bf16x8 pf[2];
#pragma unroll
        for (int qt = 0; qt < 2; ++qt)
            pf[qt] = mk8(pk2(s[2 * ks][qt][0], s[2 * ks][qt][1]), pk2(s[2 * ks][qt][2], s[2 * ks][qt][3]),
                         pk2(s[2 * ks + 1][qt][0], s[2 * ks + 1][qt][1]), pk2(s[2 * ks + 1][qt][2], s[2 * ks + 1][qt][3]));
#pragma unroll
        for (int dt = 0; dt < 4; ++dt) {
            const u32x2 v0 = *(const u32x2*)(sVt + (16 * dt + fr) * 72 + 32 * ks + 4 * fq);
            const u32x2 v1 = *(const u32x2*)(sVt + (16 * dt + fr) * 72 + 32 * ks + 16 + 4 * fq);
            const bf16x8 vf = mk8(v0.x, v0.y, v1.x, v1.y);
            st.o[dt][0] = MFMA16(vf, pf[0], st.o[dt][0]);
            st.o[dt][1] = MFMA16(vf, pf[1], st.o[dt][1]);
        }
    }
}
template <int QT>
DEV void attn_half_fast(const bf16_t* sK, const bf16_t* sVt, const bf16x8 (&qf)[2][2], AttnAcc& st, float bitoff, int fr, int fq) {
    f32x4 s[4];
#pragma unroll
    for (int kt = 0; kt < 4; ++kt) {
        s[kt] = (f32x4){0.f, 0.f, 0.f, 0.f};
#pragma unroll
        for (int ks = 0; ks < 2; ++ks) {
            const bf16x8 kf = *(const bf16x8*)(sK + (16 * kt + fr) * 80 + 32 * ks + 8 * fq);
            s[kt] = MFMA16(kf, qf[QT][ks], s[kt]);
        }
    }
    float mx = fmaxf(fmaxf(s[0][0], s[0][1]), fmaxf(s[0][2], s[0][3]));
#pragma unroll
    for (int kt = 1; kt < 4; ++kt) mx = fmaxf(mx, fmaxf(fmaxf(s[kt][0], s[kt][1]), fmaxf(s[kt][2], s[kt][3])));
    mx = fmaxf(mx, __shfl_xor(mx, 16)); mx = fmaxf(mx, __shfl_xor(mx, 32));
    const float mn = fmaxf(st.m[QT], mx);
    const float alpha = __builtin_amdgcn_exp2f((st.m[QT] - mn) * EXPC);
    st.m[QT] = mn;
    const float off = bitoff - mn * EXPC;
    float ps = 0.f;
#pragma unroll
    for (int kt = 0; kt < 4; ++kt)
#pragma unroll
        for (int j = 0; j < 4; ++j) { const float p = __builtin_amdgcn_exp2f(fmaf(s[kt][j], EXPC, off)); s[kt][j] = p; ps += p; }
    st.l[QT] = st.l[QT] * alpha + ps;
#pragma unroll
    for (int dt = 0; dt < 4; ++dt) st.o[dt][QT] *= alpha;
#pragma unroll
    for (int ks = 0; ks < 2; ++ks) {
        const bf16x8 pf = mk8(pk2(s[2 * ks][0], s[2 * ks][1]), pk2(s[2 * ks][2], s[2 * ks][3]), pk2(s[2 * ks + 1][0], s[2 * ks + 1][1]), pk2(s[2 * ks + 1][2], s[2 * ks + 1][3]));
#pragma unroll
        for (int dt = 0; dt < 4; ++dt) {
            const u32x2 v0 = *(const u32x2*)(sVt + (16 * dt + fr) * 72 + 32 * ks + 4 * fq);
            const u32x2 v1 = *(const u32x2*)(sVt + (16 * dt + fr) * 72 + 32 * ks + 16 + 4 * fq);
            st.o[dt][QT] = MFMA16(mk8(v0.x, v0.y, v1.x, v1.y), pf, st.o[dt][QT]);
        }
    }
}
DEV void attn_fold_out(bf16_t* const (&op)[2], const AttnAcc& st, const float (&gate)[2]) {
#pragma unroll
    for (int qt = 0; qt < 2; ++qt) {
        float l = st.l[qt];
        l += __shfl_xor(l, 16); l += __shfl_xor(l, 32);
        const float sc = gate[qt] * __builtin_amdgcn_rcpf(fmaxf(l, 1e-30f));
#pragma unroll
        for (int dt = 0; dt < 4; ++dt) {
            const uint2 pv = *(const uint2*)(op[qt] + 16 * dt);
            f32x4 r = st.o[dt][qt] * sc;
            r[0] += lo_f(pv.x); r[1] += hi_f(pv.x); r[2] += lo_f(pv.y); r[3] += hi_f(pv.y);
            *(uint2*)(op[qt] + 16 * dt) = make_uint2(pk2(r[0], r[1]), pk2(r[2], r[3]));
        }
    }
}
DEV void attn_fold(f32x4 (&tot)[4][2], const AttnAcc& st, const float (&gate)[2]) {
#pragma unroll
    for (int qt = 0; qt < 2; ++qt) {
        float l = st.l[qt];
        l += __shfl_xor(l, 16); l += __shfl_xor(l, 32);
        const float sc = gate[qt] * __builtin_amdgcn_rcpf(fmaxf(l, 1e-30f));
#pragma unroll
        for (int dt = 0; dt < 4; ++dt) tot[dt][qt] += st.o[dt][qt] * sc;
    }
}
DEV void ld64(u32x4 (&r)[2], const bf16_t* src, size_t sstride, int tid) {
#pragma unroll
    for (int i = 0; i < 2; ++i) { const int c = tid + 256 * i; r[i] = *(const u32x4*)(src + (size_t)(c >> 3) * sstride + (c & 7) * 8); }
}
DEV void st64(bf16_t* dst, const u32x4 (&r)[2], int tid, int stride) {
#pragma unroll
    for (int i = 0; i < 2; ++i) { const int c = tid + 256 * i; *(u32x4*)(dst + (c >> 3) * stride + (c & 7) * 8) = r[i]; }
}

#define OUTP(QT) ((dry ? (bf16_t*)(P.ws + W_YX) + (size_t)(b * S + tq[QT]) * 1024 : ZA + (size_t)(b * S + tq[QT]) * ZW + C_Q) + head * 64 + 4 * fq)
#define LOAD_GATE(G2, BR) float G2[2]; { G2[0] = bf2f(ZA[(size_t)(b * S + tq[0]) * ZW + C_G + head * 3 + (BR)]); G2[1] = bf2f(ZA[(size_t)(b * S + tq[1]) * ZW + C_G + head * 3 + (BR)]); }
struct MaskAll { DEV bool operator()(int, int) const { return true; } };
struct MaskSel { unsigned bit[2]; int t[2]; int k0; DEV bool operator()(int qt, int kk) const { return bit[qt] && (k0 + kk <= t[qt]); } };
struct MaskWin { int t[2]; int k0; DEV bool operator()(int qt, int kk) const { const int k = k0 + kk; return k <= t[qt] && k > t[qt] - 512; } };

DEV void xattn_job(const Params& P, int job, char* smem, bool dry) {
    char* aux = (char*)P.out;
    bf16_t* ZA = (bf16_t*)(P.ws + W_ZA);
    const int qb = job & 15, h = (job >> 4) & 3, b = job >> 6;
    bf16_t* sK = (bf16_t*)smem;
    bf16_t* sVt = sK + 64 * 80;
    const int tid = opaque_tid(), w = tid >> 6, lane = tid & 63, fr = lane & 15, fq = lane >> 4;
    const int t0 = qb * 128 + w * 32;
    bf16x8 qf[2][2];
#pragma unroll
    for (int qt = 0; qt < 2; ++qt)
#pragma unroll
        for (int ks = 0; ks < 2; ++ks) qf[qt][ks] = *(const bf16x8*)(ZA + (size_t)(b * S + t0 + 16 * qt + fr) * ZW + C_QX + h * 64 + 32 * ks + 8 * fq);
    const bf16_t* MK = (const bf16_t*)(aux + O_MEMK) + (size_t)(b * 4 + h) * 256 * 64;
    const bf16_t* MVT = (const bf16_t*)(aux + O_MEMVT) + (size_t)(b * 4 + h) * 64 * 256;
    AttnAcc st; attn_init(st);
    u32x4 rk[2], rv[2];
    ld64(rk, MK, 64, tid); ld64(rv, MVT, 256, tid);
#pragma unroll 1
    for (int jb = 0; jb < 4; ++jb) {
        __syncthreads();
        st64(sK, rk, tid, 80); st64(sVt, rv, tid, 72);
        __syncthreads();
        if (jb + 1 < 4) { ld64(rk, MK + (size_t)(jb + 1) * 64 * 64, 64, tid); ld64(rv, MVT + (jb + 1) * 64, 256, tid); }
        __builtin_amdgcn_sched_barrier(0);
        { const float z2[2] = {0.f, 0.f}; attn_step_fast(sK, sVt, qf, st, z2, fr, fq); }
    }
    f32x4 tot[4][2];
#pragma unroll
    for (int dt = 0; dt < 4; ++dt) { tot[dt][0] = (f32x4){0.f, 0.f, 0.f, 0.f}; tot[dt][1] = (f32x4){0.f, 0.f, 0.f, 0.f}; }
    const float one[2] = {1.f, 1.f};
    attn_fold(tot, st, one);
#pragma unroll
    for (int qt = 0; qt < 2; ++qt)
#pragma unroll
        for (int dt = 0; dt < 4; ++dt)
            *(uint2*)((dry ? (bf16_t*)(P.ws + W_Y) + (size_t)(b * S + t0 + 16 * qt + fr) * 1024 : ZA + (size_t)(b * S + t0 + 16 * qt + fr) * ZW + C_QX) + h * 64 + 16 * dt + 4 * fq) =
                make_uint2(pk2(tot[dt][qt][0], tot[dt][qt][1]), pk2(tot[dt][qt][2], tot[dt][qt][3]));
}

DEV void nsa_job(const Params& P, int job, char* smem, bool dry) {
    char* aux = (char*)P.out;
    bf16_t* ZA = (bf16_t*)(P.ws + W_ZA);
    const int pj_ = job >> 1, bg = pj_ & 31, qb = 63 - (2 * (pj_ >> 5) + (job & 1)), b = bg >> 2, g = bg & 3, t0 = qb * 32;
    bf16_t* sK = (bf16_t*)smem;
    bf16_t* sVt = (bf16_t*)(smem + 20480);
    float* sImp = (float*)(smem + 38912);
    unsigned* sSel = (unsigned*)(smem + 38912 + 4096);
    constexpr int KVBUF = 9728;
    const int tid = opaque_tid(), w = tid >> 6, lane = tid & 63, fr = lane & 15, fq = lane >> 4;
    const int head = g * 4 + (fr & 3);
    const int qi0 = 8 * w + (fr >> 2);
    int tq[2];
    bf16x8 qf[2][2];
#pragma unroll
    for (int qt = 0; qt < 2; ++qt) {
        tq[qt] = t0 + qi0 + 4 * qt;
        const bf16_t* rowp = ZA + (size_t)(b * S + tq[qt]) * ZW;
#pragma unroll
        for (int ks = 0; ks < 2; ++ks) qf[qt][ks] = *(const bf16x8*)(rowp + C_Q + head * 64 + 32 * ks + 8 * fq);
    }
    f32x4 tot[4][2];
#pragma unroll
    for (int dt = 0; dt < 4; ++dt) { tot[dt][0] = (f32x4){0.f, 0.f, 0.f, 0.f}; tot[dt][1] = (f32x4){0.f, 0.f, 0.f, 0.f}; }

    {
        const bf16_t* KC = (const bf16_t*)(aux + O_KC) + (size_t)bg * 128 * 64;
        const bf16_t* VCT = (const bf16_t*)(aux + O_VCT) + (size_t)bg * 64 * 128;
        __syncthreads();
#pragma unroll
        for (int i = 0; i < 4; ++i) {
            const int c = tid + 256 * i;
            { const int r = c >> 3, k = (c & 7) * 8; *(u32x4*)(sK + r * 80 + k) = *(const u32x4*)(KC + r * 64 + k); }
            { const int r = c >> 4, k = (c & 15) * 8; *(u32x4*)(sVt + r * 136 + k) = *(const u32x4*)(VCT + r * 128 + k); }
        }
        __syncthreads();
#pragma unroll
        for (int qt = 0; qt < 2; ++qt) {
            const float g0 = bf2f(ZA[(size_t)(b * S + tq[qt]) * ZW + C_G + head * 3 + 0]);
            f32x4 s[8];
#pragma unroll
            for (int kt = 0; kt < 8; ++kt) {
                s[kt] = (f32x4){0.f, 0.f, 0.f, 0.f};
#pragma unroll
                for (int ks = 0; ks < 2; ++ks) {
                    const bf16x8 kf = *(const bf16x8*)(sK + (16 * kt + fr) * 80 + 32 * ks + 8 * fq);
                    s[kt] = MFMA16(kf, qf[qt][ks], s[kt]);
                }
            }
            float mx = -INFINITY;
#pragma unroll
            for (int kt = 0; kt < 8; ++kt)
#pragma unroll
                for (int j = 0; j < 4; ++j) {
                    const int n = 16 * kt + 4 * fq + j;
                    const float v = (n < NCMP && 16 * n + 31 <= tq[qt]) ? s[kt][j] : -INFINITY;
                    s[kt][j] = v; mx = fmaxf(mx, v);
                }
            mx = fmaxf(mx, __shfl_xor(mx, 16)); mx = fmaxf(mx, __shfl_xor(mx, 32));
            const float msub = (mx == -INFINITY) ? 0.f : mx;
            float ps = 0.f;
#pragma unroll
            for (int kt = 0; kt < 8; ++kt)
#pragma unroll
                for (int j = 0; j < 4; ++j) { const float p = __builtin_amdgcn_exp2f((s[kt][j] - msub) * EXPC); s[kt][j] = p; ps += p; }
            ps += __shfl_xor(ps, 16); ps += __shfl_xor(ps, 32);
            const float inv = __builtin_amdgcn_rcpf(fmaxf(ps, 1e-30f));
            float bprev = 0.f;
#pragma unroll
            for (int kt = 0; kt < 8; ++kt) {
                s[kt] *= inv;
                const float a = s[kt][0] + s[kt][1] + s[kt][2] + 0.5f * s[kt][3];
                const float bq = 0.5f * s[kt][3];
                const float x = __shfl(bq, (lane + 48) & 63);
                const float y = __shfl(bprev, (lane + 48) & 63);
                float iv = a + (fq > 0 ? x : y);
                iv += __shfl_xor(iv, 1); iv += __shfl_xor(iv, 2);
                if ((fr & 3) == 0) sImp[(qi0 + 4 * qt) * 32 + 4 * kt + fq] = iv;
                bprev = bq;
            }
#pragma unroll
            for (int ks = 0; ks < 4; ++ks) {
                const f32x4 pa = s[2 * ks] * g0, pb = s[2 * ks + 1] * g0;
                const bf16x8 pf = mk8(pk2(pa[0], pa[1]), pk2(pa[2], pa[3]), pk2(pb[0], pb[1]), pk2(pb[2], pb[3]));
#pragma unroll
                for (int dt = 0; dt < 4; ++dt) {
                    const u32x2 v0 = *(const u32x2*)(sVt + (16 * dt + fr) * 136 + 32 * ks + 4 * fq);
                    const u32x2 v1 = *(const u32x2*)(sVt + (16 * dt + fr) * 136 + 32 * ks + 16 + 4 * fq);
                    tot[dt][qt] = MFMA16(mk8(v0.x, v0.y, v1.x, v1.y), pf, tot[dt][qt]);
                }
            }
            __builtin_amdgcn_sched_barrier(0);
        }
    }
#pragma unroll
    for (int qt = 0; qt < 2; ++qt) {
        bf16_t* op = (dry ? (bf16_t*)(P.ws + W_YX) + (size_t)(b * S + tq[qt]) * 1024 : ZA + (size_t)(b * S + tq[qt]) * ZW + C_Q) + head * 64 + 4 * fq;
#pragma unroll
        for (int dt = 0; dt < 4; ++dt) *(uint2*)(op + 16 * dt) = pk4(tot[dt][qt]);
    }
    __syncthreads();
    {
        float myv[4];
#pragma unroll
        for (int i = 0; i < 4; ++i) {
            const int pidx = tid + 256 * i, q = pidx >> 5, m = pidx & 31;
            const int t = t0 + q, cur = t >> 6;
            const float sum = sImp[q * 32 + m];
            const bool forced = (m == 0) || (m == cur) || (m == cur - 1);
            const bool future = m * 64 > t;
            myv[i] = forced ? INFINITY : (future ? -INFINITY : sum);
        }
        if (tid == 0) sSel[32] = 0u;
        __syncthreads();
#pragma unroll
        for (int i = 0; i < 4; ++i) { const int pidx = tid + 256 * i; sImp[pidx] = myv[i]; }
        __syncthreads();
        unsigned wun = 0u;
#pragma unroll
        for (int i = 0; i < 4; ++i) {
            const int pidx = tid + 256 * i, q = pidx >> 5, m = pidx & 31;
            const float v = myv[i];
            int rank = 0;
#pragma unroll
            for (int m2 = 0; m2 < 32; ++m2) {
                const float o = sImp[q * 32 + m2];
                rank += (o > v || (o == v && m2 < m)) ? 1 : 0;
            }
            const bool selb = (rank < 8) && (v > -INFINITY);
            const unsigned long long bal = __ballot(selb);
            const unsigned mk = (unsigned)(bal >> (32 * (lane >> 5)));
            if ((lane & 31) == 0) sSel[q] = mk;
            wun |= (unsigned)bal | (unsigned)(bal >> 32);
        }
        if (lane == 0) atomicOr(&sSel[32], wun);
    }
    __syncthreads();
    __shared__ unsigned s_xuni[2];
    if (tid == 0) s_xuni[threadIdx.x >> 8] = sSel[32];
    __syncthreads();
    const unsigned uni = s_xuni[0] | s_xuni[1];
    const int jmax = (t0 + 31) >> 6;
    {
        AttnAcc st; attn_init(st);
        const bf16_t* Kb = ZA + (size_t)(b * S) * ZW + C_KS + g * 64;
        const bf16_t* Vb = (const bf16_t*)(P.ws + W_VST) + (size_t)bg * 64 * S;
        unsigned rem = uni & ((2u << jmax) - 1u);
        u32x4 rk[2], rv[2];
        if (rem) { const int j0 = __builtin_ctz(rem); ld64(rk, Kb + (size_t)(j0 * 64) * ZW, ZW, tid); ld64(rv, Vb + j0 * 64, S, tid); }
        __syncthreads();
        int it = 0;
#pragma unroll 1
        while (rem) {
            const int jb = __builtin_ctz(rem);
            rem &= rem - 1u;
            bf16_t* sKb = (bf16_t*)smem + (it & 1) * KVBUF; bf16_t* sVb = sKb + 64 * 80; ++it;
            st64(sKb, rk, tid, 80); st64(sVb, rv, tid, 72);
            __syncthreads();
            if (rem) { const int jn = __builtin_ctz(rem); ld64(rk, Kb + (size_t)(jn * 64) * ZW, ZW, tid); ld64(rv, Vb + jn * 64, S, tid); }
            __builtin_amdgcn_sched_barrier(0);
            const unsigned b0 = (sSel[qi0] >> jb) & 1u, b1 = (sSel[qi0 + 4] >> jb) & 1u;
            if (jb * 64 + 63 <= t0) {
                const bool need0 = __builtin_amdgcn_ballot_w64(b0 != 0u) != 0ull, need1 = __builtin_amdgcn_ballot_w64(b1 != 0u) != 0ull;
                const float bo[2] = {b0 ? 0.f : -INFINITY, b1 ? 0.f : -INFINITY};
                if (need0 && need1) attn_step_fast(sKb, sVb, qf, st, bo, fr, fq);
                else if (need0) attn_half_fast<0>(sKb, sVb, qf, st, bo[0], fr, fq);
                else if (need1) attn_half_fast<1>(sKb, sVb, qf, st, bo[1], fr, fq);
            } else {
                MaskSel mf; mf.bit[0] = b0; mf.bit[1] = b1; mf.t[0] = tq[0]; mf.t[1] = tq[1]; mf.k0 = jb * 64;
                attn_step(sKb, sVb, 72, qf, st, mf, fr, fq);
            }
        }
        { LOAD_GATE(g1, 1) bf16_t* const op2[2] = {OUTP(0), OUTP(1)}; attn_fold_out(op2, st, g1); }
    }
    {
        AttnAcc st; attn_init(st);
        const bf16_t* Kb = ZA + (size_t)(b * S) * ZW + C_KW + g * 64;
        const bf16_t* Vb = (const bf16_t*)(P.ws + W_VWT) + (size_t)bg * 64 * S;
#pragma unroll
        for (int qt = 0; qt < 2; ++qt) {
            const int npad = 511 - tq[qt];
            if (npad > 0) { st.m[qt] = 0.f; st.l[qt] = (fq == 0) ? (float)npad : 0.f; }
        }
        int jlo = t0 - 511; jlo = jlo < 0 ? 0 : (jlo >> 6);
        u32x4 rk[2], rv[2];
        ld64(rk, Kb + (size_t)(jlo * 64) * ZW, ZW, tid); ld64(rv, Vb + jlo * 64, S, tid);
        __syncthreads();
#pragma unroll 1
        for (int jb = jlo; jb <= jmax; ++jb) {
            bf16_t* sKb = (bf16_t*)smem + ((jb - jlo) & 1) * KVBUF; bf16_t* sVb = sKb + 64 * 80;
            st64(sKb, rk, tid, 80); st64(sVb, rv, tid, 72);
            __syncthreads();
            if (jb < jmax) { ld64(rk, Kb + (size_t)((jb + 1) * 64) * ZW, ZW, tid); ld64(rv, Vb + (jb + 1) * 64, S, tid); }
            __builtin_amdgcn_sched_barrier(0);
            if (jb * 64 + 63 <= t0 && jb * 64 > t0 + 31 - 512) {
                const float z2[2] = {0.f, 0.f};
                attn_step_fast(sKb, sVb, qf, st, z2, fr, fq);
            } else {
                MaskWin mf; mf.t[0] = tq[0]; mf.t[1] = tq[1]; mf.k0 = jb * 64;
                attn_step(sKb, sVb, 72, qf, st, mf, fr, fq);
            }
        }
        { LOAD_GATE(g2, 2) bf16_t* const op2[2] = {OUTP(0), OUTP(1)}; attn_fold_out(op2, st, g2); }
    }
}


#define XB_TMO      128
#define XB_XCNT(j)  (256  + 64 * (j))
#define XB_XSUB(j)  (1280 + 64 * (j))
#define XB_XGEN(j)  (2304 + 64 * (j))
#define XB_TOP      3328
#define XB_TOPGEN   3392
#define XCD_BAR_WORDS 3456
#define XB_SPIN_CAP (1u << 18)
#define LAS __attribute__((address_space(3)))
DEV unsigned xb_ld(unsigned* p) { return __hip_atomic_load(p, __ATOMIC_RELAXED, __HIP_MEMORY_SCOPE_AGENT); }
DEV unsigned xb_add(unsigned* p, unsigned v) { return __hip_atomic_fetch_add(p, v, __ATOMIC_RELAXED, __HIP_MEMORY_SCOPE_AGENT); }
DEV unsigned xb_xcc_id() { return (unsigned)__builtin_amdgcn_s_getreg((3 << 11) | 20) & 0xFu; }
#define XB_SPIN(cond, bar) do { unsigned _sp = 0; while (cond) { __builtin_amdgcn_s_sleep(1); \
    if ((++_sp & 255u) == 0u) { if (xb_ld(&(bar)[XB_TMO])) break; if (_sp > XB_SPIN_CAP) { atomicAdd(&(bar)[XB_TMO], 1u); break; } } } } while (0)
struct XcdBarrier { unsigned* bar; unsigned x; volatile LAS unsigned* st; };
DEV XcdBarrier xcd_barrier_post(unsigned* bar, volatile LAS unsigned* st) {
    XcdBarrier b; b.bar = bar; b.x = xb_xcc_id(); b.st = st;
    if (threadIdx.x == 0) (void)xb_add(&bar[XB_XCNT(b.x)], 1u);
    return b;
}
DEV void xcd_barrier_complete(unsigned* bar, unsigned x, unsigned& nloc, unsigned& nx) {
    const unsigned G = gridDim.x * gridDim.y * gridDim.z;
    unsigned sum, cnt, mine, sp = 0u;
    for (;;) {
        sum = 0u; cnt = 0u; mine = 0u;
#pragma unroll
        for (unsigned j = 0; j < 16; ++j) { const unsigned c = xb_ld(&bar[XB_XCNT(j)]); sum += c; cnt += (c > 0u) ? 1u : 0u; mine = (j == x) ? c : mine; }
        if (sum == G) break;
        __builtin_amdgcn_s_sleep(1);
        if ((++sp & 255u) == 0u) { if (xb_ld(&bar[XB_TMO])) break; if (sp > XB_SPIN_CAP) { atomicAdd(&bar[XB_TMO], 1u); break; } }
    }
    nloc = mine > 0u ? mine : 1u; nx = cnt > 0u ? cnt : 1u;
}
DEV void xcd_barrier(const XcdBarrier& b) {
    asm volatile("s_waitcnt vmcnt(0)" ::: "memory");
    __syncthreads();
    if (threadIdx.x == 0) {
        unsigned* bar = b.bar;
        __builtin_amdgcn_s_waitcnt(0);
        unsigned nloc = b.st[0], nx = b.st[1];
        if (nloc == 0u) { xcd_barrier_complete(bar, b.x, nloc, nx); b.st[0] = nloc; b.st[1] = nx; }
        const unsigned old = xb_add(&bar[XB_XSUB(b.x)], 1u);
        const unsigned gen = old / nloc;
        if (old + 1u == (gen + 1u) * nloc) {
            __builtin_amdgcn_fence(__ATOMIC_RELEASE, "agent");
            asm volatile("s_waitcnt vmcnt(0)" ::: "memory");
            const unsigned og = xb_add(&bar[XB_TOP], 1u);
            const unsigned tg = og / nx;
            if (og + 1u == (tg + 1u) * nx) xb_add(&bar[XB_TOPGEN], 1u);
            else XB_SPIN(xb_ld(&bar[XB_TOPGEN]) == tg, bar);
            __builtin_amdgcn_fence(__ATOMIC_ACQUIRE, "agent");
            xb_add(&bar[XB_XGEN(b.x)], 1u);
            asm volatile("s_waitcnt vmcnt(0)" ::: "memory");
        } else {
            XB_SPIN(xb_ld(&bar[XB_XGEN(b.x)]) == gen, bar);
            __builtin_amdgcn_fence(__ATOMIC_ACQUIRE, "agent");
            asm volatile("s_waitcnt vmcnt(0)" ::: "memory");
        }
    }
    __syncthreads();
}
constexpr size_t W_BAR = 252 * MiB;

constexpr int HALF_SMEM = 56320;
constexpr int SMEM_BYTES = 131072;

extern __shared__ __attribute__((aligned(16))) char dyn_smem[];
#define RUN_PG8(EPI_T, EPI_OBJ, A_, LDA_, BT_, LDB_, M_, N_, K_) { pg8::Gemm g_; g_.A = (A_); g_.Bt = (BT_); g_.M = (M_); g_.N = (N_); g_.K = (K_); g_.lda = (LDA_); g_.ldb = (LDB_); g_.gather = 0; \
        pg8::StaticOrder so_; so_.init((M_), (N_), (int)gridDim.x, (int)blockIdx.x); __syncthreads(); \
        pg8::gemm_phase<EPI_T, pg8::StaticOrder, true, true>((PG8_LAS unsigned char*)dyn_smem, g_, so_, (EPI_OBJ)); __syncthreads(); }

template <int PH, bool DRY = false>
DEV void run_phase(const Params& P, char* smem) {
    const int nb = gridDim.x, bid = blockIdx.x, sub = opaque_tid512() >> 8;
    char* hsm = smem + sub * HALF_SMEM;
    char* aux = (char*)P.out;
    char* ws = P.ws;
    bf16_t* ZA = (bf16_t*)(ws + W_ZA);
    if (PH == 0) {
        for (int pj = bid; pj < (5088 + 4096 + 512 + 64 + 64) / 2; pj += nb) {
            int j = 2 * pj + sub;
            if (j < 5088) {
                bool done = false;
#define TR(SRC, LD, DSTOFF, KK, NN, MAP, BLK)                                                                                  \
    if (!done) { const int nrt = (NN) / 64, nt = nrt * ((KK) / 64);                                                              \
        if (j < nt) { transpose_tile((SRC), (LD), (bf16_t*)(aux + (DSTOFF)), (KK), (j % nrt) * 64, (j / nrt) * 64, (MAP), hsm, (BLK) ? (NN) : 0); done = true; } else j -= nt; }
                TR(P.w_in, 7984, O_WTA, 1024, 5120, 1, 0)
                TR(P.w_in, 7984, O_WTB, 1024, 4096, 2, 0)
                TR(P.w_up, 4096, O_WTUP, 1024, 4096, 0, 0)
                TR(P.w_down, 1024, O_WTDN, 4096, 1024, 0, 0)
                TR(P.w_o, 1024, O_WTO, 1024, 1024, 0, 0)
                TR(P.w_xo, 1024, O_WTXO, 256, 1024, 0, 0)
                TR(P.w_mkv, 512, O_WTMKV, 1024, 512, 0, 0)
                TR(P.wk1, 256, O_WTCK1, 2048, 256, 0, 0)
                TR(P.wv1, 256, O_WTCV1, 2048, 256, 0, 0)
#undef TR
                if (!done) {
                    if (j < 16) transpose_tile(P.w_a + j * 4096, 64, (bf16_t*)(aux + O_WAT) + j * 4096, 64, 0, 0, 0, hsm);
                    else { j -= 16; transpose_tile(P.w_i + j * 4096, 64, (bf16_t*)(aux + O_WIT) + j * 4096, 64, 0, 0, 0, hsm); }
                }
                continue;
            }
            j -= 5088;
            if (j < 4096) { rownorm<false>(P.x, P.g_mix, (bf16_t*)(ws + W_U), nullptr, j * 4 + (opaque_tid() >> 6)); continue; }
            j -= 4096;
            if (j < 512) { rownorm<false>(P.mem, P.g_mem, (bf16_t*)(aux + O_MEMN), nullptr, j * 4 + (opaque_tid() >> 6)); continue; }
            j -= 512;
            if (j < 64) { rope_job((float*)(aux + O_ROPEC), (float*)(aux + O_ROPES), j); continue; }
            j -= 64;
            posbias_job(P, (float*)(aux + O_PB), j, hsm);
        }
    } else if (PH == 1) {
        { PEpiMemKV ep; ep.MK = (bf16_t*)(aux + O_MEMK); ep.MVT = (bf16_t*)(aux + O_MEMVT);
          RUN_PG8(PEpiMemKV, ep, (const bf16_t*)(aux + O_MEMN), 1024, (const bf16_t*)(aux + O_WTMKV), 1024, 2048, 512, 1024) }
        { PEpiZA ep; ep.ZA = ZA; ep.VST = (bf16_t*)(ws + W_VST); ep.VWT = (bf16_t*)(ws + W_VWT); ep.ropec = (const float*)(aux + O_ROPEC); ep.ropes = (const float*)(aux + O_ROPES);
          RUN_PG8(PEpiZA, ep, (const bf16_t*)(ws + W_U), 1024, (const bf16_t*)(aux + O_WTA), 1024, 16384, 5120, 1024) }
    } else if (PH == 2) {
        { PEpiHid ep; ep.HK = (bf16_t*)(aux + O_HIDK); ep.HV = (bf16_t*)(aux + O_HIDV); ep.pb = (const float*)(aux + O_PB);
          pg8::Gemm g_; g_.A = ZA; g_.Bt = (const bf16_t*)(aux + O_WTCK1); g_.M = 4096; g_.N = 512; g_.K = 2048; g_.lda = ZW; g_.ldb = 2048; g_.gather = 1;
          pg8::StaticOrder so_; so_.init(4096, 512, (int)gridDim.x, (int)blockIdx.x); __syncthreads();
          pg8::gemm_phase<PEpiHid, pg8::StaticOrder, true, true>((PG8_LAS unsigned char*)dyn_smem, g_, so_, ep); __syncthreads(); }
        for (int job = bid; job < 512; job += nb) {
            if (job < 256) rnn_job(P, 2 * job + sub, hsm, DRY);
            else xattn_job(P, 2 * (job - 256) + sub, hsm, DRY);
        }
    } else if (PH == 3) {
        for (int pj = bid; pj < 1016; pj += nb) cmp2_job(P, 2 * pj + sub);
    } else if (PH == 4) {
        for (int job = bid; job < 1024; job += nb) nsa_job(P, 2 * job + sub, hsm, DRY);
        if (!DRY) { PEpiBf<0> ep; ep.O = (bf16_t*)(ws + W_YX); ep.ldo = 1024;
          RUN_PG8(PEpiBf<0>, ep, ZA + C_QX, ZW, (const bf16_t*)(aux + O_WTXO), 256, 16384, 1024, 256) }
    } else if (PH == 5) {
        { PEpiMerge ep; ep.ZA = ZA; ep.YX = (const bf16_t*)(ws + W_YX); ep.Y = (bf16_t*)(ws + W_Y);
          RUN_PG8(PEpiMerge, ep, (const bf16_t*)(ws + W_U), 1024, (const bf16_t*)(aux + O_WTB), 1024, 16384, 4096, 1024) }
    } else if (PH == 6) {
        { PEpiRes ep; ep.R = P.x; ep.O = (float*)(ws + W_H);
          RUN_PG8(PEpiRes, ep, (const bf16_t*)(ws + W_Y), 1024, (const bf16_t*)(aux + O_WTO), 1024, 16384, 1024, 1024) }
    } else if (PH == 7) {
        for (int pj = bid; pj < 2048; pj += nb) rownorm<false>((const float*)(ws + W_H), P.g_mlp, (bf16_t*)(ws + W_VN), nullptr, (2 * pj + sub) * 4 + (opaque_tid() >> 6));
    } else if (PH == 8) {
        { PEpiBf<1> ep; ep.O = (bf16_t*)(ws + W_HID); ep.ldo = 4096;
          RUN_PG8(PEpiBf<1>, ep, (const bf16_t*)(ws + W_VN), 1024, (const bf16_t*)(aux + O_WTUP), 1024, 16384, 4096, 1024) }
    } else if (PH == 9) {
        { PEpiRes ep; ep.R = (const float*)(ws + W_H); ep.O = (float*)(ws + W_H);
          RUN_PG8(PEpiRes, ep, (const bf16_t*)(ws + W_HID), 4096, (const bf16_t*)(aux + O_WTDN), 4096, 16384, 1024, 4096) }
    } else if (PH == 10) {
        for (int pj = bid; pj < 2048; pj += nb) rownorm<true>((const float*)(ws + W_H), P.g_final, nullptr, P.out, (2 * pj + sub) * 4 + (opaque_tid() >> 6));
    }
}

__global__ void __launch_bounds__(512, 2) mega_kernel(Params P) {
    char* smem = dyn_smem;
    cg::grid_group grid = cg::this_grid();
    __shared__ uint4 xb_words;
    if (threadIdx.x == 0) xb_words = make_uint4(0u, 0u, 0u, 0u);
    __syncthreads();
    XcdBarrier xb = xcd_barrier_post((unsigned*)(P.ws + W_BAR), (volatile LAS unsigned*)&xb_words);
    if (P.ws == nullptr) grid.sync();
#ifndef REP
#define REP -1
#endif
#define GSYNC() xcd_barrier(xb)
#define PHASE(k) { if (REP == k && k != 9) { run_phase<k, true>(P, smem); GSYNC(); } run_phase<k>(P, smem); GSYNC(); }
    PHASE(0) PHASE(1) PHASE(2) PHASE(3) PHASE(4) PHASE(5) PHASE(6) PHASE(7) PHASE(8) PHASE(9)
    if (REP == 10) { run_phase<10>(P, smem); GSYNC(); }
    if (REP == 11) { GSYNC(); GSYNC(); GSYNC(); GSYNC(); GSYNC(); GSYNC(); GSYNC(); GSYNC(); GSYNC(); GSYNC(); }
    run_phase<10>(P, smem);
}

extern "C" void kernel_launch(void* const* d_in, const int* in_sizes, int n_in, void* d_out, int out_size, void* d_ws, size_t ws_size,
                              hipStream_t stream) {
    Params P{};
    const float** pp = (const float**)&P;
    for (int i = 0; i < 25; ++i) pp[i] = (const float*)d_in[i];
    P.out = (float*)d_out;
    P.ws = (char*)d_ws;
    static int grid_blocks = 0;
    if (!grid_blocks) {
        int dev = 0, cus = 0, per_cu = 0;
        hipGetDevice(&dev);
        hipDeviceGetAttribute(&cus, hipDeviceAttributeMultiprocessorCount, dev);
        hipFuncSetAttribute((const void*)mega_kernel, hipFuncAttributeMaxDynamicSharedMemorySize, SMEM_BYTES);
        hipOccupancyMaxActiveBlocksPerMultiprocessor(&per_cu, mega_kernel, 512, SMEM_BYTES);
        if (per_cu > 1) per_cu = 1;
        if (per_cu < 1) per_cu = 1;
        grid_blocks = cus * per_cu;
    }
    hipMemsetAsync((char*)d_ws + W_BAR, 0, XCD_BAR_WORDS * 4, stream);
    void* args[] = {&P};
    hipError_t e = hipLaunchCooperativeKernel((void*)mega_kernel, dim3(grid_blocks), dim3(512), args, SMEM_BYTES, stream);
    if (e != hipSuccess) fprintf(stderr, "cooperative launch failed: %s (grid %d)\n", hipGetErrorString(e), grid_blocks);
}
```

```cpp
#include <hip/hip_runtime.h>
#include <hip/hip_cooperative_groups.h>
#include <cstdint>
#include <cstdio>
namespace cg = cooperative_groups;

#ifndef MULTI
#define MULTI 0
#endif

typedef unsigned short bf16_t;
typedef short bf16x8 __attribute__((ext_vector_type(8)));
typedef float f32x4 __attribute__((ext_vector_type(4)));
typedef __bf16 bfv2 __attribute__((ext_vector_type(2)));
typedef float f32x2 __attribute__((ext_vector_type(2)));
typedef unsigned u32x4 __attribute__((ext_vector_type(4)));
typedef unsigned u32x2 __attribute__((ext_vector_type(2)));
#define DEV __device__ __forceinline__
DEV int opaque_tid() { int t = threadIdx.x & 255; asm volatile("" : "+v"(t)); return t; }
DEV int opaque_tid512() { int t = threadIdx.x; asm volatile("" : "+v"(t)); return t; }
#define MFMA16(a, b, c) __builtin_amdgcn_mfma_f32_16x16x32_bf16((a), (b), (c), 0, 0, 0)

constexpr int T = 16384, S = 2048;
constexpr int ZW = 4480;
constexpr int C_Q = 0, C_KC = 1024, C_VC = 1280, C_KS = 1536, C_KW = 1792, C_XR = 2048, C_GR = 3072, C_QX = 4096, C_G = 4352;
constexpr int NCMP = 127;
constexpr int NCROWS = 4064;

constexpr size_t O_WTA = 0;
constexpr size_t O_WTB = O_WTA + (size_t)5120 * 1024 * 2;
constexpr size_t O_WTUP = O_WTB + (size_t)4096 * 1024 * 2;
constexpr size_t O_WTDN = O_WTUP + (size_t)4096 * 1024 * 2;
constexpr size_t O_WTO = O_WTDN + (size_t)4096 * 1024 * 2;
constexpr size_t O_WTXO = O_WTO + (size_t)1024 * 1024 * 2;
constexpr size_t O_WTMKV = O_WTXO + (size_t)1024 * 256 * 2;
constexpr size_t O_WTCK1 = O_WTMKV + (size_t)512 * 1024 * 2;
constexpr size_t O_WTCV1 = O_WTCK1 + (size_t)256 * 2048 * 2;
constexpr size_t O_WAT = O_WTCV1 + (size_t)256 * 2048 * 2;
constexpr size_t O_WIT = O_WAT + (size_t)16 * 64 * 64 * 2;
constexpr size_t O_ROPEC = O_WIT + (size_t)16 * 64 * 64 * 2;
constexpr size_t O_ROPES = O_ROPEC + (size_t)2048 * 8 * 4;
constexpr size_t O_MEMN = O_ROPES + (size_t)2048 * 8 * 4;
constexpr size_t O_MEMK = O_MEMN + (size_t)2048 * 1024 * 2;
constexpr size_t O_MEMVT = O_MEMK + (size_t)2048 * 256 * 2;
constexpr size_t O_HIDK = O_MEMVT + (size_t)2048 * 256 * 2;
constexpr size_t O_HIDV = O_HIDK + (size_t)4096 * 256 * 2;
constexpr size_t O_KC = O_HIDV + (size_t)4096 * 256 * 2;
constexpr size_t O_VCT = O_KC + (size_t)32 * 128 * 64 * 2;
constexpr size_t O_PB = O_VCT + (size_t)32 * 64 * 128 * 2;
constexpr size_t O_AUX_END = O_PB + 16384;
static_assert(O_AUX_END <= (size_t)64 << 20, "aux overflow");
constexpr size_t MiB = (size_t)1 << 20;
constexpr size_t W_U = 0, W_ZA = 32 * MiB, W_VST = 172 * MiB, W_VWT = 180 * MiB, W_YX = 188 * MiB, W_Y = 220 * MiB;
constexpr size_t W_H = 32 * MiB, W_VN = 0, W_HID = 96 * MiB;

struct Params {
    const float *x, *mem, *g_mix, *w_in, *cpk, *cpv, *wk1, *wk2, *wv1, *wv2, *conv_w, *conv_b, *w_a, *b_a, *w_i, *b_i, *lam,
        *g_mem, *w_mkv, *w_xo, *w_o, *g_mlp, *w_up, *w_down, *g_final;
    float* out;
    char* ws;
};

DEV float bf2f(bf16_t h) { return __uint_as_float(((unsigned)h) << 16); }
DEV unsigned pk2(float lo, float hi) { f32x2 v = {lo, hi}; bfv2 b = __builtin_convertvector(v, bfv2); return __builtin_bit_cast(unsigned, b); }
DEV bf16_t f2bf(float f) { return (bf16_t)(pk2(f, 0.f) & 0xffffu); }
DEV float lo_f(unsigned u) { return __uint_as_float(u << 16); }
DEV float hi_f(unsigned u) { return __uint_as_float(u & 0xffff0000u); }
DEV float sigm(float x) { return __builtin_amdgcn_rcpf(1.f + __expf(-x)); }
DEV float gelu_t(float x) {
    float y = 0.7978845608028654f * (x + 0.044715f * x * x * x);
    float e = __expf(2.f * y);
    float th = 1.f - 2.f * __builtin_amdgcn_rcpf(1.f + e);
    return 0.5f * x * (1.f + th);
}
DEV float wave_sum(float v) {
#pragma unroll
    for (int o = 32; o >= 1; o >>= 1) v += __shfl_xor(v, o);
    return v;
}

DEV int map_col(int mapid, int r) {
    if (mapid == 0) return r;
    if (mapid == 1) {
        if (r < 1536) return r;
        if (r < 1792) return 1536 + (r - 1536);
        if (r < 2048) return 2048 + (r - 1792);
        if (r < 3072) return 2608 + (r - 2048);
        if (r < 4096) return 3632 + (r - 3072);
        if (r < 4352) return 4656 + (r - 4096);
        if (r < 4608) return 1792 + (r - 4352);
        if (r < 4864) return 2304 + (r - 4608);
        if (r < 4912) return 2560 + (r - 4864);
        return -1;
    }
    const int pn = r >> 8, rem = r & 255, bj = rem >> 7, wc = (rem >> 5) & 3, n = (rem >> 4) & 1, c16 = rem & 15, slot = 2 * bj + n;
    if (slot == 3) return -1;
    return 4912 + slot * 1024 + pn * 64 + wc * 16 + c16;
}

DEV void transpose_tile(const float* __restrict__ src, int ld, bf16_t* __restrict__ dst, int K, int r0, int k0, int mapid, char* smem, int nblk = 0) {
    float* sm = (float*)smem;
    const int tid = threadIdx.x & 255, lane = tid & 63, w = tid >> 6;
    __syncthreads();
    const int sc = map_col(mapid, r0 + lane);
#pragma unroll
    for (int i = 0; i < 16; ++i) {
        int kk = w + 4 * i;
        float v = sc >= 0 ? src[(size_t)(k0 + kk) * ld + sc] : 0.f;
        sm[kk * 65 + lane] = v;
    }
    __syncthreads();
    const int rr = tid >> 2, kq = (tid & 3) * 16;
    unsigned o[8];
#pragma unroll
    for (int e = 0; e < 8; ++e) o[e] = pk2(sm[(kq + 2 * e) * 65 + rr], sm[(kq + 2 * e + 1) * 65 + rr]);
    uint4* dp = nblk ? (uint4*)(dst + (size_t)(k0 >> 6) * nblk * 64 + (size_t)(r0 + rr) * 64 + kq) : (uint4*)(dst + (size_t)(r0 + rr) * K + k0 + kq);
    dp[0] = make_uint4(o[0], o[1], o[2], o[3]);
    dp[1] = make_uint4(o[4], o[5], o[6], o[7]);
}

template <bool OUTF32>
DEV void rownorm(const float* __restrict__ src, const float* __restrict__ g, bf16_t* dstb, float* dstf, int row, bool blk = false) {
    const int lane = opaque_tid() & 63;
    const float4* sp = (const float4*)(src + (size_t)row * 1024);
    float4 v[4];
    float ss = 0.f;
#pragma unroll
    for (int i = 0; i < 4; ++i) { v[i] = sp[lane + 64 * i]; ss += v[i].x * v[i].x + v[i].y * v[i].y + v[i].z * v[i].z + v[i].w * v[i].w; }
    ss = wave_sum(ss);
    const float r = rsqrtf(ss * (1.0f / 1024.0f) + 1e-6f);
#pragma unroll
    for (int i = 0; i < 4; ++i) {
        float4 gg = ((const float4*)g)[lane + 64 * i];
        float a = v[i].x * r * gg.x, b = v[i].y * r * gg.y, c = v[i].z * r * gg.z, d = v[i].w * r * gg.w;
        if (OUTF32) ((float4*)(dstf + (size_t)row * 1024))[lane + 64 * i] = make_float4(a, b, c, d);
        else if (blk) { const int col = 4 * (lane + 64 * i); *(uint2*)(dstb + (size_t)(col >> 6) * ((size_t)16384 * 64) + (size_t)row * 64 + (col & 63)) = make_uint2(pk2(a, b), pk2(c, d)); }
        else ((uint2*)(dstb + (size_t)row * 1024))[lane + 64 * i] = make_uint2(pk2(a, b), pk2(c, d));
    }
}

DEV void rope_job(float* ct, float* st, int job) {
    const int e = job * 256 + (threadIdx.x & 255);
    const int pos = e >> 3, i = e & 7;
    const double inv = exp(-(double)i * 0.125 * 13.122363377404328);
    const double ang = (double)pos * inv;
    const double kq = rint(ang * 0.6366197723675814);
    const double r = ang - kq * 1.5707963267948966;
    const double r2 = r * r;
    const double sn = r * (1.0 + r2 * (-1.0 / 6 + r2 * (1.0 / 120 + r2 * (-1.0 / 5040 + r2 * (1.0 / 362880 + r2 * (-1.0 / 39916800 + r2 * (1.0 / 6227020800.0)))))));
    const double cs = 1.0 + r2 * (-0.5 + r2 * (1.0 / 24 + r2 * (-1.0 / 720 + r2 * (1.0 / 40320 + r2 * (-1.0 / 3628800 + r2 * (1.0 / 479001600.0))))));
    const int q = ((int)kq) & 3;
    double s_, c_;
    if (q == 0) { s_ = sn; c_ = cs; } else if (q == 1) { s_ = cs; c_ = -sn; } else if (q == 2) { s_ = -sn; c_ = -cs; } else { s_ = -cs; c_ = sn; }
    ct[e] = (float)c_; st[e] = (float)s_;
}

DEV void posbias_job(const Params& P, float* PB, int job, char* smem) {
    float* sred = (float*)smem;
    const int tid = opaque_tid(), which = job >> 5, cgi = (job >> 3) & 3, kc = job & 7, c = cgi * 64 + (tid & 63), kp = tid >> 6;
    const float* pos = (which ? P.cpv : P.cpk) + kc * 256 + kp * 64;
    const float* w1 = (which ? P.wv1 : P.wk1) + (size_t)(kc * 256 + kp * 64) * 256 + c;
    float a0 = 0.f, a1 = 0.f, a2 = 0.f, a3 = 0.f;
#pragma unroll 4
    for (int k = 0; k < 64; k += 4) {
        a0 += pos[k] * w1[(size_t)k * 256]; a1 += pos[k + 1] * w1[(size_t)(k + 1) * 256];
        a2 += pos[k + 2] * w1[(size_t)(k + 2) * 256]; a3 += pos[k + 3] * w1[(size_t)(k + 3) * 256];
    }
    __syncthreads();
    sred[kp * 64 + (tid & 63)] = (a0 + a1) + (a2 + a3);
    __syncthreads();
    if (tid < 64) PB[(which * 8 + kc) * 256 + c] = (sred[tid] + sred[64 + tid]) + (sred[128 + tid] + sred[192 + tid]);
}

struct ALPlain {
    const bf16_t* A; int lda; int ks;
    const char* base; unsigned off0;
    DEV void init(int row0, int lrow, int lk) { base = (const char*)(A + (size_t)row0 * lda); off0 = (unsigned)(lrow * lda + lk) * 2u; }
    DEV u32x4 load(int i, int k0) const { return *(const u32x4*)(base + (off0 + (unsigned)(i * 128 * lda) + (unsigned)(k0 >> 6) * (unsigned)(ks * 2))); }
    DEV u32x4 fix(int, const u32x4& v, int) const { return v; }
};
struct ALCmp {
    const bf16_t* ZA; const float* spos; int colbase;
    unsigned roff[4]; int lk_;
    DEV void init(int row0, int lrow, int lk) {
        lk_ = lk;
#pragma unroll
        for (int i = 0; i < 4; ++i) {
            const int row = row0 + lrow + 64 * i;
            const int bg = row / NCMP, n = row - bg * NCMP, b = bg >> 2, g = bg & 3;
            roff[i] = row < NCROWS ? (unsigned)(((b * S + 16 * n) * ZW + colbase + g * 64 + lk) * 2) : 0xffffffffu;
        }
    }
    DEV u32x4 load(int i, int k0) const {
        if (roff[i] == 0xffffffffu) return (u32x4){0u, 0u, 0u, 0u};
        return *(const u32x4*)((const char*)ZA + (roff[i] + (unsigned)((k0 >> 6) * ZW * 2)));
    }
    DEV u32x4 fix(int i, const u32x4& v, int k0) const {
        if (roff[i] == 0xffffffffu) return v;
        const float4 p0 = *(const float4*)(spos + k0 + lk_), p1 = *(const float4*)(spos + k0 + lk_ + 4);
        u32x4 o;
        o.x = pk2(lo_f(v.x) + p0.x, hi_f(v.x) + p0.y); o.y = pk2(lo_f(v.y) + p0.z, hi_f(v.y) + p0.w);
        o.z = pk2(lo_f(v.z) + p1.x, hi_f(v.z) + p1.y); o.w = pk2(lo_f(v.w) + p1.z, hi_f(v.w) + p1.w);
        return o;
    }
};

template <int TM, int TN, bool SWAP, class AL, class EP>
DEV void gemm_tile(AL al, const bf16_t* __restrict__ Bt, int ldb, int bks, int K, int pm, int pn, const EP& ep, char* smem) {
    constexpr int BM = TM * 32, BN = TN * 64, NA = BM / 64, NBB = (BN + 63) / 64;
    bf16_t* sA = (bf16_t*)smem;
    bf16_t* sB = sA + BM * 72;
    const int tid = opaque_tid512(), wid = tid >> 6, lane = tid & 63, wr = wid >> 2, wc = wid & 3, fr = lane & 15, fq = lane >> 4;
    f32x4 acc[TM][TN];
#pragma unroll
    for (int m = 0; m < TM; ++m)
#pragma unroll
        for (int n = 0; n < TN; ++n) acc[m][n] = (f32x4){0.f, 0.f, 0.f, 0.f};
    const int lrow = tid >> 3, lk = (tid & 7) * 8;
    u32x4 ra[NA], rb[NBB];
    al.init(pm * BM, lrow, lk);
    const char* bbase = (const char*)(Bt + (size_t)(pn * BN) * ldb);
    const unsigned boff = (unsigned)(lrow * ldb + lk) * 2u;
#pragma unroll
    for (int i = 0; i < NBB; ++i) rb[i] = (u32x4){0u, 0u, 0u, 0u};
#pragma unroll
    for (int i = 0; i < NA; ++i) ra[i] = al.load(i, 0);
#pragma unroll
    for (int i = 0; i < NBB; ++i) if (BN % 64 == 0 || lrow + 64 * i < BN) rb[i] = *(const u32x4*)(bbase + (boff + (unsigned)(i * 128 * ldb)));
    int nk = K >> 6;
    asm volatile("" : "+s"(nk));
    bf16_t* sWa = sA + lrow * 72 + lk;
    bf16_t* sWb = sB + lrow * 72 + lk;
    const bf16_t* sAr = sA + (wr * TM * 16 + fr) * 72 + fq * 8;
    const bf16_t* sBr = sB + (wc * TN * 16 + fr) * 72 + fq * 8;
#pragma unroll 1
    for (int kt = 0; kt < nk; ++kt) {
        __syncthreads();
#pragma unroll
        for (int i = 0; i < NA; ++i) *(u32x4*)(sWa + (64 * i) * 72) = al.fix(i, ra[i], kt * 64);
#pragma unroll
        for (int i = 0; i < NBB; ++i) if (BN % 64 == 0 || lrow + 64 * i < BN) *(u32x4*)(sWb + (64 * i) * 72) = rb[i];
        __syncthreads();
        if (kt + 1 < nk) {
            const int k0 = (kt + 1) * 64;
#pragma unroll
            for (int i = 0; i < NA; ++i) ra[i] = al.load(i, k0);
#pragma unroll
            for (int i = 0; i < NBB; ++i) if (BN % 64 == 0 || lrow + 64 * i < BN) rb[i] = *(const u32x4*)(bbase + (boff + (unsigned)(i * 128 * ldb) + (unsigned)(k0 >> 6) * (unsigned)(bks * 2)));
        }
        __builtin_amdgcn_sched_barrier(0);
        __builtin_amdgcn_s_setprio(1);
#pragma unroll
        for (int ks = 0; ks < 2; ++ks) {
            bf16x8 bfr[TN];
#pragma unroll
            for (int n = 0; n < TN; ++n) bfr[n] = *(const bf16x8*)(sBr + (n * 16) * 72 + ks * 32);
#pragma unroll
            for (int m = 0; m < TM; ++m) {
                const bf16x8 af = *(const bf16x8*)(sAr + (m * 16) * 72 + ks * 32);
#pragma unroll
                for (int n = 0; n < TN; ++n) acc[m][n] = SWAP ? MFMA16(bfr[n], af, acc[m][n]) : MFMA16(af, bfr[n], acc[m][n]);
            }
        }
        __builtin_amdgcn_s_setprio(0);
    }
    ep.run(acc, pm * BM + wr * TM * 16, pn * BN + wc * TN * 16, fr, fq);
}

DEV uint2 pk4(const f32x4& a) { return make_uint2(pk2(a[0], a[1]), pk2(a[2], a[3])); }

namespace pg8 {
#define PG8_LAS __attribute__((address_space(3)))
typedef unsigned short bf16_t;
typedef short bf16x8 __attribute__((ext_vector_type(8)));
typedef float f32x4 __attribute__((ext_vector_type(4)));
typedef unsigned u32x4 __attribute__((ext_vector_type(4)));
constexpr int BM = 256, BK = 64, HALF = 128, HTB = HALF * BK * 2  , STAGE_BYTES = 8 * HTB, NXCD = 8, WGM = 8;

__host__ __device__ __forceinline__ int lds_byte(int r, int c) { const int st = (r >> 4) * 2 + (c >> 5), rr = r & 15, cc = c & 31, ob = rr * 64 + cc * 2; return st * 1024 + (ob ^ (((ob >> 9) & 1) << 5)); }
__host__ __device__ __forceinline__ void stage_rc(int b, int& R, int& C) { const int st = b / 1024, sb = b % 1024, swz = sb ^ (((sb >> 9) & 1) << 5); R = (st >> 1) * 16 + swz / 64; C = (st & 1) * 32 + (swz % 64) / 2; }
__host__ __device__ __forceinline__ int perm32(int rho) { const int n = rho >> 4, i = rho & 15; return 8 * (i >> 2) + 4 * n + (i & 3); }

struct Unit { int pm, pn; };
struct Gemm { const bf16_t* A; const bf16_t* Bt; int M, N, K, lda, ldb; int gather; };

struct StaticOrder {
    int nM, nN, nwg, G, c;
    __host__ __device__ void init(int M, int N, int G_, int c_) { nM = M / BM; nN = N / BM; nwg = nM * nN; G = G_; c = c_; }
    __host__ __device__ bool next(int i, Unit& u) const {
        const long L = (long)i * G + c; if (L >= nwg) return false;
        int wgid = (int)L; { const int q = nwg / NXCD, r = nwg % NXCD, xcd = wgid % NXCD, off = wgid / NXCD; wgid = (xcd < r ? xcd * (q + 1) : r * (q + 1) + (xcd - r) * q) + off; }
        const int nig = WGM * nN, gid = wgid / nig, fm = gid * WGM, gsz = (nM - fm) < WGM ? (nM - fm) : WGM;
        u.pm = fm + ((wgid % nig) % gsz); u.pn = (wgid % nig) / gsz; return true;
    }
    __device__ __forceinline__ void a_ready(const Unit&) const {}
    __device__ __forceinline__ void done(const Unit&) const {}
};

template <class Epi, class Sched, bool ALIGN_EPI = false, bool SP2 = false>
__device__ __forceinline__ void gemm_phase(PG8_LAS unsigned char* lds, const Gemm g, const Sched& S, const Epi& E) {
    const int tid = opaque_tid512(), wid = __builtin_amdgcn_readfirstlane(tid >> 6), lane = tid & 63, wr = wid >> 2, wc = wid & 3, fr = lane & 15, fq = lane >> 4;
    const int K = g.K, nt = K / BK;
    unsigned voffA2[2][2], voffB[2];
#pragma unroll
    for (int i = 0; i < 2; ++i) { int R, C; stage_rc(tid * 16 + i * 8192, R, C); const int Rb = Epi::PERM ? ((R & ~31) + perm32(R & 31)) : R;
        voffA2[0][i] = (unsigned)(R * g.lda + C) * 2u; voffA2[1][i] = voffA2[0][i]; voffB[i] = (unsigned)(Rb * g.ldb + C) * 2u; }
    const size_t kstepB = (size_t)(BK * 2), kstepA = g.gather ? (size_t)(ZW * 2) : kstepB;
    const size_t hstepA = g.gather ? (size_t)0 : (size_t)HALF * g.lda * 2, hstepB = (size_t)HALF * g.ldb * 2;
    const size_t tstepA = 2 * hstepA, tstepB = 2 * hstepB;
    const unsigned ldsw = (unsigned)wid * 1024u;
    const int aoff = lds_byte(wr * 64 + fr, fq * 8), boff = lds_byte(wc * 32 + fr, fq * 8);
#define PG8_SA(b, h) (((b) * 2 + (h)) * HTB)
#define PG8_SB(b, h) ((4 + (b) * 2 + (h)) * HTB)
#define PG8_STAGE(bufoff, gbase, voff) do { _Pragma("unroll") for (int _i = 0; _i < 2; ++_i) \
        __builtin_amdgcn_global_load_lds((const unsigned*)((const char*)(gbase) + (voff)[_i]), (PG8_LAS unsigned*)(lds + (bufoff) + ldsw + _i * 8192), 16, 0, 0); } while (0)
#define PG8_LDA(dst, b, h) do { _Pragma("unroll") for (int m = 0; m < 4; ++m) _Pragma("unroll") for (int k = 0; k < 2; ++k) dst[m][k] = *(const PG8_LAS bf16x8*)(lds + PG8_SA(b, h) + aoff + m * 2048 + k * 1024); } while (0)
#define PG8_LDB(dst, b, h) do { _Pragma("unroll") for (int n = 0; n < 2; ++n) _Pragma("unroll") for (int k = 0; k < 2; ++k) dst[n][k] = *(const PG8_LAS bf16x8*)(lds + PG8_SB(b, h) + boff + n * 2048 + k * 1024); } while (0)
#define PG8_MMA(ai, bj, At, Bt) do { __builtin_amdgcn_s_setprio(1); _Pragma("unroll") for (int m = 0; m < 4; ++m) _Pragma("unroll") for (int n = 0; n < 2; ++n) _Pragma("unroll") for (int k = 0; k < 2; ++k) \
        acc[ai][bj][m][n] = __builtin_amdgcn_mfma_f32_16x16x32_bf16(Bt[n][k], At[m][k], acc[ai][bj][m][n], 0, 0, 0); __builtin_amdgcn_s_setprio(0); } while (0)
#define PG8_WAIT_V(n) asm volatile("s_waitcnt vmcnt(" #n ")" ::: "memory")
#define PG8_WAIT_L(n) asm volatile("s_waitcnt lgkmcnt(" #n ")" ::: "memory")
#define PG8_BAR __builtin_amdgcn_s_barrier()
#define PG8_SCHED __builtin_amdgcn_sched_barrier(0)
    Unit cur, nxt; int ui = 0;
    if (!S.next(0, cur)) return;
    f32x4 acc[2][2][4][2];
#pragma unroll
    for (int a = 0; a < 2; ++a)
#pragma unroll
        for (int b = 0; b < 2; ++b)
#pragma unroll
            for (int m = 0; m < 4; ++m)
#pragma unroll
                for (int n = 0; n < 2; ++n) acc[a][b][m][n] = (f32x4){0.f, 0.f, 0.f, 0.f};
    bf16x8 At[4][2], B0[2][2], B1[2][2];
    const char* cA = (const char*)g.A + (g.gather ? (size_t)0 : (size_t)cur.pm * tstepA); const char* cB = (const char*)g.Bt + (size_t)cur.pn * tstepB;
    if (g.gather) {
#pragma unroll
        for (int h = 0; h < 2; ++h)
#pragma unroll
            for (int i = 0; i < 2; ++i) { int R, C; stage_rc(tid * 16 + i * 8192, R, C);
                int r = cur.pm * 256 + h * HALF + R; r = r < NCROWS ? r : NCROWS - 1;
                const int bg = r / NCMP, n = r - bg * NCMP;
                voffA2[h][i] = (unsigned)((((bg >> 2) * ::S + 16 * n) * ZW + (cur.pn ? C_VC : C_KC) + (bg & 3) * 64 + C) * 2); }
    }
    S.a_ready(cur);
    if constexpr (SP2) {
        PG8_STAGE(PG8_SB(0, 0), cB, voffB); PG8_STAGE(PG8_SB(0, 1), cB + hstepB, voffB); PG8_STAGE(PG8_SA(0, 0), cA, voffA2[0]); PG8_STAGE(PG8_SA(0, 1), cA + hstepA, voffA2[1]);
        if (wr == 1) PG8_BAR;
        PG8_WAIT_V(2); PG8_BAR;
        PG8_STAGE(PG8_SB(1, 0), cB + kstepB, voffB); PG8_STAGE(PG8_SA(1, 0), cA + kstepA, voffA2[0]); PG8_STAGE(PG8_SB(1, 1), cB + hstepB + kstepB, voffB);
        PG8_WAIT_V(6); PG8_BAR;
    } else {
        PG8_STAGE(PG8_SB(0, 0), cB, voffB); PG8_STAGE(PG8_SA(0, 0), cA, voffA2[0]); PG8_STAGE(PG8_SB(0, 1), cB + hstepB, voffB); PG8_STAGE(PG8_SA(0, 1), cA + hstepA, voffA2[1]);
        if (wr == 1) PG8_BAR;
        PG8_WAIT_V(4); PG8_BAR;
        PG8_STAGE(PG8_SB(1, 0), cB + kstepB, voffB); PG8_STAGE(PG8_SA(1, 0), cA + kstepA, voffA2[0]); PG8_STAGE(PG8_SB(1, 1), cB + hstepB + kstepB, voffB);
        PG8_WAIT_V(6); PG8_BAR;
    }
    for (;;) {
        const bool has_next = S.next(ui + 1, nxt);
        const char* nA = has_next ? (const char*)g.A + (size_t)nxt.pm * tstepA : cA; const char* nB = has_next ? (const char*)g.Bt + (size_t)nxt.pn * tstepB : cB;
        for (int t = 0; t < nt; t += 2) {
            const bool last = (t == nt - 2);
            const char* a1 = cA + (size_t)(t + 1) * kstepA;
            const char* a2 = last ? nA : cA + (size_t)(t + 2) * kstepA; const char* b2 = last ? nB : cB + (size_t)(t + 2) * kstepB;
            const char* a3 = a2 + kstepA; const char* b3 = b2 + kstepB;
            if (last && has_next) S.a_ready(nxt);
            if constexpr (SP2) {
            PG8_LDB(B0, 0, 0); PG8_LDB(B1, 0, 1); PG8_SCHED; PG8_LDA(At, 0, 0); PG8_STAGE(PG8_SA(1, 1), a1 + hstepA, voffA2[1]);
            PG8_WAIT_V(8); PG8_WAIT_L(0); PG8_BAR; PG8_MMA(0, 0, At, B0); PG8_MMA(0, 1, At, B1); PG8_BAR; PG8_SCHED;
            PG8_LDA(At, 0, 1); PG8_STAGE(PG8_SB(0, 0), b2, voffB); PG8_STAGE(PG8_SB(0, 1), b2 + hstepB, voffB); PG8_STAGE(PG8_SA(0, 0), a2, voffA2[0]);
            PG8_WAIT_V(8); PG8_WAIT_L(0); PG8_BAR; PG8_MMA(1, 0, At, B0); PG8_MMA(1, 1, At, B1); PG8_BAR; PG8_SCHED;
            PG8_LDB(B0, 1, 0); PG8_LDB(B1, 1, 1); PG8_SCHED; PG8_LDA(At, 1, 0); PG8_STAGE(PG8_SA(0, 1), a2 + hstepA, voffA2[1]);
            PG8_WAIT_V(8); PG8_WAIT_L(0); PG8_BAR; PG8_MMA(0, 0, At, B0); PG8_MMA(0, 1, At, B1); PG8_BAR; PG8_SCHED;
            PG8_LDA(At, 1, 1); PG8_STAGE(PG8_SB(1, 0), b3, voffB); PG8_STAGE(PG8_SB(1, 1), b3 + hstepB, voffB); PG8_STAGE(PG8_SA(1, 0), a3, voffA2[0]);
            PG8_WAIT_V(8); PG8_WAIT_L(0); PG8_BAR; PG8_MMA(1, 0, At, B0); PG8_MMA(1, 1, At, B1); PG8_BAR; PG8_SCHED;
            } else {
            PG8_LDB(B0, 0, 0); PG8_SCHED; PG8_LDA(At, 0, 0); PG8_STAGE(PG8_SA(1, 1), a1 + hstepA, voffA2[1]);
            PG8_WAIT_L(8); PG8_BAR; PG8_WAIT_L(0); PG8_MMA(0, 0, At, B0); PG8_BAR; PG8_SCHED;
            PG8_LDB(B1, 0, 1); PG8_STAGE(PG8_SB(0, 0), b2, voffB);
            PG8_BAR; PG8_WAIT_L(0); PG8_MMA(0, 1, At, B1); PG8_BAR;
            PG8_LDA(At, 0, 1); PG8_STAGE(PG8_SA(0, 0), a2, voffA2[0]);
            PG8_BAR; PG8_WAIT_L(0); PG8_MMA(1, 0, At, B0); PG8_BAR; PG8_SCHED;
            PG8_STAGE(PG8_SB(0, 1), b2 + hstepB, voffB);
            PG8_WAIT_V(6); PG8_BAR; PG8_MMA(1, 1, At, B1); PG8_BAR;
            PG8_LDB(B0, 1, 0); PG8_SCHED; PG8_LDA(At, 1, 0); PG8_STAGE(PG8_SA(0, 1), a2 + hstepA, voffA2[1]);
            PG8_WAIT_L(8); PG8_BAR; PG8_WAIT_L(0); PG8_MMA(0, 0, At, B0); PG8_BAR; PG8_SCHED;
            PG8_LDB(B1, 1, 1); PG8_STAGE(PG8_SB(1, 0), b3, voffB);
            PG8_BAR; PG8_WAIT_L(0); PG8_MMA(0, 1, At, B1); PG8_BAR;
            PG8_LDA(At, 1, 1); PG8_STAGE(PG8_SA(1, 0), a3, voffA2[0]);
            PG8_BAR; PG8_WAIT_L(0); PG8_MMA(1, 0, At, B0); PG8_BAR; PG8_SCHED;
            PG8_STAGE(PG8_SB(1, 1), b3 + hstepB, voffB);
            PG8_WAIT_V(6); PG8_BAR; PG8_MMA(1, 1, At, B1); PG8_BAR;
            }
        }
        if constexpr (ALIGN_EPI) { if (wr == 0) PG8_BAR; }
        if constexpr (!Epi::AFTER_DRAIN) { E(acc, cur, wr, wc, fr, fq); S.done(cur); }
        if (!has_next) break;
#pragma unroll
        for (int a = 0; a < 2; ++a)
#pragma unroll
            for (int b = 0; b < 2; ++b)
#pragma unroll
                for (int m = 0; m < 4; ++m)
#pragma unroll
                    for (int n = 0; n < 2; ++n) acc[a][b][m][n] = (f32x4){0.f, 0.f, 0.f, 0.f};
        cur = nxt; cA = nA; cB = nB; ++ui;
        if constexpr (ALIGN_EPI) { if (wr == 1) PG8_BAR; }
    }
    PG8_WAIT_V(0);
    if constexpr (!ALIGN_EPI) { if (wr == 0) PG8_BAR; }
    PG8_BAR;
    if constexpr (Epi::AFTER_DRAIN) { E.fused(acc, cur, wr, wc, fr, fq, lds, wid, lane); S.done(cur); }
#undef PG8_SA
#undef PG8_SB
#undef PG8_STAGE
#undef PG8_LDA
#undef PG8_LDB
#undef PG8_MMA
#undef PG8_WAIT_V
#undef PG8_WAIT_L
#undef PG8_BAR
#undef PG8_SCHED
}
}

struct EpiHid {
    bf16_t* H;
    DEV void run(f32x4 (&acc)[8][4], int R0, int C0, int fr, int fq) const {
#pragma unroll
        for (int n = 0; n < 4; ++n)
#pragma unroll
            for (int m = 0; m < 8; ++m) {
                const int c = C0 + n * 16 + 4 * fq, r = R0 + m * 16 + fr;
                f32x4 a = acc[m][n];
#pragma unroll
                for (int j = 0; j < 4; ++j) a[j] = gelu_t(a[j]);
                if (r < NCROWS) *(uint2*)(H + (size_t)r * 256 + c) = pk4(a);
            }
    }
};
#define PG8_EPI_HEAD static constexpr bool PERM = false, AFTER_DRAIN = false;
#define PG8_FOR_TILES _Pragma("unroll") for (int ai = 0; ai < 2; ++ai) _Pragma("unroll") for (int bj = 0; bj < 2; ++bj) _Pragma("unroll") for (int m = 0; m < 4; ++m) _Pragma("unroll") for (int n = 0; n < 2; ++n)
struct PEpiZA {
    PG8_EPI_HEAD
    bf16_t *ZA, *VST, *VWT; const float *ropec, *ropes;
    DEV void operator()(const f32x4 (&acc)[2][2][4][2], const pg8::Unit& u, int wr, int wc, int fr, int fq) const {
        asm volatile("" : "+v"(fr), "+v"(fq));
        PG8_FOR_TILES {
            const int row = u.pm * 256 + ai * 128 + wr * 64 + m * 16 + fr, col0 = u.pn * 256 + bj * 128 + wc * 32 + n * 16;
            f32x4 a = acc[ai][bj][m][n];
            if (u.pn == 17 || u.pn == 18) {
                bf16_t* dst = (u.pn == 17) ? VST : VWT;
                const int c = (col0 & 255) + 4 * fq, b = row >> 11, t = row & 2047;
#pragma unroll
                for (int j = 0; j < 4; ++j) { const int cc = c + j; dst[((size_t)((b * 4 + (cc >> 6)) * 64 + (cc & 63))) * S + t] = f2bf(a[j]); }
            } else {
                const bool rope = (col0 < 1024 || (col0 >= 1536 && col0 < 2048)) && ((col0 & 63) == 0);
                if (rope) {
                    const int t = row & 2047, i0 = 4 * (fq & 1);
                    const float4 cs = *(const float4*)(ropec + t * 8 + i0), sn = *(const float4*)(ropes + t * 8 + i0);
                    const float c4[4] = {cs.x, cs.y, cs.z, cs.w}, s4[4] = {sn.x, sn.y, sn.z, sn.w};
#pragma unroll
                    for (int j = 0; j < 4; ++j) {
                        const float pr = __shfl_xor(a[j], 32);
                        a[j] = (fq & 2) ? (a[j] * c4[j] + pr * s4[j]) : (a[j] * c4[j] - pr * s4[j]);
                    }
                }
                int zc0 = col0;
                if (col0 >= 4864) {
                    zc0 = col0 - 512;
#pragma unroll
                    for (int j = 0; j < 4; ++j) a[j] = sigm(a[j]);
                }
                if (zc0 < ZW) *(uint2*)(ZA + (size_t)row * ZW + zc0 + 4 * fq) = pk4(a);
            }
        }
    }
};
struct PEpiHid {
    PG8_EPI_HEAD
    bf16_t *HK, *HV; const float* pb;
    DEV void operator()(const f32x4 (&acc)[2][2][4][2], const pg8::Unit& u, int wr, int wc, int fr, int fq) const {
        asm volatile("" : "+v"(fr), "+v"(fq));
        bf16_t* H = u.pn ? HV : HK;
        PG8_FOR_TILES {
            const int r = u.pm * 256 + ai * 128 + wr * 64 + m * 16 + fr, c = bj * 128 + wc * 32 + n * 16 + 4 * fq;
            float4 bb = *(const float4*)(pb + (u.pn * 8) * 256 + c);
#pragma unroll
            for (int kc = 1; kc < 8; ++kc) { const float4 t4 = *(const float4*)(pb + (u.pn * 8 + kc) * 256 + c); bb.x += t4.x; bb.y += t4.y; bb.z += t4.z; bb.w += t4.w; }
            f32x4 a = acc[ai][bj][m][n];
            a[0] = gelu_t(a[0] + bb.x); a[1] = gelu_t(a[1] + bb.y); a[2] = gelu_t(a[2] + bb.z); a[3] = gelu_t(a[3] + bb.w);
            if (r < NCROWS) *(uint2*)(H + (size_t)r * 256 + c) = pk4(a);
        }
    }
};
struct PEpiMemKV {
    PG8_EPI_HEAD
    bf16_t *MK, *MVT;
    DEV void operator()(const f32x4 (&acc)[2][2][4][2], const pg8::Unit& u, int wr, int wc, int fr, int fq) const {
        asm volatile("" : "+v"(fr), "+v"(fq));
        PG8_FOR_TILES {
            const int r = u.pm * 256 + ai * 128 + wr * 64 + m * 16 + fr, c = u.pn * 256 + bj * 128 + wc * 32 + n * 16 + 4 * fq;
            const int b = r >> 8, mm = r & 255;
            const f32x4 a = acc[ai][bj][m][n];
            if (u.pn == 0) { const int h = (c >> 6) & 3, d = c & 63; *(uint2*)(MK + ((size_t)(b * 4 + h) * 256 + mm) * 64 + d) = pk4(a); }
            else {
#pragma unroll
                for (int j = 0; j < 4; ++j) { const int cc = c + j, h = (cc >> 6) & 3, d = cc & 63; MVT[((size_t)(b * 4 + h) * 64 + d) * 256 + mm] = f2bf(a[j]); }
            }
        }
    }
};
template <int ACT>
struct PEpiBf {
    PG8_EPI_HEAD
    bf16_t* O; int ldo;
    DEV void operator()(const f32x4 (&acc)[2][2][4][2], const pg8::Unit& u, int wr, int wc, int fr, int fq) const {
        asm volatile("" : "+v"(fr), "+v"(fq));
        PG8_FOR_TILES {
            const int r = u.pm * 256 + ai * 128 + wr * 64 + m * 16 + fr, c = u.pn * 256 + bj * 128 + wc * 32 + n * 16 + 4 * fq;
            f32x4 a = acc[ai][bj][m][n];
            if (ACT == 1) {
#pragma unroll
                for (int j = 0; j < 4; ++j) { const float v = fmaxf(a[j], 0.f); a[j] = v * v; }
            }
            *(uint2*)(O + (size_t)r * ldo + c) = pk4(a);
        }
    }
};
struct PEpiRes {
    PG8_EPI_HEAD
    const float* R; float* O;
    DEV void operator()(const f32x4 (&acc)[2][2][4][2], const pg8::Unit& u, int wr, int wc, int fr, int fq) const {
        asm volatile("" : "+v"(fr), "+v"(fq));
        PG8_FOR_TILES {
            const size_t o = (size_t)(u.pm * 256 + ai * 128 + wr * 64 + m * 16 + fr) * 1024 + u.pn * 256 + bj * 128 + wc * 32 + n * 16 + 4 * fq;
            const f32x4 r = *(const f32x4*)(R + o);
            *(f32x4*)(O + o) = r + acc[ai][bj][m][n];
        }
    }
};
struct PEpiMerge {
    PG8_EPI_HEAD
    const bf16_t *ZA, *YX; bf16_t* Y;
    DEV void operator()(const f32x4 (&acc)[2][2][4][2], const pg8::Unit& u, int wr, int wc, int fr, int fq) const {
        asm volatile("" : "+v"(fr), "+v"(fq));
        const int ch = u.pn * 64 + wc * 16 + 4 * fq;
#pragma unroll
        for (int ai = 0; ai < 2; ++ai)
#pragma unroll
            for (int m = 0; m < 4; ++m) {
                const size_t row = (size_t)(u.pm * 256 + ai * 128 + wr * 64 + m * 16 + fr);
                const uint2 a = *(const uint2*)(ZA + row * ZW + C_Q + ch), b = *(const uint2*)(ZA + row * ZW + C_GR + ch), c = *(const uint2*)(YX + row * 1024 + ch);
                const f32x4 g0 = acc[ai][0][m][0], g1 = acc[ai][0][m][1], g2 = acc[ai][1][m][0];
                f32x4 y;
                y[0] = sigm(g0[0]) * lo_f(a.x) + sigm(g1[0]) * lo_f(b.x) + sigm(g2[0]) * lo_f(c.x);
                y[1] = sigm(g0[1]) * hi_f(a.x) + sigm(g1[1]) * hi_f(b.x) + sigm(g2[1]) * hi_f(c.x);
                y[2] = sigm(g0[2]) * lo_f(a.y) + sigm(g1[2]) * lo_f(b.y) + sigm(g2[2]) * lo_f(c.y);
                y[3] = sigm(g0[3]) * hi_f(a.y) + sigm(g1[3]) * hi_f(b.y) + sigm(g2[3]) * hi_f(c.y);
                *(uint2*)(Y + row * 1024 + ch) = pk4(y);
            }
    }
};

DEV bool tile_map(int idx, int NT, int& pm, int& pn) {
    const int x = idx & 7, pl = (idx >> 3) & 3, pmid = (idx >> 5) & 7, st = idx >> 8;
    pm = pmid * 8 + x;
    pn = st * 4 + pl;
    return pn < NT;
}
DEV int tile_count(int NT) { return ((NT + 3) / 4) * 256; }

DEV void cmp2_job(const Params& P, int job) {
    char* aux = (char*)P.out;
    const int lane = threadIdx.x & 63, w = (threadIdx.x & 255) >> 6;
    const int wj = job * 4 + w;
    const int which = wj >= NCROWS ? 1 : 0;
    const int r = wj - which * NCROWS;
    const int bg = r / NCMP, n = r - bg * NCMP;
    const bf16_t* hid = (const bf16_t*)(aux + (which ? O_HIDV : O_HIDK)) + (size_t)r * 256;
    const float* w2 = which ? P.wv2 : P.wk2;
    float acc = 0.f;
#pragma unroll 8
    for (int k = 0; k < 256; ++k) acc += bf2f(hid[k]) * w2[k * 64 + lane];
    if (!which) {
        const int pos = 16 * n + 31, i = lane & 7;
        const float cs = ((const float*)(aux + O_ROPEC))[pos * 8 + i], sn = ((const float*)(aux + O_ROPES))[pos * 8 + i];
        const float pr = __shfl_xor(acc, 8);
        float o = acc;
        if (lane < 16) o = (lane & 8) ? (acc * cs + pr * sn) : (acc * cs - pr * sn);
        bf16_t* KC = (bf16_t*)(aux + O_KC);
        KC[((size_t)bg * 128 + n) * 64 + lane] = f2bf(o);
        if (n == NCMP - 1) KC[((size_t)bg * 128 + 127) * 64 + lane] = 0;
    } else {
        bf16_t* VCT = (bf16_t*)(aux + O_VCT);
        VCT[((size_t)bg * 64 + lane) * 128 + n] = f2bf(acc);
        if (n == NCMP - 1) VCT[((size_t)bg * 64 + lane) * 128 + 127] = 0;
    }
}

DEV void rnn_job(const Params& P, int job, char* smem, bool dry) {
    char* aux = (char*)P.out;
    bf16_t* ZA = (bf16_t*)(P.ws + W_ZA);
    const int b = job >> 6, n = (job >> 2) & 15, ct = job & 3;
    bf16_t* sX = (bf16_t*)smem;
    float* sXf = (float*)(smem + 9216);
    float* sCw = (float*)(smem + 9216 + 16640);
    float* sSum = (float*)(smem + 9216 + 16640 + 1280);
    bf16_t* sRaw = (bf16_t*)(smem + 9216 + 16640 + 1280 + 2048);
    const int tid = opaque_tid(), w = tid >> 6, lane = tid & 63, fr = lane & 15, fq = lane >> 4;
    const bf16_t* WAT = (const bf16_t*)(aux + O_WAT) + n * 4096;
    const bf16_t* WIT = (const bf16_t*)(aux + O_WIT) + n * 4096;
    bf16x8 wa[2], wi[2];
#pragma unroll
    for (int ks = 0; ks < 2; ++ks) {
        wa[ks] = *(const bf16x8*)(WAT + (16 * ct + fr) * 64 + 32 * ks + 8 * fq);
        wi[ks] = *(const bf16x8*)(WIT + (16 * ct + fr) * 64 + 32 * ks + 8 * fq);
    }
    const int c = n * 64 + 16 * ct + fr;
    const float ba = P.b_a[c], bi = P.b_i[c], cl = -8.0f * log1pf(__expf(-P.lam[c]));
    float carry = 0.f;
    __syncthreads();
    for (int i = tid; i < 320; i += 256) sCw[i] = (i < 256) ? P.conv_w[(i >> 6) * 1024 + n * 64 + (i & 63)] : P.conv_b[n * 64 + (i & 63)];
    const int lt = tid >> 2, cg = (tid & 3) * 16;
    const bf16_t* xbase = ZA + (size_t)(b * S) * ZW + C_XR + n * 64 + cg;
    bf16_t* sRaw2 = sRaw + 67 * 72;
    u32x4 xm0, xm1, xh0 = {0u, 0u, 0u, 0u}, xh1 = {0u, 0u, 0u, 0u};
    { const u32x4* xp = (const u32x4*)(xbase + (size_t)lt * ZW); xm0 = xp[0]; xm1 = xp[1]; }
    *(u32x4*)(sRaw + (lt + 3) * 72 + cg) = xm0; *(u32x4*)(sRaw + (lt + 3) * 72 + cg + 8) = xm1;
    if (tid < 12) { *(u32x4*)(sRaw + lt * 72 + cg) = xh0; *(u32x4*)(sRaw + lt * 72 + cg + 8) = xh1; }
    { const u32x4* xp = (const u32x4*)(xbase + (size_t)(64 + lt) * ZW); xm0 = xp[0]; xm1 = xp[1];
      if (tid < 12) { const u32x4* hp = (const u32x4*)(xbase + (size_t)(61 + lt) * ZW); xh0 = hp[0]; xh1 = hp[1]; } }
    __syncthreads();
#pragma unroll 1
    for (int chunk = 0; chunk < 32; ++chunk) {
        const int tc = chunk * 64;
        const bf16_t* rawc = (chunk & 1) ? sRaw2 : sRaw;
        bf16_t* rawn = (chunk & 1) ? sRaw : sRaw2;
        bf16_t gv[4];
#pragma unroll
        for (int j = 0; j < 4; ++j) gv[j] = ZA[(size_t)(b * S + tc + 16 * w + 4 * fq + j) * ZW + C_GR + n * 64 + 16 * ct + fr];
        {
            float xv[16];
#pragma unroll
            for (int e4 = 0; e4 < 4; ++e4) { const float4 bb = *(const float4*)(sCw + 256 + cg + 4 * e4); xv[4 * e4] = bb.x; xv[4 * e4 + 1] = bb.y; xv[4 * e4 + 2] = bb.z; xv[4 * e4 + 3] = bb.w; }
#pragma unroll
            for (int k = 0; k < 4; ++k) {
                const u32x4 v0 = *(const u32x4*)(rawc + (lt + k) * 72 + cg), v1 = *(const u32x4*)(rawc + (lt + k) * 72 + cg + 8);
                const unsigned u[8] = {v0.x, v0.y, v0.z, v0.w, v1.x, v1.y, v1.z, v1.w};
#pragma unroll
                for (int e4 = 0; e4 < 4; ++e4) {
                    const float4 wv = *(const float4*)(sCw + k * 64 + cg + 4 * e4);
                    xv[4 * e4] += wv.x * lo_f(u[2 * e4]);
                    xv[4 * e4 + 1] += wv.y * hi_f(u[2 * e4]);
                    xv[4 * e4 + 2] += wv.z * lo_f(u[2 * e4 + 1]);
                    xv[4 * e4 + 3] += wv.w * hi_f(u[2 * e4 + 1]);
                }
            }
            if ((tid & 3) == ct) {
#pragma unroll
                for (int e = 0; e < 16; ++e) sXf[lt * 17 + e] = xv[e];
            }
            u32x4 o0 = {pk2(xv[0], xv[1]), pk2(xv[2], xv[3]), pk2(xv[4], xv[5]), pk2(xv[6], xv[7])};
            u32x4 o1 = {pk2(xv[8], xv[9]), pk2(xv[10], xv[11]), pk2(xv[12], xv[13]), pk2(xv[14], xv[15])};
            *(u32x4*)(sX + lt * 72 + cg) = o0;
            *(u32x4*)(sX + lt * 72 + cg + 8) = o1;
        }
        __syncthreads();
        f32x4 R = (f32x4){0.f, 0.f, 0.f, 0.f}, I = (f32x4){0.f, 0.f, 0.f, 0.f};
#pragma unroll
        for (int ks = 0; ks < 2; ++ks) {
            const bf16x8 af = *(const bf16x8*)(sX + (16 * w + fr) * 72 + 32 * ks + 8 * fq);
            R = MFMA16(af, wa[ks], R); I = MFMA16(af, wi[ks], I);
        }
        if (chunk + 1 < 32) {
            *(u32x4*)(rawn + (lt + 3) * 72 + cg) = xm0; *(u32x4*)(rawn + (lt + 3) * 72 + cg + 8) = xm1;
            if (tid < 12) { *(u32x4*)(rawn + lt * 72 + cg) = xh0; *(u32x4*)(rawn + lt * 72 + cg + 8) = xh1; }
        }
        float hl[4], pc[4];
        float h = 0.f, pcum = 1.f;
#pragma unroll
        for (int j = 0; j < 4; ++j) {
            const float xcv = sXf[(16 * w + 4 * fq + j) * 17 + fr];
            const float rg = sigm(R[j] + ba), gi = sigm(I[j] + bi);
            const float la = rg * cl;
            const float a_ = __expf(la);
            const float mult = sqrtf(fmaxf(1.f - a_ * a_, 0.f));
            const float u = mult * gi * xcv;
            h = a_ * h + u; pcum *= a_;
            hl[j] = h; pc[j] = pcum;
        }
        float A = pcum, H = h;
        float A1 = __shfl_up(A, 16), H1 = __shfl_up(H, 16);
        if (fq >= 1) { H = A * H1 + H; A = A * A1; }
        float A2 = __shfl_up(A, 32), H2 = __shfl_up(H, 32);
        if (fq >= 2) { H = A * H2 + H; A = A * A2; }
        float Ax = __shfl_up(A, 16), Hx = __shfl_up(H, 16);
        const float Ae = fq == 0 ? 1.f : Ax, He = fq == 0 ? 0.f : Hx;
        if (fq == 3) { sSum[w * 16 + fr] = A; sSum[64 + w * 16 + fr] = H; }
        __syncthreads();
        if (chunk + 2 < 32) {
            const u32x4* xp = (const u32x4*)(xbase + (size_t)(tc + 128 + lt) * ZW); xm0 = xp[0]; xm1 = xp[1];
            if (tid < 12) { const u32x4* hp = (const u32x4*)(xbase + (size_t)(tc + 125 + lt) * ZW); xh0 = hp[0]; xh1 = hp[1]; }
        }
        float cin = carry, mycin = 0.f;
#pragma unroll
        for (int ww = 0; ww < 4; ++ww) {
            if (ww == w) mycin = cin;
            cin = sSum[ww * 16 + fr] * cin + sSum[64 + ww * 16 + fr];
        }
        carry = cin;
        const float sq = Ae * mycin + He;
#pragma unroll
        for (int j = 0; j < 4; ++j) {
            const float hfin = hl[j] + pc[j] * sq;
            const size_t grow = (size_t)(b * S + tc + 16 * w + 4 * fq + j);
            bf16_t* op = dry ? ((bf16_t*)(P.ws + W_YX) + grow * 1024 + n * 64 + 16 * ct + fr) : (ZA + grow * ZW + C_GR + n * 64 + 16 * ct + fr);
            *op = f2bf(gelu_t(bf2f(gv[j])) * hfin);
        }
    }
}

constexpr float EXPC = 0.125f * 1.4426950408889634f;
struct AttnAcc { f32x4 o[4][2]; float m[2], l[2]; };
DEV void attn_init(AttnAcc& a) {
#pragma unroll
    for (int d = 0; d < 4; ++d)
#pragma unroll
        for (int q = 0; q < 2; ++q) a.o[d][q] = (f32x4){0.f, 0.f, 0.f, 0.f};
    a.m[0] = a.m[1] = -INFINITY; a.l[0] = a.l[1] = 0.f;
}
DEV bf16x8 mk8(unsigned a, unsigned b, unsigned c, unsigned d) { u32x4 u = {a, b, c, d}; return __builtin_bit_cast(bf16x8, u); }

template <class MF>
DEV void attn_step(const bf16_t* sK, const bf16_t* sVt, int vstride, const bf16x8 (&qf)[2][2], AttnAcc& st, const MF& mf, int fr, int fq) {
    f32x4 s[4][2];
#pragma unroll
    for (int kt = 0; kt < 4; ++kt) {
        s[kt][0] = (f32x4){0.f, 0.f, 0.f, 0.f}; s[kt][1] = (f32x4){0.f, 0.f, 0.f, 0.f};
#pragma unroll
        for (int ks = 0; ks < 2; ++ks) {
            const bf16x8 kf = *(const bf16x8*)(sK + (16 * kt + fr) * 80 + 32 * ks + 8 * fq);
            s[kt][0] = MFMA16(kf, qf[0][ks], s[kt][0]);
            s[kt][1] = MFMA16(kf, qf[1][ks], s[kt][1]);
        }
    }
#pragma unroll
    for (int qt = 0; qt < 2; ++qt) {
        float ps = 0.f;
#pragma unroll
        for (int kt = 0; kt < 4; ++kt)
#pragma unroll
            for (int j = 0; j < 4; ++j) {
                const float p = mf(qt, 16 * kt + 4 * fq + j) ? __builtin_amdgcn_exp2f(s[kt][qt][j] * EXPC) : 0.f;
                s[kt][qt][j] = p; ps += p;
            }
        st.l[qt] += ps;
    }
#pragma unroll
    for (int ks = 0; ks < 2; ++ks) {
        bf16x8 pf[2];
#pragma unroll
        for (int qt = 0; qt < 2; ++qt)
            pf[qt] = mk8(pk2(s[2 * ks][qt][0], s[2 * ks][qt][1]), pk2(s[2 * ks][qt][2], s[2 * ks][qt][3]),
                         pk2(s[2 * ks + 1][qt][0], s[2 * ks + 1][qt][1]), pk2(s[2 * ks + 1][qt][2], s[2 * ks + 1][qt][3]));
#pragma unroll
        for (int dt = 0; dt < 4; ++dt) {
            const u32x2 v0 = *(const u32x2*)(sVt + (16 * dt + fr) * vstride + 32 * ks + 4 * fq);
            const u32x2 v1 = *(const u32x2*)(sVt + (16 * dt + fr) * vstride + 32 * ks + 16 + 4 * fq);
            const bf16x8 vf = mk8(v0.x, v0.y, v1.x, v1.y);
            st.o[dt][0] = MFMA16(vf, pf[0], st.o[dt][0]);
            st.o[dt][1] = MFMA16(vf, pf[1], st.o[dt][1]);
        }
    }
}
DEV void attn_step_fast(const bf16_t* sK, const bf16_t* sVt, const bf16x8 (&qf)[2][2], AttnAcc& st, const float (&bitoff)[2], int fr, int fq) {
    f32x4 s[4][2];
#pragma unroll
    for (int kt = 0; kt < 4; ++kt) {
        s[kt][0] = (f32x4){0.f, 0.f, 0.f, 0.f}; s[kt][1] = (f32x4){0.f, 0.f, 0.f, 0.f};
#pragma unroll
        for (int ks = 0; ks < 2; ++ks) {
            const bf16x8 kf = *(const bf16x8*)(sK + (16 * kt + fr) * 80 + 32 * ks + 8 * fq);
            s[kt][0] = MFMA16(kf, qf[0][ks], s[kt][0]);
            s[kt][1] = MFMA16(kf, qf[1][ks], s[kt][1]);
        }
    }
#pragma unroll
    for (int qt = 0; qt < 2; ++qt) {
        const float off = bitoff[qt];
        float ps = 0.f;
#pragma unroll
        for (int kt = 0; kt < 4; ++kt)
#pragma unroll
            for (int j = 0; j < 4; ++j) { const float p = __builtin_amdgcn_exp2f(fmaf(s[kt][qt][j], EXPC, off)); s[kt][qt][j] = p; ps += p; }
        st.l[qt] += ps;
    }
#pragma unroll
    for (int ks = 0; ks < 2; ++ks) {
        bf16x8 pf[2];
#pragma unroll
        for (int qt = 0; qt < 2; ++qt)
            pf[qt] = mk8(pk2(s[2 * ks][qt][0], s[2 * ks][qt][1]), pk2(s[2 * ks][qt][2], s[2 * ks][qt][3]),
                         pk2(s[2 * ks + 1][qt][0], s[2 * ks + 1][qt][1]), pk2(s[2 * ks + 1][qt][2], s[2 * ks + 1][qt][3]));
#pragma unroll
        for (int dt = 0; dt < 4; ++dt) {
            const u32x2 v0 = *(const u32x2*)(sVt + (16 * dt + fr) * 72 + 32 * ks + 4 * fq);
            const u32x2 v1 = *(const u32x2*)(sVt + (16 * dt + fr) * 72 + 32 * ks + 16 + 4 * fq);
            const bf16x8 vf = mk8(v0.x, v0.y, v1.x, v1.y);
            st.o[dt][0] = MFMA16(vf, pf[0], st.o[dt][0]);
            st.o[dt][1] = MFMA16(vf, pf[1], st.o[dt][1]);
        }
    }
}
template <int QT>
DEV void attn_half_fast(const bf16_t* sK, const bf16_t* sVt, const bf16x8 (&qf)[2][2], AttnAcc& st, float bitoff, int fr, int fq) {
    f32x4 s[4];
#pragma unroll
    for (int kt = 0; kt < 4; ++kt) {
        s[kt] = (f32x4){0.f, 0.f, 0.f, 0.f};
#pragma unroll
        for (int ks = 0; ks < 2; ++ks) {
            const bf16x8 kf = *(const bf16x8*)(sK + (16 * kt + fr) * 80 + 32 * ks + 8 * fq);
            s[kt] = MFMA16(kf, qf[QT][ks], s[kt]);
        }
    }
    const float off = bitoff;
    float ps = 0.f;
#pragma unroll
    for (int kt = 0; kt < 4; ++kt)
#pragma unroll
        for (int j = 0; j < 4; ++j) { const float p = __builtin_amdgcn_exp2f(fmaf(s[kt][j], EXPC, off)); s[kt][j] = p; ps += p; }
    st.l[QT] += ps;
#pragma unroll
    for (int ks = 0; ks < 2; ++ks) {
        const bf16x8 pf = mk8(pk2(s[2 * ks][0], s[2 * ks][1]), pk2(s[2 * ks][2], s[2 * ks][3]), pk2(s[2 * ks + 1][0], s[2 * ks + 1][1]), pk2(s[2 * ks + 1][2], s[2 * ks + 1][3]));
#pragma unroll
        for (int dt = 0; dt < 4; ++dt) {
            const u32x2 v0 = *(const u32x2*)(sVt + (16 * dt + fr) * 72 + 32 * ks + 4 * fq);
            const u32x2 v1 = *(const u32x2*)(sVt + (16 * dt + fr) * 72 + 32 * ks + 16 + 4 * fq);
            st.o[dt][QT] = MFMA16(mk8(v0.x, v0.y, v1.x, v1.y), pf, st.o[dt][QT]);
        }
    }
}
DEV void attn_fold_out(bf16_t* const (&op)[2], const AttnAcc& st, const float (&gate)[2]) {
#pragma unroll
    for (int qt = 0; qt < 2; ++qt) {
        float l = st.l[qt];
        l += __shfl_xor(l, 16); l += __shfl_xor(l, 32);
        const float sc = gate[qt] * __builtin_amdgcn_rcpf(fmaxf(l, 1e-30f));
#pragma unroll
        for (int dt = 0; dt < 4; ++dt) {
            const uint2 pv = *(const uint2*)(op[qt] + 16 * dt);
            f32x4 r = st.o[dt][qt] * sc;
            r[0] += lo_f(pv.x); r[1] += hi_f(pv.x); r[2] += lo_f(pv.y); r[3] += hi_f(pv.y);
            *(uint2*)(op[qt] + 16 * dt) = make_uint2(pk2(r[0], r[1]), pk2(r[2], r[3]));
        }
    }
}
DEV void attn_fold(f32x4 (&tot)[4][2], const AttnAcc& st, const float (&gate)[2]) {
#pragma unroll
    for (int qt = 0; qt < 2; ++qt) {
        float l = st.l[qt];
        l += __shfl_xor(l, 16); l += __shfl_xor(l, 32);
        const float sc = gate[qt] * __builtin_amdgcn_rcpf(fmaxf(l, 1e-30f));
#pragma unroll
        for (int dt = 0; dt < 4; ++dt) tot[dt][qt] += st.o[dt][qt] * sc;
    }
}
DEV void ld64(u32x4 (&r)[2], const bf16_t* src, size_t sstride, int tid) {
#pragma unroll
    for (int i = 0; i < 2; ++i) { const int c = tid + 256 * i; r[i] = *(const u32x4*)(src + (size_t)(c >> 3) * sstride + (c & 7) * 8); }
}
DEV void st64(bf16_t* dst, const u32x4 (&r)[2], int tid, int stride) {
#pragma unroll
    for (int i = 0; i < 2; ++i) { const int c = tid + 256 * i; *(u32x4*)(dst + (c >> 3) * stride + (c & 7) * 8) = r[i]; }
}

#define OUTP(QT) ((dry ? (bf16_t*)(P.ws + W_YX) + (size_t)(b * S + tq[QT]) * 1024 : ZA + (size_t)(b * S + tq[QT]) * ZW + C_Q) + head * 64 + 4 * fq)
#define LOAD_GATE(G2, BR) float G2[2]; { G2[0] = bf2f(ZA[(size_t)(b * S + tq[0]) * ZW + C_G + head * 3 + (BR)]); G2[1] = bf2f(ZA[(size_t)(b * S + tq[1]) * ZW + C_G + head * 3 + (BR)]); }
struct MaskAll { DEV bool operator()(int, int) const { return true; } };
struct MaskSel { unsigned bit[2]; int t[2]; int k0; DEV bool operator()(int qt, int kk) const { return bit[qt] && (k0 + kk <= t[qt]); } };
struct MaskWin { int t[2]; int k0; DEV bool operator()(int qt, int kk) const { const int k = k0 + kk; return k <= t[qt] && k > t[qt] - 512; } };

DEV void xattn_job(const Params& P, int job, char* smem, bool dry) {
    char* aux = (char*)P.out;
    bf16_t* ZA = (bf16_t*)(P.ws + W_ZA);
    const int qb = job & 15, h = (job >> 4) & 3, b = job >> 6;
    bf16_t* sK = (bf16_t*)smem;
    bf16_t* sVt = sK + 64 * 80;
    const int tid = opaque_tid(), w = tid >> 6, lane = tid & 63, fr = lane & 15, fq = lane >> 4;
    const int t0 = qb * 128 + w * 32;
    bf16x8 qf[2][2];
#pragma unroll
    for (int qt = 0; qt < 2; ++qt)
#pragma unroll
        for (int ks = 0; ks < 2; ++ks) qf[qt][ks] = *(const bf16x8*)(ZA + (size_t)(b * S + t0 + 16 * qt + fr) * ZW + C_QX + h * 64 + 32 * ks + 8 * fq);
    const bf16_t* MK = (const bf16_t*)(aux + O_MEMK) + (size_t)(b * 4 + h) * 256 * 64;
    const bf16_t* MVT = (const bf16_t*)(aux + O_MEMVT) + (size_t)(b * 4 + h) * 64 * 256;
    AttnAcc st; attn_init(st);
    u32x4 rk[2], rv[2];
    ld64(rk, MK, 64, tid); ld64(rv, MVT, 256, tid);
#pragma unroll 1
    for (int jb = 0; jb < 4; ++jb) {
        __syncthreads();
        st64(sK, rk, tid, 80); st64(sVt, rv, tid, 72);
        __syncthreads();
        if (jb + 1 < 4) { ld64(rk, MK + (size_t)(jb + 1) * 64 * 64, 64, tid); ld64(rv, MVT + (jb + 1) * 64, 256, tid); }
        __builtin_amdgcn_sched_barrier(0);
        { const float z2[2] = {0.f, 0.f}; attn_step_fast(sK, sVt, qf, st, z2, fr, fq); }
    }
    f32x4 tot[4][2];
#pragma unroll
    for (int dt = 0; dt < 4; ++dt) { tot[dt][0] = (f32x4){0.f, 0.f, 0.f, 0.f}; tot[dt][1] = (f32x4){0.f, 0.f, 0.f, 0.f}; }
    const float one[2] = {1.f, 1.f};
    attn_fold(tot, st, one);
#pragma unroll
    for (int qt = 0; qt < 2; ++qt)
#pragma unroll
        for (int dt = 0; dt < 4; ++dt)
            *(uint2*)((dry ? (bf16_t*)(P.ws + W_Y) + (size_t)(b * S + t0 + 16 * qt + fr) * 1024 : ZA + (size_t)(b * S + t0 + 16 * qt + fr) * ZW + C_QX) + h * 64 + 16 * dt + 4 * fq) =
                make_uint2(pk2(tot[dt][qt][0], tot[dt][qt][1]), pk2(tot[dt][qt][2], tot[dt][qt][3]));
}

DEV void nsa_job(const Params& P, int job, char* smem, bool dry) {
    char* aux = (char*)P.out;
    bf16_t* ZA = (bf16_t*)(P.ws + W_ZA);
    const int pj_ = job >> 1, bg = pj_ & 31, qb = 63 - (2 * (pj_ >> 5) + (job & 1)), b = bg >> 2, g = bg & 3, t0 = qb * 32;
    bf16_t* sK = (bf16_t*)smem;
    bf16_t* sVt = (bf16_t*)(smem + 20480);
    float* sImp = (float*)(smem + 38912);
    unsigned* sSel = (unsigned*)(smem + 38912 + 4096);
    constexpr int KVBUF = 9728;
    const int tid = opaque_tid(), w = tid >> 6, lane = tid & 63, fr = lane & 15, fq = lane >> 4;
    const int head = g * 4 + (fr & 3);
    const int qi0 = 8 * w + (fr >> 2);
    int tq[2];
    bf16x8 qf[2][2];
#pragma unroll
    for (int qt = 0; qt < 2; ++qt) {
        tq[qt] = t0 + qi0 + 4 * qt;
        const bf16_t* rowp = ZA + (size_t)(b * S + tq[qt]) * ZW;
#pragma unroll
        for (int ks = 0; ks < 2; ++ks) qf[qt][ks] = *(const bf16x8*)(rowp + C_Q + head * 64 + 32 * ks + 8 * fq);
    }
    f32x4 tot[4][2];
#pragma unroll
    for (int dt = 0; dt < 4; ++dt) { tot[dt][0] = (f32x4){0.f, 0.f, 0.f, 0.f}; tot[dt][1] = (f32x4){0.f, 0.f, 0.f, 0.f}; }

    {
        const bf16_t* KC = (const bf16_t*)(aux + O_KC) + (size_t)bg * 128 * 64;
        const bf16_t* VCT = (const bf16_t*)(aux + O_VCT) + (size_t)bg * 64 * 128;
        __syncthreads();
#pragma unroll
        for (int i = 0; i < 4; ++i) {
            const int c = tid + 256 * i;
            { const int r = c >> 3, k = (c & 7) * 8; *(u32x4*)(sK + r * 80 + k) = *(const u32x4*)(KC + r * 64 + k); }
            { const int r = c >> 4, k = (c & 15) * 8; *(u32x4*)(sVt + r * 136 + k) = *(const u32x4*)(VCT + r * 128 + k); }
        }
        __syncthreads();
#pragma unroll
        for (int qt = 0; qt < 2; ++qt) {
            const float g0 = bf2f(ZA[(size_t)(b * S + tq[qt]) * ZW + C_G + head * 3 + 0]);
            f32x4 s[8];
#pragma unroll
            for (int kt = 0; kt < 8; ++kt) {
                s[kt] = (f32x4){0.f, 0.f, 0.f, 0.f};
#pragma unroll
                for (int ks = 0; ks < 2; ++ks) {
                    const bf16x8 kf = *(const bf16x8*)(sK + (16 * kt + fr) * 80 + 32 * ks + 8 * fq);
                    s[kt] = MFMA16(kf, qf[qt][ks], s[kt]);
                }
            }
            float mx = -INFINITY;
#pragma unroll
            for (int kt = 0; kt < 8; ++kt)
#pragma unroll
                for (int j = 0; j < 4; ++j) {
                    const int n = 16 * kt + 4 * fq + j;
                    const float v = (n < NCMP && 16 * n + 31 <= tq[qt]) ? s[kt][j] : -INFINITY;
                    s[kt][j] = v; mx = fmaxf(mx, v);
                }
            mx = fmaxf(mx, __shfl_xor(mx, 16)); mx = fmaxf(mx, __shfl_xor(mx, 32));
            const float msub = (mx == -INFINITY) ? 0.f : mx;
            float ps = 0.f;
#pragma unroll
            for (int kt = 0; kt < 8; ++kt)
#pragma unroll
                for (int j = 0; j < 4; ++j) { const float p = __builtin_amdgcn_exp2f((s[kt][j] - msub) * EXPC); s[kt][j] = p; ps += p; }
            ps += __shfl_xor(ps, 16); ps += __shfl_xor(ps, 32);
            const float inv = __builtin_amdgcn_rcpf(fmaxf(ps, 1e-30f));
            float bprev = 0.f;
#pragma unroll
            for (int kt = 0; kt < 8; ++kt) {
                s[kt] *= inv;
                const float a = s[kt][0] + s[kt][1] + s[kt][2] + 0.5f * s[kt][3];
                const float bq = 0.5f * s[kt][3];
                const float x = __shfl(bq, (lane + 48) & 63);
                const float y = __shfl(bprev, (lane + 48) & 63);
                float iv = a + (fq > 0 ? x : y);
                iv += __shfl_xor(iv, 1); iv += __shfl_xor(iv, 2);
                if ((fr & 3) == 0) sImp[(qi0 + 4 * qt) * 32 + 4 * kt + fq] = iv;
                bprev = bq;
            }
#pragma unroll
            for (int ks = 0; ks < 4; ++ks) {
                const f32x4 pa = s[2 * ks] * g0, pb = s[2 * ks + 1] * g0;
                const bf16x8 pf = mk8(pk2(pa[0], pa[1]), pk2(pa[2], pa[3]), pk2(pb[0], pb[1]), pk2(pb[2], pb[3]));
#pragma unroll
                for (int dt = 0; dt < 4; ++dt) {
                    const u32x2 v0 = *(const u32x2*)(sVt + (16 * dt + fr) * 136 + 32 * ks + 4 * fq);
                    const u32x2 v1 = *(const u32x2*)(sVt + (16 * dt + fr) * 136 + 32 * ks + 16 + 4 * fq);
                    tot[dt][qt] = MFMA16(mk8(v0.x, v0.y, v1.x, v1.y), pf, tot[dt][qt]);
                }
            }
            __builtin_amdgcn_sched_barrier(0);
        }
    }
#pragma unroll
    for (int qt = 0; qt < 2; ++qt) {
        bf16_t* op = (dry ? (bf16_t*)(P.ws + W_YX) + (size_t)(b * S + tq[qt]) * 1024 : ZA + (size_t)(b * S + tq[qt]) * ZW + C_Q) + head * 64 + 4 * fq;
#pragma unroll
        for (int dt = 0; dt < 4; ++dt) *(uint2*)(op + 16 * dt) = pk4(tot[dt][qt]);
    }
    __syncthreads();
    {
        float myv[4];
#pragma unroll
        for (int i = 0; i < 4; ++i) {
            const int pidx = tid + 256 * i, q = pidx >> 5, m = pidx & 31;
            const int t = t0 + q, cur = t >> 6;
            const float sum = sImp[q * 32 + m];
            const bool forced = (m == 0) || (m == cur) || (m == cur - 1);
            const bool future = m * 64 > t;
            myv[i] = forced ? INFINITY : (future ? -INFINITY : sum);
        }
        if (tid == 0) sSel[32] = 0u;
        __syncthreads();
#pragma unroll
        for (int i = 0; i < 4; ++i) { const int pidx = tid + 256 * i; sImp[pidx] = myv[i]; }
        __syncthreads();
        unsigned wun = 0u;
#pragma unroll
        for (int i = 0; i < 4; ++i) {
            const int pidx = tid + 256 * i, q = pidx >> 5, m = pidx & 31;
            const float v = myv[i];
            int rank = 0;
#pragma unroll
            for (int m2 = 0; m2 < 32; ++m2) {
                const float o = sImp[q * 32 + m2];
                rank += (o > v || (o == v && m2 < m)) ? 1 : 0;
            }
            const bool selb = (rank < 8) && (v > -INFINITY);
            const unsigned long long bal = __ballot(selb);
            const unsigned mk = (unsigned)(bal >> (32 * (lane >> 5)));
            if ((lane & 31) == 0) sSel[q] = mk;
            wun |= (unsigned)bal | (unsigned)(bal >> 32);
        }
        if (lane == 0) atomicOr(&sSel[32], wun);
    }
    __syncthreads();
    __shared__ unsigned s_xuni[2];
    if (tid == 0) s_xuni[threadIdx.x >> 8] = sSel[32];
    __syncthreads();
    const unsigned uni = s_xuni[0] | s_xuni[1];
    const int jmax = (t0 + 31) >> 6;
    {
        AttnAcc st; attn_init(st);
        const bf16_t* Kb = ZA + (size_t)(b * S) * ZW + C_KS + g * 64;
        const bf16_t* Vb = (const bf16_t*)(P.ws + W_VST) + (size_t)bg * 64 * S;
        unsigned rem = uni & ((2u << jmax) - 1u);
        u32x4 rk[2], rv[2];
        if (rem) { const int j0 = __builtin_ctz(rem); ld64(rk, Kb + (size_t)(j0 * 64) * ZW, ZW, tid); ld64(rv, Vb + j0 * 64, S, tid); }
        __syncthreads();
        int it = 0;
#pragma unroll 1
        while (rem) {
            const int jb = __builtin_ctz(rem);
            rem &= rem - 1u;
            bf16_t* sKb = (bf16_t*)smem + (it & 1) * KVBUF; bf16_t* sVb = sKb + 64 * 80; ++it;
            st64(sKb, rk, tid, 80); st64(sVb, rv, tid, 72);
            __syncthreads();
            if (rem) { const int jn = __builtin_ctz(rem); ld64(rk, Kb + (size_t)(jn * 64) * ZW, ZW, tid); ld64(rv, Vb + jn * 64, S, tid); }
            __builtin_amdgcn_sched_barrier(0);
            const unsigned b0 = (sSel[qi0] >> jb) & 1u, b1 = (sSel[qi0 + 4] >> jb) & 1u;
            if (jb * 64 + 63 <= t0) {
                const bool need0 = __builtin_amdgcn_ballot_w64(b0 != 0u) != 0ull, need1 = __builtin_amdgcn_ballot_w64(b1 != 0u) != 0ull;
                const float bo[2] = {b0 ? 0.f : -INFINITY, b1 ? 0.f : -INFINITY};
                if (need0 && need1) attn_step_fast(sKb, sVb, qf, st, bo, fr, fq);
                else if (need0) attn_half_fast<0>(sKb, sVb, qf, st, bo[0], fr, fq);
                else if (need1) attn_half_fast<1>(sKb, sVb, qf, st, bo[1], fr, fq);
            } else {
                MaskSel mf; mf.bit[0] = b0; mf.bit[1] = b1; mf.t[0] = tq[0]; mf.t[1] = tq[1]; mf.k0 = jb * 64;
                attn_step(sKb, sVb, 72, qf, st, mf, fr, fq);
            }
        }
        { LOAD_GATE(g1, 1) bf16_t* const op2[2] = {OUTP(0), OUTP(1)}; attn_fold_out(op2, st, g1); }
    }
    {
        AttnAcc st; attn_init(st);
        const bf16_t* Kb = ZA + (size_t)(b * S) * ZW + C_KW + g * 64;
        const bf16_t* Vb = (const bf16_t*)(P.ws + W_VWT) + (size_t)bg * 64 * S;
#pragma unroll
        for (int qt = 0; qt < 2; ++qt) {
            const int npad = 511 - tq[qt];
            if (npad > 0) { st.m[qt] = 0.f; st.l[qt] = (fq == 0) ? (float)npad : 0.f; }
        }
        int jlo = t0 - 511; jlo = jlo < 0 ? 0 : (jlo >> 6);
        u32x4 rk[2], rv[2];
        ld64(rk, Kb + (size_t)(jlo * 64) * ZW, ZW, tid); ld64(rv, Vb + jlo * 64, S, tid);
        __syncthreads();
#pragma unroll 1
        for (int jb = jlo; jb <= jmax; ++jb) {
            bf16_t* sKb = (bf16_t*)smem + ((jb - jlo) & 1) * KVBUF; bf16_t* sVb = sKb + 64 * 80;
            st64(sKb, rk, tid, 80); st64(sVb, rv, tid, 72);
            __syncthreads();
            if (jb < jmax) { ld64(rk, Kb + (size_t)((jb + 1) * 64) * ZW, ZW, tid); ld64(rv, Vb + (jb + 1) * 64, S, tid); }
            __builtin_amdgcn_sched_barrier(0);
            if (jb * 64 + 63 <= t0 && jb * 64 > t0 + 31 - 512) {
                const float z2[2] = {0.f, 0.f};
                attn_step_fast(sKb, sVb, qf, st, z2, fr, fq);
            } else {
                MaskWin mf; mf.t[0] = tq[0]; mf.t[1] = tq[1]; mf.k0 = jb * 64;
                attn_step(sKb, sVb, 72, qf, st, mf, fr, fq);
            }
        }
        { LOAD_GATE(g2, 2) bf16_t* const op2[2] = {OUTP(0), OUTP(1)}; attn_fold_out(op2, st, g2); }
    }
}


#define XB_TMO      128
#define XB_XCNT(j)  (256  + 64 * (j))
#define XB_XSUB(j)  (1280 + 64 * (j))
#define XB_XGEN(j)  (2304 + 64 * (j))
#define XB_TOP      3328
#define XB_TOPGEN   3392
#define XCD_BAR_WORDS 3456
#define XB_SPIN_CAP (1u << 18)
#define LAS __attribute__((address_space(3)))
DEV unsigned xb_ld(unsigned* p) { return __hip_atomic_load(p, __ATOMIC_RELAXED, __HIP_MEMORY_SCOPE_AGENT); }
DEV unsigned xb_add(unsigned* p, unsigned v) { return __hip_atomic_fetch_add(p, v, __ATOMIC_RELAXED, __HIP_MEMORY_SCOPE_AGENT); }
DEV unsigned xb_xcc_id() { return (unsigned)__builtin_amdgcn_s_getreg((3 << 11) | 20) & 0xFu; }
#define XB_SPIN(cond, bar) do { unsigned _sp = 0; while (cond) { __builtin_amdgcn_s_sleep(1); \
    if ((++_sp & 255u) == 0u) { if (xb_ld(&(bar)[XB_TMO])) break; if (_sp > XB_SPIN_CAP) { atomicAdd(&(bar)[XB_TMO], 1u); break; } } } } while (0)
struct XcdBarrier { unsigned* bar; unsigned x; volatile LAS unsigned* st; };
DEV XcdBarrier xcd_barrier_post(unsigned* bar, volatile LAS unsigned* st) {
    XcdBarrier b; b.bar = bar; b.x = xb_xcc_id(); b.st = st;
    if (threadIdx.x == 0) (void)xb_add(&bar[XB_XCNT(b.x)], 1u);
    return b;
}
DEV void xcd_barrier_complete(unsigned* bar, unsigned x, unsigned& nloc, unsigned& nx) {
    const unsigned G = gridDim.x * gridDim.y * gridDim.z;
    unsigned sum, cnt, mine, sp = 0u;
    for (;;) {
        sum = 0u; cnt = 0u; mine = 0u;
#pragma unroll
        for (unsigned j = 0; j < 16; ++j) { const unsigned c = xb_ld(&bar[XB_XCNT(j)]); sum += c; cnt += (c > 0u) ? 1u : 0u; mine = (j == x) ? c : mine; }
        if (sum == G) break;
        __builtin_amdgcn_s_sleep(1);
        if ((++sp & 255u) == 0u) { if (xb_ld(&bar[XB_TMO])) break; if (sp > XB_SPIN_CAP) { atomicAdd(&bar[XB_TMO], 1u); break; } }
    }
    nloc = mine > 0u ? mine : 1u; nx = cnt > 0u ? cnt : 1u;
}
DEV void xcd_barrier(const XcdBarrier& b) {
    asm volatile("s_waitcnt vmcnt(0)" ::: "memory");
    __syncthreads();
    if (threadIdx.x == 0) {
        unsigned* bar = b.bar;
        __builtin_amdgcn_s_waitcnt(0);
        unsigned nloc = b.st[0], nx = b.st[1];
        if (nloc == 0u) { xcd_barrier_complete(bar, b.x, nloc, nx); b.st[0] = nloc; b.st[1] = nx; }
        const unsigned old = xb_add(&bar[XB_XSUB(b.x)], 1u);
        const unsigned gen = old / nloc;
        if (old + 1u == (gen + 1u) * nloc) {
            __builtin_amdgcn_fence(__ATOMIC_RELEASE, "agent");
            asm volatile("s_waitcnt vmcnt(0)" ::: "memory");
            const unsigned og = xb_add(&bar[XB_TOP], 1u);
            const unsigned tg = og / nx;
            if (og + 1u == (tg + 1u) * nx) xb_add(&bar[XB_TOPGEN], 1u);
            else XB_SPIN(xb_ld(&bar[XB_TOPGEN]) == tg, bar);
            __builtin_amdgcn_fence(__ATOMIC_ACQUIRE, "agent");
            xb_add(&bar[XB_XGEN(b.x)], 1u);
            asm volatile("s_waitcnt vmcnt(0)" ::: "memory");
        } else {
            XB_SPIN(xb_ld(&bar[XB_XGEN(b.x)]) == gen, bar);
            __builtin_amdgcn_fence(__ATOMIC_ACQUIRE, "agent");
            asm volatile("s_waitcnt vmcnt(0)" ::: "memory");
        }
    }
    __syncthreads();
}
constexpr size_t W_BAR = 252 * MiB;

constexpr int HALF_SMEM = 56320;
constexpr int SMEM_BYTES = 131072;

extern __shared__ __attribute__((aligned(16))) char dyn_smem[];
#define RUN_PG8(EPI_T, EPI_OBJ, A_, LDA_, BT_, LDB_, M_, N_, K_) { pg8::Gemm g_; g_.A = (A_); g_.Bt = (BT_); g_.M = (M_); g_.N = (N_); g_.K = (K_); g_.lda = (LDA_); g_.ldb = (LDB_); g_.gather = 0; \
        pg8::StaticOrder so_; so_.init((M_), (N_), (int)gridDim.x, (int)blockIdx.x); __syncthreads(); \
        pg8::gemm_phase<EPI_T, pg8::StaticOrder, true, true>((PG8_LAS unsigned char*)dyn_smem, g_, so_, (EPI_OBJ)); __syncthreads(); }

template <int PH, bool DRY = false>
DEV void run_phase(const Params& P, char* smem) {
    const int nb = gridDim.x, bid = blockIdx.x, sub = opaque_tid512() >> 8;
    char* hsm = smem + sub * HALF_SMEM;
    char* aux = (char*)P.out;
    char* ws = P.ws;
    bf16_t* ZA = (bf16_t*)(ws + W_ZA);
    if (PH == 0) {
        for (int pj = bid; pj < (5088 + 4096 + 512 + 64 + 64) / 2; pj += nb) {
            int j = 2 * pj + sub;
            if (j < 5088) {
                bool done = false;
#define TR(SRC, LD, DSTOFF, KK, NN, MAP, BLK)                                                                                  \
    if (!done) { const int nrt = (NN) / 64, nt = nrt * ((KK) / 64);                                                              \
        if (j < nt) { transpose_tile((SRC), (LD), (bf16_t*)(aux + (DSTOFF)), (KK), (j % nrt) * 64, (j / nrt) * 64, (MAP), hsm, (BLK) ? (NN) : 0); done = true; } else j -= nt; }
                TR(P.w_in, 7984, O_WTA, 1024, 5120, 1, 0)
                TR(P.w_in, 7984, O_WTB, 1024, 4096, 2, 0)
                TR(P.w_up, 4096, O_WTUP, 1024, 4096, 0, 0)
                TR(P.w_down, 1024, O_WTDN, 4096, 1024, 0, 0)
                TR(P.w_o, 1024, O_WTO, 1024, 1024, 0, 0)
                TR(P.w_xo, 1024, O_WTXO, 256, 1024, 0, 0)
                TR(P.w_mkv, 512, O_WTMKV, 1024, 512, 0, 0)
                TR(P.wk1, 256, O_WTCK1, 2048, 256, 0, 0)
                TR(P.wv1, 256, O_WTCV1, 2048, 256, 0, 0)
#undef TR
                if (!done) {
                    if (j < 16) transpose_tile(P.w_a + j * 4096, 64, (bf16_t*)(aux + O_WAT) + j * 4096, 64, 0, 0, 0, hsm);
                    else { j -= 16; transpose_tile(P.w_i + j * 4096, 64, (bf16_t*)(aux + O_WIT) + j * 4096, 64, 0, 0, 0, hsm); }
                }
                continue;
            }
            j -= 5088;
            if (j < 4096) { rownorm<false>(P.x, P.g_mix, (bf16_t*)(ws + W_U), nullptr, j * 4 + (opaque_tid() >> 6)); continue; }
            j -= 4096;
            if (j < 512) { rownorm<false>(P.mem, P.g_mem, (bf16_t*)(aux + O_MEMN), nullptr, j * 4 + (opaque_tid() >> 6)); continue; }
            j -= 512;
            if (j < 64) { rope_job((float*)(aux + O_ROPEC), (float*)(aux + O_ROPES), j); continue; }
            j -= 64;
            posbias_job(P, (float*)(aux + O_PB), j, hsm);
        }
    } else if (PH == 1) {
        { PEpiMemKV ep; ep.MK = (bf16_t*)(aux + O_MEMK); ep.MVT = (bf16_t*)(aux + O_MEMVT);
          RUN_PG8(PEpiMemKV, ep, (const bf16_t*)(aux + O_MEMN), 1024, (const bf16_t*)(aux + O_WTMKV), 1024, 2048, 512, 1024) }
        { PEpiZA ep; ep.ZA = ZA; ep.VST = (bf16_t*)(ws + W_VST); ep.VWT = (bf16_t*)(ws + W_VWT); ep.ropec = (const float*)(aux + O_ROPEC); ep.ropes = (const float*)(aux + O_ROPES);
          RUN_PG8(PEpiZA, ep, (const bf16_t*)(ws + W_U), 1024, (const bf16_t*)(aux + O_WTA), 1024, 16384, 5120, 1024) }
    } else if (PH == 2) {
        { PEpiHid ep; ep.HK = (bf16_t*)(aux + O_HIDK); ep.HV = (bf16_t*)(aux + O_HIDV); ep.pb = (const float*)(aux + O_PB);
          pg8::Gemm g_; g_.A = ZA; g_.Bt = (const bf16_t*)(aux + O_WTCK1); g_.M = 4096; g_.N = 512; g_.K = 2048; g_.lda = ZW; g_.ldb = 2048; g_.gather = 1;
          pg8::StaticOrder so_; so_.init(4096, 512, (int)gridDim.x, (int)blockIdx.x); __syncthreads();
          pg8::gemm_phase<PEpiHid, pg8::StaticOrder, true, true>((PG8_LAS unsigned char*)dyn_smem, g_, so_, ep); __syncthreads(); }
        for (int job = bid; job < 512; job += nb) {
            if (job < 256) rnn_job(P, 2 * job + sub, hsm, DRY);
            else xattn_job(P, 2 * (job - 256) + sub, hsm, DRY);
        }
    } else if (PH == 3) {
        for (int pj = bid; pj < 1016; pj += nb) cmp2_job(P, 2 * pj + sub);
    } else if (PH == 4) {
        for (int job = bid; job < 1024; job += nb) nsa_job(P, 2 * job + sub, hsm, DRY);
        if (!DRY) { PEpiBf<0> ep; ep.O = (bf16_t*)(ws + W_YX); ep.ldo = 1024;
          RUN_PG8(PEpiBf<0>, ep, ZA + C_QX, ZW, (const bf16_t*)(aux + O_WTXO), 256, 16384, 1024, 256) }
    } else if (PH == 5) {
        { PEpiMerge ep; ep.ZA = ZA; ep.YX = (const bf16_t*)(ws + W_YX); ep.Y = (bf16_t*)(ws + W_Y);
          RUN_PG8(PEpiMerge, ep, (const bf16_t*)(ws + W_U), 1024, (const bf16_t*)(aux + O_WTB), 1024, 16384, 4096, 1024) }
    } else if (PH == 6) {
        { PEpiRes ep; ep.R = P.x; ep.O = (float*)(ws + W_H);
          RUN_PG8(PEpiRes, ep, (const bf16_t*)(ws + W_Y), 1024, (const bf16_t*)(aux + O_WTO), 1024, 16384, 1024, 1024) }
    } else if (PH == 7) {
        for (int pj = bid; pj < 2048; pj += nb) rownorm<false>((const float*)(ws + W_H), P.g_mlp, (bf16_t*)(ws + W_VN), nullptr, (2 * pj + sub) * 4 + (opaque_tid() >> 6));
    } else if (PH == 8) {
        { PEpiBf<1> ep; ep.O = (bf16_t*)(ws + W_HID); ep.ldo = 4096;
          RUN_PG8(PEpiBf<1>, ep, (const bf16_t*)(ws + W_VN), 1024, (const bf16_t*)(aux + O_WTUP), 1024, 16384, 4096, 1024) }
    } else if (PH == 9) {
        { PEpiRes ep; ep.R = (const float*)(ws + W_H); ep.O = (float*)(ws + W_H);
          RUN_PG8(PEpiRes, ep, (const bf16_t*)(ws + W_HID), 4096, (const bf16_t*)(aux + O_WTDN), 4096, 16384, 1024, 4096) }
    } else if (PH == 10) {
        for (int pj = bid; pj < 2048; pj += nb) rownorm<true>((const float*)(ws + W_H), P.g_final, nullptr, P.out, (2 * pj + sub) * 4 + (opaque_tid() >> 6));
    }
}

__global__ void __launch_bounds__(512, 2) mega_kernel(Params P) {
    char* smem = dyn_smem;
    cg::grid_group grid = cg::this_grid();
    __shared__ uint4 xb_words;
    if (threadIdx.x == 0) xb_words = make_uint4(0u, 0u, 0u, 0u);
    __syncthreads();
    XcdBarrier xb = xcd_barrier_post((unsigned*)(P.ws + W_BAR), (volatile LAS unsigned*)&xb_words);
    if (P.ws == nullptr) grid.sync();
#ifndef REP
#define REP -1
#endif
#define GSYNC() xcd_barrier(xb)
#define PHASE(k) { if (REP == k && k != 9) { run_phase<k, true>(P, smem); GSYNC(); } run_phase<k>(P, smem); GSYNC(); }
    PHASE(0) PHASE(1) PHASE(2) PHASE(3) PHASE(4) PHASE(5) PHASE(6) PHASE(7) PHASE(8) PHASE(9)
    if (REP == 10) { run_phase<10>(P, smem); GSYNC(); }
    if (REP == 11) { GSYNC(); GSYNC(); GSYNC(); GSYNC(); GSYNC(); GSYNC(); GSYNC(); GSYNC(); GSYNC(); GSYNC(); }
    run_phase<10>(P, smem);
}

extern "C" void kernel_launch(void* const* d_in, const int* in_sizes, int n_in, void* d_out, int out_size, void* d_ws, size_t ws_size,
                              hipStream_t stream) {
    Params P{};
    const float** pp = (const float**)&P;
    for (int i = 0; i < 25; ++i) pp[i] = (const float*)d_in[i];
    P.out = (float*)d_out;
    P.ws = (char*)d_ws;
    static int grid_blocks = 0;
    if (!grid_blocks) {
        int dev = 0, cus = 0, per_cu = 0;
        hipGetDevice(&dev);
        hipDeviceGetAttribute(&cus, hipDeviceAttributeMultiprocessorCount, dev);
        hipFuncSetAttribute((const void*)mega_kernel, hipFuncAttributeMaxDynamicSharedMemorySize, SMEM_BYTES);
        hipOccupancyMaxActiveBlocksPerMultiprocessor(&per_cu, mega_kernel, 512, SMEM_BYTES);
        if (per_cu > 1) per_cu = 1;
        if (per_cu < 1) per_cu = 1;
        grid_blocks = cus * per_cu;
    }
    hipMemsetAsync((char*)d_ws + W_BAR, 0, XCD_BAR_WORDS * 4, stream);
    void* args[] = {&P};
    hipError_t e = hipLaunchCooperativeKernel((void*)mega_kernel, dim3(grid_blocks), dim3(512), args, SMEM_BYTES, stream);
    if (e != hipSuccess) fprintf(stderr, "cooperative launch failed: %s (grid %d)\n", hipGetErrorString(e), grid_blocks);
}
```

```cpp
#include <hip/hip_runtime.h>
#include <hip/hip_cooperative_groups.h>
#include <cstdint>
#include <cstdio>
namespace cg = cooperative_groups;

#ifndef MULTI
#define MULTI 0
#endif

typedef unsigned short bf16_t;
typedef short bf16x8 __attribute__((ext_vector_type(8)));
typedef float f32x4 __attribute__((ext_vector_type(4)));
typedef __bf16 bfv2 __attribute__((ext_vector_type(2)));
typedef float f32x2 __attribute__((ext_vector_type(2)));
typedef unsigned u32x4 __attribute__((ext_vector_type(4)));
typedef unsigned u32x2 __attribute__((ext_vector_type(2)));
#define DEV __device__ __forceinline__
DEV int opaque_tid() { int t = threadIdx.x & 255; asm volatile("" : "+v"(t)); return t; }
DEV int opaque_tid512() { int t = threadIdx.x; asm volatile("" : "+v"(t)); return t; }
DEV bf16x8 ones8() { u32x4 u = {0x3f803f80u, 0x3f803f80u, 0x3f803f80u, 0x3f803f80u}; return __builtin_bit_cast(bf16x8, u); }
#define MFMA16(a, b, c) __builtin_amdgcn_mfma_f32_16x16x32_bf16((a), (b), (c), 0, 0, 0)

constexpr int T = 16384, S = 2048;
constexpr int ZW = 4480;
constexpr int C_Q = 0, C_KC = 1024, C_VC = 1280, C_KS = 1536, C_KW = 1792, C_XR = 2048, C_GR = 3072, C_QX = 4096, C_G = 4352;
constexpr int NCMP = 127;
constexpr int NCROWS = 4064;

constexpr size_t O_WTA = 0;
constexpr size_t O_WTB = O_WTA + (size_t)5120 * 1024 * 2;
constexpr size_t O_WTUP = O_WTB + (size_t)4096 * 1024 * 2;
constexpr size_t O_WTDN = O_WTUP + (size_t)4096 * 1024 * 2;
constexpr size_t O_WTO = O_WTDN + (size_t)4096 * 1024 * 2;
constexpr size_t O_WTXO = O_WTO + (size_t)1024 * 1024 * 2;
constexpr size_t O_WTMKV = O_WTXO + (size_t)1024 * 256 * 2;
constexpr size_t O_WTCK1 = O_WTMKV + (size_t)512 * 1024 * 2;
constexpr size_t O_WTCV1 = O_WTCK1 + (size_t)256 * 2048 * 2;
constexpr size_t O_WAT = O_WTCV1 + (size_t)256 * 2048 * 2;
constexpr size_t O_WIT = O_WAT + (size_t)16 * 64 * 64 * 2;
constexpr size_t O_ROPEC = O_WIT + (size_t)16 * 64 * 64 * 2;
constexpr size_t O_ROPES = O_ROPEC + (size_t)2048 * 8 * 4;
constexpr size_t O_MEMN = O_ROPES + (size_t)2048 * 8 * 4;
constexpr size_t O_MEMK = O_MEMN + (size_t)2048 * 1024 * 2;
constexpr size_t O_MEMVT = O_MEMK + (size_t)2048 * 256 * 2;
constexpr size_t O_HIDK = O_MEMVT + (size_t)2048 * 256 * 2;
constexpr size_t O_HIDV = O_HIDK + (size_t)4096 * 256 * 2;
constexpr size_t O_KC = O_HIDV + (size_t)4096 * 256 * 2;
constexpr size_t O_VCT = O_KC + (size_t)32 * 128 * 64 * 2;
constexpr size_t O_PB = O_VCT + (size_t)32 * 64 * 128 * 2;
constexpr size_t O_AUX_END = O_PB + 16384;
static_assert(O_AUX_END <= (size_t)64 << 20, "aux overflow");
constexpr size_t MiB = (size_t)1 << 20;
constexpr size_t W_U = 0, W_ZA = 32 * MiB, W_VST = 172 * MiB, W_VWT = 180 * MiB, W_YX = 188 * MiB, W_Y = 220 * MiB;
constexpr size_t W_H = 32 * MiB, W_VN = 0, W_HID = 96 * MiB;

struct Params {
    const float *x, *mem, *g_mix, *w_in, *cpk, *cpv, *wk1, *wk2, *wv1, *wv2, *conv_w, *conv_b, *w_a, *b_a, *w_i, *b_i, *lam,
        *g_mem, *w_mkv, *w_xo, *w_o, *g_mlp, *w_up, *w_down, *g_final;
    float* out;
    char* ws;
};

DEV float bf2f(bf16_t h) { return __uint_as_float(((unsigned)h) << 16); }
DEV unsigned pk2(float lo, float hi) { f32x2 v = {lo, hi}; bfv2 b = __builtin_convertvector(v, bfv2); return __builtin_bit_cast(unsigned, b); }
DEV bf16_t f2bf(float f) { return (bf16_t)(pk2(f, 0.f) & 0xffffu); }
DEV float lo_f(unsigned u) { return __uint_as_float(u << 16); }
DEV float hi_f(unsigned u) { return __uint_as_float(u & 0xffff0000u); }
DEV float sigm(float x) { return __builtin_amdgcn_rcpf(1.f + __expf(-x)); }
DEV float gelu_t(float x) {
    float y = 0.7978845608028654f * (x + 0.044715f * x * x * x);
    float e = __expf(2.f * y);
    float th = 1.f - 2.f * __builtin_amdgcn_rcpf(1.f + e);
    return 0.5f * x * (1.f + th);
}
DEV float wave_sum(float v) {
#pragma unroll
    for (int o = 32; o >= 1; o >>= 1) v += __shfl_xor(v, o);
    return v;
}

DEV int map_col(int mapid, int r) {
    if (mapid == 0) return r;
    if (mapid == 1) {
        if (r < 1536) return r;
        if (r < 1792) return 1536 + (r - 1536);
        if (r < 2048) return 2048 + (r - 1792);
        if (r < 3072) return 2608 + (r - 2048);
        if (r < 4096) return 3632 + (r - 3072);
        if (r < 4352) return 4656 + (r - 4096);
        if (r < 4608) return 1792 + (r - 4352);
        if (r < 4864) return 2304 + (r - 4608);
        if (r < 4912) return 2560 + (r - 4864);
        return -1;
    }
    const int pn = r >> 8, rem = r & 255, bj = rem >> 7, wc = (rem >> 5) & 3, n = (rem >> 4) & 1, c16 = rem & 15, slot = 2 * bj + n;
    if (slot == 3) return -1;
    return 4912 + slot * 1024 + pn * 64 + wc * 16 + c16;
}

DEV void transpose_tile(const float* __restrict__ src, int ld, bf16_t* __restrict__ dst, int K, int r0, int k0, int mapid, char* smem, int nblk = 0) {
    float* sm = (float*)smem;
    const int tid = threadIdx.x & 255, lane = tid & 63, w = tid >> 6;
    __syncthreads();
    const int sc = map_col(mapid, r0 + lane);
#pragma unroll
    for (int i = 0; i < 16; ++i) {
        int kk = w + 4 * i;
        float v = sc >= 0 ? src[(size_t)(k0 + kk) * ld + sc] : 0.f;
        sm[kk * 65 + lane] = v;
    }
    __syncthreads();
    const int rr = tid >> 2, kq = (tid & 3) * 16;
    unsigned o[8];
#pragma unroll
    for (int e = 0; e < 8; ++e) o[e] = pk2(sm[(kq + 2 * e) * 65 + rr], sm[(kq + 2 * e + 1) * 65 + rr]);
    uint4* dp = nblk ? (uint4*)(dst + (size_t)(k0 >> 6) * nblk * 64 + (size_t)(r0 + rr) * 64 + kq) : (uint4*)(dst + (size_t)(r0 + rr) * K + k0 + kq);
    dp[0] = make_uint4(o[0], o[1], o[2], o[3]);
    dp[1] = make_uint4(o[4], o[5], o[6], o[7]);
}

template <bool OUTF32>
DEV void rownorm(const float* __restrict__ src, const float* __restrict__ g, bf16_t* dstb, float* dstf, int row, bool blk = false) {
    const int lane = opaque_tid() & 63;
    const float4* sp = (const float4*)(src + (size_t)row * 1024);
    float4 v[4];
    float ss = 0.f;
#pragma unroll
    for (int i = 0; i < 4; ++i) { v[i] = sp[lane + 64 * i]; ss += v[i].x * v[i].x + v[i].y * v[i].y + v[i].z * v[i].z + v[i].w * v[i].w; }
    ss = wave_sum(ss);
    const float r = rsqrtf(ss * (1.0f / 1024.0f) + 1e-6f);
#pragma unroll
    for (int i = 0; i < 4; ++i) {
        float4 gg = ((const float4*)g)[lane + 64 * i];
        float a = v[i].x * r * gg.x, b = v[i].y * r * gg.y, c = v[i].z * r * gg.z, d = v[i].w * r * gg.w;
        if (OUTF32) ((float4*)(dstf + (size_t)row * 1024))[lane + 64 * i] = make_float4(a, b, c, d);
        else if (blk) { const int col = 4 * (lane + 64 * i); *(uint2*)(dstb + (size_t)(col >> 6) * ((size_t)16384 * 64) + (size_t)row * 64 + (col & 63)) = make_uint2(pk2(a, b), pk2(c, d)); }
        else ((uint2*)(dstb + (size_t)row * 1024))[lane + 64 * i] = make_uint2(pk2(a, b), pk2(c, d));
    }
}

DEV void rope_job(float* ct, float* st, int job) {
    const int e = job * 256 + (threadIdx.x & 255);
    const int pos = e >> 3, i = e & 7;
    const double inv = exp(-(double)i * 0.125 * 13.122363377404328);
    const double ang = (double)pos * inv;
    const double kq = rint(ang * 0.6366197723675814);
    const double r = ang - kq * 1.5707963267948966;
    const double r2 = r * r;
    const double sn = r * (1.0 + r2 * (-1.0 / 6 + r2 * (1.0 / 120 + r2 * (-1.0 / 5040 + r2 * (1.0 / 362880 + r2 * (-1.0 / 39916800 + r2 * (1.0 / 6227020800.0)))))));
    const double cs = 1.0 + r2 * (-0.5 + r2 * (1.0 / 24 + r2 * (-1.0 / 720 + r2 * (1.0 / 40320 + r2 * (-1.0 / 3628800 + r2 * (1.0 / 479001600.0))))));
    const int q = ((int)kq) & 3;
    double s_, c_;
    if (q == 0) { s_ = sn; c_ = cs; } else if (q == 1) { s_ = cs; c_ = -sn; } else if (q == 2) { s_ = -sn; c_ = -cs; } else { s_ = -cs; c_ = sn; }
    ct[e] = (float)c_; st[e] = (float)s_;
}

DEV void posbias_job(const Params& P, float* PB, int job, char* smem) {
    float* sred = (float*)smem;
    const int tid = opaque_tid(), which = job >> 5, cgi = (job >> 3) & 3, kc = job & 7, c = cgi * 64 + (tid & 63), kp = tid >> 6;
    const float* pos = (which ? P.cpv : P.cpk) + kc * 256 + kp * 64;
    const float* w1 = (which ? P.wv1 : P.wk1) + (size_t)(kc * 256 + kp * 64) * 256 + c;
    float a0 = 0.f, a1 = 0.f, a2 = 0.f, a3 = 0.f;
#pragma unroll 4
    for (int k = 0; k < 64; k += 4) {
        a0 += pos[k] * w1[(size_t)k * 256]; a1 += pos[k + 1] * w1[(size_t)(k + 1) * 256];
        a2 += pos[k + 2] * w1[(size_t)(k + 2) * 256]; a3 += pos[k + 3] * w1[(size_t)(k + 3) * 256];
    }
    __syncthreads();
    sred[kp * 64 + (tid & 63)] = (a0 + a1) + (a2 + a3);
    __syncthreads();
    if (tid < 64) PB[(which * 8 + kc) * 256 + c] = (sred[tid] + sred[64 + tid]) + (sred[128 + tid] + sred[192 + tid]);
}

struct ALPlain {
    const bf16_t* A; int lda; int ks;
    const char* base; unsigned off0;
    DEV void init(int row0, int lrow, int lk) { base = (const char*)(A + (size_t)row0 * lda); off0 = (unsigned)(lrow * lda + lk) * 2u; }
    DEV u32x4 load(int i, int k0) const { return *(const u32x4*)(base + (off0 + (unsigned)(i * 128 * lda) + (unsigned)(k0 >> 6) * (unsigned)(ks * 2))); }
    DEV u32x4 fix(int, const u32x4& v, int) const { return v; }
};
struct ALCmp {
    const bf16_t* ZA; const float* spos; int colbase;
    unsigned roff[4]; int lk_;
    DEV void init(int row0, int lrow, int lk) {
        lk_ = lk;
#pragma unroll
        for (int i = 0; i < 4; ++i) {
            const int row = row0 + lrow + 64 * i;
            const int bg = row / NCMP, n = row - bg * NCMP, b = bg >> 2, g = bg & 3;
            roff[i] = row < NCROWS ? (unsigned)(((b * S + 16 * n) * ZW + colbase + g * 64 + lk) * 2) : 0xffffffffu;
        }
    }
    DEV u32x4 load(int i, int k0) const {
        if (roff[i] == 0xffffffffu) return (u32x4){0u, 0u, 0u, 0u};
        return *(const u32x4*)((const char*)ZA + (roff[i] + (unsigned)((k0 >> 6) * ZW * 2)));
    }
    DEV u32x4 fix(int i, const u32x4& v, int k0) const {
        if (roff[i] == 0xffffffffu) return v;
        const float4 p0 = *(const float4*)(spos + k0 + lk_), p1 = *(const float4*)(spos + k0 + lk_ + 4);
        u32x4 o;
        o.x = pk2(lo_f(v.x) + p0.x, hi_f(v.x) + p0.y); o.y = pk2(lo_f(v.y) + p0.z, hi_f(v.y) + p0.w);
        o.z = pk2(lo_f(v.z) + p1.x, hi_f(v.z) + p1.y); o.w = pk2(lo_f(v.w) + p1.z, hi_f(v.w) + p1.w);
        return o;
    }
};

template <int TM, int TN, bool SWAP, class AL, class EP>
DEV void gemm_tile(AL al, const bf16_t* __restrict__ Bt, int ldb, int bks, int K, int pm, int pn, const EP& ep, char* smem) {
    constexpr int BM = TM * 32, BN = TN * 64, NA = BM / 64, NBB = (BN + 63) / 64;
    bf16_t* sA = (bf16_t*)smem;
    bf16_t* sB = sA + BM * 72;
    const int tid = opaque_tid512(), wid = tid >> 6, lane = tid & 63, wr = wid >> 2, wc = wid & 3, fr = lane & 15, fq = lane >> 4;
    f32x4 acc[TM][TN];
#pragma unroll
    for (int m = 0; m < TM; ++m)
#pragma unroll
        for (int n = 0; n < TN; ++n) acc[m][n] = (f32x4){0.f, 0.f, 0.f, 0.f};
    const int lrow = tid >> 3, lk = (tid & 7) * 8;
    u32x4 ra[NA], rb[NBB];
    al.init(pm * BM, lrow, lk);
    const char* bbase = (const char*)(Bt + (size_t)(pn * BN) * ldb);
    const unsigned boff = (unsigned)(lrow * ldb + lk) * 2u;
#pragma unroll
    for (int i = 0; i < NBB; ++i) rb[i] = (u32x4){0u, 0u, 0u, 0u};
#pragma unroll
    for (int i = 0; i < NA; ++i) ra[i] = al.load(i, 0);
#pragma unroll
    for (int i = 0; i < NBB; ++i) if (BN % 64 == 0 || lrow + 64 * i < BN) rb[i] = *(const u32x4*)(bbase + (boff + (unsigned)(i * 128 * ldb)));
    int nk = K >> 6;
    asm volatile("" : "+s"(nk));
    bf16_t* sWa = sA + lrow * 72 + lk;
    bf16_t* sWb = sB + lrow * 72 + lk;
    const bf16_t* sAr = sA + (wr * TM * 16 + fr) * 72 + fq * 8;
    const bf16_t* sBr = sB + (wc * TN * 16 + fr) * 72 + fq * 8;
#pragma unroll 1
    for (int kt = 0; kt < nk; ++kt) {
        __syncthreads();
#pragma unroll
        for (int i = 0; i < NA; ++i) *(u32x4*)(sWa + (64 * i) * 72) = al.fix(i, ra[i], kt * 64);
#pragma unroll
        for (int i = 0; i < NBB; ++i) if (BN % 64 == 0 || lrow + 64 * i < BN) *(u32x4*)(sWb + (64 * i) * 72) = rb[i];
        __syncthreads();
        if (kt + 1 < nk) {
            const int k0 = (kt + 1) * 64;
#pragma unroll
            for (int i = 0; i < NA; ++i) ra[i] = al.load(i, k0);
#pragma unroll
            for (int i = 0; i < NBB; ++i) if (BN % 64 == 0 || lrow + 64 * i < BN) rb[i] = *(const u32x4*)(bbase + (boff + (unsigned)(i * 128 * ldb) + (unsigned)(k0 >> 6) * (unsigned)(bks * 2)));
        }
        __builtin_amdgcn_sched_barrier(0);
        __builtin_amdgcn_s_setprio(1);
#pragma unroll
        for (int ks = 0; ks < 2; ++ks) {
            bf16x8 bfr[TN];
#pragma unroll
            for (int n = 0; n < TN; ++n) bfr[n] = *(const bf16x8*)(sBr + (n * 16) * 72 + ks * 32);
#pragma unroll
            for (int m = 0; m < TM; ++m) {
                const bf16x8 af = *(const bf16x8*)(sAr + (m * 16) * 72 + ks * 32);
#pragma unroll
                for (int n = 0; n < TN; ++n) acc[m][n] = SWAP ? MFMA16(bfr[n], af, acc[m][n]) : MFMA16(af, bfr[n], acc[m][n]);
            }
        }
        __builtin_amdgcn_s_setprio(0);
    }
    ep.run(acc, pm * BM + wr * TM * 16, pn * BN + wc * TN * 16, fr, fq);
}

DEV uint2 pk4(const f32x4& a) { return make_uint2(pk2(a[0], a[1]), pk2(a[2], a[3])); }

namespace pg8 {
#define PG8_LAS __attribute__((address_space(3)))
typedef unsigned short bf16_t;
typedef short bf16x8 __attribute__((ext_vector_type(8)));
typedef float f32x4 __attribute__((ext_vector_type(4)));
typedef unsigned u32x4 __attribute__((ext_vector_type(4)));
constexpr int BM = 256, BK = 64, HALF = 128, HTB = HALF * BK * 2  , STAGE_BYTES = 8 * HTB, NXCD = 8, WGM = 8;

__host__ __device__ __forceinline__ int lds_byte(int r, int c) { const int st = (r >> 4) * 2 + (c >> 5), rr = r & 15, cc = c & 31, ob = rr * 64 + cc * 2; return st * 1024 + (ob ^ (((ob >> 9) & 1) << 5)); }
__host__ __device__ __forceinline__ void stage_rc(int b, int& R, int& C) { const int st = b / 1024, sb = b % 1024, swz = sb ^ (((sb >> 9) & 1) << 5); R = (st >> 1) * 16 + swz / 64; C = (st & 1) * 32 + (swz % 64) / 2; }
__host__ __device__ __forceinline__ int perm32(int rho) { const int n = rho >> 4, i = rho & 15; return 8 * (i >> 2) + 4 * n + (i & 3); }

struct Unit { int pm, pn; };
struct Gemm { const bf16_t* A; const bf16_t* Bt; int M, N, K, lda, ldb; int gather; };

struct StaticOrder {
    int nM, nN, nwg, G, c;
    __host__ __device__ void init(int M, int N, int G_, int c_) { nM = M / BM; nN = N / BM; nwg = nM * nN; G = G_; c = c_; }
    __host__ __device__ bool next(int i, Unit& u) const {
        const long L = (long)i * G + c; if (L >= nwg) return false;
        int wgid = (int)L; { const int q = nwg / NXCD, r = nwg % NXCD, xcd = wgid % NXCD, off = wgid / NXCD; wgid = (xcd < r ? xcd * (q + 1) : r * (q + 1) + (xcd - r) * q) + off; }
        const int nig = WGM * nN, gid = wgid / nig, fm = gid * WGM, gsz = (nM - fm) < WGM ? (nM - fm) : WGM;
        u.pm = fm + ((wgid % nig) % gsz); u.pn = (wgid % nig) / gsz; return true;
    }
    __device__ __forceinline__ void a_ready(const Unit&) const {}
    __device__ __forceinline__ void done(const Unit&) const {}
};

template <class Epi, class Sched, bool ALIGN_EPI = false, bool SP2 = false>
__device__ __forceinline__ void gemm_phase(PG8_LAS unsigned char* lds, const Gemm g, const Sched& S, const Epi& E) {
    const int tid = opaque_tid512(), wid = __builtin_amdgcn_readfirstlane(tid >> 6), lane = tid & 63, wr = wid >> 2, wc = wid & 3, fr = lane & 15, fq = lane >> 4;
    const int K = g.K, nt = K / BK;
    unsigned voffA2[2][2], voffB[2];
#pragma unroll
    for (int i = 0; i < 2; ++i) { int R, C; stage_rc(tid * 16 + i * 8192, R, C); const int Rb = Epi::PERM ? ((R & ~31) + perm32(R & 31)) : R;
        voffA2[0][i] = (unsigned)(R * g.lda + C) * 2u; voffA2[1][i] = voffA2[0][i]; voffB[i] = (unsigned)(Rb * g.ldb + C) * 2u; }
    const size_t kstepB = (size_t)(BK * 2), kstepA = g.gather ? (size_t)(ZW * 2) : kstepB;
    const size_t hstepA = g.gather ? (size_t)0 : (size_t)HALF * g.lda * 2, hstepB = (size_t)HALF * g.ldb * 2;
    const size_t tstepA = 2 * hstepA, tstepB = 2 * hstepB;
    const unsigned ldsw = (unsigned)wid * 1024u;
    const int aoff = lds_byte(wr * 64 + fr, fq * 8), boff = lds_byte(wc * 32 + fr, fq * 8);
#define PG8_SA(b, h) (((b) * 2 + (h)) * HTB)
#define PG8_SB(b, h) ((4 + (b) * 2 + (h)) * HTB)
#define PG8_STAGE(bufoff, gbase, voff) do { _Pragma("unroll") for (int _i = 0; _i < 2; ++_i) \
        __builtin_amdgcn_global_load_lds((const unsigned*)((const char*)(gbase) + (voff)[_i]), (PG8_LAS unsigned*)(lds + (bufoff) + ldsw + _i * 8192), 16, 0, 0); } while (0)
#define PG8_LDA(dst, b, h) do { _Pragma("unroll") for (int m = 0; m < 4; ++m) _Pragma("unroll") for (int k = 0; k < 2; ++k) dst[m][k] = *(const PG8_LAS bf16x8*)(lds + PG8_SA(b, h) + aoff + m * 2048 + k * 1024); } while (0)
#define PG8_LDB(dst, b, h) do { _Pragma("unroll") for (int n = 0; n < 2; ++n) _Pragma("unroll") for (int k = 0; k < 2; ++k) dst[n][k] = *(const PG8_LAS bf16x8*)(lds + PG8_SB(b, h) + boff + n * 2048 + k * 1024); } while (0)
#define PG8_MMA(ai, bj, At, Bt) do { __builtin_amdgcn_s_setprio(1); _Pragma("unroll") for (int m = 0; m < 4; ++m) _Pragma("unroll") for (int n = 0; n < 2; ++n) _Pragma("unroll") for (int k = 0; k < 2; ++k) \
        acc[ai][bj][m][n] = __builtin_amdgcn_mfma_f32_16x16x32_bf16(Bt[n][k], At[m][k], acc[ai][bj][m][n], 0, 0, 0); __builtin_amdgcn_s_setprio(0); } while (0)
#define PG8_WAIT_V(n) asm volatile("s_waitcnt vmcnt(" #n ")" ::: "memory")
#define PG8_WAIT_L(n) asm volatile("s_waitcnt lgkmcnt(" #n ")" ::: "memory")
#define PG8_BAR __builtin_amdgcn_s_barrier()
#define PG8_SCHED __builtin_amdgcn_sched_barrier(0)
    Unit cur, nxt; int ui = 0;
    if (!S.next(0, cur)) return;
    f32x4 acc[2][2][4][2];
#pragma unroll
    for (int a = 0; a < 2; ++a)
#pragma unroll
        for (int b = 0; b < 2; ++b)
#pragma unroll
            for (int m = 0; m < 4; ++m)
#pragma unroll
                for (int n = 0; n < 2; ++n) acc[a][b][m][n] = (f32x4){0.f, 0.f, 0.f, 0.f};
    bf16x8 At[4][2], B0[2][2], B1[2][2];
    const char* cA = (const char*)g.A + (g.gather ? (size_t)0 : (size_t)cur.pm * tstepA); const char* cB = (const char*)g.Bt + (size_t)cur.pn * tstepB;
    if (g.gather) {
#pragma unroll
        for (int h = 0; h < 2; ++h)
#pragma unroll
            for (int i = 0; i < 2; ++i) { int R, C; stage_rc(tid * 16 + i * 8192, R, C);
                int r = cur.pm * 256 + h * HALF + R; r = r < NCROWS ? r : NCROWS - 1;
                const int bg = r / NCMP, n = r - bg * NCMP;
                voffA2[h][i] = (unsigned)((((bg >> 2) * ::S + 16 * n) * ZW + (cur.pn ? C_VC : C_KC) + (bg & 3) * 64 + C) * 2); }
    }
    S.a_ready(cur);
    if constexpr (SP2) {
        PG8_STAGE(PG8_SB(0, 0), cB, voffB); PG8_STAGE(PG8_SB(0, 1), cB + hstepB, voffB); PG8_STAGE(PG8_SA(0, 0), cA, voffA2[0]); PG8_STAGE(PG8_SA(0, 1), cA + hstepA, voffA2[1]);
        if (wr == 1) PG8_BAR;
        PG8_WAIT_V(2); PG8_BAR;
        PG8_STAGE(PG8_SB(1, 0), cB + kstepB, voffB); PG8_STAGE(PG8_SA(1, 0), cA + kstepA, voffA2[0]); PG8_STAGE(PG8_SB(1, 1), cB + hstepB + kstepB, voffB);
        PG8_WAIT_V(6); PG8_BAR;
    } else {
        PG8_STAGE(PG8_SB(0, 0), cB, voffB); PG8_STAGE(PG8_SA(0, 0), cA, voffA2[0]); PG8_STAGE(PG8_SB(0, 1), cB + hstepB, voffB); PG8_STAGE(PG8_SA(0, 1), cA + hstepA, voffA2[1]);
        if (wr == 1) PG8_BAR;
        PG8_WAIT_V(4); PG8_BAR;
        PG8_STAGE(PG8_SB(1, 0), cB + kstepB, voffB); PG8_STAGE(PG8_SA(1, 0), cA + kstepA, voffA2[0]); PG8_STAGE(PG8_SB(1, 1), cB + hstepB + kstepB, voffB);
        PG8_WAIT_V(6); PG8_BAR;
    }
    for (;;) {
        const bool has_next = S.next(ui + 1, nxt);
        const char* nA = has_next ? (const char*)g.A + (size_t)nxt.pm * tstepA : cA; const char* nB = has_next ? (const char*)g.Bt + (size_t)nxt.pn * tstepB : cB;
        for (int t = 0; t < nt; t += 2) {
            const bool last = (t == nt - 2);
            const char* a1 = cA + (size_t)(t + 1) * kstepA;
            const char* a2 = last ? nA : cA + (size_t)(t + 2) * kstepA; const char* b2 = last ? nB : cB + (size_t)(t + 2) * kstepB;
            const char* a3 = a2 + kstepA; const char* b3 = b2 + kstepB;
            if (last && has_next) S.a_ready(nxt);
            if constexpr (SP2) {
            PG8_LDB(B0, 0, 0); PG8_LDB(B1, 0, 1); PG8_SCHED; PG8_LDA(At, 0, 0); PG8_STAGE(PG8_SA(1, 1), a1 + hstepA, voffA2[1]);
            PG8_WAIT_V(8); PG8_WAIT_L(0); PG8_BAR; PG8_MMA(0, 0, At, B0); PG8_MMA(0, 1, At, B1); PG8_BAR; PG8_SCHED;
            PG8_LDA(At, 0, 1); PG8_STAGE(PG8_SB(0, 0), b2, voffB); PG8_STAGE(PG8_SB(0, 1), b2 + hstepB, voffB); PG8_STAGE(PG8_SA(0, 0), a2, voffA2[0]);
            PG8_WAIT_V(8); PG8_WAIT_L(0); PG8_BAR; PG8_MMA(1, 0, At, B0); PG8_MMA(1, 1, At, B1); PG8_BAR; PG8_SCHED;
            PG8_LDB(B0, 1, 0); PG8_LDB(B1, 1, 1); PG8_SCHED; PG8_LDA(At, 1, 0); PG8_STAGE(PG8_SA(0, 1), a2 + hstepA, voffA2[1]);
            PG8_WAIT_V(8); PG8_WAIT_L(0); PG8_BAR; PG8_MMA(0, 0, At, B0); PG8_MMA(0, 1, At, B1); PG8_BAR; PG8_SCHED;
            PG8_LDA(At, 1, 1); PG8_STAGE(PG8_SB(1, 0), b3, voffB); PG8_STAGE(PG8_SB(1, 1), b3 + hstepB, voffB); PG8_STAGE(PG8_SA(1, 0), a3, voffA2[0]);
            PG8_WAIT_V(8); PG8_WAIT_L(0); PG8_BAR; PG8_MMA(1, 0, At, B0); PG8_MMA(1, 1, At, B1); PG8_BAR; PG8_SCHED;
            } else {
            PG8_LDB(B0, 0, 0); PG8_SCHED; PG8_LDA(At, 0, 0); PG8_STAGE(PG8_SA(1, 1), a1 + hstepA, voffA2[1]);
            PG8_WAIT_L(8); PG8_BAR; PG8_WAIT_L(0); PG8_MMA(0, 0, At, B0); PG8_BAR; PG8_SCHED;
            PG8_LDB(B1, 0, 1); PG8_STAGE(PG8_SB(0, 0), b2, voffB);
            PG8_BAR; PG8_WAIT_L(0); PG8_MMA(0, 1, At, B1); PG8_BAR;
            PG8_LDA(At, 0, 1); PG8_STAGE(PG8_SA(0, 0), a2, voffA2[0]);
            PG8_BAR; PG8_WAIT_L(0); PG8_MMA(1, 0, At, B0); PG8_BAR; PG8_SCHED;
            PG8_STAGE(PG8_SB(0, 1), b2 + hstepB, voffB);
            PG8_WAIT_V(6); PG8_BAR; PG8_MMA(1, 1, At, B1); PG8_BAR;
            PG8_LDB(B0, 1, 0); PG8_SCHED; PG8_LDA(At, 1, 0); PG8_STAGE(PG8_SA(0, 1), a2 + hstepA, voffA2[1]);
            PG8_WAIT_L(8); PG8_BAR; PG8_WAIT_L(0); PG8_MMA(0, 0, At, B0); PG8_BAR; PG8_SCHED;
            PG8_LDB(B1, 1, 1); PG8_STAGE(PG8_SB(1, 0), b3, voffB);
            PG8_BAR; PG8_WAIT_L(0); PG8_MMA(0, 1, At, B1); PG8_BAR;
            PG8_LDA(At, 1, 1); PG8_STAGE(PG8_SA(1, 0), a3, voffA2[0]);
            PG8_BAR; PG8_WAIT_L(0); PG8_MMA(1, 0, At, B0); PG8_BAR; PG8_SCHED;
            PG8_STAGE(PG8_SB(1, 1), b3 + hstepB, voffB);
            PG8_WAIT_V(6); PG8_BAR; PG8_MMA(1, 1, At, B1); PG8_BAR;
            }
        }
        if constexpr (ALIGN_EPI) { if (wr == 0) PG8_BAR; }
        if constexpr (!Epi::AFTER_DRAIN) { E(acc, cur, wr, wc, fr, fq); S.done(cur); }
        if (!has_next) break;
#pragma unroll
        for (int a = 0; a < 2; ++a)
#pragma unroll
            for (int b = 0; b < 2; ++b)
#pragma unroll
                for (int m = 0; m < 4; ++m)
#pragma unroll
                    for (int n = 0; n < 2; ++n) acc[a][b][m][n] = (f32x4){0.f, 0.f, 0.f, 0.f};
        cur = nxt; cA = nA; cB = nB; ++ui;
        if constexpr (ALIGN_EPI) { if (wr == 1) PG8_BAR; }
    }
    PG8_WAIT_V(0);
    if constexpr (!ALIGN_EPI) { if (wr == 0) PG8_BAR; }
    PG8_BAR;
    if constexpr (Epi::AFTER_DRAIN) { E.fused(acc, cur, wr, wc, fr, fq, lds, wid, lane); S.done(cur); }
#undef PG8_SA
#undef PG8_SB
#undef PG8_STAGE
#undef PG8_LDA
#undef PG8_LDB
#undef PG8_MMA
#undef PG8_WAIT_V
#undef PG8_WAIT_L
#undef PG8_BAR
#undef PG8_SCHED
}
}

struct EpiHid {
    bf16_t* H;
    DEV void run(f32x4 (&acc)[8][4], int R0, int C0, int fr, int fq) const {
#pragma unroll
        for (int n = 0; n < 4; ++n)
#pragma unroll
            for (int m = 0; m < 8; ++m) {
                const int c = C0 + n * 16 + 4 * fq, r = R0 + m * 16 + fr;
                f32x4 a = acc[m][n];
#pragma unroll
                for (int j = 0; j < 4; ++j) a[j] = gelu_t(a[j]);
                if (r < NCROWS) *(uint2*)(H + (size_t)r * 256 + c) = pk4(a);
            }
    }
};
#define PG8_EPI_HEAD static constexpr bool PERM = false, AFTER_DRAIN = false;
#define PG8_FOR_TILES _Pragma("unroll") for (int ai = 0; ai < 2; ++ai) _Pragma("unroll") for (int bj = 0; bj < 2; ++bj) _Pragma("unroll") for (int m = 0; m < 4; ++m) _Pragma("unroll") for (int n = 0; n < 2; ++n)
struct PEpiZA {
    PG8_EPI_HEAD
    bf16_t *ZA, *VST, *VWT; const float *ropec, *ropes;
    DEV void operator()(const f32x4 (&acc)[2][2][4][2], const pg8::Unit& u, int wr, int wc, int fr, int fq) const {
        asm volatile("" : "+v"(fr), "+v"(fq));
        PG8_FOR_TILES {
            const int row = u.pm * 256 + ai * 128 + wr * 64 + m * 16 + fr, col0 = u.pn * 256 + bj * 128 + wc * 32 + n * 16;
            f32x4 a = acc[ai][bj][m][n];
            if (u.pn == 17 || u.pn == 18) {
                bf16_t* dst = (u.pn == 17) ? VST : VWT;
                const int c = (col0 & 255) + 4 * fq, b = row >> 11, t = row & 2047;
#pragma unroll
                for (int j = 0; j < 4; ++j) { const int cc = c + j; dst[((size_t)((b * 4 + (cc >> 6)) * 64 + (cc & 63))) * S + t] = f2bf(a[j]); }
            } else {
                const bool rope = (col0 < 1024 || (col0 >= 1536 && col0 < 2048)) && ((col0 & 63) == 0);
                if (rope) {
                    const int t = row & 2047, i0 = 4 * (fq & 1);
                    const float4 cs = *(const float4*)(ropec + t * 8 + i0), sn = *(const float4*)(ropes + t * 8 + i0);
                    const float c4[4] = {cs.x, cs.y, cs.z, cs.w}, s4[4] = {sn.x, sn.y, sn.z, sn.w};
#pragma unroll
                    for (int j = 0; j < 4; ++j) {
                        const float pr = __shfl_xor(a[j], 32);
                        a[j] = (fq & 2) ? (a[j] * c4[j] + pr * s4[j]) : (a[j] * c4[j] - pr * s4[j]);
                    }
                }
                int zc0 = col0;
                if (col0 >= 4864) {
                    zc0 = col0 - 512;
#pragma unroll
                    for (int j = 0; j < 4; ++j) a[j] = sigm(a[j]);
                }
                if (zc0 < ZW) *(uint2*)(ZA + (size_t)row * ZW + zc0 + 4 * fq) = pk4(a);
            }
        }
    }
};
struct PEpiHid {
    PG8_EPI_HEAD
    bf16_t *HK, *HV; const float* pb;
    DEV void operator()(const f32x4 (&acc)[2][2][4][2], const pg8::Unit& u, int wr, int wc, int fr, int fq) const {
        asm volatile("" : "+v"(fr), "+v"(fq));
        bf16_t* H = u.pn ? HV : HK;
        PG8_FOR_TILES {
            const int r = u.pm * 256 + ai * 128 + wr * 64 + m * 16 + fr, c = bj * 128 + wc * 32 + n * 16 + 4 * fq;
            float4 bb = *(const float4*)(pb + (u.pn * 8) * 256 + c);
#pragma unroll
            for (int kc = 1; kc < 8; ++kc) { const float4 t4 = *(const float4*)(pb + (u.pn * 8 + kc) * 256 + c); bb.x += t4.x; bb.y += t4.y; bb.z += t4.z; bb.w += t4.w; }
            f32x4 a = acc[ai][bj][m][n];
            a[0] = gelu_t(a[0] + bb.x); a[1] = gelu_t(a[1] + bb.y); a[2] = gelu_t(a[2] + bb.z); a[3] = gelu_t(a[3] + bb.w);
            if (r < NCROWS) *(uint2*)(H + (size_t)r * 256 + c) = pk4(a);
        }
    }
};
struct PEpiMemKV {
    PG8_EPI_HEAD
    bf16_t *MK, *MVT;
    DEV void operator()(const f32x4 (&acc)[2][2][4][2], const pg8::Unit& u, int wr, int wc, int fr, int fq) const {
        asm volatile("" : "+v"(fr), "+v"(fq));
        PG8_FOR_TILES {
            const int r = u.pm * 256 + ai * 128 + wr * 64 + m * 16 + fr, c = u.pn * 256 + bj * 128 + wc * 32 + n * 16 + 4 * fq;
            const int b = r >> 8, mm = r & 255;
            const f32x4 a = acc[ai][bj][m][n];
            if (u.pn == 0) { const int h = (c >> 6) & 3, d = c & 63; *(uint2*)(MK + ((size_t)(b * 4 + h) * 256 + mm) * 64 + d) = pk4(a); }
            else {
#pragma unroll
                for (int j = 0; j < 4; ++j) { const int cc = c + j, h = (cc >> 6) & 3, d = cc & 63; MVT[((size_t)(b * 4 + h) * 64 + d) * 256 + mm] = f2bf(a[j]); }
            }
        }
    }
};
template <int ACT>
struct PEpiBf {
    PG8_EPI_HEAD
    bf16_t* O; int ldo;
    DEV void operator()(const f32x4 (&acc)[2][2][4][2], const pg8::Unit& u, int wr, int wc, int fr, int fq) const {
        asm volatile("" : "+v"(fr), "+v"(fq));
        PG8_FOR_TILES {
            const int r = u.pm * 256 + ai * 128 + wr * 64 + m * 16 + fr, c = u.pn * 256 + bj * 128 + wc * 32 + n * 16 + 4 * fq;
            f32x4 a = acc[ai][bj][m][n];
            if (ACT == 1) {
#pragma unroll
                for (int j = 0; j < 4; ++j) { const float v = fmaxf(a[j], 0.f); a[j] = v * v; }
            }
            *(uint2*)(O + (size_t)r * ldo + c) = pk4(a);
        }
    }
};
struct PEpiRes {
    PG8_EPI_HEAD
    const float* R; float* O;
    DEV void operator()(const f32x4 (&acc)[2][2][4][2], const pg8::Unit& u, int wr, int wc, int fr, int fq) const {
        asm volatile("" : "+v"(fr), "+v"(fq));
        PG8_FOR_TILES {
            const size_t o = (size_t)(u.pm * 256 + ai * 128 + wr * 64 + m * 16 + fr) * 1024 + u.pn * 256 + bj * 128 + wc * 32 + n * 16 + 4 * fq;
            const f32x4 r = *(const f32x4*)(R + o);
            *(f32x4*)(O + o) = r + acc[ai][bj][m][n];
        }
    }
};
struct PEpiMerge {
    PG8_EPI_HEAD
    const bf16_t *ZA, *YX; bf16_t* Y;
    DEV void operator()(const f32x4 (&acc)[2][2][4][2], const pg8::Unit& u, int wr, int wc, int fr, int fq) const {
        asm volatile("" : "+v"(fr), "+v"(fq));
        const int ch = u.pn * 64 + wc * 16 + 4 * fq;
#pragma unroll
        for (int ai = 0; ai < 2; ++ai)
#pragma unroll
            for (int m = 0; m < 4; ++m) {
                const size_t row = (size_t)(u.pm * 256 + ai * 128 + wr * 64 + m * 16 + fr);
                const uint2 a = *(const uint2*)(ZA + row * ZW + C_Q + ch), b = *(const uint2*)(ZA + row * ZW + C_GR + ch), c = *(const uint2*)(YX + row * 1024 + ch);
                const f32x4 g0 = acc[ai][0][m][0], g1 = acc[ai][0][m][1], g2 = acc[ai][1][m][0];
                f32x4 y;
                y[0] = sigm(g0[0]) * lo_f(a.x) + sigm(g1[0]) * lo_f(b.x) + sigm(g2[0]) * lo_f(c.x);
                y[1] = sigm(g0[1]) * hi_f(a.x) + sigm(g1[1]) * hi_f(b.x) + sigm(g2[1]) * hi_f(c.x);
                y[2] = sigm(g0[2]) * lo_f(a.y) + sigm(g1[2]) * lo_f(b.y) + sigm(g2[2]) * lo_f(c.y);
                y[3] = sigm(g0[3]) * hi_f(a.y) + sigm(g1[3]) * hi_f(b.y) + sigm(g2[3]) * hi_f(c.y);
                *(uint2*)(Y + row * 1024 + ch) = pk4(y);
            }
    }
};

DEV bool tile_map(int idx, int NT, int& pm, int& pn) {
    const int x = idx & 7, pl = (idx >> 3) & 3, pmid = (idx >> 5) & 7, st = idx >> 8;
    pm = pmid * 8 + x;
    pn = st * 4 + pl;
    return pn < NT;
}
DEV int tile_count(int NT) { return ((NT + 3) / 4) * 256; }

DEV void cmp2_job(const Params& P, int job) {
    char* aux = (char*)P.out;
    const int lane = threadIdx.x & 63, w = (threadIdx.x & 255) >> 6;
    const int wj = job * 4 + w;
    const int which = wj >= NCROWS ? 1 : 0;
    const int r = wj - which * NCROWS;
    const int bg = r / NCMP, n = r - bg * NCMP;
    const bf16_t* hid = (const bf16_t*)(aux + (which ? O_HIDV : O_HIDK)) + (size_t)r * 256;
    const float* w2 = which ? P.wv2 : P.wk2;
    float acc = 0.f;
#pragma unroll 8
    for (int k = 0; k < 256; ++k) acc += bf2f(hid[k]) * w2[k * 64 + lane];
    if (!which) {
        const int pos = 16 * n + 31, i = lane & 7;
        const float cs = ((const float*)(aux + O_ROPEC))[pos * 8 + i], sn = ((const float*)(aux + O_ROPES))[pos * 8 + i];
        const float pr = __shfl_xor(acc, 8);
        float o = acc;
        if (lane < 16) o = (lane & 8) ? (acc * cs + pr * sn) : (acc * cs - pr * sn);
        bf16_t* KC = (bf16_t*)(aux + O_KC);
        KC[((size_t)bg * 128 + n) * 64 + lane] = f2bf(o);
        if (n == NCMP - 1) KC[((size_t)bg * 128 + 127) * 64 + lane] = 0;
    } else {
        bf16_t* VCT = (bf16_t*)(aux + O_VCT);
        VCT[((size_t)bg * 64 + lane) * 128 + n] = f2bf(acc);
        if (n == NCMP - 1) VCT[((size_t)bg * 64 + lane) * 128 + 127] = 0;
    }
}

DEV void rnn_job(const Params& P, int job, char* smem, bool dry) {
    char* aux = (char*)P.out;
    bf16_t* ZA = (bf16_t*)(P.ws + W_ZA);
    const int b = job >> 6, n = (job >> 2) & 15, ct = job & 3;
    bf16_t* sX = (bf16_t*)smem;
    float* sXf = (float*)(smem + 9216);
    float* sCw = (float*)(smem + 9216 + 16640);
    float* sSum = (float*)(smem + 9216 + 16640 + 1280);
    bf16_t* sRaw = (bf16_t*)(smem + 9216 + 16640 + 1280 + 2048);
    const int tid = opaque_tid(), w = tid >> 6, lane = tid & 63, fr = lane & 15, fq = lane >> 4;
    const bf16_t* WAT = (const bf16_t*)(aux + O_WAT) + n * 4096;
    const bf16_t* WIT = (const bf16_t*)(aux + O_WIT) + n * 4096;
    bf16x8 wa[2], wi[2];
#pragma unroll
    for (int ks = 0; ks < 2; ++ks) {
        wa[ks] = *(const bf16x8*)(WAT + (16 * ct + fr) * 64 + 32 * ks + 8 * fq);
        wi[ks] = *(const bf16x8*)(WIT + (16 * ct + fr) * 64 + 32 * ks + 8 * fq);
    }
    const int c = n * 64 + 16 * ct + fr;
    const float ba = P.b_a[c], bi = P.b_i[c], cl = -8.0f * log1pf(__expf(-P.lam[c]));
    float carry = 0.f;
    __syncthreads();
    for (int i = tid; i < 320; i += 256) sCw[i] = (i < 256) ? P.conv_w[(i >> 6) * 1024 + n * 64 + (i & 63)] : P.conv_b[n * 64 + (i & 63)];
    const int lt = tid >> 2, cg = (tid & 3) * 16;
    const bf16_t* xbase = ZA + (size_t)(b * S) * ZW + C_XR + n * 64 + cg;
    bf16_t* sRaw2 = sRaw + 67 * 72;
    u32x4 xm0, xm1, xh0 = {0u, 0u, 0u, 0u}, xh1 = {0u, 0u, 0u, 0u};
    { const u32x4* xp = (const u32x4*)(xbase + (size_t)lt * ZW); xm0 = xp[0]; xm1 = xp[1]; }
    *(u32x4*)(sRaw + (lt + 3) * 72 + cg) = xm0; *(u32x4*)(sRaw + (lt + 3) * 72 + cg + 8) = xm1;
    if (tid < 12) { *(u32x4*)(sRaw + lt * 72 + cg) = xh0; *(u32x4*)(sRaw + lt * 72 + cg + 8) = xh1; }
    { const u32x4* xp = (const u32x4*)(xbase + (size_t)(64 + lt) * ZW); xm0 = xp[0]; xm1 = xp[1];
      if (tid < 12) { const u32x4* hp = (const u32x4*)(xbase + (size_t)(61 + lt) * ZW); xh0 = hp[0]; xh1 = hp[1]; } }
    __syncthreads();
#pragma unroll 1
    for (int chunk = 0; chunk < 32; ++chunk) {
        const int tc = chunk * 64;
        const bf16_t* rawc = (chunk & 1) ? sRaw2 : sRaw;
        bf16_t* rawn = (chunk & 1) ? sRaw : sRaw2;
        bf16_t gv[4];
#pragma unroll
        for (int j = 0; j < 4; ++j) gv[j] = ZA[(size_t)(b * S + tc + 16 * w + 4 * fq + j) * ZW + C_GR + n * 64 + 16 * ct + fr];
        {
            float xv[16];
#pragma unroll
            for (int e4 = 0; e4 < 4; ++e4) { const float4 bb = *(const float4*)(sCw + 256 + cg + 4 * e4); xv[4 * e4] = bb.x; xv[4 * e4 + 1] = bb.y; xv[4 * e4 + 2] = bb.z; xv[4 * e4 + 3] = bb.w; }
#pragma unroll
            for (int k = 0; k < 4; ++k) {
                const u32x4 v0 = *(const u32x4*)(rawc + (lt + k) * 72 + cg), v1 = *(const u32x4*)(rawc + (lt + k) * 72 + cg + 8);
                const unsigned u[8] = {v0.x, v0.y, v0.z, v0.w, v1.x, v1.y, v1.z, v1.w};
#pragma unroll
                for (int e4 = 0; e4 < 4; ++e4) {
                    const float4 wv = *(const float4*)(sCw + k * 64 + cg + 4 * e4);
                    xv[4 * e4] += wv.x * lo_f(u[2 * e4]);
                    xv[4 * e4 + 1] += wv.y * hi_f(u[2 * e4]);
                    xv[4 * e4 + 2] += wv.z * lo_f(u[2 * e4 + 1]);
                    xv[4 * e4 + 3] += wv.w * hi_f(u[2 * e4 + 1]);
                }
            }
            if ((tid & 3) == ct) {
#pragma unroll
                for (int e = 0; e < 16; ++e) sXf[lt * 17 + e] = xv[e];
            }
            u32x4 o0 = {pk2(xv[0], xv[1]), pk2(xv[2], xv[3]), pk2(xv[4], xv[5]), pk2(xv[6], xv[7])};
            u32x4 o1 = {pk2(xv[8], xv[9]), pk2(xv[10], xv[11]), pk2(xv[12], xv[13]), pk2(xv[14], xv[15])};
            *(u32x4*)(sX + lt * 72 + cg) = o0;
            *(u32x4*)(sX + lt * 72 + cg + 8) = o1;
        }
        __syncthreads();
        f32x4 R = (f32x4){0.f, 0.f, 0.f, 0.f}, I = (f32x4){0.f, 0.f, 0.f, 0.f};
#pragma unroll
        for (int ks = 0; ks < 2; ++ks) {
            const bf16x8 af = *(const bf16x8*)(sX + (16 * w + fr) * 72 + 32 * ks + 8 * fq);
            R = MFMA16(af, wa[ks], R); I = MFMA16(af, wi[ks], I);
        }
        if (chunk + 1 < 32) {
            *(u32x4*)(rawn + (lt + 3) * 72 + cg) = xm0; *(u32x4*)(rawn + (lt + 3) * 72 + cg + 8) = xm1;
            if (tid < 12) { *(u32x4*)(rawn + lt * 72 + cg) = xh0; *(u32x4*)(rawn + lt * 72 + cg + 8) = xh1; }
        }
        float hl[4], pc[4];
        float h = 0.f, pcum = 1.f;
#pragma unroll
        for (int j = 0; j < 4; ++j) {
            const float xcv = sXf[(16 * w + 4 * fq + j) * 17 + fr];
            const float rg = sigm(R[j] + ba), gi = sigm(I[j] + bi);
            const float la = rg * cl;
            const float a_ = __expf(la);
            const float mult = sqrtf(fmaxf(1.f - a_ * a_, 0.f));
            const float u = mult * gi * xcv;
            h = a_ * h + u; pcum *= a_;
            hl[j] = h; pc[j] = pcum;
        }
        float A = pcum, H = h;
        float A1 = __shfl_up(A, 16), H1 = __shfl_up(H, 16);
        if (fq >= 1) { H = A * H1 + H; A = A * A1; }
        float A2 = __shfl_up(A, 32), H2 = __shfl_up(H, 32);
        if (fq >= 2) { H = A * H2 + H; A = A * A2; }
        float Ax = __shfl_up(A, 16), Hx = __shfl_up(H, 16);
        const float Ae = fq == 0 ? 1.f : Ax, He = fq == 0 ? 0.f : Hx;
        if (fq == 3) { sSum[w * 16 + fr] = A; sSum[64 + w * 16 + fr] = H; }
        __syncthreads();
        if (chunk + 2 < 32) {
            const u32x4* xp = (const u32x4*)(xbase + (size_t)(tc + 128 + lt) * ZW); xm0 = xp[0]; xm1 = xp[1];
            if (tid < 12) { const u32x4* hp = (const u32x4*)(xbase + (size_t)(tc + 125 + lt) * ZW); xh0 = hp[0]; xh1 = hp[1]; }
        }
        float cin = carry, mycin = 0.f;
#pragma unroll
        for (int ww = 0; ww < 4; ++ww) {
            if (ww == w) mycin = cin;
            cin = sSum[ww * 16 + fr] * cin + sSum[64 + ww * 16 + fr];
        }
        carry = cin;
        const float sq = Ae * mycin + He;
#pragma unroll
        for (int j = 0; j < 4; ++j) {
            const float hfin = hl[j] + pc[j] * sq;
            const size_t grow = (size_t)(b * S + tc + 16 * w + 4 * fq + j);
            bf16_t* op = dry ? ((bf16_t*)(P.ws + W_YX) + grow * 1024 + n * 64 + 16 * ct + fr) : (ZA + grow * ZW + C_GR + n * 64 + 16 * ct + fr);
            *op = f2bf(gelu_t(bf2f(gv[j])) * hfin);
        }
    }
}

constexpr float EXPC = 0.125f * 1.4426950408889634f;
struct AttnAcc { f32x4 o[4][2]; f32x4 ls[2]; float m[2], l[2]; };
DEV void attn_init(AttnAcc& a) {
#pragma unroll
    for (int d = 0; d < 4; ++d)
#pragma unroll
        for (int q = 0; q < 2; ++q) a.o[d][q] = (f32x4){0.f, 0.f, 0.f, 0.f};
    a.m[0] = a.m[1] = -INFINITY; a.l[0] = a.l[1] = 0.f; a.ls[0] = (f32x4){0.f, 0.f, 0.f, 0.f}; a.ls[1] = (f32x4){0.f, 0.f, 0.f, 0.f};
}
DEV bf16x8 mk8(unsigned a, unsigned b, unsigned c, unsigned d) { u32x4 u = {a, b, c, d}; return __builtin_bit_cast(bf16x8, u); }

template <class MF>
DEV void attn_step(const bf16_t* sK, const bf16_t* sVt, int vstride, const bf16x8 (&qf)[2][2], AttnAcc& st, const MF& mf, int fr, int fq) {
    f32x4 s[4][2];
#pragma unroll
    for (int kt = 0; kt < 4; ++kt) {
        s[kt][0] = (f32x4){0.f, 0.f, 0.f, 0.f}; s[kt][1] = (f32x4){0.f, 0.f, 0.f, 0.f};
#pragma unroll
        for (int ks = 0; ks < 2; ++ks) {
            const bf16x8 kf = *(const bf16x8*)(sK + (16 * kt + fr) * 80 + 32 * ks + 8 * fq);
            s[kt][0] = MFMA16(kf, qf[0][ks], s[kt][0]);
            s[kt][1] = MFMA16(kf, qf[1][ks], s[kt][1]);
        }
    }
#pragma unroll
    for (int qt = 0; qt < 2; ++qt) {
#pragma unroll
        for (int kt = 0; kt < 4; ++kt)
#pragma unroll
            for (int j = 0; j < 4; ++j) {
                const float p = mf(qt, 16 * kt + 4 * fq + j) ? __builtin_amdgcn_exp2f(s[kt][qt][j] * EXPC) : 0.f;
                s[kt][qt][j] = p;
            }
    }
#pragma unroll
    for (int ks = 0; ks < 2; ++ks) {
        bf16x8 pf[2];
#pragma unroll
        for (int qt = 0; qt < 2; ++qt)
            pf[qt] = mk8(pk2(s[2 * ks][qt][0], s[2 * ks][qt][1]), pk2(s[2 * ks][qt][2], s[2 * ks][qt][3]),
                         pk2(s[2 * ks + 1][qt][0], s[2 * ks + 1][qt][1]), pk2(s[2 * ks + 1][qt][2], s[2 * ks + 1][qt][3]));
#pragma unroll
        for (int dt = 0; dt < 4; ++dt) {
            const u32x2 v0 = *(const u32x2*)(sVt + (16 * dt + fr) * vstride + 32 * ks + 4 * fq);
            const u32x2 v1 = *(const u32x2*)(sVt + (16 * dt + fr) * vstride + 32 * ks + 16 + 4 * fq);
            const bf16x8 vf = mk8(v0.x, v0.y, v1.x, v1.y);
            st.o[dt][0] = MFMA16(vf, pf[0], st.o[dt][0]);
            st.o[dt][1] = MFMA16(vf, pf[1], st.o[dt][1]);
        }
        st.ls[0] = MFMA16(ones8(), pf[0], st.ls[0]);
        st.ls[1] = MFMA16(ones8(), pf[1], st.ls[1]);
    }
}
DEV void attn_step_fast(const bf16_t* sK, const bf16_t* sVt, const bf16x8 (&qf)[2][2], AttnAcc& st, const float (&bitoff)[2], int fr, int fq) {
    f32x4 s[4][2];
#pragma unroll
    for (int kt = 0; kt < 4; ++kt) {
        s[kt][0] = (f32x4){0.f, 0.f, 0.f, 0.f}; s[kt][1] = (f32x4){0.f, 0.f, 0.f, 0.f};
#pragma unroll
        for (int ks = 0; ks < 2; ++ks) {
            const bf16x8 kf = *(const bf16x8*)(sK + (16 * kt + fr) * 80 + 32 * ks + 8 * fq);
            s[kt][0] = MFMA16(kf, qf[0][ks], s[kt][0]);
            s[kt][1] = MFMA16(kf, qf[1][ks], s[kt][1]);
        }
    }
#pragma unroll
    for (int qt = 0; qt < 2; ++qt) {
        const float off = bitoff[qt];
#pragma unroll
        for (int kt = 0; kt < 4; ++kt)
#pragma unroll
            for (int j = 0; j < 4; ++j) s[kt][qt][j] = __builtin_amdgcn_exp2f(fmaf(s[kt][qt][j], EXPC, off));
    }
#pragma unroll
    for (int ks = 0; ks < 2; ++ks) {
        bf16x8 pf[2];
#pragma unroll
        for (int qt = 0; qt < 2; ++qt)
            pf[qt] = mk8(pk2(s[2 * ks][qt][0], s[2 * ks][qt][1]), pk2(s[2 * ks][qt][2], s[2 * ks][qt][3]),
                         pk2(s[2 * ks + 1][qt][0], s[2 * ks + 1][qt][1]), pk2(s[2 * ks + 1][qt][2], s[2 * ks + 1][qt][3]));
#pragma unroll
        for (int dt = 0; dt < 4; ++dt) {
            const u32x2 v0 = *(const u32x2*)(sVt + (16 * dt + fr) * 72 + 32 * ks + 4 * fq);
            const u32x2 v1 = *(const u32x2*)(sVt + (16 * dt + fr) * 72 + 32 * ks + 16 + 4 * fq);
            const bf16x8 vf = mk8(v0.x, v0.y, v1.x, v1.y);
            st.o[dt][0] = MFMA16(vf, pf[0], st.o[dt][0]);
            st.o[dt][1] = MFMA16(vf, pf[1], st.o[dt][1]);
        }
        st.ls[0] = MFMA16(ones8(), pf[0], st.ls[0]);
        st.ls[1] = MFMA16(ones8(), pf[1], st.ls[1]);
    }
}
template <int QT>
DEV void attn_half_fast(const bf16_t* sK, const bf16_t* sVt, const bf16x8 (&qf)[2][2], AttnAcc& st, float bitoff, int fr, int fq) {
    f32x4 s[4];
#pragma unroll
    for (int kt = 0; kt < 4; ++kt) {
        s[kt] = (f32x4){0.f, 0.f, 0.f, 0.f};
#pragma unroll
        for (int ks = 0; ks < 2; ++ks) {
            const bf16x8 kf = *(const bf16x8*)(sK + (16 * kt + fr) * 80 + 32 * ks + 8 * fq);
            s[kt] = MFMA16(kf, qf[QT][ks], s[kt]);
        }
    }
    const float off = bitoff;
#pragma unroll
    for (int kt = 0; kt < 4; ++kt)
#pragma unroll
        for (int j = 0; j < 4; ++j) s[kt][j] = __builtin_amdgcn_exp2f(fmaf(s[kt][j], EXPC, off));
#pragma unroll
    for (int ks = 0; ks < 2; ++ks) {
        const bf16x8 pf = mk8(pk2(s[2 * ks][0], s[2 * ks][1]), pk2(s[2 * ks][2], s[2 * ks][3]), pk2(s[2 * ks + 1][0], s[2 * ks + 1][1]), pk2(s[2 * ks + 1][2], s[2 * ks + 1][3]));
#pragma unroll
        for (int dt = 0; dt < 4; ++dt) {
            const u32x2 v0 = *(const u32x2*)(sVt + (16 * dt + fr) * 72 + 32 * ks + 4 * fq);
            const u32x2 v1 = *(const u32x2*)(sVt + (16 * dt + fr) * 72 + 32 * ks + 16 + 4 * fq);
            st.o[dt][QT] = MFMA16(mk8(v0.x, v0.y, v1.x, v1.y), pf, st.o[dt][QT]);
        }
        st.ls[QT] = MFMA16(ones8(), pf, st.ls[QT]);
    }
}
DEV void attn_fold_out(bf16_t* const (&op)[2], const AttnAcc& st, const float (&gate)[2]) {
#pragma unroll
    for (int qt = 0; qt < 2; ++qt) {
        const float l = st.ls[qt][0];
        const float sc = gate[qt] * __builtin_amdgcn_rcpf(fmaxf(l, 1e-30f));
#pragma unroll
        for (int dt = 0; dt < 4; ++dt) {
            const uint2 pv = *(const uint2*)(op[qt] + 16 * dt);
            f32x4 r = st.o[dt][qt] * sc;
            r[0] += lo_f(pv.x); r[1] += hi_f(pv.x); r[2] += lo_f(pv.y); r[3] += hi_f(pv.y);
            *(uint2*)(op[qt] + 16 * dt) = make_uint2(pk2(r[0], r[1]), pk2(r[2], r[3]));
        }
    }
}
DEV void attn_fold(f32x4 (&tot)[4][2], const AttnAcc& st, const float (&gate)[2]) {
#pragma unroll
    for (int qt = 0; qt < 2; ++qt) {
        const float l = st.ls[qt][0];
        const float sc = gate[qt] * __builtin_amdgcn_rcpf(fmaxf(l, 1e-30f));
#pragma unroll
        for (int dt = 0; dt < 4; ++dt) tot[dt][qt] += st.o[dt][qt] * sc;
    }
}
DEV void ld64(u32x4 (&r)[2], const bf16_t* src, size_t sstride, int tid) {
#pragma unroll
    for (int i = 0; i < 2; ++i) { const int c = tid + 256 * i; r[i] = *(const u32x4*)(src + (size_t)(c >> 3) * sstride + (c & 7) * 8); }
}
DEV void st64(bf16_t* dst, const u32x4 (&r)[2], int tid, int stride) {
#pragma unroll
    for (int i = 0; i < 2; ++i) { const int c = tid + 256 * i; *(u32x4*)(dst + (c >> 3) * stride + (c & 7) * 8) = r[i]; }
}

#define OUTP(QT) ((dry ? (bf16_t*)(P.ws + W_YX) + (size_t)(b * S + tq[QT]) * 1024 : ZA + (size_t)(b * S + tq[QT]) * ZW + C_Q) + head * 64 + 4 * fq)
#define LOAD_GATE(G2, BR) float G2[2]; { G2[0] = bf2f(ZA[(size_t)(b * S + tq[0]) * ZW + C_G + head * 3 + (BR)]); G2[1] = bf2f(ZA[(size_t)(b * S + tq[1]) * ZW + C_G + head * 3 + (BR)]); }
struct MaskAll { DEV bool operator()(int, int) const { return true; } };
struct MaskSel { unsigned bit[2]; int t[2]; int k0; DEV bool operator()(int qt, int kk) const { return bit[qt] && (k0 + kk <= t[qt]); } };
struct MaskWin { int t[2]; int k0; DEV bool operator()(int qt, int kk) const { const int k = k0 + kk; return k <= t[qt] && k > t[qt] - 512; } };

DEV void xattn_job(const Params& P, int job, char* smem, bool dry) {
    char* aux = (char*)P.out;
    bf16_t* ZA = (bf16_t*)(P.ws + W_ZA);
    const int qb = job & 15, h = (job >> 4) & 3, b = job >> 6;
    bf16_t* sK = (bf16_t*)smem;
    bf16_t* sVt = sK + 64 * 80;
    const int tid = opaque_tid(), w = tid >> 6, lane = tid & 63, fr = lane & 15, fq = lane >> 4;
    const int t0 = qb * 128 + w * 32;
    bf16x8 qf[2][2];
#pragma unroll
    for (int qt = 0; qt < 2; ++qt)
#pragma unroll
        for (int ks = 0; ks < 2; ++ks) qf[qt][ks] = *(const bf16x8*)(ZA + (size_t)(b * S + t0 + 16 * qt + fr) * ZW + C_QX + h * 64 + 32 * ks + 8 * fq);
    const bf16_t* MK = (const bf16_t*)(aux + O_MEMK) + (size_t)(b * 4 + h) * 256 * 64;
    const bf16_t* MVT = (const bf16_t*)(aux + O_MEMVT) + (size_t)(b * 4 + h) * 64 * 256;
    AttnAcc st; attn_init(st);
    u32x4 rk[2], rv[2];
    ld64(rk, MK, 64, tid); ld64(rv, MVT, 256, tid);
#pragma unroll 1
    for (int jb = 0; jb < 4; ++jb) {
        __syncthreads();
        st64(sK, rk, tid, 80); st64(sVt, rv, tid, 72);
        __syncthreads();
        if (jb + 1 < 4) { ld64(rk, MK + (size_t)(jb + 1) * 64 * 64, 64, tid); ld64(rv, MVT + (jb + 1) * 64, 256, tid); }
        __builtin_amdgcn_sched_barrier(0);
        { const float z2[2] = {0.f, 0.f}; attn_step_fast(sK, sVt, qf, st, z2, fr, fq); }
    }
    f32x4 tot[4][2];
#pragma unroll
    for (int dt = 0; dt < 4; ++dt) { tot[dt][0] = (f32x4){0.f, 0.f, 0.f, 0.f}; tot[dt][1] = (f32x4){0.f, 0.f, 0.f, 0.f}; }
    const float one[2] = {1.f, 1.f};
    attn_fold(tot, st, one);
#pragma unroll
    for (int qt = 0; qt < 2; ++qt)
#pragma unroll
        for (int dt = 0; dt < 4; ++dt)
            *(uint2*)((dry ? (bf16_t*)(P.ws + W_Y) + (size_t)(b * S + t0 + 16 * qt + fr) * 1024 : ZA + (size_t)(b * S + t0 + 16 * qt + fr) * ZW + C_QX) + h * 64 + 16 * dt + 4 * fq) =
                make_uint2(pk2(tot[dt][qt][0], tot[dt][qt][1]), pk2(tot[dt][qt][2], tot[dt][qt][3]));
}

DEV void nsa_job(const Params& P, int job, char* smem, bool dry) {
    char* aux = (char*)P.out;
    bf16_t* ZA = (bf16_t*)(P.ws + W_ZA);
    const int pj_ = job >> 1, bg = pj_ & 31, qb = 63 - (2 * (pj_ >> 5) + (job & 1)), b = bg >> 2, g = bg & 3, t0 = qb * 32;
    bf16_t* sK = (bf16_t*)smem;
    bf16_t* sVt = (bf16_t*)(smem + 20480);
    float* sImp = (float*)(smem + 38912);
    unsigned* sSel = (unsigned*)(smem + 38912 + 4096);
    constexpr int KVBUF = 9728;
    const int tid = opaque_tid(), w = tid >> 6, lane = tid & 63, fr = lane & 15, fq = lane >> 4;
    const int head = g * 4 + (fr & 3);
    const int qi0 = 8 * w + (fr >> 2);
    int tq[2];
    bf16x8 qf[2][2];
#pragma unroll
    for (int qt = 0; qt < 2; ++qt) {
        tq[qt] = t0 + qi0 + 4 * qt;
        const bf16_t* rowp = ZA + (size_t)(b * S + tq[qt]) * ZW;
#pragma unroll
        for (int ks = 0; ks < 2; ++ks) qf[qt][ks] = *(const bf16x8*)(rowp + C_Q + head * 64 + 32 * ks + 8 * fq);
    }
    f32x4 tot[4][2];
#pragma unroll
    for (int dt = 0; dt < 4; ++dt) { tot[dt][0] = (f32x4){0.f, 0.f, 0.f, 0.f}; tot[dt][1] = (f32x4){0.f, 0.f, 0.f, 0.f}; }

    {
        const bf16_t* KC = (const bf16_t*)(aux + O_KC) + (size_t)bg * 128 * 64;
        const bf16_t* VCT = (const bf16_t*)(aux + O_VCT) + (size_t)bg * 64 * 128;
        __syncthreads();
#pragma unroll
        for (int i = 0; i < 4; ++i) {
            const int c = tid + 256 * i;
            { const int r = c >> 3, k = (c & 7) * 8; *(u32x4*)(sK + r * 80 + k) = *(const u32x4*)(KC + r * 64 + k); }
            { const int r = c >> 4, k = (c & 15) * 8; *(u32x4*)(sVt + r * 136 + k) = *(const u32x4*)(VCT + r * 128 + k); }
        }
        __syncthreads();
#pragma unroll
        for (int qt = 0; qt < 2; ++qt) {
            const float g0 = bf2f(ZA[(size_t)(b * S + tq[qt]) * ZW + C_G + head * 3 + 0]);
            f32x4 s[8];
#pragma unroll
            for (int kt = 0; kt < 8; ++kt) {
                s[kt] = (f32x4){0.f, 0.f, 0.f, 0.f};
#pragma unroll
                for (int ks = 0; ks < 2; ++ks) {
                    const bf16x8 kf = *(const bf16x8*)(sK + (16 * kt + fr) * 80 + 32 * ks + 8 * fq);
                    s[kt] = MFMA16(kf, qf[qt][ks], s[kt]);
                }
            }
            float mx = -INFINITY;
#pragma unroll
            for (int kt = 0; kt < 8; ++kt)
#pragma unroll
                for (int j = 0; j < 4; ++j) {
                    const int n = 16 * kt + 4 * fq + j;
                    const float v = (n < NCMP && 16 * n + 31 <= tq[qt]) ? s[kt][j] : -INFINITY;
                    s[kt][j] = v; mx = fmaxf(mx, v);
                }
            mx = fmaxf(mx, __shfl_xor(mx, 16)); mx = fmaxf(mx, __shfl_xor(mx, 32));
            const float msub = (mx == -INFINITY) ? 0.f : mx;
            float ps = 0.f;
#pragma unroll
            for (int kt = 0; kt < 8; ++kt)
#pragma unroll
                for (int j = 0; j < 4; ++j) { const float p = __builtin_amdgcn_exp2f((s[kt][j] - msub) * EXPC); s[kt][j] = p; ps += p; }
            ps += __shfl_xor(ps, 16); ps += __shfl_xor(ps, 32);
            const float inv = __builtin_amdgcn_rcpf(fmaxf(ps, 1e-30f));
            float bprev = 0.f;
#pragma unroll
            for (int kt = 0; kt < 8; ++kt) {
                s[kt] *= inv;
                const float a = s[kt][0] + s[kt][1] + s[kt][2] + 0.5f * s[kt][3];
                const float bq = 0.5f * s[kt][3];
                const float x = __shfl(bq, (lane + 48) & 63);
                const float y = __shfl(bprev, (lane + 48) & 63);
                float iv = a + (fq > 0 ? x : y);
                iv += __shfl_xor(iv, 1); iv += __shfl_xor(iv, 2);
                if ((fr & 3) == 0) sImp[(qi0 + 4 * qt) * 32 + 4 * kt + fq] = iv;
                bprev = bq;
            }
#pragma unroll
            for (int ks = 0; ks < 4; ++ks) {
                const f32x4 pa = s[2 * ks] * g0, pb = s[2 * ks + 1] * g0;
                const bf16x8 pf = mk8(pk2(pa[0], pa[1]), pk2(pa[2], pa[3]), pk2(pb[0], pb[1]), pk2(pb[2], pb[3]));
#pragma unroll
                for (int dt = 0; dt < 4; ++dt) {
                    const u32x2 v0 = *(const u32x2*)(sVt + (16 * dt + fr) * 136 + 32 * ks + 4 * fq);
                    const u32x2 v1 = *(const u32x2*)(sVt + (16 * dt + fr) * 136 + 32 * ks + 16 + 4 * fq);
                    tot[dt][qt] = MFMA16(mk8(v0.x, v0.y, v1.x, v1.y), pf, tot[dt][qt]);
                }
            }
            __builtin_amdgcn_sched_barrier(0);
        }
    }
#pragma unroll
    for (int qt = 0; qt < 2; ++qt) {
        bf16_t* op = (dry ? (bf16_t*)(P.ws + W_YX) + (size_t)(b * S + tq[qt]) * 1024 : ZA + (size_t)(b * S + tq[qt]) * ZW + C_Q) + head * 64 + 4 * fq;
#pragma unroll
        for (int dt = 0; dt < 4; ++dt) *(uint2*)(op + 16 * dt) = pk4(tot[dt][qt]);
    }
    __syncthreads();
    {
        float myv[4];
#pragma unroll
        for (int i = 0; i < 4; ++i) {
            const int pidx = tid + 256 * i, q = pidx >> 5, m = pidx & 31;
            const int t = t0 + q, cur = t >> 6;
            const float sum = sImp[q * 32 + m];
            const bool forced = (m == 0) || (m == cur) || (m == cur - 1);
            const bool future = m * 64 > t;
            myv[i] = forced ? INFINITY : (future ? -INFINITY : sum);
        }
        if (tid == 0) sSel[32] = 0u;
        __syncthreads();
#pragma unroll
        for (int i = 0; i < 4; ++i) { const int pidx = tid + 256 * i; sImp[pidx] = myv[i]; }
        __syncthreads();
        unsigned wun = 0u;
#pragma unroll
        for (int i = 0; i < 4; ++i) {
            const int pidx = tid + 256 * i, q = pidx >> 5, m = pidx & 31;
            const float v = myv[i];
            int rank = 0;
#pragma unroll
            for (int m2 = 0; m2 < 32; ++m2) {
                const float o = sImp[q * 32 + m2];
                rank += (o > v || (o == v && m2 < m)) ? 1 : 0;
            }
            const bool selb = (rank < 8) && (v > -INFINITY);
            const unsigned long long bal = __ballot(selb);
            const unsigned mk = (unsigned)(bal >> (32 * (lane >> 5)));
            if ((lane & 31) == 0) sSel[q] = mk;
            wun |= (unsigned)bal | (unsigned)(bal >> 32);
        }
        if (lane == 0) atomicOr(&sSel[32], wun);
    }
    __syncthreads();
    __shared__ unsigned s_xuni[2];
    if (tid == 0) s_xuni[threadIdx.x >> 8] = sSel[32];
    __syncthreads();
    const unsigned uni = s_xuni[0] | s_xuni[1];
    const int jmax = (t0 + 31) >> 6;
    {
        AttnAcc st; attn_init(st);
        const bf16_t* Kb = ZA + (size_t)(b * S) * ZW + C_KS + g * 64;
        const bf16_t* Vb = (const bf16_t*)(P.ws + W_VST) + (size_t)bg * 64 * S;
        unsigned rem = uni & ((2u << jmax) - 1u);
        u32x4 rk[2], rv[2];
        if (rem) { const int j0 = __builtin_ctz(rem); ld64(rk, Kb + (size_t)(j0 * 64) * ZW, ZW, tid); ld64(rv, Vb + j0 * 64, S, tid); }
        __syncthreads();
        int it = 0;
#pragma unroll 1
        while (rem) {
            const int jb = __builtin_ctz(rem);
            rem &= rem - 1u;
            bf16_t* sKb = (bf16_t*)smem + (it & 1) * KVBUF; bf16_t* sVb = sKb + 64 * 80; ++it;
            st64(sKb, rk, tid, 80); st64(sVb, rv, tid, 72);
            __syncthreads();
            if (rem) { const int jn = __builtin_ctz(rem); ld64(rk, Kb + (size_t)(jn * 64) * ZW, ZW, tid); ld64(rv, Vb + jn * 64, S, tid); }
            __builtin_amdgcn_sched_barrier(0);
            const unsigned b0 = (sSel[qi0] >> jb) & 1u, b1 = (sSel[qi0 + 4] >> jb) & 1u;
            if (jb * 64 + 63 <= t0) {
                const bool need0 = __builtin_amdgcn_ballot_w64(b0 != 0u) != 0ull, need1 = __builtin_amdgcn_ballot_w64(b1 != 0u) != 0ull;
                const float bo[2] = {b0 ? 0.f : -INFINITY, b1 ? 0.f : -INFINITY};
                if (need0 && need1) attn_step_fast(sKb, sVb, qf, st, bo, fr, fq);
                else if (need0) attn_half_fast<0>(sKb, sVb, qf, st, bo[0], fr, fq);
                else if (need1) attn_half_fast<1>(sKb, sVb, qf, st, bo[1], fr, fq);
            } else {
                MaskSel mf; mf.bit[0] = b0; mf.bit[1] = b1; mf.t[0] = tq[0]; mf.t[1] = tq[1]; mf.k0 = jb * 64;
                attn_step(sKb, sVb, 72, qf, st, mf, fr, fq);
            }
        }
        { LOAD_GATE(g1, 1) bf16_t* const op2[2] = {OUTP(0), OUTP(1)}; attn_fold_out(op2, st, g1); }
    }
    {
        AttnAcc st; attn_init(st);
        const bf16_t* Kb = ZA + (size_t)(b * S) * ZW + C_KW + g * 64;
        const bf16_t* Vb = (const bf16_t*)(P.ws + W_VWT) + (size_t)bg * 64 * S;
#pragma unroll
        for (int qt = 0; qt < 2; ++qt) {
            const int npad = 511 - tq[qt];
            if (npad > 0) { const float np = (float)npad; st.ls[qt] = (f32x4){np, np, np, np}; }
        }
        int jlo = t0 - 511; jlo = jlo < 0 ? 0 : (jlo >> 6);
        u32x4 rk[2], rv[2];
        ld64(rk, Kb + (size_t)(jlo * 64) * ZW, ZW, tid); ld64(rv, Vb + jlo * 64, S, tid);
        __syncthreads();
#pragma unroll 1
        for (int jb = jlo; jb <= jmax; ++jb) {
            bf16_t* sKb = (bf16_t*)smem + ((jb - jlo) & 1) * KVBUF; bf16_t* sVb = sKb + 64 * 80;
            st64(sKb, rk, tid, 80); st64(sVb, rv, tid, 72);
            __syncthreads();
            if (jb < jmax) { ld64(rk, Kb + (size_t)((jb + 1) * 64) * ZW, ZW, tid); ld64(rv, Vb + (jb + 1) * 64, S, tid); }
            __builtin_amdgcn_sched_barrier(0);
            if (jb * 64 + 63 <= t0 && jb * 64 > t0 + 31 - 512) {
                const float z2[2] = {0.f, 0.f};
                attn_step_fast(sKb, sVb, qf, st, z2, fr, fq);
            } else {
                MaskWin mf; mf.t[0] = tq[0]; mf.t[1] = tq[1]; mf.k0 = jb * 64;
                attn_step(sKb, sVb, 72, qf, st, mf, fr, fq);
            }
        }
        { LOAD_GATE(g2, 2) bf16_t* const op2[2] = {OUTP(0), OUTP(1)}; attn_fold_out(op2, st, g2); }
    }
}


#define XB_TMO      128
#define XB_XCNT(j)  (256  + 64 * (j))
#define XB_XSUB(j)  (1280 + 64 * (j))
#define XB_XGEN(j)  (2304 + 64 * (j))
#define XB_TOP      3328
#define XB_TOPGEN   3392
#define XCD_BAR_WORDS 3456
#define XB_SPIN_CAP (1u << 18)
#define LAS __attribute__((address_space(3)))
DEV unsigned xb_ld(unsigned* p) { return __hip_atomic_load(p, __ATOMIC_RELAXED, __HIP_MEMORY_SCOPE_AGENT); }
DEV unsigned xb_add(unsigned* p, unsigned v) { return __hip_atomic_fetch_add(p, v, __ATOMIC_RELAXED, __HIP_MEMORY_SCOPE_AGENT); }
DEV unsigned xb_xcc_id() { return (unsigned)__builtin_amdgcn_s_getreg((3 << 11) | 20) & 0xFu; }
#define XB_SPIN(cond, bar) do { unsigned _sp = 0; while (cond) { __builtin_amdgcn_s_sleep(1); \
    if ((++_sp & 255u) == 0u) { if (xb_ld(&(bar)[XB_TMO])) break; if (_sp > XB_SPIN_CAP) { atomicAdd(&(bar)[XB_TMO], 1u); break; } } } } while (0)
struct XcdBarrier { unsigned* bar; unsigned x; volatile LAS unsigned* st; };
DEV XcdBarrier xcd_barrier_post(unsigned* bar, volatile LAS unsigned* st) {
    XcdBarrier b; b.bar = bar; b.x = xb_xcc_id(); b.st = st;
    if (threadIdx.x == 0) (void)xb_add(&bar[XB_XCNT(b.x)], 1u);
    return b;
}
DEV void xcd_barrier_complete(unsigned* bar, unsigned x, unsigned& nloc, unsigned& nx) {
    const unsigned G = gridDim.x * gridDim.y * gridDim.z;
    unsigned sum, cnt, mine, sp = 0u;
    for (;;) {
        sum = 0u; cnt = 0u; mine = 0u;
#pragma unroll
        for (unsigned j = 0; j < 16; ++j) { const unsigned c = xb_ld(&bar[XB_XCNT(j)]); sum += c; cnt += (c > 0u) ? 1u : 0u; mine = (j == x) ? c : mine; }
        if (sum == G) break;
        __builtin_amdgcn_s_sleep(1);
        if ((++sp & 255u) == 0u) { if (xb_ld(&bar[XB_TMO])) break; if (sp > XB_SPIN_CAP) { atomicAdd(&bar[XB_TMO], 1u); break; } }
    }
    nloc = mine > 0u ? mine : 1u; nx = cnt > 0u ? cnt : 1u;
}
DEV void xcd_barrier(const XcdBarrier& b) {
    asm volatile("s_waitcnt vmcnt(0)" ::: "memory");
    __syncthreads();
    if (threadIdx.x == 0) {
        unsigned* bar = b.bar;
        __builtin_amdgcn_s_waitcnt(0);
        unsigned nloc = b.st[0], nx = b.st[1];
        if (nloc == 0u) { xcd_barrier_complete(bar, b.x, nloc, nx); b.st[0] = nloc; b.st[1] = nx; }
        const unsigned old = xb_add(&bar[XB_XSUB(b.x)], 1u);
        const unsigned gen = old / nloc;
        if (old + 1u == (gen + 1u) * nloc) {
            __builtin_amdgcn_fence(__ATOMIC_RELEASE, "agent");
            asm volatile("s_waitcnt vmcnt(0)" ::: "memory");
            const unsigned og = xb_add(&bar[XB_TOP], 1u);
            const unsigned tg = og / nx;
            if (og + 1u == (tg + 1u) * nx) xb_add(&bar[XB_TOPGEN], 1u);
            else XB_SPIN(xb_ld(&bar[XB_TOPGEN]) == tg, bar);
            __builtin_amdgcn_fence(__ATOMIC_ACQUIRE, "agent");
            xb_add(&bar[XB_XGEN(b.x)], 1u);
            asm volatile("s_waitcnt vmcnt(0)" ::: "memory");
        } else {
            XB_SPIN(xb_ld(&bar[XB_XGEN(b.x)]) == gen, bar);
            __builtin_amdgcn_fence(__ATOMIC_ACQUIRE, "agent");
            asm volatile("s_waitcnt vmcnt(0)" ::: "memory");
        }
    }
    __syncthreads();
}
constexpr size_t W_BAR = 252 * MiB;

constexpr int HALF_SMEM = 56320;
constexpr int SMEM_BYTES = 131072;

extern __shared__ __attribute__((aligned(16))) char dyn_smem[];
#define RUN_PG8(EPI_T, EPI_OBJ, A_, LDA_, BT_, LDB_, M_, N_, K_) { pg8::Gemm g_; g_.A = (A_); g_.Bt = (BT_); g_.M = (M_); g_.N = (N_); g_.K = (K_); g_.lda = (LDA_); g_.ldb = (LDB_); g_.gather = 0; \
        pg8::StaticOrder so_; so_.init((M_), (N_), (int)gridDim.x, (int)blockIdx.x); __syncthreads(); \
        pg8::gemm_phase<EPI_T, pg8::StaticOrder, true, true>((PG8_LAS unsigned char*)dyn_smem, g_, so_, (EPI_OBJ)); __syncthreads(); }

template <int PH, bool DRY = false>
DEV void run_phase(const Params& P, char* smem) {
    const int nb = gridDim.x, bid = blockIdx.x, sub = opaque_tid512() >> 8;
    char* hsm = smem + sub * HALF_SMEM;
    char* aux = (char*)P.out;
    char* ws = P.ws;
    bf16_t* ZA = (bf16_t*)(ws + W_ZA);
    if (PH == 0) {
        for (int pj = bid; pj < (5088 + 4096 + 512 + 64 + 64) / 2; pj += nb) {
            int j = 2 * pj + sub;
            if (j < 5088) {
                bool done = false;
#define TR(SRC, LD, DSTOFF, KK, NN, MAP, BLK)                                                                                  \
    if (!done) { const int nrt = (NN) / 64, nt = nrt * ((KK) / 64);                                                              \
        if (j < nt) { transpose_tile((SRC), (LD), (bf16_t*)(aux + (DSTOFF)), (KK), (j % nrt) * 64, (j / nrt) * 64, (MAP), hsm, (BLK) ? (NN) : 0); done = true; } else j -= nt; }
                TR(P.w_in, 7984, O_WTA, 1024, 5120, 1, 0)
                TR(P.w_in, 7984, O_WTB, 1024, 4096, 2, 0)
                TR(P.w_up, 4096, O_WTUP, 1024, 4096, 0, 0)
                TR(P.w_down, 1024, O_WTDN, 4096, 1024, 0, 0)
                TR(P.w_o, 1024, O_WTO, 1024, 1024, 0, 0)
                TR(P.w_xo, 1024, O_WTXO, 256, 1024, 0, 0)
                TR(P.w_mkv, 512, O_WTMKV, 1024, 512, 0, 0)
                TR(P.wk1, 256, O_WTCK1, 2048, 256, 0, 0)
                TR(P.wv1, 256, O_WTCV1, 2048, 256, 0, 0)
#undef TR
                if (!done) {
                    if (j < 16) transpose_tile(P.w_a + j * 4096, 64, (bf16_t*)(aux + O_WAT) + j * 4096, 64, 0, 0, 0, hsm);
                    else { j -= 16; transpose_tile(P.w_i + j * 4096, 64, (bf16_t*)(aux + O_WIT) + j * 4096, 64, 0, 0, 0, hsm); }
                }
                continue;
            }
            j -= 5088;
            if (j < 4096) { rownorm<false>(P.x, P.g_mix, (bf16_t*)(ws + W_U), nullptr, j * 4 + (opaque_tid() >> 6)); continue; }
            j -= 4096;
            if (j < 512) { rownorm<false>(P.mem, P.g_mem, (bf16_t*)(aux + O_MEMN), nullptr, j * 4 + (opaque_tid() >> 6)); continue; }
            j -= 512;
            if (j < 64) { rope_job((float*)(aux + O_ROPEC), (float*)(aux + O_ROPES), j); continue; }
            j -= 64;
            posbias_job(P, (float*)(aux + O_PB), j, hsm);
        }
    } else if (PH == 1) {
        { PEpiMemKV ep; ep.MK = (bf16_t*)(aux + O_MEMK); ep.MVT = (bf16_t*)(aux + O_MEMVT);
          RUN_PG8(PEpiMemKV, ep, (const bf16_t*)(aux + O_MEMN), 1024, (const bf16_t*)(aux + O_WTMKV), 1024, 2048, 512, 1024) }
        { PEpiZA ep; ep.ZA = ZA; ep.VST = (bf16_t*)(ws + W_VST); ep.VWT = (bf16_t*)(ws + W_VWT); ep.ropec = (const float*)(aux + O_ROPEC); ep.ropes = (const float*)(aux + O_ROPES);
          RUN_PG8(PEpiZA, ep, (const bf16_t*)(ws + W_U), 1024, (const bf16_t*)(aux + O_WTA), 1024, 16384, 5120, 1024) }
    } else if (PH == 2) {
        { PEpiHid ep; ep.HK = (bf16_t*)(aux + O_HIDK); ep.HV = (bf16_t*)(aux + O_HIDV); ep.pb = (const float*)(aux + O_PB);
          pg8::Gemm g_; g_.A = ZA; g_.Bt = (const bf16_t*)(aux + O_WTCK1); g_.M = 4096; g_.N = 512; g_.K = 2048; g_.lda = ZW; g_.ldb = 2048; g_.gather = 1;
          pg8::StaticOrder so_; so_.init(4096, 512, (int)gridDim.x, (int)blockIdx.x); __syncthreads();
          pg8::gemm_phase<PEpiHid, pg8::StaticOrder, true, true>((PG8_LAS unsigned char*)dyn_smem, g_, so_, ep); __syncthreads(); }
        for (int job = bid; job < 512; job += nb) {
            if (job < 256) rnn_job(P, 2 * job + sub, hsm, DRY);
            else xattn_job(P, 2 * (job - 256) + sub, hsm, DRY);
        }
    } else if (PH == 3) {
        for (int pj = bid; pj < 1016; pj += nb) cmp2_job(P, 2 * pj + sub);
    } else if (PH == 4) {
        for (int job = bid; job < 1024; job += nb) nsa_job(P, 2 * job + sub, hsm, DRY);
        if (!DRY) { PEpiBf<0> ep; ep.O = (bf16_t*)(ws + W_YX); ep.ldo = 1024;
          RUN_PG8(PEpiBf<0>, ep, ZA + C_QX, ZW, (const bf16_t*)(aux + O_WTXO), 256, 16384, 1024, 256) }
    } else if (PH == 5) {
        { PEpiMerge ep; ep.ZA = ZA; ep.YX = (const bf16_t*)(ws + W_YX); ep.Y = (bf16_t*)(ws + W_Y);
          RUN_PG8(PEpiMerge, ep, (const bf16_t*)(ws + W_U), 1024, (const bf16_t*)(aux + O_WTB), 1024, 16384, 4096, 1024) }
    } else if (PH == 6) {
        { PEpiRes ep; ep.R = P.x; ep.O = (float*)(ws + W_H);
          RUN_PG8(PEpiRes, ep, (const bf16_t*)(ws + W_Y), 1024, (const bf16_t*)(aux + O_WTO), 1024, 16384, 1024, 1024) }
    } else if (PH == 7) {
        for (int pj = bid; pj < 2048; pj += nb) rownorm<false>((const float*)(ws + W_H), P.g_mlp, (bf16_t*)(ws + W_VN), nullptr, (2 * pj + sub) * 4 + (opaque_tid() >> 6));
    } else if (PH == 8) {
        { PEpiBf<1> ep; ep.O = (bf16_t*)(ws + W_HID); ep.ldo = 4096;
          RUN_PG8(PEpiBf<1>, ep, (const bf16_t*)(ws + W_VN), 1024, (const bf16_t*)(aux + O_WTUP), 1024, 16384, 4096, 1024) }
    } else if (PH == 9) {
        { PEpiRes ep; ep.R = (const float*)(ws + W_H); ep.O = (float*)(ws + W_H);
          RUN_PG8(PEpiRes, ep, (const bf16_t*)(ws + W_HID), 4096, (const bf16_t*)(aux + O_WTDN), 4096, 16384, 1024, 4096) }
    } else if (PH == 10) {
        for (int pj = bid; pj < 2048; pj += nb) rownorm<true>((const float*)(ws + W_H), P.g_final, nullptr, P.out, (2 * pj + sub) * 4 + (opaque_tid() >> 6));
    }
}

__global__ void __launch_bounds__(512, 2) mega_kernel(Params P) {
    char* smem = dyn_smem;
    cg::grid_group grid = cg::this_grid();
    __shared__ uint4 xb_words;
    if (threadIdx.x == 0) xb_words = make_uint4(0u, 0u, 0u, 0u);
    __syncthreads();
    XcdBarrier xb = xcd_barrier_post((unsigned*)(P.ws + W_BAR), (volatile LAS unsigned*)&xb_words);
    if (P.ws == nullptr) grid.sync();
#ifndef REP
#define REP -1
#endif
#define GSYNC() xcd_barrier(xb)
#define PHASE(k) { if (REP == k && k != 9) { run_phase<k, true>(P, smem); GSYNC(); } run_phase<k>(P, smem); GSYNC(); }
    PHASE(0) PHASE(1) PHASE(2) PHASE(3) PHASE(4) PHASE(5) PHASE(6) PHASE(7) PHASE(8) PHASE(9)
    if (REP == 10) { run_phase<10>(P, smem); GSYNC(); }
    if (REP == 11) { GSYNC(); GSYNC(); GSYNC(); GSYNC(); GSYNC(); GSYNC(); GSYNC(); GSYNC(); GSYNC(); GSYNC(); }
    run_phase<10>(P, smem);
}

extern "C" void kernel_launch(void* const* d_in, const int* in_sizes, int n_in, void* d_out, int out_size, void* d_ws, size_t ws_size,
                              hipStream_t stream) {
    Params P{};
    const float** pp = (const float**)&P;
    for (int i = 0; i < 25; ++i) pp[i] = (const float*)d_in[i];
    P.out = (float*)d_out;
    P.ws = (char*)d_ws;
    static int grid_blocks = 0;
    if (!grid_blocks) {
        int dev = 0, cus = 0, per_cu = 0;
        hipGetDevice(&dev);
        hipDeviceGetAttribute(&cus, hipDeviceAttributeMultiprocessorCount, dev);
        hipFuncSetAttribute((const void*)mega_kernel, hipFuncAttributeMaxDynamicSharedMemorySize, SMEM_BYTES);
        hipOccupancyMaxActiveBlocksPerMultiprocessor(&per_cu, mega_kernel, 512, SMEM_BYTES);
        if (per_cu > 1) per_cu = 1;
        if (per_cu < 1) per_cu = 1;
        grid_blocks = cus * per_cu;
    }
    hipMemsetAsync((char*)d_ws + W_BAR, 0, XCD_BAR_WORDS * 4, stream);
    void* args[] = {&P};
    hipError_t e = hipLaunchCooperativeKernel((void*)mega_kernel, dim3(grid_blocks), dim3(512), args, SMEM_BYTES, stream);
    if (e != hipSuccess) fprintf(stderr, "cooperative launch failed: %s (grid %d)\n", hipGetErrorString(e), grid_blocks);
}
```

```cpp
#include <hip/hip_runtime.h>
#include <hip/hip_cooperative_groups.h>
#include <cstdint>
#include <cstdio>
namespace cg = cooperative_groups;

#ifndef MULTI
#define MULTI 0
#endif

typedef unsigned short bf16_t;
typedef short bf16x8 __attribute__((ext_vector_type(8)));
typedef float f32x4 __attribute__((ext_vector_type(4)));
typedef __bf16 bfv2 __attribute__((ext_vector_type(2)));
typedef float f32x2 __attribute__((ext_vector_type(2)));
typedef unsigned u32x4 __attribute__((ext_vector_type(4)));
typedef unsigned u32x2 __attribute__((ext_vector_type(2)));
#define DEV __device__ __forceinline__
DEV int opaque_tid() { int t = threadIdx.x & 255; asm volatile("" : "+v"(t)); return t; }
DEV int opaque_tid512() { int t = threadIdx.x; asm volatile("" : "+v"(t)); return t; }
#define MFMA16(a, b, c) __builtin_amdgcn_mfma_f32_16x16x32_bf16((a), (b), (c), 0, 0, 0)

constexpr int T = 16384, S = 2048;
constexpr int ZW = 4480;
constexpr int C_Q = 0, C_KC = 1024, C_VC = 1280, C_KS = 1536, C_KW = 1792, C_XR = 2048, C_GR = 3072, C_QX = 4096, C_G = 4352;
constexpr int NCMP = 127;
constexpr int NCROWS = 4064;

constexpr size_t O_WTA = 0;
constexpr size_t O_WTB = O_WTA + (size_t)5120 * 1024 * 2;
constexpr size_t O_WTUP = O_WTB + (size_t)4096 * 1024 * 2;
constexpr size_t O_WTDN = O_WTUP + (size_t)4096 * 1024 * 2;
constexpr size_t O_WTO = O_WTDN + (size_t)4096 * 1024 * 2;
constexpr size_t O_WTXO = O_WTO + (size_t)1024 * 1024 * 2;
constexpr size_t O_WTMKV = O_WTXO + (size_t)1024 * 256 * 2;
constexpr size_t O_WTCK1 = O_WTMKV + (size_t)512 * 1024 * 2;
constexpr size_t O_WTCV1 = O_WTCK1 + (size_t)256 * 2048 * 2;
constexpr size_t O_WAT = O_WTCV1 + (size_t)256 * 2048 * 2;
constexpr size_t O_WIT = O_WAT + (size_t)16 * 64 * 64 * 2;
constexpr size_t O_ROPEC = O_WIT + (size_t)16 * 64 * 64 * 2;
constexpr size_t O_ROPES = O_ROPEC + (size_t)2048 * 8 * 4;
constexpr size_t O_MEMN = O_ROPES + (size_t)2048 * 8 * 4;
constexpr size_t O_MEMK = O_MEMN + (size_t)2048 * 1024 * 2;
constexpr size_t O_MEMVT = O_MEMK + (size_t)2048 * 256 * 2;
constexpr size_t O_HIDK = O_MEMVT + (size_t)2048 * 256 * 2;
constexpr size_t O_HIDV = O_HIDK + (size_t)4096 * 256 * 2;
constexpr size_t O_KC = O_HIDV + (size_t)4096 * 256 * 2;
constexpr size_t O_VCT = O_KC + (size_t)32 * 128 * 64 * 2;
constexpr size_t O_PB = O_VCT + (size_t)32 * 64 * 128 * 2;
constexpr size_t O_AUX_END = O_PB + 16384;
static_assert(O_AUX_END <= (size_t)64 << 20, "aux overflow");
constexpr size_t MiB = (size_t)1 << 20;
constexpr size_t W_U = 0, W_ZA = 32 * MiB, W_VST = 172 * MiB, W_VWT = 180 * MiB, W_YX = 188 * MiB, W_Y = 220 * MiB;
constexpr size_t W_H = 32 * MiB, W_VN = 0, W_HID = 96 * MiB;

struct Params {
    const float *x, *mem, *g_mix, *w_in, *cpk, *cpv, *wk1, *wk2, *wv1, *wv2, *conv_w, *conv_b, *w_a, *b_a, *w_i, *b_i, *lam,
        *g_mem, *w_mkv, *w_xo, *w_o, *g_mlp, *w_up, *w_down, *g_final;
    float* out;
    char* ws;
};

DEV float bf2f(bf16_t h) { return __uint_as_float(((unsigned)h) << 16); }
DEV unsigned pk2(float lo, float hi) { f32x2 v = {lo, hi}; bfv2 b = __builtin_convertvector(v, bfv2); return __builtin_bit_cast(unsigned, b); }
DEV bf16_t f2bf(float f) { return (bf16_t)(pk2(f, 0.f) & 0xffffu); }
DEV float lo_f(unsigned u) { return __uint_as_float(u << 16); }
DEV float hi_f(unsigned u) { return __uint_as_float(u & 0xffff0000u); }
DEV float sigm(float x) { return __builtin_amdgcn_rcpf(1.f + __expf(-x)); }
DEV float gelu_t(float x) {
    float y = 0.7978845608028654f * (x + 0.044715f * x * x * x);
    float e = __expf(2.f * y);
    float th = 1.f - 2.f * __builtin_amdgcn_rcpf(1.f + e);
    return 0.5f * x * (1.f + th);
}
DEV float wave_sum(float v) {
#pragma unroll
    for (int o = 32; o >= 1; o >>= 1) v += __shfl_xor(v, o);
    return v;
}

DEV int map_col(int mapid, int r) {
    if (mapid == 0) return r;
    if (mapid == 1) {
        if (r < 1536) return r;
        if (r < 1792) return 1536 + (r - 1536);
        if (r < 2048) return 2048 + (r - 1792);
        if (r < 3072) return 2608 + (r - 2048);
        if (r < 4096) return 3632 + (r - 3072);
        if (r < 4352) return 4656 + (r - 4096);
        if (r < 4608) return 1792 + (r - 4352);
        if (r < 4864) return 2304 + (r - 4608);
        if (r < 4912) return 2560 + (r - 4864);
        return -1;
    }
    const int pn = r >> 8, rem = r & 255, bj = rem >> 7, wc = (rem >> 5) & 3, n = (rem >> 4) & 1, c16 = rem & 15, slot = 2 * bj + n;
    if (slot == 3) return -1;
    return 4912 + slot * 1024 + pn * 64 + wc * 16 + c16;
}

DEV void transpose_tile(const float* __restrict__ src, int ld, bf16_t* __restrict__ dst, int K, int r0, int k0, int mapid, char* smem, int nblk = 0) {
    float* sm = (float*)smem;
    const int tid = threadIdx.x & 255, lane = tid & 63, w = tid >> 6;
    __syncthreads();
    const int sc = map_col(mapid, r0 + lane);
#pragma unroll
    for (int i = 0; i < 16; ++i) {
        int kk = w + 4 * i;
        float v = sc >= 0 ? src[(size_t)(k0 + kk) * ld + sc] : 0.f;
        sm[kk * 65 + lane] = v;
    }
    __syncthreads();
    const int rr = tid >> 2, kq = (tid & 3) * 16;
    unsigned o[8];
#pragma unroll
    for (int e = 0; e < 8; ++e) o[e] = pk2(sm[(kq + 2 * e) * 65 + rr], sm[(kq + 2 * e + 1) * 65 + rr]);
    uint4* dp = nblk ? (uint4*)(dst + (size_t)(k0 >> 6) * nblk * 64 + (size_t)(r0 + rr) * 64 + kq) : (uint4*)(dst + (size_t)(r0 + rr) * K + k0 + kq);
    dp[0] = make_uint4(o[0], o[1], o[2], o[3]);
    dp[1] = make_uint4(o[4], o[5], o[6], o[7]);
}

template <bool OUTF32>
DEV void rownorm(const float* __restrict__ src, const float* __restrict__ g, bf16_t* dstb, float* dstf, int row, bool blk = false) {
    const int lane = opaque_tid() & 63;
    const float4* sp = (const float4*)(src + (size_t)row * 1024);
    float4 v[4];
    float ss = 0.f;
#pragma unroll
    for (int i = 0; i < 4; ++i) { v[i] = sp[lane + 64 * i]; ss += v[i].x * v[i].x + v[i].y * v[i].y + v[i].z * v[i].z + v[i].w * v[i].w; }
    ss = wave_sum(ss);
    const float r = rsqrtf(ss * (1.0f / 1024.0f) + 1e-6f);
#pragma unroll
    for (int i = 0; i < 4; ++i) {
        float4 gg = ((const float4*)g)[lane + 64 * i];
        float a = v[i].x * r * gg.x, b = v[i].y * r * gg.y, c = v[i].z * r * gg.z, d = v[i].w * r * gg.w;
        if (OUTF32) ((float4*)(dstf + (size_t)row * 1024))[lane + 64 * i] = make_float4(a, b, c, d);
        else if (blk) { const int col = 4 * (lane + 64 * i); *(uint2*)(dstb + (size_t)(col >> 6) * ((size_t)16384 * 64) + (size_t)row * 64 + (col & 63)) = make_uint2(pk2(a, b), pk2(c, d)); }
        else ((uint2*)(dstb + (size_t)row * 1024))[lane + 64 * i] = make_uint2(pk2(a, b), pk2(c, d));
    }
}

DEV void rope_job(float* ct, float* st, int job) {
    const int e = job * 256 + (threadIdx.x & 255);
    const int pos = e >> 3, i = e & 7;
    const double inv = exp(-(double)i * 0.125 * 13.122363377404328);
    const double ang = (double)pos * inv;
    const double kq = rint(ang * 0.6366197723675814);
    const double r = ang - kq * 1.5707963267948966;
    const double r2 = r * r;
    const double sn = r * (1.0 + r2 * (-1.0 / 6 + r2 * (1.0 / 120 + r2 * (-1.0 / 5040 + r2 * (1.0 / 362880 + r2 * (-1.0 / 39916800 + r2 * (1.0 / 6227020800.0)))))));
    const double cs = 1.0 + r2 * (-0.5 + r2 * (1.0 / 24 + r2 * (-1.0 / 720 + r2 * (1.0 / 40320 + r2 * (-1.0 / 3628800 + r2 * (1.0 / 479001600.0))))));
    const int q = ((int)kq) & 3;
    double s_, c_;
    if (q == 0) { s_ = sn; c_ = cs; } else if (q == 1) { s_ = cs; c_ = -sn; } else if (q == 2) { s_ = -sn; c_ = -cs; } else { s_ = -cs; c_ = sn; }
    ct[e] = (float)c_; st[e] = (float)s_;
}

DEV void posbias_job(const Params& P, float* PB, int job, char* smem) {
    float* sred = (float*)smem;
    const int tid = opaque_tid(), which = job >> 5, cgi = (job >> 3) & 3, kc = job & 7, c = cgi * 64 + (tid & 63), kp = tid >> 6;
    const float* pos = (which ? P.cpv : P.cpk) + kc * 256 + kp * 64;
    const float* w1 = (which ? P.wv1 : P.wk1) + (size_t)(kc * 256 + kp * 64) * 256 + c;
    float a0 = 0.f, a1 = 0.f, a2 = 0.f, a3 = 0.f;
#pragma unroll 4
    for (int k = 0; k < 64; k += 4) {
        a0 += pos[k] * w1[(size_t)k * 256]; a1 += pos[k + 1] * w1[(size_t)(k + 1) * 256];
        a2 += pos[k + 2] * w1[(size_t)(k + 2) * 256]; a3 += pos[k + 3] * w1[(size_t)(k + 3) * 256];
    }
    __syncthreads();
    sred[kp * 64 + (tid & 63)] = (a0 + a1) + (a2 + a3);
    __syncthreads();
    if (tid < 64) PB[(which * 8 + kc) * 256 + c] = (sred[tid] + sred[64 + tid]) + (sred[128 + tid] + sred[192 + tid]);
}

struct ALPlain {
    const bf16_t* A; int lda; int ks;
    const char* base; unsigned off0;
    DEV void init(int row0, int lrow, int lk) { base = (const char*)(A + (size_t)row0 * lda); off0 = (unsigned)(lrow * lda + lk) * 2u; }
    DEV u32x4 load(int i, int k0) const { return *(const u32x4*)(base + (off0 + (unsigned)(i * 128 * lda) + (unsigned)(k0 >> 6) * (unsigned)(ks * 2))); }
    DEV u32x4 fix(int, const u32x4& v, int) const { return v; }
};
struct ALCmp {
    const bf16_t* ZA; const float* spos; int colbase;
    unsigned roff[4]; int lk_;
    DEV void init(int row0, int lrow, int lk) {
        lk_ = lk;
#pragma unroll
        for (int i = 0; i < 4; ++i) {
            const int row = row0 + lrow + 64 * i;
            const int bg = row / NCMP, n = row - bg * NCMP, b = bg >> 2, g = bg & 3;
            roff[i] = row < NCROWS ? (unsigned)(((b * S + 16 * n) * ZW + colbase + g * 64 + lk) * 2) : 0xffffffffu;
        }
    }
    DEV u32x4 load(int i, int k0) const {
        if (roff[i] == 0xffffffffu) return (u32x4){0u, 0u, 0u, 0u};
        return *(const u32x4*)((const char*)ZA + (roff[i] + (unsigned)((k0 >> 6) * ZW * 2)));
    }
    DEV u32x4 fix(int i, const u32x4& v, int k0) const {
        if (roff[i] == 0xffffffffu) return v;
        const float4 p0 = *(const float4*)(spos + k0 + lk_), p1 = *(const float4*)(spos + k0 + lk_ + 4);
        u32x4 o;
        o.x = pk2(lo_f(v.x) + p0.x, hi_f(v.x) + p0.y); o.y = pk2(lo_f(v.y) + p0.z, hi_f(v.y) + p0.w);
        o.z = pk2(lo_f(v.z) + p1.x, hi_f(v.z) + p1.y); o.w = pk2(lo_f(v.w) + p1.z, hi_f(v.w) + p1.w);
        return o;
    }
};

template <int TM, int TN, bool SWAP, class AL, class EP>
DEV void gemm_tile(AL al, const bf16_t* __restrict__ Bt, int ldb, int bks, int K, int pm, int pn, const EP& ep, char* smem) {
    constexpr int BM = TM * 32, BN = TN * 64, NA = BM / 64, NBB = (BN + 63) / 64;
    bf16_t* sA = (bf16_t*)smem;
    bf16_t* sB = sA + BM * 72;
    const int tid = opaque_tid512(), wid = tid >> 6, lane = tid & 63, wr = wid >> 2, wc = wid & 3, fr = lane & 15, fq = lane >> 4;
    f32x4 acc[TM][TN];
#pragma unroll
    for (int m = 0; m < TM; ++m)
#pragma unroll
        for (int n = 0; n < TN; ++n) acc[m][n] = (f32x4){0.f, 0.f, 0.f, 0.f};
    const int lrow = tid >> 3, lk = (tid & 7) * 8;
    u32x4 ra[NA], rb[NBB];
    al.init(pm * BM, lrow, lk);
    const char* bbase = (const char*)(Bt + (size_t)(pn * BN) * ldb);
    const unsigned boff = (unsigned)(lrow * ldb + lk) * 2u;
#pragma unroll
    for (int i = 0; i < NBB; ++i) rb[i] = (u32x4){0u, 0u, 0u, 0u};
#pragma unroll
    for (int i = 0; i < NA; ++i) ra[i] = al.load(i, 0);
#pragma unroll
    for (int i = 0; i < NBB; ++i) if (BN % 64 == 0 || lrow + 64 * i < BN) rb[i] = *(const u32x4*)(bbase + (boff + (unsigned)(i * 128 * ldb)));
    int nk = K >> 6;
    asm volatile("" : "+s"(nk));
    bf16_t* sWa = sA + lrow * 72 + lk;
    bf16_t* sWb = sB + lrow * 72 + lk;
    const bf16_t* sAr = sA + (wr * TM * 16 + fr) * 72 + fq * 8;
    const bf16_t* sBr = sB + (wc * TN * 16 + fr) * 72 + fq * 8;
#pragma unroll 1
    for (int kt = 0; kt < nk; ++kt) {
        __syncthreads();
#pragma unroll
        for (int i = 0; i < NA; ++i) *(u32x4*)(sWa + (64 * i) * 72) = al.fix(i, ra[i], kt * 64);
#pragma unroll
        for (int i = 0; i < NBB; ++i) if (BN % 64 == 0 || lrow + 64 * i < BN) *(u32x4*)(sWb + (64 * i) * 72) = rb[i];
        __syncthreads();
        if (kt + 1 < nk) {
            const int k0 = (kt + 1) * 64;
#pragma unroll
            for (int i = 0; i < NA; ++i) ra[i] = al.load(i, k0);
#pragma unroll
            for (int i = 0; i < NBB; ++i) if (BN % 64 == 0 || lrow + 64 * i < BN) rb[i] = *(const u32x4*)(bbase + (boff + (unsigned)(i * 128 * ldb) + (unsigned)(k0 >> 6) * (unsigned)(bks * 2)));
        }
        __builtin_amdgcn_sched_barrier(0);
        __builtin_amdgcn_s_setprio(1);
#pragma unroll
        for (int ks = 0; ks < 2; ++ks) {
            bf16x8 bfr[TN];
#pragma unroll
            for (int n = 0; n < TN; ++n) bfr[n] = *(const bf16x8*)(sBr + (n * 16) * 72 + ks * 32);
#pragma unroll
            for (int m = 0; m < TM; ++m) {
                const bf16x8 af = *(const bf16x8*)(sAr + (m * 16) * 72 + ks * 32);
#pragma unroll
                for (int n = 0; n < TN; ++n) acc[m][n] = SWAP ? MFMA16(bfr[n], af, acc[m][n]) : MFMA16(af, bfr[n], acc[m][n]);
            }
        }
        __builtin_amdgcn_s_setprio(0);
    }
    ep.run(acc, pm * BM + wr * TM * 16, pn * BN + wc * TN * 16, fr, fq);
}

DEV uint2 pk4(const f32x4& a) { return make_uint2(pk2(a[0], a[1]), pk2(a[2], a[3])); }

namespace pg8 {
#define PG8_LAS __attribute__((address_space(3)))
typedef unsigned short bf16_t;
typedef short bf16x8 __attribute__((ext_vector_type(8)));
typedef float f32x4 __attribute__((ext_vector_type(4)));
typedef unsigned u32x4 __attribute__((ext_vector_type(4)));
constexpr int BM = 256, BK = 64, HALF = 128, HTB = HALF * BK * 2  , STAGE_BYTES = 8 * HTB, NXCD = 8, WGM = 8;

__host__ __device__ __forceinline__ int lds_byte(int r, int c) { const int st = (r >> 4) * 2 + (c >> 5), rr = r & 15, cc = c & 31, ob = rr * 64 + cc * 2; return st * 1024 + (ob ^ (((ob >> 9) & 1) << 5)); }
__host__ __device__ __forceinline__ void stage_rc(int b, int& R, int& C) { const int st = b / 1024, sb = b % 1024, swz = sb ^ (((sb >> 9) & 1) << 5); R = (st >> 1) * 16 + swz / 64; C = (st & 1) * 32 + (swz % 64) / 2; }
__host__ __device__ __forceinline__ int perm32(int rho) { const int n = rho >> 4, i = rho & 15; return 8 * (i >> 2) + 4 * n + (i & 3); }

struct Unit { int pm, pn; };
struct Gemm { const bf16_t* A; const bf16_t* Bt; int M, N, K, lda, ldb; int gather; };

struct StaticOrder {
    int nM, nN, nwg, G, c;
    __host__ __device__ void init(int M, int N, int G_, int c_) { nM = M / BM; nN = N / BM; nwg = nM * nN; G = G_; c = c_; }
    __host__ __device__ bool next(int i, Unit& u) const {
        const long L = (long)i * G + c; if (L >= nwg) return false;
        int wgid = (int)L; { const int q = nwg / NXCD, r = nwg % NXCD, xcd = wgid % NXCD, off = wgid / NXCD; wgid = (xcd < r ? xcd * (q + 1) : r * (q + 1) + (xcd - r) * q) + off; }
        const int nig = WGM * nN, gid = wgid / nig, fm = gid * WGM, gsz = (nM - fm) < WGM ? (nM - fm) : WGM;
        u.pm = fm + ((wgid % nig) % gsz); u.pn = (wgid % nig) / gsz; return true;
    }
    __device__ __forceinline__ void a_ready(const Unit&) const {}
    __device__ __forceinline__ void done(const Unit&) const {}
};

template <class Epi, class Sched, bool ALIGN_EPI = false, bool SP2 = false>
__device__ __forceinline__ void gemm_phase(PG8_LAS unsigned char* lds, const Gemm g, const Sched& S, const Epi& E) {
    const int tid = opaque_tid512(), wid = __builtin_amdgcn_readfirstlane(tid >> 6), lane = tid & 63, wr = wid >> 2, wc = wid & 3, fr = lane & 15, fq = lane >> 4;
    const int K = g.K, nt = K / BK;
    unsigned voffA2[2][2], voffB[2];
#pragma unroll
    for (int i = 0; i < 2; ++i) { int R, C; stage_rc(tid * 16 + i * 8192, R, C); const int Rb = Epi::PERM ? ((R & ~31) + perm32(R & 31)) : R;
        voffA2[0][i] = (unsigned)(R * g.lda + C) * 2u; voffA2[1][i] = voffA2[0][i]; voffB[i] = (unsigned)(Rb * g.ldb + C) * 2u; }
    const size_t kstepB = (size_t)(BK * 2), kstepA = g.gather ? (size_t)(ZW * 2) : kstepB;
    const size_t hstepA = g.gather ? (size_t)0 : (size_t)HALF * g.lda * 2, hstepB = (size_t)HALF * g.ldb * 2;
    const size_t tstepA = 2 * hstepA, tstepB = 2 * hstepB;
    const unsigned ldsw = (unsigned)wid * 1024u;
    const int aoff = lds_byte(wr * 64 + fr, fq * 8), boff = lds_byte(wc * 32 + fr, fq * 8);
#define PG8_SA(b, h) (((b) * 2 + (h)) * HTB)
#define PG8_SB(b, h) ((4 + (b) * 2 + (h)) * HTB)
#define PG8_STAGE(bufoff, gbase, voff) do { _Pragma("unroll") for (int _i = 0; _i < 2; ++_i) \
        __builtin_amdgcn_global_load_lds((const unsigned*)((const char*)(gbase) + (voff)[_i]), (PG8_LAS unsigned*)(lds + (bufoff) + ldsw + _i * 8192), 16, 0, 0); } while (0)
#define PG8_LDA(dst, b, h) do { _Pragma("unroll") for (int m = 0; m < 4; ++m) _Pragma("unroll") for (int k = 0; k < 2; ++k) dst[m][k] = *(const PG8_LAS bf16x8*)(lds + PG8_SA(b, h) + aoff + m * 2048 + k * 1024); } while (0)
#define PG8_LDB(dst, b, h) do { _Pragma("unroll") for (int n = 0; n < 2; ++n) _Pragma("unroll") for (int k = 0; k < 2; ++k) dst[n][k] = *(const PG8_LAS bf16x8*)(lds + PG8_SB(b, h) + boff + n * 2048 + k * 1024); } while (0)
#define PG8_MMA(ai, bj, At, Bt) do { __builtin_amdgcn_s_setprio(1); _Pragma("unroll") for (int m = 0; m < 4; ++m) _Pragma("unroll") for (int n = 0; n < 2; ++n) _Pragma("unroll") for (int k = 0; k < 2; ++k) \
        acc[ai][bj][m][n] = __builtin_amdgcn_mfma_f32_16x16x32_bf16(Bt[n][k], At[m][k], acc[ai][bj][m][n], 0, 0, 0); __builtin_amdgcn_s_setprio(0); } while (0)
#define PG8_WAIT_V(n) asm volatile("s_waitcnt vmcnt(" #n ")" ::: "memory")
#define PG8_WAIT_L(n) asm volatile("s_waitcnt lgkmcnt(" #n ")" ::: "memory")
#define PG8_BAR __builtin_amdgcn_s_barrier()
#define PG8_SCHED __builtin_amdgcn_sched_barrier(0)
    Unit cur, nxt; int ui = 0;
    if (!S.next(0, cur)) return;
    f32x4 acc[2][2][4][2];
#pragma unroll
    for (int a = 0; a < 2; ++a)
#pragma unroll
        for (int b = 0; b < 2; ++b)
#pragma unroll
            for (int m = 0; m < 4; ++m)
#pragma unroll
                for (int n = 0; n < 2; ++n) acc[a][b][m][n] = (f32x4){0.f, 0.f, 0.f, 0.f};
    bf16x8 At[4][2], B0[2][2], B1[2][2];
    const char* cA = (const char*)g.A + (g.gather ? (size_t)0 : (size_t)cur.pm * tstepA); const char* cB = (const char*)g.Bt + (size_t)cur.pn * tstepB;
    if (g.gather) {
#pragma unroll
        for (int h = 0; h < 2; ++h)
#pragma unroll
            for (int i = 0; i < 2; ++i) { int R, C; stage_rc(tid * 16 + i * 8192, R, C);
                int r = cur.pm * 256 + h * HALF + R; r = r < NCROWS ? r : NCROWS - 1;
                const int bg = r / NCMP, n = r - bg * NCMP;
                voffA2[h][i] = (unsigned)((((bg >> 2) * ::S + 16 * n) * ZW + (cur.pn ? C_VC : C_KC) + (bg & 3) * 64 + C) * 2); }
    }
    S.a_ready(cur);
    if constexpr (SP2) {
        PG8_STAGE(PG8_SB(0, 0), cB, voffB); PG8_STAGE(PG8_SB(0, 1), cB + hstepB, voffB); PG8_STAGE(PG8_SA(0, 0), cA, voffA2[0]); PG8_STAGE(PG8_SA(0, 1), cA + hstepA, voffA2[1]);
        if (wr == 1) PG8_BAR;
        PG8_WAIT_V(2); PG8_BAR;
        PG8_STAGE(PG8_SB(1, 0), cB + kstepB, voffB); PG8_STAGE(PG8_SA(1, 0), cA + kstepA, voffA2[0]); PG8_STAGE(PG8_SB(1, 1), cB + hstepB + kstepB, voffB);
        PG8_WAIT_V(6); PG8_BAR;
    } else {
        PG8_STAGE(PG8_SB(0, 0), cB, voffB); PG8_STAGE(PG8_SA(0, 0), cA, voffA2[0]); PG8_STAGE(PG8_SB(0, 1), cB + hstepB, voffB); PG8_STAGE(PG8_SA(0, 1), cA + hstepA, voffA2[1]);
        if (wr == 1) PG8_BAR;
        PG8_WAIT_V(4); PG8_BAR;
        PG8_STAGE(PG8_SB(1, 0), cB + kstepB, voffB); PG8_STAGE(PG8_SA(1, 0), cA + kstepA, voffA2[0]); PG8_STAGE(PG8_SB(1, 1), cB + hstepB + kstepB, voffB);
        PG8_WAIT_V(6); PG8_BAR;
    }
    for (;;) {
        const bool has_next = S.next(ui + 1, nxt);
        const char* nA = has_next ? (const char*)g.A + (size_t)nxt.pm * tstepA : cA; const char* nB = has_next ? (const char*)g.Bt + (size_t)nxt.pn * tstepB : cB;
        for (int t = 0; t < nt; t += 2) {
            const bool last = (t == nt - 2);
            const char* a1 = cA + (size_t)(t + 1) * kstepA;
            const char* a2 = last ? nA : cA + (size_t)(t + 2) * kstepA; const char* b2 = last ? nB : cB + (size_t)(t + 2) * kstepB;
            const char* a3 = a2 + kstepA; const char* b3 = b2 + kstepB;
            if (last && has_next) S.a_ready(nxt);
            if constexpr (SP2) {
            PG8_LDB(B0, 0, 0); PG8_LDB(B1, 0, 1); PG8_SCHED; PG8_LDA(At, 0, 0); PG8_STAGE(PG8_SA(1, 1), a1 + hstepA, voffA2[1]);
            PG8_WAIT_V(8); PG8_WAIT_L(0); PG8_BAR; PG8_MMA(0, 0, At, B0); PG8_MMA(0, 1, At, B1); PG8_BAR; PG8_SCHED;
            PG8_LDA(At, 0, 1); PG8_STAGE(PG8_SB(0, 0), b2, voffB); PG8_STAGE(PG8_SB(0, 1), b2 + hstepB, voffB); PG8_STAGE(PG8_SA(0, 0), a2, voffA2[0]);
            PG8_WAIT_V(8); PG8_WAIT_L(0); PG8_BAR; PG8_MMA(1, 0, At, B0); PG8_MMA(1, 1, At, B1); PG8_BAR; PG8_SCHED;
            PG8_LDB(B0, 1, 0); PG8_LDB(B1, 1, 1); PG8_SCHED; PG8_LDA(At, 1, 0); PG8_STAGE(PG8_SA(0, 1), a2 + hstepA, voffA2[1]);
            PG8_WAIT_V(8); PG8_WAIT_L(0); PG8_BAR; PG8_MMA(0, 0, At, B0); PG8_MMA(0, 1, At, B1); PG8_BAR; PG8_SCHED;
            PG8_LDA(At, 1, 1); PG8_STAGE(PG8_SB(1, 0), b3, voffB); PG8_STAGE(PG8_SB(1, 1), b3 + hstepB, voffB); PG8_STAGE(PG8_SA(1, 0), a3, voffA2[0]);
            PG8_WAIT_V(8); PG8_WAIT_L(0); PG8_BAR; PG8_MMA(1, 0, At, B0); PG8_MMA(1, 1, At, B1); PG8_BAR; PG8_SCHED;
            } else {
            PG8_LDB(B0, 0, 0); PG8_SCHED; PG8_LDA(At, 0, 0); PG8_STAGE(PG8_SA(1, 1), a1 + hstepA, voffA2[1]);
            PG8_WAIT_L(8); PG8_BAR; PG8_WAIT_L(0); PG8_MMA(0, 0, At, B0); PG8_BAR; PG8_SCHED;
            PG8_LDB(B1, 0, 1); PG8_STAGE(PG8_SB(0, 0), b2, voffB);
            PG8_BAR; PG8_WAIT_L(0); PG8_MMA(0, 1, At, B1); PG8_BAR;
            PG8_LDA(At, 0, 1); PG8_STAGE(PG8_SA(0, 0), a2, voffA2[0]);
            PG8_BAR; PG8_WAIT_L(0); PG8_MMA(1, 0, At, B0); PG8_BAR; PG8_SCHED;
            PG8_STAGE(PG8_SB(0, 1), b2 + hstepB, voffB);
            PG8_WAIT_V(6); PG8_BAR; PG8_MMA(1, 1, At, B1); PG8_BAR;
            PG8_LDB(B0, 1, 0); PG8_SCHED; PG8_LDA(At, 1, 0); PG8_STAGE(PG8_SA(0, 1), a2 + hstepA, voffA2[1]);
            PG8_WAIT_L(8); PG8_BAR; PG8_WAIT_L(0); PG8_MMA(0, 0, At, B0); PG8_BAR; PG8_SCHED;
            PG8_LDB(B1, 1, 1); PG8_STAGE(PG8_SB(1, 0), b3, voffB);
            PG8_BAR; PG8_WAIT_L(0); PG8_MMA(0, 1, At, B1); PG8_BAR;
            PG8_LDA(At, 1, 1); PG8_STAGE(PG8_SA(1, 0), a3, voffA2[0]);
            PG8_BAR; PG8_WAIT_L(0); PG8_MMA(1, 0, At, B0); PG8_BAR; PG8_SCHED;
            PG8_STAGE(PG8_SB(1, 1), b3 + hstepB, voffB);
            PG8_WAIT_V(6); PG8_BAR; PG8_MMA(1, 1, At, B1); PG8_BAR;
            }
        }
        if constexpr (ALIGN_EPI) { if (wr == 0) PG8_BAR; }
        if constexpr (!Epi::AFTER_DRAIN) { E(acc, cur, wr, wc, fr, fq); S.done(cur); }
        if (!has_next) break;
#pragma unroll
        for (int a = 0; a < 2; ++a)
#pragma unroll
            for (int b = 0; b < 2; ++b)
#pragma unroll
                for (int m = 0; m < 4; ++m)
#pragma unroll
                    for (int n = 0; n < 2; ++n) acc[a][b][m][n] = (f32x4){0.f, 0.f, 0.f, 0.f};
        cur = nxt; cA = nA; cB = nB; ++ui;
        if constexpr (ALIGN_EPI) { if (wr == 1) PG8_BAR; }
    }
    PG8_WAIT_V(0);
    if constexpr (!ALIGN_EPI) { if (wr == 0) PG8_BAR; }
    PG8_BAR;
    if constexpr (Epi::AFTER_DRAIN) { E.fused(acc, cur, wr, wc, fr, fq, lds, wid, lane); S.done(cur); }
#undef PG8_SA
#undef PG8_SB
#undef PG8_STAGE
#undef PG8_LDA
#undef PG8_LDB
#undef PG8_MMA
#undef PG8_WAIT_V
#undef PG8_WAIT_L
#undef PG8_BAR
#undef PG8_SCHED
}
}

struct EpiHid {
    bf16_t* H;
    DEV void run(f32x4 (&acc)[8][4], int R0, int C0, int fr, int fq) const {
#pragma unroll
        for (int n = 0; n < 4; ++n)
#pragma unroll
            for (int m = 0; m < 8; ++m) {
                const int c = C0 + n * 16 + 4 * fq, r = R0 + m * 16 + fr;
                f32x4 a = acc[m][n];
#pragma unroll
                for (int j = 0; j < 4; ++j) a[j] = gelu_t(a[j]);
                if (r < NCROWS) *(uint2*)(H + (size_t)r * 256 + c) = pk4(a);
            }
    }
};
#define PG8_EPI_HEAD static constexpr bool PERM = false, AFTER_DRAIN = false;
#define PG8_FOR_TILES _Pragma("unroll") for (int ai = 0; ai < 2; ++ai) _Pragma("unroll") for (int bj = 0; bj < 2; ++bj) _Pragma("unroll") for (int m = 0; m < 4; ++m) _Pragma("unroll") for (int n = 0; n < 2; ++n)
struct PEpiZA {
    PG8_EPI_HEAD
    bf16_t *ZA, *VST, *VWT; const float *ropec, *ropes;
    DEV void operator()(const f32x4 (&acc)[2][2][4][2], const pg8::Unit& u, int wr, int wc, int fr, int fq) const {
        asm volatile("" : "+v"(fr), "+v"(fq));
        PG8_FOR_TILES {
            const int row = u.pm * 256 + ai * 128 + wr * 64 + m * 16 + fr, col0 = u.pn * 256 + bj * 128 + wc * 32 + n * 16;
            f32x4 a = acc[ai][bj][m][n];
            if (u.pn == 17 || u.pn == 18) {
                bf16_t* dst = (u.pn == 17) ? VST : VWT;
                const int c = (col0 & 255) + 4 * fq, b = row >> 11, t = row & 2047;
#pragma unroll
                for (int j = 0; j < 4; ++j) { const int cc = c + j; dst[((size_t)((b * 4 + (cc >> 6)) * 64 + (cc & 63))) * S + t] = f2bf(a[j]); }
            } else {
                const bool rope = (col0 < 1024 || (col0 >= 1536 && col0 < 2048)) && ((col0 & 63) == 0);
                if (rope) {
                    const int t = row & 2047, i0 = 4 * (fq & 1);
                    const float4 cs = *(const float4*)(ropec + t * 8 + i0), sn = *(const float4*)(ropes + t * 8 + i0);
                    const float c4[4] = {cs.x, cs.y, cs.z, cs.w}, s4[4] = {sn.x, sn.y, sn.z, sn.w};
#pragma unroll
                    for (int j = 0; j < 4; ++j) {
                        const float pr = __shfl_xor(a[j], 32);
                        a[j] = (fq & 2) ? (a[j] * c4[j] + pr * s4[j]) : (a[j] * c4[j] - pr * s4[j]);
                    }
                }
                int zc0 = col0;
                if (col0 >= 4864) {
                    zc0 = col0 - 512;
#pragma unroll
                    for (int j = 0; j < 4; ++j) a[j] = sigm(a[j]);
                }
                if (zc0 < ZW) *(uint2*)(ZA + (size_t)row * ZW + zc0 + 4 * fq) = pk4(a);
            }
        }
    }
};
struct PEpiHid {
    PG8_EPI_HEAD
    bf16_t *HK, *HV; const float* pb;
    DEV void operator()(const f32x4 (&acc)[2][2][4][2], const pg8::Unit& u, int wr, int wc, int fr, int fq) const {
        asm volatile("" : "+v"(fr), "+v"(fq));
        bf16_t* H = u.pn ? HV : HK;
        PG8_FOR_TILES {
            const int r = u.pm * 256 + ai * 128 + wr * 64 + m * 16 + fr, c = bj * 128 + wc * 32 + n * 16 + 4 * fq;
            float4 bb = *(const float4*)(pb + (u.pn * 8) * 256 + c);
#pragma unroll
            for (int kc = 1; kc < 8; ++kc) { const float4 t4 = *(const float4*)(pb + (u.pn * 8 + kc) * 256 + c); bb.x += t4.x; bb.y += t4.y; bb.z += t4.z; bb.w += t4.w; }
            f32x4 a = acc[ai][bj][m][n];
            a[0] = gelu_t(a[0] + bb.x); a[1] = gelu_t(a[1] + bb.y); a[2] = gelu_t(a[2] + bb.z); a[3] = gelu_t(a[3] + bb.w);
            if (r < NCROWS) *(uint2*)(H + (size_t)r * 256 + c) = pk4(a);
        }
    }
};
struct PEpiMemKV {
    PG8_EPI_HEAD
    bf16_t *MK, *MVT;
    DEV void operator()(const f32x4 (&acc)[2][2][4][2], const pg8::Unit& u, int wr, int wc, int fr, int fq) const {
        asm volatile("" : "+v"(fr), "+v"(fq));
        PG8_FOR_TILES {
            const int r = u.pm * 256 + ai * 128 + wr * 64 + m * 16 + fr, c = u.pn * 256 + bj * 128 + wc * 32 + n * 16 + 4 * fq;
            const int b = r >> 8, mm = r & 255;
            const f32x4 a = acc[ai][bj][m][n];
            if (u.pn == 0) { const int h = (c >> 6) & 3, d = c & 63; *(uint2*)(MK + ((size_t)(b * 4 + h) * 256 + mm) * 64 + d) = pk4(a); }
            else {
#pragma unroll
                for (int j = 0; j < 4; ++j) { const int cc = c + j, h = (cc >> 6) & 3, d = cc & 63; MVT[((size_t)(b * 4 + h) * 64 + d) * 256 + mm] = f2bf(a[j]); }
            }
        }
    }
};
template <int ACT>
struct PEpiBf {
    PG8_EPI_HEAD
    bf16_t* O; int ldo;
    DEV void operator()(const f32x4 (&acc)[2][2][4][2], const pg8::Unit& u, int wr, int wc, int fr, int fq) const {
        asm volatile("" : "+v"(fr), "+v"(fq));
        PG8_FOR_TILES {
            const int r = u.pm * 256 + ai * 128 + wr * 64 + m * 16 + fr, c = u.pn * 256 + bj * 128 + wc * 32 + n * 16 + 4 * fq;
            f32x4 a = acc[ai][bj][m][n];
            if (ACT == 1) {
#pragma unroll
                for (int j = 0; j < 4; ++j) { const float v = fmaxf(a[j], 0.f); a[j] = v * v; }
            }
            *(uint2*)(O + (size_t)r * ldo + c) = pk4(a);
        }
    }
};
struct PEpiRes {
    PG8_EPI_HEAD
    const float* R; float* O;
    DEV void operator()(const f32x4 (&acc)[2][2][4][2], const pg8::Unit& u, int wr, int wc, int fr, int fq) const {
        asm volatile("" : "+v"(fr), "+v"(fq));
        PG8_FOR_TILES {
            const size_t o = (size_t)(u.pm * 256 + ai * 128 + wr * 64 + m * 16 + fr) * 1024 + u.pn * 256 + bj * 128 + wc * 32 + n * 16 + 4 * fq;
            const f32x4 r = *(const f32x4*)(R + o);
            *(f32x4*)(O + o) = r + acc[ai][bj][m][n];
        }
    }
};
struct PEpiMerge {
    PG8_EPI_HEAD
    const bf16_t *ZA, *YX; bf16_t* Y;
    DEV void operator()(const f32x4 (&acc)[2][2][4][2], const pg8::Unit& u, int wr, int wc, int fr, int fq) const {
        asm volatile("" : "+v"(fr), "+v"(fq));
        const int ch = u.pn * 64 + wc * 16 + 4 * fq;
#pragma unroll
        for (int ai = 0; ai < 2; ++ai)
#pragma unroll
            for (int m = 0; m < 4; ++m) {
                const size_t row = (size_t)(u.pm * 256 + ai * 128 + wr * 64 + m * 16 + fr);
                const uint2 a = *(const uint2*)(ZA + row * ZW + C_Q + ch), b = *(const uint2*)(ZA + row * ZW + C_GR + ch), c = *(const uint2*)(YX + row * 1024 + ch);
                const f32x4 g0 = acc[ai][0][m][0], g1 = acc[ai][0][m][1], g2 = acc[ai][1][m][0];
                f32x4 y;
                y[0] = sigm(g0[0]) * lo_f(a.x) + sigm(g1[0]) * lo_f(b.x) + sigm(g2[0]) * lo_f(c.x);
                y[1] = sigm(g0[1]) * hi_f(a.x) + sigm(g1[1]) * hi_f(b.x) + sigm(g2[1]) * hi_f(c.x);
                y[2] = sigm(g0[2]) * lo_f(a.y) + sigm(g1[2]) * lo_f(b.y) + sigm(g2[2]) * lo_f(c.y);
                y[3] = sigm(g0[3]) * hi_f(a.y) + sigm(g1[3]) * hi_f(b.y) + sigm(g2[3]) * hi_f(c.y);
                *(uint2*)(Y + row * 1024 + ch) = pk4(y);
            }
    }
};

DEV bool tile_map(int idx, int NT, int& pm, int& pn) {
    const int x = idx & 7, pl = (idx >> 3) & 3, pmid = (idx >> 5) & 7, st = idx >> 8;
    pm = pmid * 8 + x;
    pn = st * 4 + pl;
    return pn < NT;
}
DEV int tile_count(int NT) { return ((NT + 3) / 4) * 256; }

DEV void cmp2_job(const Params& P, int job) {
    char* aux = (char*)P.out;
    const int lane = threadIdx.x & 63, w = (threadIdx.x & 255) >> 6;
    const int wj = job * 4 + w;
    const int which = wj >= NCROWS ? 1 : 0;
    const int r = wj - which * NCROWS;
    const int bg = r / NCMP, n = r - bg * NCMP;
    const bf16_t* hid = (const bf16_t*)(aux + (which ? O_HIDV : O_HIDK)) + (size_t)r * 256;
    const float* w2 = which ? P.wv2 : P.wk2;
    float acc = 0.f;
#pragma unroll 8
    for (int k = 0; k < 256; ++k) acc += bf2f(hid[k]) * w2[k * 64 + lane];
    if (!which) {
        const int pos = 16 * n + 31, i = lane & 7;
        const float cs = ((const float*)(aux + O_ROPEC))[pos * 8 + i], sn = ((const float*)(aux + O_ROPES))[pos * 8 + i];
        const float pr = __shfl_xor(acc, 8);
        float o = acc;
        if (lane < 16) o = (lane & 8) ? (acc * cs + pr * sn) : (acc * cs - pr * sn);
        bf16_t* KC = (bf16_t*)(aux + O_KC);
        KC[((size_t)bg * 128 + n) * 64 + lane] = f2bf(o);
        if (n == NCMP - 1) KC[((size_t)bg * 128 + 127) * 64 + lane] = 0;
    } else {
        bf16_t* VCT = (bf16_t*)(aux + O_VCT);
        VCT[((size_t)bg * 64 + lane) * 128 + n] = f2bf(acc);
        if (n == NCMP - 1) VCT[((size_t)bg * 64 + lane) * 128 + 127] = 0;
    }
}

DEV void rnn_job(const Params& P, int job, char* smem, bool dry) {
    char* aux = (char*)P.out;
    bf16_t* ZA = (bf16_t*)(P.ws + W_ZA);
    const int b = job >> 6, n = (job >> 2) & 15, ct = job & 3;
    bf16_t* sX = (bf16_t*)smem;
    float* sXf = (float*)(smem + 9216);
    float* sCw = (float*)(smem + 9216 + 16640);
    float* sSum = (float*)(smem + 9216 + 16640 + 1280);
    bf16_t* sRaw = (bf16_t*)(smem + 9216 + 16640 + 1280 + 2048);
    const int tid = opaque_tid(), w = tid >> 6, lane = tid & 63, fr = lane & 15, fq = lane >> 4;
    const bf16_t* WAT = (const bf16_t*)(aux + O_WAT) + n * 4096;
    const bf16_t* WIT = (const bf16_t*)(aux + O_WIT) + n * 4096;
    bf16x8 wa[2], wi[2];
#pragma unroll
    for (int ks = 0; ks < 2; ++ks) {
        wa[ks] = *(const bf16x8*)(WAT + (16 * ct + fr) * 64 + 32 * ks + 8 * fq);
        wi[ks] = *(const bf16x8*)(WIT + (16 * ct + fr) * 64 + 32 * ks + 8 * fq);
    }
    const int c = n * 64 + 16 * ct + fr;
    const float ba = P.b_a[c], bi = P.b_i[c], cl = -8.0f * log1pf(__expf(-P.lam[c]));
    float carry = 0.f;
    __syncthreads();
    for (int i = tid; i < 320; i += 256) sCw[i] = (i < 256) ? P.conv_w[(i >> 6) * 1024 + n * 64 + (i & 63)] : P.conv_b[n * 64 + (i & 63)];
    const int lt = tid >> 2, cg = (tid & 3) * 16;
    const bf16_t* xbase = ZA + (size_t)(b * S) * ZW + C_XR + n * 64 + cg;
    bf16_t* sRaw2 = sRaw + 67 * 72;
    u32x4 xm0, xm1, xh0 = {0u, 0u, 0u, 0u}, xh1 = {0u, 0u, 0u, 0u};
    { const u32x4* xp = (const u32x4*)(xbase + (size_t)lt * ZW); xm0 = xp[0]; xm1 = xp[1]; }
    *(u32x4*)(sRaw + (lt + 3) * 72 + cg) = xm0; *(u32x4*)(sRaw + (lt + 3) * 72 + cg + 8) = xm1;
    if (tid < 12) { *(u32x4*)(sRaw + lt * 72 + cg) = xh0; *(u32x4*)(sRaw + lt * 72 + cg + 8) = xh1; }
    { const u32x4* xp = (const u32x4*)(xbase + (size_t)(64 + lt) * ZW); xm0 = xp[0]; xm1 = xp[1];
      if (tid < 12) { const u32x4* hp = (const u32x4*)(xbase + (size_t)(61 + lt) * ZW); xh0 = hp[0]; xh1 = hp[1]; } }
    __syncthreads();
#pragma unroll 1
    for (int chunk = 0; chunk < 32; ++chunk) {
        const int tc = chunk * 64;
        const bf16_t* rawc = (chunk & 1) ? sRaw2 : sRaw;
        bf16_t* rawn = (chunk & 1) ? sRaw : sRaw2;
        bf16_t gv[4];
#pragma unroll
        for (int j = 0; j < 4; ++j) gv[j] = ZA[(size_t)(b * S + tc + 16 * w + 4 * fq + j) * ZW + C_GR + n * 64 + 16 * ct + fr];
        {
            float xv[16];
#pragma unroll
            for (int e4 = 0; e4 < 4; ++e4) { const float4 bb = *(const float4*)(sCw + 256 + cg + 4 * e4); xv[4 * e4] = bb.x; xv[4 * e4 + 1] = bb.y; xv[4 * e4 + 2] = bb.z; xv[4 * e4 + 3] = bb.w; }
#pragma unroll
            for (int k = 0; k < 4; ++k) {
                const u32x4 v0 = *(const u32x4*)(rawc + (lt + k) * 72 + cg), v1 = *(const u32x4*)(rawc + (lt + k) * 72 + cg + 8);
                const unsigned u[8] = {v0.x, v0.y, v0.z, v0.w, v1.x, v1.y, v1.z, v1.w};
#pragma unroll
                for (int e4 = 0; e4 < 4; ++e4) {
                    const float4 wv = *(const float4*)(sCw + k * 64 + cg + 4 * e4);
                    xv[4 * e4] += wv.x * lo_f(u[2 * e4]);
                    xv[4 * e4 + 1] += wv.y * hi_f(u[2 * e4]);
                    xv[4 * e4 + 2] += wv.z * lo_f(u[2 * e4 + 1]);
                    xv[4 * e4 + 3] += wv.w * hi_f(u[2 * e4 + 1]);
                }
            }
            if ((tid & 3) == ct) {
#pragma unroll
                for (int e = 0; e < 16; ++e) sXf[lt * 17 + e] = xv[e];
            }
            u32x4 o0 = {pk2(xv[0], xv[1]), pk2(xv[2], xv[3]), pk2(xv[4], xv[5]), pk2(xv[6], xv[7])};
            u32x4 o1 = {pk2(xv[8], xv[9]), pk2(xv[10], xv[11]), pk2(xv[12], xv[13]), pk2(xv[14], xv[15])};
            *(u32x4*)(sX + lt * 72 + cg) = o0;
            *(u32x4*)(sX + lt * 72 + cg + 8) = o1;
        }
        __syncthreads();
        f32x4 R = (f32x4){0.f, 0.f, 0.f, 0.f}, I = (f32x4){0.f, 0.f, 0.f, 0.f};
#pragma unroll
        for (int ks = 0; ks < 2; ++ks) {
            const bf16x8 af = *(const bf16x8*)(sX + (16 * w + fr) * 72 + 32 * ks + 8 * fq);
            R = MFMA16(af, wa[ks], R); I = MFMA16(af, wi[ks], I);
        }
        if (chunk + 1 < 32) {
            *(u32x4*)(rawn + (lt + 3) * 72 + cg) = xm0; *(u32x4*)(rawn + (lt + 3) * 72 + cg + 8) = xm1;
            if (tid < 12) { *(u32x4*)(rawn + lt * 72 + cg) = xh0; *(u32x4*)(rawn + lt * 72 + cg + 8) = xh1; }
        }
        float hl[4], pc[4];
        float h = 0.f, pcum = 1.f;
#pragma unroll
        for (int j = 0; j < 4; ++j) {
            const float xcv = sXf[(16 * w + 4 * fq + j) * 17 + fr];
            const float rg = sigm(R[j] + ba), gi = sigm(I[j] + bi);
            const float la = rg * cl;
            const float a_ = __expf(la);
            const float mult = sqrtf(fmaxf(1.f - a_ * a_, 0.f));
            const float u = mult * gi * xcv;
            h = a_ * h + u; pcum *= a_;
            hl[j] = h; pc[j] = pcum;
        }
        float A = pcum, H = h;
        float A1 = __shfl_up(A, 16), H1 = __shfl_up(H, 16);
        if (fq >= 1) { H = A * H1 + H; A = A * A1; }
        float A2 = __shfl_up(A, 32), H2 = __shfl_up(H, 32);
        if (fq >= 2) { H = A * H2 + H; A = A * A2; }
        float Ax = __shfl_up(A, 16), Hx = __shfl_up(H, 16);
        const float Ae = fq == 0 ? 1.f : Ax, He = fq == 0 ? 0.f : Hx;
        if (fq == 3) { sSum[w * 16 + fr] = A; sSum[64 + w * 16 + fr] = H; }
        __syncthreads();
        if (chunk + 2 < 32) {
            const u32x4* xp = (const u32x4*)(xbase + (size_t)(tc + 128 + lt) * ZW); xm0 = xp[0]; xm1 = xp[1];
            if (tid < 12) { const u32x4* hp = (const u32x4*)(xbase + (size_t)(tc + 125 + lt) * ZW); xh0 = hp[0]; xh1 = hp[1]; }
        }
        float cin = carry, mycin = 0.f;
#pragma unroll
        for (int ww = 0; ww < 4; ++ww) {
            if (ww == w) mycin = cin;
            cin = sSum[ww * 16 + fr] * cin + sSum[64 + ww * 16 + fr];
        }
        carry = cin;
        const float sq = Ae * mycin + He;
#pragma unroll
        for (int j = 0; j < 4; ++j) {
            const float hfin = hl[j] + pc[j] * sq;
            const size_t grow = (size_t)(b * S + tc + 16 * w + 4 * fq + j);
            bf16_t* op = dry ? ((bf16_t*)(P.ws + W_YX) + grow * 1024 + n * 64 + 16 * ct + fr) : (ZA + grow * ZW + C_GR + n * 64 + 16 * ct + fr);
            *op = f2bf(gelu_t(bf2f(gv[j])) * hfin);
        }
    }
}

constexpr float EXPC = 0.125f * 1.4426950408889634f;
struct AttnAcc { f32x4 o[4][2]; float m[2], l[2]; };
DEV void attn_init(AttnAcc& a) {
#pragma unroll
    for (int d = 0; d < 4; ++d)
#pragma unroll
        for (int q = 0; q < 2; ++q) a.o[d][q] = (f32x4){0.f, 0.f, 0.f, 0.f};
    a.m[0] = a.m[1] = -INFINITY; a.l[0] = a.l[1] = 0.f;
}
DEV bf16x8 mk8(unsigned a, unsigned b, unsigned c, unsigned d) { u32x4 u = {a, b, c, d}; return __builtin_bit_cast(bf16x8, u); }

template <class MF>
DEV void attn_step(const bf16_t* sK, const bf16_t* sVt, int vstride, const bf16x8 (&qf)[2][2], AttnAcc& st, const MF& mf, int fr, int fq) {
    f32x4 s[4][2];
#pragma unroll
    for (int kt = 0; kt < 4; ++kt) {
        s[kt][0] = (f32x4){0.f, 0.f, 0.f, 0.f}; s[kt][1] = (f32x4){0.f, 0.f, 0.f, 0.f};
#pragma unroll
        for (int ks = 0; ks < 2; ++ks) {
            const bf16x8 kf = *(const bf16x8*)(sK + (16 * kt + fr) * 80 + 32 * ks + 8 * fq);
            s[kt][0] = MFMA16(kf, qf[0][ks], s[kt][0]);
            s[kt][1] = MFMA16(kf, qf[1][ks], s[kt][1]);
        }
    }
#pragma unroll
    for (int qt = 0; qt < 2; ++qt) {
        float ps = 0.f;
#pragma unroll
        for (int kt = 0; kt < 4; ++kt)
#pragma unroll
            for (int j = 0; j < 4; ++j) {
                const float p = mf(qt, 16 * kt + 4 * fq + j) ? __builtin_amdgcn_exp2f(s[kt][qt][j] * EXPC) : 0.f;
                s[kt][qt][j] = p; ps += p;
            }
        st.l[qt] += ps;
    }
#pragma unroll
    for (int ks = 0; ks < 2; ++ks) {
        bf16x8 pf[2];
#pragma unroll
        for (int qt = 0; qt < 2; ++qt)
            pf[qt] = mk8(pk2(s[2 * ks][qt][0], s[2 * ks][qt][1]), pk2(s[2 * ks][qt][2], s[2 * ks][qt][3]),
                         pk2(s[2 * ks + 1][qt][0], s[2 * ks + 1][qt][1]), pk2(s[2 * ks + 1][qt][2], s[2 * ks + 1][qt][3]));
#pragma unroll
        for (int dt = 0; dt < 4; ++dt) {
            const u32x2 v0 = *(const u32x2*)(sVt + (16 * dt + fr) * vstride + 32 * ks + 4 * fq);
            const u32x2 v1 = *(const u32x2*)(sVt + (16 * dt + fr) * vstride + 32 * ks + 16 + 4 * fq);
            const bf16x8 vf = mk8(v0.x, v0.y, v1.x, v1.y);
            st.o[dt][0] = MFMA16(vf, pf[0], st.o[dt][0]);
            st.o[dt][1] = MFMA16(vf, pf[1], st.o[dt][1]);
        }
    }
}
DEV void attn_step_fast(const bf16_t* sK, const bf16_t* sVt, const bf16x8 (&qf)[2][2], AttnAcc& st, const float (&bitoff)[2], int fr, int fq) {
    f32x4 s[4][2];
#pragma unroll
    for (int kt = 0; kt < 4; ++kt) {
        s[kt][0] = (f32x4){0.f, 0.f, 0.f, 0.f}; s[kt][1] = (f32x4){0.f, 0.f, 0.f, 0.f};
#pragma unroll
        for (int ks = 0; ks < 2; ++ks) {
            const bf16x8 kf = *(const bf16x8*)(sK + (16 * kt + fr) * 80 + 32 * ks + 8 * fq);
            s[kt][0] = MFMA16(kf, qf[0][ks], s[kt][0]);
            s[kt][1] = MFMA16(kf, qf[1][ks], s[kt][1]);
        }
    }
#pragma unroll
    for (int qt = 0; qt < 2; ++qt) {
        const float off = bitoff[qt];
        float ps = 0.f;
#pragma unroll
        for (int kt = 0; kt < 4; ++kt)
#pragma unroll
            for (int j = 0; j < 4; ++j) { const float p = __builtin_amdgcn_exp2f(fmaf(s[kt][qt][j], EXPC, off)); s[kt][qt][j] = p; ps += p; }
        st.l[qt] += ps;
    }
#pragma unroll
    for (int ks = 0; ks < 2; ++ks) {
        bf16x8 pf[2];
#pragma unroll
        for (int qt = 0; qt < 2; ++qt)
            pf[qt] = mk8(pk2(s[2 * ks][qt][0], s[2 * ks][qt][1]), pk2(s[2 * ks][qt][2], s[2 * ks][qt][3]),
                         pk2(s[2 * ks + 1][qt][0], s[2 * ks + 1][qt][1]), pk2(s[2 * ks + 1][qt][2], s[2 * ks + 1][qt][3]));
#pragma unroll
        for (int dt = 0; dt < 4; ++dt) {
            const u32x2 v0 = *(const u32x2*)(sVt + (16 * dt + fr) * 72 + 32 * ks + 4 * fq);
            const u32x2 v1 = *(const u32x2*)(sVt + (16 * dt + fr) * 72 + 32 * ks + 16 + 4 * fq);
            const bf16x8 vf = mk8(v0.x, v0.y, v1.x, v1.y);
            st.o[dt][0] = MFMA16(vf, pf[0], st.o[dt][0]);
            st.o[dt][1] = MFMA16(vf, pf[1], st.o[dt][1]);
        }
    }
}
template <int QT>
DEV void attn_half_fast(const bf16_t* sK, const bf16_t* sVt, const bf16x8 (&qf)[2][2], AttnAcc& st, float bitoff, int fr, int fq) {
    f32x4 s[4];
#pragma unroll
    for (int kt = 0; kt < 4; ++kt) {
        s[kt] = (f32x4){0.f, 0.f, 0.f, 0.f};
#pragma unroll
        for (int ks = 0; ks < 2; ++ks) {
            const bf16x8 kf = *(const bf16x8*)(sK + (16 * kt + fr) * 80 + 32 * ks + 8 * fq);
            s[kt] = MFMA16(kf, qf[QT][ks], s[kt]);
        }
    }
    const float off = bitoff;
    float ps = 0.f;
#pragma unroll
    for (int kt = 0; kt < 4; ++kt)
#pragma unroll
        for (int j = 0; j < 4; ++j) { const float p = __builtin_amdgcn_exp2f(fmaf(s[kt][j], EXPC, off)); s[kt][j] = p; ps += p; }
    st.l[QT] += ps;
#pragma unroll
    for (int ks = 0; ks < 2; ++ks) {
        const bf16x8 pf = mk8(pk2(s[2 * ks][0], s[2 * ks][1]), pk2(s[2 * ks][2], s[2 * ks][3]), pk2(s[2 * ks + 1][0], s[2 * ks + 1][1]), pk2(s[2 * ks + 1][2], s[2 * ks + 1][3]));
#pragma unroll
        for (int dt = 0; dt < 4; ++dt) {
            const u32x2 v0 = *(const u32x2*)(sVt + (16 * dt + fr) * 72 + 32 * ks + 4 * fq);
            const u32x2 v1 = *(const u32x2*)(sVt + (16 * dt + fr) * 72 + 32 * ks + 16 + 4 * fq);
            st.o[dt][QT] = MFMA16(mk8(v0.x, v0.y, v1.x, v1.y), pf, st.o[dt][QT]);
        }
    }
}
DEV void attn_fold_out(bf16_t* const (&op)[2], const AttnAcc& st, const float (&gate)[2]) {
#pragma unroll
    for (int qt = 0; qt < 2; ++qt) {
        float l = st.l[qt];
        l += __shfl_xor(l, 16); l += __shfl_xor(l, 32);
        const float sc = gate[qt] * __builtin_amdgcn_rcpf(fmaxf(l, 1e-30f));
#pragma unroll
        for (int dt = 0; dt < 4; ++dt) {
            const uint2 pv = *(const uint2*)(op[qt] + 16 * dt);
            f32x4 r = st.o[dt][qt] * sc;
            r[0] += lo_f(pv.x); r[1] += hi_f(pv.x); r[2] += lo_f(pv.y); r[3] += hi_f(pv.y);
            *(uint2*)(op[qt] + 16 * dt) = make_uint2(pk2(r[0], r[1]), pk2(r[2], r[3]));
        }
    }
}
DEV void attn_fold(f32x4 (&tot)[4][2], const AttnAcc& st, const float (&gate)[2]) {
#pragma unroll
    for (int qt = 0; qt < 2; ++qt) {
        float l = st.l[qt];
        l += __shfl_xor(l, 16); l += __shfl_xor(l, 32);
        const float sc = gate[qt] * __builtin_amdgcn_rcpf(fmaxf(l, 1e-30f));
#pragma unroll
        for (int dt = 0; dt < 4; ++dt) tot[dt][qt] += st.o[dt][qt] * sc;
    }
}
DEV void ld64(u32x4 (&r)[2], const bf16_t* src, size_t sstride, int tid) {
#pragma unroll
    for (int i = 0; i < 2; ++i) { const int c = tid + 256 * i; r[i] = *(const u32x4*)(src + (size_t)(c >> 3) * sstride + (c & 7) * 8); }
}
DEV void st64(bf16_t* dst, const u32x4 (&r)[2], int tid, int stride) {
#pragma unroll
    for (int i = 0; i < 2; ++i) { const int c = tid + 256 * i; *(u32x4*)(dst + (c >> 3) * stride + (c & 7) * 8) = r[i]; }
}

#define OUTP(QT) ((dry ? (bf16_t*)(P.ws + W_YX) + (size_t)(b * S + tq[QT]) * 1024 : ZA + (size_t)(b * S + tq[QT]) * ZW + C_Q) + head * 64 + 4 * fq)
#define LOAD_GATE(G2, BR) float G2[2]; { G2[0] = bf2f(ZA[(size_t)(b * S + tq[0]) * ZW + C_G + head * 3 + (BR)]); G2[1] = bf2f(ZA[(size_t)(b * S + tq[1]) * ZW + C_G + head * 3 + (BR)]); }
DEV u32x4 ld64w(const bf16_t* src, size_t sstride, int t512) { return *(const u32x4*)(src + (size_t)(t512 >> 3) * sstride + (t512 & 7) * 8); }
DEV void st64w(bf16_t* dst, const u32x4& r, int t512, int stride) { *(u32x4*)(dst + (t512 >> 3) * stride + (t512 & 7) * 8) = r; }
struct MaskAll { DEV bool operator()(int, int) const { return true; } };
struct MaskSel { unsigned bit[2]; int t[2]; int k0; DEV bool operator()(int qt, int kk) const { return bit[qt] && (k0 + kk <= t[qt]); } };
struct MaskWin { int t[2]; int k0; DEV bool operator()(int qt, int kk) const { const int k = k0 + kk; return k <= t[qt] && k > t[qt] - 512; } };

DEV void xattn_job(const Params& P, int job, char* smem, bool dry) {
    char* aux = (char*)P.out;
    bf16_t* ZA = (bf16_t*)(P.ws + W_ZA);
    const int qb = job & 15, h = (job >> 4) & 3, b = job >> 6;
    bf16_t* sK = (bf16_t*)smem;
    bf16_t* sVt = sK + 64 * 80;
    const int tid = opaque_tid(), w = tid >> 6, lane = tid & 63, fr = lane & 15, fq = lane >> 4;
    const int t0 = qb * 128 + w * 32;
    bf16x8 qf[2][2];
#pragma unroll
    for (int qt = 0; qt < 2; ++qt)
#pragma unroll
        for (int ks = 0; ks < 2; ++ks) qf[qt][ks] = *(const bf16x8*)(ZA + (size_t)(b * S + t0 + 16 * qt + fr) * ZW + C_QX + h * 64 + 32 * ks + 8 * fq);
    const bf16_t* MK = (const bf16_t*)(aux + O_MEMK) + (size_t)(b * 4 + h) * 256 * 64;
    const bf16_t* MVT = (const bf16_t*)(aux + O_MEMVT) + (size_t)(b * 4 + h) * 64 * 256;
    AttnAcc st; attn_init(st);
    u32x4 rk[2], rv[2];
    ld64(rk, MK, 64, tid); ld64(rv, MVT, 256, tid);
#pragma unroll 1
    for (int jb = 0; jb < 4; ++jb) {
        __syncthreads();
        st64(sK, rk, tid, 80); st64(sVt, rv, tid, 72);
        __syncthreads();
        if (jb + 1 < 4) { ld64(rk, MK + (size_t)(jb + 1) * 64 * 64, 64, tid); ld64(rv, MVT + (jb + 1) * 64, 256, tid); }
        __builtin_amdgcn_sched_barrier(0);
        { const float z2[2] = {0.f, 0.f}; attn_step_fast(sK, sVt, qf, st, z2, fr, fq); }
    }
    f32x4 tot[4][2];
#pragma unroll
    for (int dt = 0; dt < 4; ++dt) { tot[dt][0] = (f32x4){0.f, 0.f, 0.f, 0.f}; tot[dt][1] = (f32x4){0.f, 0.f, 0.f, 0.f}; }
    const float one[2] = {1.f, 1.f};
    attn_fold(tot, st, one);
#pragma unroll
    for (int qt = 0; qt < 2; ++qt)
#pragma unroll
        for (int dt = 0; dt < 4; ++dt)
            *(uint2*)((dry ? (bf16_t*)(P.ws + W_Y) + (size_t)(b * S + t0 + 16 * qt + fr) * 1024 : ZA + (size_t)(b * S + t0 + 16 * qt + fr) * ZW + C_QX) + h * 64 + 16 * dt + 4 * fq) =
                make_uint2(pk2(tot[dt][qt][0], tot[dt][qt][1]), pk2(tot[dt][qt][2], tot[dt][qt][3]));
}

DEV void nsa_job(const Params& P, int job, char* smem, bool dry) {
    char* aux = (char*)P.out;
    bf16_t* ZA = (bf16_t*)(P.ws + W_ZA);
    const int pj_ = job >> 1, bg = pj_ & 31, qb = 63 - (2 * (pj_ >> 5) + (job & 1)), b = bg >> 2, g = bg & 3, t0 = qb * 32;
    bf16_t* sK = (bf16_t*)smem;
    bf16_t* sVt = (bf16_t*)(smem + 20480);
    float* sImp = (float*)(smem + 38912);
    unsigned* sSel = (unsigned*)(smem + 38912 + 4096);
    constexpr int KVBUF = 9728;
    const int tid = opaque_tid(), w = tid >> 6, lane = tid & 63, fr = lane & 15, fq = lane >> 4;
    const int head = g * 4 + (fr & 3);
    const int qi0 = 8 * w + (fr >> 2);
    int tq[2];
    bf16x8 qf[2][2];
#pragma unroll
    for (int qt = 0; qt < 2; ++qt) {
        tq[qt] = t0 + qi0 + 4 * qt;
        const bf16_t* rowp = ZA + (size_t)(b * S + tq[qt]) * ZW;
#pragma unroll
        for (int ks = 0; ks < 2; ++ks) qf[qt][ks] = *(const bf16x8*)(rowp + C_Q + head * 64 + 32 * ks + 8 * fq);
    }
    f32x4 tot[4][2];
#pragma unroll
    for (int dt = 0; dt < 4; ++dt) { tot[dt][0] = (f32x4){0.f, 0.f, 0.f, 0.f}; tot[dt][1] = (f32x4){0.f, 0.f, 0.f, 0.f}; }

    {
        const bf16_t* KC = (const bf16_t*)(aux + O_KC) + (size_t)bg * 128 * 64;
        const bf16_t* VCT = (const bf16_t*)(aux + O_VCT) + (size_t)bg * 64 * 128;
        __syncthreads();
#pragma unroll
        for (int i = 0; i < 4; ++i) {
            const int c = tid + 256 * i;
            { const int r = c >> 3, k = (c & 7) * 8; *(u32x4*)(sK + r * 80 + k) = *(const u32x4*)(KC + r * 64 + k); }
            { const int r = c >> 4, k = (c & 15) * 8; *(u32x4*)(sVt + r * 136 + k) = *(const u32x4*)(VCT + r * 128 + k); }
        }
        __syncthreads();
#pragma unroll
        for (int qt = 0; qt < 2; ++qt) {
            const float g0 = bf2f(ZA[(size_t)(b * S + tq[qt]) * ZW + C_G + head * 3 + 0]);
            f32x4 s[8];
#pragma unroll
            for (int kt = 0; kt < 8; ++kt) {
                s[kt] = (f32x4){0.f, 0.f, 0.f, 0.f};
#pragma unroll
                for (int ks = 0; ks < 2; ++ks) {
                    const bf16x8 kf = *(const bf16x8*)(sK + (16 * kt + fr) * 80 + 32 * ks + 8 * fq);
                    s[kt] = MFMA16(kf, qf[qt][ks], s[kt]);
                }
            }
            float mx = -INFINITY;
#pragma unroll
            for (int kt = 0; kt < 8; ++kt)
#pragma unroll
                for (int j = 0; j < 4; ++j) {
                    const int n = 16 * kt + 4 * fq + j;
                    const float v = (n < NCMP && 16 * n + 31 <= tq[qt]) ? s[kt][j] : -INFINITY;
                    s[kt][j] = v; mx = fmaxf(mx, v);
                }
            mx = fmaxf(mx, __shfl_xor(mx, 16)); mx = fmaxf(mx, __shfl_xor(mx, 32));
            const float msub = (mx == -INFINITY) ? 0.f : mx;
            float ps = 0.f;
#pragma unroll
            for (int kt = 0; kt < 8; ++kt)
#pragma unroll
                for (int j = 0; j < 4; ++j) { const float p = __builtin_amdgcn_exp2f((s[kt][j] - msub) * EXPC); s[kt][j] = p; ps += p; }
            ps += __shfl_xor(ps, 16); ps += __shfl_xor(ps, 32);
            const float inv = __builtin_amdgcn_rcpf(fmaxf(ps, 1e-30f));
            float bprev = 0.f;
#pragma unroll
            for (int kt = 0; kt < 8; ++kt) {
                s[kt] *= inv;
                const float a = s[kt][0] + s[kt][1] + s[kt][2] + 0.5f * s[kt][3];
                const float bq = 0.5f * s[kt][3];
                const float x = __shfl(bq, (lane + 48) & 63);
                const float y = __shfl(bprev, (lane + 48) & 63);
                float iv = a + (fq > 0 ? x : y);
                iv += __shfl_xor(iv, 1); iv += __shfl_xor(iv, 2);
                if ((fr & 3) == 0) sImp[(qi0 + 4 * qt) * 32 + 4 * kt + fq] = iv;
                bprev = bq;
            }
#pragma unroll
            for (int ks = 0; ks < 4; ++ks) {
                const f32x4 pa = s[2 * ks] * g0, pb = s[2 * ks + 1] * g0;
                const bf16x8 pf = mk8(pk2(pa[0], pa[1]), pk2(pa[2], pa[3]), pk2(pb[0], pb[1]), pk2(pb[2], pb[3]));
#pragma unroll
                for (int dt = 0; dt < 4; ++dt) {
                    const u32x2 v0 = *(const u32x2*)(sVt + (16 * dt + fr) * 136 + 32 * ks + 4 * fq);
                    const u32x2 v1 = *(const u32x2*)(sVt + (16 * dt + fr) * 136 + 32 * ks + 16 + 4 * fq);
                    tot[dt][qt] = MFMA16(mk8(v0.x, v0.y, v1.x, v1.y), pf, tot[dt][qt]);
                }
            }
            __builtin_amdgcn_sched_barrier(0);
        }
    }
#pragma unroll
    for (int qt = 0; qt < 2; ++qt) {
        bf16_t* op = (dry ? (bf16_t*)(P.ws + W_YX) + (size_t)(b * S + tq[qt]) * 1024 : ZA + (size_t)(b * S + tq[qt]) * ZW + C_Q) + head * 64 + 4 * fq;
#pragma unroll
        for (int dt = 0; dt < 4; ++dt) *(uint2*)(op + 16 * dt) = pk4(tot[dt][qt]);
    }
    __syncthreads();
    {
        float myv[4];
#pragma unroll
        for (int i = 0; i < 4; ++i) {
            const int pidx = tid + 256 * i, q = pidx >> 5, m = pidx & 31;
            const int t = t0 + q, cur = t >> 6;
            const float sum = sImp[q * 32 + m];
            const bool forced = (m == 0) || (m == cur) || (m == cur - 1);
            const bool future = m * 64 > t;
            myv[i] = forced ? INFINITY : (future ? -INFINITY : sum);
        }
        if (tid == 0) sSel[32] = 0u;
        __syncthreads();
#pragma unroll
        for (int i = 0; i < 4; ++i) { const int pidx = tid + 256 * i; sImp[pidx] = myv[i]; }
        __syncthreads();
        unsigned wun = 0u;
#pragma unroll
        for (int i = 0; i < 4; ++i) {
            const int pidx = tid + 256 * i, q = pidx >> 5, m = pidx & 31;
            const float v = myv[i];
            int rank = 0;
#pragma unroll
            for (int m2 = 0; m2 < 32; ++m2) {
                const float o = sImp[q * 32 + m2];
                rank += (o > v || (o == v && m2 < m)) ? 1 : 0;
            }
            const bool selb = (rank < 8) && (v > -INFINITY);
            const unsigned long long bal = __ballot(selb);
            const unsigned mk = (unsigned)(bal >> (32 * (lane >> 5)));
            if ((lane & 31) == 0) sSel[q] = mk;
            wun |= (unsigned)bal | (unsigned)(bal >> 32);
        }
        if (lane == 0) atomicOr(&sSel[32], wun);
    }
    __syncthreads();
    __shared__ unsigned s_xuni[2];
    if (tid == 0) s_xuni[threadIdx.x >> 8] = sSel[32];
    __syncthreads();
    const unsigned uni = s_xuni[0] | s_xuni[1];
    const int jmax = (t0 + 31) >> 6;
    const int t512 = opaque_tid512();
    bf16_t* shKV = (bf16_t*)(smem - (t512 >> 8) * 56320);
    {
        AttnAcc st; attn_init(st);
        const bf16_t* Kb = ZA + (size_t)(b * S) * ZW + C_KS + g * 64;
        const bf16_t* Vb = (const bf16_t*)(P.ws + W_VST) + (size_t)bg * 64 * S;
        unsigned rem = uni & ((2u << jmax) - 1u);
        u32x4 rk, rv;
        if (rem) { const int j0 = __builtin_ctz(rem); rk = ld64w(Kb + (size_t)(j0 * 64) * ZW, ZW, t512); rv = ld64w(Vb + j0 * 64, S, t512); }
        __syncthreads();
        int it = 0;
#pragma unroll 1
        while (rem) {
            const int jb = __builtin_ctz(rem);
            rem &= rem - 1u;
            bf16_t* sKb = shKV + (it & 1) * KVBUF; bf16_t* sVb = sKb + 64 * 80; ++it;
            st64w(sKb, rk, t512, 80); st64w(sVb, rv, t512, 72);
            __syncthreads();
            if (rem) { const int jn = __builtin_ctz(rem); rk = ld64w(Kb + (size_t)(jn * 64) * ZW, ZW, t512); rv = ld64w(Vb + jn * 64, S, t512); }
            __builtin_amdgcn_sched_barrier(0);
            const unsigned b0 = (sSel[qi0] >> jb) & 1u, b1 = (sSel[qi0 + 4] >> jb) & 1u;
            if (jb * 64 + 63 <= t0) {
                const bool need0 = __builtin_amdgcn_ballot_w64(b0 != 0u) != 0ull, need1 = __builtin_amdgcn_ballot_w64(b1 != 0u) != 0ull;
                const float bo[2] = {b0 ? 0.f : -INFINITY, b1 ? 0.f : -INFINITY};
                if (need0 && need1) attn_step_fast(sKb, sVb, qf, st, bo, fr, fq);
                else if (need0) attn_half_fast<0>(sKb, sVb, qf, st, bo[0], fr, fq);
                else if (need1) attn_half_fast<1>(sKb, sVb, qf, st, bo[1], fr, fq);
            } else {
                MaskSel mf; mf.bit[0] = b0; mf.bit[1] = b1; mf.t[0] = tq[0]; mf.t[1] = tq[1]; mf.k0 = jb * 64;
                attn_step(sKb, sVb, 72, qf, st, mf, fr, fq);
            }
        }
        { LOAD_GATE(g1, 1) bf16_t* const op2[2] = {OUTP(0), OUTP(1)}; attn_fold_out(op2, st, g1); }
    }
    {
        AttnAcc st; attn_init(st);
        const bf16_t* Kb = ZA + (size_t)(b * S) * ZW + C_KW + g * 64;
        const bf16_t* Vb = (const bf16_t*)(P.ws + W_VWT) + (size_t)bg * 64 * S;
#pragma unroll
        for (int qt = 0; qt < 2; ++qt) {
            const int npad = 511 - tq[qt];
            if (npad > 0) { st.m[qt] = 0.f; st.l[qt] = (fq == 0) ? (float)npad : 0.f; }
        }
        int jlo = t0 - 511; jlo = jlo < 0 ? 0 : (jlo >> 6);
        u32x4 rk = ld64w(Kb + (size_t)(jlo * 64) * ZW, ZW, t512), rv = ld64w(Vb + jlo * 64, S, t512);
        __syncthreads();
#pragma unroll 1
        for (int jb = jlo; jb <= jmax; ++jb) {
            bf16_t* sKb = shKV + ((jb - jlo) & 1) * KVBUF; bf16_t* sVb = sKb + 64 * 80;
            st64w(sKb, rk, t512, 80); st64w(sVb, rv, t512, 72);
            __syncthreads();
            if (jb < jmax) { rk = ld64w(Kb + (size_t)((jb + 1) * 64) * ZW, ZW, t512); rv = ld64w(Vb + (jb + 1) * 64, S, t512); }
            __builtin_amdgcn_sched_barrier(0);
            if (jb * 64 + 63 <= t0 && jb * 64 > t0 + 31 - 512) {
                const float z2[2] = {0.f, 0.f};
                attn_step_fast(sKb, sVb, qf, st, z2, fr, fq);
            } else {
                MaskWin mf; mf.t[0] = tq[0]; mf.t[1] = tq[1]; mf.k0 = jb * 64;
                attn_step(sKb, sVb, 72, qf, st, mf, fr, fq);
            }
        }
        { LOAD_GATE(g2, 2) bf16_t* const op2[2] = {OUTP(0), OUTP(1)}; attn_fold_out(op2, st, g2); }
    }
}


#define XB_TMO      128
#define XB_XCNT(j)  (256  + 64 * (j))
#define XB_XSUB(j)  (1280 + 64 * (j))
#define XB_XGEN(j)  (2304 + 64 * (j))
#define XB_TOP      3328
#define XB_TOPGEN   3392
#define XCD_BAR_WORDS 3456
#define XB_SPIN_CAP (1u << 18)
#define LAS __attribute__((address_space(3)))
DEV unsigned xb_ld(unsigned* p) { return __hip_atomic_load(p, __ATOMIC_RELAXED, __HIP_MEMORY_SCOPE_AGENT); }
DEV unsigned xb_add(unsigned* p, unsigned v) { return __hip_atomic_fetch_add(p, v, __ATOMIC_RELAXED, __HIP_MEMORY_SCOPE_AGENT); }
DEV unsigned xb_xcc_id() { return (unsigned)__builtin_amdgcn_s_getreg((3 << 11) | 20) & 0xFu; }
#define XB_SPIN(cond, bar) do { unsigned _sp = 0; while (cond) { __builtin_amdgcn_s_sleep(1); \
    if ((++_sp & 255u) == 0u) { if (xb_ld(&(bar)[XB_TMO])) break; if (_sp > XB_SPIN_CAP) { atomicAdd(&(bar)[XB_TMO], 1u); break; } } } } while (0)
struct XcdBarrier { unsigned* bar; unsigned x; volatile LAS unsigned* st; };
DEV XcdBarrier xcd_barrier_post(unsigned* bar, volatile LAS unsigned* st) {
    XcdBarrier b; b.bar = bar; b.x = xb_xcc_id(); b.st = st;
    if (threadIdx.x == 0) (void)xb_add(&bar[XB_XCNT(b.x)], 1u);
    return b;
}
DEV void xcd_barrier_complete(unsigned* bar, unsigned x, unsigned& nloc, unsigned& nx) {
    const unsigned G = gridDim.x * gridDim.y * gridDim.z;
    unsigned sum, cnt, mine, sp = 0u;
    for (;;) {
        sum = 0u; cnt = 0u; mine = 0u;
#pragma unroll
        for (unsigned j = 0; j < 16; ++j) { const unsigned c = xb_ld(&bar[XB_XCNT(j)]); sum += c; cnt += (c > 0u) ? 1u : 0u; mine = (j == x) ? c : mine; }
        if (sum == G) break;
        __builtin_amdgcn_s_sleep(1);
        if ((++sp & 255u) == 0u) { if (xb_ld(&bar[XB_TMO])) break; if (sp > XB_SPIN_CAP) { atomicAdd(&bar[XB_TMO], 1u); break; } }
    }
    nloc = mine > 0u ? mine : 1u; nx = cnt > 0u ? cnt : 1u;
}
DEV void xcd_barrier(const XcdBarrier& b) {
    asm volatile("s_waitcnt vmcnt(0)" ::: "memory");
    __syncthreads();
    if (threadIdx.x == 0) {
        unsigned* bar = b.bar;
        __builtin_amdgcn_s_waitcnt(0);
        unsigned nloc = b.st[0], nx = b.st[1];
        if (nloc == 0u) { xcd_barrier_complete(bar, b.x, nloc, nx); b.st[0] = nloc; b.st[1] = nx; }
        const unsigned old = xb_add(&bar[XB_XSUB(b.x)], 1u);
        const unsigned gen = old / nloc;
        if (old + 1u == (gen + 1u) * nloc) {
            __builtin_amdgcn_fence(__ATOMIC_RELEASE, "agent");
            asm volatile("s_waitcnt vmcnt(0)" ::: "memory");
            const unsigned og = xb_add(&bar[XB_TOP], 1u);
            const unsigned tg = og / nx;
            if (og + 1u == (tg + 1u) * nx) xb_add(&bar[XB_TOPGEN], 1u);
            else XB_SPIN(xb_ld(&bar[XB_TOPGEN]) == tg, bar);
            __builtin_amdgcn_fence(__ATOMIC_ACQUIRE, "agent");
            xb_add(&bar[XB_XGEN(b.x)], 1u);
            asm volatile("s_waitcnt vmcnt(0)" ::: "memory");
        } else {
            XB_SPIN(xb_ld(&bar[XB_XGEN(b.x)]) == gen, bar);
            __builtin_amdgcn_fence(__ATOMIC_ACQUIRE, "agent");
            asm volatile("s_waitcnt vmcnt(0)" ::: "memory");
        }
    }
    __syncthreads();
}
constexpr size_t W_BAR = 252 * MiB;

constexpr int HALF_SMEM = 56320;
static_assert(HALF_SMEM == 56320, "update nsa_job");
constexpr int SMEM_BYTES = 131072;

extern __shared__ __attribute__((aligned(16))) char dyn_smem[];
#define RUN_PG8(EPI_T, EPI_OBJ, A_, LDA_, BT_, LDB_, M_, N_, K_) { pg8::Gemm g_; g_.A = (A_); g_.Bt = (BT_); g_.M = (M_); g_.N = (N_); g_.K = (K_); g_.lda = (LDA_); g_.ldb = (LDB_); g_.gather = 0; \
        pg8::StaticOrder so_; so_.init((M_), (N_), (int)gridDim.x, (int)blockIdx.x); __syncthreads(); \
        pg8::gemm_phase<EPI_T, pg8::StaticOrder, true, true>((PG8_LAS unsigned char*)dyn_smem, g_, so_, (EPI_OBJ)); __syncthreads(); }

template <int PH, bool DRY = false>
DEV void run_phase(const Params& P, char* smem) {
    const int nb = gridDim.x, bid = blockIdx.x, sub = opaque_tid512() >> 8;
    char* hsm = smem + sub * HALF_SMEM;
    char* aux = (char*)P.out;
    char* ws = P.ws;
    bf16_t* ZA = (bf16_t*)(ws + W_ZA);
    if (PH == 0) {
        for (int pj = bid; pj < (5088 + 4096 + 512 + 64 + 64) / 2; pj += nb) {
            int j = 2 * pj + sub;
            if (j < 5088) {
                bool done = false;
#define TR(SRC, LD, DSTOFF, KK, NN, MAP, BLK)                                                                                  \
    if (!done) { const int nrt = (NN) / 64, nt = nrt * ((KK) / 64);                                                              \
        if (j < nt) { transpose_tile((SRC), (LD), (bf16_t*)(aux + (DSTOFF)), (KK), (j % nrt) * 64, (j / nrt) * 64, (MAP), hsm, (BLK) ? (NN) : 0); done = true; } else j -= nt; }
                TR(P.w_in, 7984, O_WTA, 1024, 5120, 1, 0)
                TR(P.w_in, 7984, O_WTB, 1024, 4096, 2, 0)
                TR(P.w_up, 4096, O_WTUP, 1024, 4096, 0, 0)
                TR(P.w_down, 1024, O_WTDN, 4096, 1024, 0, 0)
                TR(P.w_o, 1024, O_WTO, 1024, 1024, 0, 0)
                TR(P.w_xo, 1024, O_WTXO, 256, 1024, 0, 0)
                TR(P.w_mkv, 512, O_WTMKV, 1024, 512, 0, 0)
                TR(P.wk1, 256, O_WTCK1, 2048, 256, 0, 0)
                TR(P.wv1, 256, O_WTCV1, 2048, 256, 0, 0)
#undef TR
                if (!done) {
                    if (j < 16) transpose_tile(P.w_a + j * 4096, 64, (bf16_t*)(aux + O_WAT) + j * 4096, 64, 0, 0, 0, hsm);
                    else { j -= 16; transpose_tile(P.w_i + j * 4096, 64, (bf16_t*)(aux + O_WIT) + j * 4096, 64, 0, 0, 0, hsm); }
                }
                continue;
            }
            j -= 5088;
            if (j < 4096) { rownorm<false>(P.x, P.g_mix, (bf16_t*)(ws + W_U), nullptr, j * 4 + (opaque_tid() >> 6)); continue; }
            j -= 4096;
            if (j < 512) { rownorm<false>(P.mem, P.g_mem, (bf16_t*)(aux + O_MEMN), nullptr, j * 4 + (opaque_tid() >> 6)); continue; }
            j -= 512;
            if (j < 64) { rope_job((float*)(aux + O_ROPEC), (float*)(aux + O_ROPES), j); continue; }
            j -= 64;
            posbias_job(P, (float*)(aux + O_PB), j, hsm);
        }
    } else if (PH == 1) {
        { PEpiMemKV ep; ep.MK = (bf16_t*)(aux + O_MEMK); ep.MVT = (bf16_t*)(aux + O_MEMVT);
          RUN_PG8(PEpiMemKV, ep, (const bf16_t*)(aux + O_MEMN), 1024, (const bf16_t*)(aux + O_WTMKV), 1024, 2048, 512, 1024) }
        { PEpiZA ep; ep.ZA = ZA; ep.VST = (bf16_t*)(ws + W_VST); ep.VWT = (bf16_t*)(ws + W_VWT); ep.ropec = (const float*)(aux + O_ROPEC); ep.ropes = (const float*)(aux + O_ROPES);
          RUN_PG8(PEpiZA, ep, (const bf16_t*)(ws + W_U), 1024, (const bf16_t*)(aux + O_WTA), 1024, 16384, 5120, 1024) }
    } else if (PH == 2) {
        { PEpiHid ep; ep.HK = (bf16_t*)(aux + O_HIDK); ep.HV = (bf16_t*)(aux + O_HIDV); ep.pb = (const float*)(aux + O_PB);
          pg8::Gemm g_; g_.A = ZA; g_.Bt = (const bf16_t*)(aux + O_WTCK1); g_.M = 4096; g_.N = 512; g_.K = 2048; g_.lda = ZW; g_.ldb = 2048; g_.gather = 1;
          pg8::StaticOrder so_; so_.init(4096, 512, (int)gridDim.x, (int)blockIdx.x); __syncthreads();
          pg8::gemm_phase<PEpiHid, pg8::StaticOrder, true, true>((PG8_LAS unsigned char*)dyn_smem, g_, so_, ep); __syncthreads(); }
        for (int job = bid; job < 512; job += nb) {
            if (job < 256) rnn_job(P, 2 * job + sub, hsm, DRY);
            else xattn_job(P, 2 * (job - 256) + sub, hsm, DRY);
        }
    } else if (PH == 3) {
        for (int pj = bid; pj < 1016; pj += nb) cmp2_job(P, 2 * pj + sub);
    } else if (PH == 4) {
        for (int job = bid; job < 1024; job += nb) nsa_job(P, 2 * job + sub, hsm, DRY);
        if (!DRY) { PEpiBf<0> ep; ep.O = (bf16_t*)(ws + W_YX); ep.ldo = 1024;
          RUN_PG8(PEpiBf<0>, ep, ZA + C_QX, ZW, (const bf16_t*)(aux + O_WTXO), 256, 16384, 1024, 256) }
    } else if (PH == 5) {
        { PEpiMerge ep; ep.ZA = ZA; ep.YX = (const bf16_t*)(ws + W_YX); ep.Y = (bf16_t*)(ws + W_Y);
          RUN_PG8(PEpiMerge, ep, (const bf16_t*)(ws + W_U), 1024, (const bf16_t*)(aux + O_WTB), 1024, 16384, 4096, 1024) }
    } else if (PH == 6) {
        { PEpiRes ep; ep.R = P.x; ep.O = (float*)(ws + W_H);
          RUN_PG8(PEpiRes, ep, (const bf16_t*)(ws + W_Y), 1024, (const bf16_t*)(aux + O_WTO), 1024, 16384, 1024, 1024) }
    } else if (PH == 7) {
        for (int pj = bid; pj < 2048; pj += nb) rownorm<false>((const float*)(ws + W_H), P.g_mlp, (bf16_t*)(ws + W_VN), nullptr, (2 * pj + sub) * 4 + (opaque_tid() >> 6));
    } else if (PH == 8) {
        { PEpiBf<1> ep; ep.O = (bf16_t*)(ws + W_HID); ep.ldo = 4096;
          RUN_PG8(PEpiBf<1>, ep, (const bf16_t*)(ws + W_VN), 1024, (const bf16_t*)(aux + O_WTUP), 1024, 16384, 4096, 1024) }
    } else if (PH == 9) {
        { PEpiRes ep; ep.R = (const float*)(ws + W_H); ep.O = (float*)(ws + W_H);
          RUN_PG8(PEpiRes, ep, (const bf16_t*)(ws + W_HID), 4096, (const bf16_t*)(aux + O_WTDN), 4096, 16384, 1024, 4096) }
    } else if (PH == 10) {
        for (int pj = bid; pj < 2048; pj += nb) rownorm<true>((const float*)(ws + W_H), P.g_final, nullptr, P.out, (2 * pj + sub) * 4 + (opaque_tid() >> 6));
    }
}

__global__ void __launch_bounds__(512, 2) mega_kernel(Params P) {
    char* smem = dyn_smem;
    cg::grid_group grid = cg::this_grid();
    __shared__ uint4 xb_words;
    if (threadIdx.x == 0) xb_words = make_uint4(0u, 0u, 0u, 0u);
    __syncthreads();
    XcdBarrier xb = xcd_barrier_post((unsigned*)(P.ws + W_BAR), (volatile LAS unsigned*)&xb_words);
    if (P.ws == nullptr) grid.sync();
#ifndef REP
#define REP -1
#endif
#define GSYNC() xcd_barrier(xb)
#define PHASE(k) { if (REP == k && k != 9) { run_phase<k, true>(P, smem); GSYNC(); } run_phase<k>(P, smem); GSYNC(); }
    PHASE(0) PHASE(1) PHASE(2) PHASE(3) PHASE(4) PHASE(5) PHASE(6) PHASE(7) PHASE(8) PHASE(9)
    if (REP == 10) { run_phase<10>(P, smem); GSYNC(); }
    if (REP == 11) { GSYNC(); GSYNC(); GSYNC(); GSYNC(); GSYNC(); GSYNC(); GSYNC(); GSYNC(); GSYNC(); GSYNC(); }
    run_phase<10>(P, smem);
}

extern "C" void kernel_launch(void* const* d_in, const int* in_sizes, int n_in, void* d_out, int out_size, void* d_ws, size_t ws_size,
                              hipStream_t stream) {
    Params P{};
    const float** pp = (const float**)&P;
    for (int i = 0; i < 25; ++i) pp[i] = (const float*)d_in[i];
    P.out = (float*)d_out;
    P.ws = (char*)d_ws;
    static int grid_blocks = 0;
    if (!grid_blocks) {
        int dev = 0, cus = 0, per_cu = 0;
        hipGetDevice(&dev);
        hipDeviceGetAttribute(&cus, hipDeviceAttributeMultiprocessorCount, dev);
        hipFuncSetAttribute((const void*)mega_kernel, hipFuncAttributeMaxDynamicSharedMemorySize, SMEM_BYTES);
        hipOccupancyMaxActiveBlocksPerMultiprocessor(&per_cu, mega_kernel, 512, SMEM_BYTES);
        if (per_cu > 1) per_cu = 1;
        if (per_cu < 1) per_cu = 1;
        grid_blocks = cus * per_cu;
    }
    hipMemsetAsync((char*)d_ws + W_BAR, 0, XCD_BAR_WORDS * 4, stream);
    void* args[] = {&P};
    hipError_t e = hipLaunchCooperativeKernel((void*)mega_kernel, dim3(grid_blocks), dim3(512), args, SMEM_BYTES, stream);
    if (e != hipSuccess) fprintf(stderr, "cooperative launch failed: %s (grid %d)\n", hipGetErrorString(e), grid_blocks);
}
```

```cpp
#include <hip/hip_runtime.h>
#include <hip/hip_cooperative_groups.h>
#include <cstdint>
#include <cstdio>
namespace cg = cooperative_groups;

#ifndef MULTI
#define MULTI 0
#endif

typedef unsigned short bf16_t;
typedef short bf16x8 __attribute__((ext_vector_type(8)));
typedef float f32x4 __attribute__((ext_vector_type(4)));
typedef __bf16 bfv2 __attribute__((ext_vector_type(2)));
typedef float f32x2 __attribute__((ext_vector_type(2)));
typedef unsigned u32x4 __attribute__((ext_vector_type(4)));
typedef unsigned u32x2 __attribute__((ext_vector_type(2)));
#define DEV __device__ __forceinline__
DEV int opaque_tid() { int t = threadIdx.x & 255; asm volatile("" : "+v"(t)); return t; }
DEV int opaque_tid512() { int t = threadIdx.x; asm volatile("" : "+v"(t)); return t; }
#define MFMA16(a, b, c) __builtin_amdgcn_mfma_f32_16x16x32_bf16((a), (b), (c), 0, 0, 0)

constexpr int T = 16384, S = 2048;
constexpr int ZW = 4480;
constexpr int C_Q = 0, C_KC = 1024, C_VC = 1280, C_KS = 1536, C_KW = 1792, C_XR = 2048, C_GR = 3072, C_QX = 4096, C_G = 4352;
constexpr int NCMP = 127;
constexpr int NCROWS = 4064;

constexpr size_t O_WTA = 0;
constexpr size_t O_WTB = O_WTA + (size_t)5120 * 1024 * 2;
constexpr size_t O_WTUP = O_WTB + (size_t)4096 * 1024 * 2;
constexpr size_t O_WTDN = O_WTUP + (size_t)4096 * 1024 * 2;
constexpr size_t O_WTO = O_WTDN + (size_t)4096 * 1024 * 2;
constexpr size_t O_WTXO = O_WTO + (size_t)1024 * 1024 * 2;
constexpr size_t O_WTMKV = O_WTXO + (size_t)1024 * 256 * 2;
constexpr size_t O_WTCK1 = O_WTMKV + (size_t)512 * 1024 * 2;
constexpr size_t O_WTCV1 = O_WTCK1 + (size_t)256 * 2048 * 2;
constexpr size_t O_WAT = O_WTCV1 + (size_t)256 * 2048 * 2;
constexpr size_t O_WIT = O_WAT + (size_t)16 * 64 * 64 * 2;
constexpr size_t O_ROPEC = O_WIT + (size_t)16 * 64 * 64 * 2;
constexpr size_t O_ROPES = O_ROPEC + (size_t)2048 * 8 * 4;
constexpr size_t O_MEMN = O_ROPES + (size_t)2048 * 8 * 4;
constexpr size_t O_MEMK = O_MEMN + (size_t)2048 * 1024 * 2;
constexpr size_t O_MEMVT = O_MEMK + (size_t)2048 * 256 * 2;
constexpr size_t O_HIDK = O_MEMVT + (size_t)2048 * 256 * 2;
constexpr size_t O_HIDV = O_HIDK + (size_t)4096 * 256 * 2;
constexpr size_t O_KC = O_HIDV + (size_t)4096 * 256 * 2;
constexpr size_t O_VCT = O_KC + (size_t)32 * 128 * 64 * 2;
constexpr size_t O_PB = O_VCT + (size_t)32 * 64 * 128 * 2;
constexpr size_t O_AUX_END = O_PB + 16384;
static_assert(O_AUX_END <= (size_t)64 << 20, "aux overflow");
constexpr size_t MiB = (size_t)1 << 20;
constexpr size_t W_U = 0, W_ZA = 32 * MiB, W_VST = 172 * MiB, W_VWT = 180 * MiB, W_YX = 188 * MiB, W_Y = 220 * MiB;
constexpr size_t W_H = 32 * MiB, W_VN = 0, W_HID = 96 * MiB;

struct Params {
    const float *x, *mem, *g_mix, *w_in, *cpk, *cpv, *wk1, *wk2, *wv1, *wv2, *conv_w, *conv_b, *w_a, *b_a, *w_i, *b_i, *lam,
        *g_mem, *w_mkv, *w_xo, *w_o, *g_mlp, *w_up, *w_down, *g_final;
    float* out;
    char* ws;
};

DEV float bf2f(bf16_t h) { return __uint_as_float(((unsigned)h) << 16); }
DEV unsigned pk2(float lo, float hi) { f32x2 v = {lo, hi}; bfv2 b = __builtin_convertvector(v, bfv2); return __builtin_bit_cast(unsigned, b); }
DEV bf16_t f2bf(float f) { return (bf16_t)(pk2(f, 0.f) & 0xffffu); }
DEV float lo_f(unsigned u) { return __uint_as_float(u << 16); }
DEV float hi_f(unsigned u) { return __uint_as_float(u & 0xffff0000u); }
DEV float sigm(float x) { return __builtin_amdgcn_rcpf(1.f + __expf(-x)); }
DEV float gelu_t(float x) {
    float y = 0.7978845608028654f * (x + 0.044715f * x * x * x);
    float e = __expf(2.f * y);
    float th = 1.f - 2.f * __builtin_amdgcn_rcpf(1.f + e);
    return 0.5f * x * (1.f + th);
}
DEV float wave_sum(float v) {
#pragma unroll
    for (int o = 32; o >= 1; o >>= 1) v += __shfl_xor(v, o);
    return v;
}

DEV int map_col(int mapid, int r) {
    if (mapid == 0) return r;
    if (mapid == 1) {
        if (r < 1536) return r;
        if (r < 1792) return 1536 + (r - 1536);
        if (r < 2048) return 2048 + (r - 1792);
        if (r < 3072) return 2608 + (r - 2048);
        if (r < 4096) return 3632 + (r - 3072);
        if (r < 4352) return 4656 + (r - 4096);
        if (r < 4608) return 1792 + (r - 4352);
        if (r < 4864) return 2304 + (r - 4608);
        if (r < 4912) return 2560 + (r - 4864);
        return -1;
    }
    const int pn = r >> 8, rem = r & 255, bj = rem >> 7, wc = (rem >> 5) & 3, n = (rem >> 4) & 1, c16 = rem & 15, slot = 2 * bj + n;
    if (slot == 3) return -1;
    return 4912 + slot * 1024 + pn * 64 + wc * 16 + c16;
}

DEV void transpose_tile(const float* __restrict__ src, int ld, bf16_t* __restrict__ dst, int K, int r0, int k0, int mapid, char* smem, int nblk = 0) {
    float* sm = (float*)smem;
    const int tid = threadIdx.x & 255, lane = tid & 63, w = tid >> 6;
    __syncthreads();
    const int sc = map_col(mapid, r0 + lane);
#pragma unroll
    for (int i = 0; i < 16; ++i) {
        int kk = w + 4 * i;
        float v = sc >= 0 ? src[(size_t)(k0 + kk) * ld + sc] : 0.f;
        sm[kk * 65 + lane] = v;
    }
    __syncthreads();
    const int rr = tid >> 2, kq = (tid & 3) * 16;
    unsigned o[8];
#pragma unroll
    for (int e = 0; e < 8; ++e) o[e] = pk2(sm[(kq + 2 * e) * 65 + rr], sm[(kq + 2 * e + 1) * 65 + rr]);
    uint4* dp = nblk ? (uint4*)(dst + (size_t)(k0 >> 6) * nblk * 64 + (size_t)(r0 + rr) * 64 + kq) : (uint4*)(dst + (size_t)(r0 + rr) * K + k0 + kq);
    dp[0] = make_uint4(o[0], o[1], o[2], o[3]);
    dp[1] = make_uint4(o[4], o[5], o[6], o[7]);
}

template <bool OUTF32>
DEV void rownorm(const float* __restrict__ src, const float* __restrict__ g, bf16_t* dstb, float* dstf, int row, bool blk = false) {
    const int lane = opaque_tid() & 63;
    const float4* sp = (const float4*)(src + (size_t)row * 1024);
    float4 v[4];
    float ss = 0.f;
#pragma unroll
    for (int i = 0; i < 4; ++i) { v[i] = sp[lane + 64 * i]; ss += v[i].x * v[i].x + v[i].y * v[i].y + v[i].z * v[i].z + v[i].w * v[i].w; }
    ss = wave_sum(ss);
    const float r = rsqrtf(ss * (1.0f / 1024.0f) + 1e-6f);
#pragma unroll
    for (int i = 0; i < 4; ++i) {
        float4 gg = ((const float4*)g)[lane + 64 * i];
        float a = v[i].x * r * gg.x, b = v[i].y * r * gg.y, c = v[i].z * r * gg.z, d = v[i].w * r * gg.w;
        if (OUTF32) ((float4*)(dstf + (size_t)row * 1024))[lane + 64 * i] = make_float4(a, b, c, d);
        else if (blk) { const int col = 4 * (lane + 64 * i); *(uint2*)(dstb + (size_t)(col >> 6) * ((size_t)16384 * 64) + (size_t)row * 64 + (col & 63)) = make_uint2(pk2(a, b), pk2(c, d)); }
        else ((uint2*)(dstb + (size_t)row * 1024))[lane + 64 * i] = make_uint2(pk2(a, b), pk2(c, d));
    }
}

DEV void rope_job(float* ct, float* st, int job) {
    const int e = job * 256 + (threadIdx.x & 255);
    const int pos = e >> 3, i = e & 7;
    const double inv = exp(-(double)i * 0.125 * 13.122363377404328);
    const double ang = (double)pos * inv;
    const double kq = rint(ang * 0.6366197723675814);
    const double r = ang - kq * 1.5707963267948966;
    const double r2 = r * r;
    const double sn = r * (1.0 + r2 * (-1.0 / 6 + r2 * (1.0 / 120 + r2 * (-1.0 / 5040 + r2 * (1.0 / 362880 + r2 * (-1.0 / 39916800 + r2 * (1.0 / 6227020800.0)))))));
    const double cs = 1.0 + r2 * (-0.5 + r2 * (1.0 / 24 + r2 * (-1.0 / 720 + r2 * (1.0 / 40320 + r2 * (-1.0 / 3628800 + r2 * (1.0 / 479001600.0))))));
    const int q = ((int)kq) & 3;
    double s_, c_;
    if (q == 0) { s_ = sn; c_ = cs; } else if (q == 1) { s_ = cs; c_ = -sn; } else if (q == 2) { s_ = -sn; c_ = -cs; } else { s_ = -cs; c_ = sn; }
    ct[e] = (float)c_; st[e] = (float)s_;
}

DEV void posbias_job(const Params& P, float* PB, int job, char* smem) {
    float* sred = (float*)smem;
    const int tid = opaque_tid(), which = job >> 5, cgi = (job >> 3) & 3, kc = job & 7, c = cgi * 64 + (tid & 63), kp = tid >> 6;
    const float* pos = (which ? P.cpv : P.cpk) + kc * 256 + kp * 64;
    const float* w1 = (which ? P.wv1 : P.wk1) + (size_t)(kc * 256 + kp * 64) * 256 + c;
    float a0 = 0.f, a1 = 0.f, a2 = 0.f, a3 = 0.f;
#pragma unroll 4
    for (int k = 0; k < 64; k += 4) {
        a0 += pos[k] * w1[(size_t)k * 256]; a1 += pos[k + 1] * w1[(size_t)(k + 1) * 256];
        a2 += pos[k + 2] * w1[(size_t)(k + 2) * 256]; a3 += pos[k + 3] * w1[(size_t)(k + 3) * 256];
    }
    __syncthreads();
    sred[kp * 64 + (tid & 63)] = (a0 + a1) + (a2 + a3);
    __syncthreads();
    if (tid < 64) PB[(which * 8 + kc) * 256 + c] = (sred[tid] + sred[64 + tid]) + (sred[128 + tid] + sred[192 + tid]);
}

struct ALPlain {
    const bf16_t* A; int lda; int ks;
    const char* base; unsigned off0;
    DEV void init(int row0, int lrow, int lk) { base = (const char*)(A + (size_t)row0 * lda); off0 = (unsigned)(lrow * lda + lk) * 2u; }
    DEV u32x4 load(int i, int k0) const { return *(const u32x4*)(base + (off0 + (unsigned)(i * 128 * lda) + (unsigned)(k0 >> 6) * (unsigned)(ks * 2))); }
    DEV u32x4 fix(int, const u32x4& v, int) const { return v; }
};
struct ALCmp {
    const bf16_t* ZA; const float* spos; int colbase;
    unsigned roff[4]; int lk_;
    DEV void init(int row0, int lrow, int lk) {
        lk_ = lk;
#pragma unroll
        for (int i = 0; i < 4; ++i) {
            const int row = row0 + lrow + 64 * i;
            const int bg = row / NCMP, n = row - bg * NCMP, b = bg >> 2, g = bg & 3;
            roff[i] = row < NCROWS ? (unsigned)(((b * S + 16 * n) * ZW + colbase + g * 64 + lk) * 2) : 0xffffffffu;
        }
    }
    DEV u32x4 load(int i, int k0) const {
        if (roff[i] == 0xffffffffu) return (u32x4){0u, 0u, 0u, 0u};
        return *(const u32x4*)((const char*)ZA + (roff[i] + (unsigned)((k0 >> 6) * ZW * 2)));
    }
    DEV u32x4 fix(int i, const u32x4& v, int k0) const {
        if (roff[i] == 0xffffffffu) return v;
        const float4 p0 = *(const float4*)(spos + k0 + lk_), p1 = *(const float4*)(spos + k0 + lk_ + 4);
        u32x4 o;
        o.x = pk2(lo_f(v.x) + p0.x, hi_f(v.x) + p0.y); o.y = pk2(lo_f(v.y) + p0.z, hi_f(v.y) + p0.w);
        o.z = pk2(lo_f(v.z) + p1.x, hi_f(v.z) + p1.y); o.w = pk2(lo_f(v.w) + p1.z, hi_f(v.w) + p1.w);
        return o;
    }
};

template <int TM, int TN, bool SWAP, class AL, class EP>
DEV void gemm_tile(AL al, const bf16_t* __restrict__ Bt, int ldb, int bks, int K, int pm, int pn, const EP& ep, char* smem) {
    constexpr int BM = TM * 32, BN = TN * 64, NA = BM / 64, NBB = (BN + 63) / 64;
    bf16_t* sA = (bf16_t*)smem;
    bf16_t* sB = sA + BM * 72;
    const int tid = opaque_tid512(), wid = tid >> 6, lane = tid & 63, wr = wid >> 2, wc = wid & 3, fr = lane & 15, fq = lane >> 4;
    f32x4 acc[TM][TN];
#pragma unroll
    for (int m = 0; m < TM; ++m)
#pragma unroll
        for (int n = 0; n < TN; ++n) acc[m][n] = (f32x4){0.f, 0.f, 0.f, 0.f};
    const int lrow = tid >> 3, lk = (tid & 7) * 8;
    u32x4 ra[NA], rb[NBB];
    al.init(pm * BM, lrow, lk);
    const char* bbase = (const char*)(Bt + (size_t)(pn * BN) * ldb);
    const unsigned boff = (unsigned)(lrow * ldb + lk) * 2u;
#pragma unroll
    for (int i = 0; i < NBB; ++i) rb[i] = (u32x4){0u, 0u, 0u, 0u};
#pragma unroll
    for (int i = 0; i < NA; ++i) ra[i] = al.load(i, 0);
#pragma unroll
    for (int i = 0; i < NBB; ++i) if (BN % 64 == 0 || lrow + 64 * i < BN) rb[i] = *(const u32x4*)(bbase + (boff + (unsigned)(i * 128 * ldb)));
    int nk = K >> 6;
    asm volatile("" : "+s"(nk));
    bf16_t* sWa = sA + lrow * 72 + lk;
    bf16_t* sWb = sB + lrow * 72 + lk;
    const bf16_t* sAr = sA + (wr * TM * 16 + fr) * 72 + fq * 8;
    const bf16_t* sBr = sB + (wc * TN * 16 + fr) * 72 + fq * 8;
#pragma unroll 1
    for (int kt = 0; kt < nk; ++kt) {
        __syncthreads();
#pragma unroll
        for (int i = 0; i < NA; ++i) *(u32x4*)(sWa + (64 * i) * 72) = al.fix(i, ra[i], kt * 64);
#pragma unroll
        for (int i = 0; i < NBB; ++i) if (BN % 64 == 0 || lrow + 64 * i < BN) *(u32x4*)(sWb + (64 * i) * 72) = rb[i];
        __syncthreads();
        if (kt + 1 < nk) {
            const int k0 = (kt + 1) * 64;
#pragma unroll
            for (int i = 0; i < NA; ++i) ra[i] = al.load(i, k0);
#pragma unroll
            for (int i = 0; i < NBB; ++i) if (BN % 64 == 0 || lrow + 64 * i < BN) rb[i] = *(const u32x4*)(bbase + (boff + (unsigned)(i * 128 * ldb) + (unsigned)(k0 >> 6) * (unsigned)(bks * 2)));
        }
        __builtin_amdgcn_sched_barrier(0);
        __builtin_amdgcn_s_setprio(1);
#pragma unroll
        for (int ks = 0; ks < 2; ++ks) {
            bf16x8 bfr[TN];
#pragma unroll
            for (int n = 0; n < TN; ++n) bfr[n] = *(const bf16x8*)(sBr + (n * 16) * 72 + ks * 32);
#pragma unroll
            for (int m = 0; m < TM; ++m) {
                const bf16x8 af = *(const bf16x8*)(sAr + (m * 16) * 72 + ks * 32);
#pragma unroll
                for (int n = 0; n < TN; ++n) acc[m][n] = SWAP ? MFMA16(bfr[n], af, acc[m][n]) : MFMA16(af, bfr[n], acc[m][n]);
            }
        }
        __builtin_amdgcn_s_setprio(0);
    }
    ep.run(acc, pm * BM + wr * TM * 16, pn * BN + wc * TN * 16, fr, fq);
}

DEV uint2 pk4(const f32x4& a) { return make_uint2(pk2(a[0], a[1]), pk2(a[2], a[3])); }

namespace pg8 {
#define PG8_LAS __attribute__((address_space(3)))
typedef unsigned short bf16_t;
typedef short bf16x8 __attribute__((ext_vector_type(8)));
typedef float f32x4 __attribute__((ext_vector_type(4)));
typedef unsigned u32x4 __attribute__((ext_vector_type(4)));
constexpr int BM = 256, BK = 64, HALF = 128, HTB = HALF * BK * 2  , STAGE_BYTES = 8 * HTB, NXCD = 8, WGM = 8;

__host__ __device__ __forceinline__ int lds_byte(int r, int c) { const int st = (r >> 4) * 2 + (c >> 5), rr = r & 15, cc = c & 31, ob = rr * 64 + cc * 2; return st * 1024 + (ob ^ (((ob >> 9) & 1) << 5)); }
__host__ __device__ __forceinline__ void stage_rc(int b, int& R, int& C) { const int st = b / 1024, sb = b % 1024, swz = sb ^ (((sb >> 9) & 1) << 5); R = (st >> 1) * 16 + swz / 64; C = (st & 1) * 32 + (swz % 64) / 2; }
__host__ __device__ __forceinline__ int perm32(int rho) { const int n = rho >> 4, i = rho & 15; return 8 * (i >> 2) + 4 * n + (i & 3); }

struct Unit { int pm, pn; };
struct Gemm { const bf16_t* A; const bf16_t* Bt; int M, N, K, lda, ldb; int gather; };

struct StaticOrder {
    int nM, nN, nwg, G, c;
    __host__ __device__ void init(int M, int N, int G_, int c_) { nM = M / BM; nN = N / BM; nwg = nM * nN; G = G_; c = c_; }
    __host__ __device__ bool next(int i, Unit& u) const {
        const long L = (long)i * G + c; if (L >= nwg) return false;
        int wgid = (int)L; { const int q = nwg / NXCD, r = nwg % NXCD, xcd = wgid % NXCD, off = wgid / NXCD; wgid = (xcd < r ? xcd * (q + 1) : r * (q + 1) + (xcd - r) * q) + off; }
        const int nig = WGM * nN, gid = wgid / nig, fm = gid * WGM, gsz = (nM - fm) < WGM ? (nM - fm) : WGM;
        u.pm = fm + ((wgid % nig) % gsz); u.pn = (wgid % nig) / gsz; return true;
    }
    __device__ __forceinline__ void a_ready(const Unit&) const {}
    __device__ __forceinline__ void done(const Unit&) const {}
};

template <class Epi, class Sched, bool ALIGN_EPI = false, bool SP2 = false>
__device__ __forceinline__ void gemm_phase(PG8_LAS unsigned char* lds, const Gemm g, const Sched& S, const Epi& E) {
    const int tid = opaque_tid512(), wid = __builtin_amdgcn_readfirstlane(tid >> 6), lane = tid & 63, wr = wid >> 2, wc = wid & 3, fr = lane & 15, fq = lane >> 4;
    const int K = g.K, nt = K / BK;
    unsigned voffA2[2][2], voffB[2];
#pragma unroll
    for (int i = 0; i < 2; ++i) { int R, C; stage_rc(tid * 16 + i * 8192, R, C); const int Rb = Epi::PERM ? ((R & ~31) + perm32(R & 31)) : R;
        voffA2[0][i] = (unsigned)(R * g.lda + C) * 2u; voffA2[1][i] = voffA2[0][i]; voffB[i] = (unsigned)(Rb * g.ldb + C) * 2u; }
    const size_t kstepB = (size_t)(BK * 2), kstepA = g.gather ? (size_t)(ZW * 2) : kstepB;
    const size_t hstepA = g.gather ? (size_t)0 : (size_t)HALF * g.lda * 2, hstepB = (size_t)HALF * g.ldb * 2;
    const size_t tstepA = 2 * hstepA, tstepB = 2 * hstepB;
    const unsigned ldsw = (unsigned)wid * 1024u;
    const int aoff = lds_byte(wr * 64 + fr, fq * 8), boff = lds_byte(wc * 32 + fr, fq * 8);
#define PG8_SA(b, h) (((b) * 2 + (h)) * HTB)
#define PG8_SB(b, h) ((4 + (b) * 2 + (h)) * HTB)
#define PG8_STAGE(bufoff, gbase, voff) do { _Pragma("unroll") for (int _i = 0; _i < 2; ++_i) \
        __builtin_amdgcn_global_load_lds((const unsigned*)((const char*)(gbase) + (voff)[_i]), (PG8_LAS unsigned*)(lds + (bufoff) + ldsw + _i * 8192), 16, 0, 0); } while (0)
#define PG8_LDA(dst, b, h) do { _Pragma("unroll") for (int m = 0; m < 4; ++m) _Pragma("unroll") for (int k = 0; k < 2; ++k) dst[m][k] = *(const PG8_LAS bf16x8*)(lds + PG8_SA(b, h) + aoff + m * 2048 + k * 1024); } while (0)
#define PG8_LDB(dst, b, h) do { _Pragma("unroll") for (int n = 0; n < 2; ++n) _Pragma("unroll") for (int k = 0; k < 2; ++k) dst[n][k] = *(const PG8_LAS bf16x8*)(lds + PG8_SB(b, h) + boff + n * 2048 + k * 1024); } while (0)
#define PG8_MMA(ai, bj, At, Bt) do { __builtin_amdgcn_s_setprio(1); _Pragma("unroll") for (int m = 0; m < 4; ++m) _Pragma("unroll") for (int n = 0; n < 2; ++n) _Pragma("unroll") for (int k = 0; k < 2; ++k) \
        acc[ai][bj][m][n] = __builtin_amdgcn_mfma_f32_16x16x32_bf16(Bt[n][k], At[m][k], acc[ai][bj][m][n], 0, 0, 0); __builtin_amdgcn_s_setprio(0); } while (0)
#define PG8_WAIT_V(n) asm volatile("s_waitcnt vmcnt(" #n ")" ::: "memory")
#define PG8_WAIT_L(n) asm volatile("s_waitcnt lgkmcnt(" #n ")" ::: "memory")
#define PG8_BAR __builtin_amdgcn_s_barrier()
#define PG8_SCHED __builtin_amdgcn_sched_barrier(0)
    Unit cur, nxt; int ui = 0;
    if (!S.next(0, cur)) return;
    f32x4 acc[2][2][4][2];
#pragma unroll
    for (int a = 0; a < 2; ++a)
#pragma unroll
        for (int b = 0; b < 2; ++b)
#pragma unroll
            for (int m = 0; m < 4; ++m)
#pragma unroll
                for (int n = 0; n < 2; ++n) acc[a][b][m][n] = (f32x4){0.f, 0.f, 0.f, 0.f};
    bf16x8 At[4][2], B0[2][2], B1[2][2];
    const char* cA = (const char*)g.A + (g.gather ? (size_t)0 : (size_t)cur.pm * tstepA); const char* cB = (const char*)g.Bt + (size_t)cur.pn * tstepB;
    if (g.gather) {
#pragma unroll
        for (int h = 0; h < 2; ++h)
#pragma unroll
            for (int i = 0; i < 2; ++i) { int R, C; stage_rc(tid * 16 + i * 8192, R, C);
                int r = cur.pm * 256 + h * HALF + R; r = r < NCROWS ? r : NCROWS - 1;
                const int bg = r / NCMP, n = r - bg * NCMP;
                voffA2[h][i] = (unsigned)((((bg >> 2) * ::S + 16 * n) * ZW + (cur.pn ? C_VC : C_KC) + (bg & 3) * 64 + C) * 2); }
    }
    S.a_ready(cur);
    if constexpr (SP2) {
        PG8_STAGE(PG8_SB(0, 0), cB, voffB); PG8_STAGE(PG8_SB(0, 1), cB + hstepB, voffB); PG8_STAGE(PG8_SA(0, 0), cA, voffA2[0]); PG8_STAGE(PG8_SA(0, 1), cA + hstepA, voffA2[1]);
        if (wr == 1) PG8_BAR;
        PG8_WAIT_V(2); PG8_BAR;
        PG8_STAGE(PG8_SB(1, 0), cB + kstepB, voffB); PG8_STAGE(PG8_SA(1, 0), cA + kstepA, voffA2[0]); PG8_STAGE(PG8_SB(1, 1), cB + hstepB + kstepB, voffB);
        PG8_WAIT_V(6); PG8_BAR;
    } else {
        PG8_STAGE(PG8_SB(0, 0), cB, voffB); PG8_STAGE(PG8_SA(0, 0), cA, voffA2[0]); PG8_STAGE(PG8_SB(0, 1), cB + hstepB, voffB); PG8_STAGE(PG8_SA(0, 1), cA + hstepA, voffA2[1]);
        if (wr == 1) PG8_BAR;
        PG8_WAIT_V(4); PG8_BAR;
        PG8_STAGE(PG8_SB(1, 0), cB + kstepB, voffB); PG8_STAGE(PG8_SA(1, 0), cA + kstepA, voffA2[0]); PG8_STAGE(PG8_SB(1, 1), cB + hstepB + kstepB, voffB);
        PG8_WAIT_V(6); PG8_BAR;
    }
    for (;;) {
        const bool has_next = S.next(ui + 1, nxt);
        const char* nA = has_next ? (const char*)g.A + (size_t)nxt.pm * tstepA : cA; const char* nB = has_next ? (const char*)g.Bt + (size_t)nxt.pn * tstepB : cB;
        for (int t = 0; t < nt; t += 2) {
            const bool last = (t == nt - 2);
            const char* a1 = cA + (size_t)(t + 1) * kstepA;
            const char* a2 = last ? nA : cA + (size_t)(t + 2) * kstepA; const char* b2 = last ? nB : cB + (size_t)(t + 2) * kstepB;
            const char* a3 = a2 + kstepA; const char* b3 = b2 + kstepB;
            if (last && has_next) S.a_ready(nxt);
            if constexpr (SP2) {
            PG8_LDB(B0, 0, 0); PG8_LDB(B1, 0, 1); PG8_SCHED; PG8_LDA(At, 0, 0); PG8_STAGE(PG8_SA(1, 1), a1 + hstepA, voffA2[1]);
            PG8_WAIT_V(8); PG8_WAIT_L(0); PG8_BAR; PG8_MMA(0, 0, At, B0); PG8_MMA(0, 1, At, B1); PG8_BAR; PG8_SCHED;
            PG8_LDA(At, 0, 1); PG8_STAGE(PG8_SB(0, 0), b2, voffB); PG8_STAGE(PG8_SB(0, 1), b2 + hstepB, voffB); PG8_STAGE(PG8_SA(0, 0), a2, voffA2[0]);
            PG8_WAIT_V(8); PG8_WAIT_L(0); PG8_BAR; PG8_MMA(1, 0, At, B0); PG8_MMA(1, 1, At, B1); PG8_BAR; PG8_SCHED;
            PG8_LDB(B0, 1, 0); PG8_LDB(B1, 1, 1); PG8_SCHED; PG8_LDA(At, 1, 0); PG8_STAGE(PG8_SA(0, 1), a2 + hstepA, voffA2[1]);
            PG8_WAIT_V(8); PG8_WAIT_L(0); PG8_BAR; PG8_MMA(0, 0, At, B0); PG8_MMA(0, 1, At, B1); PG8_BAR; PG8_SCHED;
            PG8_LDA(At, 1, 1); PG8_STAGE(PG8_SB(1, 0), b3, voffB); PG8_STAGE(PG8_SB(1, 1), b3 + hstepB, voffB); PG8_STAGE(PG8_SA(1, 0), a3, voffA2[0]);
            PG8_WAIT_V(8); PG8_WAIT_L(0); PG8_BAR; PG8_MMA(1, 0, At, B0); PG8_MMA(1, 1, At, B1); PG8_BAR; PG8_SCHED;
            } else {
            PG8_LDB(B0, 0, 0); PG8_SCHED; PG8_LDA(At, 0, 0); PG8_STAGE(PG8_SA(1, 1), a1 + hstepA, voffA2[1]);
            PG8_WAIT_L(8); PG8_BAR; PG8_WAIT_L(0); PG8_MMA(0, 0, At, B0); PG8_BAR; PG8_SCHED;
            PG8_LDB(B1, 0, 1); PG8_STAGE(PG8_SB(0, 0), b2, voffB);
            PG8_BAR; PG8_WAIT_L(0); PG8_MMA(0, 1, At, B1); PG8_BAR;
            PG8_LDA(At, 0, 1); PG8_STAGE(PG8_SA(0, 0), a2, voffA2[0]);
            PG8_BAR; PG8_WAIT_L(0); PG8_MMA(1, 0, At, B0); PG8_BAR; PG8_SCHED;
            PG8_STAGE(PG8_SB(0, 1), b2 + hstepB, voffB);
            PG8_WAIT_V(6); PG8_BAR; PG8_MMA(1, 1, At, B1); PG8_BAR;
            PG8_LDB(B0, 1, 0); PG8_SCHED; PG8_LDA(At, 1, 0); PG8_STAGE(PG8_SA(0, 1), a2 + hstepA, voffA2[1]);
            PG8_WAIT_L(8); PG8_BAR; PG8_WAIT_L(0); PG8_MMA(0, 0, At, B0); PG8_BAR; PG8_SCHED;
            PG8_LDB(B1, 1, 1); PG8_STAGE(PG8_SB(1, 0), b3, voffB);
            PG8_BAR; PG8_WAIT_L(0); PG8_MMA(0, 1, At, B1); PG8_BAR;
            PG8_LDA(At, 1, 1); PG8_STAGE(PG8_SA(1, 0), a3, voffA2[0]);
            PG8_BAR; PG8_WAIT_L(0); PG8_MMA(1, 0, At, B0); PG8_BAR; PG8_SCHED;
            PG8_STAGE(PG8_SB(1, 1), b3 + hstepB, voffB);
            PG8_WAIT_V(6); PG8_BAR; PG8_MMA(1, 1, At, B1); PG8_BAR;
            }
        }
        if constexpr (ALIGN_EPI) { if (wr == 0) PG8_BAR; }
        if constexpr (!Epi::AFTER_DRAIN) { E(acc, cur, wr, wc, fr, fq); S.done(cur); }
        if (!has_next) break;
#pragma unroll
        for (int a = 0; a < 2; ++a)
#pragma unroll
            for (int b = 0; b < 2; ++b)
#pragma unroll
                for (int m = 0; m < 4; ++m)
#pragma unroll
                    for (int n = 0; n < 2; ++n) acc[a][b][m][n] = (f32x4){0.f, 0.f, 0.f, 0.f};
        cur = nxt; cA = nA; cB = nB; ++ui;
        if constexpr (ALIGN_EPI) { if (wr == 1) PG8_BAR; }
    }
    PG8_WAIT_V(0);
    if constexpr (!ALIGN_EPI) { if (wr == 0) PG8_BAR; }
    PG8_BAR;
    if constexpr (Epi::AFTER_DRAIN) { E.fused(acc, cur, wr, wc, fr, fq, lds, wid, lane); S.done(cur); }
#undef PG8_SA
#undef PG8_SB
#undef PG8_STAGE
#undef PG8_LDA
#undef PG8_LDB
#undef PG8_MMA
#undef PG8_WAIT_V
#undef PG8_WAIT_L
#undef PG8_BAR
#undef PG8_SCHED
}
}

struct EpiHid {
    bf16_t* H;
    DEV void run(f32x4 (&acc)[8][4], int R0, int C0, int fr, int fq) const {
#pragma unroll
        for (int n = 0; n < 4; ++n)
#pragma unroll
            for (int m = 0; m < 8; ++m) {
                const int c = C0 + n * 16 + 4 * fq, r = R0 + m * 16 + fr;
                f32x4 a = acc[m][n];
#pragma unroll
                for (int j = 0; j < 4; ++j) a[j] = gelu_t(a[j]);
                if (r < NCROWS) *(uint2*)(H + (size_t)r * 256 + c) = pk4(a);
            }
    }
};
#define PG8_EPI_HEAD static constexpr bool PERM = false, AFTER_DRAIN = false;
#define PG8_FOR_TILES _Pragma("unroll") for (int ai = 0; ai < 2; ++ai) _Pragma("unroll") for (int bj = 0; bj < 2; ++bj) _Pragma("unroll") for (int m = 0; m < 4; ++m) _Pragma("unroll") for (int n = 0; n < 2; ++n)
struct PEpiZA {
    PG8_EPI_HEAD
    bf16_t *ZA, *VST, *VWT; const float *ropec, *ropes;
    DEV void operator()(const f32x4 (&acc)[2][2][4][2], const pg8::Unit& u, int wr, int wc, int fr, int fq) const {
        asm volatile("" : "+v"(fr), "+v"(fq));
        PG8_FOR_TILES {
            const int row = u.pm * 256 + ai * 128 + wr * 64 + m * 16 + fr, col0 = u.pn * 256 + bj * 128 + wc * 32 + n * 16;
            f32x4 a = acc[ai][bj][m][n];
            if (u.pn == 17 || u.pn == 18) {
                bf16_t* dst = (u.pn == 17) ? VST : VWT;
                const int c = (col0 & 255) + 4 * fq, b = row >> 11, t = row & 2047;
#pragma unroll
                for (int j = 0; j < 4; ++j) { const int cc = c + j; dst[((size_t)((b * 4 + (cc >> 6)) * 64 + (cc & 63))) * S + t] = f2bf(a[j]); }
            } else {
                const bool rope = (col0 < 1024 || (col0 >= 1536 && col0 < 2048)) && ((col0 & 63) == 0);
                if (rope) {
                    const int t = row & 2047, i0 = 4 * (fq & 1);
                    const float4 cs = *(const float4*)(ropec + t * 8 + i0), sn = *(const float4*)(ropes + t * 8 + i0);
                    const float c4[4] = {cs.x, cs.y, cs.z, cs.w}, s4[4] = {sn.x, sn.y, sn.z, sn.w};
#pragma unroll
                    for (int j = 0; j < 4; ++j) {
                        const float pr = __shfl_xor(a[j], 32);
                        a[j] = (fq & 2) ? (a[j] * c4[j] + pr * s4[j]) : (a[j] * c4[j] - pr * s4[j]);
                    }
                }
                int zc0 = col0;
                if (col0 >= 4864) {
                    zc0 = col0 - 512;
#pragma unroll
                    for (int j = 0; j < 4; ++j) a[j] = sigm(a[j]);
                }
                if (zc0 < ZW) *(uint2*)(ZA + (size_t)row * ZW + zc0 + 4 * fq) = pk4(a);
            }
        }
    }
};
struct PEpiHid {
    PG8_EPI_HEAD
    bf16_t *HK, *HV; const float* pb;
    DEV void operator()(const f32x4 (&acc)[2][2][4][2], const pg8::Unit& u, int wr, int wc, int fr, int fq) const {
        asm volatile("" : "+v"(fr), "+v"(fq));
        bf16_t* H = u.pn ? HV : HK;
        PG8_FOR_TILES {
            const int r = u.pm * 256 + ai * 128 + wr * 64 + m * 16 + fr, c = bj * 128 + wc * 32 + n * 16 + 4 * fq;
            float4 bb = *(const float4*)(pb + (u.pn * 8) * 256 + c);
#pragma unroll
            for (int kc = 1; kc < 8; ++kc) { const float4 t4 = *(const float4*)(pb + (u.pn * 8 + kc) * 256 + c); bb.x += t4.x; bb.y += t4.y; bb.z += t4.z; bb.w += t4.w; }
            f32x4 a = acc[ai][bj][m][n];
            a[0] = gelu_t(a[0] + bb.x); a[1] = gelu_t(a[1] + bb.y); a[2] = gelu_t(a[2] + bb.z); a[3] = gelu_t(a[3] + bb.w);
            if (r < NCROWS) *(uint2*)(H + (size_t)r * 256 + c) = pk4(a);
        }
    }
};
struct PEpiMemKV {
    PG8_EPI_HEAD
    bf16_t *MK, *MVT;
    DEV void operator()(const f32x4 (&acc)[2][2][4][2], const pg8::Unit& u, int wr, int wc, int fr, int fq) const {
        asm volatile("" : "+v"(fr), "+v"(fq));
        PG8_FOR_TILES {
            const int r = u.pm * 256 + ai * 128 + wr * 64 + m * 16 + fr, c = u.pn * 256 + bj * 128 + wc * 32 + n * 16 + 4 * fq;
            const int b = r >> 8, mm = r & 255;
            const f32x4 a = acc[ai][bj][m][n];
            if (u.pn == 0) { const int h = (c >> 6) & 3, d = c & 63; *(uint2*)(MK + ((size_t)(b * 4 + h) * 256 + mm) * 64 + d) = pk4(a); }
            else {
#pragma unroll
                for (int j = 0; j < 4; ++j) { const int cc = c + j, h = (cc >> 6) & 3, d = cc & 63; MVT[((size_t)(b * 4 + h) * 64 + d) * 256 + mm] = f2bf(a[j]); }
            }
        }
    }
};
template <int ACT>
struct PEpiBf {
    PG8_EPI_HEAD
    bf16_t* O; int ldo;
    DEV void operator()(const f32x4 (&acc)[2][2][4][2], const pg8::Unit& u, int wr, int wc, int fr, int fq) const {
        asm volatile("" : "+v"(fr), "+v"(fq));
        PG8_FOR_TILES {
            const int r = u.pm * 256 + ai * 128 + wr * 64 + m * 16 + fr, c = u.pn * 256 + bj * 128 + wc * 32 + n * 16 + 4 * fq;
            f32x4 a = acc[ai][bj][m][n];
            if (ACT == 1) {
#pragma unroll
                for (int j = 0; j < 4; ++j) { const float v = fmaxf(a[j], 0.f); a[j] = v * v; }
            }
            *(uint2*)(O + (size_t)r * ldo + c) = pk4(a);
        }
    }
};
struct PEpiRes {
    PG8_EPI_HEAD
    const float* R; float* O;
    DEV void operator()(const f32x4 (&acc)[2][2][4][2], const pg8::Unit& u, int wr, int wc, int fr, int fq) const {
        asm volatile("" : "+v"(fr), "+v"(fq));
        PG8_FOR_TILES {
            const size_t o = (size_t)(u.pm * 256 + ai * 128 + wr * 64 + m * 16 + fr) * 1024 + u.pn * 256 + bj * 128 + wc * 32 + n * 16 + 4 * fq;
            const f32x4 r = *(const f32x4*)(R + o);
            *(f32x4*)(O + o) = r + acc[ai][bj][m][n];
        }
    }
};
struct PEpiMerge {
    PG8_EPI_HEAD
    const bf16_t *ZA, *YX; bf16_t* Y;
    DEV void operator()(const f32x4 (&acc)[2][2][4][2], const pg8::Unit& u, int wr, int wc, int fr, int fq) const {
        asm volatile("" : "+v"(fr), "+v"(fq));
        const int ch = u.pn * 64 + wc * 16 + 4 * fq;
#pragma unroll
        for (int ai = 0; ai < 2; ++ai)
#pragma unroll
            for (int m = 0; m < 4; ++m) {
                const size_t row = (size_t)(u.pm * 256 + ai * 128 + wr * 64 + m * 16 + fr);
                const uint2 a = *(const uint2*)(ZA + row * ZW + C_Q + ch), b = *(const uint2*)(ZA + row * ZW + C_GR + ch), c = *(const uint2*)(YX + row * 1024 + ch);
                const f32x4 g0 = acc[ai][0][m][0], g1 = acc[ai][0][m][1], g2 = acc[ai][1][m][0];
                f32x4 y;
                y[0] = sigm(g0[0]) * lo_f(a.x) + sigm(g1[0]) * lo_f(b.x) + sigm(g2[0]) * lo_f(c.x);
                y[1] = sigm(g0[1]) * hi_f(a.x) + sigm(g1[1]) * hi_f(b.x) + sigm(g2[1]) * hi_f(c.x);
                y[2] = sigm(g0[2]) * lo_f(a.y) + sigm(g1[2]) * lo_f(b.y) + sigm(g2[2]) * lo_f(c.y);
                y[3] = sigm(g0[3]) * hi_f(a.y) + sigm(g1[3]) * hi_f(b.y) + sigm(g2[3]) * hi_f(c.y);
                *(uint2*)(Y + row * 1024 + ch) = pk4(y);
            }
    }
};

DEV bool tile_map(int idx, int NT, int& pm, int& pn) {
    const int x = idx & 7, pl = (idx >> 3) & 3, pmid = (idx >> 5) & 7, st = idx >> 8;
    pm = pmid * 8 + x;
    pn = st * 4 + pl;
    return pn < NT;
}
DEV int tile_count(int NT) { return ((NT + 3) / 4) * 256; }

DEV void cmp2_job(const Params& P, int job) {
    char* aux = (char*)P.out;
    const int lane = threadIdx.x & 63, w = (threadIdx.x & 255) >> 6;
    const int wj = job * 4 + w;
    const int which = wj >= NCROWS ? 1 : 0;
    const int r = wj - which * NCROWS;
    const int bg = r / NCMP, n = r - bg * NCMP;
    const bf16_t* hid = (const bf16_t*)(aux + (which ? O_HIDV : O_HIDK)) + (size_t)r * 256;
    const float* w2 = which ? P.wv2 : P.wk2;
    float acc = 0.f;
#pragma unroll 8
    for (int k = 0; k < 256; ++k) acc += bf2f(hid[k]) * w2[k * 64 + lane];
    if (!which) {
        const int pos = 16 * n + 31, i = lane & 7;
        const float cs = ((const float*)(aux + O_ROPEC))[pos * 8 + i], sn = ((const float*)(aux + O_ROPES))[pos * 8 + i];
        const float pr = __shfl_xor(acc, 8);
        float o = acc;
        if (lane < 16) o = (lane & 8) ? (acc * cs + pr * sn) : (acc * cs - pr * sn);
        bf16_t* KC = (bf16_t*)(aux + O_KC);
        KC[((size_t)bg * 128 + n) * 64 + lane] = f2bf(o);
        if (n == NCMP - 1) KC[((size_t)bg * 128 + 127) * 64 + lane] = 0;
    } else {
        bf16_t* VCT = (bf16_t*)(aux + O_VCT);
        VCT[((size_t)bg * 64 + lane) * 128 + n] = f2bf(acc);
        if (n == NCMP - 1) VCT[((size_t)bg * 64 + lane) * 128 + 127] = 0;
    }
}

DEV void rnn_job(const Params& P, int job, char* smem, bool dry) {
    char* aux = (char*)P.out;
    bf16_t* ZA = (bf16_t*)(P.ws + W_ZA);
    const int b = job >> 6, n = (job >> 2) & 15, ct = job & 3;
    const int t512 = opaque_tid512(), sub = t512 >> 8;
    char* sh = smem - sub * 56320;
    bf16_t* sX = (bf16_t*)sh;
    float* sCw = (float*)(sh + 9216);
    bf16_t* sRaw = (bf16_t*)(sh + 10496);
    bf16_t* sRaw2 = sRaw + 67 * 72;
    float* sXf = (float*)(smem + 32768);
    float* sSum = (float*)(smem + 37120);
    const int tid = t512 & 255, w = tid >> 6, lane = tid & 63, fr = lane & 15, fq = lane >> 4;
    const bf16_t* WAT = (const bf16_t*)(aux + O_WAT) + n * 4096;
    const bf16_t* WIT = (const bf16_t*)(aux + O_WIT) + n * 4096;
    bf16x8 wa[2], wi[2];
#pragma unroll
    for (int ks = 0; ks < 2; ++ks) {
        wa[ks] = *(const bf16x8*)(WAT + (16 * ct + fr) * 64 + 32 * ks + 8 * fq);
        wi[ks] = *(const bf16x8*)(WIT + (16 * ct + fr) * 64 + 32 * ks + 8 * fq);
    }
    const int c = n * 64 + 16 * ct + fr;
    const float ba = P.b_a[c], bi = P.b_i[c], cl = -8.0f * log1pf(__expf(-P.lam[c]));
    float carry = 0.f;
    __syncthreads();
    for (int i = t512; i < 320; i += 512) sCw[i] = (i < 256) ? P.conv_w[(i >> 6) * 1024 + n * 64 + (i & 63)] : P.conv_b[n * 64 + (i & 63)];
    const int lt = t512 >> 3, c8 = (t512 & 7) * 8;
    const int dct = (c8 >> 4) - (ct & ~1);
    float* sXfT = (float*)(sh + (dct == 1 ? 56320 : 0) + 32768);
    const bf16_t* xbase = ZA + (size_t)(b * S) * ZW + C_XR + n * 64 + c8;
    u32x4 xm, xh = {0u, 0u, 0u, 0u};
    xm = *(const u32x4*)(xbase + (size_t)lt * ZW);
    *(u32x4*)(sRaw + (lt + 3) * 72 + c8) = xm;
    if (t512 < 24) *(u32x4*)(sRaw + lt * 72 + c8) = xh;
    xm = *(const u32x4*)(xbase + (size_t)(64 + lt) * ZW);
    if (t512 < 24) xh = *(const u32x4*)(xbase + (size_t)(61 + lt) * ZW);
    __syncthreads();
#pragma unroll 1
    for (int chunk = 0; chunk < 32; ++chunk) {
        const int tc = chunk * 64;
        const bf16_t* rawc = (chunk & 1) ? sRaw2 : sRaw;
        bf16_t* rawn = (chunk & 1) ? sRaw : sRaw2;
        bf16_t gv[4];
#pragma unroll
        for (int j = 0; j < 4; ++j) gv[j] = ZA[(size_t)(b * S + tc + 16 * w + 4 * fq + j) * ZW + C_GR + n * 64 + 16 * ct + fr];
        {
            float xv[8];
            { const float4 b0 = *(const float4*)(sCw + 256 + c8), b1 = *(const float4*)(sCw + 256 + c8 + 4);
              xv[0] = b0.x; xv[1] = b0.y; xv[2] = b0.z; xv[3] = b0.w; xv[4] = b1.x; xv[5] = b1.y; xv[6] = b1.z; xv[7] = b1.w; }
#pragma unroll
            for (int k = 0; k < 4; ++k) {
                const u32x4 v = *(const u32x4*)(rawc + (lt + k) * 72 + c8);
                const float4 w0 = *(const float4*)(sCw + k * 64 + c8), w1 = *(const float4*)(sCw + k * 64 + c8 + 4);
                xv[0] += w0.x * lo_f(v.x); xv[1] += w0.y * hi_f(v.x); xv[2] += w0.z * lo_f(v.y); xv[3] += w0.w * hi_f(v.y);
                xv[4] += w1.x * lo_f(v.z); xv[5] += w1.y * hi_f(v.z); xv[6] += w1.z * lo_f(v.w); xv[7] += w1.w * hi_f(v.w);
            }
            if (dct == 0 || dct == 1) {
#pragma unroll
                for (int e = 0; e < 8; ++e) sXfT[lt * 17 + (c8 & 15) + e] = xv[e];
            }
            u32x4 o0 = {pk2(xv[0], xv[1]), pk2(xv[2], xv[3]), pk2(xv[4], xv[5]), pk2(xv[6], xv[7])};
            *(u32x4*)(sX + lt * 72 + c8) = o0;
        }
        __syncthreads();
        f32x4 R = (f32x4){0.f, 0.f, 0.f, 0.f}, I = (f32x4){0.f, 0.f, 0.f, 0.f};
#pragma unroll
        for (int ks = 0; ks < 2; ++ks) {
            const bf16x8 af = *(const bf16x8*)(sX + (16 * w + fr) * 72 + 32 * ks + 8 * fq);
            R = MFMA16(af, wa[ks], R); I = MFMA16(af, wi[ks], I);
        }
        if (chunk + 1 < 32) {
            *(u32x4*)(rawn + (lt + 3) * 72 + c8) = xm;
            if (t512 < 24) *(u32x4*)(rawn + lt * 72 + c8) = xh;
        }
        float hl[4], pc[4];
        float h = 0.f, pcum = 1.f;
#pragma unroll
        for (int j = 0; j < 4; ++j) {
            const float xcv = sXf[(16 * w + 4 * fq + j) * 17 + fr];
            const float rg = sigm(R[j] + ba), gi = sigm(I[j] + bi);
            const float la = rg * cl;
            const float a_ = __expf(la);
            const float mult = sqrtf(fmaxf(1.f - a_ * a_, 0.f));
            const float u = mult * gi * xcv;
            h = a_ * h + u; pcum *= a_;
            hl[j] = h; pc[j] = pcum;
        }
        float A = pcum, H = h;
        float A1 = __shfl_up(A, 16), H1 = __shfl_up(H, 16);
        if (fq >= 1) { H = A * H1 + H; A = A * A1; }
        float A2 = __shfl_up(A, 32), H2 = __shfl_up(H, 32);
        if (fq >= 2) { H = A * H2 + H; A = A * A2; }
        float Ax = __shfl_up(A, 16), Hx = __shfl_up(H, 16);
        const float Ae = fq == 0 ? 1.f : Ax, He = fq == 0 ? 0.f : Hx;
        if (fq == 3) { sSum[w * 16 + fr] = A; sSum[64 + w * 16 + fr] = H; }
        __syncthreads();
        if (chunk + 2 < 32) {
            xm = *(const u32x4*)(xbase + (size_t)(tc + 128 + lt) * ZW);
            if (t512 < 24) xh = *(const u32x4*)(xbase + (size_t)(tc + 125 + lt) * ZW);
        }
        float cin = carry, mycin = 0.f;
#pragma unroll
        for (int ww = 0; ww < 4; ++ww) {
            if (ww == w) mycin = cin;
            cin = sSum[ww * 16 + fr] * cin + sSum[64 + ww * 16 + fr];
        }
        carry = cin;
        const float sq = Ae * mycin + He;
#pragma unroll
        for (int j = 0; j < 4; ++j) {
            const float hfin = hl[j] + pc[j] * sq;
            const size_t grow = (size_t)(b * S + tc + 16 * w + 4 * fq + j);
            bf16_t* op = dry ? ((bf16_t*)(P.ws + W_YX) + grow * 1024 + n * 64 + 16 * ct + fr) : (ZA + grow * ZW + C_GR + n * 64 + 16 * ct + fr);
            *op = f2bf(gelu_t(bf2f(gv[j])) * hfin);
        }
    }
}

constexpr float EXPC = 0.125f * 1.4426950408889634f;
struct AttnAcc { f32x4 o[4][2]; float m[2], l[2]; };
DEV void attn_init(AttnAcc& a) {
#pragma unroll
    for (int d = 0; d < 4; ++d)
#pragma unroll
        for (int q = 0; q < 2; ++q) a.o[d][q] = (f32x4){0.f, 0.f, 0.f, 0.f};
    a.m[0] = a.m[1] = -INFINITY; a.l[0] = a.l[1] = 0.f;
}
DEV bf16x8 mk8(unsigned a, unsigned b, unsigned c, unsigned d) { u32x4 u = {a, b, c, d}; return __builtin_bit_cast(bf16x8, u); }

template <class MF>
DEV void attn_step(const bf16_t* sK, const bf16_t* sVt, int vstride, const bf16x8 (&qf)[2][2], AttnAcc& st, const MF& mf, int fr, int fq) {
    f32x4 s[4][2];
#pragma unroll
    for (int kt = 0; kt < 4; ++kt) {
        s[kt][0] = (f32x4){0.f, 0.f, 0.f, 0.f}; s[kt][1] = (f32x4){0.f, 0.f, 0.f, 0.f};
#pragma unroll
        for (int ks = 0; ks < 2; ++ks) {
            const bf16x8 kf = *(const bf16x8*)(sK + (16 * kt + fr) * 80 + 32 * ks + 8 * fq);
            s[kt][0] = MFMA16(kf, qf[0][ks], s[kt][0]);
            s[kt][1] = MFMA16(kf, qf[1][ks], s[kt][1]);
        }
    }
#pragma unroll
    for (int qt = 0; qt < 2; ++qt) {
        float ps = 0.f;
#pragma unroll
        for (int kt = 0; kt < 4; ++kt)
#pragma unroll
            for (int j = 0; j < 4; ++j) {
                const float p = mf(qt, 16 * kt + 4 * fq + j) ? __builtin_amdgcn_exp2f(s[kt][qt][j] * EXPC) : 0.f;
                s[kt][qt][j] = p; ps += p;
            }
        st.l[qt] += ps;
    }
#pragma unroll
    for (int ks = 0; ks < 2; ++ks) {
        bf16x8 pf[2];
#pragma unroll
        for (int qt = 0; qt < 2; ++qt)
            pf[qt] = mk8(pk2(s[2 * ks][qt][0], s[2 * ks][qt][1]), pk2(s[2 * ks][qt][2], s[2 * ks][qt][3]),
                         pk2(s[2 * ks + 1][qt][0], s[2 * ks + 1][qt][1]), pk2(s[2 * ks + 1][qt][2], s[2 * ks + 1][qt][3]));
#pragma unroll
        for (int dt = 0; dt < 4; ++dt) {
            const u32x2 v0 = *(const u32x2*)(sVt + (16 * dt + fr) * vstride + 32 * ks + 4 * fq);
            const u32x2 v1 = *(const u32x2*)(sVt + (16 * dt + fr) * vstride + 32 * ks + 16 + 4 * fq);
            const bf16x8 vf = mk8(v0.x, v0.y, v1.x, v1.y);
            st.o[dt][0] = MFMA16(vf, pf[0], st.o[dt][0]);
            st.o[dt][1] = MFMA16(vf, pf[1], st.o[dt][1]);
        }
    }
}
DEV void attn_step_fast(const bf16_t* sK, const bf16_t* sVt, const bf16x8 (&qf)[2][2], AttnAcc& st, const float (&bitoff)[2], int fr, int fq) {
    f32x4 s[4][2];
#pragma unroll
    for (int kt = 0; kt < 4; ++kt) {
        s[kt][0] = (f32x4){0.f, 0.f, 0.f, 0.f}; s[kt][1] = (f32x4){0.f, 0.f, 0.f, 0.f};
#pragma unroll
        for (int ks = 0; ks < 2; ++ks) {
            const bf16x8 kf = *(const bf16x8*)(sK + (16 * kt + fr) * 80 + 32 * ks + 8 * fq);
            s[kt][0] = MFMA16(kf, qf[0][ks], s[kt][0]);
            s[kt][1] = MFMA16(kf, qf[1][ks], s[kt][1]);
        }
    }
#pragma unroll
    for (int qt = 0; qt < 2; ++qt) {
        const float off = bitoff[qt];
        float ps = 0.f;
#pragma unroll
        for (int kt = 0; kt < 4; ++kt)
#pragma unroll
            for (int j = 0; j < 4; ++j) { const float p = __builtin_amdgcn_exp2f(fmaf(s[kt][qt][j], EXPC, off)); s[kt][qt][j] = p; ps += p; }
        st.l[qt] += ps;
    }
#pragma unroll
    for (int ks = 0; ks < 2; ++ks) {
        bf16x8 pf[2];
#pragma unroll
        for (int qt = 0; qt < 2; ++qt)
            pf[qt] = mk8(pk2(s[2 * ks][qt][0], s[2 * ks][qt][1]), pk2(s[2 * ks][qt][2], s[2 * ks][qt][3]),
                         pk2(s[2 * ks + 1][qt][0], s[2 * ks + 1][qt][1]), pk2(s[2 * ks + 1][qt][2], s[2 * ks + 1][qt][3]));
#pragma unroll
        for (int dt = 0; dt < 4; ++dt) {
            const u32x2 v0 = *(const u32x2*)(sVt + (16 * dt + fr) * 72 + 32 * ks + 4 * fq);
            const u32x2 v1 = *(const u32x2*)(sVt + (16 * dt + fr) * 72 + 32 * ks + 16 + 4 * fq);
            const bf16x8 vf = mk8(v0.x, v0.y, v1.x, v1.y);
            st.o[dt][0] = MFMA16(vf, pf[0], st.o[dt][0]);
            st.o[dt][1] = MFMA16(vf, pf[1], st.o[dt][1]);
        }
    }
}
template <int QT>
DEV void attn_half_fast(const bf16_t* sK, const bf16_t* sVt, const bf16x8 (&qf)[2][2], AttnAcc& st, float bitoff, int fr, int fq) {
    f32x4 s[4];
#pragma unroll
    for (int kt = 0; kt < 4; ++kt) {
        s[kt] = (f32x4){0.f, 0.f, 0.f, 0.f};
#pragma unroll
        for (int ks = 0; ks < 2; ++ks) {
            const bf16x8 kf = *(const bf16x8*)(sK + (16 * kt + fr) * 80 + 32 * ks + 8 * fq);
            s[kt] = MFMA16(kf, qf[QT][ks], s[kt]);
        }
    }
    const float off = bitoff;
    float ps = 0.f;
#pragma unroll
    for (int kt = 0; kt < 4; ++kt)
#pragma unroll
        for (int j = 0; j < 4; ++j) { const float p = __builtin_amdgcn_exp2f(fmaf(s[kt][j], EXPC, off)); s[kt][j] = p; ps += p; }
    st.l[QT] += ps;
#pragma unroll
    for (int ks = 0; ks < 2; ++ks) {
        const bf16x8 pf = mk8(pk2(s[2 * ks][0], s[2 * ks][1]), pk2(s[2 * ks][2], s[2 * ks][3]), pk2(s[2 * ks + 1][0], s[2 * ks + 1][1]), pk2(s[2 * ks + 1][2], s[2 * ks + 1][3]));
#pragma unroll
        for (int dt = 0; dt < 4; ++dt) {
            const u32x2 v0 = *(const u32x2*)(sVt + (16 * dt + fr) * 72 + 32 * ks + 4 * fq);
            const u32x2 v1 = *(const u32x2*)(sVt + (16 * dt + fr) * 72 + 32 * ks + 16 + 4 * fq);
            st.o[dt][QT] = MFMA16(mk8(v0.x, v0.y, v1.x, v1.y), pf, st.o[dt][QT]);
        }
    }
}
DEV void attn_fold_out(bf16_t* const (&op)[2], const AttnAcc& st, const float (&gate)[2]) {
#pragma unroll
    for (int qt = 0; qt < 2; ++qt) {
        float l = st.l[qt];
        l += __shfl_xor(l, 16); l += __shfl_xor(l, 32);
        const float sc = gate[qt] * __builtin_amdgcn_rcpf(fmaxf(l, 1e-30f));
#pragma unroll
        for (int dt = 0; dt < 4; ++dt) {
            const uint2 pv = *(const uint2*)(op[qt] + 16 * dt);
            f32x4 r = st.o[dt][qt] * sc;
            r[0] += lo_f(pv.x); r[1] += hi_f(pv.x); r[2] += lo_f(pv.y); r[3] += hi_f(pv.y);
            *(uint2*)(op[qt] + 16 * dt) = make_uint2(pk2(r[0], r[1]), pk2(r[2], r[3]));
        }
    }
}
DEV void attn_fold(f32x4 (&tot)[4][2], const AttnAcc& st, const float (&gate)[2]) {
#pragma unroll
    for (int qt = 0; qt < 2; ++qt) {
        float l = st.l[qt];
        l += __shfl_xor(l, 16); l += __shfl_xor(l, 32);
        const float sc = gate[qt] * __builtin_amdgcn_rcpf(fmaxf(l, 1e-30f));
#pragma unroll
        for (int dt = 0; dt < 4; ++dt) tot[dt][qt] += st.o[dt][qt] * sc;
    }
}
DEV void ld64(u32x4 (&r)[2], const bf16_t* src, size_t sstride, int tid) {
#pragma unroll
    for (int i = 0; i < 2; ++i) { const int c = tid + 256 * i; r[i] = *(const u32x4*)(src + (size_t)(c >> 3) * sstride + (c & 7) * 8); }
}
DEV void st64(bf16_t* dst, const u32x4 (&r)[2], int tid, int stride) {
#pragma unroll
    for (int i = 0; i < 2; ++i) { const int c = tid + 256 * i; *(u32x4*)(dst + (c >> 3) * stride + (c & 7) * 8) = r[i]; }
}

#define OUTP(QT) ((dry ? (bf16_t*)(P.ws + W_YX) + (size_t)(b * S + tq[QT]) * 1024 : ZA + (size_t)(b * S + tq[QT]) * ZW + C_Q) + head * 64 + 4 * fq)
#define LOAD_GATE(G2, BR) float G2[2]; { G2[0] = bf2f(ZA[(size_t)(b * S + tq[0]) * ZW + C_G + head * 3 + (BR)]); G2[1] = bf2f(ZA[(size_t)(b * S + tq[1]) * ZW + C_G + head * 3 + (BR)]); }
DEV u32x4 ld64w(const bf16_t* src, size_t sstride, int t512) { return *(const u32x4*)(src + (size_t)(t512 >> 3) * sstride + (t512 & 7) * 8); }
DEV void st64w(bf16_t* dst, const u32x4& r, int t512, int stride) { *(u32x4*)(dst + (t512 >> 3) * stride + (t512 & 7) * 8) = r; }
struct MaskAll { DEV bool operator()(int, int) const { return true; } };
struct MaskSel { unsigned bit[2]; int t[2]; int k0; DEV bool operator()(int qt, int kk) const { return bit[qt] && (k0 + kk <= t[qt]); } };
struct MaskWin { int t[2]; int k0; DEV bool operator()(int qt, int kk) const { const int k = k0 + kk; return k <= t[qt] && k > t[qt] - 512; } };

DEV void xattn_job(const Params& P, int job, char* smem, bool dry) {
    char* aux = (char*)P.out;
    bf16_t* ZA = (bf16_t*)(P.ws + W_ZA);
    const int qb = job & 15, h = (job >> 4) & 3, b = job >> 6;
    bf16_t* sK = (bf16_t*)smem;
    bf16_t* sVt = sK + 64 * 80;
    const int tid = opaque_tid(), w = tid >> 6, lane = tid & 63, fr = lane & 15, fq = lane >> 4;
    const int t0 = qb * 128 + w * 32;
    bf16x8 qf[2][2];
#pragma unroll
    for (int qt = 0; qt < 2; ++qt)
#pragma unroll
        for (int ks = 0; ks < 2; ++ks) qf[qt][ks] = *(const bf16x8*)(ZA + (size_t)(b * S + t0 + 16 * qt + fr) * ZW + C_QX + h * 64 + 32 * ks + 8 * fq);
    const bf16_t* MK = (const bf16_t*)(aux + O_MEMK) + (size_t)(b * 4 + h) * 256 * 64;
    const bf16_t* MVT = (const bf16_t*)(aux + O_MEMVT) + (size_t)(b * 4 + h) * 64 * 256;
    AttnAcc st; attn_init(st);
    u32x4 rk[2], rv[2];
    ld64(rk, MK, 64, tid); ld64(rv, MVT, 256, tid);
#pragma unroll 1
    for (int jb = 0; jb < 4; ++jb) {
        __syncthreads();
        st64(sK, rk, tid, 80); st64(sVt, rv, tid, 72);
        __syncthreads();
        if (jb + 1 < 4) { ld64(rk, MK + (size_t)(jb + 1) * 64 * 64, 64, tid); ld64(rv, MVT + (jb + 1) * 64, 256, tid); }
        __builtin_amdgcn_sched_barrier(0);
        { const float z2[2] = {0.f, 0.f}; attn_step_fast(sK, sVt, qf, st, z2, fr, fq); }
    }
    f32x4 tot[4][2];
#pragma unroll
    for (int dt = 0; dt < 4; ++dt) { tot[dt][0] = (f32x4){0.f, 0.f, 0.f, 0.f}; tot[dt][1] = (f32x4){0.f, 0.f, 0.f, 0.f}; }
    const float one[2] = {1.f, 1.f};
    attn_fold(tot, st, one);
#pragma unroll
    for (int qt = 0; qt < 2; ++qt)
#pragma unroll
        for (int dt = 0; dt < 4; ++dt)
            *(uint2*)((dry ? (bf16_t*)(P.ws + W_Y) + (size_t)(b * S + t0 + 16 * qt + fr) * 1024 : ZA + (size_t)(b * S + t0 + 16 * qt + fr) * ZW + C_QX) + h * 64 + 16 * dt + 4 * fq) =
                make_uint2(pk2(tot[dt][qt][0], tot[dt][qt][1]), pk2(tot[dt][qt][2], tot[dt][qt][3]));
}

DEV void nsa_job(const Params& P, int job, char* smem, bool dry) {
    char* aux = (char*)P.out;
    bf16_t* ZA = (bf16_t*)(P.ws + W_ZA);
    const int pj_ = job >> 1, bg = pj_ & 31, qb = 63 - (2 * (pj_ >> 5) + (job & 1)), b = bg >> 2, g = bg & 3, t0 = qb * 32;
    bf16_t* sK = (bf16_t*)smem;
    bf16_t* sVt = (bf16_t*)(smem + 20480);
    float* sImp = (float*)(smem + 38912);
    unsigned* sSel = (unsigned*)(smem + 38912 + 4096);
    constexpr int KVBUF = 9728;
    const int tid = opaque_tid(), w = tid >> 6, lane = tid & 63, fr = lane & 15, fq = lane >> 4;
    const int head = g * 4 + (fr & 3);
    const int qi0 = 8 * w + (fr >> 2);
    int tq[2];
    bf16x8 qf[2][2];
#pragma unroll
    for (int qt = 0; qt < 2; ++qt) {
        tq[qt] = t0 + qi0 + 4 * qt;
        const bf16_t* rowp = ZA + (size_t)(b * S + tq[qt]) * ZW;
#pragma unroll
        for (int ks = 0; ks < 2; ++ks) qf[qt][ks] = *(const bf16x8*)(rowp + C_Q + head * 64 + 32 * ks + 8 * fq);
    }
    f32x4 tot[4][2];
#pragma unroll
    for (int dt = 0; dt < 4; ++dt) { tot[dt][0] = (f32x4){0.f, 0.f, 0.f, 0.f}; tot[dt][1] = (f32x4){0.f, 0.f, 0.f, 0.f}; }

    {
        const bf16_t* KC = (const bf16_t*)(aux + O_KC) + (size_t)bg * 128 * 64;
        const bf16_t* VCT = (const bf16_t*)(aux + O_VCT) + (size_t)bg * 64 * 128;
        __syncthreads();
#pragma unroll
        for (int i = 0; i < 4; ++i) {
            const int c = tid + 256 * i;
            { const int r = c >> 3, k = (c & 7) * 8; *(u32x4*)(sK + r * 80 + k) = *(const u32x4*)(KC + r * 64 + k); }
            { const int r = c >> 4, k = (c & 15) * 8; *(u32x4*)(sVt + r * 136 + k) = *(const u32x4*)(VCT + r * 128 + k); }
        }
        __syncthreads();
#pragma unroll
        for (int qt = 0; qt < 2; ++qt) {
            const float g0 = bf2f(ZA[(size_t)(b * S + tq[qt]) * ZW + C_G + head * 3 + 0]);
            f32x4 s[8];
#pragma unroll
            for (int kt = 0; kt < 8; ++kt) {
                s[kt] = (f32x4){0.f, 0.f, 0.f, 0.f};
#pragma unroll
                for (int ks = 0; ks < 2; ++ks) {
                    const bf16x8 kf = *(const bf16x8*)(sK + (16 * kt + fr) * 80 + 32 * ks + 8 * fq);
                    s[kt] = MFMA16(kf, qf[qt][ks], s[kt]);
                }
            }
            float mx = -INFINITY;
#pragma unroll
            for (int kt = 0; kt < 8; ++kt)
#pragma unroll
                for (int j = 0; j < 4; ++j) {
                    const int n = 16 * kt + 4 * fq + j;
                    const float v = (n < NCMP && 16 * n + 31 <= tq[qt]) ? s[kt][j] : -INFINITY;
                    s[kt][j] = v; mx = fmaxf(mx, v);
                }
            mx = fmaxf(mx, __shfl_xor(mx, 16)); mx = fmaxf(mx, __shfl_xor(mx, 32));
            const float msub = (mx == -INFINITY) ? 0.f : mx;
            float ps = 0.f;
#pragma unroll
            for (int kt = 0; kt < 8; ++kt)
#pragma unroll
                for (int j = 0; j < 4; ++j) { const float p = __builtin_amdgcn_exp2f((s[kt][j] - msub) * EXPC); s[kt][j] = p; ps += p; }
            ps += __shfl_xor(ps, 16); ps += __shfl_xor(ps, 32);
            const float inv = __builtin_amdgcn_rcpf(fmaxf(ps, 1e-30f));
            float bprev = 0.f;
#pragma unroll
            for (int kt = 0; kt < 8; ++kt) {
                s[kt] *= inv;
                const float a = s[kt][0] + s[kt][1] + s[kt][2] + 0.5f * s[kt][3];
                const float bq = 0.5f * s[kt][3];
                const float x = __shfl(bq, (lane + 48) & 63);
                const float y = __shfl(bprev, (lane + 48) & 63);
                float iv = a + (fq > 0 ? x : y);
                iv += __shfl_xor(iv, 1); iv += __shfl_xor(iv, 2);
                if ((fr & 3) == 0) sImp[(qi0 + 4 * qt) * 32 + 4 * kt + fq] = iv;
                bprev = bq;
            }
#pragma unroll
            for (int ks = 0; ks < 4; ++ks) {
                const f32x4 pa = s[2 * ks] * g0, pb = s[2 * ks + 1] * g0;
                const bf16x8 pf = mk8(pk2(pa[0], pa[1]), pk2(pa[2], pa[3]), pk2(pb[0], pb[1]), pk2(pb[2], pb[3]));
#pragma unroll
                for (int dt = 0; dt < 4; ++dt) {
                    const u32x2 v0 = *(const u32x2*)(sVt + (16 * dt + fr) * 136 + 32 * ks + 4 * fq);
                    const u32x2 v1 = *(const u32x2*)(sVt + (16 * dt + fr) * 136 + 32 * ks + 16 + 4 * fq);
                    tot[dt][qt] = MFMA16(mk8(v0.x, v0.y, v1.x, v1.y), pf, tot[dt][qt]);
                }
            }
            __builtin_amdgcn_sched_barrier(0);
        }
    }
#pragma unroll
    for (int qt = 0; qt < 2; ++qt) {
        bf16_t* op = (dry ? (bf16_t*)(P.ws + W_YX) + (size_t)(b * S + tq[qt]) * 1024 : ZA + (size_t)(b * S + tq[qt]) * ZW + C_Q) + head * 64 + 4 * fq;
#pragma unroll
        for (int dt = 0; dt < 4; ++dt) *(uint2*)(op + 16 * dt) = pk4(tot[dt][qt]);
    }
    __syncthreads();
    {
        float myv[4];
#pragma unroll
        for (int i = 0; i < 4; ++i) {
            const int pidx = tid + 256 * i, q = pidx >> 5, m = pidx & 31;
            const int t = t0 + q, cur = t >> 6;
            const float sum = sImp[q * 32 + m];
            const bool forced = (m == 0) || (m == cur) || (m == cur - 1);
            const bool future = m * 64 > t;
            myv[i] = forced ? INFINITY : (future ? -INFINITY : sum);
        }
        if (tid == 0) sSel[32] = 0u;
        __syncthreads();
#pragma unroll
        for (int i = 0; i < 4; ++i) { const int pidx = tid + 256 * i; sImp[pidx] = myv[i]; }
        __syncthreads();
        unsigned wun = 0u;
#pragma unroll
        for (int i = 0; i < 4; ++i) {
            const int pidx = tid + 256 * i, q = pidx >> 5, m = pidx & 31;
            const float v = myv[i];
            int rank = 0;
#pragma unroll
            for (int m2 = 0; m2 < 32; ++m2) {
                const float o = sImp[q * 32 + m2];
                rank += (o > v || (o == v && m2 < m)) ? 1 : 0;
            }
            const bool selb = (rank < 8) && (v > -INFINITY);
            const unsigned long long bal = __ballot(selb);
            const unsigned mk = (unsigned)(bal >> (32 * (lane >> 5)));
            if ((lane & 31) == 0) sSel[q] = mk;
            wun |= (unsigned)bal | (unsigned)(bal >> 32);
        }
        if (lane == 0) atomicOr(&sSel[32], wun);
    }
    __syncthreads();
    __shared__ unsigned s_xuni[2];
    if (tid == 0) s_xuni[threadIdx.x >> 8] = sSel[32];
    __syncthreads();
    const unsigned uni = s_xuni[0] | s_xuni[1];
    const int jmax = (t0 + 31) >> 6;
    const int t512 = opaque_tid512();
    bf16_t* shKV = (bf16_t*)(smem - (t512 >> 8) * 56320);
    {
        AttnAcc st; attn_init(st);
        const bf16_t* Kb = ZA + (size_t)(b * S) * ZW + C_KS + g * 64;
        const bf16_t* Vb = (const bf16_t*)(P.ws + W_VST) + (size_t)bg * 64 * S;
        unsigned rem = uni & ((2u << jmax) - 1u);
        u32x4 rk, rv;
        if (rem) { const int j0 = __builtin_ctz(rem); rk = ld64w(Kb + (size_t)(j0 * 64) * ZW, ZW, t512); rv = ld64w(Vb + j0 * 64, S, t512); }
        __syncthreads();
        int it = 0;
#pragma unroll 1
        while (rem) {
            const int jb = __builtin_ctz(rem);
            rem &= rem - 1u;
            bf16_t* sKb = shKV + (it & 1) * KVBUF; bf16_t* sVb = sKb + 64 * 80; ++it;
            st64w(sKb, rk, t512, 80); st64w(sVb, rv, t512, 72);
            __syncthreads();
            if (rem) { const int jn = __builtin_ctz(rem); rk = ld64w(Kb + (size_t)(jn * 64) * ZW, ZW, t512); rv = ld64w(Vb + jn * 64, S, t512); }
            __builtin_amdgcn_sched_barrier(0);
            const unsigned b0 = (sSel[qi0] >> jb) & 1u, b1 = (sSel[qi0 + 4] >> jb) & 1u;
            if (jb * 64 + 63 <= t0) {
                const bool need0 = __builtin_amdgcn_ballot_w64(b0 != 0u) != 0ull, need1 = __builtin_amdgcn_ballot_w64(b1 != 0u) != 0ull;
                const float bo[2] = {b0 ? 0.f : -INFINITY, b1 ? 0.f : -INFINITY};
                if (need0 && need1) attn_step_fast(sKb, sVb, qf, st, bo, fr, fq);
                else if (need0) attn_half_fast<0>(sKb, sVb, qf, st, bo[0], fr, fq);
                else if (need1) attn_half_fast<1>(sKb, sVb, qf, st, bo[1], fr, fq);
            } else {
                MaskSel mf; mf.bit[0] = b0; mf.bit[1] = b1; mf.t[0] = tq[0]; mf.t[1] = tq[1]; mf.k0 = jb * 64;
                attn_step(sKb, sVb, 72, qf, st, mf, fr, fq);
            }
        }
        { LOAD_GATE(g1, 1) bf16_t* const op2[2] = {OUTP(0), OUTP(1)}; attn_fold_out(op2, st, g1); }
    }
    {
        AttnAcc st; attn_init(st);
        const bf16_t* Kb = ZA + (size_t)(b * S) * ZW + C_KW + g * 64;
        const bf16_t* Vb = (const bf16_t*)(P.ws + W_VWT) + (size_t)bg * 64 * S;
#pragma unroll
        for (int qt = 0; qt < 2; ++qt) {
            const int npad = 511 - tq[qt];
            if (npad > 0) { st.m[qt] = 0.f; st.l[qt] = (fq == 0) ? (float)npad : 0.f; }
        }
        int jlo = t0 - 511; jlo = jlo < 0 ? 0 : (jlo >> 6);
        u32x4 rk = ld64w(Kb + (size_t)(jlo * 64) * ZW, ZW, t512), rv = ld64w(Vb + jlo * 64, S, t512);
        __syncthreads();
#pragma unroll 1
        for (int jb = jlo; jb <= jmax; ++jb) {
            bf16_t* sKb = shKV + ((jb - jlo) & 1) * KVBUF; bf16_t* sVb = sKb + 64 * 80;
            st64w(sKb, rk, t512, 80); st64w(sVb, rv, t512, 72);
            __syncthreads();
            if (jb < jmax) { rk = ld64w(Kb + (size_t)((jb + 1) * 64) * ZW, ZW, t512); rv = ld64w(Vb + (jb + 1) * 64, S, t512); }
            __builtin_amdgcn_sched_barrier(0);
            if (jb * 64 + 63 <= t0 && jb * 64 > t0 + 31 - 512) {
                const float z2[2] = {0.f, 0.f};
                attn_step_fast(sKb, sVb, qf, st, z2, fr, fq);
            } else {
                MaskWin mf; mf.t[0] = tq[0]; mf.t[1] = tq[1]; mf.k0 = jb * 64;
                attn_step(sKb, sVb, 72, qf, st, mf, fr, fq);
            }
        }
        { LOAD_GATE(g2, 2) bf16_t* const op2[2] = {OUTP(0), OUTP(1)}; attn_fold_out(op2, st, g2); }
    }
}


#define XB_TMO      128
#define XB_XCNT(j)  (256  + 64 * (j))
#define XB_XSUB(j)  (1280 + 64 * (j))
#define XB_XGEN(j)  (2304 + 64 * (j))
#define XB_TOP      3328
#define XB_TOPGEN   3392
#define XCD_BAR_WORDS 3456
#define XB_SPIN_CAP (1u << 18)
#define LAS __attribute__((address_space(3)))
DEV unsigned xb_ld(unsigned* p) { return __hip_atomic_load(p, __ATOMIC_RELAXED, __HIP_MEMORY_SCOPE_AGENT); }
DEV unsigned xb_add(unsigned* p, unsigned v) { return __hip_atomic_fetch_add(p, v, __ATOMIC_RELAXED, __HIP_MEMORY_SCOPE_AGENT); }
DEV unsigned xb_xcc_id() { return (unsigned)__builtin_amdgcn_s_getreg((3 << 11) | 20) & 0xFu; }
#define XB_SPIN(cond, bar) do { unsigned _sp = 0; while (cond) { __builtin_amdgcn_s_sleep(1); \
    if ((++_sp & 255u) == 0u) { if (xb_ld(&(bar)[XB_TMO])) break; if (_sp > XB_SPIN_CAP) { atomicAdd(&(bar)[XB_TMO], 1u); break; } } } } while (0)
struct XcdBarrier { unsigned* bar; unsigned x; volatile LAS unsigned* st; };
DEV XcdBarrier xcd_barrier_post(unsigned* bar, volatile LAS unsigned* st) {
    XcdBarrier b; b.bar = bar; b.x = xb_xcc_id(); b.st = st;
    if (threadIdx.x == 0) (void)xb_add(&bar[XB_XCNT(b.x)], 1u);
    return b;
}
DEV void xcd_barrier_complete(unsigned* bar, unsigned x, unsigned& nloc, unsigned& nx) {
    const unsigned G = gridDim.x * gridDim.y * gridDim.z;
    unsigned sum, cnt, mine, sp = 0u;
    for (;;) {
        sum = 0u; cnt = 0u; mine = 0u;
#pragma unroll
        for (unsigned j = 0; j < 16; ++j) { const unsigned c = xb_ld(&bar[XB_XCNT(j)]); sum += c; cnt += (c > 0u) ? 1u : 0u; mine = (j == x) ? c : mine; }
        if (sum == G) break;
        __builtin_amdgcn_s_sleep(1);
        if ((++sp & 255u) == 0u) { if (xb_ld(&bar[XB_TMO])) break; if (sp > XB_SPIN_CAP) { atomicAdd(&bar[XB_TMO], 1u); break; } }
    }
    nloc = mine > 0u ? mine : 1u; nx = cnt > 0u ? cnt : 1u;
}
DEV void xcd_barrier(const XcdBarrier& b) {
    asm volatile("s_waitcnt vmcnt(0)" ::: "memory");
    __syncthreads();
    if (threadIdx.x == 0) {
        unsigned* bar = b.bar;
        __builtin_amdgcn_s_waitcnt(0);
        unsigned nloc = b.st[0], nx = b.st[1];
        if (nloc == 0u) { xcd_barrier_complete(bar, b.x, nloc, nx); b.st[0] = nloc; b.st[1] = nx; }
        const unsigned old = xb_add(&bar[XB_XSUB(b.x)], 1u);
        const unsigned gen = old / nloc;
        if (old + 1u == (gen + 1u) * nloc) {
            __builtin_amdgcn_fence(__ATOMIC_RELEASE, "agent");
            asm volatile("s_waitcnt vmcnt(0)" ::: "memory");
            const unsigned og = xb_add(&bar[XB_TOP], 1u);
            const unsigned tg = og / nx;
            if (og + 1u == (tg + 1u) * nx) xb_add(&bar[XB_TOPGEN], 1u);
            else XB_SPIN(xb_ld(&bar[XB_TOPGEN]) == tg, bar);
            __builtin_amdgcn_fence(__ATOMIC_ACQUIRE, "agent");
            xb_add(&bar[XB_XGEN(b.x)], 1u);
            asm volatile("s_waitcnt vmcnt(0)" ::: "memory");
        } else {
            XB_SPIN(xb_ld(&bar[XB_XGEN(b.x)]) == gen, bar);
            __builtin_amdgcn_fence(__ATOMIC_ACQUIRE, "agent");
            asm volatile("s_waitcnt vmcnt(0)" ::: "memory");
        }
    }
    __syncthreads();
}
constexpr size_t W_BAR = 252 * MiB;

constexpr int HALF_SMEM = 56320;
static_assert(HALF_SMEM == 56320, "update nsa_job");
constexpr int SMEM_BYTES = 131072;

extern __shared__ __attribute__((aligned(16))) char dyn_smem[];
#define RUN_PG8(EPI_T, EPI_OBJ, A_, LDA_, BT_, LDB_, M_, N_, K_) { pg8::Gemm g_; g_.A = (A_); g_.Bt = (BT_); g_.M = (M_); g_.N = (N_); g_.K = (K_); g_.lda = (LDA_); g_.ldb = (LDB_); g_.gather = 0; \
        pg8::StaticOrder so_; so_.init((M_), (N_), (int)gridDim.x, (int)blockIdx.x); __syncthreads(); \
        pg8::gemm_phase<EPI_T, pg8::StaticOrder, true, true>((PG8_LAS unsigned char*)dyn_smem, g_, so_, (EPI_OBJ)); __syncthreads(); }

template <int PH, bool DRY = false>
DEV void run_phase(const Params& P, char* smem) {
    const int nb = gridDim.x, bid = blockIdx.x, sub = opaque_tid512() >> 8;
    char* hsm = smem + sub * HALF_SMEM;
    char* aux = (char*)P.out;
    char* ws = P.ws;
    bf16_t* ZA = (bf16_t*)(ws + W_ZA);
    if (PH == 0) {
        for (int pj = bid; pj < (5088 + 4096 + 512 + 64 + 64) / 2; pj += nb) {
            int j = 2 * pj + sub;
            if (j < 5088) {
                bool done = false;
#define TR(SRC, LD, DSTOFF, KK, NN, MAP, BLK)                                                                                  \
    if (!done) { const int nrt = (NN) / 64, nt = nrt * ((KK) / 64);                                                              \
        if (j < nt) { transpose_tile((SRC), (LD), (bf16_t*)(aux + (DSTOFF)), (KK), (j % nrt) * 64, (j / nrt) * 64, (MAP), hsm, (BLK) ? (NN) : 0); done = true; } else j -= nt; }
                TR(P.w_in, 7984, O_WTA, 1024, 5120, 1, 0)
                TR(P.w_in, 7984, O_WTB, 1024, 4096, 2, 0)
                TR(P.w_up, 4096, O_WTUP, 1024, 4096, 0, 0)
                TR(P.w_down, 1024, O_WTDN, 4096, 1024, 0, 0)
                TR(P.w_o, 1024, O_WTO, 1024, 1024, 0, 0)
                TR(P.w_xo, 1024, O_WTXO, 256, 1024, 0, 0)
                TR(P.w_mkv, 512, O_WTMKV, 1024, 512, 0, 0)
                TR(P.wk1, 256, O_WTCK1, 2048, 256, 0, 0)
                TR(P.wv1, 256, O_WTCV1, 2048, 256, 0, 0)
#undef TR
                if (!done) {
                    if (j < 16) transpose_tile(P.w_a + j * 4096, 64, (bf16_t*)(aux + O_WAT) + j * 4096, 64, 0, 0, 0, hsm);
                    else { j -= 16; transpose_tile(P.w_i + j * 4096, 64, (bf16_t*)(aux + O_WIT) + j * 4096, 64, 0, 0, 0, hsm); }
                }
                continue;
            }
            j -= 5088;
            if (j < 4096) { rownorm<false>(P.x, P.g_mix, (bf16_t*)(ws + W_U), nullptr, j * 4 + (opaque_tid() >> 6)); continue; }
            j -= 4096;
            if (j < 512) { rownorm<false>(P.mem, P.g_mem, (bf16_t*)(aux + O_MEMN), nullptr, j * 4 + (opaque_tid() >> 6)); continue; }
            j -= 512;
            if (j < 64) { rope_job((float*)(aux + O_ROPEC), (float*)(aux + O_ROPES), j); continue; }
            j -= 64;
            posbias_job(P, (float*)(aux + O_PB), j, hsm);
        }
    } else if (PH == 1) {
        { PEpiMemKV ep; ep.MK = (bf16_t*)(aux + O_MEMK); ep.MVT = (bf16_t*)(aux + O_MEMVT);
          RUN_PG8(PEpiMemKV, ep, (const bf16_t*)(aux + O_MEMN), 1024, (const bf16_t*)(aux + O_WTMKV), 1024, 2048, 512, 1024) }
        { PEpiZA ep; ep.ZA = ZA; ep.VST = (bf16_t*)(ws + W_VST); ep.VWT = (bf16_t*)(ws + W_VWT); ep.ropec = (const float*)(aux + O_ROPEC); ep.ropes = (const float*)(aux + O_ROPES);
          RUN_PG8(PEpiZA, ep, (const bf16_t*)(ws + W_U), 1024, (const bf16_t*)(aux + O_WTA), 1024, 16384, 5120, 1024) }
    } else if (PH == 2) {
        { PEpiHid ep; ep.HK = (bf16_t*)(aux + O_HIDK); ep.HV = (bf16_t*)(aux + O_HIDV); ep.pb = (const float*)(aux + O_PB);
          pg8::Gemm g_; g_.A = ZA; g_.Bt = (const bf16_t*)(aux + O_WTCK1); g_.M = 4096; g_.N = 512; g_.K = 2048; g_.lda = ZW; g_.ldb = 2048; g_.gather = 1;
          pg8::StaticOrder so_; so_.init(4096, 512, (int)gridDim.x, (int)blockIdx.x); __syncthreads();
          pg8::gemm_phase<PEpiHid, pg8::StaticOrder, true, true>((PG8_LAS unsigned char*)dyn_smem, g_, so_, ep); __syncthreads(); }
        for (int job = bid; job < 512; job += nb) {
            if (job < 256) rnn_job(P, 2 * job + sub, hsm, DRY);
            else xattn_job(P, 2 * (job - 256) + sub, hsm, DRY);
        }
    } else if (PH == 3) {
        for (int pj = bid; pj < 1016; pj += nb) cmp2_job(P, 2 * pj + sub);
    } else if (PH == 4) {
        for (int job = bid; job < 1024; job += nb) nsa_job(P, 2 * job + sub, hsm, DRY);
        if (!DRY) { PEpiBf<0> ep; ep.O = (bf16_t*)(ws + W_YX); ep.ldo = 1024;
          RUN_PG8(PEpiBf<0>, ep, ZA + C_QX, ZW, (const bf16_t*)(aux + O_WTXO), 256, 16384, 1024, 256) }
    } else if (PH == 5) {
        { PEpiMerge ep; ep.ZA = ZA; ep.YX = (const bf16_t*)(ws + W_YX); ep.Y = (bf16_t*)(ws + W_Y);
          RUN_PG8(PEpiMerge, ep, (const bf16_t*)(ws + W_U), 1024, (const bf16_t*)(aux + O_WTB), 1024, 16384, 4096, 1024) }
    } else if (PH == 6) {
        { PEpiRes ep; ep.R = P.x; ep.O = (float*)(ws + W_H);
          RUN_PG8(PEpiRes, ep, (const bf16_t*)(ws + W_Y), 1024, (const bf16_t*)(aux + O_WTO), 1024, 16384, 1024, 1024) }
    } else if (PH == 7) {
        for (int pj = bid; pj < 2048; pj += nb) rownorm<false>((const float*)(ws + W_H), P.g_mlp, (bf16_t*)(ws + W_VN), nullptr, (2 * pj + sub) * 4 + (opaque_tid() >> 6));
    } else if (PH == 8) {
        { PEpiBf<1> ep; ep.O = (bf16_t*)(ws + W_HID); ep.ldo = 4096;
          RUN_PG8(PEpiBf<1>, ep, (const bf16_t*)(ws + W_VN), 1024, (const bf16_t*)(aux + O_WTUP), 1024, 16384, 4096, 1024) }
    } else if (PH == 9) {
        { PEpiRes ep; ep.R = (const float*)(ws + W_H); ep.O = (float*)(ws + W_H);
          RUN_PG8(PEpiRes, ep, (const bf16_t*)(ws + W_HID), 4096, (const bf16_t*)(aux + O_WTDN), 4096, 16384, 1024, 4096) }
    } else if (PH == 10) {
        for (int pj = bid; pj < 2048; pj += nb) rownorm<true>((const float*)(ws + W_H), P.g_final, nullptr, P.out, (2 * pj + sub) * 4 + (opaque_tid() >> 6));
    }
}

__global__ void __launch_bounds__(512, 2) mega_kernel(Params P) {
    char* smem = dyn_smem;
    cg::grid_group grid = cg::this_grid();
    __shared__ uint4 xb_words;
    if (threadIdx.x == 0) xb_words = make_uint4(0u, 0u, 0u, 0u);
    __syncthreads();
    XcdBarrier xb = xcd_barrier_post((unsigned*)(P.ws + W_BAR), (volatile LAS unsigned*)&xb_words);
    if (P.ws == nullptr) grid.sync();
#ifndef REP
#define REP -1
#endif
#define GSYNC() xcd_barrier(xb)
#define PHASE(k) { if (REP == k && k != 9) { run_phase<k, true>(P, smem); GSYNC(); } run_phase<k>(P, smem); GSYNC(); }
    PHASE(0) PHASE(1) PHASE(2) PHASE(3) PHASE(4) PHASE(5) PHASE(6) PHASE(7) PHASE(8) PHASE(9)
    if (REP == 10) { run_phase<10>(P, smem); GSYNC(); }
    if (REP == 11) { GSYNC(); GSYNC(); GSYNC(); GSYNC(); GSYNC(); GSYNC(); GSYNC(); GSYNC(); GSYNC(); GSYNC(); }
    run_phase<10>(P, smem);
}

extern "C" void kernel_launch(void* const* d_in, const int* in_sizes, int n_in, void* d_out, int out_size, void* d_ws, size_t ws_size,
                              hipStream_t stream) {
    Params P{};
    const float** pp = (const float**)&P;
    for (int i = 0; i < 25; ++i) pp[i] = (const float*)d_in[i];
    P.out = (float*)d_out;
    P.ws = (char*)d_ws;
    static int grid_blocks = 0;
    if (!grid_blocks) {
        int dev = 0, cus = 0, per_cu = 0;
        hipGetDevice(&dev);
        hipDeviceGetAttribute(&cus, hipDeviceAttributeMultiprocessorCount, dev);
        hipFuncSetAttribute((const void*)mega_kernel, hipFuncAttributeMaxDynamicSharedMemorySize, SMEM_BYTES);
        hipOccupancyMaxActiveBlocksPerMultiprocessor(&per_cu, mega_kernel, 512, SMEM_BYTES);
        if (per_cu > 1) per_cu = 1;
        if (per_cu < 1) per_cu = 1;
        grid_blocks = cus * per_cu;
    }
    hipMemsetAsync((char*)d_ws + W_BAR, 0, XCD_BAR_WORDS * 4, stream);
    void* args[] = {&P};
    hipError_t e = hipLaunchCooperativeKernel((void*)mega_kernel, dim3(grid_blocks), dim3(512), args, SMEM_BYTES, stream);
    if (e != hipSuccess) fprintf(stderr, "cooperative launch failed: %s (grid %d)\n", hipGetErrorString(e), grid_blocks);
}
```

```cpp
#include <hip/hip_runtime.h>
#include <hip/hip_cooperative_groups.h>
#include <cstdint>
#include <cstdio>
namespace cg = cooperative_groups;

#ifndef MULTI
#define MULTI 0
#endif

typedef unsigned short bf16_t;
typedef short bf16x8 __attribute__((ext_vector_type(8)));
typedef float f32x4 __attribute__((ext_vector_type(4)));
typedef __bf16 bfv2 __attribute__((ext_vector_type(2)));
typedef float f32x2 __attribute__((ext_vector_type(2)));
typedef unsigned u32x4 __attribute__((ext_vector_type(4)));
typedef unsigned u32x2 __attribute__((ext_vector_type(2)));
#define DEV __device__ __forceinline__
DEV int opaque_tid() { int t = threadIdx.x & 255; asm volatile("" : "+v"(t)); return t; }
DEV int opaque_tid512() { int t = threadIdx.x; asm volatile("" : "+v"(t)); return t; }
#define MFMA16(a, b, c) __builtin_amdgcn_mfma_f32_16x16x32_bf16((a), (b), (c), 0, 0, 0)

constexpr int T = 16384, S = 2048;
constexpr int ZW = 4480;
constexpr int C_Q = 0, C_KC = 1024, C_VC = 1280, C_KS = 1536, C_KW = 1792, C_XR = 2048, C_GR = 3072, C_QX = 4096, C_G = 4352;
constexpr int NCMP = 127;
constexpr int NCROWS = 4064;

constexpr size_t O_WTA = 0;
constexpr size_t O_WTB = O_WTA + (size_t)5120 * 1024 * 2;
constexpr size_t O_WTUP = O_WTB + (size_t)4096 * 1024 * 2;
constexpr size_t O_WTDN = O_WTUP + (size_t)4096 * 1024 * 2;
constexpr size_t O_WTO = O_WTDN + (size_t)4096 * 1024 * 2;
constexpr size_t O_WTXO = O_WTO + (size_t)1024 * 1024 * 2;
constexpr size_t O_WTMKV = O_WTXO + (size_t)1024 * 256 * 2;
constexpr size_t O_WTCK1 = O_WTMKV + (size_t)512 * 1024 * 2;
constexpr size_t O_WTCV1 = O_WTCK1 + (size_t)256 * 2048 * 2;
constexpr size_t O_WAT = O_WTCV1 + (size_t)256 * 2048 * 2;
constexpr size_t O_WIT = O_WAT + (size_t)16 * 64 * 64 * 2;
constexpr size_t O_ROPEC = O_WIT + (size_t)16 * 64 * 64 * 2;
constexpr size_t O_ROPES = O_ROPEC + (size_t)2048 * 8 * 4;
constexpr size_t O_MEMN = O_ROPES + (size_t)2048 * 8 * 4;
constexpr size_t O_MEMK = O_MEMN + (size_t)2048 * 1024 * 2;
constexpr size_t O_MEMVT = O_MEMK + (size_t)2048 * 256 * 2;
constexpr size_t O_HIDK = O_MEMVT + (size_t)2048 * 256 * 2;
constexpr size_t O_HIDV = O_HIDK + (size_t)4096 * 256 * 2;
constexpr size_t O_KC = O_HIDV + (size_t)4096 * 256 * 2;
constexpr size_t O_VCT = O_KC + (size_t)32 * 128 * 64 * 2;
constexpr size_t O_PB = O_VCT + (size_t)32 * 64 * 128 * 2;
constexpr size_t O_AUX_END = O_PB + 16384;
static_assert(O_AUX_END <= (size_t)64 << 20, "aux overflow");
constexpr size_t MiB = (size_t)1 << 20;
constexpr size_t W_U = 0, W_ZA = 32 * MiB, W_VST = 172 * MiB, W_VWT = 180 * MiB, W_YX = 188 * MiB, W_Y = 220 * MiB;
constexpr size_t W_H = 32 * MiB, W_VN = 0, W_HID = 96 * MiB;

struct Params {
    const float *x, *mem, *g_mix, *w_in, *cpk, *cpv, *wk1, *wk2, *wv1, *wv2, *conv_w, *conv_b, *w_a, *b_a, *w_i, *b_i, *lam,
        *g_mem, *w_mkv, *w_xo, *w_o, *g_mlp, *w_up, *w_down, *g_final;
    float* out;
    char* ws;
};

DEV float bf2f(bf16_t h) { return __uint_as_float(((unsigned)h) << 16); }
DEV unsigned pk2(float lo, float hi) { f32x2 v = {lo, hi}; bfv2 b = __builtin_convertvector(v, bfv2); return __builtin_bit_cast(unsigned, b); }
DEV bf16_t f2bf(float f) { return (bf16_t)(pk2(f, 0.f) & 0xffffu); }
DEV float lo_f(unsigned u) { return __uint_as_float(u << 16); }
DEV float hi_f(unsigned u) { return __uint_as_float(u & 0xffff0000u); }
DEV float sigm(float x) { return __builtin_amdgcn_rcpf(1.f + __expf(-x)); }
DEV float gelu_t(float x) {
    float y = 0.7978845608028654f * (x + 0.044715f * x * x * x);
    float e = __expf(2.f * y);
    float th = 1.f - 2.f * __builtin_amdgcn_rcpf(1.f + e);
    return 0.5f * x * (1.f + th);
}
DEV float wave_sum(float v) {
#pragma unroll
    for (int o = 32; o >= 1; o >>= 1) v += __shfl_xor(v, o);
    return v;
}

DEV int map_col(int mapid, int r) {
    if (mapid == 0) return r;
    if (mapid == 1) {
        if (r < 1536) return r;
        if (r < 1792) return 1536 + (r - 1536);
        if (r < 2048) return 2048 + (r - 1792);
        if (r < 3072) return 2608 + (r - 2048);
        if (r < 4096) return 3632 + (r - 3072);
        if (r < 4352) return 4656 + (r - 4096);
        if (r < 4608) return 1792 + (r - 4352);
        if (r < 4864) return 2304 + (r - 4608);
        if (r < 4912) return 2560 + (r - 4864);
        return -1;
    }
    const int pn = r >> 8, rem = r & 255, bj = rem >> 7, wc = (rem >> 5) & 3, n = (rem >> 4) & 1, c16 = rem & 15, slot = 2 * bj + n;
    if (slot == 3) return -1;
    return 4912 + slot * 1024 + pn * 64 + wc * 16 + c16;
}

DEV void transpose_tile(const float* __restrict__ src, int ld, bf16_t* __restrict__ dst, int K, int r0, int k0, int mapid, char* smem, int nblk = 0) {
    float* sm = (float*)smem;
    const int tid = threadIdx.x & 255, lane = tid & 63, w = tid >> 6;
    __syncthreads();
    const int sc = map_col(mapid, r0 + lane);
#pragma unroll
    for (int i = 0; i < 16; ++i) {
        int kk = w + 4 * i;
        float v = sc >= 0 ? src[(size_t)(k0 + kk) * ld + sc] : 0.f;
        sm[kk * 65 + lane] = v;
    }
    __syncthreads();
    const int rr = tid >> 2, kq = (tid & 3) * 16;
    unsigned o[8];
#pragma unroll
    for (int e = 0; e < 8; ++e) o[e] = pk2(sm[(kq + 2 * e) * 65 + rr], sm[(kq + 2 * e + 1) * 65 + rr]);
    uint4* dp = nblk ? (uint4*)(dst + (size_t)(k0 >> 6) * nblk * 64 + (size_t)(r0 + rr) * 64 + kq) : (uint4*)(dst + (size_t)(r0 + rr) * K + k0 + kq);
    dp[0] = make_uint4(o[0], o[1], o[2], o[3]);
    dp[1] = make_uint4(o[4], o[5], o[6], o[7]);
}

template <bool OUTF32>
DEV void rownorm(const float* __restrict__ src, const float* __restrict__ g, bf16_t* dstb, float* dstf, int row, bool blk = false) {
    const int lane = opaque_tid() & 63;
    const float4* sp = (const float4*)(src + (size_t)row * 1024);
    float4 v[4];
    float ss = 0.f;
#pragma unroll
    for (int i = 0; i < 4; ++i) { v[i] = sp[lane + 64 * i]; ss += v[i].x * v[i].x + v[i].y * v[i].y + v[i].z * v[i].z + v[i].w * v[i].w; }
    ss = wave_sum(ss);
    const float r = rsqrtf(ss * (1.0f / 1024.0f) + 1e-6f);
#pragma unroll
    for (int i = 0; i < 4; ++i) {
        float4 gg = ((const float4*)g)[lane + 64 * i];
        float a = v[i].x * r * gg.x, b = v[i].y * r * gg.y, c = v[i].z * r * gg.z, d = v[i].w * r * gg.w;
        if (OUTF32) ((float4*)(dstf + (size_t)row * 1024))[lane + 64 * i] = make_float4(a, b, c, d);
        else if (blk) { const int col = 4 * (lane + 64 * i); *(uint2*)(dstb + (size_t)(col >> 6) * ((size_t)16384 * 64) + (size_t)row * 64 + (col & 63)) = make_uint2(pk2(a, b), pk2(c, d)); }
        else ((uint2*)(dstb + (size_t)row * 1024))[lane + 64 * i] = make_uint2(pk2(a, b), pk2(c, d));
    }
}

DEV void rope_job(float* ct, float* st, int job) {
    const int e = job * 256 + (threadIdx.x & 255);
    const int pos = e >> 3, i = e & 7;
    const double inv = exp(-(double)i * 0.125 * 13.122363377404328);
    const double ang = (double)pos * inv;
    const double kq = rint(ang * 0.6366197723675814);
    const double r = ang - kq * 1.5707963267948966;
    const double r2 = r * r;
    const double sn = r * (1.0 + r2 * (-1.0 / 6 + r2 * (1.0 / 120 + r2 * (-1.0 / 5040 + r2 * (1.0 / 362880 + r2 * (-1.0 / 39916800 + r2 * (1.0 / 6227020800.0)))))));
    const double cs = 1.0 + r2 * (-0.5 + r2 * (1.0 / 24 + r2 * (-1.0 / 720 + r2 * (1.0 / 40320 + r2 * (-1.0 / 3628800 + r2 * (1.0 / 479001600.0))))));
    const int q = ((int)kq) & 3;
    double s_, c_;
    if (q == 0) { s_ = sn; c_ = cs; } else if (q == 1) { s_ = cs; c_ = -sn; } else if (q == 2) { s_ = -sn; c_ = -cs; } else { s_ = -cs; c_ = sn; }
    ct[e] = (float)c_; st[e] = (float)s_;
}

DEV void posbias_job(const Params& P, float* PB, int job, char* smem) {
    float* sred = (float*)smem;
    const int tid = opaque_tid(), which = job >> 5, cgi = (job >> 3) & 3, kc = job & 7, c = cgi * 64 + (tid & 63), kp = tid >> 6;
    const float* pos = (which ? P.cpv : P.cpk) + kc * 256 + kp * 64;
    const float* w1 = (which ? P.wv1 : P.wk1) + (size_t)(kc * 256 + kp * 64) * 256 + c;
    float a0 = 0.f, a1 = 0.f, a2 = 0.f, a3 = 0.f;
#pragma unroll 4
    for (int k = 0; k < 64; k += 4) {
        a0 += pos[k] * w1[(size_t)k * 256]; a1 += pos[k + 1] * w1[(size_t)(k + 1) * 256];
        a2 += pos[k + 2] * w1[(size_t)(k + 2) * 256]; a3 += pos[k + 3] * w1[(size_t)(k + 3) * 256];
    }
    __syncthreads();
    sred[kp * 64 + (tid & 63)] = (a0 + a1) + (a2 + a3);
    __syncthreads();
    if (tid < 64) PB[(which * 8 + kc) * 256 + c] = (sred[tid] + sred[64 + tid]) + (sred[128 + tid] + sred[192 + tid]);
}

struct ALPlain {
    const bf16_t* A; int lda; int ks;
    const char* base; unsigned off0;
    DEV void init(int row0, int lrow, int lk) { base = (const char*)(A + (size_t)row0 * lda); off0 = (unsigned)(lrow * lda + lk) * 2u; }
    DEV u32x4 load(int i, int k0) const { return *(const u32x4*)(base + (off0 + (unsigned)(i * 128 * lda) + (unsigned)(k0 >> 6) * (unsigned)(ks * 2))); }
    DEV u32x4 fix(int, const u32x4& v, int) const { return v; }
};
struct ALCmp {
    const bf16_t* ZA; const float* spos; int colbase;
    unsigned roff[4]; int lk_;
    DEV void init(int row0, int lrow, int lk) {
        lk_ = lk;
#pragma unroll
        for (int i = 0; i < 4; ++i) {
            const int row = row0 + lrow + 64 * i;
            const int bg = row / NCMP, n = row - bg * NCMP, b = bg >> 2, g = bg & 3;
            roff[i] = row < NCROWS ? (unsigned)(((b * S + 16 * n) * ZW + colbase + g * 64 + lk) * 2) : 0xffffffffu;
        }
    }
    DEV u32x4 load(int i, int k0) const {
        if (roff[i] == 0xffffffffu) return (u32x4){0u, 0u, 0u, 0u};
        return *(const u32x4*)((const char*)ZA + (roff[i] + (unsigned)((k0 >> 6) * ZW * 2)));
    }
    DEV u32x4 fix(int i, const u32x4& v, int k0) const {
        if (roff[i] == 0xffffffffu) return v;
        const float4 p0 = *(const float4*)(spos + k0 + lk_), p1 = *(const float4*)(spos + k0 + lk_ + 4);
        u32x4 o;
        o.x = pk2(lo_f(v.x) + p0.x, hi_f(v.x) + p0.y); o.y = pk2(lo_f(v.y) + p0.z, hi_f(v.y) + p0.w);
        o.z = pk2(lo_f(v.z) + p1.x, hi_f(v.z) + p1.y); o.w = pk2(lo_f(v.w) + p1.z, hi_f(v.w) + p1.w);
        return o;
    }
};

template <int TM, int TN, bool SWAP, class AL, class EP>
DEV void gemm_tile(AL al, const bf16_t* __restrict__ Bt, int ldb, int bks, int K, int pm, int pn, const EP& ep, char* smem) {
    constexpr int BM = TM * 32, BN = TN * 64, NA = BM / 64, NBB = (BN + 63) / 64;
    bf16_t* sA = (bf16_t*)smem;
    bf16_t* sB = sA + BM * 72;
    const int tid = opaque_tid512(), wid = tid >> 6, lane = tid & 63, wr = wid >> 2, wc = wid & 3, fr = lane & 15, fq = lane >> 4;
    f32x4 acc[TM][TN];
#pragma unroll
    for (int m = 0; m < TM; ++m)
#pragma unroll
        for (int n = 0; n < TN; ++n) acc[m][n] = (f32x4){0.f, 0.f, 0.f, 0.f};
    const int lrow = tid >> 3, lk = (tid & 7) * 8;
    u32x4 ra[NA], rb[NBB];
    al.init(pm * BM, lrow, lk);
    const char* bbase = (const char*)(Bt + (size_t)(pn * BN) * ldb);
    const unsigned boff = (unsigned)(lrow * ldb + lk) * 2u;
#pragma unroll
    for (int i = 0; i < NBB; ++i) rb[i] = (u32x4){0u, 0u, 0u, 0u};
#pragma unroll
    for (int i = 0; i < NA; ++i) ra[i] = al.load(i, 0);
#pragma unroll
    for (int i = 0; i < NBB; ++i) if (BN % 64 == 0 || lrow + 64 * i < BN) rb[i] = *(const u32x4*)(bbase + (boff + (unsigned)(i * 128 * ldb)));
    int nk = K >> 6;
    asm volatile("" : "+s"(nk));
    bf16_t* sWa = sA + lrow * 72 + lk;
    bf16_t* sWb = sB + lrow * 72 + lk;
    const bf16_t* sAr = sA + (wr * TM * 16 + fr) * 72 + fq * 8;
    const bf16_t* sBr = sB + (wc * TN * 16 + fr) * 72 + fq * 8;
#pragma unroll 1
    for (int kt = 0; kt < nk; ++kt) {
        __syncthreads();
#pragma unroll
        for (int i = 0; i < NA; ++i) *(u32x4*)(sWa + (64 * i) * 72) = al.fix(i, ra[i], kt * 64);
#pragma unroll
        for (int i = 0; i < NBB; ++i) if (BN % 64 == 0 || lrow + 64 * i < BN) *(u32x4*)(sWb + (64 * i) * 72) = rb[i];
        __syncthreads();
        if (kt + 1 < nk) {
            const int k0 = (kt + 1) * 64;
#pragma unroll
            for (int i = 0; i < NA; ++i) ra[i] = al.load(i, k0);
#pragma unroll
            for (int i = 0; i < NBB; ++i) if (BN % 64 == 0 || lrow + 64 * i < BN) rb[i] = *(const u32x4*)(bbase + (boff + (unsigned)(i * 128 * ldb) + (unsigned)(k0 >> 6) * (unsigned)(bks * 2)));
        }
        __builtin_amdgcn_sched_barrier(0);
        __builtin_amdgcn_s_setprio(1);
#pragma unroll
        for (int ks = 0; ks < 2; ++ks) {
            bf16x8 bfr[TN];
#pragma unroll
            for (int n = 0; n < TN; ++n) bfr[n] = *(const bf16x8*)(sBr + (n * 16) * 72 + ks * 32);
#pragma unroll
            for (int m = 0; m < TM; ++m) {
                const bf16x8 af = *(const bf16x8*)(sAr + (m * 16) * 72 + ks * 32);
#pragma unroll
                for (int n = 0; n < TN; ++n) acc[m][n] = SWAP ? MFMA16(bfr[n], af, acc[m][n]) : MFMA16(af, bfr[n], acc[m][n]);
            }
        }
        __builtin_amdgcn_s_setprio(0);
    }
    ep.run(acc, pm * BM + wr * TM * 16, pn * BN + wc * TN * 16, fr, fq);
}

DEV uint2 pk4(const f32x4& a) { return make_uint2(pk2(a[0], a[1]), pk2(a[2], a[3])); }

namespace pg8 {
#define PG8_LAS __attribute__((address_space(3)))
typedef unsigned short bf16_t;
typedef short bf16x8 __attribute__((ext_vector_type(8)));
typedef float f32x4 __attribute__((ext_vector_type(4)));
typedef unsigned u32x4 __attribute__((ext_vector_type(4)));
constexpr int BM = 256, BK = 64, HALF = 128, HTB = HALF * BK * 2  , STAGE_BYTES = 8 * HTB, NXCD = 8, WGM = 8;

__host__ __device__ __forceinline__ int lds_byte(int r, int c) { const int st = (r >> 4) * 2 + (c >> 5), rr = r & 15, cc = c & 31, ob = rr * 64 + cc * 2; return st * 1024 + (ob ^ (((ob >> 9) & 1) << 5)); }
__host__ __device__ __forceinline__ void stage_rc(int b, int& R, int& C) { const int st = b / 1024, sb = b % 1024, swz = sb ^ (((sb >> 9) & 1) << 5); R = (st >> 1) * 16 + swz / 64; C = (st & 1) * 32 + (swz % 64) / 2; }
__host__ __device__ __forceinline__ int perm32(int rho) { const int n = rho >> 4, i = rho & 15; return 8 * (i >> 2) + 4 * n + (i & 3); }

struct Unit { int pm, pn; };
struct Gemm { const bf16_t* A; const bf16_t* Bt; int M, N, K, lda, ldb; int gather; };

struct StaticOrder {
    int nM, nN, nwg, G, c;
    __host__ __device__ void init(int M, int N, int G_, int c_) { nM = M / BM; nN = N / BM; nwg = nM * nN; G = G_; c = c_; }
    __host__ __device__ bool next(int i, Unit& u) const {
        const long L = (long)i * G + c; if (L >= nwg) return false;
        int wgid = (int)L; { const int q = nwg / NXCD, r = nwg % NXCD, xcd = wgid % NXCD, off = wgid / NXCD; wgid = (xcd < r ? xcd * (q + 1) : r * (q + 1) + (xcd - r) * q) + off; }
        const int nig = WGM * nN, gid = wgid / nig, fm = gid * WGM, gsz = (nM - fm) < WGM ? (nM - fm) : WGM;
        u.pm = fm + ((wgid % nig) % gsz); u.pn = (wgid % nig) / gsz; return true;
    }
    __device__ __forceinline__ void a_ready(const Unit&) const {}
    __device__ __forceinline__ void done(const Unit&) const {}
};

template <class Epi, class Sched, bool ALIGN_EPI = false, bool SP2 = false>
__device__ __forceinline__ void gemm_phase(PG8_LAS unsigned char* lds, const Gemm g, const Sched& S, const Epi& E) {
    const int tid = opaque_tid512(), wid = __builtin_amdgcn_readfirstlane(tid >> 6), lane = tid & 63, wr = wid >> 2, wc = wid & 3, fr = lane & 15, fq = lane >> 4;
    const int K = g.K, nt = K / BK;
    unsigned voffA2[2][2], voffB[2];
#pragma unroll
    for (int i = 0; i < 2; ++i) { int R, C; stage_rc(tid * 16 + i * 8192, R, C); const int Rb = Epi::PERM ? ((R & ~31) + perm32(R & 31)) : R;
        voffA2[0][i] = (unsigned)(R * g.lda + C) * 2u; voffA2[1][i] = voffA2[0][i]; voffB[i] = (unsigned)(Rb * g.ldb + C) * 2u; }
    const size_t kstepB = (size_t)(BK * 2), kstepA = g.gather ? (size_t)(ZW * 2) : kstepB;
    const size_t hstepA = g.gather ? (size_t)0 : (size_t)HALF * g.lda * 2, hstepB = (size_t)HALF * g.ldb * 2;
    const size_t tstepA = 2 * hstepA, tstepB = 2 * hstepB;
    const unsigned ldsw = (unsigned)wid * 1024u;
    const int aoff = lds_byte(wr * 64 + fr, fq * 8), boff = lds_byte(wc * 32 + fr, fq * 8);
#define PG8_SA(b, h) (((b) * 2 + (h)) * HTB)
#define PG8_SB(b, h) ((4 + (b) * 2 + (h)) * HTB)
#define PG8_STAGE(bufoff, gbase, voff) do { _Pragma("unroll") for (int _i = 0; _i < 2; ++_i) \
        __builtin_amdgcn_global_load_lds((const unsigned*)((const char*)(gbase) + (voff)[_i]), (PG8_LAS unsigned*)(lds + (bufoff) + ldsw + _i * 8192), 16, 0, 0); } while (0)
#define PG8_LDA(dst, b, h) do { _Pragma("unroll") for (int m = 0; m < 4; ++m) _Pragma("unroll") for (int k = 0; k < 2; ++k) dst[m][k] = *(const PG8_LAS bf16x8*)(lds + PG8_SA(b, h) + aoff + m * 2048 + k * 1024); } while (0)
#define PG8_LDB(dst, b, h) do { _Pragma("unroll") for (int n = 0; n < 2; ++n) _Pragma("unroll") for (int k = 0; k < 2; ++k) dst[n][k] = *(const PG8_LAS bf16x8*)(lds + PG8_SB(b, h) + boff + n * 2048 + k * 1024); } while (0)
#define PG8_MMA(ai, bj, At, Bt) do { __builtin_amdgcn_s_setprio(1); _Pragma("unroll") for (int m = 0; m < 4; ++m) _Pragma("unroll") for (int n = 0; n < 2; ++n) _Pragma("unroll") for (int k = 0; k < 2; ++k) \
        acc[ai][bj][m][n] = __builtin_amdgcn_mfma_f32_16x16x32_bf16(Bt[n][k], At[m][k], acc[ai][bj][m][n], 0, 0, 0); __builtin_amdgcn_s_setprio(0); } while (0)
#define PG8_WAIT_V(n) asm volatile("s_waitcnt vmcnt(" #n ")" ::: "memory")
#define PG8_WAIT_L(n) asm volatile("s_waitcnt lgkmcnt(" #n ")" ::: "memory")
#define PG8_BAR __builtin_amdgcn_s_barrier()
#define PG8_SCHED __builtin_amdgcn_sched_barrier(0)
    Unit cur, nxt; int ui = 0;
    if (!S.next(0, cur)) return;
    f32x4 acc[2][2][4][2];
#pragma unroll
    for (int a = 0; a < 2; ++a)
#pragma unroll
        for (int b = 0; b < 2; ++b)
#pragma unroll
            for (int m = 0; m < 4; ++m)
#pragma unroll
                for (int n = 0; n < 2; ++n) acc[a][b][m][n] = (f32x4){0.f, 0.f, 0.f, 0.f};
    bf16x8 At[4][2], B0[2][2], B1[2][2];
    const char* cA = (const char*)g.A + (g.gather ? (size_t)0 : (size_t)cur.pm * tstepA); const char* cB = (const char*)g.Bt + (size_t)cur.pn * tstepB;
    if (g.gather) {
#pragma unroll
        for (int h = 0; h < 2; ++h)
#pragma unroll
            for (int i = 0; i < 2; ++i) { int R, C; stage_rc(tid * 16 + i * 8192, R, C);
                int r = cur.pm * 256 + h * HALF + R; r = r < NCROWS ? r : NCROWS - 1;
                const int bg = r / NCMP, n = r - bg * NCMP;
                voffA2[h][i] = (unsigned)((((bg >> 2) * ::S + 16 * n) * ZW + (cur.pn ? C_VC : C_KC) + (bg & 3) * 64 + C) * 2); }
    }
    S.a_ready(cur);
    if constexpr (SP2) {
        PG8_STAGE(PG8_SB(0, 0), cB, voffB); PG8_STAGE(PG8_SB(0, 1), cB + hstepB, voffB); PG8_STAGE(PG8_SA(0, 0), cA, voffA2[0]); PG8_STAGE(PG8_SA(0, 1), cA + hstepA, voffA2[1]);
        if (wr == 1) PG8_BAR;
        PG8_WAIT_V(2); PG8_BAR;
        PG8_STAGE(PG8_SB(1, 0), cB + kstepB, voffB); PG8_STAGE(PG8_SA(1, 0), cA + kstepA, voffA2[0]); PG8_STAGE(PG8_SB(1, 1), cB + hstepB + kstepB, voffB);
        PG8_WAIT_V(6); PG8_BAR;
    } else {
        PG8_STAGE(PG8_SB(0, 0), cB, voffB); PG8_STAGE(PG8_SA(0, 0), cA, voffA2[0]); PG8_STAGE(PG8_SB(0, 1), cB + hstepB, voffB); PG8_STAGE(PG8_SA(0, 1), cA + hstepA, voffA2[1]);
        if (wr == 1) PG8_BAR;
        PG8_WAIT_V(4); PG8_BAR;
        PG8_STAGE(PG8_SB(1, 0), cB + kstepB, voffB); PG8_STAGE(PG8_SA(1, 0), cA + kstepA, voffA2[0]); PG8_STAGE(PG8_SB(1, 1), cB + hstepB + kstepB, voffB);
        PG8_WAIT_V(6); PG8_BAR;
    }
    for (;;) {
        const bool has_next = S.next(ui + 1, nxt);
        const char* nA = has_next ? (const char*)g.A + (size_t)nxt.pm * tstepA : cA; const char* nB = has_next ? (const char*)g.Bt + (size_t)nxt.pn * tstepB : cB;
        for (int t = 0; t < nt; t += 2) {
            const bool last = (t == nt - 2);
            const char* a1 = cA + (size_t)(t + 1) * kstepA;
            const char* a2 = last ? nA : cA + (size_t)(t + 2) * kstepA; const char* b2 = last ? nB : cB + (size_t)(t + 2) * kstepB;
            const char* a3 = a2 + kstepA; const char* b3 = b2 + kstepB;
            if (last && has_next) S.a_ready(nxt);
            if constexpr (SP2) {
            PG8_LDB(B0, 0, 0); PG8_LDB(B1, 0, 1); PG8_SCHED; PG8_LDA(At, 0, 0); PG8_STAGE(PG8_SA(1, 1), a1 + hstepA, voffA2[1]);
            PG8_WAIT_V(8); PG8_WAIT_L(0); PG8_BAR; PG8_MMA(0, 0, At, B0); PG8_MMA(0, 1, At, B1); PG8_BAR; PG8_SCHED;
            PG8_LDA(At, 0, 1); PG8_STAGE(PG8_SB(0, 0), b2, voffB); PG8_STAGE(PG8_SB(0, 1), b2 + hstepB, voffB); PG8_STAGE(PG8_SA(0, 0), a2, voffA2[0]);
            PG8_WAIT_V(8); PG8_WAIT_L(0); PG8_BAR; PG8_MMA(1, 0, At, B0); PG8_MMA(1, 1, At, B1); PG8_BAR; PG8_SCHED;
            PG8_LDB(B0, 1, 0); PG8_LDB(B1, 1, 1); PG8_SCHED; PG8_LDA(At, 1, 0); PG8_STAGE(PG8_SA(0, 1), a2 + hstepA, voffA2[1]);
            PG8_WAIT_V(8); PG8_WAIT_L(0); PG8_BAR; PG8_MMA(0, 0, At, B0); PG8_MMA(0, 1, At, B1); PG8_BAR; PG8_SCHED;
            PG8_LDA(At, 1, 1); PG8_STAGE(PG8_SB(1, 0), b3, voffB); PG8_STAGE(PG8_SB(1, 1), b3 + hstepB, voffB); PG8_STAGE(PG8_SA(1, 0), a3, voffA2[0]);
            PG8_WAIT_V(8); PG8_WAIT_L(0); PG8_BAR; PG8_MMA(1, 0, At, B0); PG8_MMA(1, 1, At, B1); PG8_BAR; PG8_SCHED;
            } else {
            PG8_LDB(B0, 0, 0); PG8_SCHED; PG8_LDA(At, 0, 0); PG8_STAGE(PG8_SA(1, 1), a1 + hstepA, voffA2[1]);
            PG8_WAIT_L(8); PG8_BAR; PG8_WAIT_L(0); PG8_MMA(0, 0, At, B0); PG8_BAR; PG8_SCHED;
            PG8_LDB(B1, 0, 1); PG8_STAGE(PG8_SB(0, 0), b2, voffB);
            PG8_BAR; PG8_WAIT_L(0); PG8_MMA(0, 1, At, B1); PG8_BAR;
            PG8_LDA(At, 0, 1); PG8_STAGE(PG8_SA(0, 0), a2, voffA2[0]);
            PG8_BAR; PG8_WAIT_L(0); PG8_MMA(1, 0, At, B0); PG8_BAR; PG8_SCHED;
            PG8_STAGE(PG8_SB(0, 1), b2 + hstepB, voffB);
            PG8_WAIT_V(6); PG8_BAR; PG8_MMA(1, 1, At, B1); PG8_BAR;
            PG8_LDB(B0, 1, 0); PG8_SCHED; PG8_LDA(At, 1, 0); PG8_STAGE(PG8_SA(0, 1), a2 + hstepA, voffA2[1]);
            PG8_WAIT_L(8); PG8_BAR; PG8_WAIT_L(0); PG8_MMA(0, 0, At, B0); PG8_BAR; PG8_SCHED;
            PG8_LDB(B1, 1, 1); PG8_STAGE(PG8_SB(1, 0), b3, voffB);
            PG8_BAR; PG8_WAIT_L(0); PG8_MMA(0, 1, At, B1); PG8_BAR;
            PG8_LDA(At, 1, 1); PG8_STAGE(PG8_SA(1, 0), a3, voffA2[0]);
            PG8_BAR; PG8_WAIT_L(0); PG8_MMA(1, 0, At, B0); PG8_BAR; PG8_SCHED;
            PG8_STAGE(PG8_SB(1, 1), b3 + hstepB, voffB);
            PG8_WAIT_V(6); PG8_BAR; PG8_MMA(1, 1, At, B1); PG8_BAR;
            }
        }
        if constexpr (ALIGN_EPI) { if (wr == 0) PG8_BAR; }
        if constexpr (!Epi::AFTER_DRAIN) { E(acc, cur, wr, wc, fr, fq); S.done(cur); }
        if (!has_next) break;
#pragma unroll
        for (int a = 0; a < 2; ++a)
#pragma unroll
            for (int b = 0; b < 2; ++b)
#pragma unroll
                for (int m = 0; m < 4; ++m)
#pragma unroll
                    for (int n = 0; n < 2; ++n) acc[a][b][m][n] = (f32x4){0.f, 0.f, 0.f, 0.f};
        cur = nxt; cA = nA; cB = nB; ++ui;
        if constexpr (ALIGN_EPI) { if (wr == 1) PG8_BAR; }
    }
    PG8_WAIT_V(0);
    if constexpr (!ALIGN_EPI) { if (wr == 0) PG8_BAR; }
    PG8_BAR;
    if constexpr (Epi::AFTER_DRAIN) { E.fused(acc, cur, wr, wc, fr, fq, lds, wid, lane); S.done(cur); }
#undef PG8_SA
#undef PG8_SB
#undef PG8_STAGE
#undef PG8_LDA
#undef PG8_LDB
#undef PG8_MMA
#undef PG8_WAIT_V
#undef PG8_WAIT_L
#undef PG8_BAR
#undef PG8_SCHED
}
}

struct EpiHid {
    bf16_t* H;
    DEV void run(f32x4 (&acc)[8][4], int R0, int C0, int fr, int fq) const {
#pragma unroll
        for (int n = 0; n < 4; ++n)
#pragma unroll
            for (int m = 0; m < 8; ++m) {
                const int c = C0 + n * 16 + 4 * fq, r = R0 + m * 16 + fr;
                f32x4 a = acc[m][n];
#pragma unroll
                for (int j = 0; j < 4; ++j) a[j] = gelu_t(a[j]);
                if (r < NCROWS) *(uint2*)(H + (size_t)r * 256 + c) = pk4(a);
            }
    }
};
#define PG8_EPI_HEAD static constexpr bool PERM = false, AFTER_DRAIN = false;
#define PG8_FOR_TILES _Pragma("unroll") for (int ai = 0; ai < 2; ++ai) _Pragma("unroll") for (int bj = 0; bj < 2; ++bj) _Pragma("unroll") for (int m = 0; m < 4; ++m) _Pragma("unroll") for (int n = 0; n < 2; ++n)
struct PEpiZA {
    PG8_EPI_HEAD
    bf16_t *ZA, *VST, *VWT; const float *ropec, *ropes;
    DEV void operator()(const f32x4 (&acc)[2][2][4][2], const pg8::Unit& u, int wr, int wc, int fr, int fq) const {
        asm volatile("" : "+v"(fr), "+v"(fq));
        PG8_FOR_TILES {
            const int row = u.pm * 256 + ai * 128 + wr * 64 + m * 16 + fr, col0 = u.pn * 256 + bj * 128 + wc * 32 + n * 16;
            f32x4 a = acc[ai][bj][m][n];
            if (u.pn == 17 || u.pn == 18) {
                bf16_t* dst = (u.pn == 17) ? VST : VWT;
                const int c = (col0 & 255) + 4 * fq, b = row >> 11, t = row & 2047;
#pragma unroll
                for (int j = 0; j < 4; ++j) { const int cc = c + j; dst[((size_t)((b * 4 + (cc >> 6)) * 64 + (cc & 63))) * S + t] = f2bf(a[j]); }
            } else {
                const bool rope = (col0 < 1024 || (col0 >= 1536 && col0 < 2048)) && ((col0 & 63) == 0);
                if (rope) {
                    const int t = row & 2047, i0 = 4 * (fq & 1);
                    const float4 cs = *(const float4*)(ropec + t * 8 + i0), sn = *(const float4*)(ropes + t * 8 + i0);
                    const float c4[4] = {cs.x, cs.y, cs.z, cs.w}, s4[4] = {sn.x, sn.y, sn.z, sn.w};
#pragma unroll
                    for (int j = 0; j < 4; ++j) {
                        const float pr = __shfl_xor(a[j], 32);
                        a[j] = (fq & 2) ? (a[j] * c4[j] + pr * s4[j]) : (a[j] * c4[j] - pr * s4[j]);
                    }
                }
                int zc0 = col0;
                if (col0 >= 4864) {
                    zc0 = col0 - 512;
#pragma unroll
                    for (int j = 0; j < 4; ++j) a[j] = sigm(a[j]);
                }
                if (zc0 < ZW) *(uint2*)(ZA + (size_t)row * ZW + zc0 + 4 * fq) = pk4(a);
            }
        }
    }
};
struct PEpiHid {
    PG8_EPI_HEAD
    bf16_t *HK, *HV; const float* pb;
    DEV void operator()(const f32x4 (&acc)[2][2][4][2], const pg8::Unit& u, int wr, int wc, int fr, int fq) const {
        asm volatile("" : "+v"(fr), "+v"(fq));
        bf16_t* H = u.pn ? HV : HK;
        PG8_FOR_TILES {
            const int r = u.pm * 256 + ai * 128 + wr * 64 + m * 16 + fr, c = bj * 128 + wc * 32 + n * 16 + 4 * fq;
            float4 bb = *(const float4*)(pb + (u.pn * 8) * 256 + c);
#pragma unroll
            for (int kc = 1; kc < 8; ++kc) { const float4 t4 = *(const float4*)(pb + (u.pn * 8 + kc) * 256 + c); bb.x += t4.x; bb.y += t4.y; bb.z += t4.z; bb.w += t4.w; }
            f32x4 a = acc[ai][bj][m][n];
            a[0] = gelu_t(a[0] + bb.x); a[1] = gelu_t(a[1] + bb.y); a[2] = gelu_t(a[2] + bb.z); a[3] = gelu_t(a[3] + bb.w);
            if (r < NCROWS) *(uint2*)(H + (size_t)r * 256 + c) = pk4(a);
        }
    }
};
struct PEpiMemKV {
    PG8_EPI_HEAD
    bf16_t *MK, *MVT;
    DEV void operator()(const f32x4 (&acc)[2][2][4][2], const pg8::Unit& u, int wr, int wc, int fr, int fq) const {
        asm volatile("" : "+v"(fr), "+v"(fq));
        PG8_FOR_TILES {
            const int r = u.pm * 256 + ai * 128 + wr * 64 + m * 16 + fr, c = u.pn * 256 + bj * 128 + wc * 32 + n * 16 + 4 * fq;
            const int b = r >> 8, mm = r & 255;
            const f32x4 a = acc[ai][bj][m][n];
            if (u.pn == 0) { const int h = (c >> 6) & 3, d = c & 63; *(uint2*)(MK + ((size_t)(b * 4 + h) * 256 + mm) * 64 + d) = pk4(a); }
            else {
#pragma unroll
                for (int j = 0; j < 4; ++j) { const int cc = c + j, h = (cc >> 6) & 3, d = cc & 63; MVT[((size_t)(b * 4 + h) * 64 + d) * 256 + mm] = f2bf(a[j]); }
            }
        }
    }
};
template <int ACT>
struct PEpiBf {
    PG8_EPI_HEAD
    bf16_t* O; int ldo;
    DEV void operator()(const f32x4 (&acc)[2][2][4][2], const pg8::Unit& u, int wr, int wc, int fr, int fq) const {
        asm volatile("" : "+v"(fr), "+v"(fq));
        PG8_FOR_TILES {
            const int r = u.pm * 256 + ai * 128 + wr * 64 + m * 16 + fr, c = u.pn * 256 + bj * 128 + wc * 32 + n * 16 + 4 * fq;
            f32x4 a = acc[ai][bj][m][n];
            if (ACT == 1) {
#pragma unroll
                for (int j = 0; j < 4; ++j) { const float v = fmaxf(a[j], 0.f); a[j] = v * v; }
            }
            *(uint2*)(O + (size_t)r * ldo + c) = pk4(a);
        }
    }
};
struct PEpiRes {
    PG8_EPI_HEAD
    const float* R; float* O;
    DEV void operator()(const f32x4 (&acc)[2][2][4][2], const pg8::Unit& u, int wr, int wc, int fr, int fq) const {
        asm volatile("" : "+v"(fr), "+v"(fq));
        PG8_FOR_TILES {
            const size_t o = (size_t)(u.pm * 256 + ai * 128 + wr * 64 + m * 16 + fr) * 1024 + u.pn * 256 + bj * 128 + wc * 32 + n * 16 + 4 * fq;
            const f32x4 r = *(const f32x4*)(R + o);
            *(f32x4*)(O + o) = r + acc[ai][bj][m][n];
        }
    }
};
struct PEpiMerge {
    PG8_EPI_HEAD
    const bf16_t *ZA, *YX; bf16_t* Y;
    DEV void operator()(const f32x4 (&acc)[2][2][4][2], const pg8::Unit& u, int wr, int wc, int fr, int fq) const {
        asm volatile("" : "+v"(fr), "+v"(fq));
        const int ch = u.pn * 64 + wc * 16 + 4 * fq;
#pragma unroll
        for (int ai = 0; ai < 2; ++ai)
#pragma unroll
            for (int m = 0; m < 4; ++m) {
                const size_t row = (size_t)(u.pm * 256 + ai * 128 + wr * 64 + m * 16 + fr);
                const uint2 a = *(const uint2*)(ZA + row * ZW + C_Q + ch), b = *(const uint2*)(ZA + row * ZW + C_GR + ch), c = *(const uint2*)(YX + row * 1024 + ch);
                const f32x4 g0 = acc[ai][0][m][0], g1 = acc[ai][0][m][1], g2 = acc[ai][1][m][0];
                f32x4 y;
                y[0] = sigm(g0[0]) * lo_f(a.x) + sigm(g1[0]) * lo_f(b.x) + sigm(g2[0]) * lo_f(c.x);
                y[1] = sigm(g0[1]) * hi_f(a.x) + sigm(g1[1]) * hi_f(b.x) + sigm(g2[1]) * hi_f(c.x);
                y[2] = sigm(g0[2]) * lo_f(a.y) + sigm(g1[2]) * lo_f(b.y) + sigm(g2[2]) * lo_f(c.y);
                y[3] = sigm(g0[3]) * hi_f(a.y) + sigm(g1[3]) * hi_f(b.y) + sigm(g2[3]) * hi_f(c.y);
                *(uint2*)(Y + row * 1024 + ch) = pk4(y);
            }
    }
};

DEV bool tile_map(int idx, int NT, int& pm, int& pn) {
    const int x = idx & 7, pl = (idx >> 3) & 3, pmid = (idx >> 5) & 7, st = idx >> 8;
    pm = pmid * 8 + x;
    pn = st * 4 + pl;
    return pn < NT;
}
DEV int tile_count(int NT) { return ((NT + 3) / 4) * 256; }

DEV void cmp2_job(const Params& P, int job) {
    char* aux = (char*)P.out;
    const int lane = threadIdx.x & 63, w = (threadIdx.x & 255) >> 6;
    const int wj = job * 4 + w;
    const int which = wj >= NCROWS ? 1 : 0;
    const int r = wj - which * NCROWS;
    const int bg = r / NCMP, n = r - bg * NCMP;
    const bf16_t* hid = (const bf16_t*)(aux + (which ? O_HIDV : O_HIDK)) + (size_t)r * 256;
    const float* w2 = which ? P.wv2 : P.wk2;
    float acc = 0.f;
#pragma unroll 8
    for (int k = 0; k < 256; ++k) acc += bf2f(hid[k]) * w2[k * 64 + lane];
    if (!which) {
        const int pos = 16 * n + 31, i = lane & 7;
        const float cs = ((const float*)(aux + O_ROPEC))[pos * 8 + i], sn = ((const float*)(aux + O_ROPES))[pos * 8 + i];
        const float pr = __shfl_xor(acc, 8);
        float o = acc;
        if (lane < 16) o = (lane & 8) ? (acc * cs + pr * sn) : (acc * cs - pr * sn);
        bf16_t* KC = (bf16_t*)(aux + O_KC);
        KC[((size_t)bg * 128 + n) * 64 + lane] = f2bf(o);
        if (n == NCMP - 1) KC[((size_t)bg * 128 + 127) * 64 + lane] = 0;
    } else {
        bf16_t* VCT = (bf16_t*)(aux + O_VCT);
        VCT[((size_t)bg * 64 + lane) * 128 + n] = f2bf(acc);
        if (n == NCMP - 1) VCT[((size_t)bg * 64 + lane) * 128 + 127] = 0;
    }
}

DEV void rnn_job(const Params& P, int job, char* smem, bool dry) {
    char* aux = (char*)P.out;
    bf16_t* ZA = (bf16_t*)(P.ws + W_ZA);
    const int b = job >> 6, n = (job >> 2) & 15, ct = job & 3;
    const int t512 = opaque_tid512(), sub = t512 >> 8;
    char* sh = smem - sub * 56320;
    bf16_t* sX = (bf16_t*)sh;
    float* sCw = (float*)(sh + 9216);
    bf16_t* sRaw = (bf16_t*)(sh + 10496);
    bf16_t* sRaw2 = sRaw + 67 * 72;
    float* sXf = (float*)(smem + 32768);
    float* sSum = (float*)(smem + 37120);
    const int tid = t512 & 255, w = tid >> 6, lane = tid & 63, fr = lane & 15, fq = lane >> 4;
    const bf16_t* WAT = (const bf16_t*)(aux + O_WAT) + n * 4096;
    const bf16_t* WIT = (const bf16_t*)(aux + O_WIT) + n * 4096;
    bf16x8 wa[2], wi[2];
#pragma unroll
    for (int ks = 0; ks < 2; ++ks) {
        wa[ks] = *(const bf16x8*)(WAT + (16 * ct + fr) * 64 + 32 * ks + 8 * fq);
        wi[ks] = *(const bf16x8*)(WIT + (16 * ct + fr) * 64 + 32 * ks + 8 * fq);
    }
    const int c = n * 64 + 16 * ct + fr;
    const float ba = P.b_a[c], bi = P.b_i[c], cl = -8.0f * log1pf(__expf(-P.lam[c]));
    float carry = 0.f;
    __syncthreads();
    for (int i = t512; i < 320; i += 512) sCw[i] = (i < 256) ? P.conv_w[(i >> 6) * 1024 + n * 64 + (i & 63)] : P.conv_b[n * 64 + (i & 63)];
    const int lt = t512 >> 3, c8 = (t512 & 7) * 8;
    const int dct = (c8 >> 4) - (ct & ~1);
    float* sXfT = (float*)(sh + (dct == 1 ? 56320 : 0) + 32768);
    const bf16_t* xbase = ZA + (size_t)(b * S) * ZW + C_XR + n * 64 + c8;
    u32x4 xm, xh = {0u, 0u, 0u, 0u};
    xm = *(const u32x4*)(xbase + (size_t)lt * ZW);
    *(u32x4*)(sRaw + (lt + 3) * 72 + c8) = xm;
    if (t512 < 24) *(u32x4*)(sRaw + lt * 72 + c8) = xh;
    xm = *(const u32x4*)(xbase + (size_t)(64 + lt) * ZW);
    if (t512 < 24) xh = *(const u32x4*)(xbase + (size_t)(61 + lt) * ZW);
    __syncthreads();
#pragma unroll 1
    for (int chunk = 0; chunk < 32; ++chunk) {
        const int tc = chunk * 64;
        const bf16_t* rawc = (chunk & 1) ? sRaw2 : sRaw;
        bf16_t* rawn = (chunk & 1) ? sRaw : sRaw2;
        bf16_t gv[4];
#pragma unroll
        for (int j = 0; j < 4; ++j) gv[j] = ZA[(size_t)(b * S + tc + 16 * w + 4 * fq + j) * ZW + C_GR + n * 64 + 16 * ct + fr];
        {
            float xv[8];
            { const float4 b0 = *(const float4*)(sCw + 256 + c8), b1 = *(const float4*)(sCw + 256 + c8 + 4);
              xv[0] = b0.x; xv[1] = b0.y; xv[2] = b0.z; xv[3] = b0.w; xv[4] = b1.x; xv[5] = b1.y; xv[6] = b1.z; xv[7] = b1.w; }
#pragma unroll
            for (int k = 0; k < 4; ++k) {
                const u32x4 v = *(const u32x4*)(rawc + (lt + k) * 72 + c8);
                const float4 w0 = *(const float4*)(sCw + k * 64 + c8), w1 = *(const float4*)(sCw + k * 64 + c8 + 4);
                xv[0] += w0.x * lo_f(v.x); xv[1] += w0.y * hi_f(v.x); xv[2] += w0.z * lo_f(v.y); xv[3] += w0.w * hi_f(v.y);
                xv[4] += w1.x * lo_f(v.z); xv[5] += w1.y * hi_f(v.z); xv[6] += w1.z * lo_f(v.w); xv[7] += w1.w * hi_f(v.w);
            }
            if (dct == 0 || dct == 1) {
#pragma unroll
                for (int e = 0; e < 8; ++e) sXfT[lt * 17 + (c8 & 15) + e] = xv[e];
            }
            u32x4 o0 = {pk2(xv[0], xv[1]), pk2(xv[2], xv[3]), pk2(xv[4], xv[5]), pk2(xv[6], xv[7])};
            *(u32x4*)(sX + lt * 72 + c8) = o0;
        }
        __syncthreads();
        f32x4 R = (f32x4){0.f, 0.f, 0.f, 0.f}, I = (f32x4){0.f, 0.f, 0.f, 0.f};
#pragma unroll
        for (int ks = 0; ks < 2; ++ks) {
            const bf16x8 af = *(const bf16x8*)(sX + (16 * w + fr) * 72 + 32 * ks + 8 * fq);
            R = MFMA16(af, wa[ks], R); I = MFMA16(af, wi[ks], I);
        }
        if (chunk + 1 < 32) {
            *(u32x4*)(rawn + (lt + 3) * 72 + c8) = xm;
            if (t512 < 24) *(u32x4*)(rawn + lt * 72 + c8) = xh;
        }
        float hl[4], pc[4];
        float h = 0.f, pcum = 1.f;
#pragma unroll
        for (int j = 0; j < 4; ++j) {
            const float xcv = sXf[(16 * w + 4 * fq + j) * 17 + fr];
            const float rg = sigm(R[j] + ba), gi = sigm(I[j] + bi);
            const float la = rg * cl;
            const float a_ = __expf(la);
            const float mult = sqrtf(fmaxf(1.f - a_ * a_, 0.f));
            const float u = mult * gi * xcv;
            h = a_ * h + u; pcum *= a_;
            hl[j] = h; pc[j] = pcum;
        }
        float A = pcum, H = h;
        float A1 = __shfl_up(A, 16), H1 = __shfl_up(H, 16);
        if (fq >= 1) { H = A * H1 + H; A = A * A1; }
        float A2 = __shfl_up(A, 32), H2 = __shfl_up(H, 32);
        if (fq >= 2) { H = A * H2 + H; A = A * A2; }
        float Ax = __shfl_up(A, 16), Hx = __shfl_up(H, 16);
        const float Ae = fq == 0 ? 1.f : Ax, He = fq == 0 ? 0.f : Hx;
        if (fq == 3) { sSum[w * 16 + fr] = A; sSum[64 + w * 16 + fr] = H; }
        __syncthreads();
        if (chunk + 2 < 32) {
            xm = *(const u32x4*)(xbase + (size_t)(tc + 128 + lt) * ZW);
            if (t512 < 24) xh = *(const u32x4*)(xbase + (size_t)(tc + 125 + lt) * ZW);
        }
        float cin = carry, mycin = 0.f;
#pragma unroll
        for (int ww = 0; ww < 4; ++ww) {
            if (ww == w) mycin = cin;
            cin = sSum[ww * 16 + fr] * cin + sSum[64 + ww * 16 + fr];
        }
        carry = cin;
        const float sq = Ae * mycin + He;
#pragma unroll
        for (int j = 0; j < 4; ++j) {
            const float hfin = hl[j] + pc[j] * sq;
            const size_t grow = (size_t)(b * S + tc + 16 * w + 4 * fq + j);
            bf16_t* op = dry ? ((bf16_t*)(P.ws + W_YX) + grow * 1024 + n * 64 + 16 * ct + fr) : (ZA + grow * ZW + C_GR + n * 64 + 16 * ct + fr);
            *op = f2bf(gelu_t(bf2f(gv[j])) * hfin);
        }
    }
}

constexpr float EXPC = 0.125f * 1.4426950408889634f;
struct AttnAcc { f32x4 o[4][2]; float m[2], l[2]; };
DEV void attn_init(AttnAcc& a) {
#pragma unroll
    for (int d = 0; d < 4; ++d)
#pragma unroll
        for (int q = 0; q < 2; ++q) a.o[d][q] = (f32x4){0.f, 0.f, 0.f, 0.f};
    a.m[0] = a.m[1] = -INFINITY; a.l[0] = a.l[1] = 0.f;
}
DEV bf16x8 mk8(unsigned a, unsigned b, unsigned c, unsigned d) { u32x4 u = {a, b, c, d}; return __builtin_bit_cast(bf16x8, u); }

template <class MF>
DEV void attn_step(const bf16_t* sK, const bf16_t* sVt, int vstride, const bf16x8 (&qf)[2][2], AttnAcc& st, const MF& mf, int fr, int fq) {
    f32x4 s[4][2];
#pragma unroll
    for (int kt = 0; kt < 4; ++kt) {
        s[kt][0] = (f32x4){0.f, 0.f, 0.f, 0.f}; s[kt][1] = (f32x4){0.f, 0.f, 0.f, 0.f};
#pragma unroll
        for (int ks = 0; ks < 2; ++ks) {
            const bf16x8 kf = *(const bf16x8*)(sK + (16 * kt + fr) * 80 + 32 * ks + 8 * fq);
            s[kt][0] = MFMA16(kf, qf[0][ks], s[kt][0]);
            s[kt][1] = MFMA16(kf, qf[1][ks], s[kt][1]);
        }
    }
#pragma unroll
    for (int qt = 0; qt < 2; ++qt) {
        float ps = 0.f;
#pragma unroll
        for (int kt = 0; kt < 4; ++kt)
#pragma unroll
            for (int j = 0; j < 4; ++j) {
                const float p = mf(qt, 16 * kt + 4 * fq + j) ? __builtin_amdgcn_exp2f(s[kt][qt][j] * EXPC) : 0.f;
                s[kt][qt][j] = p; ps += p;
            }
        st.l[qt] += ps;
    }
#pragma unroll
    for (int ks = 0; ks < 2; ++ks) {
        bf16x8 pf[2];
#pragma unroll
        for (int qt = 0; qt < 2; ++qt)
            pf[qt] = mk8(pk2(s[2 * ks][qt][0], s[2 * ks][qt][1]), pk2(s[2 * ks][qt][2], s[2 * ks][qt][3]),
                         pk2(s[2 * ks + 1][qt][0], s[2 * ks + 1][qt][1]), pk2(s[2 * ks + 1][qt][2], s[2 * ks + 1][qt][3]));
#pragma unroll
        for (int dt = 0; dt < 4; ++dt) {
            const u32x2 v0 = *(const u32x2*)(sVt + (16 * dt + fr) * vstride + 32 * ks + 4 * fq);
            const u32x2 v1 = *(const u32x2*)(sVt + (16 * dt + fr) * vstride + 32 * ks + 16 + 4 * fq);
            const bf16x8 vf = mk8(v0.x, v0.y, v1.x, v1.y);
            st.o[dt][0] = MFMA16(vf, pf[0], st.o[dt][0]);
            st.o[dt][1] = MFMA16(vf, pf[1], st.o[dt][1]);
        }
    }
}
DEV void attn_step_fast(const bf16_t* sK, const bf16_t* sVt, const bf16x8 (&qf)[2][2], AttnAcc& st, const float (&bitoff)[2], int fr, int fq) {
    f32x4 s[4][2];
#pragma unroll
    for (int kt = 0; kt < 4; ++kt) {
        s[kt][0] = (f32x4){0.f, 0.f, 0.f, 0.f}; s[kt][1] = (f32x4){0.f, 0.f, 0.f, 0.f};
#pragma unroll
        for (int ks = 0; ks < 2; ++ks) {
            const bf16x8 kf = *(const bf16x8*)(sK + (16 * kt + fr) * 80 + 32 * ks + 8 * fq);
            s[kt][0] = MFMA16(kf, qf[0][ks], s[kt][0]);
            s[kt][1] = MFMA16(kf, qf[1][ks], s[kt][1]);
        }
    }
#pragma unroll
    for (int qt = 0; qt < 2; ++qt) {
        const float off = bitoff[qt];
        float ps = 0.f;
#pragma unroll
        for (int kt = 0; kt < 4; ++kt)
#pragma unroll
            for (int j = 0; j < 4; ++j) { const float p = __builtin_amdgcn_exp2f(fmaf(s[kt][qt][j], EXPC, off)); s[kt][qt][j] = p; ps += p; }
        st.l[qt] += ps;
    }
#pragma unroll
    for (int ks = 0; ks < 2; ++ks) {
        bf16x8 pf[2];
#pragma unroll
        for (int qt = 0; qt < 2; ++qt)
            pf[qt] = mk8(pk2(s[2 * ks][qt][0], s[2 * ks][qt][1]), pk2(s[2 * ks][qt][2], s[2 * ks][qt][3]),
                         pk2(s[2 * ks + 1][qt][0], s[2 * ks + 1][qt][1]), pk2(s[2 * ks + 1][qt][2], s[2 * ks + 1][qt][3]));
#pragma unroll
        for (int dt = 0; dt < 4; ++dt) {
            const u32x2 v0 = *(const u32x2*)(sVt + (16 * dt + fr) * 72 + 32 * ks + 4 * fq);
            const u32x2 v1 = *(const u32x2*)(sVt + (16 * dt + fr) * 72 + 32 * ks + 16 + 4 * fq);
            const bf16x8 vf = mk8(v0.x, v0.y, v1.x, v1.y);
            st.o[dt][0] = MFMA16(vf, pf[0], st.o[dt][0]);
            st.o[dt][1] = MFMA16(vf, pf[1], st.o[dt][1]);
        }
    }
}
template <int QT>
DEV void attn_half_fast(const bf16_t* sK, const bf16_t* sVt, const bf16x8 (&qf)[2][2], AttnAcc& st, float bitoff, int fr, int fq) {
    f32x4 s[4];
#pragma unroll
    for (int kt = 0; kt < 4; ++kt) {
        s[kt] = (f32x4){0.f, 0.f, 0.f, 0.f};
#pragma unroll
        for (int ks = 0; ks < 2; ++ks) {
            const bf16x8 kf = *(const bf16x8*)(sK + (16 * kt + fr) * 80 + 32 * ks + 8 * fq);
            s[kt] = MFMA16(kf, qf[QT][ks], s[kt]);
        }
    }
    const float off = bitoff;
    float ps = 0.f;
#pragma unroll
    for (int kt = 0; kt < 4; ++kt)
#pragma unroll
        for (int j = 0; j < 4; ++j) { const float p = __builtin_amdgcn_exp2f(fmaf(s[kt][j], EXPC, off)); s[kt][j] = p; ps += p; }
    st.l[QT] += ps;
#pragma unroll
    for (int ks = 0; ks < 2; ++ks) {
        const bf16x8 pf = mk8(pk2(s[2 * ks][0], s[2 * ks][1]), pk2(s[2 * ks][2], s[2 * ks][3]), pk2(s[2 * ks + 1][0], s[2 * ks + 1][1]), pk2(s[2 * ks + 1][2], s[2 * ks + 1][3]));
#pragma unroll
        for (int dt = 0; dt < 4; ++dt) {
            const u32x2 v0 = *(const u32x2*)(sVt + (16 * dt + fr) * 72 + 32 * ks + 4 * fq);
            const u32x2 v1 = *(const u32x2*)(sVt + (16 * dt + fr) * 72 + 32 * ks + 16 + 4 * fq);
            st.o[dt][QT] = MFMA16(mk8(v0.x, v0.y, v1.x, v1.y), pf, st.o[dt][QT]);
        }
    }
}
DEV void attn_fold_out(bf16_t* const (&op)[2], const AttnAcc& st, const float (&gate)[2]) {
#pragma unroll
    for (int qt = 0; qt < 2; ++qt) {
        float l = st.l[qt];
        l += __shfl_xor(l, 16); l += __shfl_xor(l, 32);
        const float sc = gate[qt] * __builtin_amdgcn_rcpf(fmaxf(l, 1e-30f));
#pragma unroll
        for (int dt = 0; dt < 4; ++dt) {
            const uint2 pv = *(const uint2*)(op[qt] + 16 * dt);
            f32x4 r = st.o[dt][qt] * sc;
            r[0] += lo_f(pv.x); r[1] += hi_f(pv.x); r[2] += lo_f(pv.y); r[3] += hi_f(pv.y);
            *(uint2*)(op[qt] + 16 * dt) = make_uint2(pk2(r[0], r[1]), pk2(r[2], r[3]));
        }
    }
}
DEV void attn_fold(f32x4 (&tot)[4][2], const AttnAcc& st, const float (&gate)[2]) {
#pragma unroll
    for (int qt = 0; qt < 2; ++qt) {
        float l = st.l[qt];
        l += __shfl_xor(l, 16); l += __shfl_xor(l, 32);
        const float sc = gate[qt] * __builtin_amdgcn_rcpf(fmaxf(l, 1e-30f));
#pragma unroll
        for (int dt = 0; dt < 4; ++dt) tot[dt][qt] += st.o[dt][qt] * sc;
    }
}
DEV void ld64(u32x4 (&r)[2], const bf16_t* src, size_t sstride, int tid) {
#pragma unroll
    for (int i = 0; i < 2; ++i) { const int c = tid + 256 * i; r[i] = *(const u32x4*)(src + (size_t)(c >> 3) * sstride + (c & 7) * 8); }
}
DEV void st64(bf16_t* dst, const u32x4 (&r)[2], int tid, int stride) {
#pragma unroll
    for (int i = 0; i < 2; ++i) { const int c = tid + 256 * i; *(u32x4*)(dst + (c >> 3) * stride + (c & 7) * 8) = r[i]; }
}

#define OUTP(QT) ((dry ? (bf16_t*)(P.ws + W_YX) + (size_t)(b * S + tq[QT]) * 1024 : ZA + (size_t)(b * S + tq[QT]) * ZW + C_Q) + head * 64 + 4 * fq)
#define LOAD_GATE(G2, BR) float G2[2]; { G2[0] = bf2f(ZA[(size_t)(b * S + tq[0]) * ZW + C_G + head * 3 + (BR)]); G2[1] = bf2f(ZA[(size_t)(b * S + tq[1]) * ZW + C_G + head * 3 + (BR)]); }
DEV u32x4 ld64w(const bf16_t* src, size_t sstride, int t512) { return *(const u32x4*)(src + (size_t)(t512 >> 3) * sstride + (t512 & 7) * 8); }
DEV void st64w(bf16_t* dst, const u32x4& r, int t512, int stride) { *(u32x4*)(dst + (t512 >> 3) * stride + (t512 & 7) * 8) = r; }
struct MaskAll { DEV bool operator()(int, int) const { return true; } };
struct MaskSel { unsigned bit[2]; int t[2]; int k0; DEV bool operator()(int qt, int kk) const { return bit[qt] && (k0 + kk <= t[qt]); } };
struct MaskWin { int t[2]; int k0; DEV bool operator()(int qt, int kk) const { const int k = k0 + kk; return k <= t[qt] && k > t[qt] - 512; } };

DEV void xattn_job(const Params& P, int job, char* smem, bool dry) {
    char* aux = (char*)P.out;
    bf16_t* ZA = (bf16_t*)(P.ws + W_ZA);
    const int qb = job & 15, h = (job >> 4) & 3, b = job >> 6;
    bf16_t* sK = (bf16_t*)smem;
    bf16_t* sVt = sK + 64 * 80;
    const int tid = opaque_tid(), w = tid >> 6, lane = tid & 63, fr = lane & 15, fq = lane >> 4;
    const int t0 = qb * 128 + w * 32;
    bf16x8 qf[2][2];
#pragma unroll
    for (int qt = 0; qt < 2; ++qt)
#pragma unroll
        for (int ks = 0; ks < 2; ++ks) qf[qt][ks] = *(const bf16x8*)(ZA + (size_t)(b * S + t0 + 16 * qt + fr) * ZW + C_QX + h * 64 + 32 * ks + 8 * fq);
    const bf16_t* MK = (const bf16_t*)(aux + O_MEMK) + (size_t)(b * 4 + h) * 256 * 64;
    const bf16_t* MVT = (const bf16_t*)(aux + O_MEMVT) + (size_t)(b * 4 + h) * 64 * 256;
    AttnAcc st; attn_init(st);
    u32x4 rk[2], rv[2];
    ld64(rk, MK, 64, tid); ld64(rv, MVT, 256, tid);
#pragma unroll 1
    for (int jb = 0; jb < 4; ++jb) {
        __syncthreads();
        st64(sK, rk, tid, 80); st64(sVt, rv, tid, 72);
        __syncthreads();
        if (jb + 1 < 4) { ld64(rk, MK + (size_t)(jb + 1) * 64 * 64, 64, tid); ld64(rv, MVT + (jb + 1) * 64, 256, tid); }
        __builtin_amdgcn_sched_barrier(0);
        { const float z2[2] = {0.f, 0.f}; attn_step_fast(sK, sVt, qf, st, z2, fr, fq); }
    }
    f32x4 tot[4][2];
#pragma unroll
    for (int dt = 0; dt < 4; ++dt) { tot[dt][0] = (f32x4){0.f, 0.f, 0.f, 0.f}; tot[dt][1] = (f32x4){0.f, 0.f, 0.f, 0.f}; }
    const float one[2] = {1.f, 1.f};
    attn_fold(tot, st, one);
#pragma unroll
    for (int qt = 0; qt < 2; ++qt)
#pragma unroll
        for (int dt = 0; dt < 4; ++dt)
            *(uint2*)((dry ? (bf16_t*)(P.ws + W_Y) + (size_t)(b * S + t0 + 16 * qt + fr) * 1024 : ZA + (size_t)(b * S + t0 + 16 * qt + fr) * ZW + C_QX) + h * 64 + 16 * dt + 4 * fq) =
                make_uint2(pk2(tot[dt][qt][0], tot[dt][qt][1]), pk2(tot[dt][qt][2], tot[dt][qt][3]));
}

DEV void nsa_job(const Params& P, int job, char* smem, bool dry) {
    char* aux = (char*)P.out;
    bf16_t* ZA = (bf16_t*)(P.ws + W_ZA);
    const int pj_ = job >> 1, bg = pj_ & 31, qb = 63 - (2 * (pj_ >> 5) + (job & 1)), b = bg >> 2, g = bg & 3, t0 = qb * 32;
    bf16_t* sK = (bf16_t*)smem;
    bf16_t* sVt = (bf16_t*)(smem + 20480);
    float* sImp = (float*)(smem + 38912);
    unsigned* sSel = (unsigned*)(smem + 38912 + 4096);
    constexpr int KVBUF = 9728;
    const int tid = opaque_tid(), w = tid >> 6, lane = tid & 63, fr = lane & 15, fq = lane >> 4;
    const int head = g * 4 + (fr & 3);
    const int qi0 = 8 * w + (fr >> 2);
    int tq[2];
    bf16x8 qf[2][2];
#pragma unroll
    for (int qt = 0; qt < 2; ++qt) {
        tq[qt] = t0 + qi0 + 4 * qt;
        const bf16_t* rowp = ZA + (size_t)(b * S + tq[qt]) * ZW;
#pragma unroll
        for (int ks = 0; ks < 2; ++ks) qf[qt][ks] = *(const bf16x8*)(rowp + C_Q + head * 64 + 32 * ks + 8 * fq);
    }
    f32x4 tot[4][2];
#pragma unroll
    for (int dt = 0; dt < 4; ++dt) { tot[dt][0] = (f32x4){0.f, 0.f, 0.f, 0.f}; tot[dt][1] = (f32x4){0.f, 0.f, 0.f, 0.f}; }

    {
        const bf16_t* KC = (const bf16_t*)(aux + O_KC) + (size_t)bg * 128 * 64;
        const bf16_t* VCT = (const bf16_t*)(aux + O_VCT) + (size_t)bg * 64 * 128;
        __syncthreads();
#pragma unroll
        for (int i = 0; i < 4; ++i) {
            const int c = tid + 256 * i;
            { const int r = c >> 3, k = (c & 7) * 8; *(u32x4*)(sK + r * 80 + k) = *(const u32x4*)(KC + r * 64 + k); }
            { const int r = c >> 4, k = (c & 15) * 8; *(u32x4*)(sVt + r * 136 + k) = *(const u32x4*)(VCT + r * 128 + k); }
        }
        __syncthreads();
#pragma unroll
        for (int qt = 0; qt < 2; ++qt) {
            const float g0 = bf2f(ZA[(size_t)(b * S + tq[qt]) * ZW + C_G + head * 3 + 0]);
            f32x4 s[8];
#pragma unroll
            for (int kt = 0; kt < 8; ++kt) {
                s[kt] = (f32x4){0.f, 0.f, 0.f, 0.f};
#pragma unroll
                for (int ks = 0; ks < 2; ++ks) {
                    const bf16x8 kf = *(const bf16x8*)(sK + (16 * kt + fr) * 80 + 32 * ks + 8 * fq);
                    s[kt] = MFMA16(kf, qf[qt][ks], s[kt]);
                }
            }
            float mx = -INFINITY;
#pragma unroll
            for (int kt = 0; kt < 8; ++kt)
#pragma unroll
                for (int j = 0; j < 4; ++j) {
                    const int n = 16 * kt + 4 * fq + j;
                    const float v = (n < NCMP && 16 * n + 31 <= tq[qt]) ? s[kt][j] : -INFINITY;
                    s[kt][j] = v; mx = fmaxf(mx, v);
                }
            mx = fmaxf(mx, __shfl_xor(mx, 16)); mx = fmaxf(mx, __shfl_xor(mx, 32));
            const float msub = (mx == -INFINITY) ? 0.f : mx;
            float ps = 0.f;
#pragma unroll
            for (int kt = 0; kt < 8; ++kt)
#pragma unroll
                for (int j = 0; j < 4; ++j) { const float p = __builtin_amdgcn_exp2f((s[kt][j] - msub) * EXPC); s[kt][j] = p; ps += p; }
            ps += __shfl_xor(ps, 16); ps += __shfl_xor(ps, 32);
            const float inv = __builtin_amdgcn_rcpf(fmaxf(ps, 1e-30f));
            float bprev = 0.f;
#pragma unroll
            for (int kt = 0; kt < 8; ++kt) {
                s[kt] *= inv;
                const float a = s[kt][0] + s[kt][1] + s[kt][2] + 0.5f * s[kt][3];
                const float bq = 0.5f * s[kt][3];
                const float x = __shfl(bq, (lane + 48) & 63);
                const float y = __shfl(bprev, (lane + 48) & 63);
                float iv = a + (fq > 0 ? x : y);
                iv += __shfl_xor(iv, 1); iv += __shfl_xor(iv, 2);
                if ((fr & 3) == 0) sImp[(qi0 + 4 * qt) * 32 + 4 * kt + fq] = iv;
                bprev = bq;
            }
#pragma unroll
            for (int ks = 0; ks < 4; ++ks) {
                const f32x4 pa = s[2 * ks] * g0, pb = s[2 * ks + 1] * g0;
                const bf16x8 pf = mk8(pk2(pa[0], pa[1]), pk2(pa[2], pa[3]), pk2(pb[0], pb[1]), pk2(pb[2], pb[3]));
#pragma unroll
                for (int dt = 0; dt < 4; ++dt) {
                    const u32x2 v0 = *(const u32x2*)(sVt + (16 * dt + fr) * 136 + 32 * ks + 4 * fq);
                    const u32x2 v1 = *(const u32x2*)(sVt + (16 * dt + fr) * 136 + 32 * ks + 16 + 4 * fq);
                    tot[dt][qt] = MFMA16(mk8(v0.x, v0.y, v1.x, v1.y), pf, tot[dt][qt]);
                }
            }
            __builtin_amdgcn_sched_barrier(0);
        }
    }
#pragma unroll
    for (int qt = 0; qt < 2; ++qt) {
        bf16_t* op = (dry ? (bf16_t*)(P.ws + W_YX) + (size_t)(b * S + tq[qt]) * 1024 : ZA + (size_t)(b * S + tq[qt]) * ZW + C_Q) + head * 64 + 4 * fq;
#pragma unroll
        for (int dt = 0; dt < 4; ++dt) *(uint2*)(op + 16 * dt) = pk4(tot[dt][qt]);
    }
    __syncthreads();
    {
        float myv[4];
#pragma unroll
        for (int i = 0; i < 4; ++i) {
            const int pidx = tid + 256 * i, q = pidx >> 5, m = pidx & 31;
            const int t = t0 + q, cur = t >> 6;
            const float sum = sImp[q * 32 + m];
            const bool forced = (m == 0) || (m == cur) || (m == cur - 1);
            const bool future = m * 64 > t;
            myv[i] = forced ? INFINITY : (future ? -INFINITY : sum);
        }
        if (tid == 0) sSel[32] = 0u;
        __syncthreads();
#pragma unroll
        for (int i = 0; i < 4; ++i) { const int pidx = tid + 256 * i; sImp[pidx] = myv[i]; }
        __syncthreads();
        unsigned wun = 0u;
#pragma unroll
        for (int i = 0; i < 4; ++i) {
            const int pidx = tid + 256 * i, q = pidx >> 5, m = pidx & 31;
            const float v = myv[i];
            int rank = 0;
#pragma unroll
            for (int m2 = 0; m2 < 32; ++m2) {
                const float o = sImp[q * 32 + m2];
                rank += (o > v || (o == v && m2 < m)) ? 1 : 0;
            }
            const bool selb = (rank < 8) && (v > -INFINITY);
            const unsigned long long bal = __ballot(selb);
            const unsigned mk = (unsigned)(bal >> (32 * (lane >> 5)));
            if ((lane & 31) == 0) sSel[q] = mk;
            wun |= (unsigned)bal | (unsigned)(bal >> 32);
        }
        if (lane == 0) atomicOr(&sSel[32], wun);
    }
    __syncthreads();
    __shared__ unsigned s_xuni[2];
    if (tid == 0) s_xuni[threadIdx.x >> 8] = sSel[32];
    __syncthreads();
    const unsigned uni = s_xuni[0] | s_xuni[1];
    const int jmax = (t0 + 31) >> 6;
    const int t512 = opaque_tid512();
    bf16_t* shKV = (bf16_t*)(smem - (t512 >> 8) * 56320);
    {
        AttnAcc st; attn_init(st);
        const bf16_t* Kb = ZA + (size_t)(b * S) * ZW + C_KS + g * 64;
        const bf16_t* Vb = (const bf16_t*)(P.ws + W_VST) + (size_t)bg * 64 * S;
        unsigned rem = uni & ((2u << jmax) - 1u);
        u32x4 rk, rv;
        if (rem) { const int j0 = __builtin_ctz(rem); rk = ld64w(Kb + (size_t)(j0 * 64) * ZW, ZW, t512); rv = ld64w(Vb + j0 * 64, S, t512); }
        __syncthreads();
        int it = 0;
#pragma unroll 1
        while (rem) {
            const int jb = __builtin_ctz(rem);
            rem &= rem - 1u;
            bf16_t* sKb = shKV + (it & 1) * KVBUF; bf16_t* sVb = sKb + 64 * 80; ++it;
            st64w(sKb, rk, t512, 80); st64w(sVb, rv, t512, 72);
            __syncthreads();
            if (rem) { const int jn = __builtin_ctz(rem); rk = ld64w(Kb + (size_t)(jn * 64) * ZW, ZW, t512); rv = ld64w(Vb + jn * 64, S, t512); }
            __builtin_amdgcn_sched_barrier(0);
            const unsigned b0 = (sSel[qi0] >> jb) & 1u, b1 = (sSel[qi0 + 4] >> jb) & 1u;
            if (jb * 64 + 63 <= t0) {
                const bool need0 = __builtin_amdgcn_ballot_w64(b0 != 0u) != 0ull, need1 = __builtin_amdgcn_ballot_w64(b1 != 0u) != 0ull;
                const float bo[2] = {b0 ? 0.f : -INFINITY, b1 ? 0.f : -INFINITY};
                if (need0 && need1) attn_step_fast(sKb, sVb, qf, st, bo, fr, fq);
                else if (need0) attn_half_fast<0>(sKb, sVb, qf, st, bo[0], fr, fq);
                else if (need1) attn_half_fast<1>(sKb, sVb, qf, st, bo[1], fr, fq);
            } else {
                MaskSel mf; mf.bit[0] = b0; mf.bit[1] = b1; mf.t[0] = tq[0]; mf.t[1] = tq[1]; mf.k0 = jb * 64;
                attn_step(sKb, sVb, 72, qf, st, mf, fr, fq);
            }
        }
        { LOAD_GATE(g1, 1) bf16_t* const op2[2] = {OUTP(0), OUTP(1)}; attn_fold_out(op2, st, g1); }
    }
    {
        AttnAcc st; attn_init(st);
        const bf16_t* Kb = ZA + (size_t)(b * S) * ZW + C_KW + g * 64;
        const bf16_t* Vb = (const bf16_t*)(P.ws + W_VWT) + (size_t)bg * 64 * S;
#pragma unroll
        for (int qt = 0; qt < 2; ++qt) {
            const int npad = 511 - tq[qt];
            if (npad > 0) { st.m[qt] = 0.f; st.l[qt] = (fq == 0) ? (float)npad : 0.f; }
        }
        int jlo = t0 - 511; jlo = jlo < 0 ? 0 : (jlo >> 6);
        u32x4 rk = ld64w(Kb + (size_t)(jlo * 64) * ZW, ZW, t512), rv = ld64w(Vb + jlo * 64, S, t512);
        __syncthreads();
#pragma unroll 1
        for (int jb = jlo; jb <= jmax; ++jb) {
            bf16_t* sKb = shKV + ((jb - jlo) & 1) * KVBUF; bf16_t* sVb = sKb + 64 * 80;
            st64w(sKb, rk, t512, 80); st64w(sVb, rv, t512, 72);
            __syncthreads();
            if (jb < jmax) { rk = ld64w(Kb + (size_t)((jb + 1) * 64) * ZW, ZW, t512); rv = ld64w(Vb + (jb + 1) * 64, S, t512); }
            __builtin_amdgcn_sched_barrier(0);
            if (jb * 64 + 63 <= t0 && jb * 64 > t0 + 31 - 512) {
                const float z2[2] = {0.f, 0.f};
                attn_step_fast(sKb, sVb, qf, st, z2, fr, fq);
            } else {
                MaskWin mf; mf.t[0] = tq[0]; mf.t[1] = tq[1]; mf.k0 = jb * 64;
                attn_step(sKb, sVb, 72, qf, st, mf, fr, fq);
            }
        }
        { LOAD_GATE(g2, 2) bf16_t* const op2[2] = {OUTP(0), OUTP(1)}; attn_fold_out(op2, st, g2); }
    }
}


#define XB_TMO      128
#define XB_XCNT(j)  (256  + 64 * (j))
#define XB_XSUB(j)  (1280 + 64 * (j))
#define XB_XGEN(j)  (2304 + 64 * (j))
#define XB_TOP      3328
#define XB_TOPGEN   3392
#define XCD_BAR_WORDS 3456
#define XB_SPIN_CAP (1u << 18)
#define LAS __attribute__((address_space(3)))
DEV unsigned xb_ld(unsigned* p) { return __hip_atomic_load(p, __ATOMIC_RELAXED, __HIP_MEMORY_SCOPE_AGENT); }
DEV unsigned xb_add(unsigned* p, unsigned v) { return __hip_atomic_fetch_add(p, v, __ATOMIC_RELAXED, __HIP_MEMORY_SCOPE_AGENT); }
DEV unsigned xb_xcc_id() { return (unsigned)__builtin_amdgcn_s_getreg((3 << 11) | 20) & 0xFu; }
#define XB_SPIN(cond, bar) do { unsigned _sp = 0; while (cond) { __builtin_amdgcn_s_sleep(1); \
    if ((++_sp & 255u) == 0u) { if (xb_ld(&(bar)[XB_TMO])) break; if (_sp > XB_SPIN_CAP) { atomicAdd(&(bar)[XB_TMO], 1u); break; } } } } while (0)
struct XcdBarrier { unsigned* bar; unsigned x; volatile LAS unsigned* st; };
DEV XcdBarrier xcd_barrier_post(unsigned* bar, volatile LAS unsigned* st) {
    XcdBarrier b; b.bar = bar; b.x = xb_xcc_id(); b.st = st;
    if (threadIdx.x == 0) (void)xb_add(&bar[XB_XCNT(b.x)], 1u);
    return b;
}
DEV void xcd_barrier_complete(unsigned* bar, unsigned x, unsigned& nloc, unsigned& nx) {
    const unsigned G = gridDim.x * gridDim.y * gridDim.z;
    unsigned sum, cnt, mine, sp = 0u;
    for (;;) {
        sum = 0u; cnt = 0u; mine = 0u;
#pragma unroll
        for (unsigned j = 0; j < 16; ++j) { const unsigned c = xb_ld(&bar[XB_XCNT(j)]); sum += c; cnt += (c > 0u) ? 1u : 0u; mine = (j == x) ? c : mine; }
        if (sum == G) break;
        __builtin_amdgcn_s_sleep(1);
        if ((++sp & 255u) == 0u) { if (xb_ld(&bar[XB_TMO])) break; if (sp > XB_SPIN_CAP) { atomicAdd(&bar[XB_TMO], 1u); break; } }
    }
    nloc = mine > 0u ? mine : 1u; nx = cnt > 0u ? cnt : 1u;
}
DEV void xcd_barrier(const XcdBarrier& b) {
    asm volatile("s_waitcnt vmcnt(0)" ::: "memory");
    __syncthreads();
    if (threadIdx.x == 0) {
        unsigned* bar = b.bar;
        __builtin_amdgcn_s_waitcnt(0);
        unsigned nloc = b.st[0], nx = b.st[1];
        if (nloc == 0u) { xcd_barrier_complete(bar, b.x, nloc, nx); b.st[0] = nloc; b.st[1] = nx; }
        const unsigned old = xb_add(&bar[XB_XSUB(b.x)], 1u);
        const unsigned gen = old / nloc;
        if (old + 1u == (gen + 1u) * nloc) {
            __builtin_amdgcn_fence(__ATOMIC_RELEASE, "agent");
            asm volatile("s_waitcnt vmcnt(0)" ::: "memory");
            const unsigned og = xb_add(&bar[XB_TOP], 1u);
            const unsigned tg = og / nx;
            if (og + 1u == (tg + 1u) * nx) xb_add(&bar[XB_TOPGEN], 1u);
            else XB_SPIN(xb_ld(&bar[XB_TOPGEN]) == tg, bar);
            __builtin_amdgcn_fence(__ATOMIC_ACQUIRE, "agent");
            xb_add(&bar[XB_XGEN(b.x)], 1u);
            asm volatile("s_waitcnt vmcnt(0)" ::: "memory");
        } else {
            XB_SPIN(xb_ld(&bar[XB_XGEN(b.x)]) == gen, bar);
            __builtin_amdgcn_fence(__ATOMIC_ACQUIRE, "agent");
            asm volatile("s_waitcnt vmcnt(0)" ::: "memory");
        }
    }
    __syncthreads();
}
constexpr size_t W_BAR = 252 * MiB;

constexpr int HALF_SMEM = 56320;
static_assert(HALF_SMEM == 56320, "update nsa_job");
constexpr int SMEM_BYTES = 131072;

extern __shared__ __attribute__((aligned(16))) char dyn_smem[];
#define RUN_PG8(EPI_T, EPI_OBJ, A_, LDA_, BT_, LDB_, M_, N_, K_) { pg8::Gemm g_; g_.A = (A_); g_.Bt = (BT_); g_.M = (M_); g_.N = (N_); g_.K = (K_); g_.lda = (LDA_); g_.ldb = (LDB_); g_.gather = 0; \
        pg8::StaticOrder so_; so_.init((M_), (N_), (int)gridDim.x, (int)blockIdx.x); __syncthreads(); \
        pg8::gemm_phase<EPI_T, pg8::StaticOrder, true, true>((PG8_LAS unsigned char*)dyn_smem, g_, so_, (EPI_OBJ)); __syncthreads(); }

template <int PH, bool DRY = false>
DEV void run_phase(const Params& P, char* smem) {
    const int nb = gridDim.x, bid = blockIdx.x, sub = opaque_tid512() >> 8;
    char* hsm = smem + sub * HALF_SMEM;
    char* aux = (char*)P.out;
    char* ws = P.ws;
    bf16_t* ZA = (bf16_t*)(ws + W_ZA);
    if (PH == 0) {
        for (int pj = bid; pj < (5088 + 4096 + 512 + 64 + 64) / 2; pj += nb) {
            int j = 2 * pj + sub;
            if (j < 5088) {
                bool done = false;
#define TR(SRC, LD, DSTOFF, KK, NN, MAP, BLK)                                                                                  \
    if (!done) { const int nrt = (NN) / 64, nt = nrt * ((KK) / 64);                                                              \
        if (j < nt) { transpose_tile((SRC), (LD), (bf16_t*)(aux + (DSTOFF)), (KK), (j % nrt) * 64, (j / nrt) * 64, (MAP), hsm, (BLK) ? (NN) : 0); done = true; } else j -= nt; }
                TR(P.w_in, 7984, O_WTA, 1024, 5120, 1, 0)
                TR(P.w_in, 7984, O_WTB, 1024, 4096, 2, 0)
                TR(P.w_up, 4096, O_WTUP, 1024, 4096, 0, 0)
                TR(P.w_down, 1024, O_WTDN, 4096, 1024, 0, 0)
                TR(P.w_o, 1024, O_WTO, 1024, 1024, 0, 0)
                TR(P.w_xo, 1024, O_WTXO, 256, 1024, 0, 0)
                TR(P.w_mkv, 512, O_WTMKV, 1024, 512, 0, 0)
                TR(P.wk1, 256, O_WTCK1, 2048, 256, 0, 0)
                TR(P.wv1, 256, O_WTCV1, 2048, 256, 0, 0)
#undef TR
                if (!done) {
                    if (j < 16) transpose_tile(P.w_a + j * 4096, 64, (bf16_t*)(aux + O_WAT) + j * 4096, 64, 0, 0, 0, hsm);
                    else { j -= 16; transpose_tile(P.w_i + j * 4096, 64, (bf16_t*)(aux + O_WIT) + j * 4096, 64, 0, 0, 0, hsm); }
                }
                continue;
            }
            j -= 5088;
            if (j < 4096) { rownorm<false>(P.x, P.g_mix, (bf16_t*)(ws + W_U), nullptr, j * 4 + (opaque_tid() >> 6)); continue; }
            j -= 4096;
            if (j < 512) { rownorm<false>(P.mem, P.g_mem, (bf16_t*)(aux + O_MEMN), nullptr, j * 4 + (opaque_tid() >> 6)); continue; }
            j -= 512;
            if (j < 64) { rope_job((float*)(aux + O_ROPEC), (float*)(aux + O_ROPES), j); continue; }
            j -= 64;
            posbias_job(P, (float*)(aux + O_PB), j, hsm);
        }
    } else if (PH == 1) {
        { PEpiMemKV ep; ep.MK = (bf16_t*)(aux + O_MEMK); ep.MVT = (bf16_t*)(aux + O_MEMVT);
          RUN_PG8(PEpiMemKV, ep, (const bf16_t*)(aux + O_MEMN), 1024, (const bf16_t*)(aux + O_WTMKV), 1024, 2048, 512, 1024) }
        { PEpiZA ep; ep.ZA = ZA; ep.VST = (bf16_t*)(ws + W_VST); ep.VWT = (bf16_t*)(ws + W_VWT); ep.ropec = (const float*)(aux + O_ROPEC); ep.ropes = (const float*)(aux + O_ROPES);
          RUN_PG8(PEpiZA, ep, (const bf16_t*)(ws + W_U), 1024, (const bf16_t*)(aux + O_WTA), 1024, 16384, 5120, 1024) }
    } else if (PH == 2) {
        { PEpiHid ep; ep.HK = (bf16_t*)(aux + O_HIDK); ep.HV = (bf16_t*)(aux + O_HIDV); ep.pb = (const float*)(aux + O_PB);
          pg8::Gemm g_; g_.A = ZA; g_.Bt = (const bf16_t*)(aux + O_WTCK1); g_.M = 4096; g_.N = 512; g_.K = 2048; g_.lda = ZW; g_.ldb = 2048; g_.gather = 1;
          pg8::StaticOrder so_; so_.init(4096, 512, (int)gridDim.x, (int)blockIdx.x); __syncthreads();
          pg8::gemm_phase<PEpiHid, pg8::StaticOrder, true, true>((PG8_LAS unsigned char*)dyn_smem, g_, so_, ep); __syncthreads(); }
        for (int job = bid; job < 576; job += nb) {
            if (job < 256) rnn_job(P, 2 * job + sub, hsm, DRY);
            else if (job >= 288 && job < 512) xattn_job(P, 2 * (job - 288) + sub, hsm, DRY);
            else if (job >= 544) xattn_job(P, 2 * (job - 320) + sub, hsm, DRY);
        }
    } else if (PH == 3) {
        for (int pj = bid; pj < 1016; pj += nb) cmp2_job(P, 2 * pj + sub);
    } else if (PH == 4) {
        for (int job = bid; job < 1024; job += nb) nsa_job(P, 2 * job + sub, hsm, DRY);
        if (!DRY) { PEpiBf<0> ep; ep.O = (bf16_t*)(ws + W_YX); ep.ldo = 1024;
          RUN_PG8(PEpiBf<0>, ep, ZA + C_QX, ZW, (const bf16_t*)(aux + O_WTXO), 256, 16384, 1024, 256) }
    } else if (PH == 5) {
        { PEpiMerge ep; ep.ZA = ZA; ep.YX = (const bf16_t*)(ws + W_YX); ep.Y = (bf16_t*)(ws + W_Y);
          RUN_PG8(PEpiMerge, ep, (const bf16_t*)(ws + W_U), 1024, (const bf16_t*)(aux + O_WTB), 1024, 16384, 4096, 1024) }
    } else if (PH == 6) {
        { PEpiRes ep; ep.R = P.x; ep.O = (float*)(ws + W_H);
          RUN_PG8(PEpiRes, ep, (const bf16_t*)(ws + W_Y), 1024, (const bf16_t*)(aux + O_WTO), 1024, 16384, 1024, 1024) }
    } else if (PH == 7) {
        for (int pj = bid; pj < 2048; pj += nb) rownorm<false>((const float*)(ws + W_H), P.g_mlp, (bf16_t*)(ws + W_VN), nullptr, (2 * pj + sub) * 4 + (opaque_tid() >> 6));
    } else if (PH == 8) {
        { PEpiBf<1> ep; ep.O = (bf16_t*)(ws + W_HID); ep.ldo = 4096;
          RUN_PG8(PEpiBf<1>, ep, (const bf16_t*)(ws + W_VN), 1024, (const bf16_t*)(aux + O_WTUP), 1024, 16384, 4096, 1024) }
    } else if (PH == 9) {
        { PEpiRes ep; ep.R = (const float*)(ws + W_H); ep.O = (float*)(ws + W_H);
          RUN_PG8(PEpiRes, ep, (const bf16_t*)(ws + W_HID), 4096, (const bf16_t*)(aux + O_WTDN), 4096, 16384, 1024, 4096) }
    } else if (PH == 10) {
        for (int pj = bid; pj < 2048; pj += nb) rownorm<true>((const float*)(ws + W_H), P.g_final, nullptr, P.out, (2 * pj + sub) * 4 + (opaque_tid() >> 6));
    }
}

__global__ void __launch_bounds__(512, 2) mega_kernel(Params P) {
    char* smem = dyn_smem;
    cg::grid_group grid = cg::this_grid();
    __shared__ uint4 xb_words;
    if (threadIdx.x == 0) xb_words = make_uint4(0u, 0u, 0u, 0u);
    __syncthreads();
    XcdBarrier xb = xcd_barrier_post((unsigned*)(P.ws + W_BAR), (volatile LAS unsigned*)&xb_words);
    if (P.ws == nullptr) grid.sync();
#ifndef REP
#define REP -1
#endif
#define GSYNC() xcd_barrier(xb)
#define PHASE(k) { if (REP == k && k != 9) { run_phase<k, true>(P, smem); GSYNC(); } run_phase<k>(P, smem); GSYNC(); }
    PHASE(0) PHASE(1) PHASE(2) PHASE(3) PHASE(4) PHASE(5) PHASE(6) PHASE(7) PHASE(8) PHASE(9)
    if (REP == 10) { run_phase<10>(P, smem); GSYNC(); }
    if (REP == 11) { GSYNC(); GSYNC(); GSYNC(); GSYNC(); GSYNC(); GSYNC(); GSYNC(); GSYNC(); GSYNC(); GSYNC(); }
    run_phase<10>(P, smem);
}

extern "C" void kernel_launch(void* const* d_in, const int* in_sizes, int n_in, void* d_out, int out_size, void* d_ws, size_t ws_size,
                              hipStream_t stream) {
    Params P{};
    const float** pp = (const float**)&P;
    for (int i = 0; i < 25; ++i) pp[i] = (const float*)d_in[i];
    P.out = (float*)d_out;
    P.ws = (char*)d_ws;
    static int grid_blocks = 0;
    if (!grid_blocks) {
        int dev = 0, cus = 0, per_cu = 0;
        hipGetDevice(&dev);
        hipDeviceGetAttribute(&cus, hipDeviceAttributeMultiprocessorCount, dev);
        hipFuncSetAttribute((const void*)mega_kernel, hipFuncAttributeMaxDynamicSharedMemorySize, SMEM_BYTES);
        hipOccupancyMaxActiveBlocksPerMultiprocessor(&per_cu, mega_kernel, 512, SMEM_BYTES);
        if (per_cu > 1) per_cu = 1;
        if (per_cu < 1) per_cu = 1;
        grid_blocks = cus * per_cu;
    }
    hipMemsetAsync((char*)d_ws + W_BAR, 0, XCD_BAR_WORDS * 4, stream);
    void* args[] = {&P};
    hipError_t e = hipLaunchCooperativeKernel((void*)mega_kernel, dim3(grid_blocks), dim3(512), args, SMEM_BYTES, stream);
    if (e != hipSuccess) fprintf(stderr, "cooperative launch failed: %s (grid %d)\n", hipGetErrorString(e), grid_blocks);
}
```

```cpp
#include <hip/hip_runtime.h>
#include <hip/hip_cooperative_groups.h>
#include <cstdint>
#include <cstdio>
namespace cg = cooperative_groups;

#ifndef MULTI
#define MULTI 0
#endif

typedef unsigned short bf16_t;
typedef short bf16x8 __attribute__((ext_vector_type(8)));
typedef float f32x4 __attribute__((ext_vector_type(4)));
typedef __bf16 bfv2 __attribute__((ext_vector_type(2)));
typedef float f32x2 __attribute__((ext_vector_type(2)));
typedef unsigned u32x4 __attribute__((ext_vector_type(4)));
typedef unsigned u32x2 __attribute__((ext_vector_type(2)));
#define DEV __device__ __forceinline__
DEV int opaque_tid() { int t = threadIdx.x & 255; asm volatile("" : "+v"(t)); return t; }
DEV int opaque_tid512() { int t = threadIdx.x; asm volatile("" : "+v"(t)); return t; }
#define MFMA16(a, b, c) __builtin_amdgcn_mfma_f32_16x16x32_bf16((a), (b), (c), 0, 0, 0)

constexpr int T = 16384, S = 2048;
constexpr int ZW = 4480;
constexpr int C_Q = 0, C_KC = 1024, C_VC = 1280, C_KS = 1536, C_KW = 1792, C_XR = 2048, C_GR = 3072, C_QX = 4096, C_G = 4352;
constexpr int NCMP = 127;
constexpr int NCROWS = 4064;

constexpr size_t O_WTA = 0;
constexpr size_t O_WTB = O_WTA + (size_t)5120 * 1024 * 2;
constexpr size_t O_WTUP = O_WTB + (size_t)4096 * 1024 * 2;
constexpr size_t O_WTDN = O_WTUP + (size_t)4096 * 1024 * 2;
constexpr size_t O_WTO = O_WTDN + (size_t)4096 * 1024 * 2;
constexpr size_t O_WTXO = O_WTO + (size_t)1024 * 1024 * 2;
constexpr size_t O_WTMKV = O_WTXO + (size_t)1024 * 256 * 2;
constexpr size_t O_WTCK1 = O_WTMKV + (size_t)512 * 1024 * 2;
constexpr size_t O_WTCV1 = O_WTCK1 + (size_t)256 * 2048 * 2;
constexpr size_t O_WAT = O_WTCV1 + (size_t)256 * 2048 * 2;
constexpr size_t O_WIT = O_WAT + (size_t)16 * 64 * 64 * 2;
constexpr size_t O_ROPEC = O_WIT + (size_t)16 * 64 * 64 * 2;
constexpr size_t O_ROPES = O_ROPEC + (size_t)2048 * 8 * 4;
constexpr size_t O_MEMN = O_ROPES + (size_t)2048 * 8 * 4;
constexpr size_t O_MEMK = O_MEMN + (size_t)2048 * 1024 * 2;
constexpr size_t O_MEMVT = O_MEMK + (size_t)2048 * 256 * 2;
constexpr size_t O_HIDK = O_MEMVT + (size_t)2048 * 256 * 2;
constexpr size_t O_HIDV = O_HIDK + (size_t)4096 * 256 * 2;
constexpr size_t O_KC = O_HIDV + (size_t)4096 * 256 * 2;
constexpr size_t O_VCT = O_KC + (size_t)32 * 128 * 64 * 2;
constexpr size_t O_PB = O_VCT + (size_t)32 * 64 * 128 * 2;
constexpr size_t O_AUX_END = O_PB + 16384;
static_assert(O_AUX_END <= (size_t)64 << 20, "aux overflow");
constexpr size_t MiB = (size_t)1 << 20;
constexpr size_t W_U = 0, W_ZA = 32 * MiB, W_VST = 172 * MiB, W_VWT = 180 * MiB, W_YX = 188 * MiB, W_Y = 220 * MiB;
constexpr size_t W_H = 32 * MiB, W_VN = 0, W_HID = 96 * MiB;

struct Params {
    const float *x, *mem, *g_mix, *w_in, *cpk, *cpv, *wk1, *wk2, *wv1, *wv2, *conv_w, *conv_b, *w_a, *b_a, *w_i, *b_i, *lam,
        *g_mem, *w_mkv, *w_xo, *w_o, *g_mlp, *w_up, *w_down, *g_final;
    float* out;
    char* ws;
};

DEV float bf2f(bf16_t h) { return __uint_as_float(((unsigned)h) << 16); }
DEV unsigned pk2(float lo, float hi) { f32x2 v = {lo, hi}; bfv2 b = __builtin_convertvector(v, bfv2); return __builtin_bit_cast(unsigned, b); }
DEV bf16_t f2bf(float f) { return (bf16_t)(pk2(f, 0.f) & 0xffffu); }
DEV float lo_f(unsigned u) { return __uint_as_float(u << 16); }
DEV float hi_f(unsigned u) { return __uint_as_float(u & 0xffff0000u); }
DEV float sigm(float x) { return __builtin_amdgcn_rcpf(1.f + __expf(-x)); }
DEV float gelu_t(float x) {
    float y = 0.7978845608028654f * (x + 0.044715f * x * x * x);
    float e = __expf(2.f * y);
    float th = 1.f - 2.f * __builtin_amdgcn_rcpf(1.f + e);
    return 0.5f * x * (1.f + th);
}
DEV float wave_sum(float v) {
#pragma unroll
    for (int o = 32; o >= 1; o >>= 1) v += __shfl_xor(v, o);
    return v;
}

DEV int map_col(int mapid, int r) {
    if (mapid == 0) return r;
    if (mapid == 1) {
        if (r < 1536) return r;
        if (r < 1792) return 1536 + (r - 1536);
        if (r < 2048) return 2048 + (r - 1792);
        if (r < 3072) return 2608 + (r - 2048);
        if (r < 4096) return 3632 + (r - 3072);
        if (r < 4352) return 4656 + (r - 4096);
        if (r < 4608) return 1792 + (r - 4352);
        if (r < 4864) return 2304 + (r - 4608);
        if (r < 4912) return 2560 + (r - 4864);
        return -1;
    }
    const int pn = r >> 8, rem = r & 255, bj = rem >> 7, wc = (rem >> 5) & 3, n = (rem >> 4) & 1, c16 = rem & 15, slot = 2 * bj + n;
    if (slot == 3) return -1;
    return 4912 + slot * 1024 + pn * 64 + wc * 16 + c16;
}

DEV void transpose_tile(const float* __restrict__ src, int ld, bf16_t* __restrict__ dst, int K, int r0, int k0, int mapid, char* smem, int nblk = 0) {
    float* sm = (float*)smem;
    const int tid = threadIdx.x & 255, lane = tid & 63, w = tid >> 6;
    __syncthreads();
    const int sc = map_col(mapid, r0 + lane);
#pragma unroll
    for (int i = 0; i < 16; ++i) {
        int kk = w + 4 * i;
        float v = sc >= 0 ? src[(size_t)(k0 + kk) * ld + sc] : 0.f;
        sm[kk * 65 + lane] = v;
    }
    __syncthreads();
    const int rr = tid >> 2, kq = (tid & 3) * 16;
    unsigned o[8];
#pragma unroll
    for (int e = 0; e < 8; ++e) o[e] = pk2(sm[(kq + 2 * e) * 65 + rr], sm[(kq + 2 * e + 1) * 65 + rr]);
    uint4* dp = nblk ? (uint4*)(dst + (size_t)(k0 >> 6) * nblk * 64 + (size_t)(r0 + rr) * 64 + kq) : (uint4*)(dst + (size_t)(r0 + rr) * K + k0 + kq);
    dp[0] = make_uint4(o[0], o[1], o[2], o[3]);
    dp[1] = make_uint4(o[4], o[5], o[6], o[7]);
}

template <bool OUTF32>
DEV void rownorm(const float* __restrict__ src, const float* __restrict__ g, bf16_t* dstb, float* dstf, int row, bool blk = false) {
    const int lane = opaque_tid() & 63;
    const float4* sp = (const float4*)(src + (size_t)row * 1024);
    float4 v[4];
    float ss = 0.f;
#pragma unroll
    for (int i = 0; i < 4; ++i) { v[i] = sp[lane + 64 * i]; ss += v[i].x * v[i].x + v[i].y * v[i].y + v[i].z * v[i].z + v[i].w * v[i].w; }
    ss = wave_sum(ss);
    const float r = rsqrtf(ss * (1.0f / 1024.0f) + 1e-6f);
#pragma unroll
    for (int i = 0; i < 4; ++i) {
        float4 gg = ((const float4*)g)[lane + 64 * i];
        float a = v[i].x * r * gg.x, b = v[i].y * r * gg.y, c = v[i].z * r * gg.z, d = v[i].w * r * gg.w;
        if (OUTF32) ((float4*)(dstf + (size_t)row * 1024))[lane + 64 * i] = make_float4(a, b, c, d);
        else if (blk) { const int col = 4 * (lane + 64 * i); *(uint2*)(dstb + (size_t)(col >> 6) * ((size_t)16384 * 64) + (size_t)row * 64 + (col & 63)) = make_uint2(pk2(a, b), pk2(c, d)); }
        else ((uint2*)(dstb + (size_t)row * 1024))[lane + 64 * i] = make_uint2(pk2(a, b), pk2(c, d));
    }
}

DEV void rope_job(float* ct, float* st, int job) {
    const int e = job * 256 + (threadIdx.x & 255);
    const int pos = e >> 3, i = e & 7;
    const double inv = exp(-(double)i * 0.125 * 13.122363377404328);
    const double ang = (double)pos * inv;
    const double kq = rint(ang * 0.6366197723675814);
    const double r = ang - kq * 1.5707963267948966;
    const double r2 = r * r;
    const double sn = r * (1.0 + r2 * (-1.0 / 6 + r2 * (1.0 / 120 + r2 * (-1.0 / 5040 + r2 * (1.0 / 362880 + r2 * (-1.0 / 39916800 + r2 * (1.0 / 6227020800.0)))))));
    const double cs = 1.0 + r2 * (-0.5 + r2 * (1.0 / 24 + r2 * (-1.0 / 720 + r2 * (1.0 / 40320 + r2 * (-1.0 / 3628800 + r2 * (1.0 / 479001600.0))))));
    const int q = ((int)kq) & 3;
    double s_, c_;
    if (q == 0) { s_ = sn; c_ = cs; } else if (q == 1) { s_ = cs; c_ = -sn; } else if (q == 2) { s_ = -sn; c_ = -cs; } else { s_ = -cs; c_ = sn; }
    ct[e] = (float)c_; st[e] = (float)s_;
}

DEV void posbias_job(const Params& P, float* PB, int job, char* smem) {
    float* sred = (float*)smem;
    const int tid = opaque_tid(), which = job >> 5, cgi = (job >> 3) & 3, kc = job & 7, c = cgi * 64 + (tid & 63), kp = tid >> 6;
    const float* pos = (which ? P.cpv : P.cpk) + kc * 256 + kp * 64;
    const float* w1 = (which ? P.wv1 : P.wk1) + (size_t)(kc * 256 + kp * 64) * 256 + c;
    float a0 = 0.f, a1 = 0.f, a2 = 0.f, a3 = 0.f;
#pragma unroll 4
    for (int k = 0; k < 64; k += 4) {
        a0 += pos[k] * w1[(size_t)k * 256]; a1 += pos[k + 1] * w1[(size_t)(k + 1) * 256];
        a2 += pos[k + 2] * w1[(size_t)(k + 2) * 256]; a3 += pos[k + 3] * w1[(size_t)(k + 3) * 256];
    }
    __syncthreads();
    sred[kp * 64 + (tid & 63)] = (a0 + a1) + (a2 + a3);
    __syncthreads();
    if (tid < 64) PB[(which * 8 + kc) * 256 + c] = (sred[tid] + sred[64 + tid]) + (sred[128 + tid] + sred[192 + tid]);
}

struct ALPlain {
    const bf16_t* A; int lda; int ks;
    const char* base; unsigned off0;
    DEV void init(int row0, int lrow, int lk) { base = (const char*)(A + (size_t)row0 * lda); off0 = (unsigned)(lrow * lda + lk) * 2u; }
    DEV u32x4 load(int i, int k0) const { return *(const u32x4*)(base + (off0 + (unsigned)(i * 128 * lda) + (unsigned)(k0 >> 6) * (unsigned)(ks * 2))); }
    DEV u32x4 fix(int, const u32x4& v, int) const { return v; }
};
struct ALCmp {
    const bf16_t* ZA; const float* spos; int colbase;
    unsigned roff[4]; int lk_;
    DEV void init(int row0, int lrow, int lk) {
        lk_ = lk;
#pragma unroll
        for (int i = 0; i < 4; ++i) {
            const int row = row0 + lrow + 64 * i;
            const int bg = row / NCMP, n = row - bg * NCMP, b = bg >> 2, g = bg & 3;
            roff[i] = row < NCROWS ? (unsigned)(((b * S + 16 * n) * ZW + colbase + g * 64 + lk) * 2) : 0xffffffffu;
        }
    }
    DEV u32x4 load(int i, int k0) const {
        if (roff[i] == 0xffffffffu) return (u32x4){0u, 0u, 0u, 0u};
        return *(const u32x4*)((const char*)ZA + (roff[i] + (unsigned)((k0 >> 6) * ZW * 2)));
    }
    DEV u32x4 fix(int i, const u32x4& v, int k0) const {
        if (roff[i] == 0xffffffffu) return v;
        const float4 p0 = *(const float4*)(spos + k0 + lk_), p1 = *(const float4*)(spos + k0 + lk_ + 4);
        u32x4 o;
        o.x = pk2(lo_f(v.x) + p0.x, hi_f(v.x) + p0.y); o.y = pk2(lo_f(v.y) + p0.z, hi_f(v.y) + p0.w);
        o.z = pk2(lo_f(v.z) + p1.x, hi_f(v.z) + p1.y); o.w = pk2(lo_f(v.w) + p1.z, hi_f(v.w) + p1.w);
        return o;
    }
};

template <int TM, int TN, bool SWAP, class AL, class EP>
DEV void gemm_tile(AL al, const bf16_t* __restrict__ Bt, int ldb, int bks, int K, int pm, int pn, const EP& ep, char* smem) {
    constexpr int BM = TM * 32, BN = TN * 64, NA = BM / 64, NBB = (BN + 63) / 64;
    bf16_t* sA = (bf16_t*)smem;
    bf16_t* sB = sA + BM * 72;
    const int tid = opaque_tid512(), wid = tid >> 6, lane = tid & 63, wr = wid >> 2, wc = wid & 3, fr = lane & 15, fq = lane >> 4;
    f32x4 acc[TM][TN];
#pragma unroll
    for (int m = 0; m < TM; ++m)
#pragma unroll
        for (int n = 0; n < TN; ++n) acc[m][n] = (f32x4){0.f, 0.f, 0.f, 0.f};
    const int lrow = tid >> 3, lk = (tid & 7) * 8;
    u32x4 ra[NA], rb[NBB];
    al.init(pm * BM, lrow, lk);
    const char* bbase = (const char*)(Bt + (size_t)(pn * BN) * ldb);
    const unsigned boff = (unsigned)(lrow * ldb + lk) * 2u;
#pragma unroll
    for (int i = 0; i < NBB; ++i) rb[i] = (u32x4){0u, 0u, 0u, 0u};
#pragma unroll
    for (int i = 0; i < NA; ++i) ra[i] = al.load(i, 0);
#pragma unroll
    for (int i = 0; i < NBB; ++i) if (BN % 64 == 0 || lrow + 64 * i < BN) rb[i] = *(const u32x4*)(bbase + (boff + (unsigned)(i * 128 * ldb)));
    int nk = K >> 6;
    asm volatile("" : "+s"(nk));
    bf16_t* sWa = sA + lrow * 72 + lk;
    bf16_t* sWb = sB + lrow * 72 + lk;
    const bf16_t* sAr = sA + (wr * TM * 16 + fr) * 72 + fq * 8;
    const bf16_t* sBr = sB + (wc * TN * 16 + fr) * 72 + fq * 8;
#pragma unroll 1
    for (int kt = 0; kt < nk; ++kt) {
        __syncthreads();
#pragma unroll
        for (int i = 0; i < NA; ++i) *(u32x4*)(sWa + (64 * i) * 72) = al.fix(i, ra[i], kt * 64);
#pragma unroll
        for (int i = 0; i < NBB; ++i) if (BN % 64 == 0 || lrow + 64 * i < BN) *(u32x4*)(sWb + (64 * i) * 72) = rb[i];
        __syncthreads();
        if (kt + 1 < nk) {
            const int k0 = (kt + 1) * 64;
#pragma unroll
            for (int i = 0; i < NA; ++i) ra[i] = al.load(i, k0);
#pragma unroll
            for (int i = 0; i < NBB; ++i) if (BN % 64 == 0 || lrow + 64 * i < BN) rb[i] = *(const u32x4*)(bbase + (boff + (unsigned)(i * 128 * ldb) + (unsigned)(k0 >> 6) * (unsigned)(bks * 2)));
        }
        __builtin_amdgcn_sched_barrier(0);
        __builtin_amdgcn_s_setprio(1);
#pragma unroll
        for (int ks = 0; ks < 2; ++ks) {
            bf16x8 bfr[TN];
#pragma unroll
            for (int n = 0; n < TN; ++n) bfr[n] = *(const bf16x8*)(sBr + (n * 16) * 72 + ks * 32);
#pragma unroll
            for (int m = 0; m < TM; ++m) {
                const bf16x8 af = *(const bf16x8*)(sAr + (m * 16) * 72 + ks * 32);
#pragma unroll
                for (int n = 0; n < TN; ++n) acc[m][n] = SWAP ? MFMA16(bfr[n], af, acc[m][n]) : MFMA16(af, bfr[n], acc[m][n]);
            }
        }
        __builtin_amdgcn_s_setprio(0);
    }
    ep.run(acc, pm * BM + wr * TM * 16, pn * BN + wc * TN * 16, fr, fq);
}

DEV uint2 pk4(const f32x4& a) { return make_uint2(pk2(a[0], a[1]), pk2(a[2], a[3])); }

namespace pg8 {
#define PG8_LAS __attribute__((address_space(3)))
typedef unsigned short bf16_t;
typedef short bf16x8 __attribute__((ext_vector_type(8)));
typedef float f32x4 __attribute__((ext_vector_type(4)));
typedef unsigned u32x4 __attribute__((ext_vector_type(4)));
constexpr int BM = 256, BK = 64, HALF = 128, HTB = HALF * BK * 2  , STAGE_BYTES = 8 * HTB, NXCD = 8, WGM = 8;

__host__ __device__ __forceinline__ int lds_byte(int r, int c) { const int st = (r >> 4) * 2 + (c >> 5), rr = r & 15, cc = c & 31, ob = rr * 64 + cc * 2; return st * 1024 + (ob ^ (((ob >> 9) & 1) << 5)); }
__host__ __device__ __forceinline__ void stage_rc(int b, int& R, int& C) { const int st = b / 1024, sb = b % 1024, swz = sb ^ (((sb >> 9) & 1) << 5); R = (st >> 1) * 16 + swz / 64; C = (st & 1) * 32 + (swz % 64) / 2; }
__host__ __device__ __forceinline__ int perm32(int rho) { const int n = rho >> 4, i = rho & 15; return 8 * (i >> 2) + 4 * n + (i & 3); }

struct Unit { int pm, pn; };
struct Gemm { const bf16_t* A; const bf16_t* Bt; int M, N, K, lda, ldb; int gather; };

struct StaticOrder {
    int nM, nN, nwg, G, c;
    __host__ __device__ void init(int M, int N, int G_, int c_) { nM = M / BM; nN = N / BM; nwg = nM * nN; G = G_; c = c_; }
    __host__ __device__ bool next(int i, Unit& u) const {
        const long L = (long)i * G + c; if (L >= nwg) return false;
        int wgid = (int)L; { const int q = nwg / NXCD, r = nwg % NXCD, xcd = wgid % NXCD, off = wgid / NXCD; wgid = (xcd < r ? xcd * (q + 1) : r * (q + 1) + (xcd - r) * q) + off; }
        const int nig = WGM * nN, gid = wgid / nig, fm = gid * WGM, gsz = (nM - fm) < WGM ? (nM - fm) : WGM;
        u.pm = fm + ((wgid % nig) % gsz); u.pn = (wgid % nig) / gsz; return true;
    }
    __device__ __forceinline__ void a_ready(const Unit&) const {}
    __device__ __forceinline__ void done(const Unit&) const {}
};

template <class Epi, class Sched, bool ALIGN_EPI = false, bool SP2 = false>
__device__ __forceinline__ void gemm_phase(PG8_LAS unsigned char* lds, const Gemm g, const Sched& S, const Epi& E) {
    const int tid = opaque_tid512(), wid = __builtin_amdgcn_readfirstlane(tid >> 6), lane = tid & 63, wr = wid >> 2, wc = wid & 3, fr = lane & 15, fq = lane >> 4;
    const int K = g.K, nt = K / BK;
    unsigned voffA2[2][2], voffB[2];
#pragma unroll
    for (int i = 0; i < 2; ++i) { int R, C; stage_rc(tid * 16 + i * 8192, R, C); const int Rb = Epi::PERM ? ((R & ~31) + perm32(R & 31)) : R;
        voffA2[0][i] = (unsigned)(R * g.lda + C) * 2u; voffA2[1][i] = voffA2[0][i]; voffB[i] = (unsigned)(Rb * g.ldb + C) * 2u; }
    const size_t kstepB = (size_t)(BK * 2), kstepA = g.gather ? (size_t)(ZW * 2) : kstepB;
    const size_t hstepA = g.gather ? (size_t)0 : (size_t)HALF * g.lda * 2, hstepB = (size_t)HALF * g.ldb * 2;
    const size_t tstepA = 2 * hstepA, tstepB = 2 * hstepB;
    const unsigned ldsw = (unsigned)wid * 1024u;
    const int aoff = lds_byte(wr * 64 + fr, fq * 8), boff = lds_byte(wc * 32 + fr, fq * 8);
#define PG8_SA(b, h) (((b) * 2 + (h)) * HTB)
#define PG8_SB(b, h) ((4 + (b) * 2 + (h)) * HTB)
#define PG8_STAGE(bufoff, gbase, voff) do { _Pragma("unroll") for (int _i = 0; _i < 2; ++_i) \
        __builtin_amdgcn_global_load_lds((const unsigned*)((const char*)(gbase) + (voff)[_i]), (PG8_LAS unsigned*)(lds + (bufoff) + ldsw + _i * 8192), 16, 0, 0); } while (0)
#define PG8_LDA(dst, b, h) do { _Pragma("unroll") for (int m = 0; m < 4; ++m) _Pragma("unroll") for (int k = 0; k < 2; ++k) dst[m][k] = *(const PG8_LAS bf16x8*)(lds + PG8_SA(b, h) + aoff + m * 2048 + k * 1024); } while (0)
#define PG8_LDB(dst, b, h) do { _Pragma("unroll") for (int n = 0; n < 2; ++n) _Pragma("unroll") for (int k = 0; k < 2; ++k) dst[n][k] = *(const PG8_LAS bf16x8*)(lds + PG8_SB(b, h) + boff + n * 2048 + k * 1024); } while (0)
#define PG8_MMA(ai, bj, At, Bt) do { __builtin_amdgcn_s_setprio(1); _Pragma("unroll") for (int m = 0; m < 4; ++m) _Pragma("unroll") for (int n = 0; n < 2; ++n) _Pragma("unroll") for (int k = 0; k < 2; ++k) \
        acc[ai][bj][m][n] = __builtin_amdgcn_mfma_f32_16x16x32_bf16(Bt[n][k], At[m][k], acc[ai][bj][m][n], 0, 0, 0); __builtin_amdgcn_s_setprio(0); } while (0)
#define PG8_WAIT_V(n) asm volatile("s_waitcnt vmcnt(" #n ")" ::: "memory")
#define PG8_WAIT_L(n) asm volatile("s_waitcnt lgkmcnt(" #n ")" ::: "memory")
#define PG8_BAR __builtin_amdgcn_s_barrier()
#define PG8_SCHED __builtin_amdgcn_sched_barrier(0)
    Unit cur, nxt; int ui = 0;
    if (!S.next(0, cur)) return;
    f32x4 acc[2][2][4][2];
#pragma unroll
    for (int a = 0; a < 2; ++a)
#pragma unroll
        for (int b = 0; b < 2; ++b)
#pragma unroll
            for (int m = 0; m < 4; ++m)
#pragma unroll
                for (int n = 0; n < 2; ++n) acc[a][b][m][n] = (f32x4){0.f, 0.f, 0.f, 0.f};
    bf16x8 At[4][2], B0[2][2], B1[2][2];
    const char* cA = (const char*)g.A + (g.gather ? (size_t)0 : (size_t)cur.pm * tstepA); const char* cB = (const char*)g.Bt + (size_t)cur.pn * tstepB;
    if (g.gather) {
#pragma unroll
        for (int h = 0; h < 2; ++h)
#pragma unroll
            for (int i = 0; i < 2; ++i) { int R, C; stage_rc(tid * 16 + i * 8192, R, C);
                int r = cur.pm * 256 + h * HALF + R; r = r < NCROWS ? r : NCROWS - 1;
                const int bg = r / NCMP, n = r - bg * NCMP;
                voffA2[h][i] = (unsigned)((((bg >> 2) * ::S + 16 * n) * ZW + (cur.pn ? C_VC : C_KC) + (bg & 3) * 64 + C) * 2); }
    }
    S.a_ready(cur);
    if constexpr (SP2) {
        PG8_STAGE(PG8_SB(0, 0), cB, voffB); PG8_STAGE(PG8_SB(0, 1), cB + hstepB, voffB); PG8_STAGE(PG8_SA(0, 0), cA, voffA2[0]); PG8_STAGE(PG8_SA(0, 1), cA + hstepA, voffA2[1]);
        if (wr == 1) PG8_BAR;
        PG8_WAIT_V(2); PG8_BAR;
        PG8_STAGE(PG8_SB(1, 0), cB + kstepB, voffB); PG8_STAGE(PG8_SA(1, 0), cA + kstepA, voffA2[0]); PG8_STAGE(PG8_SB(1, 1), cB + hstepB + kstepB, voffB);
        PG8_WAIT_V(6); PG8_BAR;
    } else {
        PG8_STAGE(PG8_SB(0, 0), cB, voffB); PG8_STAGE(PG8_SA(0, 0), cA, voffA2[0]); PG8_STAGE(PG8_SB(0, 1), cB + hstepB, voffB); PG8_STAGE(PG8_SA(0, 1), cA + hstepA, voffA2[1]);
        if (wr == 1) PG8_BAR;
        PG8_WAIT_V(4); PG8_BAR;
        PG8_STAGE(PG8_SB(1, 0), cB + kstepB, voffB); PG8_STAGE(PG8_SA(1, 0), cA + kstepA, voffA2[0]); PG8_STAGE(PG8_SB(1, 1), cB + hstepB + kstepB, voffB);
        PG8_WAIT_V(6); PG8_BAR;
    }
    for (;;) {
        const bool has_next = S.next(ui + 1, nxt);
        const char* nA = has_next ? (const char*)g.A + (size_t)nxt.pm * tstepA : cA; const char* nB = has_next ? (const char*)g.Bt + (size_t)nxt.pn * tstepB : cB;
        for (int t = 0; t < nt; t += 2) {
            const bool last = (t == nt - 2);
            const char* a1 = cA + (size_t)(t + 1) * kstepA;
            const char* a2 = last ? nA : cA + (size_t)(t + 2) * kstepA; const char* b2 = last ? nB : cB + (size_t)(t + 2) * kstepB;
            const char* a3 = a2 + kstepA; const char* b3 = b2 + kstepB;
            if (last && has_next) S.a_ready(nxt);
            if constexpr (SP2) {
            PG8_LDB(B0, 0, 0); PG8_LDB(B1, 0, 1); PG8_SCHED; PG8_LDA(At, 0, 0); PG8_STAGE(PG8_SA(1, 1), a1 + hstepA, voffA2[1]);
            PG8_WAIT_V(8); PG8_WAIT_L(0); PG8_BAR; PG8_MMA(0, 0, At, B0); PG8_MMA(0, 1, At, B1); PG8_BAR; PG8_SCHED;
            PG8_LDA(At, 0, 1); PG8_STAGE(PG8_SB(0, 0), b2, voffB); PG8_STAGE(PG8_SB(0, 1), b2 + hstepB, voffB); PG8_STAGE(PG8_SA(0, 0), a2, voffA2[0]);
            PG8_WAIT_V(8); PG8_WAIT_L(0); PG8_BAR; PG8_MMA(1, 0, At, B0); PG8_MMA(1, 1, At, B1); PG8_BAR; PG8_SCHED;
            PG8_LDB(B0, 1, 0); PG8_LDB(B1, 1, 1); PG8_SCHED; PG8_LDA(At, 1, 0); PG8_STAGE(PG8_SA(0, 1), a2 + hstepA, voffA2[1]);
            PG8_WAIT_V(8); PG8_WAIT_L(0); PG8_BAR; PG8_MMA(0, 0, At, B0); PG8_MMA(0, 1, At, B1); PG8_BAR; PG8_SCHED;
            PG8_LDA(At, 1, 1); PG8_STAGE(PG8_SB(1, 0), b3, voffB); PG8_STAGE(PG8_SB(1, 1), b3 + hstepB, voffB); PG8_STAGE(PG8_SA(1, 0), a3, voffA2[0]);
            PG8_WAIT_V(8); PG8_WAIT_L(0); PG8_BAR; PG8_MMA(1, 0, At, B0); PG8_MMA(1, 1, At, B1); PG8_BAR; PG8_SCHED;
            } else {
            PG8_LDB(B0, 0, 0); PG8_SCHED; PG8_LDA(At, 0, 0); PG8_STAGE(PG8_SA(1, 1), a1 + hstepA, voffA2[1]);
            PG8_WAIT_L(8); PG8_BAR; PG8_WAIT_L(0); PG8_MMA(0, 0, At, B0); PG8_BAR; PG8_SCHED;
            PG8_LDB(B1, 0, 1); PG8_STAGE(PG8_SB(0, 0), b2, voffB);
            PG8_BAR; PG8_WAIT_L(0); PG8_MMA(0, 1, At, B1); PG8_BAR;
            PG8_LDA(At, 0, 1); PG8_STAGE(PG8_SA(0, 0), a2, voffA2[0]);
            PG8_BAR; PG8_WAIT_L(0); PG8_MMA(1, 0, At, B0); PG8_BAR; PG8_SCHED;
            PG8_STAGE(PG8_SB(0, 1), b2 + hstepB, voffB);
            PG8_WAIT_V(6); PG8_BAR; PG8_MMA(1, 1, At, B1); PG8_BAR;
            PG8_LDB(B0, 1, 0); PG8_SCHED; PG8_LDA(At, 1, 0); PG8_STAGE(PG8_SA(0, 1), a2 + hstepA, voffA2[1]);
            PG8_WAIT_L(8); PG8_BAR; PG8_WAIT_L(0); PG8_MMA(0, 0, At, B0); PG8_BAR; PG8_SCHED;
            PG8_LDB(B1, 1, 1); PG8_STAGE(PG8_SB(1, 0), b3, voffB);
            PG8_BAR; PG8_WAIT_L(0); PG8_MMA(0, 1, At, B1); PG8_BAR;
            PG8_LDA(At, 1, 1); PG8_STAGE(PG8_SA(1, 0), a3, voffA2[0]);
            PG8_BAR; PG8_WAIT_L(0); PG8_MMA(1, 0, At, B0); PG8_BAR; PG8_SCHED;
            PG8_STAGE(PG8_SB(1, 1), b3 + hstepB, voffB);
            PG8_WAIT_V(6); PG8_BAR; PG8_MMA(1, 1, At, B1); PG8_BAR;
            }
        }
        if constexpr (ALIGN_EPI) { if (wr == 0) PG8_BAR; }
        if constexpr (!Epi::AFTER_DRAIN) { E(acc, cur, wr, wc, fr, fq); S.done(cur); }
        if (!has_next) break;
#pragma unroll
        for (int a = 0; a < 2; ++a)
#pragma unroll
            for (int b = 0; b < 2; ++b)
#pragma unroll
                for (int m = 0; m < 4; ++m)
#pragma unroll
                    for (int n = 0; n < 2; ++n) acc[a][b][m][n] = (f32x4){0.f, 0.f, 0.f, 0.f};
        cur = nxt; cA = nA; cB = nB; ++ui;
        if constexpr (ALIGN_EPI) { if (wr == 1) PG8_BAR; }
    }
    PG8_WAIT_V(0);
    if constexpr (!ALIGN_EPI) { if (wr == 0) PG8_BAR; }
    PG8_BAR;
    if constexpr (Epi::AFTER_DRAIN) { E.fused(acc, cur, wr, wc, fr, fq, lds, wid, lane); S.done(cur); }
#undef PG8_SA
#undef PG8_SB
#undef PG8_STAGE
#undef PG8_LDA
#undef PG8_LDB
#undef PG8_MMA
#undef PG8_WAIT_V
#undef PG8_WAIT_L
#undef PG8_BAR
#undef PG8_SCHED
}
}

struct EpiHid {
    bf16_t* H;
    DEV void run(f32x4 (&acc)[8][4], int R0, int C0, int fr, int fq) const {
#pragma unroll
        for (int n = 0; n < 4; ++n)
#pragma unroll
            for (int m = 0; m < 8; ++m) {
                const int c = C0 + n * 16 + 4 * fq, r = R0 + m * 16 + fr;
                f32x4 a = acc[m][n];
#pragma unroll
                for (int j = 0; j < 4; ++j) a[j] = gelu_t(a[j]);
                if (r < NCROWS) *(uint2*)(H + (size_t)r * 256 + c) = pk4(a);
            }
    }
};
#define PG8_EPI_HEAD static constexpr bool PERM = false, AFTER_DRAIN = false;
#define PG8_FOR_TILES _Pragma("unroll") for (int ai = 0; ai < 2; ++ai) _Pragma("unroll") for (int bj = 0; bj < 2; ++bj) _Pragma("unroll") for (int m = 0; m < 4; ++m) _Pragma("unroll") for (int n = 0; n < 2; ++n)
struct PEpiZA {
    PG8_EPI_HEAD
    bf16_t *ZA, *VST, *VWT; const float *ropec, *ropes;
    DEV void operator()(const f32x4 (&acc)[2][2][4][2], const pg8::Unit& u, int wr, int wc, int fr, int fq) const {
        asm volatile("" : "+v"(fr), "+v"(fq));
        PG8_FOR_TILES {
            const int row = u.pm * 256 + ai * 128 + wr * 64 + m * 16 + fr, col0 = u.pn * 256 + bj * 128 + wc * 32 + n * 16;
            f32x4 a = acc[ai][bj][m][n];
            if (u.pn == 17 || u.pn == 18) {
                bf16_t* dst = (u.pn == 17) ? VST : VWT;
                const int c = (col0 & 255) + 4 * fq, b = row >> 11, t = row & 2047;
#pragma unroll
                for (int j = 0; j < 4; ++j) { const int cc = c + j; dst[((size_t)((b * 4 + (cc >> 6)) * 64 + (cc & 63))) * S + t] = f2bf(a[j]); }
            } else {
                const bool rope = (col0 < 1024 || (col0 >= 1536 && col0 < 2048)) && ((col0 & 63) == 0);
                if (rope) {
                    const int t = row & 2047, i0 = 4 * (fq & 1);
                    const float4 cs = *(const float4*)(ropec + t * 8 + i0), sn = *(const float4*)(ropes + t * 8 + i0);
                    const float c4[4] = {cs.x, cs.y, cs.z, cs.w}, s4[4] = {sn.x, sn.y, sn.z, sn.w};
#pragma unroll
                    for (int j = 0; j < 4; ++j) {
                        const float pr = __shfl_xor(a[j], 32);
                        a[j] = (fq & 2) ? (a[j] * c4[j] + pr * s4[j]) : (a[j] * c4[j] - pr * s4[j]);
                    }
                }
                int zc0 = col0;
                if (col0 >= 4864) {
                    zc0 = col0 - 512;
#pragma unroll
                    for (int j = 0; j < 4; ++j) a[j] = sigm(a[j]);
                }
                if (zc0 < ZW) *(uint2*)(ZA + (size_t)row * ZW + zc0 + 4 * fq) = pk4(a);
            }
        }
    }
};
struct PEpiHid {
    PG8_EPI_HEAD
    bf16_t *HK, *HV; const float* pb;
    DEV void operator()(const f32x4 (&acc)[2][2][4][2], const pg8::Unit& u, int wr, int wc, int fr, int fq) const {
        asm volatile("" : "+v"(fr), "+v"(fq));
        bf16_t* H = u.pn ? HV : HK;
        PG8_FOR_TILES {
            const int r = u.pm * 256 + ai * 128 + wr * 64 + m * 16 + fr, c = bj * 128 + wc * 32 + n * 16 + 4 * fq;
            float4 bb = *(const float4*)(pb + (u.pn * 8) * 256 + c);
#pragma unroll
            for (int kc = 1; kc < 8; ++kc) { const float4 t4 = *(const float4*)(pb + (u.pn * 8 + kc) * 256 + c); bb.x += t4.x; bb.y += t4.y; bb.z += t4.z; bb.w += t4.w; }
            f32x4 a = acc[ai][bj][m][n];
            a[0] = gelu_t(a[0] + bb.x); a[1] = gelu_t(a[1] + bb.y); a[2] = gelu_t(a[2] + bb.z); a[3] = gelu_t(a[3] + bb.w);
            if (r < NCROWS) *(uint2*)(H + (size_t)r * 256 + c) = pk4(a);
        }
    }
};
struct PEpiMemKV {
    PG8_EPI_HEAD
    bf16_t *MK, *MVT;
    DEV void operator()(const f32x4 (&acc)[2][2][4][2], const pg8::Unit& u, int wr, int wc, int fr, int fq) const {
        asm volatile("" : "+v"(fr), "+v"(fq));
        PG8_FOR_TILES {
            const int r = u.pm * 256 + ai * 128 + wr * 64 + m * 16 + fr, c = u.pn * 256 + bj * 128 + wc * 32 + n * 16 + 4 * fq;
            const int b = r >> 8, mm = r & 255;
            const f32x4 a = acc[ai][bj][m][n];
            if (u.pn == 0) { const int h = (c >> 6) & 3, d = c & 63; *(uint2*)(MK + ((size_t)(b * 4 + h) * 256 + mm) * 64 + d) = pk4(a); }
            else {
#pragma unroll
                for (int j = 0; j < 4; ++j) { const int cc = c + j, h = (cc >> 6) & 3, d = cc & 63; MVT[((size_t)(b * 4 + h) * 64 + d) * 256 + mm] = f2bf(a[j]); }
            }
        }
    }
};
template <int ACT>
struct PEpiBf {
    PG8_EPI_HEAD
    bf16_t* O; int ldo;
    DEV void operator()(const f32x4 (&acc)[2][2][4][2], const pg8::Unit& u, int wr, int wc, int fr, int fq) const {
        asm volatile("" : "+v"(fr), "+v"(fq));
        PG8_FOR_TILES {
            const int r = u.pm * 256 + ai * 128 + wr * 64 + m * 16 + fr, c = u.pn * 256 + bj * 128 + wc * 32 + n * 16 + 4 * fq;
            f32x4 a = acc[ai][bj][m][n];
            if (ACT == 1) {
#pragma unroll
                for (int j = 0; j < 4; ++j) { const float v = fmaxf(a[j], 0.f); a[j] = v * v; }
            }
            *(uint2*)(O + (size_t)r * ldo + c) = pk4(a);
        }
    }
};
struct PEpiRes {
    PG8_EPI_HEAD
    const float* R; float* O;
    DEV void operator()(const f32x4 (&acc)[2][2][4][2], const pg8::Unit& u, int wr, int wc, int fr, int fq) const {
        asm volatile("" : "+v"(fr), "+v"(fq));
        PG8_FOR_TILES {
            const size_t o = (size_t)(u.pm * 256 + ai * 128 + wr * 64 + m * 16 + fr) * 1024 + u.pn * 256 + bj * 128 + wc * 32 + n * 16 + 4 * fq;
            const f32x4 r = *(const f32x4*)(R + o);
            *(f32x4*)(O + o) = r + acc[ai][bj][m][n];
        }
    }
};
struct PEpiMerge {
    PG8_EPI_HEAD
    const bf16_t *ZA, *YX; bf16_t* Y;
    DEV void operator()(const f32x4 (&acc)[2][2][4][2], const pg8::Unit& u, int wr, int wc, int fr, int fq) const {
        asm volatile("" : "+v"(fr), "+v"(fq));
        const int ch = u.pn * 64 + wc * 16 + 4 * fq;
#pragma unroll
        for (int ai = 0; ai < 2; ++ai)
#pragma unroll
            for (int m = 0; m < 4; ++m) {
                const size_t row = (size_t)(u.pm * 256 + ai * 128 + wr * 64 + m * 16 + fr);
                const uint2 a = *(const uint2*)(ZA + row * ZW + C_Q + ch), b = *(const uint2*)(ZA + row * ZW + C_GR + ch), c = *(const uint2*)(YX + row * 1024 + ch);
                const f32x4 g0 = acc[ai][0][m][0], g1 = acc[ai][0][m][1], g2 = acc[ai][1][m][0];
                f32x4 y;
                y[0] = sigm(g0[0]) * lo_f(a.x) + sigm(g1[0]) * lo_f(b.x) + sigm(g2[0]) * lo_f(c.x);
                y[1] = sigm(g0[1]) * hi_f(a.x) + sigm(g1[1]) * hi_f(b.x) + sigm(g2[1]) * hi_f(c.x);
                y[2] = sigm(g0[2]) * lo_f(a.y) + sigm(g1[2]) * lo_f(b.y) + sigm(g2[2]) * lo_f(c.y);
                y[3] = sigm(g0[3]) * hi_f(a.y) + sigm(g1[3]) * hi_f(b.y) + sigm(g2[3]) * hi_f(c.y);
                *(uint2*)(Y + row * 1024 + ch) = pk4(y);
            }
    }
};

DEV bool tile_map(int idx, int NT, int& pm, int& pn) {
    const int x = idx & 7, pl = (idx >> 3) & 3, pmid = (idx >> 5) & 7, st = idx >> 8;
    pm = pmid * 8 + x;
    pn = st * 4 + pl;
    return pn < NT;
}
DEV int tile_count(int NT) { return ((NT + 3) / 4) * 256; }

DEV void cmp2_job(const Params& P, int job) {
    char* aux = (char*)P.out;
    const int lane = threadIdx.x & 63, w = (threadIdx.x & 255) >> 6;
    const int wj = job * 4 + w;
    const int which = wj >= NCROWS ? 1 : 0;
    const int r = wj - which * NCROWS;
    const int bg = r / NCMP, n = r - bg * NCMP;
    const bf16_t* hid = (const bf16_t*)(aux + (which ? O_HIDV : O_HIDK)) + (size_t)r * 256;
    const float* w2 = which ? P.wv2 : P.wk2;
    float a0 = 0.f, a1 = 0.f, a2 = 0.f, a3 = 0.f;
#pragma unroll 4
    for (int k = 0; k < 256; k += 8) {
        const u32x4 hv = *(const u32x4*)(hid + k);
        const float* wp = w2 + k * 64 + lane;
        a0 += lo_f(hv.x) * wp[0];   a1 += hi_f(hv.x) * wp[64];
        a2 += lo_f(hv.y) * wp[128]; a3 += hi_f(hv.y) * wp[192];
        a0 += lo_f(hv.z) * wp[256]; a1 += hi_f(hv.z) * wp[320];
        a2 += lo_f(hv.w) * wp[384]; a3 += hi_f(hv.w) * wp[448];
    }
    float acc = (a0 + a1) + (a2 + a3);
    if (!which) {
        const int pos = 16 * n + 31, i = lane & 7;
        const float cs = ((const float*)(aux + O_ROPEC))[pos * 8 + i], sn = ((const float*)(aux + O_ROPES))[pos * 8 + i];
        const float pr = __shfl_xor(acc, 8);
        float o = acc;
        if (lane < 16) o = (lane & 8) ? (acc * cs + pr * sn) : (acc * cs - pr * sn);
        bf16_t* KC = (bf16_t*)(aux + O_KC);
        KC[((size_t)bg * 128 + n) * 64 + lane] = f2bf(o);
        if (n == NCMP - 1) KC[((size_t)bg * 128 + 127) * 64 + lane] = 0;
    } else {
        bf16_t* VCT = (bf16_t*)(aux + O_VCT);
        VCT[((size_t)bg * 64 + lane) * 128 + n] = f2bf(acc);
        if (n == NCMP - 1) VCT[((size_t)bg * 64 + lane) * 128 + 127] = 0;
    }
}

DEV void rnn_job(const Params& P, int job, char* smem, bool dry) {
    char* aux = (char*)P.out;
    bf16_t* ZA = (bf16_t*)(P.ws + W_ZA);
    const int b = job >> 6, n = (job >> 2) & 15, ct = job & 3;
    const int t512 = opaque_tid512(), sub = t512 >> 8;
    char* sh = smem - sub * 56320;
    bf16_t* sX = (bf16_t*)sh;
    float* sCw = (float*)(sh + 9216);
    bf16_t* sRaw = (bf16_t*)(sh + 10496);
    bf16_t* sRaw2 = sRaw + 67 * 72;
    float* sXf = (float*)(smem + 32768);
    float* sSum = (float*)(smem + 37120);
    const int tid = t512 & 255, w = tid >> 6, lane = tid & 63, fr = lane & 15, fq = lane >> 4;
    const bf16_t* WAT = (const bf16_t*)(aux + O_WAT) + n * 4096;
    const bf16_t* WIT = (const bf16_t*)(aux + O_WIT) + n * 4096;
    bf16x8 wa[2], wi[2];
#pragma unroll
    for (int ks = 0; ks < 2; ++ks) {
        wa[ks] = *(const bf16x8*)(WAT + (16 * ct + fr) * 64 + 32 * ks + 8 * fq);
        wi[ks] = *(const bf16x8*)(WIT + (16 * ct + fr) * 64 + 32 * ks + 8 * fq);
    }
    const int c = n * 64 + 16 * ct + fr;
    const float ba = P.b_a[c], bi = P.b_i[c], cl = -8.0f * log1pf(__expf(-P.lam[c]));
    float carry = 0.f;
    __syncthreads();
    for (int i = t512; i < 320; i += 512) sCw[i] = (i < 256) ? P.conv_w[(i >> 6) * 1024 + n * 64 + (i & 63)] : P.conv_b[n * 64 + (i & 63)];
    const int lt = t512 >> 3, c8 = (t512 & 7) * 8;
    const int dct = (c8 >> 4) - (ct & ~1);
    float* sXfT = (float*)(sh + (dct == 1 ? 56320 : 0) + 32768);
    const bf16_t* xbase = ZA + (size_t)(b * S) * ZW + C_XR + n * 64 + c8;
    u32x4 xm, xh = {0u, 0u, 0u, 0u};
    xm = *(const u32x4*)(xbase + (size_t)lt * ZW);
    *(u32x4*)(sRaw + (lt + 3) * 72 + c8) = xm;
    if (t512 < 24) *(u32x4*)(sRaw + lt * 72 + c8) = xh;
    xm = *(const u32x4*)(xbase + (size_t)(64 + lt) * ZW);
    if (t512 < 24) xh = *(const u32x4*)(xbase + (size_t)(61 + lt) * ZW);
    __syncthreads();
#pragma unroll 1
    for (int chunk = 0; chunk < 32; ++chunk) {
        const int tc = chunk * 64;
        const bf16_t* rawc = (chunk & 1) ? sRaw2 : sRaw;
        bf16_t* rawn = (chunk & 1) ? sRaw : sRaw2;
        bf16_t gv[4];
#pragma unroll
        for (int j = 0; j < 4; ++j) gv[j] = ZA[(size_t)(b * S + tc + 16 * w + 4 * fq + j) * ZW + C_GR + n * 64 + 16 * ct + fr];
        {
            float xv[8];
            { const float4 b0 = *(const float4*)(sCw + 256 + c8), b1 = *(const float4*)(sCw + 256 + c8 + 4);
              xv[0] = b0.x; xv[1] = b0.y; xv[2] = b0.z; xv[3] = b0.w; xv[4] = b1.x; xv[5] = b1.y; xv[6] = b1.z; xv[7] = b1.w; }
#pragma unroll
            for (int k = 0; k < 4; ++k) {
                const u32x4 v = *(const u32x4*)(rawc + (lt + k) * 72 + c8);
                const float4 w0 = *(const float4*)(sCw + k * 64 + c8), w1 = *(const float4*)(sCw + k * 64 + c8 + 4);
                xv[0] += w0.x * lo_f(v.x); xv[1] += w0.y * hi_f(v.x); xv[2] += w0.z * lo_f(v.y); xv[3] += w0.w * hi_f(v.y);
                xv[4] += w1.x * lo_f(v.z); xv[5] += w1.y * hi_f(v.z); xv[6] += w1.z * lo_f(v.w); xv[7] += w1.w * hi_f(v.w);
            }
            if (dct == 0 || dct == 1) {
#pragma unroll
                for (int e = 0; e < 8; ++e) sXfT[lt * 17 + (c8 & 15) + e] = xv[e];
            }
            u32x4 o0 = {pk2(xv[0], xv[1]), pk2(xv[2], xv[3]), pk2(xv[4], xv[5]), pk2(xv[6], xv[7])};
            *(u32x4*)(sX + lt * 72 + c8) = o0;
        }
        __syncthreads();
        f32x4 R = (f32x4){0.f, 0.f, 0.f, 0.f}, I = (f32x4){0.f, 0.f, 0.f, 0.f};
#pragma unroll
        for (int ks = 0; ks < 2; ++ks) {
            const bf16x8 af = *(const bf16x8*)(sX + (16 * w + fr) * 72 + 32 * ks + 8 * fq);
            R = MFMA16(af, wa[ks], R); I = MFMA16(af, wi[ks], I);
        }
        if (chunk + 1 < 32) {
            *(u32x4*)(rawn + (lt + 3) * 72 + c8) = xm;
            if (t512 < 24) *(u32x4*)(rawn + lt * 72 + c8) = xh;
        }
        float hl[4], pc[4];
        float h = 0.f, pcum = 1.f;
#pragma unroll
        for (int j = 0; j < 4; ++j) {
            const float xcv = sXf[(16 * w + 4 * fq + j) * 17 + fr];
            const float rg = sigm(R[j] + ba), gi = sigm(I[j] + bi);
            const float la = rg * cl;
            const float a_ = __expf(la);
            const float mult = sqrtf(fmaxf(1.f - a_ * a_, 0.f));
            const float u = mult * gi * xcv;
            h = a_ * h + u; pcum *= a_;
            hl[j] = h; pc[j] = pcum;
        }
        float A = pcum, H = h;
        float A1 = __shfl_up(A, 16), H1 = __shfl_up(H, 16);
        if (fq >= 1) { H = A * H1 + H; A = A * A1; }
        float A2 = __shfl_up(A, 32), H2 = __shfl_up(H, 32);
        if (fq >= 2) { H = A * H2 + H; A = A * A2; }
        float Ax = __shfl_up(A, 16), Hx = __shfl_up(H, 16);
        const float Ae = fq == 0 ? 1.f : Ax, He = fq == 0 ? 0.f : Hx;
        if (fq == 3) { sSum[w * 16 + fr] = A; sSum[64 + w * 16 + fr] = H; }
        __syncthreads();
        if (chunk + 2 < 32) {
            xm = *(const u32x4*)(xbase + (size_t)(tc + 128 + lt) * ZW);
            if (t512 < 24) xh = *(const u32x4*)(xbase + (size_t)(tc + 125 + lt) * ZW);
        }
        float cin = carry, mycin = 0.f;
#pragma unroll
        for (int ww = 0; ww < 4; ++ww) {
            if (ww == w) mycin = cin;
            cin = sSum[ww * 16 + fr] * cin + sSum[64 + ww * 16 + fr];
        }
        carry = cin;
        const float sq = Ae * mycin + He;
#pragma unroll
        for (int j = 0; j < 4; ++j) {
            const float hfin = hl[j] + pc[j] * sq;
            const size_t grow = (size_t)(b * S + tc + 16 * w + 4 * fq + j);
            bf16_t* op = dry ? ((bf16_t*)(P.ws + W_YX) + grow * 1024 + n * 64 + 16 * ct + fr) : (ZA + grow * ZW + C_GR + n * 64 + 16 * ct + fr);
            *op = f2bf(gelu_t(bf2f(gv[j])) * hfin);
        }
    }
}

constexpr float EXPC = 0.125f * 1.4426950408889634f;
struct AttnAcc { f32x4 o[4][2]; float m[2], l[2]; };
DEV void attn_init(AttnAcc& a) {
#pragma unroll
    for (int d = 0; d < 4; ++d)
#pragma unroll
        for (int q = 0; q < 2; ++q) a.o[d][q] = (f32x4){0.f, 0.f, 0.f, 0.f};
    a.m[0] = a.m[1] = -INFINITY; a.l[0] = a.l[1] = 0.f;
}
DEV bf16x8 mk8(unsigned a, unsigned b, unsigned c, unsigned d) { u32x4 u = {a, b, c, d}; return __builtin_bit_cast(bf16x8, u); }

template <class MF>
DEV void attn_step(const bf16_t* sK, const bf16_t* sVt, int vstride, const bf16x8 (&qf)[2][2], AttnAcc& st, const MF& mf, int fr, int fq) {
    f32x4 s[4][2];
#pragma unroll
    for (int kt = 0; kt < 4; ++kt) {
        s[kt][0] = (f32x4){0.f, 0.f, 0.f, 0.f}; s[kt][1] = (f32x4){0.f, 0.f, 0.f, 0.f};
#pragma unroll
        for (int ks = 0; ks < 2; ++ks) {
            const bf16x8 kf = *(const bf16x8*)(sK + (16 * kt + fr) * 80 + 32 * ks + 8 * fq);
            s[kt][0] = MFMA16(kf, qf[0][ks], s[kt][0]);
            s[kt][1] = MFMA16(kf, qf[1][ks], s[kt][1]);
        }
    }
#pragma unroll
    for (int qt = 0; qt < 2; ++qt) {
        float ps = 0.f;
#pragma unroll
        for (int kt = 0; kt < 4; ++kt)
#pragma unroll
            for (int j = 0; j < 4; ++j) {
                const float p = mf(qt, 16 * kt + 4 * fq + j) ? __builtin_amdgcn_exp2f(s[kt][qt][j] * EXPC) : 0.f;
                s[kt][qt][j] = p; ps += p;
            }
        st.l[qt] += ps;
    }
#pragma unroll
    for (int ks = 0; ks < 2; ++ks) {
        bf16x8 pf[2];
#pragma unroll
        for (int qt = 0; qt < 2; ++qt)
            pf[qt] = mk8(pk2(s[2 * ks][qt][0], s[2 * ks][qt][1]), pk2(s[2 * ks][qt][2], s[2 * ks][qt][3]),
                         pk2(s[2 * ks + 1][qt][0], s[2 * ks + 1][qt][1]), pk2(s[2 * ks + 1][qt][2], s[2 * ks + 1][qt][3]));
#pragma unroll
        for (int dt = 0; dt < 4; ++dt) {
            const u32x2 v0 = *(const u32x2*)(sVt + (16 * dt + fr) * vstride + 32 * ks + 4 * fq);
            const u32x2 v1 = *(const u32x2*)(sVt + (16 * dt + fr) * vstride + 32 * ks + 16 + 4 * fq);
            const bf16x8 vf = mk8(v0.x, v0.y, v1.x, v1.y);
            st.o[dt][0] = MFMA16(vf, pf[0], st.o[dt][0]);
            st.o[dt][1] = MFMA16(vf, pf[1], st.o[dt][1]);
        }
    }
}
DEV void attn_step_fast(const bf16_t* sK, const bf16_t* sVt, const bf16x8 (&qf)[2][2], AttnAcc& st, const float (&bitoff)[2], int fr, int fq) {
    f32x4 s[4][2];
#pragma unroll
    for (int kt = 0; kt < 4; ++kt) {
        s[kt][0] = (f32x4){0.f, 0.f, 0.f, 0.f}; s[kt][1] = (f32x4){0.f, 0.f, 0.f, 0.f};
#pragma unroll
        for (int ks = 0; ks < 2; ++ks) {
            const bf16x8 kf = *(const bf16x8*)(sK + (16 * kt + fr) * 80 + 32 * ks + 8 * fq);
            s[kt][0] = MFMA16(kf, qf[0][ks], s[kt][0]);
            s[kt][1] = MFMA16(kf, qf[1][ks], s[kt][1]);
        }
    }
#pragma unroll
    for (int qt = 0; qt < 2; ++qt) {
        const float off = bitoff[qt];
        float ps = 0.f;
#pragma unroll
        for (int kt = 0; kt < 4; ++kt)
#pragma unroll
            for (int j = 0; j < 4; ++j) { const float p = __builtin_amdgcn_exp2f(fmaf(s[kt][qt][j], EXPC, off)); s[kt][qt][j] = p; ps += p; }
        st.l[qt] += ps;
    }
#pragma unroll
    for (int ks = 0; ks < 2; ++ks) {
        bf16x8 pf[2];
#pragma unroll
        for (int qt = 0; qt < 2; ++qt)
            pf[qt] = mk8(pk2(s[2 * ks][qt][0], s[2 * ks][qt][1]), pk2(s[2 * ks][qt][2], s[2 * ks][qt][3]),
                         pk2(s[2 * ks + 1][qt][0], s[2 * ks + 1][qt][1]), pk2(s[2 * ks + 1][qt][2], s[2 * ks + 1][qt][3]));
#pragma unroll
        for (int dt = 0; dt < 4; ++dt) {
            const u32x2 v0 = *(const u32x2*)(sVt + (16 * dt + fr) * 72 + 32 * ks + 4 * fq);
            const u32x2 v1 = *(const u32x2*)(sVt + (16 * dt + fr) * 72 + 32 * ks + 16 + 4 * fq);
            const bf16x8 vf = mk8(v0.x, v0.y, v1.x, v1.y);
            st.o[dt][0] = MFMA16(vf, pf[0], st.o[dt][0]);
            st.o[dt][1] = MFMA16(vf, pf[1], st.o[dt][1]);
        }
    }
}
template <int QT>
DEV void attn_half_fast(const bf16_t* sK, const bf16_t* sVt, const bf16x8 (&qf)[2][2], AttnAcc& st, float bitoff, int fr, int fq) {
    f32x4 s[4];
#pragma unroll
    for (int kt = 0; kt < 4; ++kt) {
        s[kt] = (f32x4){0.f, 0.f, 0.f, 0.f};
#pragma unroll
        for (int ks = 0; ks < 2; ++ks) {
            const bf16x8 kf = *(const bf16x8*)(sK + (16 * kt + fr) * 80 + 32 * ks + 8 * fq);
            s[kt] = MFMA16(kf, qf[QT][ks], s[kt]);
        }
    }
    const float off = bitoff;
    float ps = 0.f;
#pragma unroll
    for (int kt = 0; kt < 4; ++kt)
#pragma unroll
        for (int j = 0; j < 4; ++j) { const float p = __builtin_amdgcn_exp2f(fmaf(s[kt][j], EXPC, off)); s[kt][j] = p; ps += p; }
    st.l[QT] += ps;
#pragma unroll
    for (int ks = 0; ks < 2; ++ks) {
        const bf16x8 pf = mk8(pk2(s[2 * ks][0], s[2 * ks][1]), pk2(s[2 * ks][2], s[2 * ks][3]), pk2(s[2 * ks + 1][0], s[2 * ks + 1][1]), pk2(s[2 * ks + 1][2], s[2 * ks + 1][3]));
#pragma unroll
        for (int dt = 0; dt < 4; ++dt) {
            const u32x2 v0 = *(const u32x2*)(sVt + (16 * dt + fr) * 72 + 32 * ks + 4 * fq);
            const u32x2 v1 = *(const u32x2*)(sVt + (16 * dt + fr) * 72 + 32 * ks + 16 + 4 * fq);
            st.o[dt][QT] = MFMA16(mk8(v0.x, v0.y, v1.x, v1.y), pf, st.o[dt][QT]);
        }
    }
}
DEV void attn_fold_out(bf16_t* const (&op)[2], const AttnAcc& st, const float (&gate)[2]) {
#pragma unroll
    for (int qt = 0; qt < 2; ++qt) {
        float l = st.l[qt];
        l += __shfl_xor(l, 16); l += __shfl_xor(l, 32);
        const float sc = gate[qt] * __builtin_amdgcn_rcpf(fmaxf(l, 1e-30f));
#pragma unroll
        for (int dt = 0; dt < 4; ++dt) {
            const uint2 pv = *(const uint2*)(op[qt] + 16 * dt);
            f32x4 r = st.o[dt][qt] * sc;
            r[0] += lo_f(pv.x); r[1] += hi_f(pv.x); r[2] += lo_f(pv.y); r[3] += hi_f(pv.y);
            *(uint2*)(op[qt] + 16 * dt) = make_uint2(pk2(r[0], r[1]), pk2(r[2], r[3]));
        }
    }
}
DEV void attn_fold(f32x4 (&tot)[4][2], const AttnAcc& st, const float (&gate)[2]) {
#pragma unroll
    for (int qt = 0; qt < 2; ++qt) {
        float l = st.l[qt];
        l += __shfl_xor(l, 16); l += __shfl_xor(l, 32);
        const float sc = gate[qt] * __builtin_amdgcn_rcpf(fmaxf(l, 1e-30f));
#pragma unroll
        for (int dt = 0; dt < 4; ++dt) tot[dt][qt] += st.o[dt][qt] * sc;
    }
}
DEV void ld64(u32x4 (&r)[2], const bf16_t* src, size_t sstride, int tid) {
#pragma unroll
    for (int i = 0; i < 2; ++i) { const int c = tid + 256 * i; r[i] = *(const u32x4*)(src + (size_t)(c >> 3) * sstride + (c & 7) * 8); }
}
DEV void st64(bf16_t* dst, const u32x4 (&r)[2], int tid, int stride) {
#pragma unroll
    for (int i = 0; i < 2; ++i) { const int c = tid + 256 * i; *(u32x4*)(dst + (c >> 3) * stride + (c & 7) * 8) = r[i]; }
}

#define OUTP(QT) ((dry ? (bf16_t*)(P.ws + W_YX) + (size_t)(b * S + tq[QT]) * 1024 : ZA + (size_t)(b * S + tq[QT]) * ZW + C_Q) + head * 64 + 4 * fq)
#define LOAD_GATE(G2, BR) float G2[2]; { G2[0] = bf2f(ZA[(size_t)(b * S + tq[0]) * ZW + C_G + head * 3 + (BR)]); G2[1] = bf2f(ZA[(size_t)(b * S + tq[1]) * ZW + C_G + head * 3 + (BR)]); }
DEV u32x4 ld64w(const bf16_t* src, size_t sstride, int t512) { return *(const u32x4*)(src + (size_t)(t512 >> 3) * sstride + (t512 & 7) * 8); }
DEV void st64w(bf16_t* dst, const u32x4& r, int t512, int stride) { *(u32x4*)(dst + (t512 >> 3) * stride + (t512 & 7) * 8) = r; }
struct MaskAll { DEV bool operator()(int, int) const { return true; } };
struct MaskSel { unsigned bit[2]; int t[2]; int k0; DEV bool operator()(int qt, int kk) const { return bit[qt] && (k0 + kk <= t[qt]); } };
struct MaskWin { int t[2]; int k0; DEV bool operator()(int qt, int kk) const { const int k = k0 + kk; return k <= t[qt] && k > t[qt] - 512; } };

DEV void xattn_job(const Params& P, int job, char* smem, bool dry) {
    char* aux = (char*)P.out;
    bf16_t* ZA = (bf16_t*)(P.ws + W_ZA);
    const int qb = job & 15, h = (job >> 4) & 3, b = job >> 6;
    bf16_t* sK = (bf16_t*)smem;
    bf16_t* sVt = sK + 64 * 80;
    const int tid = opaque_tid(), w = tid >> 6, lane = tid & 63, fr = lane & 15, fq = lane >> 4;
    const int t0 = qb * 128 + w * 32;
    bf16x8 qf[2][2];
#pragma unroll
    for (int qt = 0; qt < 2; ++qt)
#pragma unroll
        for (int ks = 0; ks < 2; ++ks) qf[qt][ks] = *(const bf16x8*)(ZA + (size_t)(b * S + t0 + 16 * qt + fr) * ZW + C_QX + h * 64 + 32 * ks + 8 * fq);
    const bf16_t* MK = (const bf16_t*)(aux + O_MEMK) + (size_t)(b * 4 + h) * 256 * 64;
    const bf16_t* MVT = (const bf16_t*)(aux + O_MEMVT) + (size_t)(b * 4 + h) * 64 * 256;
    AttnAcc st; attn_init(st);
    u32x4 rk[2], rv[2];
    ld64(rk, MK, 64, tid); ld64(rv, MVT, 256, tid);
#pragma unroll 1
    for (int jb = 0; jb < 4; ++jb) {
        __syncthreads();
        st64(sK, rk, tid, 80); st64(sVt, rv, tid, 72);
        __syncthreads();
        if (jb + 1 < 4) { ld64(rk, MK + (size_t)(jb + 1) * 64 * 64, 64, tid); ld64(rv, MVT + (jb + 1) * 64, 256, tid); }
        __builtin_amdgcn_sched_barrier(0);
        { const float z2[2] = {0.f, 0.f}; attn_step_fast(sK, sVt, qf, st, z2, fr, fq); }
    }
    f32x4 tot[4][2];
#pragma unroll
    for (int dt = 0; dt < 4; ++dt) { tot[dt][0] = (f32x4){0.f, 0.f, 0.f, 0.f}; tot[dt][1] = (f32x4){0.f, 0.f, 0.f, 0.f}; }
    const float one[2] = {1.f, 1.f};
    attn_fold(tot, st, one);
#pragma unroll
    for (int qt = 0; qt < 2; ++qt)
#pragma unroll
        for (int dt = 0; dt < 4; ++dt)
            *(uint2*)((dry ? (bf16_t*)(P.ws + W_Y) + (size_t)(b * S + t0 + 16 * qt + fr) * 1024 : ZA + (size_t)(b * S + t0 + 16 * qt + fr) * ZW + C_QX) + h * 64 + 16 * dt + 4 * fq) =
                make_uint2(pk2(tot[dt][qt][0], tot[dt][qt][1]), pk2(tot[dt][qt][2], tot[dt][qt][3]));
}

DEV void nsa_job(const Params& P, int job, char* smem, bool dry) {
    char* aux = (char*)P.out;
    bf16_t* ZA = (bf16_t*)(P.ws + W_ZA);
    const int pj_ = job >> 1, bg = pj_ & 31, qb = 63 - (2 * (pj_ >> 5) + (job & 1)), b = bg >> 2, g = bg & 3, t0 = qb * 32;
    bf16_t* sK = (bf16_t*)smem;
    bf16_t* sVt = (bf16_t*)(smem + 20480);
    float* sImp = (float*)(smem + 38912);
    unsigned* sSel = (unsigned*)(smem + 38912 + 4096);
    constexpr int KVBUF = 9728;
    const int tid = opaque_tid(), w = tid >> 6, lane = tid & 63, fr = lane & 15, fq = lane >> 4;
    const int head = g * 4 + (fr & 3);
    const int qi0 = 8 * w + (fr >> 2);
    int tq[2];
    bf16x8 qf[2][2];
#pragma unroll
    for (int qt = 0; qt < 2; ++qt) {
        tq[qt] = t0 + qi0 + 4 * qt;
        const bf16_t* rowp = ZA + (size_t)(b * S + tq[qt]) * ZW;
#pragma unroll
        for (int ks = 0; ks < 2; ++ks) qf[qt][ks] = *(const bf16x8*)(rowp + C_Q + head * 64 + 32 * ks + 8 * fq);
    }
    f32x4 tot[4][2];
#pragma unroll
    for (int dt = 0; dt < 4; ++dt) { tot[dt][0] = (f32x4){0.f, 0.f, 0.f, 0.f}; tot[dt][1] = (f32x4){0.f, 0.f, 0.f, 0.f}; }

    {
        const bf16_t* KC = (const bf16_t*)(aux + O_KC) + (size_t)bg * 128 * 64;
        const bf16_t* VCT = (const bf16_t*)(aux + O_VCT) + (size_t)bg * 64 * 128;
        __syncthreads();
#pragma unroll
        for (int i = 0; i < 4; ++i) {
            const int c = tid + 256 * i;
            { const int r = c >> 3, k = (c & 7) * 8; *(u32x4*)(sK + r * 80 + k) = *(const u32x4*)(KC + r * 64 + k); }
            { const int r = c >> 4, k = (c & 15) * 8; *(u32x4*)(sVt + r * 136 + k) = *(const u32x4*)(VCT + r * 128 + k); }
        }
        __syncthreads();
#pragma unroll
        for (int qt = 0; qt < 2; ++qt) {
            const float g0 = bf2f(ZA[(size_t)(b * S + tq[qt]) * ZW + C_G + head * 3 + 0]);
            f32x4 s[8];
#pragma unroll
            for (int kt = 0; kt < 8; ++kt) {
                s[kt] = (f32x4){0.f, 0.f, 0.f, 0.f};
#pragma unroll
                for (int ks = 0; ks < 2; ++ks) {
                    const bf16x8 kf = *(const bf16x8*)(sK + (16 * kt + fr) * 80 + 32 * ks + 8 * fq);
                    s[kt] = MFMA16(kf, qf[qt][ks], s[kt]);
                }
            }
            float mx = -INFINITY;
#pragma unroll
            for (int kt = 0; kt < 8; ++kt)
#pragma unroll
                for (int j = 0; j < 4; ++j) {
                    const int n = 16 * kt + 4 * fq + j;
                    const float v = (n < NCMP && 16 * n + 31 <= tq[qt]) ? s[kt][j] : -INFINITY;
                    s[kt][j] = v; mx = fmaxf(mx, v);
                }
            mx = fmaxf(mx, __shfl_xor(mx, 16)); mx = fmaxf(mx, __shfl_xor(mx, 32));
            const float msub = (mx == -INFINITY) ? 0.f : mx;
            float ps = 0.f;
#pragma unroll
            for (int kt = 0; kt < 8; ++kt)
#pragma unroll
                for (int j = 0; j < 4; ++j) { const float p = __builtin_amdgcn_exp2f((s[kt][j] - msub) * EXPC); s[kt][j] = p; ps += p; }
            ps += __shfl_xor(ps, 16); ps += __shfl_xor(ps, 32);
            const float inv = __builtin_amdgcn_rcpf(fmaxf(ps, 1e-30f));
            float bprev = 0.f;
#pragma unroll
            for (int kt = 0; kt < 8; ++kt) {
                s[kt] *= inv;
                const float a = s[kt][0] + s[kt][1] + s[kt][2] + 0.5f * s[kt][3];
                const float bq = 0.5f * s[kt][3];
                const float x = __shfl(bq, (lane + 48) & 63);
                const float y = __shfl(bprev, (lane + 48) & 63);
                float iv = a + (fq > 0 ? x : y);
                iv += __shfl_xor(iv, 1); iv += __shfl_xor(iv, 2);
                if ((fr & 3) == 0) sImp[(qi0 + 4 * qt) * 32 + 4 * kt + fq] = iv;
                bprev = bq;
            }
#pragma unroll
            for (int ks = 0; ks < 4; ++ks) {
                const f32x4 pa = s[2 * ks] * g0, pb = s[2 * ks + 1] * g0;
                const bf16x8 pf = mk8(pk2(pa[0], pa[1]), pk2(pa[2], pa[3]), pk2(pb[0], pb[1]), pk2(pb[2], pb[3]));
#pragma unroll
                for (int dt = 0; dt < 4; ++dt) {
                    const u32x2 v0 = *(const u32x2*)(sVt + (16 * dt + fr) * 136 + 32 * ks + 4 * fq);
                    const u32x2 v1 = *(const u32x2*)(sVt + (16 * dt + fr) * 136 + 32 * ks + 16 + 4 * fq);
                    tot[dt][qt] = MFMA16(mk8(v0.x, v0.y, v1.x, v1.y), pf, tot[dt][qt]);
                }
            }
            __builtin_amdgcn_sched_barrier(0);
        }
    }
#pragma unroll
    for (int qt = 0; qt < 2; ++qt) {
        bf16_t* op = (dry ? (bf16_t*)(P.ws + W_YX) + (size_t)(b * S + tq[qt]) * 1024 : ZA + (size_t)(b * S + tq[qt]) * ZW + C_Q) + head * 64 + 4 * fq;
#pragma unroll
        for (int dt = 0; dt < 4; ++dt) *(uint2*)(op + 16 * dt) = pk4(tot[dt][qt]);
    }
    __syncthreads();
    {
        float myv[4];
#pragma unroll
        for (int i = 0; i < 4; ++i) {
            const int pidx = tid + 256 * i, q = pidx >> 5, m = pidx & 31;
            const int t = t0 + q, cur = t >> 6;
            const float sum = sImp[q * 32 + m];
            const bool forced = (m == 0) || (m == cur) || (m == cur - 1);
            const bool future = m * 64 > t;
            myv[i] = forced ? INFINITY : (future ? -INFINITY : sum);
        }
        if (tid == 0) sSel[32] = 0u;
        __syncthreads();
#pragma unroll
        for (int i = 0; i < 4; ++i) { const int pidx = tid + 256 * i; sImp[pidx] = myv[i]; }
        __syncthreads();
        unsigned wun = 0u;
#pragma unroll
        for (int i = 0; i < 4; ++i) {
            const int pidx = tid + 256 * i, q = pidx >> 5, m = pidx & 31;
            const float v = myv[i];
            int rank = 0;
#pragma unroll
            for (int m2 = 0; m2 < 32; ++m2) {
                const float o = sImp[q * 32 + m2];
                rank += (o > v || (o == v && m2 < m)) ? 1 : 0;
            }
            const bool selb = (rank < 8) && (v > -INFINITY);
            const unsigned long long bal = __ballot(selb);
            const unsigned mk = (unsigned)(bal >> (32 * (lane >> 5)));
            if ((lane & 31) == 0) sSel[q] = mk;
            wun |= (unsigned)bal | (unsigned)(bal >> 32);
        }
        if (lane == 0) atomicOr(&sSel[32], wun);
    }
    __syncthreads();
    __shared__ unsigned s_xuni[2];
    if (tid == 0) s_xuni[threadIdx.x >> 8] = sSel[32];
    __syncthreads();
    const unsigned uni = s_xuni[0] | s_xuni[1];
    const int jmax = (t0 + 31) >> 6;
    const int t512 = opaque_tid512();
    bf16_t* shKV = (bf16_t*)(smem - (t512 >> 8) * 56320);
    {
        AttnAcc st; attn_init(st);
        const bf16_t* Kb = ZA + (size_t)(b * S) * ZW + C_KS + g * 64;
        const bf16_t* Vb = (const bf16_t*)(P.ws + W_VST) + (size_t)bg * 64 * S;
        unsigned rem = uni & ((2u << jmax) - 1u);
        u32x4 rk, rv;
        if (rem) { const int j0 = __builtin_ctz(rem); rk = ld64w(Kb + (size_t)(j0 * 64) * ZW, ZW, t512); rv = ld64w(Vb + j0 * 64, S, t512); }
        __syncthreads();
        int it = 0;
#pragma unroll 1
        while (rem) {
            const int jb = __builtin_ctz(rem);
            rem &= rem - 1u;
            bf16_t* sKb = shKV + (it & 1) * KVBUF; bf16_t* sVb = sKb + 64 * 80; ++it;
            st64w(sKb, rk, t512, 80); st64w(sVb, rv, t512, 72);
            __syncthreads();
            if (rem) { const int jn = __builtin_ctz(rem); rk = ld64w(Kb + (size_t)(jn * 64) * ZW, ZW, t512); rv = ld64w(Vb + jn * 64, S, t512); }
            __builtin_amdgcn_sched_barrier(0);
            const unsigned b0 = (sSel[qi0] >> jb) & 1u, b1 = (sSel[qi0 + 4] >> jb) & 1u;
            if (jb * 64 + 63 <= t0) {
                const bool need0 = __builtin_amdgcn_ballot_w64(b0 != 0u) != 0ull, need1 = __builtin_amdgcn_ballot_w64(b1 != 0u) != 0ull;
                const float bo[2] = {b0 ? 0.f : -INFINITY, b1 ? 0.f : -INFINITY};
                if (need0 && need1) attn_step_fast(sKb, sVb, qf, st, bo, fr, fq);
                else if (need0) attn_half_fast<0>(sKb, sVb, qf, st, bo[0], fr, fq);
                else if (need1) attn_half_fast<1>(sKb, sVb, qf, st, bo[1], fr, fq);
            } else {
                MaskSel mf; mf.bit[0] = b0; mf.bit[1] = b1; mf.t[0] = tq[0]; mf.t[1] = tq[1]; mf.k0 = jb * 64;
                attn_step(sKb, sVb, 72, qf, st, mf, fr, fq);
            }
        }
        { LOAD_GATE(g1, 1) bf16_t* const op2[2] = {OUTP(0), OUTP(1)}; attn_fold_out(op2, st, g1); }
    }
    {
        AttnAcc st; attn_init(st);
        const bf16_t* Kb = ZA + (size_t)(b * S) * ZW + C_KW + g * 64;
        const bf16_t* Vb = (const bf16_t*)(P.ws + W_VWT) + (size_t)bg * 64 * S;
#pragma unroll
        for (int qt = 0; qt < 2; ++qt) {
            const int npad = 511 - tq[qt];
            if (npad > 0) { st.m[qt] = 0.f; st.l[qt] = (fq == 0) ? (float)npad : 0.f; }
        }
        int jlo = t0 - 511; jlo = jlo < 0 ? 0 : (jlo >> 6);
        u32x4 rk = ld64w(Kb + (size_t)(jlo * 64) * ZW, ZW, t512), rv = ld64w(Vb + jlo * 64, S, t512);
        __syncthreads();
#pragma unroll 1
        for (int jb = jlo; jb <= jmax; ++jb) {
            bf16_t* sKb = shKV + ((jb - jlo) & 1) * KVBUF; bf16_t* sVb = sKb + 64 * 80;
            st64w(sKb, rk, t512, 80); st64w(sVb, rv, t512, 72);
            __syncthreads();
            if (jb < jmax) { rk = ld64w(Kb + (size_t)((jb + 1) * 64) * ZW, ZW, t512); rv = ld64w(Vb + (jb + 1) * 64, S, t512); }
            __builtin_amdgcn_sched_barrier(0);
            if (jb * 64 + 63 <= t0 && jb * 64 > t0 + 31 - 512) {
                const float z2[2] = {0.f, 0.f};
                attn_step_fast(sKb, sVb, qf, st, z2, fr, fq);
            } else {
                MaskWin mf; mf.t[0] = tq[0]; mf.t[1] = tq[1]; mf.k0 = jb * 64;
                attn_step(sKb, sVb, 72, qf, st, mf, fr, fq);
            }
        }
        { LOAD_GATE(g2, 2) bf16_t* const op2[2] = {OUTP(0), OUTP(1)}; attn_fold_out(op2, st, g2); }
    }
}


#define XB_TMO      128
#define XB_XCNT(j)  (256  + 64 * (j))
#define XB_XSUB(j)  (1280 + 64 * (j))
#define XB_XGEN(j)  (2304 + 64 * (j))
#define XB_TOP      3328
#define XB_TOPGEN   3392
#define XCD_BAR_WORDS 3456
#define XB_SPIN_CAP (1u << 18)
#define LAS __attribute__((address_space(3)))
DEV unsigned xb_ld(unsigned* p) { return __hip_atomic_load(p, __ATOMIC_RELAXED, __HIP_MEMORY_SCOPE_AGENT); }
DEV unsigned xb_add(unsigned* p, unsigned v) { return __hip_atomic_fetch_add(p, v, __ATOMIC_RELAXED, __HIP_MEMORY_SCOPE_AGENT); }
DEV unsigned xb_xcc_id() { return (unsigned)__builtin_amdgcn_s_getreg((3 << 11) | 20) & 0xFu; }
#define XB_SPIN(cond, bar) do { unsigned _sp = 0; while (cond) { __builtin_amdgcn_s_sleep(1); \
    if ((++_sp & 255u) == 0u) { if (xb_ld(&(bar)[XB_TMO])) break; if (_sp > XB_SPIN_CAP) { atomicAdd(&(bar)[XB_TMO], 1u); break; } } } } while (0)
struct XcdBarrier { unsigned* bar; unsigned x; volatile LAS unsigned* st; };
DEV XcdBarrier xcd_barrier_post(unsigned* bar, volatile LAS unsigned* st) {
    XcdBarrier b; b.bar = bar; b.x = xb_xcc_id(); b.st = st;
    if (threadIdx.x == 0) (void)xb_add(&bar[XB_XCNT(b.x)], 1u);
    return b;
}
DEV void xcd_barrier_complete(unsigned* bar, unsigned x, unsigned& nloc, unsigned& nx) {
    const unsigned G = gridDim.x * gridDim.y * gridDim.z;
    unsigned sum, cnt, mine, sp = 0u;
    for (;;) {
        sum = 0u; cnt = 0u; mine = 0u;
#pragma unroll
        for (unsigned j = 0; j < 16; ++j) { const unsigned c = xb_ld(&bar[XB_XCNT(j)]); sum += c; cnt += (c > 0u) ? 1u : 0u; mine = (j == x) ? c : mine; }
        if (sum == G) break;
        __builtin_amdgcn_s_sleep(1);
        if ((++sp & 255u) == 0u) { if (xb_ld(&bar[XB_TMO])) break; if (sp > XB_SPIN_CAP) { atomicAdd(&bar[XB_TMO], 1u); break; } }
    }
    nloc = mine > 0u ? mine : 1u; nx = cnt > 0u ? cnt : 1u;
}
DEV void xcd_barrier(const XcdBarrier& b) {
    asm volatile("s_waitcnt vmcnt(0)" ::: "memory");
    __syncthreads();
    if (threadIdx.x == 0) {
        unsigned* bar = b.bar;
        __builtin_amdgcn_s_waitcnt(0);
        unsigned nloc = b.st[0], nx = b.st[1];
        if (nloc == 0u) { xcd_barrier_complete(bar, b.x, nloc, nx); b.st[0] = nloc; b.st[1] = nx; }
        const unsigned old = xb_add(&bar[XB_XSUB(b.x)], 1u);
        const unsigned gen = old / nloc;
        if (old + 1u == (gen + 1u) * nloc) {
            __builtin_amdgcn_fence(__ATOMIC_RELEASE, "agent");
            asm volatile("s_waitcnt vmcnt(0)" ::: "memory");
            const unsigned og = xb_add(&bar[XB_TOP], 1u);
            const unsigned tg = og / nx;
            if (og + 1u == (tg + 1u) * nx) xb_add(&bar[XB_TOPGEN], 1u);
            else XB_SPIN(xb_ld(&bar[XB_TOPGEN]) == tg, bar);
            __builtin_amdgcn_fence(__ATOMIC_ACQUIRE, "agent");
            xb_add(&bar[XB_XGEN(b.x)], 1u);
            asm volatile("s_waitcnt vmcnt(0)" ::: "memory");
        } else {
            XB_SPIN(xb_ld(&bar[XB_XGEN(b.x)]) == gen, bar);
            __builtin_amdgcn_fence(__ATOMIC_ACQUIRE, "agent");
            asm volatile("s_waitcnt vmcnt(0)" ::: "memory");
        }
    }
    __syncthreads();
}
constexpr size_t W_BAR = 252 * MiB;

constexpr int HALF_SMEM = 56320;
static_assert(HALF_SMEM == 56320, "update nsa_job");
constexpr int SMEM_BYTES = 131072;

extern __shared__ __attribute__((aligned(16))) char dyn_smem[];
#define RUN_PG8(EPI_T, EPI_OBJ, A_, LDA_, BT_, LDB_, M_, N_, K_) { pg8::Gemm g_; g_.A = (A_); g_.Bt = (BT_); g_.M = (M_); g_.N = (N_); g_.K = (K_); g_.lda = (LDA_); g_.ldb = (LDB_); g_.gather = 0; \
        pg8::StaticOrder so_; so_.init((M_), (N_), (int)gridDim.x, (int)blockIdx.x); __syncthreads(); \
        pg8::gemm_phase<EPI_T, pg8::StaticOrder, true, true>((PG8_LAS unsigned char*)dyn_smem, g_, so_, (EPI_OBJ)); __syncthreads(); }

template <int PH, bool DRY = false>
DEV void run_phase(const Params& P, char* smem) {
    const int nb = gridDim.x, bid = blockIdx.x, sub = opaque_tid512() >> 8;
    char* hsm = smem + sub * HALF_SMEM;
    char* aux = (char*)P.out;
    char* ws = P.ws;
    bf16_t* ZA = (bf16_t*)(ws + W_ZA);
    if (PH == 0) {
        for (int pj = bid; pj < (5088 + 4096 + 512 + 64 + 64) / 2; pj += nb) {
            int j = 2 * pj + sub;
            if (j < 5088) {
                bool done = false;
#define TR(SRC, LD, DSTOFF, KK, NN, MAP, BLK)                                                                                  \
    if (!done) { const int nrt = (NN) / 64, nt = nrt * ((KK) / 64);                                                              \
        if (j < nt) { transpose_tile((SRC), (LD), (bf16_t*)(aux + (DSTOFF)), (KK), (j % nrt) * 64, (j / nrt) * 64, (MAP), hsm, (BLK) ? (NN) : 0); done = true; } else j -= nt; }
                TR(P.w_in, 7984, O_WTA, 1024, 5120, 1, 0)
                TR(P.w_in, 7984, O_WTB, 1024, 4096, 2, 0)
                TR(P.w_up, 4096, O_WTUP, 1024, 4096, 0, 0)
                TR(P.w_down, 1024, O_WTDN, 4096, 1024, 0, 0)
                TR(P.w_o, 1024, O_WTO, 1024, 1024, 0, 0)
                TR(P.w_xo, 1024, O_WTXO, 256, 1024, 0, 0)
                TR(P.w_mkv, 512, O_WTMKV, 1024, 512, 0, 0)
                TR(P.wk1, 256, O_WTCK1, 2048, 256, 0, 0)
                TR(P.wv1, 256, O_WTCV1, 2048, 256, 0, 0)
#undef TR
                if (!done) {
                    if (j < 16) transpose_tile(P.w_a + j * 4096, 64, (bf16_t*)(aux + O_WAT) + j * 4096, 64, 0, 0, 0, hsm);
                    else { j -= 16; transpose_tile(P.w_i + j * 4096, 64, (bf16_t*)(aux + O_WIT) + j * 4096, 64, 0, 0, 0, hsm); }
                }
                continue;
            }
            j -= 5088;
            if (j < 4096) { rownorm<false>(P.x, P.g_mix, (bf16_t*)(ws + W_U), nullptr, j * 4 + (opaque_tid() >> 6)); continue; }
            j -= 4096;
            if (j < 512) { rownorm<false>(P.mem, P.g_mem, (bf16_t*)(aux + O_MEMN), nullptr, j * 4 + (opaque_tid() >> 6)); continue; }
            j -= 512;
            if (j < 64) { rope_job((float*)(aux + O_ROPEC), (float*)(aux + O_ROPES), j); continue; }
            j -= 64;
            posbias_job(P, (float*)(aux + O_PB), j, hsm);
        }
    } else if (PH == 1) {
        { PEpiMemKV ep; ep.MK = (bf16_t*)(aux + O_MEMK); ep.MVT = (bf16_t*)(aux + O_MEMVT);
          RUN_PG8(PEpiMemKV, ep, (const bf16_t*)(aux + O_MEMN), 1024, (const bf16_t*)(aux + O_WTMKV), 1024, 2048, 512, 1024) }
        { PEpiZA ep; ep.ZA = ZA; ep.VST = (bf16_t*)(ws + W_VST); ep.VWT = (bf16_t*)(ws + W_VWT); ep.ropec = (const float*)(aux + O_ROPEC); ep.ropes = (const float*)(aux + O_ROPES);
          RUN_PG8(PEpiZA, ep, (const bf16_t*)(ws + W_U), 1024, (const bf16_t*)(aux + O_WTA), 1024, 16384, 5120, 1024) }
    } else if (PH == 2) {
        { PEpiHid ep; ep.HK = (bf16_t*)(aux + O_HIDK); ep.HV = (bf16_t*)(aux + O_HIDV); ep.pb = (const float*)(aux + O_PB);
          pg8::Gemm g_; g_.A = ZA; g_.Bt = (const bf16_t*)(aux + O_WTCK1); g_.M = 4096; g_.N = 512; g_.K = 2048; g_.lda = ZW; g_.ldb = 2048; g_.gather = 1;
          pg8::StaticOrder so_; so_.init(4096, 512, (int)gridDim.x, (int)blockIdx.x); __syncthreads();
          pg8::gemm_phase<PEpiHid, pg8::StaticOrder, true, true>((PG8_LAS unsigned char*)dyn_smem, g_, so_, ep); __syncthreads(); }
        for (int job = bid; job < 576; job += nb) {
            if (job < 256) rnn_job(P, 2 * job + sub, hsm, DRY);
            else if (job >= 288 && job < 512) xattn_job(P, 2 * (job - 288) + sub, hsm, DRY);
            else if (job >= 544) xattn_job(P, 2 * (job - 320) + sub, hsm, DRY);
        }
    } else if (PH == 3) {
        for (int pj = bid; pj < 1016; pj += nb) cmp2_job(P, 2 * pj + sub);
    } else if (PH == 4) {
        for (int job = bid; job < 1024; job += nb) nsa_job(P, 2 * job + sub, hsm, DRY);
        if (!DRY) { PEpiBf<0> ep; ep.O = (bf16_t*)(ws + W_YX); ep.ldo = 1024;
          RUN_PG8(PEpiBf<0>, ep, ZA + C_QX, ZW, (const bf16_t*)(aux + O_WTXO), 256, 16384, 1024, 256) }
    } else if (PH == 5) {
        { PEpiMerge ep; ep.ZA = ZA; ep.YX = (const bf16_t*)(ws + W_YX); ep.Y = (bf16_t*)(ws + W_Y);
          RUN_PG8(PEpiMerge, ep, (const bf16_t*)(ws + W_U), 1024, (const bf16_t*)(aux + O_WTB), 1024, 16384, 4096, 1024) }
    } else if (PH == 6) {
        { PEpiRes ep; ep.R = P.x; ep.O = (float*)(ws + W_H);
          RUN_PG8(PEpiRes, ep, (const bf16_t*)(ws + W_Y), 1024, (const bf16_t*)(aux + O_WTO), 1024, 16384, 1024, 1024) }
    } else if (PH == 7) {
        for (int pj = bid; pj < 2048; pj += nb) rownorm<false>((const float*)(ws + W_H), P.g_mlp, (bf16_t*)(ws + W_VN), nullptr, (2 * pj + sub) * 4 + (opaque_tid() >> 6));
    } else if (PH == 8) {
        { PEpiBf<1> ep; ep.O = (bf16_t*)(ws + W_HID); ep.ldo = 4096;
          RUN_PG8(PEpiBf<1>, ep, (const bf16_t*)(ws + W_VN), 1024, (const bf16_t*)(aux + O_WTUP), 1024, 16384, 4096, 1024) }
    } else if (PH == 9) {
        { PEpiRes ep; ep.R = (const float*)(ws + W_H); ep.O = (float*)(ws + W_H);
          RUN_PG8(PEpiRes, ep, (const bf16_t*)(ws + W_HID), 4096, (const bf16_t*)(aux + O_WTDN), 4096, 16384, 1024, 4096) }
    } else if (PH == 10) {
        for (int pj = bid; pj < 2048; pj += nb) rownorm<true>((const float*)(ws + W_H), P.g_final, nullptr, P.out, (2 * pj + sub) * 4 + (opaque_tid() >> 6));
    }
}

__global__ void __launch_bounds__(512, 2) mega_kernel(Params P) {
    char* smem = dyn_smem;
    cg::grid_group grid = cg::this_grid();
    __shared__ uint4 xb_words;
    if (threadIdx.x == 0) xb_words = make_uint4(0u, 0u, 0u, 0u);
    __syncthreads();
    XcdBarrier xb = xcd_barrier_post((unsigned*)(P.ws + W_BAR), (volatile LAS unsigned*)&xb_words);
    if (P.ws == nullptr) grid.sync();
#ifndef REP
#define REP -1
#endif
#define GSYNC() xcd_barrier(xb)
#define PHASE(k) { if (REP == k && k != 9) { run_phase<k, true>(P, smem); GSYNC(); } run_phase<k>(P, smem); GSYNC(); }
    PHASE(0) PHASE(1) PHASE(2) PHASE(3) PHASE(4) PHASE(5) PHASE(6) PHASE(7) PHASE(8) PHASE(9)
    if (REP == 10) { run_phase<10>(P, smem); GSYNC(); }
    if (REP == 11) { GSYNC(); GSYNC(); GSYNC(); GSYNC(); GSYNC(); GSYNC(); GSYNC(); GSYNC(); GSYNC(); GSYNC(); }
    run_phase<10>(P, smem);
}

extern "C" void kernel_launch(void* const* d_in, const int* in_sizes, int n_in, void* d_out, int out_size, void* d_ws, size_t ws_size,
                              hipStream_t stream) {
    Params P{};
    const float** pp = (const float**)&P;
    for (int i = 0; i < 25; ++i) pp[i] = (const float*)d_in[i];
    P.out = (float*)d_out;
    P.ws = (char*)d_ws;
    static int grid_blocks = 0;
    if (!grid_blocks) {
        int dev = 0, cus = 0, per_cu = 0;
        hipGetDevice(&dev);
        hipDeviceGetAttribute(&cus, hipDeviceAttributeMultiprocessorCount, dev);
        hipFuncSetAttribute((const void*)mega_kernel, hipFuncAttributeMaxDynamicSharedMemorySize, SMEM_BYTES);
        hipOccupancyMaxActiveBlocksPerMultiprocessor(&per_cu, mega_kernel, 512, SMEM_BYTES);
        if (per_cu > 1) per_cu = 1;
        if (per_cu < 1) per_cu = 1;
        grid_blocks = cus * per_cu;
    }
    hipMemsetAsync((char*)d_ws + W_BAR, 0, XCD_BAR_WORDS * 4, stream);
    void* args[] = {&P};
    hipError_t e = hipLaunchCooperativeKernel((void*)mega_kernel, dim3(grid_blocks), dim3(512), args, SMEM_BYTES, stream);
    if (e != hipSuccess) fprintf(stderr, "cooperative launch failed: %s (grid %d)\n", hipGetErrorString(e), grid_blocks);
}
```
